# Optimizing an MI355X kernel written in HIP

```python
import math
import jax, jax.numpy as jnp
from jax import lax
import numpy as np

D_MODEL = 1024
BATCH = 4
SEQ = 4096
DEPTH = 2

GRID_W = 64
CTX_LEN = 256
HEAD_DIM = 64
N_EVEN = (DEPTH + 1) // 2
N_ODD = DEPTH // 2
ROPE_THETA = 10000.0
EPS = 1e-6
ATTN_SCALE = HEAD_DIM ** -0.5

A_HEADS = 8
A_KV_HEADS = 2
A_WINDOW = 128
A_BLOCK = 128
B_HEADS = 8
B_WIN_H = 8
B_WIN_W = 16
C_HEADS = 8
C_KV_HEADS = 2
C_BLOCK = 128
D_CH = 512
HY_ORDER = 2
HY_SHORT = 3
HY_BANDS = 16
HY_EMB = 1 + 2 * HY_BANDS
HY_FFN = 64
HY_MAX_DECAY = math.log(1e-2) / 0.3
HY_MIN_DECAY = math.log(1e-2) / 1.5

A_Q = A_HEADS * HEAD_DIM
A_KV = A_KV_HEADS * HEAD_DIM
B_W = B_HEADS * HEAD_DIM
C_Q = C_HEADS * HEAD_DIM
C_KV = C_KV_HEADS * HEAD_DIM
EVEN_SPLIT = (A_Q, A_KV, A_KV, B_W, B_W, B_W)
ODD_SPLIT = (C_Q, C_KV, C_KV, 3 * D_CH)
EVEN_IN = A_Q + 2 * A_KV + 3 * B_W
ODD_IN = C_Q + 2 * C_KV + 3 * D_CH
EVEN_OUT = A_Q + B_W
ODD_OUT = C_Q + D_CH

N_EXPERTS = 16
N_GROUPS = 4
EXPERTS_PER_GROUP = N_EXPERTS // N_GROUPS
TOP_K = 2
D_EXPERT = 512

kernel_name = 'hybrid_flow_backbone_block'

F32 = jnp.float32


def rmsnorm(x, g):
    xf = x.astype(F32)
    y = xf * lax.rsqrt(jnp.mean(xf * xf, axis=-1, keepdims=True) + EPS)
    return (y * g.astype(F32)).astype(x.dtype)


def split_cols(p, sizes):
    return jnp.split(p, [int(v) for v in np.cumsum(sizes)[:-1]], axis=-1)


def heads(t, n):
    return t.reshape(t.shape[0], t.shape[1], n, HEAD_DIM)


def joint_softmax(parts):
    sizes = [p.shape[-1] for p in parts]
    probs = jax.nn.softmax(jnp.concatenate(parts, axis=-1), axis=-1)
    return jnp.split(probs, [int(v) for v in np.cumsum(sizes)[:-1]], axis=-1)


def rope_tables(S):
    t = jnp.arange(S)
    row = (t // GRID_W).astype(F32)
    col = (t % GRID_W).astype(F32)
    half = HEAD_DIM // 2
    inv = ROPE_THETA ** (-jnp.arange(0, half, 2, dtype=F32) / half)
    ar = row[:, None] * inv[None]
    ac = col[:, None] * inv[None]
    return (jnp.cos(ar)[:, None, :], jnp.sin(ar)[:, None, :], jnp.cos(ac)[:, None, :], jnp.sin(ac)[:, None, :])


def _rot(x, cos, sin):
    m = x.shape[-1] // 2
    x1, x2 = x[..., :m], x[..., m:]
    return jnp.concatenate([x1 * cos - x2 * sin, x2 * cos + x1 * sin], axis=-1)


def rope2d(x, rope):
    cr, sr, cc, sc = rope
    xf = x.astype(F32)
    half = HEAD_DIM // 2
    return jnp.concatenate([_rot(xf[..., :half], cr, sr), _rot(xf[..., half:], cc, sc)], axis=-1).astype(x.dtype)


def ctx_self_attention(q, k, v, sink=None):
    B, L, H, d = q.shape
    HKV = k.shape[2]
    G = H // HKV
    qg = q.reshape(B, L, HKV, G, d)
    s = jnp.einsum('bqkgd,bjkd->bkgqj', qg, k).astype(F32) * ATTN_SCALE
    parts = [s]
    if sink is not None:
        parts.append(jnp.broadcast_to(sink.astype(F32).reshape(1, HKV, G, 1, 1), s.shape[:-1] + (1,)))
    p = joint_softmax(parts)[0]
    o = jnp.einsum('bkgqj,bjkd->bqkgd', p.astype(v.dtype), v)
    return o.reshape(B, L, H * d)


def window_attention(q, k, v, kc, vc, sink):
    B, S, H, d = q.shape
    HKV = k.shape[2]
    G = H // HKV
    nb = S // A_BLOCK
    n_side = -(-A_WINDOW // A_BLOCK)
    pad = n_side * A_BLOCK
    nw = 2 * n_side + 1
    qb = q.reshape(B, nb, A_BLOCK, HKV, G, d)
    kp = jnp.pad(k, ((0, 0), (pad, pad), (0, 0), (0, 0))).reshape(B, nb + 2 * n_side, A_BLOCK, HKV, d)
    vp = jnp.pad(v, ((0, 0), (pad, pad), (0, 0), (0, 0))).reshape(B, nb + 2 * n_side, A_BLOCK, HKV, d)
    kw = jnp.concatenate([kp[:, i:i + nb] for i in range(nw)], axis=2)
    vw = jnp.concatenate([vp[:, i:i + nb] for i in range(nw)], axis=2)
    qpos = (jnp.arange(nb) * A_BLOCK)[:, None] + jnp.arange(A_BLOCK)[None]
    kpos = (jnp.arange(nb) * A_BLOCK - pad)[:, None] + jnp.arange(nw * A_BLOCK)[None]
    mask = ((jnp.abs(qpos[:, :, None] - kpos[:, None, :]) <= A_WINDOW)
            & (kpos[:, None, :] >= 0) & (kpos[:, None, :] < S))
    s_loc = jnp.einsum('bnqkgd,bnjkd->bnkgqj', qb, kw).astype(F32) * ATTN_SCALE
    s_loc = jnp.where(mask[None, :, None, None], s_loc, -jnp.inf)
    s_ctx = jnp.einsum('bnqkgd,bjkd->bnkgqj', qb, kc).astype(F32) * ATTN_SCALE
    s_sink = jnp.broadcast_to(sink.astype(F32).reshape(1, 1, HKV, G, 1, 1), s_loc.shape[:-1] + (1,))
    p_loc, p_ctx, _ = joint_softmax([s_loc, s_ctx, s_sink])
    o = (jnp.einsum('bnkgqj,bnjkd->bnqkgd', p_loc.astype(v.dtype), vw)
         + jnp.einsum('bnkgqj,bjkd->bnqkgd', p_ctx.astype(vc.dtype), vc))
    return o.reshape(B, S, H * d)


def neighbourhood_attention(q, k, v, kc, vc, rpb):
    B, S, H, d = q.shape
    R = S // GRID_W
    kh = min(B_WIN_H, R)
    qg = q.reshape(B, R, GRID_W, H, d)
    kg = k.reshape(B, R, GRID_W, H, d)
    vg = v.reshape(B, R, GRID_W, H, d)
    r = jnp.arange(R)
    rs = jnp.clip(r - kh // 2, 0, R - kh)
    row_idx = rs[:, None] + jnp.arange(kh)[None]
    k_rows = kg[:, row_idx]
    v_rows = vg[:, row_idx]
    col = jnp.arange(GRID_W)
    cs = jnp.clip(col - B_WIN_W // 2, 0, GRID_W - B_WIN_W)
    colmask = (col[None, :] >= cs[:, None]) & (col[None, :] < cs[:, None] + B_WIN_W)
    dr = row_idx - r[:, None]
    dc = jnp.clip(col[None, :] - col[:, None], -(B_WIN_W - 1), B_WIN_W - 1)
    bias = rpb[:, dr[:, :, None, None] + B_WIN_H - 1, dc[None, None] + B_WIN_W - 1]
    bias = bias.transpose(1, 0, 3, 2, 4).astype(F32)
    s = jnp.einsum('brqhd,brkwhd->brhqkw', qg, k_rows).astype(F32) * ATTN_SCALE + bias[None]
    s = jnp.where(colmask[:, None, :], s, -jnp.inf).reshape(B, R, H, GRID_W, kh * GRID_W)
    s_ctx = jnp.einsum('brqhd,bjhd->brhqj', qg, kc).astype(F32) * ATTN_SCALE
    p_loc, p_ctx = joint_softmax([s, s_ctx])
    p_loc = p_loc.reshape(B, R, H, GRID_W, kh, GRID_W)
    o = (jnp.einsum('brhqkw,brkwhd->brqhd', p_loc.astype(v.dtype), v_rows)
         + jnp.einsum('brhqj,bjhd->brqhd', p_ctx.astype(vc.dtype), vc))
    return o.reshape(B, S, H * d)


def block_attention(q, k, v):
    B, S, H, d = q.shape
    HKV = k.shape[2]
    G = H // HKV
    nb = S // C_BLOCK
    qb = q.reshape(B, nb, C_BLOCK, HKV, G, d).transpose(1, 0, 2, 3, 4, 5)

    def one(qi):
        s = jnp.einsum('bqkgd,bjkd->bkgqj', qi, k).astype(F32) * ATTN_SCALE
        p = jax.nn.softmax(s, axis=-1).astype(v.dtype)
        return jnp.einsum('bkgqj,bjkd->bqkgd', p, v)

    o = lax.map(one, qb)
    return o.transpose(1, 0, 2, 3, 4, 5).reshape(B, S, H * d)


def short_conv(u, w, b):
    K, C = w.shape
    pad = K // 2
    y = lax.conv_general_dilated(u, w[:, None, :].astype(u.dtype), window_strides=(1,),
                                 padding=[(pad, K - 1 - pad)], dimension_numbers=('NWC', 'WIO', 'NWC'),
                                 feature_group_count=C)
    return y + b


def implicit_filters(L, w1, b1, f1, w2, b2, f2, w3, b3):
    t = jnp.arange(L, dtype=F32)
    tn = t / max(L - 1, 1)
    bands = jnp.linspace(1e-4, HY_BANDS - 1, HY_BANDS, dtype=F32)
    ang = 2.0 * math.pi * t[:, None] * bands[None] / L
    feats = jnp.concatenate([tn[:, None], jnp.cos(ang), jnp.sin(ang)], axis=-1)
    h = jnp.sin(f1 * (feats @ w1 + b1))
    h = jnp.sin(f2 * (h @ w2 + b2))
    h = (h @ w3 + b3).astype(F32).reshape(L, 2, HY_ORDER, D_CH)
    deltas = jnp.abs(jnp.linspace(HY_MIN_DECAY, HY_MAX_DECAY, D_CH, dtype=F32))
    decay = jnp.exp(-tn[:, None] * deltas[None])
    h = h * decay[:, None, None, :]
    return h / (jnp.sum(jnp.abs(h), axis=(0, 1), keepdims=True) + EPS)


def long_conv(z, hf, hb):
    L, C = hf.shape
    kf = jnp.concatenate([hf, jnp.zeros((1, C), F32), hb[1:][::-1]], axis=0)
    Z = jnp.fft.rfft(z.astype(F32), n=2 * L, axis=1)
    Kf = jnp.fft.rfft(kf, axis=0)
    y = jnp.fft.irfft(Z * Kf[None], n=2 * L, axis=1)[:, :L]
    return y.astype(z.dtype)


def hyena(u, sw, sb, w1, b1, f1, w2, b2, f2, w3, b3, hbias):
    L = u.shape[1]
    u = short_conv(u, sw, sb)
    v, g1, g2 = split_cols(u, (D_CH, D_CH, D_CH))
    h = implicit_filters(L, w1, b1, f1, w2, b2, f2, w3, b3)
    z = v
    for o, g in enumerate((g1, g2)):
        z = g * (long_conv(z, h[:, 0, o], h[:, 1, o]) + z * hbias[o])
    return z


def even_mixer(hx, hc, w_in, w_out, sink, rpb, rope, need_ctx):
    aq, ak, av, bq, bk, bv = split_cols(hx @ w_in, EVEN_SPLIT)
    caq, cak, cav, cbq, cbk, cbv = split_cols(hc @ w_in, EVEN_SPLIT)
    aq, ak, av = heads(aq, A_HEADS), heads(ak, A_KV_HEADS), heads(av, A_KV_HEADS)
    bq, bk, bv = heads(bq, B_HEADS), heads(bk, B_HEADS), heads(bv, B_HEADS)
    caq, cak, cav = heads(caq, A_HEADS), heads(cak, A_KV_HEADS), heads(cav, A_KV_HEADS)
    cbq, cbk, cbv = heads(cbq, B_HEADS), heads(cbk, B_HEADS), heads(cbv, B_HEADS)
    ya = window_attention(rope2d(aq, rope), rope2d(ak, rope), av, cak, cav, sink)
    yb = neighbourhood_attention(bq, bk, bv, cbk, cbv, rpb)
    yx = jnp.concatenate([ya, yb], axis=-1) @ w_out
    if not need_ctx:
        return yx, None
    yc = jnp.concatenate([ctx_self_attention(caq, cak, cav, sink), ctx_self_attention(cbq, cbk, cbv)], axis=-1) @ w_out
    return yx, yc


def odd_mixer(hx, hc, w_in, w_out, qn, kn, hy, rope, need_ctx):
    qx, kx, vx, ux = split_cols(hx @ w_in, ODD_SPLIT)
    qc, kc, vc, uc = split_cols(hc @ w_in, ODD_SPLIT)
    qx = rope2d(rmsnorm(heads(qx, C_HEADS), qn), rope)
    kx = rope2d(rmsnorm(heads(kx, C_KV_HEADS), kn), rope)
    vx = heads(vx, C_KV_HEADS)
    qc = rmsnorm(heads(qc, C_HEADS), qn)
    kc = rmsnorm(heads(kc, C_KV_HEADS), kn)
    vc = heads(vc, C_KV_HEADS)
    y_attn = block_attention(qx, jnp.concatenate([kc, kx], axis=1), jnp.concatenate([vc, vx], axis=1))
    y_hy = hyena(ux, *hy)
    yx = jnp.concatenate([y_attn, y_hy], axis=-1) @ w_out
    if not need_ctx:
        return yx, None
    yc = jnp.concatenate([ctx_self_attention(qc, kc, vc), hyena(uc, *hy)], axis=-1) @ w_out
    return yx, yc


def moe(h, w_router, b_router, wg, wu, wd):
    Bsz, L, D = h.shape
    t = h.reshape(Bsz * L, D)
    T = t.shape[0]
    s = jax.nn.sigmoid((t @ w_router).astype(F32))
    sel = s + b_router.astype(F32)
    gscore = lax.top_k(sel.reshape(T, N_GROUPS, EXPERTS_PER_GROUP), TOP_K)[0].sum(-1)
    gbest = jnp.argmax(gscore, axis=-1)
    in_group = (jnp.arange(N_EXPERTS) // EXPERTS_PER_GROUP)[None, :] == gbest[:, None]
    _, idx = lax.top_k(jnp.where(in_group, sel, -jnp.inf), TOP_K)
    wsel = jnp.take_along_axis(s, idx, axis=-1)
    wsel = wsel / jnp.sum(wsel, axis=-1, keepdims=True)
    combine = jnp.sum(jax.nn.one_hot(idx, N_EXPERTS, dtype=F32) * wsel[..., None], axis=1).astype(h.dtype)
    y = jnp.zeros_like(t)
    for e in range(N_EXPERTS):
        he = jax.nn.silu(t @ wg[e]) * (t @ wu[e])
        y = y + combine[:, e:e + 1] * (he @ wd[e])
    return y.reshape(Bsz, L, D)


def setup_inputs(seed: int = 0) -> dict:
    key = jax.random.key(seed)
    ks = iter(jax.random.split(key, 40))

    def nrm(shape, scale):
        return jax.random.normal(next(ks), shape, F32) * scale

    D = D_MODEL
    return {
        'x': nrm((BATCH, SEQ, D), 1.0),
        'c': nrm((BATCH, D), 1.0),
        'ctx': nrm((BATCH, CTX_LEN, D), 1.0),
        'c_ctx': nrm((D,), 1.0),
        'w_ada': nrm((DEPTH, D, 6 * D), 0.5 * D ** -0.5),
        'b_ada': nrm((DEPTH, 6 * D), 0.02),
        'norm_g': 1.0 + nrm((DEPTH, 2, D), 0.02),
        'final_g': 1.0 + nrm((D,), 0.02),
        'w_in_even': nrm((N_EVEN, D, EVEN_IN), D ** -0.5),
        'w_out_even': nrm((N_EVEN, EVEN_OUT, D), EVEN_OUT ** -0.5),
        'a_sink': nrm((N_EVEN, A_HEADS), 0.5),
        'b_rpb': nrm((N_EVEN, B_HEADS, 2 * B_WIN_H - 1, 2 * B_WIN_W - 1), 0.1),
        'w_in_odd': nrm((N_ODD, D, ODD_IN), D ** -0.5),
        'w_out_odd': nrm((N_ODD, ODD_OUT, D), ODD_OUT ** -0.5),
        'c_qnorm': 1.0 + nrm((N_ODD, HEAD_DIM), 0.02),
        'c_knorm': 1.0 + nrm((N_ODD, HEAD_DIM), 0.02),
        'hy_short_w': nrm((N_ODD, HY_SHORT, 3 * D_CH), HY_SHORT ** -0.5),
        'hy_short_b': nrm((N_ODD, 3 * D_CH), 0.02),
        'hy_w1': nrm((N_ODD, HY_EMB, HY_FFN), HY_EMB ** -0.5),
        'hy_b1': nrm((N_ODD, HY_FFN), 0.02),
        'hy_f1': 1.0 + nrm((N_ODD, HY_FFN), 0.1),
        'hy_w2': nrm((N_ODD, HY_FFN, HY_FFN), HY_FFN ** -0.5),
        'hy_b2': nrm((N_ODD, HY_FFN), 0.02),
        'hy_f2': 1.0 + nrm((N_ODD, HY_FFN), 0.1),
        'hy_w3': nrm((N_ODD, HY_FFN, 2 * HY_ORDER * D_CH), HY_FFN ** -0.5),
        'hy_b3': nrm((N_ODD, 2 * HY_ORDER * D_CH), 0.02),
        'hy_bias': nrm((N_ODD, HY_ORDER, D_CH), 0.5),
        'w_router': nrm((D, N_EXPERTS), D ** -0.5),
        'b_router': nrm((N_EXPERTS,), 0.01),
        'moe_wg': nrm((DEPTH, N_EXPERTS, D, D_EXPERT), D ** -0.5),
        'moe_wu': nrm((DEPTH, N_EXPERTS, D, D_EXPERT), D ** -0.5),
        'moe_wd': nrm((DEPTH, N_EXPERTS, D_EXPERT, D), D_EXPERT ** -0.5),
    }


def reference(x, c, ctx, c_ctx, w_ada, b_ada, norm_g, final_g,
              w_in_even, w_out_even, a_sink, b_rpb,
              w_in_odd, w_out_odd, c_qnorm, c_knorm,
              hy_short_w, hy_short_b, hy_w1, hy_b1, hy_f1, hy_w2, hy_b2, hy_f2, hy_w3, hy_b3, hy_bias,
              w_router, b_router, moe_wg, moe_wu, moe_wd):
    B, S, D = x.shape
    rope = rope_tables(S)
    sc = jax.nn.silu(c)
    scc = jax.nn.silu(c_ctx)
    xc = ctx
    for l in range(DEPTH):
        need_ctx = l < DEPTH - 1
        mx = (sc @ w_ada[l] + b_ada[l]).reshape(B, 6, 1, D)
        mc = (scc @ w_ada[l] + b_ada[l]).reshape(6, 1, 1, D)
        hx = rmsnorm(x, norm_g[l, 0]) * (1.0 + mx[:, 1]) + mx[:, 0]
        hc = rmsnorm(xc, norm_g[l, 0]) * (1.0 + mc[1]) + mc[0]
        i = l // 2
        if l % 2 == 0:
            yx, yc = even_mixer(hx, hc, w_in_even[i], w_out_even[i], a_sink[i], b_rpb[i], rope, need_ctx)
        else:
            hy = (hy_short_w[i], hy_short_b[i], hy_w1[i], hy_b1[i], hy_f1[i], hy_w2[i], hy_b2[i], hy_f2[i],
                  hy_w3[i], hy_b3[i], hy_bias[i])
            yx, yc = odd_mixer(hx, hc, w_in_odd[i], w_out_odd[i], c_qnorm[i], c_knorm[i], hy, rope, need_ctx)
        x = x + mx[:, 2] * yx
        hx = rmsnorm(x, norm_g[l, 1]) * (1.0 + mx[:, 4]) + mx[:, 3]
        if need_ctx:
            xc = xc + mc[2] * yc
            hc = rmsnorm(xc, norm_g[l, 1]) * (1.0 + mc[4]) + mc[3]
            y_all = moe(jnp.concatenate([hc, hx], axis=1), w_router, b_router, moe_wg[l], moe_wu[l], moe_wd[l])
            xc = xc + mc[5] * y_all[:, :CTX_LEN]
            x = x + mx[:, 5] * y_all[:, CTX_LEN:]
        else:
            x = x + mx[:, 5] * moe(hx, w_router, b_router, moe_wg[l], moe_wu[l], moe_wd[l])
    return rmsnorm(x, final_g)
```

```cpp
#include <hip/hip_runtime.h>
#include <cstdio>
#include <math.h>
#include <stdint.h>
#include <string.h>

#ifdef CPU_TEST
#define HD
#define GLOBAL
struct U3 { unsigned x, y, z; };
static thread_local U3 threadIdx, blockIdx, blockDim, gridDim;
static inline int atomicAdd(int* p, int v) { return __sync_fetch_and_add(p, v); }
#else
#define HD __device__ __forceinline__
#define GLOBAL __global__ __launch_bounds__(256)
#endif

#if defined(HY_TEST)
constexpr int D_MODEL = 64, BATCH = 2, SEQ = 4096, GRID_W = 64, CTX_LEN = 64, D_CH = 4, D_EXPERT = 64;
#elif defined(SMALL_CFG)
constexpr int D_MODEL = 128, BATCH = 2, SEQ = 512, GRID_W = 32, CTX_LEN = 64, D_CH = 32, D_EXPERT = 64;
#else
constexpr int D_MODEL = 1024, BATCH = 4, SEQ = 4096, GRID_W = 64, CTX_LEN = 256, D_CH = 512, D_EXPERT = 512;
#endif
constexpr int DEPTH = 2, HEAD_DIM = 64;
constexpr int GRID_H = SEQ / GRID_W;
constexpr int A_WINDOW = 128;
constexpr int B_WIN_H = 8, B_WIN_W = 16;
constexpr int HY_BANDS = 16, HY_EMB = 33, HY_FFN = 64;
constexpr int EVEN_IN = 2304, EVEN_OUT = 1024;
constexpr int ODD_IN = 768 + 3 * D_CH, ODD_OUT = 512 + D_CH;
constexpr int N_EXPERTS = 16;
constexpr int TX = BATCH * SEQ, TC = BATCH * CTX_LEN, TT = TX + TC;
constexpr int LKV = CTX_LEN + SEQ;
constexpr int NPAIR = 24;
constexpr int HE_W = 2 * D_EXPERT;
constexpr float EPS = 1e-6f;
constexpr float ATTN_SCALE = 0.125f;

typedef unsigned short bf16_t;
HD bf16_t f2bf(float f) { unsigned u; __builtin_memcpy(&u, &f, 4); u = (u + 0x7fffu + ((u >> 16) & 1u)) >> 16; return (bf16_t)u; }
HD float bf2f(bf16_t h) { unsigned u = ((unsigned)h) << 16; float f; __builtin_memcpy(&f, &u, 4); return f; }
HD float silu_f(float x) { return x / (1.0f + expf(-x)); }
HD float sigmoid_f(float x) { return 1.0f / (1.0f + expf(-x)); }

struct Params {
    const float *x, *c, *ctx, *c_ctx, *w_ada, *b_ada, *norm_g, *final_g, *w_in_even, *w_out_even, *a_sink, *b_rpb;
    const float *w_in_odd, *w_out_odd, *c_qnorm, *c_knorm, *hy_short_w, *hy_short_b, *hy_w1, *hy_b1, *hy_f1, *hy_w2;
    const float *hy_b2, *hy_f2, *hy_w3, *hy_b3, *hy_bias, *w_router, *b_router, *moe_wg, *moe_wu, *moe_wd;
    float* out;
    float* XC;
    float* mod;
    float* ropet;
    float* h1;
    float* h2;
    float* HFT;
    float* hnorm;
    bf16_t* hbuf;
    bf16_t *QA, *KA, *VAt, *QB, *KB, *VBt;
    bf16_t *QC, *KC, *VCt, *UT;
    bf16_t* Y;
    bf16_t* YHT;
    float* Z1;
    bf16_t* HE;
    int* cnt;
    int* list;
    float* tokw;
    bf16_t *Wt_in_even, *Wt_out_even, *Wt_in_odd, *Wt_out_odd, *Wt_gu, *Wt_d;
    unsigned* bar;
};

#define GS_LOOP(i, n) for (long i = (long)blockIdx.x * blockDim.x + threadIdx.x; i < (long)(n); i += (long)gridDim.x * blockDim.x)

HD const float* xrow_in(const Params& p, int l, int row) {
    if (l == 0) return row < TX ? p.x + (size_t)row * D_MODEL : p.ctx + (size_t)(row - TX) * D_MODEL;
    return row < TX ? p.out + (size_t)row * D_MODEL : p.XC + (size_t)(row - TX) * D_MODEL;
}
HD float* xrow_cur(const Params& p, int row) { return row < TX ? p.out + (size_t)row * D_MODEL : p.XC + (size_t)(row - TX) * D_MODEL; }
HD int row_mod(int row) { return row < TX ? row / SEQ : BATCH; }
HD const float* modp(const Params& p, int l, int row, int which) { return p.mod + ((size_t)(l * (BATCH + 1) + row_mod(row)) * 6 + which) * D_MODEL; }

GLOBAL void nk_mod(Params p) {
    GS_LOOP(i, DEPTH * (BATCH + 1) * 6 * D_MODEL) {
        int j = i % (6 * D_MODEL); int r = (i / (6 * D_MODEL)) % (BATCH + 1); int l = i / (6 * D_MODEL * (BATCH + 1));
        const float* cv = r < BATCH ? p.c + r * D_MODEL : p.c_ctx;
        const float* w = p.w_ada + (size_t)l * D_MODEL * 6 * D_MODEL;
        float acc = 0.f;
        for (int k = 0; k < D_MODEL; ++k) acc += silu_f(cv[k]) * w[(size_t)k * 6 * D_MODEL + j];
        p.mod[i] = acc + p.b_ada[l * 6 * D_MODEL + j];
    }
}
HD void d_rope(const Params& p) {
    GS_LOOP(i, 64 * 16) {
        int pos = i / 16, k = i % 16;
        float inv = powf(10000.0f, -(float)(2 * k) / 32.0f);
        float a = (float)pos * inv;
        p.ropet[pos * 32 + k] = cosf(a); p.ropet[pos * 32 + 16 + k] = sinf(a);
    }
}
HD void d_hy_h1(const Params& p) {
    GS_LOOP(i, SEQ * HY_FFN) {
        int t = i / HY_FFN, k = i % HY_FFN;
        float tn = (float)t / (float)(SEQ - 1);
        float acc = tn * p.hy_w1[0 * HY_FFN + k];
        for (int b = 0; b < HY_BANDS; ++b) {
            float band = 1e-4f + (float)b * ((float)(HY_BANDS - 1) - 1e-4f) / (float)(HY_BANDS - 1);
            float ang = 2.0f * 3.14159265358979323846f * (float)t * band / (float)SEQ;
            acc += cosf(ang) * p.hy_w1[(1 + b) * HY_FFN + k] + sinf(ang) * p.hy_w1[(1 + HY_BANDS + b) * HY_FFN + k];
        }
        p.h1[i] = sinf(p.hy_f1[k] * (acc + p.hy_b1[k]));
    }
}
HD void d_hy_h2(const Params& p) {
    GS_LOOP(i, SEQ * HY_FFN) {
        int t = i / HY_FFN, j = i % HY_FFN;
        float acc = 0.f;
        for (int k = 0; k < HY_FFN; ++k) acc += p.h1[t * HY_FFN + k] * p.hy_w2[k * HY_FFN + j];
        p.h2[i] = sinf(p.hy_f2[j] * (acc + p.hy_b2[j]));
    }
}
HD float hy_decay(int t, int c) {
    const float mind = logf(1e-2f) / 1.5f, maxd = logf(1e-2f) / 0.3f;
    float delta = fabsf(mind + (float)c * (maxd - mind) / (float)(D_CH - 1));
    float tn = (float)t / (float)(SEQ - 1);
    return expf(-tn * delta);
}
GLOBAL void nk_hy_filt(Params p) {
    GS_LOOP(i, 4 * D_CH * SEQ) {
        int t = i % SEQ, col = i / SEQ, c = col % D_CH;
        float acc = p.hy_b3[col];
        for (int k = 0; k < HY_FFN; ++k) acc += p.h2[t * HY_FFN + k] * p.hy_w3[k * 4 * D_CH + col];
        p.HFT[i] = acc * hy_decay(t, c);
    }
}
GLOBAL void nk_hy_norm(Params p) {
    GS_LOOP(i, 2 * D_CH) {
        int o = i / D_CH, c = i % D_CH;
        float s = 0.f;
        for (int dir = 0; dir < 2; ++dir) { const float* h = p.HFT + (size_t)((dir * 2 + o) * D_CH + c) * SEQ; for (int t = 0; t < SEQ; ++t) s += fabsf(h[t]); }
        p.hnorm[i] = s + EPS;
    }
}
GLOBAL void nk_zero_cnt(Params p) { GS_LOOP(i, 64) p.cnt[i] = 0; }

GLOBAL void nk_norm(Params p, int l, int which, int nrows) {
    GS_LOOP(row, nrows) {
        const float* xr = which == 0 ? xrow_in(p, l, (int)row) : xrow_cur(p, (int)row);
        float ss = 0.f;
        for (int k = 0; k < D_MODEL; ++k) ss += xr[k] * xr[k];
        float rstd = 1.0f / sqrtf(ss / D_MODEL + EPS);
        const float* g = p.norm_g + (l * 2 + which) * D_MODEL;
        const float* sh = modp(p, l, (int)row, which * 3 + 0); const float* sc = modp(p, l, (int)row, which * 3 + 1);
        for (int k = 0; k < D_MODEL; ++k) p.hbuf[row * D_MODEL + k] = f2bf(xr[k] * rstd * g[k] * (1.0f + sc[k]) + sh[k]);
    }
}

HD float dot_row(const bf16_t* a, const float* W, int ldw, int col, int K) {
    float acc = 0.f;
    for (int k = 0; k < K; ++k) acc += bf2f(a[k]) * W[(size_t)k * ldw + col];
    return acc;
}
HD float rope_apply(const Params& p, float v, float partner, int d, int s) {
    int half = d >> 5, dd = d & 31, k = dd & 15;
    int pos = half == 0 ? s / GRID_W : s % GRID_W;
    float c = p.ropet[pos * 32 + k], sn = p.ropet[pos * 32 + 16 + k];
    return dd < 16 ? v * c - partner * sn : v * c + partner * sn;
}

GLOBAL void nk_inproj_even(Params p) {
    GS_LOOP(i, (long)TT * EVEN_IN) {
        int row = i / EVEN_IN, col = i % EVEN_IN;
        const bf16_t* a = p.hbuf + (size_t)row * D_MODEL;
        float v = dot_row(a, p.w_in_even, EVEN_IN, col, D_MODEL);
        bool lat = row < TX; int b = lat ? row / SEQ : (row - TX) / CTX_LEN; int s = lat ? row % SEQ : (row - TX) % CTX_LEN;
        int pos = lat ? CTX_LEN + s : s;
        if (col < 640) {
            int d = col & 63;
            if (lat) { int pc = (d & 31) < 16 ? col + 16 : col - 16; float pv = dot_row(a, p.w_in_even, EVEN_IN, pc, D_MODEL); v = rope_apply(p, v, pv, d, s); }
            if (col < 512) p.QA[(size_t)row * 512 + col] = f2bf(v);
            else { int h = (col - 512) >> 6; p.KA[((size_t)(b * 2 + h) * LKV + pos) * 64 + d] = f2bf(v); }
        } else if (col < 768) { int h = (col - 640) >> 6, d = col & 63; p.VAt[((size_t)(b * 2 + h) * 64 + d) * LKV + pos] = f2bf(v); }
        else if (col < 1280) p.QB[(size_t)row * 512 + (col - 768)] = f2bf(v);
        else if (col < 1792) { int h = (col - 1280) >> 6, d = col & 63; p.KB[((size_t)(b * 8 + h) * LKV + pos) * 64 + d] = f2bf(v); }
        else { int h = (col - 1792) >> 6, d = col & 63; p.VBt[((size_t)(b * 8 + h) * 64 + d) * LKV + pos] = f2bf(v); }
    }
}

struct OSM { float m, l; };
#define ATT_BEGIN() float q[64], acc[64]; for (int d = 0; d < 64; ++d) { q[d] = bf2f(qp[d]) * ATTN_SCALE; acc[d] = 0.f; } float m_ = -1e30f, l_ = 0.f;
#define ATT_KEY(Kp, Vt, key, bias) do { const bf16_t* kk_ = (Kp) + (size_t)(key) * 64; float s_ = (bias); for (int d = 0; d < 64; ++d) s_ += q[d] * bf2f(kk_[d]); \
    float mn_ = fmaxf(m_, s_); float f_ = expf(m_ - mn_), pe_ = expf(s_ - mn_); l_ = l_ * f_ + pe_; \
    for (int d = 0; d < 64; ++d) acc[d] = acc[d] * f_ + pe_ * bf2f((Vt)[(size_t)d * LKV + (key)]); m_ = mn_; } while (0)
#define ATT_SINK(sv) do { float s_ = (sv); float mn_ = fmaxf(m_, s_); float f_ = expf(m_ - mn_); l_ = l_ * f_ + expf(s_ - mn_); for (int d = 0; d < 64; ++d) acc[d] *= f_; m_ = mn_; } while (0)

GLOBAL void nk_attnA(Params p) {
    GS_LOOP(i, (long)TX * 8) {
        int h = i % 8, row = i / 8, b = row / SEQ, s = row % SEQ, kvh = h / 4;
        const bf16_t* qp = p.QA + (size_t)row * 512 + h * 64;
        const bf16_t* Kp = p.KA + (size_t)(b * 2 + kvh) * LKV * 64; const bf16_t* Vt = p.VAt + (size_t)(b * 2 + kvh) * 64 * LKV;
        ATT_BEGIN();
        for (int j = 0; j < CTX_LEN; ++j) ATT_KEY(Kp, Vt, j, 0.f);
        int lo = s - A_WINDOW < 0 ? 0 : s - A_WINDOW, hi = s + A_WINDOW > SEQ - 1 ? SEQ - 1 : s + A_WINDOW;
        for (int j = lo; j <= hi; ++j) ATT_KEY(Kp, Vt, CTX_LEN + j, 0.f);
        ATT_SINK(p.a_sink[h]);
        for (int d = 0; d < 64; ++d) p.Y[(size_t)row * 1024 + h * 64 + d] = f2bf(acc[d] / l_);
    }
}
GLOBAL void nk_attnB(Params p) {
    GS_LOOP(i, (long)TX * 8) {
        int h = i % 8, row = i / 8, b = row / SEQ, s = row % SEQ, r = s / GRID_W, cq = s % GRID_W;
        const bf16_t* qp = p.QB + (size_t)row * 512 + h * 64;
        const bf16_t* Kp = p.KB + (size_t)(b * 8 + h) * LKV * 64; const bf16_t* Vt = p.VBt + (size_t)(b * 8 + h) * 64 * LKV;
        ATT_BEGIN();
        for (int j = 0; j < CTX_LEN; ++j) ATT_KEY(Kp, Vt, j, 0.f);
        int kh = B_WIN_H < GRID_H ? B_WIN_H : GRID_H;
        int rs = r - kh / 2; if (rs < 0) rs = 0; if (rs > GRID_H - kh) rs = GRID_H - kh;
        int cs = cq - B_WIN_W / 2; if (cs < 0) cs = 0; if (cs > GRID_W - B_WIN_W) cs = GRID_W - B_WIN_W;
        for (int kr = rs; kr < rs + kh; ++kr)
            for (int kc = cs; kc < cs + B_WIN_W; ++kc) {
                int dr = kr - r, dc = kc - cq;
                float bias = p.b_rpb[(h * (2 * B_WIN_H - 1) + dr + B_WIN_H - 1) * (2 * B_WIN_W - 1) + dc + B_WIN_W - 1];
                ATT_KEY(Kp, Vt, CTX_LEN + kr * GRID_W + kc, bias);
            }
        for (int d = 0; d < 64; ++d) p.Y[(size_t)row * 1024 + 512 + h * 64 + d] = f2bf(acc[d] / l_);
    }
}
GLOBAL void nk_attn_ctx(Params p) {
    GS_LOOP(i, (long)TC * 16) {
        int hh = i % 16, rc = i / 16, ty = hh / 8, h = hh % 8, b = rc / CTX_LEN; int row = TX + rc;
        const bf16_t* qp = (ty == 0 ? p.QA : p.QB) + (size_t)row * 512 + h * 64;
        const bf16_t* Kp = ty == 0 ? p.KA + (size_t)(b * 2 + h / 4) * LKV * 64 : p.KB + (size_t)(b * 8 + h) * LKV * 64;
        const bf16_t* Vt = ty == 0 ? p.VAt + (size_t)(b * 2 + h / 4) * 64 * LKV : p.VBt + (size_t)(b * 8 + h) * 64 * LKV;
        ATT_BEGIN();
        for (int j = 0; j < CTX_LEN; ++j) ATT_KEY(Kp, Vt, j, 0.f);
        if (ty == 0) ATT_SINK(p.a_sink[h]);
        for (int d = 0; d < 64; ++d) p.Y[(size_t)row * 1024 + ty * 512 + h * 64 + d] = f2bf(acc[d] / l_);
    }
}
GLOBAL void nk_attnC(Params p) {
    GS_LOOP(i, (long)TX * 8) {
        int h = i % 8, row = i / 8, b = row / SEQ, kvh = h / 4;
        const bf16_t* qp = p.QC + (size_t)row * 512 + h * 64;
        const bf16_t* Kp = p.KC + (size_t)(b * 2 + kvh) * LKV * 64; const bf16_t* Vt = p.VCt + (size_t)(b * 2 + kvh) * 64 * LKV;
        ATT_BEGIN();
        for (int j = 0; j < LKV; ++j) ATT_KEY(Kp, Vt, j, 0.f);
        for (int d = 0; d < 64; ++d) p.Y[(size_t)row * 1024 + h * 64 + d] = f2bf(acc[d] / l_);
    }
}

GLOBAL void nk_outproj_even(Params p) {
    GS_LOOP(i, (long)TT * D_MODEL) {
        int row = i / D_MODEL, col = i % D_MODEL;
        float acc = dot_row(p.Y + (size_t)row * 1024, p.w_out_even, D_MODEL, col, EVEN_OUT);
        xrow_cur(p, row)[col] = xrow_in(p, 0, row)[col] + modp(p, 0, row, 2)[col] * acc;
    }
}
GLOBAL void nk_outproj_odd(Params p) {
    GS_LOOP(i, (long)TX * D_MODEL) {
        int row = i / D_MODEL, col = i % D_MODEL, b = row / SEQ, s = row % SEQ;
        float acc = dot_row(p.Y + (size_t)row * 1024, p.w_out_odd, D_MODEL, col, 512);
        for (int c = 0; c < D_CH; ++c) acc += bf2f(p.YHT[((size_t)b * D_CH + c) * SEQ + s]) * p.w_out_odd[(size_t)(512 + c) * D_MODEL + col];
        p.out[i] = p.out[i] + modp(p, 1, row, 2)[col] * acc;
    }
}

GLOBAL void nk_router(Params p, int l, int nrows) {
    GS_LOOP(row, nrows) {
        const float* xr = xrow_cur(p, (int)row);
        float ss = 0.f;
        for (int k = 0; k < D_MODEL; ++k) ss += xr[k] * xr[k];
        float rstd = 1.0f / sqrtf(ss / D_MODEL + EPS);
        const float* g = p.norm_g + (l * 2 + 1) * D_MODEL; const float* sh = modp(p, l, (int)row, 3); const float* sc = modp(p, l, (int)row, 4);
        float lg[16];
#pragma unroll
        for (int e = 0; e < 16; ++e) lg[e] = 0.f;
        for (int k = 0; k < D_MODEL; ++k) { float hv = xr[k] * rstd * g[k] * (1.0f + sc[k]) + sh[k];
#pragma unroll
            for (int e = 0; e < 16; ++e) lg[e] += hv * p.w_router[k * 16 + e]; }
        int gbest = 0, a = 0, bb = 1; float gbs = -1e30f, wa = 0.f, wb = 0.f;
#pragma unroll
        for (int gI = 0; gI < 4; ++gI) {
            float m1 = -1e30f, m2 = -1e30f, s1 = 0.f, s2 = 0.f; int i1 = 0, i2 = 0;
#pragma unroll
            for (int j = 0; j < 4; ++j) { float sgv = sigmoid_f(lg[gI * 4 + j]); float v = sgv + p.b_router[gI * 4 + j];
                if (v > m1) { m2 = m1; i2 = i1; s2 = s1; m1 = v; i1 = j; s1 = sgv; } else if (v > m2) { m2 = v; i2 = j; s2 = sgv; } }
            float gs = m1 + m2;
            if (gs > gbs) { gbs = gs; gbest = gI; if (i1 < i2) { a = i1; bb = i2; wa = s1; wb = s2; } else { a = i2; bb = i1; wa = s2; wb = s1; } }
        }
        float inv = 1.0f / (wa + wb);
        int pidx = a == 0 ? bb - 1 : (a == 1 ? bb + 1 : 5);
        int pr = gbest * 6 + pidx;
        int pos = atomicAdd(p.cnt + l * 32 + pr, 1);
        p.list[(size_t)pr * TT + pos] = (int)row;
        p.tokw[row * 2 + 0] = wa * inv; p.tokw[row * 2 + 1] = wb * inv;
    }
}
HD void pair_experts(int pr, int& e1, int& e2) { int g = pr / 6, q = pr % 6; int a = q < 3 ? 0 : (q < 5 ? 1 : 2); int b = q < 3 ? q + 1 : (q < 5 ? q - 1 : 3); e1 = g * 4 + a; e2 = g * 4 + b; }
HD bool slot_lookup(const Params& p, int l, int slot, int& pr, int& row) { int acc = 0; for (int q = 0; q < NPAIR; ++q) { int c = p.cnt[l * 32 + q]; if (slot < acc + c) { pr = q; row = p.list[(size_t)q * TT + (slot - acc)]; return true; } acc += c; } return false; }
GLOBAL void nk_moe_up(Params p, int l, int nrows) {
    GS_LOOP(i, (long)nrows * HE_W) {
        int slot = i / HE_W, j = i % HE_W, k = j / D_EXPERT, jj = j % D_EXPERT; int pr, row; if (!slot_lookup(p, l, slot, pr, row)) continue;
        int e1, e2; pair_experts(pr, e1, e2); int e = k == 0 ? e1 : e2;
        const bf16_t* a = p.hbuf + (size_t)row * D_MODEL;
        const float* wg = p.moe_wg + (size_t)(l * N_EXPERTS + e) * D_MODEL * D_EXPERT; const float* wu = p.moe_wu + (size_t)(l * N_EXPERTS + e) * D_MODEL * D_EXPERT;
        float g = dot_row(a, wg, D_EXPERT, jj, D_MODEL), u = dot_row(a, wu, D_EXPERT, jj, D_MODEL);
        p.HE[(size_t)row * HE_W + j] = f2bf(p.tokw[row * 2 + k] * silu_f(g) * u);
    }
}
GLOBAL void nk_moe_down(Params p, int l, int nrows) {
    GS_LOOP(i, (long)nrows * D_MODEL) {
        int slot = i / D_MODEL, col = i % D_MODEL; int pr, row; if (!slot_lookup(p, l, slot, pr, row)) continue;
        int e1, e2; pair_experts(pr, e1, e2);
        const bf16_t* a = p.HE + (size_t)row * HE_W;
        float acc = dot_row(a, p.moe_wd + (size_t)(l * N_EXPERTS + e1) * D_EXPERT * D_MODEL, D_MODEL, col, D_EXPERT)
                  + dot_row(a + D_EXPERT, p.moe_wd + (size_t)(l * N_EXPERTS + e2) * D_EXPERT * D_MODEL, D_MODEL, col, D_EXPERT);
        float* xr = xrow_cur(p, row);
        xr[col] = xr[col] + modp(p, l, row, 5)[col] * acc;
    }
}

GLOBAL void nk_inproj_odd_qk(Params p) {
    GS_LOOP(i, (long)TT * 10) {
        int row = i / 10, hu = i % 10; const bf16_t* a = p.hbuf + (size_t)row * D_MODEL;
        bool lat = row < TX; int b = lat ? row / SEQ : (row - TX) / CTX_LEN; int s = lat ? row % SEQ : (row - TX) % CTX_LEN; int pos = lat ? CTX_LEN + s : s;
        int col0 = hu * 64;
        float v[64]; float ss = 0.f;
        for (int d = 0; d < 64; ++d) { v[d] = dot_row(a, p.w_in_odd, ODD_IN, col0 + d, D_MODEL); ss += v[d] * v[d]; }
        float rstd = 1.0f / sqrtf(ss / 64.0f + EPS);
        const float* gn = hu < 8 ? p.c_qnorm : p.c_knorm;
        for (int d = 0; d < 64; ++d) v[d] = v[d] * rstd * gn[d];
        for (int d = 0; d < 64; ++d) {
            float o = v[d];
            if (lat) { int pd = (d & 31) < 16 ? d + 16 : d - 16; o = rope_apply(p, v[d], v[pd], d, s); }
            if (hu < 8) p.QC[(size_t)row * 512 + col0 + d] = f2bf(o);
            else p.KC[((size_t)(b * 2 + (hu - 8)) * LKV + pos) * 64 + d] = f2bf(o);
        }
    }
}
GLOBAL void nk_inproj_odd_vu(Params p) {
    GS_LOOP(i, (long)TT * (ODD_IN - 640)) {
        int row = i / (ODD_IN - 640), col = 640 + i % (ODD_IN - 640); const bf16_t* a = p.hbuf + (size_t)row * D_MODEL;
        bool lat = row < TX; int b = lat ? row / SEQ : (row - TX) / CTX_LEN; int s = lat ? row % SEQ : (row - TX) % CTX_LEN; int pos = lat ? CTX_LEN + s : s;
        if (col >= 768 && !lat) continue;
        float v = dot_row(a, p.w_in_odd, ODD_IN, col, D_MODEL);
        if (col < 768) { int h = (col - 640) >> 6, d = col & 63; p.VCt[((size_t)(b * 2 + h) * 64 + d) * LKV + pos] = f2bf(v); }
        else p.UT[((size_t)b * 3 * D_CH + (col - 768)) * SEQ + s] = f2bf(v);
    }
}

HD float hy_sc(const Params& p, int b, int ch, int t) {
    const bf16_t* u = p.UT + ((size_t)b * 3 * D_CH + ch) * SEQ;
    float acc = p.hy_short_b[ch];
    for (int kk = 0; kk < 3; ++kk) { int tt = t + kk - 1; if (tt >= 0 && tt < SEQ) acc += p.hy_short_w[kk * 3 * D_CH + ch] * bf2f(u[tt]); }
    return acc;
}
GLOBAL void nk_hy_conv(Params p, int o) {
    GS_LOOP(i, (long)BATCH * D_CH * SEQ) {
        int n = i % SEQ, c = (i / SEQ) % D_CH, b = i / ((long)SEQ * D_CH);
        const float* hf = p.HFT + (size_t)((0 * 2 + o) * D_CH + c) * SEQ; const float* hb = p.HFT + (size_t)((1 * 2 + o) * D_CH + c) * SEQ;
        float inv = 1.0f / p.hnorm[o * D_CH + c];
        float acc = 0.f;
        for (int m = 0; m < SEQ; ++m) {
            float z = o == 0 ? hy_sc(p, b, c, m) : p.Z1[((size_t)b * D_CH + c) * SEQ + m];
            int d = n - m; float hv = d >= 0 ? hf[d] : hb[-d];
            acc += hv * z;
        }
        acc *= inv;
        float zn = o == 0 ? hy_sc(p, b, c, n) : p.Z1[((size_t)b * D_CH + c) * SEQ + n];
        float g = hy_sc(p, b, (o + 1) * D_CH + c, n);
        float r = g * (acc + zn * p.hy_bias[o * D_CH + c]);
        if (o == 0) p.Z1[i] = r; else p.YHT[i] = f2bf(r);
    }
}

GLOBAL void nk_final(Params p) {
    GS_LOOP(row, TX) {
        float* xr = p.out + (size_t)row * D_MODEL; float ss = 0.f;
        for (int k = 0; k < D_MODEL; ++k) ss += xr[k] * xr[k];
        float rstd = 1.0f / sqrtf(ss / D_MODEL + EPS);
        for (int k = 0; k < D_MODEL; ++k) xr[k] = xr[k] * rstd * p.final_g[k];
    }
}
GLOBAL void nk_yht_to_y(Params p) {
    GS_LOOP(i, (long)TX * D_CH) { int row = i / D_CH, c = i % D_CH, b = row / SEQ, s = row % SEQ; p.Y[(size_t)row * 1024 + 512 + c] = p.YHT[((size_t)b * D_CH + c) * SEQ + s]; }
}

GLOBAL void nk_rope(Params p) { d_rope(p); }
GLOBAL void nk_hy_h1(Params p) { d_hy_h1(p); }
GLOBAL void nk_hy_h2(Params p) { d_hy_h2(p); }
static inline size_t al256(size_t x) { return (x + 255) & ~(size_t)255; }
static size_t setup_ws(Params& p, char* ws) {
    size_t o = 0;
    auto take = [&](size_t bytes) { char* r = ws + o; o += al256(bytes); return r; };
    p.bar = (unsigned*)take(64 * 1024);
    p.cnt = (int*)take(256);
    p.XC = (float*)take((size_t)TC * D_MODEL * 4);
    p.mod = (float*)take((size_t)DEPTH * (BATCH + 1) * 6 * D_MODEL * 4);
    p.ropet = (float*)take(64 * 32 * 4);
    p.h1 = (float*)take((size_t)SEQ * 64 * 4);
    p.h2 = (float*)take((size_t)SEQ * 64 * 4);
    p.HFT = (float*)take((size_t)4 * D_CH * SEQ * 4);
    p.hnorm = (float*)take(2 * D_CH * 4);
    p.list = (int*)take((size_t)NPAIR * TT * 4);
    p.tokw = (float*)take((size_t)TT * 2 * 4);
    size_t hb = (size_t)TT * D_MODEL * 2, z1 = (size_t)BATCH * D_CH * SEQ * 4;
    char* r0 = take(hb > z1 ? hb : z1); p.hbuf = (bf16_t*)r0; p.Z1 = (float*)r0;
    size_t q = al256((size_t)TT * 512 * 2), kva = al256((size_t)BATCH * 2 * LKV * 64 * 2), kvb = al256((size_t)BATCH * 8 * LKV * 64 * 2), ut = al256((size_t)BATCH * 3 * D_CH * SEQ * 2);
    size_t l0 = 2 * q + 2 * kva + 2 * kvb, l1 = q + 2 * kva + ut;
    char* R = take(l0 > l1 ? l0 : l1);
    p.QA = (bf16_t*)R; p.KA = (bf16_t*)(R + q); p.VAt = (bf16_t*)(R + q + kva); p.QB = (bf16_t*)(R + q + 2 * kva); p.KB = (bf16_t*)(R + 2 * q + 2 * kva); p.VBt = (bf16_t*)(R + 2 * q + 2 * kva + kvb);
    p.QC = (bf16_t*)R; p.KC = (bf16_t*)(R + q); p.VCt = (bf16_t*)(R + q + kva); p.UT = (bf16_t*)(R + q + 2 * kva);
    size_t yb = (size_t)TT * 1024 * 2, heb = (size_t)TT * HE_W * 2;
    char* r1 = take(yb > heb ? yb : heb); p.Y = (bf16_t*)r1; p.HE = (bf16_t*)r1;
    p.YHT = (bf16_t*)take((size_t)BATCH * D_CH * SEQ * 2);
    p.Wt_in_even = (bf16_t*)take((size_t)EVEN_IN * D_MODEL * 2);
    p.Wt_out_even = (bf16_t*)take((size_t)D_MODEL * EVEN_OUT * 2);
    p.Wt_in_odd = (bf16_t*)take((size_t)ODD_IN * D_MODEL * 2);
    p.Wt_out_odd = (bf16_t*)take((size_t)D_MODEL * ODD_OUT * 2);
    p.Wt_gu = (bf16_t*)take((size_t)DEPTH * N_EXPERTS * 2 * D_EXPERT * D_MODEL * 2);
    p.Wt_d = (bf16_t*)take((size_t)DEPTH * N_EXPERTS * D_MODEL * D_EXPERT * 2);
    return o;
}
static void fill_inputs(Params& p, void* const* d_in, void* d_out) {
    const float** f = (const float**)&p.x;
    for (int i = 0; i < 32; ++i) f[i] = (const float*)d_in[i];
    p.out = (float*)d_out;
}
#define LAS __attribute__((address_space(3)))
typedef short bf16x8 __attribute__((ext_vector_type(8)));
typedef float f32x4 __attribute__((ext_vector_type(4)));
typedef float f32x16 __attribute__((ext_vector_type(16)));
typedef unsigned u32x4 __attribute__((ext_vector_type(4)));
typedef unsigned u32x2 __attribute__((ext_vector_type(2)));

constexpr int NTHREADS = 256;
constexpr int LDS_BYTES = 69632;
constexpr int MT_ALL = TT / 128, MT_LAT = TX / 128;

__device__ __forceinline__ unsigned pk2bf(float lo, float hi) { return (unsigned)f2bf(lo) | ((unsigned)f2bf(hi) << 16); }
__device__ __forceinline__ float wave_sum(float v) {
#pragma unroll
    for (int o = 1; o < 64; o <<= 1) v += __shfl_xor(v, o);
    return v;
}

template <class SrcF, class DstF>
__device__ __forceinline__ void cvt_tile(char* lds, int k0, int n0, const SrcF& src, const DstF& dst) {
    float* T = (float*)lds;
    const int tid = threadIdx.x;
#pragma unroll
    for (int i = 0; i < 16; ++i) { int kk = i * 4 + (tid >> 6), n = tid & 63; T[kk * 65 + n] = src(k0 + kk, n0 + n); }
    __syncthreads();
    { int n = tid >> 2, kq = (tid & 3) * 16; u32x4 o0, o1; const float* s = T + kq * 65 + n;
      o0.x = pk2bf(s[0 * 65], s[1 * 65]); o0.y = pk2bf(s[2 * 65], s[3 * 65]); o0.z = pk2bf(s[4 * 65], s[5 * 65]); o0.w = pk2bf(s[6 * 65], s[7 * 65]);
      o1.x = pk2bf(s[8 * 65], s[9 * 65]); o1.y = pk2bf(s[10 * 65], s[11 * 65]); o1.z = pk2bf(s[12 * 65], s[13 * 65]); o1.w = pk2bf(s[14 * 65], s[15 * 65]);
      bf16_t* d = dst(n0 + n) + k0 + kq; *(u32x4*)d = o0; *(u32x4*)(d + 8) = o1; }
    __syncthreads();
}
__device__ __forceinline__ void cvt_plain(char* lds, const float* W, bf16_t* Wt, int K, int N, int item) {
    int nb = N / 64, kb = item / nb, nbi = item % nb;
    cvt_tile(lds, kb * 64, nbi * 64, [&](int k, int n) { return W[(size_t)k * N + n]; }, [&](int n) { return Wt + (size_t)n * K; });
}
constexpr int CVT_IN = (D_MODEL / 64) * (EVEN_IN / 64), CVT_OUT = (D_MODEL / 64) * (D_MODEL / 64), CVT_GU1 = (D_MODEL / 64) * (D_EXPERT / 64), CVT_D1 = (D_EXPERT / 64) * (D_MODEL / 64);
constexpr int CVT_GU = DEPTH * N_EXPERTS * 2 * CVT_GU1, CVT_D = DEPTH * N_EXPERTS * CVT_D1;
constexpr int CVT_TOTAL = 2 * CVT_IN + 2 * CVT_OUT + CVT_GU + CVT_D;
__device__ __forceinline__ void cvt_item(const Params& p, char* lds, int it) {
    if (it < CVT_IN) { cvt_plain(lds, p.w_in_even, p.Wt_in_even, D_MODEL, EVEN_IN, it); return; } it -= CVT_IN;
    if (it < CVT_IN) { cvt_plain(lds, p.w_in_odd, p.Wt_in_odd, D_MODEL, ODD_IN, it); return; } it -= CVT_IN;
    if (it < CVT_OUT) { cvt_plain(lds, p.w_out_even, p.Wt_out_even, EVEN_OUT, D_MODEL, it); return; } it -= CVT_OUT;
    if (it < CVT_OUT) { cvt_plain(lds, p.w_out_odd, p.Wt_out_odd, ODD_OUT, D_MODEL, it); return; } it -= CVT_OUT;
    if (it < CVT_GU) {
        int le = it / (2 * CVT_GU1), r = it % (2 * CVT_GU1), half = r / CVT_GU1, r2 = r % CVT_GU1; int nb = D_EXPERT / 64, kb = r2 / nb, nbi = r2 % nb;
        const float* W = (half ? p.moe_wu : p.moe_wg) + (size_t)le * D_MODEL * D_EXPERT; bf16_t* Wt = p.Wt_gu + (size_t)le * 2 * D_EXPERT * D_MODEL;
        cvt_tile(lds, kb * 64, nbi * 64, [&](int k, int n) { return W[(size_t)k * D_EXPERT + n]; }, [&](int n) { return Wt + (size_t)(32 * (n >> 4) + 16 * half + (n & 15)) * D_MODEL; });
        return; } it -= CVT_GU;
    { int le = it / CVT_D1, r = it % CVT_D1; cvt_plain(lds, p.moe_wd + (size_t)le * D_EXPERT * D_MODEL, p.Wt_d + (size_t)le * D_MODEL * D_EXPERT, D_EXPERT, D_MODEL, r); }
}

struct TileGeom { int tid, lane, wid, wr, wc, l15, q, srow, schunk; };
__device__ __forceinline__ TileGeom tile_geom() { TileGeom g; g.tid = threadIdx.x; g.lane = g.tid & 63; g.wid = __builtin_amdgcn_readfirstlane(g.tid >> 6); g.wr = g.wid >> 1; g.wc = g.wid & 1; g.l15 = g.lane & 15; g.q = g.lane >> 4; g.srow = g.tid >> 3; g.schunk = g.tid & 7; return g; }

template <class ALoad, class BLoad>
__device__ __forceinline__ void gemm_mainloop(char* lds, const TileGeom& g, int nk, const ALoad& AL, const BLoad& BL, f32x4 (&acc)[4][4]) {
#pragma unroll
    for (int i = 0; i < 4; ++i)
#pragma unroll
        for (int j = 0; j < 4; ++j) acc[i][j] = (f32x4){0.f, 0.f, 0.f, 0.f};
    const int wofs = g.srow * 128 + ((g.schunk ^ ((g.srow >> 1) & 7)) << 4);
    const int swz = g.l15 >> 1;
    const int aofs = (g.wr * 64 + g.l15) * 128 + ((g.q ^ swz) << 4);
    const int bofs = 32768 + (g.wc * 64 + g.l15) * 128 + ((g.q ^ swz) << 4);
    u32x4 ra[4], rb[4];
#pragma unroll
    for (int i = 0; i < 4; ++i) { ra[i] = *(const u32x4*)AL(i, 0); rb[i] = *(const u32x4*)BL(i, 0); }
#pragma unroll
    for (int i = 0; i < 4; ++i) { *(u32x4*)(lds + wofs + i * 4096) = ra[i]; *(u32x4*)(lds + 32768 + wofs + i * 4096) = rb[i]; }
    __syncthreads();
    for (int kt = 0; kt < nk; ++kt) {
        const int cur = (kt & 1) * 16384, nxt = 16384 - cur;
        const bool more = kt + 1 < nk;
        if (more) {
#pragma unroll
            for (int i = 0; i < 4; ++i) { ra[i] = *(const u32x4*)AL(i, kt + 1); rb[i] = *(const u32x4*)BL(i, kt + 1); }
        }
#pragma unroll
        for (int kk = 0; kk < 2; ++kk) {
            bf16x8 af[4], bfr[4];
#pragma unroll
            for (int i = 0; i < 4; ++i) { af[i] = *(const bf16x8*)(lds + cur + ((aofs + i * 2048) ^ (kk * 64))); bfr[i] = *(const bf16x8*)(lds + cur + ((bofs + i * 2048) ^ (kk * 64))); }
#pragma unroll
            for (int mi = 0; mi < 4; ++mi)
#pragma unroll
                for (int ni = 0; ni < 4; ++ni) acc[mi][ni] = __builtin_amdgcn_mfma_f32_16x16x32_bf16(bfr[ni], af[mi], acc[mi][ni], 0, 0, 0);
        }
        if (more) {
#pragma unroll
            for (int i = 0; i < 4; ++i) { *(u32x4*)(lds + nxt + wofs + i * 4096) = ra[i]; *(u32x4*)(lds + 32768 + nxt + wofs + i * 4096) = rb[i]; }
        }
        __syncthreads();
    }
}

template <class DstF>
__device__ __forceinline__ void store_transposed(char* lds, const TileGeom& g, const f32x4 (&acc)[4][4], const DstF& dst) {
    bf16_t* T = (bf16_t*)lds;
#pragma unroll
    for (int mi = 0; mi < 4; ++mi)
#pragma unroll
        for (int ni = 0; ni < 4; ++ni)
#pragma unroll
            for (int r = 0; r < 4; ++r) T[(g.wc * 64 + ni * 16 + g.q * 4 + r) * 136 + g.wr * 64 + mi * 16 + g.l15] = f2bf(acc[mi][ni][r]);
    __syncthreads();
    { int col = g.tid >> 1, half = g.tid & 1; bf16_t* d = dst(col) + half * 64; const bf16_t* s = T + col * 136 + half * 64;
#pragma unroll
      for (int j = 0; j < 8; ++j) *(u32x4*)(d + j * 8) = *(const u32x4*)(s + j * 8); }
    __syncthreads();
}
__device__ __forceinline__ void store4bf(bf16_t* d, const f32x4& v) { u32x2 w; w.x = pk2bf(v[0], v[1]); w.y = pk2bf(v[2], v[3]); *(u32x2*)d = w; }
__device__ __forceinline__ void rope_head(const Params& p, f32x4 (&a)[4], int s, int q) {
    const int pr = s / GRID_W, pc = s % GRID_W;
    const f32x4 cr = *(const f32x4*)(p.ropet + pr * 32 + q * 4), sr = *(const f32x4*)(p.ropet + pr * 32 + 16 + q * 4);
    const f32x4 cc = *(const f32x4*)(p.ropet + pc * 32 + q * 4), sc = *(const f32x4*)(p.ropet + pc * 32 + 16 + q * 4);
    f32x4 x1 = a[0], x2 = a[1]; a[0] = x1 * cr - x2 * sr; a[1] = x2 * cr + x1 * sr;
    x1 = a[2]; x2 = a[3]; a[2] = x1 * cc - x2 * sc; a[3] = x2 * cc + x1 * sc;
}

template <int LAYER>
__device__ __forceinline__ void inproj_tile(const Params& p, char* lds, int mt, int nt) {
    const TileGeom g = tile_geom();
    const bf16_t* Abase = p.hbuf + (size_t)(mt * 128 + g.srow) * D_MODEL + g.schunk * 8;
    const bf16_t* Bbase = (LAYER == 0 ? p.Wt_in_even : p.Wt_in_odd) + (size_t)(nt * 128 + g.srow) * D_MODEL + g.schunk * 8;
    f32x4 acc[4][4];
    gemm_mainloop(lds, g, D_MODEL / 64, [&](int i, int kt) { return Abase + (size_t)i * 32 * D_MODEL + kt * 64; }, [&](int i, int kt) { return Bbase + (size_t)i * 32 * D_MODEL + kt * 64; }, acc);
    const bool lat = mt < MT_LAT; const int row0 = mt * 128;
    const int b = lat ? row0 / SEQ : (row0 - TX) / CTX_LEN, s0 = lat ? row0 % SEQ : (row0 - TX) % CTX_LEN, pos0 = lat ? CTX_LEN + s0 : s0;
    int kind;
    bf16_t* base; int h0 = 0, qcol0 = 0, nh = 2;
    if (LAYER == 0) {
        if (nt < 4) { kind = 0; base = p.QA; qcol0 = nt * 128; }
        else if (nt == 4) { kind = 1; base = p.KA; h0 = 0; nh = 2; }
        else if (nt == 5) { kind = 2; base = p.VAt; h0 = 0; nh = 2; }
        else if (nt < 10) { kind = 0; base = p.QB; qcol0 = (nt - 6) * 128; }
        else if (nt < 14) { kind = 1; base = p.KB; h0 = (nt - 10) * 2; nh = 8; }
        else { kind = 2; base = p.VBt; h0 = (nt - 14) * 2; nh = 8; }
    } else {
        if (nt < 4) { kind = 0; base = p.QC; qcol0 = nt * 128; }
        else if (nt == 4) { kind = 1; base = p.KC; h0 = 0; nh = 2; }
        else if (nt == 5) { kind = 2; base = p.VCt; h0 = 0; nh = 2; }
        else { kind = 3; base = p.UT; }
    }
    if (kind <= 1) {
        const bool rope = lat && (LAYER == 1 || nt <= 4);
#pragma unroll
        for (int mi = 0; mi < 4; ++mi) {
            const int rowl = g.wr * 64 + mi * 16 + g.l15;
            if (LAYER == 1) {
                float ss = 0.f;
#pragma unroll
                for (int ni = 0; ni < 4; ++ni) ss += acc[mi][ni][0] * acc[mi][ni][0] + acc[mi][ni][1] * acc[mi][ni][1] + acc[mi][ni][2] * acc[mi][ni][2] + acc[mi][ni][3] * acc[mi][ni][3];
                ss += __shfl_xor(ss, 16); ss += __shfl_xor(ss, 32);
                const float rstd = 1.0f / sqrtf(ss * (1.0f / 64.0f) + EPS);
                const float* gn = kind == 0 ? p.c_qnorm : p.c_knorm;
#pragma unroll
                for (int ni = 0; ni < 4; ++ni) acc[mi][ni] = acc[mi][ni] * rstd * *(const f32x4*)(gn + ni * 16 + g.q * 4);
            }
            if (rope) rope_head(p, acc[mi], s0 + rowl, g.q);
            bf16_t* d = kind == 0 ? base + (size_t)(row0 + rowl) * 512 + qcol0 + g.wc * 64 + g.q * 4
                                  : base + ((size_t)(b * nh + h0 + g.wc) * LKV + pos0 + rowl) * 64 + g.q * 4;
#pragma unroll
            for (int ni = 0; ni < 4; ++ni) store4bf(d + ni * 16, acc[mi][ni]);
        }
    } else if (kind == 2) {
        store_transposed(lds, g, acc, [&](int col) { return base + ((size_t)(b * nh + h0 + (col >> 6)) * 64 + (col & 63)) * LKV + pos0; });
    } else {
        store_transposed(lds, g, acc, [&](int col) { return base + ((size_t)b * 3 * D_CH + (nt - 6) * 128 + col) * SEQ + s0; });
    }
}
template <int LAYER>
__device__ __forceinline__ void ph_inproj(const Params& p, char* lds, int bid, int nb) {
    constexpr int NT = 18;
    if (LAYER == 0) { for (int t = bid; t < MT_ALL * NT; t += nb) inproj_tile<0>(p, lds, t / NT, t % NT); }
    else {
        const int n_lat = MT_LAT * NT, n_all = n_lat + (MT_ALL - MT_LAT) * 2;
        for (int t = bid; t < n_all; t += nb) { if (t < n_lat) inproj_tile<1>(p, lds, t / NT, t % NT); else { int u = t - n_lat; inproj_tile<1>(p, lds, MT_LAT + u / 2, 4 + u % 2); } }
    }
}

template <int LAYER>
__device__ __forceinline__ void outproj_tile(const Params& p, char* lds, int mt, int nt) {
    const TileGeom g = tile_geom();
    const bf16_t* Abase = p.Y + (size_t)(mt * 128 + g.srow) * 1024 + g.schunk * 8;
    const bf16_t* Bbase = (LAYER == 0 ? p.Wt_out_even : p.Wt_out_odd) + (size_t)(nt * 128 + g.srow) * 1024 + g.schunk * 8;
    f32x4 acc[4][4];
    gemm_mainloop(lds, g, 16, [&](int i, int kt) { return Abase + (size_t)i * 32 * 1024 + kt * 64; }, [&](int i, int kt) { return Bbase + (size_t)i * 32 * 1024 + kt * 64; }, acc);
    const int row0 = mt * 128;
#pragma unroll
    for (int mi = 0; mi < 4; ++mi) {
        const int row = row0 + g.wr * 64 + mi * 16 + g.l15;
        const float* xin = xrow_in(p, LAYER, row); float* xo = xrow_cur(p, row); const float* gate = modp(p, LAYER, row, 2);
#pragma unroll
        for (int ni = 0; ni < 4; ++ni) { const int col = nt * 128 + g.wc * 64 + ni * 16 + g.q * 4;
            *(f32x4*)(xo + col) = *(const f32x4*)(xin + col) + *(const f32x4*)(gate + col) * acc[mi][ni]; }
    }
}

template <int LAYER>
__device__ __forceinline__ void ph_outproj(const Params& p, char* lds, int bid, int nb) {
    const int nmt = LAYER == 0 ? MT_ALL : MT_LAT;
    for (int t = bid; t < nmt * 8; t += nb) outproj_tile<LAYER>(p, lds, t / 8, t % 8);
}

template <int NTN>
__device__ __forceinline__ bool moe_tile_lookup(const int* cnt, int t, int& pr, int& mt, int& nt, int& n) {
    int acc = 0;
    for (int q = 0; q < NPAIR; ++q) { const int c = cnt[q]; const int tiles = ((c + 127) >> 7) * NTN; if (t < acc + tiles) { pr = q; const int u = t - acc; mt = u / NTN; nt = u % NTN; n = c; return true; } acc += tiles; }
    return false;
}
__device__ __forceinline__ void moe_up_tile(const Params& p, char* lds, int l, int pr, int mt, int nt, int n) {
    const TileGeom g = tile_geom();
    int e1, e2; pair_experts(pr, e1, e2); const int k = nt >> 3, e = k ? e2 : e1;
    const int* lst = p.list + (size_t)pr * TT + mt * 128;
    const int navail = n - mt * 128;
    const bf16_t* arow[4];
#pragma unroll
    for (int i = 0; i < 4; ++i) { int r = g.srow + 32 * i; if (r >= navail) r = navail - 1; arow[i] = p.hbuf + (size_t)lst[r] * D_MODEL + g.schunk * 8; }
    const bf16_t* Bbase = p.Wt_gu + ((size_t)(l * N_EXPERTS + e) * 2 * D_EXPERT + (nt & 7) * 128 + g.srow) * D_MODEL + g.schunk * 8;
    f32x4 acc[4][4];
    gemm_mainloop(lds, g, D_MODEL / 64, [&](int i, int kt) { return arow[i] + kt * 64; }, [&](int i, int kt) { return Bbase + (size_t)i * 32 * D_MODEL + kt * 64; }, acc);
#pragma unroll
    for (int mi = 0; mi < 4; ++mi) {
        const int rl = g.wr * 64 + mi * 16 + g.l15;
        if (rl < navail) {
            const int row = lst[rl]; const float w = p.tokw[row * 2 + k];
            bf16_t* d = p.HE + (size_t)row * HE_W + k * D_EXPERT + (nt & 7) * 64 + g.wc * 32 + g.q * 4;
#pragma unroll
            for (int h2 = 0; h2 < 2; ++h2) { f32x4 gg = acc[mi][2 * h2], uu = acc[mi][2 * h2 + 1], o;
#pragma unroll
                for (int r = 0; r < 4; ++r) o[r] = w * (gg[r] / (1.0f + __expf(-gg[r]))) * uu[r];
                store4bf(d + h2 * 16, o); }
        }
    }
}
__device__ __forceinline__ void moe_down_tile(const Params& p, char* lds, int l, int pr, int mt, int nt, int n) {
    const TileGeom g = tile_geom();
    int e1, e2; pair_experts(pr, e1, e2);
    const int* lst = p.list + (size_t)pr * TT + mt * 128;
    const int navail = n - mt * 128;
    const bf16_t* arow[4];
#pragma unroll
    for (int i = 0; i < 4; ++i) { int r = g.srow + 32 * i; if (r >= navail) r = navail - 1; arow[i] = p.HE + (size_t)lst[r] * HE_W + g.schunk * 8; }
    const bf16_t* B1 = p.Wt_d + ((size_t)(l * N_EXPERTS + e1) * D_MODEL + nt * 128 + g.srow) * D_EXPERT + g.schunk * 8;
    const bf16_t* B2 = p.Wt_d + ((size_t)(l * N_EXPERTS + e2) * D_MODEL + nt * 128 + g.srow) * D_EXPERT + g.schunk * 8;
    constexpr int KT1 = D_EXPERT / 64;
    f32x4 acc[4][4];
    gemm_mainloop(lds, g, HE_W / 64, [&](int i, int kt) { return arow[i] + kt * 64; },
                  [&](int i, int kt) { return (kt < KT1 ? B1 + kt * 64 : B2 + (kt - KT1) * 64) + (size_t)i * 32 * D_EXPERT; }, acc);
#pragma unroll
    for (int mi = 0; mi < 4; ++mi) {
        const int rl = g.wr * 64 + mi * 16 + g.l15;
        if (rl < navail) {
            const int row = lst[rl]; float* xo = xrow_cur(p, row); const float* gate = modp(p, l, row, 5);
#pragma unroll
            for (int ni = 0; ni < 4; ++ni) { const int col = nt * 128 + g.wc * 64 + ni * 16 + g.q * 4; *(f32x4*)(xo + col) = *(const f32x4*)(xo + col) + *(const f32x4*)(gate + col) * acc[mi][ni]; }
        }
    }
}
__device__ __forceinline__ void ph_moe_up(const Params& p, char* lds, int l, int bid, int nb) {
    int pr, mt, nt, n; for (int t = bid; moe_tile_lookup<16>(p.cnt + l * 32, t, pr, mt, nt, n); t += nb) moe_up_tile(p, lds, l, pr, mt, nt, n);
}
__device__ __forceinline__ void ph_moe_down(const Params& p, char* lds, int l, int bid, int nb) {
    int pr, mt, nt, n; for (int t = bid; moe_tile_lookup<8>(p.cnt + l * 32, t, pr, mt, nt, n); t += nb) moe_down_tile(p, lds, l, pr, mt, nt, n);
}
typedef float f32x2 __attribute__((ext_vector_type(2)));
typedef __bf16 bf16x2_t __attribute__((ext_vector_type(2)));
__device__ __forceinline__ unsigned cvtpk(float lo, float hi) { f32x2 v = {lo, hi}; bf16x2_t b = __builtin_convertvector(v, bf16x2_t); return __builtin_bit_cast(unsigned, b); }
__device__ __forceinline__ int crow(int r, int hi) { return (r & 3) + 8 * (r >> 2) + 4 * hi; }
constexpr float LOG2E = 1.4426950408889634f;
constexpr float QK_C = ATTN_SCALE * LOG2E;
constexpr float NEG_BIG = -1e30f;

template <int MODE>
__device__ __forceinline__ void attn_unit(char* lds, const bf16_t* Qp, const bf16_t* Kp, const bf16_t* Vt, bf16_t* Op, int s0, int nctx, int lt0, int nlat, float sink2, bool has_sink, const float* rpb_h) {
    const int tid = threadIdx.x, lane = tid & 63, wid = __builtin_amdgcn_readfirstlane(tid >> 6), l31 = lane & 31, hi = lane >> 5;
    float* bias_s = (float*)(lds + 32768);
    if (MODE == 2) { for (int i = tid; i < 15 * 31; i += NTHREADS) bias_s[i] = rpb_h[i] * LOG2E; }
    const int ntiles = nctx + nlat;
    const int srow0 = tid >> 3, schunk = tid & 7;
    const int swzw = (srow0 >> 1) & 7;
    const int wofs = srow0 * 128 + ((schunk ^ swzw) << 4);
    const bool vswap0 = (srow0 >> 4) & 1;
    const int x = (l31 >> 1) & 7;
    const int kofs = l31 * 128 + ((hi ^ x) << 4);
    const int vofs = 16384 + l31 * 128 + ((0 ^ x) << 4) + 8 * (hi ^ (l31 >> 4));
    bf16x8 qf[4];
    { const bf16_t* qr = Qp + (size_t)(wid * 32 + l31) * 512 + hi * 8;
#pragma unroll
      for (int s = 0; s < 4; ++s) qf[s] = *(const bf16x8*)(qr + s * 16); }
    auto tile_pos = [&](int j) { return j < nctx ? 64 * j : CTX_LEN + 64 * (lt0 + j - nctx); };
    u32x4 rk[2], rv[2];
    auto gload = [&](int j) { const int pos = tile_pos(j);
#pragma unroll
        for (int i = 0; i < 2; ++i) { rk[i] = *(const u32x4*)(Kp + (size_t)(pos + srow0 + 32 * i) * 64 + schunk * 8); rv[i] = *(const u32x4*)(Vt + (size_t)(srow0 + 32 * i) * LKV + pos + schunk * 8); } };
    auto lstore = [&](int buf) {
#pragma unroll
        for (int i = 0; i < 2; ++i) { *(u32x4*)(lds + buf * 8192 + wofs + i * 4096) = rk[i]; u32x4 v = rv[i]; if (vswap0) v = (u32x4){v.z, v.w, v.x, v.y}; *(u32x4*)(lds + 16384 + buf * 8192 + wofs + i * 4096) = v; } };
    f32x16 o0 = {}, o1 = {};
    float m = NEG_BIG, l = 0.f;
    const int sq = s0 + wid * 32 + l31;
    int rq = 0, cq = 0, rsq = 0, csq = 0;
    if (MODE == 2) { rq = sq / GRID_W; cq = sq % GRID_W; rsq = rq - B_WIN_H / 2; rsq = rsq < 0 ? 0 : (rsq > GRID_H - B_WIN_H ? GRID_H - B_WIN_H : rsq); csq = cq - B_WIN_W / 2; csq = csq < 0 ? 0 : (csq > GRID_W - B_WIN_W ? GRID_W - B_WIN_W : csq); }
    gload(0); lstore(0);
    __syncthreads();
    for (int j = 0; j < ntiles; ++j) {
        const int buf = j & 1; const bool more = j + 1 < ntiles;
        if (more) gload(j + 1);
        const char* Kb = lds + buf * 8192; const char* Vb = lds + buf * 8192;
        f32x16 p0 = {}, p1 = {};
#pragma unroll
        for (int s = 0; s < 4; ++s) {
            const bf16x8 k0 = *(const bf16x8*)(Kb + (kofs ^ (s << 5))); const bf16x8 k1 = *(const bf16x8*)(Kb + 4096 + (kofs ^ (s << 5)));
            p0 = __builtin_amdgcn_mfma_f32_32x32x16_bf16(k0, qf[s], p0, 0, 0, 0); p1 = __builtin_amdgcn_mfma_f32_32x32x16_bf16(k1, qf[s], p1, 0, 0, 0);
        }
        float tmax = NEG_BIG;
        if (MODE == 0 || j < nctx) {
#pragma unroll
            for (int r = 0; r < 16; ++r) { p0[r] *= QK_C; p1[r] *= QK_C; tmax = fmaxf(tmax, fmaxf(p0[r], p1[r])); }
        } else if (MODE == 1) {
            const int sk0 = 64 * (lt0 + j - nctx);
#pragma unroll
            for (int r = 0; r < 16; ++r) { const int d0 = sk0 + crow(r, hi) - sq, d1 = d0 + 32;
                p0[r] = (d0 >= -A_WINDOW && d0 <= A_WINDOW) ? p0[r] * QK_C : NEG_BIG; p1[r] = (d1 >= -A_WINDOW && d1 <= A_WINDOW) ? p1[r] * QK_C : NEG_BIG; tmax = fmaxf(tmax, fmaxf(p0[r], p1[r])); }
        } else {
            const int kr = lt0 + j - nctx; const bool rowok = kr >= rsq && kr < rsq + B_WIN_H;
            const float* brow = bias_s + (kr - rq + B_WIN_H - 1) * 31 + (B_WIN_W - 1) - cq;
#pragma unroll
            for (int r = 0; r < 16; ++r) { const int kc0 = crow(r, hi), kc1 = kc0 + 32;
                const bool ok0 = rowok && kc0 >= csq && kc0 < csq + B_WIN_W, ok1 = rowok && kc1 >= csq && kc1 < csq + B_WIN_W;
                p0[r] = ok0 ? p0[r] * QK_C + brow[kc0] : NEG_BIG; p1[r] = ok1 ? p1[r] * QK_C + brow[kc1] : NEG_BIG; tmax = fmaxf(tmax, fmaxf(p0[r], p1[r])); }
        }
        tmax = fmaxf(tmax, __shfl_xor(tmax, 32));
        const float mn = fmaxf(m, tmax), alpha = __builtin_amdgcn_exp2f(m - mn); m = mn;
        float ls = 0.f;
#pragma unroll
        for (int r = 0; r < 16; ++r) { p0[r] = __builtin_amdgcn_exp2f(p0[r] - mn); p1[r] = __builtin_amdgcn_exp2f(p1[r] - mn); ls += p0[r] + p1[r]; }
        l = l * alpha + ls;
#pragma unroll
        for (int r = 0; r < 16; ++r) { o0[r] *= alpha; o1[r] *= alpha; }
        bf16x8 pf[4];
        { u32x4 w;
          w.x = cvtpk(p0[0], p0[1]); w.y = cvtpk(p0[2], p0[3]); w.z = cvtpk(p0[4], p0[5]); w.w = cvtpk(p0[6], p0[7]); pf[0] = __builtin_bit_cast(bf16x8, w);
          w.x = cvtpk(p0[8], p0[9]); w.y = cvtpk(p0[10], p0[11]); w.z = cvtpk(p0[12], p0[13]); w.w = cvtpk(p0[14], p0[15]); pf[1] = __builtin_bit_cast(bf16x8, w);
          w.x = cvtpk(p1[0], p1[1]); w.y = cvtpk(p1[2], p1[3]); w.z = cvtpk(p1[4], p1[5]); w.w = cvtpk(p1[6], p1[7]); pf[2] = __builtin_bit_cast(bf16x8, w);
          w.x = cvtpk(p1[8], p1[9]); w.y = cvtpk(p1[10], p1[11]); w.z = cvtpk(p1[12], p1[13]); w.w = cvtpk(p1[14], p1[15]); pf[3] = __builtin_bit_cast(bf16x8, w); }
#pragma unroll
        for (int s = 0; s < 4; ++s) {
            const int a0 = vofs ^ (s << 5);
            u32x2 va = *(const u32x2*)(Vb + a0), vb = *(const u32x2*)(Vb + (a0 ^ 16));
            u32x2 vc = *(const u32x2*)(Vb + 4096 + a0), vd = *(const u32x2*)(Vb + 4096 + (a0 ^ 16));
            const bf16x8 f0 = __builtin_bit_cast(bf16x8, (u32x4){va.x, va.y, vb.x, vb.y}), f1 = __builtin_bit_cast(bf16x8, (u32x4){vc.x, vc.y, vd.x, vd.y});
            o0 = __builtin_amdgcn_mfma_f32_32x32x16_bf16(f0, pf[s], o0, 0, 0, 0); o1 = __builtin_amdgcn_mfma_f32_32x32x16_bf16(f1, pf[s], o1, 0, 0, 0);
        }
        if (more) lstore(buf ^ 1);
        __syncthreads();
    }
    l += __shfl_xor(l, 32);
    if (has_sink) l += __builtin_amdgcn_exp2f(sink2 - m);
    const float inv = 1.0f / l;
    bf16_t* orow = Op + (size_t)(wid * 32 + l31) * 1024;
#pragma unroll
    for (int g4 = 0; g4 < 4; ++g4) {
        u32x2 w; w.x = cvtpk(o0[g4 * 4 + 0] * inv, o0[g4 * 4 + 1] * inv); w.y = cvtpk(o0[g4 * 4 + 2] * inv, o0[g4 * 4 + 3] * inv); *(u32x2*)(orow + 8 * g4 + 4 * hi) = w;
        w.x = cvtpk(o1[g4 * 4 + 0] * inv, o1[g4 * 4 + 1] * inv); w.y = cvtpk(o1[g4 * 4 + 2] * inv, o1[g4 * 4 + 3] * inv); *(u32x2*)(orow + 32 + 8 * g4 + 4 * hi) = w;
    }
}

constexpr int NU_LAT = BATCH * 8 * (SEQ / 128);
constexpr int NU_CTX = BATCH * 8 * (CTX_LEN / 128);
__device__ __forceinline__ void ph_attn0(const Params& p, char* lds, int bid, int nb) {
    for (int u = bid; u < 2 * NU_LAT + 2 * NU_CTX; u += nb) {
        if (u < NU_LAT) {
            const int blk = u % (SEQ / 128), h = (u / (SEQ / 128)) % 8, b = u / (8 * (SEQ / 128)); const int s0 = blk * 128, r0 = s0 / GRID_W;
            int rs0 = r0 - 4; rs0 = rs0 < 0 ? 0 : (rs0 > GRID_H - 8 ? GRID_H - 8 : rs0); int rs1 = r0 + 1 - 4; rs1 = rs1 < 0 ? 0 : (rs1 > GRID_H - 8 ? GRID_H - 8 : rs1);
            attn_unit<2>(lds, p.QB + (size_t)(b * SEQ + s0) * 512 + h * 64, p.KB + (size_t)(b * 8 + h) * LKV * 64, p.VBt + (size_t)(b * 8 + h) * 64 * LKV,
                         p.Y + (size_t)(b * SEQ + s0) * 1024 + 512 + h * 64, s0, CTX_LEN / 64, rs0, rs1 + 8 - rs0, 0.f, false, p.b_rpb + h * 15 * 31);
        } else if (u < 2 * NU_LAT) {
            const int v = u - NU_LAT; const int blk = v % (SEQ / 128), h = (v / (SEQ / 128)) % 8, b = v / (8 * (SEQ / 128)); const int s0 = blk * 128;
            int t0 = (s0 - 128) / 64; if (t0 < 0) t0 = 0; int t1 = (s0 + 255) / 64; if (t1 > SEQ / 64 - 1) t1 = SEQ / 64 - 1;
            attn_unit<1>(lds, p.QA + (size_t)(b * SEQ + s0) * 512 + h * 64, p.KA + (size_t)(b * 2 + h / 4) * LKV * 64, p.VAt + (size_t)(b * 2 + h / 4) * 64 * LKV,
                         p.Y + (size_t)(b * SEQ + s0) * 1024 + h * 64, s0, CTX_LEN / 64, t0, t1 - t0 + 1, p.a_sink[h] * LOG2E, true, nullptr);
        } else {
            const int v = u - 2 * NU_LAT; const int ty = v / NU_CTX, w = v % NU_CTX; const int blk = w % (CTX_LEN / 128), h = (w / (CTX_LEN / 128)) % 8, b = w / (8 * (CTX_LEN / 128));
            const int row0 = TX + b * CTX_LEN + blk * 128;
            if (ty == 0) attn_unit<0>(lds, p.QA + (size_t)row0 * 512 + h * 64, p.KA + (size_t)(b * 2 + h / 4) * LKV * 64, p.VAt + (size_t)(b * 2 + h / 4) * 64 * LKV, p.Y + (size_t)row0 * 1024 + h * 64, 0, CTX_LEN / 64, 0, 0, p.a_sink[h] * LOG2E, true, nullptr);
            else attn_unit<0>(lds, p.QB + (size_t)row0 * 512 + h * 64, p.KB + (size_t)(b * 8 + h) * LKV * 64, p.VBt + (size_t)(b * 8 + h) * 64 * LKV, p.Y + (size_t)row0 * 1024 + 512 + h * 64, 0, CTX_LEN / 64, 0, 0, 0.f, false, nullptr);
        }
    }
}
__device__ __forceinline__ void ph_attnC(const Params& p, char* lds, int bid, int nb) {
    for (int u = bid; u < NU_LAT; u += nb) {
        const int blk = u % (SEQ / 128), h = (u / (SEQ / 128)) % 8, b = u / (8 * (SEQ / 128)); const int s0 = blk * 128;
        attn_unit<0>(lds, p.QC + (size_t)(b * SEQ + s0) * 512 + h * 64, p.KC + (size_t)(b * 2 + h / 4) * LKV * 64, p.VCt + (size_t)(b * 2 + h / 4) * 64 * LKV,
                     p.Y + (size_t)(b * SEQ + s0) * 1024 + h * 64, s0, CTX_LEN / 64, 0, SEQ / 64, 0.f, false, nullptr);
    }
}
#ifdef HY_TEST
#define HY_OUT(b, t, v) p.YHT[((size_t)(b) * D_CH + c) * SEQ + (t)] = f2bf(v)
#else
#define HY_OUT(b, t, v) p.Y[((size_t)(b) * SEQ + (t)) * 1024 + 512 + c] = f2bf(v)
#endif
#ifdef CPU_TEST
#define FOR_T for (int tid = 0; tid < 256; ++tid)
#define HSYNC
#define HST(t) st[t]
#define HY_DECL HySt* st = new HySt[256]
#define HY_FREE delete[] st
static inline void sincos_rev(float a, float& c, float& s) { c = cosf(6.283185307179586f * a); s = sinf(6.283185307179586f * a); }
#else
__device__ __forceinline__ int hy_launder(int v) { asm volatile("" : "+v"(v)); return v; }
#define FOR_T if (const int tid = hy_launder((int)threadIdx.x); true)
#define HSYNC __syncthreads()
#define HST(t) st
#define HY_DECL HySt st
#define HY_FREE
__device__ __forceinline__ void sincos_rev(float a, float& c, float& s) { c = __builtin_amdgcn_cosf(a); s = __builtin_amdgcn_sinf(a); }
#endif
constexpr int FN = 2 * SEQ;
constexpr int FPAD = FN + (FN >> 5);
#if !defined(SMALL_CFG)
static_assert(FN == 8192, "pass plan 8,8,8,16 is for N = 8192");
constexpr int R4 = 16;
constexpr int NS4 = 512;
#else
constexpr int R4 = 2;
constexpr int NS4 = 512;
#endif
constexpr int NB8 = FN / 8 / 256;
constexpr int NB4 = FN / R4 / 256;
constexpr int EPT = FN / 256;
struct HySt { float xr[EPT], xi[EPT], kr[EPT], ki[EPT]; };
HD int pidx(int i) { return i + (i >> 5); }

constexpr float W16C[8] = {1.0f, 0.9238795325112867f, 0.7071067811865476f, 0.3826834323650898f, 0.0f, -0.3826834323650898f, -0.7071067811865476f, -0.9238795325112867f};
constexpr float W16S[8] = {0.0f, -0.3826834323650898f, -0.7071067811865476f, -0.9238795325112867f, -1.0f, -0.9238795325112867f, -0.7071067811865476f, -0.3826834323650898f};
template <int R> HD void fft_reg(float* xr, float* xi) {
    constexpr int LG = R == 16 ? 4 : (R == 8 ? 3 : (R == 4 ? 2 : 1));
#pragma unroll
    for (int sg = 0; sg < LG; ++sg) {
        const int h = (R / 2) >> sg;
#pragma unroll
        for (int pr = 0; pr < R / 2; ++pr) {
            const int blk = (pr / h) * 2 * h, i = pr % h;
            const int a = blk + i, b = blk + i + h;
            const float ar = xr[a], ai = xi[a], br = xr[b], bi = xi[b];
            xr[a] = ar + br; xi[a] = ai + bi;
            const float tr = ar - br, ti = ai - bi;
            const int tw = i * (8 / h);
            if (tw == 0) { xr[b] = tr; xi[b] = ti; }
            else if (tw == 4) { xr[b] = ti; xi[b] = -tr; }
            else { const float c = W16C[tw & 7], s = W16S[tw & 7]; xr[b] = tr * c - ti * s; xi[b] = tr * s + ti * c; }
        }
    }
}
template <int R> HD constexpr int bitrev(int i) { int r = 0; for (int b = 1; b < R; b <<= 1) { r = (r << 1) | (i & 1); i >>= 1; } return r; }

template <int R, int NB, class In> HD void pass_load(int tid, HySt& s, const In& in) {
#pragma unroll
    for (int b = 0; b < NB; ++b)
#pragma unroll
        for (int r = 0; r < R; ++r) in(tid + 256 * b + (FN / R) * r, s.xr[b * R + r], s.xi[b * R + r]);
}
template <int R, int NB, class Out> HD void pass_compute(int tid, HySt& s, int Ns, const Out& out) {
#pragma unroll
    for (int b = 0; b < NB; ++b) {
        const int j = tid + 256 * b, k = j & (Ns - 1);
        float* xr = s.xr + b * R; float* xi = s.xi + b * R;
        if (Ns > 1) {
            float wc, ws; sincos_rev(-(float)k / (float)(Ns * R), wc, ws);
            float cr = wc, ci = ws;
#pragma unroll
            for (int r = 1; r < R; ++r) {
                const float vr = xr[r], vi = xi[r]; xr[r] = vr * cr - vi * ci; xi[r] = vr * ci + vi * cr;
                const float nr = cr * wc - ci * ws, ni = cr * ws + ci * wc; cr = nr; ci = ni;
            }
        }
        fft_reg<R>(xr, xi);
        const int j0 = (j - k) * R + k;
#pragma unroll
        for (int i = 0; i < R; ++i) out(j0 + bitrev<R>(i) * Ns, b, bitrev<R>(i), xr[i], xi[i]);
    }
}
struct LdsIn { const float* re; const float* im; HD void operator()(int idx, float& r, float& i) const { r = re[pidx(idx)]; i = im[pidx(idx)]; } };
struct LdsOut { float* re; float* im; HD void operator()(int idx, int, int, float r, float i) const { re[pidx(idx)] = r; im[pidx(idx)] = i; } };

HD float hy_sc_ut(const bf16_t* u, const float* sw3, float sb, int t) {
    float acc = sb;
    if (t > 0) acc += sw3[0] * bf2f(u[t - 1]);
    acc += sw3[1] * bf2f(u[t]);
    if (t < SEQ - 1) acc += sw3[2] * bf2f(u[t + 1]);
    return acc;
}

HD void hyena_channel(const Params& p, int c, float* lds) {
    HY_DECL;
    float* re = lds; float* im = lds + FPAD;
    const LdsIn lin{re, im}; const LdsOut lout{re, im};
    float nrm[2];
#pragma unroll
    for (int o = 0; o < 2; ++o) {
        const float* hf = p.HFT + (size_t)((0 * 2 + o) * D_CH + c) * SEQ; const float* hb = p.HFT + (size_t)((1 * 2 + o) * D_CH + c) * SEQ;
        FOR_T { float sacc = 0.f; for (int i = 0; i < SEQ / 256; ++i) sacc += fabsf(hf[tid + 256 * i]) + fabsf(hb[tid + 256 * i]); re[tid] = sacc; }
        HSYNC;
        { float tot = 0.f; for (int i = 0; i < 256; ++i) tot += re[i]; nrm[o] = tot + EPS; }
        HSYNC;
    }
    float sw[3][3], sbv[3];
#pragma unroll
    for (int q = 0; q < 3; ++q) { sbv[q] = p.hy_short_b[q * D_CH + c];
#pragma unroll
        for (int kk = 0; kk < 3; ++kk) sw[q][kk] = p.hy_short_w[kk * 3 * D_CH + q * D_CH + c]; }
#pragma unroll
    for (int o = 0; o < 2; ++o) {
        const float* hf = p.HFT + (size_t)((0 * 2 + o) * D_CH + c) * SEQ; const float* hb = p.HFT + (size_t)((1 * 2 + o) * D_CH + c) * SEQ;
        const float inv = 1.0f / nrm[o]; const float hbias = p.hy_bias[o * D_CH + c];
        FOR_T { pass_load<8, NB8>(tid, HST(tid), [&](int idx, float& r, float& i) __attribute__((always_inline)) { r = idx < SEQ ? hf[idx] * inv : (idx == SEQ ? 0.f : hb[FN - idx] * inv); i = 0.f; });
                pass_compute<8, NB8>(tid, HST(tid), 1, lout); }
        HSYNC;
        FOR_T { pass_load<8, NB8>(tid, HST(tid), lin); } HSYNC; FOR_T { pass_compute<8, NB8>(tid, HST(tid), 8, lout); } HSYNC;
        FOR_T { pass_load<8, NB8>(tid, HST(tid), lin); } HSYNC; FOR_T { pass_compute<8, NB8>(tid, HST(tid), 64, lout); } HSYNC;
        FOR_T { pass_load<R4, NB4>(tid, HST(tid), lin);
                HySt& s = HST(tid); pass_compute<R4, NB4>(tid, s, NS4, [&](int, int b, int rr, float r, float i) __attribute__((always_inline)) { s.kr[b + NB4 * rr] = r; s.ki[b + NB4 * rr] = i; }); }
        HSYNC;
        for (int bp = 0; bp < BATCH / 2; ++bp) {
            const int b0 = 2 * bp, b1 = 2 * bp + 1;
            const bf16_t* u0 = p.UT + ((size_t)b0 * 3 * D_CH + c) * SEQ; const bf16_t* u1 = p.UT + ((size_t)b1 * 3 * D_CH + c) * SEQ;
            const float* z0 = p.Z1 + ((size_t)b0 * D_CH + c) * SEQ; const float* z1 = p.Z1 + ((size_t)b1 * D_CH + c) * SEQ;
            auto zval = [&](int b, int t) __attribute__((always_inline)) { return o == 0 ? hy_sc_ut(b == b0 ? u0 : u1, sw[0], sbv[0], t) : (b == b0 ? z0 : z1)[t]; };
            FOR_T { pass_load<8, NB8>(tid, HST(tid), [&](int idx, float& r, float& i) __attribute__((always_inline)) { if (idx < SEQ) { r = zval(b0, idx); i = zval(b1, idx); } else { r = 0.f; i = 0.f; } });
                    pass_compute<8, NB8>(tid, HST(tid), 1, lout); }
            HSYNC;
            FOR_T { pass_load<8, NB8>(tid, HST(tid), lin); } HSYNC; FOR_T { pass_compute<8, NB8>(tid, HST(tid), 8, lout); } HSYNC;
            FOR_T { pass_load<8, NB8>(tid, HST(tid), lin); } HSYNC; FOR_T { pass_compute<8, NB8>(tid, HST(tid), 64, lout); } HSYNC;
            FOR_T { pass_load<R4, NB4>(tid, HST(tid), lin); } HSYNC;
            FOR_T { HySt& s = HST(tid); pass_compute<R4, NB4>(tid, s, NS4, [&](int idx, int b, int rr, float r, float i) __attribute__((always_inline)) { const float kr = s.kr[b + NB4 * rr], ki = s.ki[b + NB4 * rr];
                        re[pidx(idx)] = r * kr - i * ki; im[pidx(idx)] = -(r * ki + i * kr); }); }
            HSYNC;
            FOR_T { pass_load<8, NB8>(tid, HST(tid), lin); } HSYNC; FOR_T { pass_compute<8, NB8>(tid, HST(tid), 1, lout); } HSYNC;
            FOR_T { pass_load<8, NB8>(tid, HST(tid), lin); } HSYNC; FOR_T { pass_compute<8, NB8>(tid, HST(tid), 8, lout); } HSYNC;
            FOR_T { pass_load<8, NB8>(tid, HST(tid), lin); } HSYNC; FOR_T { pass_compute<8, NB8>(tid, HST(tid), 64, lout); } HSYNC;
            FOR_T { pass_load<R4, NB4>(tid, HST(tid), lin);
                    const bf16_t* g0 = p.UT + ((size_t)b0 * 3 * D_CH + (o + 1) * D_CH + c) * SEQ; const bf16_t* g1 = p.UT + ((size_t)b1 * 3 * D_CH + (o + 1) * D_CH + c) * SEQ;
                    pass_compute<R4, NB4>(tid, HST(tid), NS4, [&](int idx, int, int, float r, float i) __attribute__((always_inline)) {
                        if (idx < SEQ) {
                            const float y0 = r * (1.0f / FN), y1 = -i * (1.0f / FN);
                            const float zn0 = hy_sc_ut(g0, sw[o + 1], sbv[o + 1], idx) * (y0 + zval(b0, idx) * hbias);
                            const float zn1 = hy_sc_ut(g1, sw[o + 1], sbv[o + 1], idx) * (y1 + zval(b1, idx) * hbias);
                            if (o == 0) { p.Z1[((size_t)b0 * D_CH + c) * SEQ + idx] = zn0; p.Z1[((size_t)b1 * D_CH + c) * SEQ + idx] = zn1; }
                            else { HY_OUT(b0, idx, zn0); HY_OUT(b1, idx, zn1); }
                        } }); }
            HSYNC;
        }
    }
    HY_FREE;
}
constexpr int MOD_ITEMS = DEPTH * (6 * D_MODEL / 64);
__device__ __forceinline__ void mod_item(const Params& p, char* lds, int item) {
    float* sc = (float*)lds;
    float* red = sc + 5 * D_MODEL;
    const int tid = threadIdx.x, l = item / (6 * D_MODEL / 64), j0 = (item % (6 * D_MODEL / 64)) * 64;
    for (int i = tid; i < 5 * D_MODEL; i += NTHREADS) { const int r = i / D_MODEL, k = i % D_MODEL; const float v = r < BATCH ? p.c[r * D_MODEL + k] : p.c_ctx[k]; sc[i] = silu_f(v); }
    __syncthreads();
    const int col = tid & 63, kp = tid >> 6;
    const float* w = p.w_ada + ((size_t)l * D_MODEL + kp * 256) * 6 * D_MODEL + j0 + col;
    float a0 = 0.f, a1 = 0.f, a2 = 0.f, a3 = 0.f, a4 = 0.f;
#pragma unroll 8
    for (int k = 0; k < 256; ++k) { const float wv = w[(size_t)k * 6 * D_MODEL]; const int kk = kp * 256 + k;
        a0 += sc[kk] * wv; a1 += sc[D_MODEL + kk] * wv; a2 += sc[2 * D_MODEL + kk] * wv; a3 += sc[3 * D_MODEL + kk] * wv; a4 += sc[4 * D_MODEL + kk] * wv; }
    red[(kp * 5 + 0) * 64 + col] = a0; red[(kp * 5 + 1) * 64 + col] = a1; red[(kp * 5 + 2) * 64 + col] = a2; red[(kp * 5 + 3) * 64 + col] = a3; red[(kp * 5 + 4) * 64 + col] = a4;
    __syncthreads();
    for (int i = tid; i < 5 * 64; i += NTHREADS) { const int r = i / 64, cc = i % 64;
        const float v = red[(0 * 5 + r) * 64 + cc] + red[(1 * 5 + r) * 64 + cc] + red[(2 * 5 + r) * 64 + cc] + red[(3 * 5 + r) * 64 + cc];
        p.mod[((size_t)(l * (BATCH + 1) + r)) * 6 * D_MODEL + j0 + cc] = v + p.b_ada[l * 6 * D_MODEL + j0 + cc]; }
    __syncthreads();
}
__device__ __forceinline__ void d_hy_filt(const Params& p) {
    GS_LOOP(i, (long)D_CH * SEQ) {
        const int t = i % SEQ, cg = i / SEQ, col = cg * 4;
        f32x4 acc = *(const f32x4*)(p.hy_b3 + col);
        const f32x4* hrow = (const f32x4*)(p.h2 + (size_t)t * HY_FFN);
#pragma unroll 4
        for (int k4 = 0; k4 < HY_FFN / 4; ++k4) { const f32x4 hv = hrow[k4];
#pragma unroll
            for (int kk = 0; kk < 4; ++kk) acc += *(const f32x4*)(p.hy_w3 + (size_t)(k4 * 4 + kk) * 4 * D_CH + col) * hv[kk]; }
#pragma unroll
        for (int q = 0; q < 4; ++q) p.HFT[(size_t)(col + q) * SEQ + t] = acc[q] * hy_decay(t, (col + q) % D_CH);
    }
}
__device__ __forceinline__ void ph_norm(const Params& p, int l, int which, int nrows, int bid, int nb) {
    const int lane = threadIdx.x & 63, wid = threadIdx.x >> 6;
    for (int row = bid * 4 + wid; row < nrows; row += nb * 4) {
        const float* xr = which == 0 ? xrow_in(p, l, row) : xrow_cur(p, row);
        const float* g = p.norm_g + (l * 2 + which) * D_MODEL; const float* sh = modp(p, l, row, which * 3 + 0); const float* sc = modp(p, l, row, which * 3 + 1);
        f32x4 v[4]; float ss = 0.f;
#pragma unroll
        for (int j = 0; j < 4; ++j) { v[j] = *(const f32x4*)(xr + j * 256 + lane * 4); ss += v[j][0] * v[j][0] + v[j][1] * v[j][1] + v[j][2] * v[j][2] + v[j][3] * v[j][3]; }
        const float rstd = 1.0f / sqrtf(wave_sum(ss) * (1.0f / D_MODEL) + EPS);
#pragma unroll
        for (int j = 0; j < 4; ++j) { const int c = j * 256 + lane * 4; const f32x4 o = v[j] * rstd * *(const f32x4*)(g + c) * (*(const f32x4*)(sc + c) + 1.0f) + *(const f32x4*)(sh + c);
            store4bf(p.hbuf + (size_t)row * D_MODEL + c, o); }
    }
}
__device__ __forceinline__ void ph_router(const Params& p, char* lds, int l, int nrows, int bid, int nb) {
    const int lane = threadIdx.x & 63, wid = threadIdx.x >> 6;
    float* wr_s = (float*)lds;
    for (int i = threadIdx.x; i < D_MODEL * 16 / 4; i += NTHREADS) ((f32x4*)wr_s)[i] = ((const f32x4*)p.w_router)[i];
    __syncthreads();
    for (int row = bid * 4 + wid; row < nrows; row += nb * 4) {
        const float* xr = xrow_cur(p, row);
        const float* g = p.norm_g + (l * 2 + 1) * D_MODEL; const float* sh = modp(p, l, row, 3); const float* sc = modp(p, l, row, 4);
        f32x4 v[4]; float ss = 0.f;
#pragma unroll
        for (int j = 0; j < 4; ++j) { v[j] = *(const f32x4*)(xr + j * 256 + lane * 4); ss += v[j][0] * v[j][0] + v[j][1] * v[j][1] + v[j][2] * v[j][2] + v[j][3] * v[j][3]; }
        const float rstd = 1.0f / sqrtf(wave_sum(ss) * (1.0f / D_MODEL) + EPS);
        float lg[16];
#pragma unroll
        for (int e = 0; e < 16; ++e) lg[e] = 0.f;
#pragma unroll
        for (int j = 0; j < 4; ++j) { const int c = j * 256 + lane * 4; const f32x4 o = v[j] * rstd * *(const f32x4*)(g + c) * (*(const f32x4*)(sc + c) + 1.0f) + *(const f32x4*)(sh + c);
            store4bf(p.hbuf + (size_t)row * D_MODEL + c, o);
#pragma unroll
            for (int r = 0; r < 4; ++r) { const float* w = wr_s + (c + r) * 16;
#pragma unroll
                for (int e4 = 0; e4 < 4; ++e4) { const f32x4 wv = *(const f32x4*)(w + e4 * 4); lg[e4 * 4 + 0] += o[r] * wv[0]; lg[e4 * 4 + 1] += o[r] * wv[1]; lg[e4 * 4 + 2] += o[r] * wv[2]; lg[e4 * 4 + 3] += o[r] * wv[3]; } }
            asm volatile("" ::: "memory"); }
#pragma unroll
        for (int e = 0; e < 16; ++e) lg[e] = wave_sum(lg[e]);
        if (lane == 0) {
            int gbest = 0, a = 0, bb = 1; float gbs = -1e30f, wa = 0.f, wb = 0.f;
#pragma unroll
            for (int gI = 0; gI < 4; ++gI) {
                float m1 = -1e30f, m2 = -1e30f, s1 = 0.f, s2 = 0.f; int i1 = 0, i2 = 0;
#pragma unroll
                for (int j = 0; j < 4; ++j) { float sgv = sigmoid_f(lg[gI * 4 + j]); float vv = sgv + p.b_router[gI * 4 + j];
                    if (vv > m1) { m2 = m1; i2 = i1; s2 = s1; m1 = vv; i1 = j; s1 = sgv; } else if (vv > m2) { m2 = vv; i2 = j; s2 = sgv; } }
                float gs = m1 + m2;
                if (gs > gbs) { gbs = gs; gbest = gI; if (i1 < i2) { a = i1; bb = i2; wa = s1; wb = s2; } else { a = i2; bb = i1; wa = s2; wb = s1; } }
            }
            const float inv = 1.0f / (wa + wb);
            const int pidx = a == 0 ? bb - 1 : (a == 1 ? bb + 1 : 5);
            const int pr = gbest * 6 + pidx;
            const int pos = atomicAdd(p.cnt + l * 32 + pr, 1);
            p.list[(size_t)pr * TT + pos] = row;
            p.tokw[row * 2 + 0] = wa * inv; p.tokw[row * 2 + 1] = wb * inv;
        }
    }
    __syncthreads();
}
__device__ __forceinline__ void ph_final(const Params& p, int bid, int nb) {
    const int lane = threadIdx.x & 63, wid = threadIdx.x >> 6;
    for (int row = bid * 4 + wid; row < TX; row += nb * 4) {
        float* xr = p.out + (size_t)row * D_MODEL;
        f32x4 v[4]; float ss = 0.f;
#pragma unroll
        for (int j = 0; j < 4; ++j) { v[j] = *(const f32x4*)(xr + j * 256 + lane * 4); ss += v[j][0] * v[j][0] + v[j][1] * v[j][1] + v[j][2] * v[j][2] + v[j][3] * v[j][3]; }
        const float rstd = 1.0f / sqrtf(wave_sum(ss) * (1.0f / D_MODEL) + EPS);
#pragma unroll
        for (int j = 0; j < 4; ++j) { const int c = j * 256 + lane * 4; *(f32x4*)(xr + c) = v[j] * rstd * *(const f32x4*)(p.final_g + c); }
    }
}

#define XB_TMO      128
#define XB_XCNT(j)  (256  + 64 * (j))
#define XB_XSUB(j)  (1280 + 64 * (j))
#define XB_XGEN(j)  (2304 + 64 * (j))
#define XB_TOP      3328
#define XB_TOPGEN   3392
#define XCD_BAR_WORDS 3456
#define XB_SPIN_CAP (1u << 20)
__device__ __forceinline__ unsigned xb_ld(unsigned* p)              { return __hip_atomic_load(p, __ATOMIC_RELAXED, __HIP_MEMORY_SCOPE_AGENT); }
__device__ __forceinline__ unsigned xb_add(unsigned* p, unsigned v) { return __hip_atomic_fetch_add(p, v, __ATOMIC_RELAXED, __HIP_MEMORY_SCOPE_AGENT); }
__device__ __forceinline__ unsigned xb_xcc_id() { return (unsigned)__builtin_amdgcn_s_getreg((3 << 11) | 20) & 0xFu; }
#define XB_SPIN(cond, bar) do { unsigned _sp = 0; while (cond) { __builtin_amdgcn_s_sleep(1); \
    if ((++_sp & 255u) == 0u) { if (xb_ld(&(bar)[XB_TMO])) break; if (_sp > XB_SPIN_CAP) { atomicAdd(&(bar)[XB_TMO], 1u); break; } } } } while (0)
struct XcdBarrier { unsigned* bar; unsigned x; volatile LAS unsigned* st; };
__device__ __forceinline__ XcdBarrier xcd_barrier_post(unsigned* bar, volatile LAS unsigned* st) {
    XcdBarrier b; b.bar = bar; b.x = xb_xcc_id(); b.st = st;
    if (threadIdx.x == 0) (void)xb_add(&bar[XB_XCNT(b.x)], 1u);
    return b;
}
__device__ __forceinline__ void xcd_barrier_complete(unsigned* bar, unsigned x, unsigned& nloc, unsigned& nx) {
    const unsigned G = gridDim.x * gridDim.y * gridDim.z;
    unsigned sum, cnt, mine, sp = 0u;
    for (;;) {
        sum = 0u; cnt = 0u; mine = 0u;
#pragma unroll
        for (unsigned j = 0; j < 16; ++j) { const unsigned c = xb_ld(&bar[XB_XCNT(j)]); sum += c; cnt += (c > 0u) ? 1u : 0u; mine = (j == x) ? c : mine; }
        if (sum == G) break;
        __builtin_amdgcn_s_sleep(1);
        if ((++sp & 255u) == 0u) { if (xb_ld(&bar[XB_TMO])) break; if (sp > XB_SPIN_CAP) { atomicAdd(&bar[XB_TMO], 1u); break; } }
    }
    nloc = mine > 0u ? mine : 1u; nx = cnt > 0u ? cnt : 1u;
}
__device__ __forceinline__ void xcd_barrier(const XcdBarrier& b) {
    asm volatile("s_waitcnt vmcnt(0)" ::: "memory");
    __syncthreads();
    if (threadIdx.x == 0) {
        unsigned* bar = b.bar;
        __builtin_amdgcn_s_waitcnt(0);
        unsigned nloc = b.st[0], nx = b.st[1];
        if (nloc == 0u) { xcd_barrier_complete(bar, b.x, nloc, nx); b.st[0] = nloc; b.st[1] = nx; }
        const unsigned old = xb_add(&bar[XB_XSUB(b.x)], 1u);
        const unsigned gen = old / nloc;
        if (old + 1u == (gen + 1u) * nloc) {
            __builtin_amdgcn_fence(__ATOMIC_RELEASE, "agent");
            asm volatile("s_waitcnt vmcnt(0)" ::: "memory");
            const unsigned og = xb_add(&bar[XB_TOP], 1u);
            const unsigned tg = og / nx;
            if (og + 1u == (tg + 1u) * nx) xb_add(&bar[XB_TOPGEN], 1u);
            else XB_SPIN(xb_ld(&bar[XB_TOPGEN]) == tg, bar);
            __builtin_amdgcn_fence(__ATOMIC_ACQUIRE, "agent");
            xb_add(&bar[XB_XGEN(b.x)], 1u);
            asm volatile("s_waitcnt vmcnt(0)" ::: "memory");
        } else {
            XB_SPIN(xb_ld(&bar[XB_XGEN(b.x)]) == gen, bar);
            __builtin_amdgcn_fence(__ATOMIC_ACQUIRE, "agent");
            asm volatile("s_waitcnt vmcnt(0)" ::: "memory");
        }
    }
    __syncthreads();
}

__device__ __forceinline__ void ph_mix1(const Params& p, char* lds, int bid, int nb) {
    for (int u = bid; u < NU_LAT + D_CH; u += nb) {
        if (u < NU_LAT) { const int blk = u % (SEQ / 128), h = (u / (SEQ / 128)) % 8, b = u / (8 * (SEQ / 128)); const int s0 = blk * 128;
            attn_unit<0>(lds, p.QC + (size_t)(b * SEQ + s0) * 512 + h * 64, p.KC + (size_t)(b * 2 + h / 4) * LKV * 64, p.VCt + (size_t)(b * 2 + h / 4) * 64 * LKV,
                         p.Y + (size_t)(b * SEQ + s0) * 1024 + h * 64, s0, CTX_LEN / 64, 0, SEQ / 64, 0.f, false, nullptr); }
        else hyena_channel(p, u - NU_LAT, (float*)lds);
    }
}
enum { PH_PREP = 0, PH_NORM0, PH_INPROJ0, PH_ATTN0, PH_OUT0, PH_ROUTE0, PH_UP0, PH_DOWN0, PH_NORM1, PH_INPROJ1, PH_MIX1, PH_OUT1, PH_ROUTE1, PH_UP1, PH_DOWN1, PH_FINAL, PH_COUNT };
__global__ void __launch_bounds__(NTHREADS, 2) mega(Params p, int lo, int hi) {
    extern __shared__ __attribute__((aligned(16))) char lds[];
    const int bid = blockIdx.x, nb = gridDim.x;
    volatile LAS unsigned* st = (volatile LAS unsigned*)(lds + LDS_BYTES - 16);
    if (threadIdx.x < 4) st[threadIdx.x] = 0u;
    __syncthreads();
    XcdBarrier bar; bar.bar = p.bar; bar.x = 0; bar.st = st;
    if (hi - lo > 1) bar = xcd_barrier_post(p.bar, st);
#define PHASE(PH, body) if (lo <= (PH) && (PH) < hi) { body; if ((PH) + 1 < hi) xcd_barrier(bar); }
    PHASE(PH_PREP, { for (int it = bid; it < MOD_ITEMS + CVT_TOTAL; it += nb) { if (it < MOD_ITEMS) mod_item(p, lds, it); else cvt_item(p, lds, it - MOD_ITEMS); } d_rope(p); d_hy_h1(p); })
    PHASE(PH_NORM0, { ph_norm(p, 0, 0, TT, bid, nb); d_hy_h2(p); })
    PHASE(PH_INPROJ0, { ph_inproj<0>(p, lds, bid, nb); d_hy_filt(p); })
    PHASE(PH_ATTN0, ph_attn0(p, lds, bid, nb))
    PHASE(PH_OUT0, ph_outproj<0>(p, lds, bid, nb))
    PHASE(PH_ROUTE0, ph_router(p, lds, 0, TT, bid, nb))
    PHASE(PH_UP0, ph_moe_up(p, lds, 0, bid, nb))
    PHASE(PH_DOWN0, ph_moe_down(p, lds, 0, bid, nb))
    PHASE(PH_NORM1, ph_norm(p, 1, 0, TT, bid, nb))
    PHASE(PH_INPROJ1, ph_inproj<1>(p, lds, bid, nb))
    PHASE(PH_MIX1, ph_mix1(p, lds, bid, nb))
    PHASE(PH_OUT1, ph_outproj<1>(p, lds, bid, nb))
    PHASE(PH_ROUTE1, ph_router(p, lds, 1, TX, bid, nb))
    PHASE(PH_UP1, ph_moe_up(p, lds, 1, bid, nb))
    PHASE(PH_DOWN1, ph_moe_down(p, lds, 1, bid, nb))
    PHASE(PH_FINAL, ph_final(p, bid, nb))
}
extern "C" void kernel_launch(void* const* d_in, const int* in_sizes, int n_in, void* d_out, int out_size, void* d_ws, size_t ws_size, hipStream_t stream) {
    static int grid = 0;
    if (grid == 0) {
        int dev = 0, cus = 0;
        if (hipGetDevice(&dev) != hipSuccess || hipDeviceGetAttribute(&cus, hipDeviceAttributeMultiprocessorCount, dev) != hipSuccess) { fprintf(stderr, "kernel_launch: device query failed\n"); grid = -1; return; }
        if (hipFuncSetAttribute((const void*)mega, hipFuncAttributeMaxDynamicSharedMemorySize, LDS_BYTES) != hipSuccess) { fprintf(stderr, "kernel_launch: hipFuncSetAttribute failed\n"); grid = -1; return; }
        grid = 2 * cus;
    }
    if (grid < 0) return;
    Params p{};
    size_t need = setup_ws(p, (char*)d_ws);
    if (n_in != 32 || need > ws_size || out_size != TX * D_MODEL) { fprintf(stderr, "kernel_launch: bad config n_in %d ws %zu need %zu out %d\n", n_in, ws_size, need, out_size); return; }
    fill_inputs(p, d_in, d_out);
    hipMemsetAsync(p.bar, 0, 64 * 1024 + 256, stream);
#ifdef PER_PHASE
    for (int ph = 0; ph < PH_COUNT; ++ph) mega<<<dim3(grid), dim3(NTHREADS), LDS_BYTES, stream>>>(p, ph, ph + 1);
#else
    mega<<<dim3(grid), dim3(NTHREADS), LDS_BYTES, stream>>>(p, 0, PH_COUNT);
#endif
}
```

```cpp
#include <hip/hip_runtime.h>
#include <cstdio>
#include <math.h>
#include <stdint.h>
#include <string.h>

#ifdef CPU_TEST
#define HD
#define GLOBAL
struct U3 { unsigned x, y, z; };
static thread_local U3 threadIdx, blockIdx, blockDim, gridDim;
static inline int atomicAdd(int* p, int v) { return __sync_fetch_and_add(p, v); }
#else
#define HD __device__ __forceinline__
#define GLOBAL __global__ __launch_bounds__(256)
#endif

#if defined(HY_TEST)
constexpr int D_MODEL = 64, BATCH = 2, SEQ = 4096, GRID_W = 64, CTX_LEN = 64, D_CH = 4, D_EXPERT = 64;
#elif defined(SMALL_CFG)
constexpr int D_MODEL = 128, BATCH = 2, SEQ = 512, GRID_W = 32, CTX_LEN = 64, D_CH = 32, D_EXPERT = 64;
#else
constexpr int D_MODEL = 1024, BATCH = 4, SEQ = 4096, GRID_W = 64, CTX_LEN = 256, D_CH = 512, D_EXPERT = 512;
#endif
constexpr int DEPTH = 2, HEAD_DIM = 64;
constexpr int GRID_H = SEQ / GRID_W;
constexpr int A_WINDOW = 128;
constexpr int B_WIN_H = 8, B_WIN_W = 16;
constexpr int HY_BANDS = 16, HY_EMB = 33, HY_FFN = 64;
constexpr int EVEN_IN = 2304, EVEN_OUT = 1024;
constexpr int ODD_IN = 768 + 3 * D_CH, ODD_OUT = 512 + D_CH;
constexpr int N_EXPERTS = 16;
constexpr int TX = BATCH * SEQ, TC = BATCH * CTX_LEN, TT = TX + TC;
constexpr int LKV = CTX_LEN + SEQ;
constexpr int NPAIR = 24;
constexpr int HE_W = 2 * D_EXPERT;
constexpr float EPS = 1e-6f;
constexpr float ATTN_SCALE = 0.125f;

typedef unsigned short bf16_t;
HD bf16_t f2bf(float f) { unsigned u; __builtin_memcpy(&u, &f, 4); u = (u + 0x7fffu + ((u >> 16) & 1u)) >> 16; return (bf16_t)u; }
HD float bf2f(bf16_t h) { unsigned u = ((unsigned)h) << 16; float f; __builtin_memcpy(&f, &u, 4); return f; }
HD float silu_f(float x) { return x / (1.0f + expf(-x)); }
HD float sigmoid_f(float x) { return 1.0f / (1.0f + expf(-x)); }

struct Params {
    const float *x, *c, *ctx, *c_ctx, *w_ada, *b_ada, *norm_g, *final_g, *w_in_even, *w_out_even, *a_sink, *b_rpb;
    const float *w_in_odd, *w_out_odd, *c_qnorm, *c_knorm, *hy_short_w, *hy_short_b, *hy_w1, *hy_b1, *hy_f1, *hy_w2;
    const float *hy_b2, *hy_f2, *hy_w3, *hy_b3, *hy_bias, *w_router, *b_router, *moe_wg, *moe_wu, *moe_wd;
    float* out;
    float* XC;
    float* mod;
    float* ropet;
    float* h1;
    float* h2;
    float* HFT;
    float* hnorm;
    bf16_t* hbuf;
    bf16_t *QA, *KA, *VAt, *QB, *KB, *VBt;
    bf16_t *QC, *KC, *VCt, *UT;
    bf16_t* Y;
    bf16_t* YHT;
    float* Z1;
    bf16_t* HE;
    int* cnt;
    int* list;
    float* tokw;
    bf16_t *Wt_in_even, *Wt_out_even, *Wt_in_odd, *Wt_out_odd, *Wt_gu, *Wt_d;
    unsigned* bar;
};

#define GS_LOOP(i, n) for (long i = (long)blockIdx.x * blockDim.x + threadIdx.x; i < (long)(n); i += (long)gridDim.x * blockDim.x)

HD const float* xrow_in(const Params& p, int l, int row) {
    if (l == 0) return row < TX ? p.x + (size_t)row * D_MODEL : p.ctx + (size_t)(row - TX) * D_MODEL;
    return row < TX ? p.out + (size_t)row * D_MODEL : p.XC + (size_t)(row - TX) * D_MODEL;
}
HD float* xrow_cur(const Params& p, int row) { return row < TX ? p.out + (size_t)row * D_MODEL : p.XC + (size_t)(row - TX) * D_MODEL; }
HD int row_mod(int row) { return row < TX ? row / SEQ : BATCH; }
HD const float* modp(const Params& p, int l, int row, int which) { return p.mod + ((size_t)(l * (BATCH + 1) + row_mod(row)) * 6 + which) * D_MODEL; }

GLOBAL void nk_mod(Params p) {
    GS_LOOP(i, DEPTH * (BATCH + 1) * 6 * D_MODEL) {
        int j = i % (6 * D_MODEL); int r = (i / (6 * D_MODEL)) % (BATCH + 1); int l = i / (6 * D_MODEL * (BATCH + 1));
        const float* cv = r < BATCH ? p.c + r * D_MODEL : p.c_ctx;
        const float* w = p.w_ada + (size_t)l * D_MODEL * 6 * D_MODEL;
        float acc = 0.f;
        for (int k = 0; k < D_MODEL; ++k) acc += silu_f(cv[k]) * w[(size_t)k * 6 * D_MODEL + j];
        p.mod[i] = acc + p.b_ada[l * 6 * D_MODEL + j];
    }
}
HD void d_rope(const Params& p) {
    GS_LOOP(i, 64 * 16) {
        int pos = i / 16, k = i % 16;
        float inv = powf(10000.0f, -(float)(2 * k) / 32.0f);
        float a = (float)pos * inv;
        p.ropet[pos * 32 + k] = cosf(a); p.ropet[pos * 32 + 16 + k] = sinf(a);
    }
}
HD void d_hy_h1(const Params& p) {
    GS_LOOP(i, SEQ * HY_FFN) {
        int t = i / HY_FFN, k = i % HY_FFN;
        float tn = (float)t / (float)(SEQ - 1);
        float acc = tn * p.hy_w1[0 * HY_FFN + k];
        for (int b = 0; b < HY_BANDS; ++b) {
            float band = 1e-4f + (float)b * ((float)(HY_BANDS - 1) - 1e-4f) / (float)(HY_BANDS - 1);
            float ang = 2.0f * 3.14159265358979323846f * (float)t * band / (float)SEQ;
            acc += cosf(ang) * p.hy_w1[(1 + b) * HY_FFN + k] + sinf(ang) * p.hy_w1[(1 + HY_BANDS + b) * HY_FFN + k];
        }
        p.h1[i] = sinf(p.hy_f1[k] * (acc + p.hy_b1[k]));
    }
}
HD void d_hy_h2(const Params& p) {
    GS_LOOP(i, SEQ * HY_FFN) {
        int t = i / HY_FFN, j = i % HY_FFN;
        float acc = 0.f;
        for (int k = 0; k < HY_FFN; ++k) acc += p.h1[t * HY_FFN + k] * p.hy_w2[k * HY_FFN + j];
        p.h2[i] = sinf(p.hy_f2[j] * (acc + p.hy_b2[j]));
    }
}
HD float hy_decay(int t, int c) {
    const float mind = logf(1e-2f) / 1.5f, maxd = logf(1e-2f) / 0.3f;
    float delta = fabsf(mind + (float)c * (maxd - mind) / (float)(D_CH - 1));
    float tn = (float)t / (float)(SEQ - 1);
    return expf(-tn * delta);
}
GLOBAL void nk_hy_filt(Params p) {
    GS_LOOP(i, 4 * D_CH * SEQ) {
        int t = i % SEQ, col = i / SEQ, c = col % D_CH;
        float acc = p.hy_b3[col];
        for (int k = 0; k < HY_FFN; ++k) acc += p.h2[t * HY_FFN + k] * p.hy_w3[k * 4 * D_CH + col];
        p.HFT[i] = acc * hy_decay(t, c);
    }
}
GLOBAL void nk_hy_norm(Params p) {
    GS_LOOP(i, 2 * D_CH) {
        int o = i / D_CH, c = i % D_CH;
        float s = 0.f;
        for (int dir = 0; dir < 2; ++dir) { const float* h = p.HFT + (size_t)((dir * 2 + o) * D_CH + c) * SEQ; for (int t = 0; t < SEQ; ++t) s += fabsf(h[t]); }
        p.hnorm[i] = s + EPS;
    }
}
GLOBAL void nk_zero_cnt(Params p) { GS_LOOP(i, 64) p.cnt[i] = 0; }

GLOBAL void nk_norm(Params p, int l, int which, int nrows) {
    GS_LOOP(row, nrows) {
        const float* xr = which == 0 ? xrow_in(p, l, (int)row) : xrow_cur(p, (int)row);
        float ss = 0.f;
        for (int k = 0; k < D_MODEL; ++k) ss += xr[k] * xr[k];
        float rstd = 1.0f / sqrtf(ss / D_MODEL + EPS);
        const float* g = p.norm_g + (l * 2 + which) * D_MODEL;
        const float* sh = modp(p, l, (int)row, which * 3 + 0); const float* sc = modp(p, l, (int)row, which * 3 + 1);
        for (int k = 0; k < D_MODEL; ++k) p.hbuf[row * D_MODEL + k] = f2bf(xr[k] * rstd * g[k] * (1.0f + sc[k]) + sh[k]);
    }
}

HD float dot_row(const bf16_t* a, const float* W, int ldw, int col, int K) {
    float acc = 0.f;
    for (int k = 0; k < K; ++k) acc += bf2f(a[k]) * W[(size_t)k * ldw + col];
    return acc;
}
HD float rope_apply(const Params& p, float v, float partner, int d, int s) {
    int half = d >> 5, dd = d & 31, k = dd & 15;
    int pos = half == 0 ? s / GRID_W : s % GRID_W;
    float c = p.ropet[pos * 32 + k], sn = p.ropet[pos * 32 + 16 + k];
    return dd < 16 ? v * c - partner * sn : v * c + partner * sn;
}

GLOBAL void nk_inproj_even(Params p) {
    GS_LOOP(i, (long)TT * EVEN_IN) {
        int row = i / EVEN_IN, col = i % EVEN_IN;
        const bf16_t* a = p.hbuf + (size_t)row * D_MODEL;
        float v = dot_row(a, p.w_in_even, EVEN_IN, col, D_MODEL);
        bool lat = row < TX; int b = lat ? row / SEQ : (row - TX) / CTX_LEN; int s = lat ? row % SEQ : (row - TX) % CTX_LEN;
        int pos = lat ? CTX_LEN + s : s;
        if (col < 640) {
            int d = col & 63;
            if (lat) { int pc = (d & 31) < 16 ? col + 16 : col - 16; float pv = dot_row(a, p.w_in_even, EVEN_IN, pc, D_MODEL); v = rope_apply(p, v, pv, d, s); }
            if (col < 512) p.QA[(size_t)row * 512 + col] = f2bf(v);
            else { int h = (col - 512) >> 6; p.KA[((size_t)(b * 2 + h) * LKV + pos) * 64 + d] = f2bf(v); }
        } else if (col < 768) { int h = (col - 640) >> 6, d = col & 63; p.VAt[((size_t)(b * 2 + h) * 64 + d) * LKV + pos] = f2bf(v); }
        else if (col < 1280) p.QB[(size_t)row * 512 + (col - 768)] = f2bf(v);
        else if (col < 1792) { int h = (col - 1280) >> 6, d = col & 63; p.KB[((size_t)(b * 8 + h) * LKV + pos) * 64 + d] = f2bf(v); }
        else { int h = (col - 1792) >> 6, d = col & 63; p.VBt[((size_t)(b * 8 + h) * 64 + d) * LKV + pos] = f2bf(v); }
    }
}

struct OSM { float m, l; };
#define ATT_BEGIN() float q[64], acc[64]; for (int d = 0; d < 64; ++d) { q[d] = bf2f(qp[d]) * ATTN_SCALE; acc[d] = 0.f; } float m_ = -1e30f, l_ = 0.f;
#define ATT_KEY(Kp, Vt, key, bias) do { const bf16_t* kk_ = (Kp) + (size_t)(key) * 64; float s_ = (bias); for (int d = 0; d < 64; ++d) s_ += q[d] * bf2f(kk_[d]); \
    float mn_ = fmaxf(m_, s_); float f_ = expf(m_ - mn_), pe_ = expf(s_ - mn_); l_ = l_ * f_ + pe_; \
    for (int d = 0; d < 64; ++d) acc[d] = acc[d] * f_ + pe_ * bf2f((Vt)[(size_t)d * LKV + (key)]); m_ = mn_; } while (0)
#define ATT_SINK(sv) do { float s_ = (sv); float mn_ = fmaxf(m_, s_); float f_ = expf(m_ - mn_); l_ = l_ * f_ + expf(s_ - mn_); for (int d = 0; d < 64; ++d) acc[d] *= f_; m_ = mn_; } while (0)

GLOBAL void nk_attnA(Params p) {
    GS_LOOP(i, (long)TX * 8) {
        int h = i % 8, row = i / 8, b = row / SEQ, s = row % SEQ, kvh = h / 4;
        const bf16_t* qp = p.QA + (size_t)row * 512 + h * 64;
        const bf16_t* Kp = p.KA + (size_t)(b * 2 + kvh) * LKV * 64; const bf16_t* Vt = p.VAt + (size_t)(b * 2 + kvh) * 64 * LKV;
        ATT_BEGIN();
        for (int j = 0; j < CTX_LEN; ++j) ATT_KEY(Kp, Vt, j, 0.f);
        int lo = s - A_WINDOW < 0 ? 0 : s - A_WINDOW, hi = s + A_WINDOW > SEQ - 1 ? SEQ - 1 : s + A_WINDOW;
        for (int j = lo; j <= hi; ++j) ATT_KEY(Kp, Vt, CTX_LEN + j, 0.f);
        ATT_SINK(p.a_sink[h]);
        for (int d = 0; d < 64; ++d) p.Y[(size_t)row * 1024 + h * 64 + d] = f2bf(acc[d] / l_);
    }
}
GLOBAL void nk_attnB(Params p) {
    GS_LOOP(i, (long)TX * 8) {
        int h = i % 8, row = i / 8, b = row / SEQ, s = row % SEQ, r = s / GRID_W, cq = s % GRID_W;
        const bf16_t* qp = p.QB + (size_t)row * 512 + h * 64;
        const bf16_t* Kp = p.KB + (size_t)(b * 8 + h) * LKV * 64; const bf16_t* Vt = p.VBt + (size_t)(b * 8 + h) * 64 * LKV;
        ATT_BEGIN();
        for (int j = 0; j < CTX_LEN; ++j) ATT_KEY(Kp, Vt, j, 0.f);
        int kh = B_WIN_H < GRID_H ? B_WIN_H : GRID_H;
        int rs = r - kh / 2; if (rs < 0) rs = 0; if (rs > GRID_H - kh) rs = GRID_H - kh;
        int cs = cq - B_WIN_W / 2; if (cs < 0) cs = 0; if (cs > GRID_W - B_WIN_W) cs = GRID_W - B_WIN_W;
        for (int kr = rs; kr < rs + kh; ++kr)
            for (int kc = cs; kc < cs + B_WIN_W; ++kc) {
                int dr = kr - r, dc = kc - cq;
                float bias = p.b_rpb[(h * (2 * B_WIN_H - 1) + dr + B_WIN_H - 1) * (2 * B_WIN_W - 1) + dc + B_WIN_W - 1];
                ATT_KEY(Kp, Vt, CTX_LEN + kr * GRID_W + kc, bias);
            }
        for (int d = 0; d < 64; ++d) p.Y[(size_t)row * 1024 + 512 + h * 64 + d] = f2bf(acc[d] / l_);
    }
}
GLOBAL void nk_attn_ctx(Params p) {
    GS_LOOP(i, (long)TC * 16) {
        int hh = i % 16, rc = i / 16, ty = hh / 8, h = hh % 8, b = rc / CTX_LEN; int row = TX + rc;
        const bf16_t* qp = (ty == 0 ? p.QA : p.QB) + (size_t)row * 512 + h * 64;
        const bf16_t* Kp = ty == 0 ? p.KA + (size_t)(b * 2 + h / 4) * LKV * 64 : p.KB + (size_t)(b * 8 + h) * LKV * 64;
        const bf16_t* Vt = ty == 0 ? p.VAt + (size_t)(b * 2 + h / 4) * 64 * LKV : p.VBt + (size_t)(b * 8 + h) * 64 * LKV;
        ATT_BEGIN();
        for (int j = 0; j < CTX_LEN; ++j) ATT_KEY(Kp, Vt, j, 0.f);
        if (ty == 0) ATT_SINK(p.a_sink[h]);
        for (int d = 0; d < 64; ++d) p.Y[(size_t)row * 1024 + ty * 512 + h * 64 + d] = f2bf(acc[d] / l_);
    }
}
GLOBAL void nk_attnC(Params p) {
    GS_LOOP(i, (long)TX * 8) {
        int h = i % 8, row = i / 8, b = row / SEQ, kvh = h / 4;
        const bf16_t* qp = p.QC + (size_t)row * 512 + h * 64;
        const bf16_t* Kp = p.KC + (size_t)(b * 2 + kvh) * LKV * 64; const bf16_t* Vt = p.VCt + (size_t)(b * 2 + kvh) * 64 * LKV;
        ATT_BEGIN();
        for (int j = 0; j < LKV; ++j) ATT_KEY(Kp, Vt, j, 0.f);
        for (int d = 0; d < 64; ++d) p.Y[(size_t)row * 1024 + h * 64 + d] = f2bf(acc[d] / l_);
    }
}

GLOBAL void nk_outproj_even(Params p) {
    GS_LOOP(i, (long)TT * D_MODEL) {
        int row = i / D_MODEL, col = i % D_MODEL;
        float acc = dot_row(p.Y + (size_t)row * 1024, p.w_out_even, D_MODEL, col, EVEN_OUT);
        xrow_cur(p, row)[col] = xrow_in(p, 0, row)[col] + modp(p, 0, row, 2)[col] * acc;
    }
}
GLOBAL void nk_outproj_odd(Params p) {
    GS_LOOP(i, (long)TX * D_MODEL) {
        int row = i / D_MODEL, col = i % D_MODEL, b = row / SEQ, s = row % SEQ;
        float acc = dot_row(p.Y + (size_t)row * 1024, p.w_out_odd, D_MODEL, col, 512);
        for (int c = 0; c < D_CH; ++c) acc += bf2f(p.YHT[((size_t)b * D_CH + c) * SEQ + s]) * p.w_out_odd[(size_t)(512 + c) * D_MODEL + col];
        p.out[i] = p.out[i] + modp(p, 1, row, 2)[col] * acc;
    }
}

GLOBAL void nk_router(Params p, int l, int nrows) {
    GS_LOOP(row, nrows) {
        const float* xr = xrow_cur(p, (int)row);
        float ss = 0.f;
        for (int k = 0; k < D_MODEL; ++k) ss += xr[k] * xr[k];
        float rstd = 1.0f / sqrtf(ss / D_MODEL + EPS);
        const float* g = p.norm_g + (l * 2 + 1) * D_MODEL; const float* sh = modp(p, l, (int)row, 3); const float* sc = modp(p, l, (int)row, 4);
        float lg[16];
#pragma unroll
        for (int e = 0; e < 16; ++e) lg[e] = 0.f;
        for (int k = 0; k < D_MODEL; ++k) { float hv = xr[k] * rstd * g[k] * (1.0f + sc[k]) + sh[k];
#pragma unroll
            for (int e = 0; e < 16; ++e) lg[e] += hv * p.w_router[k * 16 + e]; }
        int gbest = 0, a = 0, bb = 1; float gbs = -1e30f, wa = 0.f, wb = 0.f;
#pragma unroll
        for (int gI = 0; gI < 4; ++gI) {
            float m1 = -1e30f, m2 = -1e30f, s1 = 0.f, s2 = 0.f; int i1 = 0, i2 = 0;
#pragma unroll
            for (int j = 0; j < 4; ++j) { float sgv = sigmoid_f(lg[gI * 4 + j]); float v = sgv + p.b_router[gI * 4 + j];
                if (v > m1) { m2 = m1; i2 = i1; s2 = s1; m1 = v; i1 = j; s1 = sgv; } else if (v > m2) { m2 = v; i2 = j; s2 = sgv; } }
            float gs = m1 + m2;
            if (gs > gbs) { gbs = gs; gbest = gI; if (i1 < i2) { a = i1; bb = i2; wa = s1; wb = s2; } else { a = i2; bb = i1; wa = s2; wb = s1; } }
        }
        float inv = 1.0f / (wa + wb);
        int pidx = a == 0 ? bb - 1 : (a == 1 ? bb + 1 : 5);
        int pr = gbest * 6 + pidx;
        int pos = atomicAdd(p.cnt + l * 32 + pr, 1);
        p.list[(size_t)pr * TT + pos] = (int)row;
        p.tokw[row * 2 + 0] = wa * inv; p.tokw[row * 2 + 1] = wb * inv;
    }
}
HD void pair_experts(int pr, int& e1, int& e2) { int g = pr / 6, q = pr % 6; int a = q < 3 ? 0 : (q < 5 ? 1 : 2); int b = q < 3 ? q + 1 : (q < 5 ? q - 1 : 3); e1 = g * 4 + a; e2 = g * 4 + b; }
HD bool slot_lookup(const Params& p, int l, int slot, int& pr, int& row) { int acc = 0; for (int q = 0; q < NPAIR; ++q) { int c = p.cnt[l * 32 + q]; if (slot < acc + c) { pr = q; row = p.list[(size_t)q * TT + (slot - acc)]; return true; } acc += c; } return false; }
GLOBAL void nk_moe_up(Params p, int l, int nrows) {
    GS_LOOP(i, (long)nrows * HE_W) {
        int slot = i / HE_W, j = i % HE_W, k = j / D_EXPERT, jj = j % D_EXPERT; int pr, row; if (!slot_lookup(p, l, slot, pr, row)) continue;
        int e1, e2; pair_experts(pr, e1, e2); int e = k == 0 ? e1 : e2;
        const bf16_t* a = p.hbuf + (size_t)row * D_MODEL;
        const float* wg = p.moe_wg + (size_t)(l * N_EXPERTS + e) * D_MODEL * D_EXPERT; const float* wu = p.moe_wu + (size_t)(l * N_EXPERTS + e) * D_MODEL * D_EXPERT;
        float g = dot_row(a, wg, D_EXPERT, jj, D_MODEL), u = dot_row(a, wu, D_EXPERT, jj, D_MODEL);
        p.HE[(size_t)row * HE_W + j] = f2bf(p.tokw[row * 2 + k] * silu_f(g) * u);
    }
}
GLOBAL void nk_moe_down(Params p, int l, int nrows) {
    GS_LOOP(i, (long)nrows * D_MODEL) {
        int slot = i / D_MODEL, col = i % D_MODEL; int pr, row; if (!slot_lookup(p, l, slot, pr, row)) continue;
        int e1, e2; pair_experts(pr, e1, e2);
        const bf16_t* a = p.HE + (size_t)row * HE_W;
        float acc = dot_row(a, p.moe_wd + (size_t)(l * N_EXPERTS + e1) * D_EXPERT * D_MODEL, D_MODEL, col, D_EXPERT)
                  + dot_row(a + D_EXPERT, p.moe_wd + (size_t)(l * N_EXPERTS + e2) * D_EXPERT * D_MODEL, D_MODEL, col, D_EXPERT);
        float* xr = xrow_cur(p, row);
        xr[col] = xr[col] + modp(p, l, row, 5)[col] * acc;
    }
}

GLOBAL void nk_inproj_odd_qk(Params p) {
    GS_LOOP(i, (long)TT * 10) {
        int row = i / 10, hu = i % 10; const bf16_t* a = p.hbuf + (size_t)row * D_MODEL;
        bool lat = row < TX; int b = lat ? row / SEQ : (row - TX) / CTX_LEN; int s = lat ? row % SEQ : (row - TX) % CTX_LEN; int pos = lat ? CTX_LEN + s : s;
        int col0 = hu * 64;
        float v[64]; float ss = 0.f;
        for (int d = 0; d < 64; ++d) { v[d] = dot_row(a, p.w_in_odd, ODD_IN, col0 + d, D_MODEL); ss += v[d] * v[d]; }
        float rstd = 1.0f / sqrtf(ss / 64.0f + EPS);
        const float* gn = hu < 8 ? p.c_qnorm : p.c_knorm;
        for (int d = 0; d < 64; ++d) v[d] = v[d] * rstd * gn[d];
        for (int d = 0; d < 64; ++d) {
            float o = v[d];
            if (lat) { int pd = (d & 31) < 16 ? d + 16 : d - 16; o = rope_apply(p, v[d], v[pd], d, s); }
            if (hu < 8) p.QC[(size_t)row * 512 + col0 + d] = f2bf(o);
            else p.KC[((size_t)(b * 2 + (hu - 8)) * LKV + pos) * 64 + d] = f2bf(o);
        }
    }
}
GLOBAL void nk_inproj_odd_vu(Params p) {
    GS_LOOP(i, (long)TT * (ODD_IN - 640)) {
        int row = i / (ODD_IN - 640), col = 640 + i % (ODD_IN - 640); const bf16_t* a = p.hbuf + (size_t)row * D_MODEL;
        bool lat = row < TX; int b = lat ? row / SEQ : (row - TX) / CTX_LEN; int s = lat ? row % SEQ : (row - TX) % CTX_LEN; int pos = lat ? CTX_LEN + s : s;
        if (col >= 768 && !lat) continue;
        float v = dot_row(a, p.w_in_odd, ODD_IN, col, D_MODEL);
        if (col < 768) { int h = (col - 640) >> 6, d = col & 63; p.VCt[((size_t)(b * 2 + h) * 64 + d) * LKV + pos] = f2bf(v); }
        else p.UT[((size_t)b * 3 * D_CH + (col - 768)) * SEQ + s] = f2bf(v);
    }
}

HD float hy_sc(const Params& p, int b, int ch, int t) {
    const bf16_t* u = p.UT + ((size_t)b * 3 * D_CH + ch) * SEQ;
    float acc = p.hy_short_b[ch];
    for (int kk = 0; kk < 3; ++kk) { int tt = t + kk - 1; if (tt >= 0 && tt < SEQ) acc += p.hy_short_w[kk * 3 * D_CH + ch] * bf2f(u[tt]); }
    return acc;
}
GLOBAL void nk_hy_conv(Params p, int o) {
    GS_LOOP(i, (long)BATCH * D_CH * SEQ) {
        int n = i % SEQ, c = (i / SEQ) % D_CH, b = i / ((long)SEQ * D_CH);
        const float* hf = p.HFT + (size_t)((0 * 2 + o) * D_CH + c) * SEQ; const float* hb = p.HFT + (size_t)((1 * 2 + o) * D_CH + c) * SEQ;
        float inv = 1.0f / p.hnorm[o * D_CH + c];
        float acc = 0.f;
        for (int m = 0; m < SEQ; ++m) {
            float z = o == 0 ? hy_sc(p, b, c, m) : p.Z1[((size_t)b * D_CH + c) * SEQ + m];
            int d = n - m; float hv = d >= 0 ? hf[d] : hb[-d];
            acc += hv * z;
        }
        acc *= inv;
        float zn = o == 0 ? hy_sc(p, b, c, n) : p.Z1[((size_t)b * D_CH + c) * SEQ + n];
        float g = hy_sc(p, b, (o + 1) * D_CH + c, n);
        float r = g * (acc + zn * p.hy_bias[o * D_CH + c]);
        if (o == 0) p.Z1[i] = r; else p.YHT[i] = f2bf(r);
    }
}

GLOBAL void nk_final(Params p) {
    GS_LOOP(row, TX) {
        float* xr = p.out + (size_t)row * D_MODEL; float ss = 0.f;
        for (int k = 0; k < D_MODEL; ++k) ss += xr[k] * xr[k];
        float rstd = 1.0f / sqrtf(ss / D_MODEL + EPS);
        for (int k = 0; k < D_MODEL; ++k) xr[k] = xr[k] * rstd * p.final_g[k];
    }
}
GLOBAL void nk_yht_to_y(Params p) {
    GS_LOOP(i, (long)TX * D_CH) { int row = i / D_CH, c = i % D_CH, b = row / SEQ, s = row % SEQ; p.Y[(size_t)row * 1024 + 512 + c] = p.YHT[((size_t)b * D_CH + c) * SEQ + s]; }
}

GLOBAL void nk_rope(Params p) { d_rope(p); }
GLOBAL void nk_hy_h1(Params p) { d_hy_h1(p); }
GLOBAL void nk_hy_h2(Params p) { d_hy_h2(p); }
static inline size_t al256(size_t x) { return (x + 255) & ~(size_t)255; }
static size_t setup_ws(Params& p, char* ws) {
    size_t o = 0;
    auto take = [&](size_t bytes) { char* r = ws + o; o += al256(bytes); return r; };
    p.bar = (unsigned*)take(64 * 1024);
    p.cnt = (int*)take(256);
    p.XC = (float*)take((size_t)TC * D_MODEL * 4);
    p.mod = (float*)take((size_t)DEPTH * (BATCH + 1) * 6 * D_MODEL * 4);
    p.ropet = (float*)take(64 * 32 * 4);
    p.h1 = (float*)take((size_t)SEQ * 64 * 4);
    p.h2 = (float*)take((size_t)SEQ * 64 * 4);
    p.HFT = (float*)take((size_t)4 * D_CH * SEQ * 4);
    p.hnorm = (float*)take(2 * D_CH * 4);
    p.list = (int*)take((size_t)NPAIR * TT * 4);
    p.tokw = (float*)take((size_t)TT * 2 * 4);
    size_t hb = (size_t)TT * D_MODEL * 2, z1 = (size_t)BATCH * D_CH * SEQ * 4;
    char* r0 = take(hb > z1 ? hb : z1); p.hbuf = (bf16_t*)r0; p.Z1 = (float*)r0;
    size_t q = al256((size_t)TT * 512 * 2), kva = al256((size_t)BATCH * 2 * LKV * 64 * 2), kvb = al256((size_t)BATCH * 8 * LKV * 64 * 2), ut = al256((size_t)BATCH * 3 * D_CH * SEQ * 2);
    size_t l0 = 2 * q + 2 * kva + 2 * kvb, l1 = q + 2 * kva + ut;
    char* R = take(l0 > l1 ? l0 : l1);
    p.QA = (bf16_t*)R; p.KA = (bf16_t*)(R + q); p.VAt = (bf16_t*)(R + q + kva); p.QB = (bf16_t*)(R + q + 2 * kva); p.KB = (bf16_t*)(R + 2 * q + 2 * kva); p.VBt = (bf16_t*)(R + 2 * q + 2 * kva + kvb);
    p.QC = (bf16_t*)R; p.KC = (bf16_t*)(R + q); p.VCt = (bf16_t*)(R + q + kva); p.UT = (bf16_t*)(R + q + 2 * kva);
    size_t yb = (size_t)TT * 1024 * 2, heb = (size_t)TT * HE_W * 2;
    char* r1 = take(yb > heb ? yb : heb); p.Y = (bf16_t*)r1; p.HE = (bf16_t*)r1;
    p.YHT = (bf16_t*)take((size_t)BATCH * D_CH * SEQ * 2);
    p.Wt_in_even = (bf16_t*)take((size_t)EVEN_IN * D_MODEL * 2);
    p.Wt_out_even = (bf16_t*)take((size_t)D_MODEL * EVEN_OUT * 2);
    p.Wt_in_odd = (bf16_t*)take((size_t)ODD_IN * D_MODEL * 2);
    p.Wt_out_odd = (bf16_t*)take((size_t)D_MODEL * ODD_OUT * 2);
    p.Wt_gu = (bf16_t*)take((size_t)DEPTH * N_EXPERTS * 2 * D_EXPERT * D_MODEL * 2);
    p.Wt_d = (bf16_t*)take((size_t)DEPTH * N_EXPERTS * D_MODEL * D_EXPERT * 2);
    return o;
}
static void fill_inputs(Params& p, void* const* d_in, void* d_out) {
    const float** f = (const float**)&p.x;
    for (int i = 0; i < 32; ++i) f[i] = (const float*)d_in[i];
    p.out = (float*)d_out;
}
#define LAS __attribute__((address_space(3)))
typedef short bf16x8 __attribute__((ext_vector_type(8)));
typedef float f32x4 __attribute__((ext_vector_type(4)));
typedef float f32x16 __attribute__((ext_vector_type(16)));
typedef unsigned u32x4 __attribute__((ext_vector_type(4)));
typedef unsigned u32x2 __attribute__((ext_vector_type(2)));

constexpr int NTHREADS = 256;
constexpr int LDS_BYTES = 69632;
constexpr int MT_ALL = TT / 128, MT_LAT = TX / 128;

__device__ __forceinline__ unsigned pk2bf(float lo, float hi) { return (unsigned)f2bf(lo) | ((unsigned)f2bf(hi) << 16); }
__device__ __forceinline__ float wave_sum(float v) {
#pragma unroll
    for (int o = 1; o < 64; o <<= 1) v += __shfl_xor(v, o);
    return v;
}

template <class SrcF, class DstF>
__device__ __forceinline__ void cvt_tile(char* lds, int k0, int n0, const SrcF& src, const DstF& dst) {
    float* T = (float*)lds;
    const int tid = threadIdx.x;
#pragma unroll
    for (int i = 0; i < 16; ++i) { int kk = i * 4 + (tid >> 6), n = tid & 63; T[kk * 65 + n] = src(k0 + kk, n0 + n); }
    __syncthreads();
    { int n = tid >> 2, kq = (tid & 3) * 16; u32x4 o0, o1; const float* s = T + kq * 65 + n;
      o0.x = pk2bf(s[0 * 65], s[1 * 65]); o0.y = pk2bf(s[2 * 65], s[3 * 65]); o0.z = pk2bf(s[4 * 65], s[5 * 65]); o0.w = pk2bf(s[6 * 65], s[7 * 65]);
      o1.x = pk2bf(s[8 * 65], s[9 * 65]); o1.y = pk2bf(s[10 * 65], s[11 * 65]); o1.z = pk2bf(s[12 * 65], s[13 * 65]); o1.w = pk2bf(s[14 * 65], s[15 * 65]);
      bf16_t* d = dst(n0 + n) + k0 + kq; *(u32x4*)d = o0; *(u32x4*)(d + 8) = o1; }
    __syncthreads();
}
__device__ __forceinline__ void cvt_plain(char* lds, const float* W, bf16_t* Wt, int K, int N, int item) {
    int nb = N / 64, kb = item / nb, nbi = item % nb;
    cvt_tile(lds, kb * 64, nbi * 64, [&](int k, int n) { return W[(size_t)k * N + n]; }, [&](int n) { return Wt + (size_t)n * K; });
}
constexpr int CVT_IN = (D_MODEL / 64) * (EVEN_IN / 64), CVT_OUT = (D_MODEL / 64) * (D_MODEL / 64), CVT_GU1 = (D_MODEL / 64) * (D_EXPERT / 64), CVT_D1 = (D_EXPERT / 64) * (D_MODEL / 64);
constexpr int CVT_GU = DEPTH * N_EXPERTS * 2 * CVT_GU1, CVT_D = DEPTH * N_EXPERTS * CVT_D1;
constexpr int CVT_TOTAL = 2 * CVT_IN + 2 * CVT_OUT + CVT_GU + CVT_D;
__device__ __forceinline__ void cvt_item(const Params& p, char* lds, int it) {
    if (it < CVT_IN) { cvt_plain(lds, p.w_in_even, p.Wt_in_even, D_MODEL, EVEN_IN, it); return; } it -= CVT_IN;
    if (it < CVT_IN) { cvt_plain(lds, p.w_in_odd, p.Wt_in_odd, D_MODEL, ODD_IN, it); return; } it -= CVT_IN;
    if (it < CVT_OUT) { cvt_plain(lds, p.w_out_even, p.Wt_out_even, EVEN_OUT, D_MODEL, it); return; } it -= CVT_OUT;
    if (it < CVT_OUT) { cvt_plain(lds, p.w_out_odd, p.Wt_out_odd, ODD_OUT, D_MODEL, it); return; } it -= CVT_OUT;
    if (it < CVT_GU) {
        int le = it / (2 * CVT_GU1), r = it % (2 * CVT_GU1), half = r / CVT_GU1, r2 = r % CVT_GU1; int nb = D_EXPERT / 64, kb = r2 / nb, nbi = r2 % nb;
        const float* W = (half ? p.moe_wu : p.moe_wg) + (size_t)le * D_MODEL * D_EXPERT; bf16_t* Wt = p.Wt_gu + (size_t)le * 2 * D_EXPERT * D_MODEL;
        cvt_tile(lds, kb * 64, nbi * 64, [&](int k, int n) { return W[(size_t)k * D_EXPERT + n]; }, [&](int n) { return Wt + (size_t)(32 * (n >> 4) + 16 * half + (n & 15)) * D_MODEL; });
        return; } it -= CVT_GU;
    { int le = it / CVT_D1, r = it % CVT_D1; cvt_plain(lds, p.moe_wd + (size_t)le * D_EXPERT * D_MODEL, p.Wt_d + (size_t)le * D_MODEL * D_EXPERT, D_EXPERT, D_MODEL, r); }
}

struct TileGeom { int tid, lane, wid, wr, wc, l15, q, srow, schunk;
    __device__ __forceinline__ int drow(int i) const { return wid * 32 + i * 8 + (lane >> 3); }
    __device__ __forceinline__ int dchunk(int i) const { return (lane & 7) ^ (((lane >> 4) + 4 * i) & 7); } };
__device__ __forceinline__ TileGeom tile_geom() { TileGeom g; g.tid = threadIdx.x; g.lane = g.tid & 63; g.wid = __builtin_amdgcn_readfirstlane(g.tid >> 6); g.wr = g.wid >> 1; g.wc = g.wid & 1; g.l15 = g.lane & 15; g.q = g.lane >> 4; g.srow = g.tid >> 3; g.schunk = g.tid & 7; return g; }

template <class ALoad, class BLoad>
__device__ __forceinline__ void gemm_mainloop(char* lds, const TileGeom& g, int nk, const ALoad& AL, const BLoad& BL, f32x4 (&acc)[4][4]) {
#pragma unroll
    for (int i = 0; i < 4; ++i)
#pragma unroll
        for (int j = 0; j < 4; ++j) acc[i][j] = (f32x4){0.f, 0.f, 0.f, 0.f};
    const int swz = g.l15 >> 1;
    const int aofs = (g.wr * 64 + g.l15) * 128 + ((g.q ^ swz) << 4);
    const int bofs = 32768 + (g.wc * 64 + g.l15) * 128 + ((g.q ^ swz) << 4);
    LAS char* l3 = (LAS char*)lds;
    const int dbase = g.wid * 4096;
#define GEMM_STAGE(kt_, buf_) do { _Pragma("unroll") for (int i_ = 0; i_ < 4; ++i_) { \
        __builtin_amdgcn_global_load_lds((const unsigned*)AL(i_, (kt_)), (LAS unsigned*)(l3 + (buf_) + dbase + i_ * 1024), 16, 0, 0); \
        __builtin_amdgcn_global_load_lds((const unsigned*)BL(i_, (kt_)), (LAS unsigned*)(l3 + 32768 + (buf_) + dbase + i_ * 1024), 16, 0, 0); } } while (0)
    GEMM_STAGE(0, 0);
    __syncthreads();
    for (int kt = 0; kt < nk; ++kt) {
        const int cur = (kt & 1) * 16384, nxt = 16384 - cur;
        if (kt + 1 < nk) GEMM_STAGE(kt + 1, nxt);
#pragma unroll
        for (int kk = 0; kk < 2; ++kk) {
            bf16x8 af[4], bfr[4];
#pragma unroll
            for (int i = 0; i < 4; ++i) { af[i] = *(const bf16x8*)(lds + cur + ((aofs + i * 2048) ^ (kk * 64))); bfr[i] = *(const bf16x8*)(lds + cur + ((bofs + i * 2048) ^ (kk * 64))); }
#pragma unroll
            for (int mi = 0; mi < 4; ++mi)
#pragma unroll
                for (int ni = 0; ni < 4; ++ni) acc[mi][ni] = __builtin_amdgcn_mfma_f32_16x16x32_bf16(bfr[ni], af[mi], acc[mi][ni], 0, 0, 0);
        }
        __syncthreads();
    }
#undef GEMM_STAGE
}

template <class DstF>
__device__ __forceinline__ void store_transposed(char* lds, const TileGeom& g, const f32x4 (&acc)[4][4], const DstF& dst) {
    bf16_t* T = (bf16_t*)lds;
#pragma unroll
    for (int mi = 0; mi < 4; ++mi)
#pragma unroll
        for (int ni = 0; ni < 4; ++ni)
#pragma unroll
            for (int r = 0; r < 4; ++r) T[(g.wc * 64 + ni * 16 + g.q * 4 + r) * 136 + g.wr * 64 + mi * 16 + g.l15] = f2bf(acc[mi][ni][r]);
    __syncthreads();
    { int col = g.tid >> 1, half = g.tid & 1; bf16_t* d = dst(col) + half * 64; const bf16_t* s = T + col * 136 + half * 64;
#pragma unroll
      for (int j = 0; j < 8; ++j) *(u32x4*)(d + j * 8) = *(const u32x4*)(s + j * 8); }
    __syncthreads();
}
__device__ __forceinline__ void store4bf(bf16_t* d, const f32x4& v) { u32x2 w; w.x = pk2bf(v[0], v[1]); w.y = pk2bf(v[2], v[3]); *(u32x2*)d = w; }
__device__ __forceinline__ void rope_head(const Params& p, f32x4 (&a)[4], int s, int q) {
    const int pr = s / GRID_W, pc = s % GRID_W;
    const f32x4 cr = *(const f32x4*)(p.ropet + pr * 32 + q * 4), sr = *(const f32x4*)(p.ropet + pr * 32 + 16 + q * 4);
    const f32x4 cc = *(const f32x4*)(p.ropet + pc * 32 + q * 4), sc = *(const f32x4*)(p.ropet + pc * 32 + 16 + q * 4);
    f32x4 x1 = a[0], x2 = a[1]; a[0] = x1 * cr - x2 * sr; a[1] = x2 * cr + x1 * sr;
    x1 = a[2]; x2 = a[3]; a[2] = x1 * cc - x2 * sc; a[3] = x2 * cc + x1 * sc;
}

template <int LAYER>
__device__ __forceinline__ void inproj_tile(const Params& p, char* lds, int mt, int nt) {
    const TileGeom g = tile_geom();
    const bf16_t* Abase = p.hbuf + (size_t)(mt * 128) * D_MODEL;
    const bf16_t* Bbase = (LAYER == 0 ? p.Wt_in_even : p.Wt_in_odd) + (size_t)(nt * 128) * D_MODEL;
    f32x4 acc[4][4];
    gemm_mainloop(lds, g, D_MODEL / 64, [&](int i, int kt) { return Abase + (size_t)g.drow(i) * D_MODEL + kt * 64 + g.dchunk(i) * 8; }, [&](int i, int kt) { return Bbase + (size_t)g.drow(i) * D_MODEL + kt * 64 + g.dchunk(i) * 8; }, acc);
    const bool lat = mt < MT_LAT; const int row0 = mt * 128;
    const int b = lat ? row0 / SEQ : (row0 - TX) / CTX_LEN, s0 = lat ? row0 % SEQ : (row0 - TX) % CTX_LEN, pos0 = lat ? CTX_LEN + s0 : s0;
    int kind;
    bf16_t* base; int h0 = 0, qcol0 = 0, nh = 2;
    if (LAYER == 0) {
        if (nt < 4) { kind = 0; base = p.QA; qcol0 = nt * 128; }
        else if (nt == 4) { kind = 1; base = p.KA; h0 = 0; nh = 2; }
        else if (nt == 5) { kind = 2; base = p.VAt; h0 = 0; nh = 2; }
        else if (nt < 10) { kind = 0; base = p.QB; qcol0 = (nt - 6) * 128; }
        else if (nt < 14) { kind = 1; base = p.KB; h0 = (nt - 10) * 2; nh = 8; }
        else { kind = 2; base = p.VBt; h0 = (nt - 14) * 2; nh = 8; }
    } else {
        if (nt < 4) { kind = 0; base = p.QC; qcol0 = nt * 128; }
        else if (nt == 4) { kind = 1; base = p.KC; h0 = 0; nh = 2; }
        else if (nt == 5) { kind = 2; base = p.VCt; h0 = 0; nh = 2; }
        else { kind = 3; base = p.UT; }
    }
    if (kind <= 1) {
        const bool rope = lat && (LAYER == 1 || nt <= 4);
#pragma unroll
        for (int mi = 0; mi < 4; ++mi) {
            const int rowl = g.wr * 64 + mi * 16 + g.l15;
            if (LAYER == 1) {
                float ss = 0.f;
#pragma unroll
                for (int ni = 0; ni < 4; ++ni) ss += acc[mi][ni][0] * acc[mi][ni][0] + acc[mi][ni][1] * acc[mi][ni][1] + acc[mi][ni][2] * acc[mi][ni][2] + acc[mi][ni][3] * acc[mi][ni][3];
                ss += __shfl_xor(ss, 16); ss += __shfl_xor(ss, 32);
                const float rstd = 1.0f / sqrtf(ss * (1.0f / 64.0f) + EPS);
                const float* gn = kind == 0 ? p.c_qnorm : p.c_knorm;
#pragma unroll
                for (int ni = 0; ni < 4; ++ni) acc[mi][ni] = acc[mi][ni] * rstd * *(const f32x4*)(gn + ni * 16 + g.q * 4);
            }
            if (rope) rope_head(p, acc[mi], s0 + rowl, g.q);
            bf16_t* d = kind == 0 ? base + (size_t)(row0 + rowl) * 512 + qcol0 + g.wc * 64 + g.q * 4
                                  : base + ((size_t)(b * nh + h0 + g.wc) * LKV + pos0 + rowl) * 64 + g.q * 4;
#pragma unroll
            for (int ni = 0; ni < 4; ++ni) store4bf(d + ni * 16, acc[mi][ni]);
        }
    } else if (kind == 2) {
        store_transposed(lds, g, acc, [&](int col) { return base + ((size_t)(b * nh + h0 + (col >> 6)) * 64 + (col & 63)) * LKV + pos0; });
    } else {
        store_transposed(lds, g, acc, [&](int col) { return base + ((size_t)b * 3 * D_CH + (nt - 6) * 128 + col) * SEQ + s0; });
    }
}
template <int LAYER>
__device__ __forceinline__ void ph_inproj(const Params& p, char* lds, int bid, int nb) {
    constexpr int NT = 18;
    if (LAYER == 0) { for (int t = bid; t < MT_ALL * NT; t += nb) inproj_tile<0>(p, lds, t / NT, t % NT); }
    else {
        const int n_lat = MT_LAT * NT, n_all = n_lat + (MT_ALL - MT_LAT) * 2;
        for (int t = bid; t < n_all; t += nb) { if (t < n_lat) inproj_tile<1>(p, lds, t / NT, t % NT); else { int u = t - n_lat; inproj_tile<1>(p, lds, MT_LAT + u / 2, 4 + u % 2); } }
    }
}

template <int LAYER>
__device__ __forceinline__ void outproj_tile(const Params& p, char* lds, int mt, int nt) {
    const TileGeom g = tile_geom();
    const bf16_t* Abase = p.Y + (size_t)(mt * 128) * 1024;
    const bf16_t* Bbase = (LAYER == 0 ? p.Wt_out_even : p.Wt_out_odd) + (size_t)(nt * 128) * 1024;
    f32x4 acc[4][4];
    gemm_mainloop(lds, g, 16, [&](int i, int kt) { return Abase + (size_t)g.drow(i) * 1024 + kt * 64 + g.dchunk(i) * 8; }, [&](int i, int kt) { return Bbase + (size_t)g.drow(i) * 1024 + kt * 64 + g.dchunk(i) * 8; }, acc);
    const int row0 = mt * 128;
#pragma unroll
    for (int mi = 0; mi < 4; ++mi) {
        const int row = row0 + g.wr * 64 + mi * 16 + g.l15;
        const float* xin = xrow_in(p, LAYER, row); float* xo = xrow_cur(p, row); const float* gate = modp(p, LAYER, row, 2);
#pragma unroll
        for (int ni = 0; ni < 4; ++ni) { const int col = nt * 128 + g.wc * 64 + ni * 16 + g.q * 4;
            *(f32x4*)(xo + col) = *(const f32x4*)(xin + col) + *(const f32x4*)(gate + col) * acc[mi][ni]; }
    }
}

template <int LAYER>
__device__ __forceinline__ void ph_outproj(const Params& p, char* lds, int bid, int nb) {
    const int nmt = LAYER == 0 ? MT_ALL : MT_LAT;
    for (int t = bid; t < nmt * 8; t += nb) outproj_tile<LAYER>(p, lds, t / 8, t % 8);
}

template <int NTN>
__device__ __forceinline__ bool moe_tile_lookup(const int* cnt, int t, int& pr, int& mt, int& nt, int& n) {
    int acc = 0;
    for (int q = 0; q < NPAIR; ++q) { const int c = cnt[q]; const int tiles = ((c + 127) >> 7) * NTN; if (t < acc + tiles) { pr = q; const int u = t - acc; mt = u / NTN; nt = u % NTN; n = c; return true; } acc += tiles; }
    return false;
}
__device__ __forceinline__ void moe_up_tile(const Params& p, char* lds, int l, int pr, int mt, int nt, int n) {
    const TileGeom g = tile_geom();
    int e1, e2; pair_experts(pr, e1, e2); const int k = nt >> 3, e = k ? e2 : e1;
    const int* lst = p.list + (size_t)pr * TT + mt * 128;
    const int navail = n - mt * 128;
    const bf16_t* arow[4];
#pragma unroll
    for (int i = 0; i < 4; ++i) { int r = g.drow(i); if (r >= navail) r = navail - 1; arow[i] = p.hbuf + (size_t)lst[r] * D_MODEL + g.dchunk(i) * 8; }
    const bf16_t* Bbase = p.Wt_gu + ((size_t)(l * N_EXPERTS + e) * 2 * D_EXPERT + (nt & 7) * 128) * D_MODEL;
    f32x4 acc[4][4];
    gemm_mainloop(lds, g, D_MODEL / 64, [&](int i, int kt) { return arow[i] + kt * 64; }, [&](int i, int kt) { return Bbase + (size_t)g.drow(i) * D_MODEL + kt * 64 + g.dchunk(i) * 8; }, acc);
#pragma unroll
    for (int mi = 0; mi < 4; ++mi) {
        const int rl = g.wr * 64 + mi * 16 + g.l15;
        if (rl < navail) {
            const int row = lst[rl]; const float w = p.tokw[row * 2 + k];
            bf16_t* d = p.HE + (size_t)row * HE_W + k * D_EXPERT + (nt & 7) * 64 + g.wc * 32 + g.q * 4;
#pragma unroll
            for (int h2 = 0; h2 < 2; ++h2) { f32x4 gg = acc[mi][2 * h2], uu = acc[mi][2 * h2 + 1], o;
#pragma unroll
                for (int r = 0; r < 4; ++r) o[r] = w * (gg[r] / (1.0f + __expf(-gg[r]))) * uu[r];
                store4bf(d + h2 * 16, o); }
        }
    }
}
__device__ __forceinline__ void moe_down_tile(const Params& p, char* lds, int l, int pr, int mt, int nt, int n) {
    const TileGeom g = tile_geom();
    int e1, e2; pair_experts(pr, e1, e2);
    const int* lst = p.list + (size_t)pr * TT + mt * 128;
    const int navail = n - mt * 128;
    const bf16_t* arow[4];
#pragma unroll
    for (int i = 0; i < 4; ++i) { int r = g.drow(i); if (r >= navail) r = navail - 1; arow[i] = p.HE + (size_t)lst[r] * HE_W + g.dchunk(i) * 8; }
    const bf16_t* B1 = p.Wt_d + ((size_t)(l * N_EXPERTS + e1) * D_MODEL + nt * 128) * D_EXPERT;
    const bf16_t* B2 = p.Wt_d + ((size_t)(l * N_EXPERTS + e2) * D_MODEL + nt * 128) * D_EXPERT;
    constexpr int KT1 = D_EXPERT / 64;
    f32x4 acc[4][4];
    gemm_mainloop(lds, g, HE_W / 64, [&](int i, int kt) { return arow[i] + kt * 64; },
                  [&](int i, int kt) { return (kt < KT1 ? B1 + kt * 64 : B2 + (kt - KT1) * 64) + (size_t)g.drow(i) * D_EXPERT + g.dchunk(i) * 8; }, acc);
#pragma unroll
    for (int mi = 0; mi < 4; ++mi) {
        const int rl = g.wr * 64 + mi * 16 + g.l15;
        if (rl < navail) {
            const int row = lst[rl]; float* xo = xrow_cur(p, row); const float* gate = modp(p, l, row, 5);
#pragma unroll
            for (int ni = 0; ni < 4; ++ni) { const int col = nt * 128 + g.wc * 64 + ni * 16 + g.q * 4; *(f32x4*)(xo + col) = *(const f32x4*)(xo + col) + *(const f32x4*)(gate + col) * acc[mi][ni]; }
        }
    }
}
__device__ __forceinline__ void ph_moe_up(const Params& p, char* lds, int l, int bid, int nb) {
    int pr, mt, nt, n; for (int t = bid; moe_tile_lookup<16>(p.cnt + l * 32, t, pr, mt, nt, n); t += nb) moe_up_tile(p, lds, l, pr, mt, nt, n);
}
__device__ __forceinline__ void ph_moe_down(const Params& p, char* lds, int l, int bid, int nb) {
    int pr, mt, nt, n; for (int t = bid; moe_tile_lookup<8>(p.cnt + l * 32, t, pr, mt, nt, n); t += nb) moe_down_tile(p, lds, l, pr, mt, nt, n);
}
typedef float f32x2 __attribute__((ext_vector_type(2)));
typedef __bf16 bf16x2_t __attribute__((ext_vector_type(2)));
__device__ __forceinline__ unsigned cvtpk(float lo, float hi) { f32x2 v = {lo, hi}; bf16x2_t b = __builtin_convertvector(v, bf16x2_t); return __builtin_bit_cast(unsigned, b); }
__device__ __forceinline__ int crow(int r, int hi) { return (r & 3) + 8 * (r >> 2) + 4 * hi; }
constexpr float LOG2E = 1.4426950408889634f;
constexpr float QK_C = ATTN_SCALE * LOG2E;
constexpr float NEG_BIG = -1e30f;

template <int MODE>
__device__ __forceinline__ void attn_unit(char* lds, const bf16_t* Qp, const bf16_t* Kp, const bf16_t* Vt, bf16_t* Op, int s0, int nctx, int lt0, int nlat, float sink2, bool has_sink, const float* rpb_h) {
    const int tid = threadIdx.x, lane = tid & 63, wid = __builtin_amdgcn_readfirstlane(tid >> 6), l31 = lane & 31, hi = lane >> 5;
    float* bias_s = (float*)(lds + 32768);
    if (MODE == 2) { for (int i = tid; i < 15 * 31; i += NTHREADS) bias_s[i] = rpb_h[i] * LOG2E; }
    const int ntiles = nctx + nlat;
    const int srow0 = tid >> 3, schunk = tid & 7;
    const int swzw = (srow0 >> 1) & 7;
    const int wofs = srow0 * 128 + ((schunk ^ swzw) << 4);
    const bool vswap0 = (srow0 >> 4) & 1;
    const int x = (l31 >> 1) & 7;
    const int kofs = l31 * 128 + ((hi ^ x) << 4);
    const int vofs = 16384 + l31 * 128 + ((0 ^ x) << 4) + 8 * (hi ^ (l31 >> 4));
    bf16x8 qf[4];
    { const bf16_t* qr = Qp + (size_t)(wid * 32 + l31) * 512 + hi * 8;
#pragma unroll
      for (int s = 0; s < 4; ++s) qf[s] = *(const bf16x8*)(qr + s * 16); }
    auto tile_pos = [&](int j) { return j < nctx ? 64 * j : CTX_LEN + 64 * (lt0 + j - nctx); };
    u32x4 rk[2], rv[2];
    auto gload = [&](int j) { const int pos = tile_pos(j);
#pragma unroll
        for (int i = 0; i < 2; ++i) { rk[i] = *(const u32x4*)(Kp + (size_t)(pos + srow0 + 32 * i) * 64 + schunk * 8); rv[i] = *(const u32x4*)(Vt + (size_t)(srow0 + 32 * i) * LKV + pos + schunk * 8); } };
    auto lstore = [&](int buf) {
#pragma unroll
        for (int i = 0; i < 2; ++i) { *(u32x4*)(lds + buf * 8192 + wofs + i * 4096) = rk[i]; u32x4 v = rv[i]; if (vswap0) v = (u32x4){v.z, v.w, v.x, v.y}; *(u32x4*)(lds + 16384 + buf * 8192 + wofs + i * 4096) = v; } };
    f32x16 o0 = {}, o1 = {};
    float m = NEG_BIG, l = 0.f;
    const int sq = s0 + wid * 32 + l31;
    int rq = 0, cq = 0, rsq = 0, csq = 0;
    if (MODE == 2) { rq = sq / GRID_W; cq = sq % GRID_W; rsq = rq - B_WIN_H / 2; rsq = rsq < 0 ? 0 : (rsq > GRID_H - B_WIN_H ? GRID_H - B_WIN_H : rsq); csq = cq - B_WIN_W / 2; csq = csq < 0 ? 0 : (csq > GRID_W - B_WIN_W ? GRID_W - B_WIN_W : csq); }
    gload(0); lstore(0);
    __syncthreads();
    for (int j = 0; j < ntiles; ++j) {
        const int buf = j & 1; const bool more = j + 1 < ntiles;
        if (more) gload(j + 1);
        const char* Kb = lds + buf * 8192; const char* Vb = lds + buf * 8192;
        f32x16 p0 = {}, p1 = {};
#pragma unroll
        for (int s = 0; s < 4; ++s) {
            const bf16x8 k0 = *(const bf16x8*)(Kb + (kofs ^ (s << 5))); const bf16x8 k1 = *(const bf16x8*)(Kb + 4096 + (kofs ^ (s << 5)));
            p0 = __builtin_amdgcn_mfma_f32_32x32x16_bf16(k0, qf[s], p0, 0, 0, 0); p1 = __builtin_amdgcn_mfma_f32_32x32x16_bf16(k1, qf[s], p1, 0, 0, 0);
        }
        float tmax = NEG_BIG;
        if (MODE == 0 || j < nctx) {
#pragma unroll
            for (int r = 0; r < 16; ++r) { p0[r] *= QK_C; p1[r] *= QK_C; tmax = fmaxf(tmax, fmaxf(p0[r], p1[r])); }
        } else if (MODE == 1) {
            const int sk0 = 64 * (lt0 + j - nctx);
#pragma unroll
            for (int r = 0; r < 16; ++r) { const int d0 = sk0 + crow(r, hi) - sq, d1 = d0 + 32;
                p0[r] = (d0 >= -A_WINDOW && d0 <= A_WINDOW) ? p0[r] * QK_C : NEG_BIG; p1[r] = (d1 >= -A_WINDOW && d1 <= A_WINDOW) ? p1[r] * QK_C : NEG_BIG; tmax = fmaxf(tmax, fmaxf(p0[r], p1[r])); }
        } else {
            const int kr = lt0 + j - nctx; const bool rowok = kr >= rsq && kr < rsq + B_WIN_H;
            const float* brow = bias_s + (kr - rq + B_WIN_H - 1) * 31 + (B_WIN_W - 1) - cq;
#pragma unroll
            for (int r = 0; r < 16; ++r) { const int kc0 = crow(r, hi), kc1 = kc0 + 32;
                const bool ok0 = rowok && kc0 >= csq && kc0 < csq + B_WIN_W, ok1 = rowok && kc1 >= csq && kc1 < csq + B_WIN_W;
                p0[r] = ok0 ? p0[r] * QK_C + brow[kc0] : NEG_BIG; p1[r] = ok1 ? p1[r] * QK_C + brow[kc1] : NEG_BIG; tmax = fmaxf(tmax, fmaxf(p0[r], p1[r])); }
        }
        tmax = fmaxf(tmax, __shfl_xor(tmax, 32));
        const float mn = fmaxf(m, tmax), alpha = __builtin_amdgcn_exp2f(m - mn); m = mn;
        float ls = 0.f;
#pragma unroll
        for (int r = 0; r < 16; ++r) { p0[r] = __builtin_amdgcn_exp2f(p0[r] - mn); p1[r] = __builtin_amdgcn_exp2f(p1[r] - mn); ls += p0[r] + p1[r]; }
        l = l * alpha + ls;
#pragma unroll
        for (int r = 0; r < 16; ++r) { o0[r] *= alpha; o1[r] *= alpha; }
        bf16x8 pf[4];
        { u32x4 w;
          w.x = cvtpk(p0[0], p0[1]); w.y = cvtpk(p0[2], p0[3]); w.z = cvtpk(p0[4], p0[5]); w.w = cvtpk(p0[6], p0[7]); pf[0] = __builtin_bit_cast(bf16x8, w);
          w.x = cvtpk(p0[8], p0[9]); w.y = cvtpk(p0[10], p0[11]); w.z = cvtpk(p0[12], p0[13]); w.w = cvtpk(p0[14], p0[15]); pf[1] = __builtin_bit_cast(bf16x8, w);
          w.x = cvtpk(p1[0], p1[1]); w.y = cvtpk(p1[2], p1[3]); w.z = cvtpk(p1[4], p1[5]); w.w = cvtpk(p1[6], p1[7]); pf[2] = __builtin_bit_cast(bf16x8, w);
          w.x = cvtpk(p1[8], p1[9]); w.y = cvtpk(p1[10], p1[11]); w.z = cvtpk(p1[12], p1[13]); w.w = cvtpk(p1[14], p1[15]); pf[3] = __builtin_bit_cast(bf16x8, w); }
#pragma unroll
        for (int s = 0; s < 4; ++s) {
            const int a0 = vofs ^ (s << 5);
            u32x2 va = *(const u32x2*)(Vb + a0), vb = *(const u32x2*)(Vb + (a0 ^ 16));
            u32x2 vc = *(const u32x2*)(Vb + 4096 + a0), vd = *(const u32x2*)(Vb + 4096 + (a0 ^ 16));
            const bf16x8 f0 = __builtin_bit_cast(bf16x8, (u32x4){va.x, va.y, vb.x, vb.y}), f1 = __builtin_bit_cast(bf16x8, (u32x4){vc.x, vc.y, vd.x, vd.y});
            o0 = __builtin_amdgcn_mfma_f32_32x32x16_bf16(f0, pf[s], o0, 0, 0, 0); o1 = __builtin_amdgcn_mfma_f32_32x32x16_bf16(f1, pf[s], o1, 0, 0, 0);
        }
        if (more) lstore(buf ^ 1);
        __syncthreads();
    }
    l += __shfl_xor(l, 32);
    if (has_sink) l += __builtin_amdgcn_exp2f(sink2 - m);
    const float inv = 1.0f / l;
    bf16_t* orow = Op + (size_t)(wid * 32 + l31) * 1024;
#pragma unroll
    for (int g4 = 0; g4 < 4; ++g4) {
        u32x2 w; w.x = cvtpk(o0[g4 * 4 + 0] * inv, o0[g4 * 4 + 1] * inv); w.y = cvtpk(o0[g4 * 4 + 2] * inv, o0[g4 * 4 + 3] * inv); *(u32x2*)(orow + 8 * g4 + 4 * hi) = w;
        w.x = cvtpk(o1[g4 * 4 + 0] * inv, o1[g4 * 4 + 1] * inv); w.y = cvtpk(o1[g4 * 4 + 2] * inv, o1[g4 * 4 + 3] * inv); *(u32x2*)(orow + 32 + 8 * g4 + 4 * hi) = w;
    }
}

constexpr int NU_LAT = BATCH * 8 * (SEQ / 128);
constexpr int NU_CTX = BATCH * 8 * (CTX_LEN / 128);
__device__ __forceinline__ void ph_attn0(const Params& p, char* lds, int bid, int nb) {
    for (int u = bid; u < 2 * NU_LAT + 2 * NU_CTX; u += nb) {
        if (u < NU_LAT) {
            const int blk = u % (SEQ / 128), h = (u / (SEQ / 128)) % 8, b = u / (8 * (SEQ / 128)); const int s0 = blk * 128, r0 = s0 / GRID_W;
            int rs0 = r0 - 4; rs0 = rs0 < 0 ? 0 : (rs0 > GRID_H - 8 ? GRID_H - 8 : rs0); int rs1 = r0 + 1 - 4; rs1 = rs1 < 0 ? 0 : (rs1 > GRID_H - 8 ? GRID_H - 8 : rs1);
            attn_unit<2>(lds, p.QB + (size_t)(b * SEQ + s0) * 512 + h * 64, p.KB + (size_t)(b * 8 + h) * LKV * 64, p.VBt + (size_t)(b * 8 + h) * 64 * LKV,
                         p.Y + (size_t)(b * SEQ + s0) * 1024 + 512 + h * 64, s0, CTX_LEN / 64, rs0, rs1 + 8 - rs0, 0.f, false, p.b_rpb + h * 15 * 31);
        } else if (u < 2 * NU_LAT) {
            const int v = u - NU_LAT; const int blk = v % (SEQ / 128), h = (v / (SEQ / 128)) % 8, b = v / (8 * (SEQ / 128)); const int s0 = blk * 128;
            int t0 = (s0 - 128) / 64; if (t0 < 0) t0 = 0; int t1 = (s0 + 255) / 64; if (t1 > SEQ / 64 - 1) t1 = SEQ / 64 - 1;
            attn_unit<1>(lds, p.QA + (size_t)(b * SEQ + s0) * 512 + h * 64, p.KA + (size_t)(b * 2 + h / 4) * LKV * 64, p.VAt + (size_t)(b * 2 + h / 4) * 64 * LKV,
                         p.Y + (size_t)(b * SEQ + s0) * 1024 + h * 64, s0, CTX_LEN / 64, t0, t1 - t0 + 1, p.a_sink[h] * LOG2E, true, nullptr);
        } else {
            const int v = u - 2 * NU_LAT; const int ty = v / NU_CTX, w = v % NU_CTX; const int blk = w % (CTX_LEN / 128), h = (w / (CTX_LEN / 128)) % 8, b = w / (8 * (CTX_LEN / 128));
            const int row0 = TX + b * CTX_LEN + blk * 128;
            if (ty == 0) attn_unit<0>(lds, p.QA + (size_t)row0 * 512 + h * 64, p.KA + (size_t)(b * 2 + h / 4) * LKV * 64, p.VAt + (size_t)(b * 2 + h / 4) * 64 * LKV, p.Y + (size_t)row0 * 1024 + h * 64, 0, CTX_LEN / 64, 0, 0, p.a_sink[h] * LOG2E, true, nullptr);
            else attn_unit<0>(lds, p.QB + (size_t)row0 * 512 + h * 64, p.KB + (size_t)(b * 8 + h) * LKV * 64, p.VBt + (size_t)(b * 8 + h) * 64 * LKV, p.Y + (size_t)row0 * 1024 + 512 + h * 64, 0, CTX_LEN / 64, 0, 0, 0.f, false, nullptr);
        }
    }
}
__device__ __forceinline__ void ph_attnC(const Params& p, char* lds, int bid, int nb) {
    for (int u = bid; u < NU_LAT; u += nb) {
        const int blk = u % (SEQ / 128), h = (u / (SEQ / 128)) % 8, b = u / (8 * (SEQ / 128)); const int s0 = blk * 128;
        attn_unit<0>(lds, p.QC + (size_t)(b * SEQ + s0) * 512 + h * 64, p.KC + (size_t)(b * 2 + h / 4) * LKV * 64, p.VCt + (size_t)(b * 2 + h / 4) * 64 * LKV,
                     p.Y + (size_t)(b * SEQ + s0) * 1024 + h * 64, s0, CTX_LEN / 64, 0, SEQ / 64, 0.f, false, nullptr);
    }
}
#ifdef HY_TEST
#define HY_OUT(b, t, v) p.YHT[((size_t)(b) * D_CH + c) * SEQ + (t)] = f2bf(v)
#else
#define HY_OUT(b, t, v) p.Y[((size_t)(b) * SEQ + (t)) * 1024 + 512 + c] = f2bf(v)
#endif
#ifdef CPU_TEST
#define FOR_T for (int tid = 0; tid < 256; ++tid)
#define HSYNC
#define HST(t) st[t]
#define HY_DECL HySt* st = new HySt[256]
#define HY_FREE delete[] st
static inline void sincos_rev(float a, float& c, float& s) { c = cosf(6.283185307179586f * a); s = sinf(6.283185307179586f * a); }
#else
__device__ __forceinline__ int hy_launder(int v) { asm volatile("" : "+v"(v)); return v; }
#define FOR_T if (const int tid = hy_launder((int)threadIdx.x); true)
#define HSYNC __syncthreads()
#define HST(t) st
#define HY_DECL HySt st
#define HY_FREE
__device__ __forceinline__ void sincos_rev(float a, float& c, float& s) { c = __builtin_amdgcn_cosf(a); s = __builtin_amdgcn_sinf(a); }
#endif
constexpr int FN = 2 * SEQ;
constexpr int FPAD = FN + (FN >> 5);
#if !defined(SMALL_CFG)
static_assert(FN == 8192, "pass plan 8,8,8,16 is for N = 8192");
constexpr int R4 = 16;
constexpr int NS4 = 512;
#else
constexpr int R4 = 2;
constexpr int NS4 = 512;
#endif
constexpr int NB8 = FN / 8 / 256;
constexpr int NB4 = FN / R4 / 256;
constexpr int EPT = FN / 256;
struct HySt { float xr[EPT], xi[EPT], kr[EPT], ki[EPT]; };
HD int pidx(int i) { return i + (i >> 5); }

constexpr float W16C[8] = {1.0f, 0.9238795325112867f, 0.7071067811865476f, 0.3826834323650898f, 0.0f, -0.3826834323650898f, -0.7071067811865476f, -0.9238795325112867f};
constexpr float W16S[8] = {0.0f, -0.3826834323650898f, -0.7071067811865476f, -0.9238795325112867f, -1.0f, -0.9238795325112867f, -0.7071067811865476f, -0.3826834323650898f};
template <int R> HD void fft_reg(float* xr, float* xi) {
    constexpr int LG = R == 16 ? 4 : (R == 8 ? 3 : (R == 4 ? 2 : 1));
#pragma unroll
    for (int sg = 0; sg < LG; ++sg) {
        const int h = (R / 2) >> sg;
#pragma unroll
        for (int pr = 0; pr < R / 2; ++pr) {
            const int blk = (pr / h) * 2 * h, i = pr % h;
            const int a = blk + i, b = blk + i + h;
            const float ar = xr[a], ai = xi[a], br = xr[b], bi = xi[b];
            xr[a] = ar + br; xi[a] = ai + bi;
            const float tr = ar - br, ti = ai - bi;
            const int tw = i * (8 / h);
            if (tw == 0) { xr[b] = tr; xi[b] = ti; }
            else if (tw == 4) { xr[b] = ti; xi[b] = -tr; }
            else { const float c = W16C[tw & 7], s = W16S[tw & 7]; xr[b] = tr * c - ti * s; xi[b] = tr * s + ti * c; }
        }
    }
}
template <int R> HD constexpr int bitrev(int i) { int r = 0; for (int b = 1; b < R; b <<= 1) { r = (r << 1) | (i & 1); i >>= 1; } return r; }

template <int R, int NB, class In> HD void pass_load(int tid, HySt& s, const In& in) {
#pragma unroll
    for (int b = 0; b < NB; ++b)
#pragma unroll
        for (int r = 0; r < R; ++r) in(tid + 256 * b + (FN / R) * r, s.xr[b * R + r], s.xi[b * R + r]);
}
template <int R, int NB, class Out> HD void pass_compute(int tid, HySt& s, int Ns, const Out& out) {
#pragma unroll
    for (int b = 0; b < NB; ++b) {
        const int j = tid + 256 * b, k = j & (Ns - 1);
        float* xr = s.xr + b * R; float* xi = s.xi + b * R;
        if (Ns > 1) {
            float wc, ws; sincos_rev(-(float)k / (float)(Ns * R), wc, ws);
            float cr = wc, ci = ws;
#pragma unroll
            for (int r = 1; r < R; ++r) {
                const float vr = xr[r], vi = xi[r]; xr[r] = vr * cr - vi * ci; xi[r] = vr * ci + vi * cr;
                const float nr = cr * wc - ci * ws, ni = cr * ws + ci * wc; cr = nr; ci = ni;
            }
        }
        fft_reg<R>(xr, xi);
        const int j0 = (j - k) * R + k;
#pragma unroll
        for (int i = 0; i < R; ++i) out(j0 + bitrev<R>(i) * Ns, b, bitrev<R>(i), xr[i], xi[i]);
    }
}
struct LdsIn { const float* re; const float* im; HD void operator()(int idx, float& r, float& i) const { r = re[pidx(idx)]; i = im[pidx(idx)]; } };
struct LdsOut { float* re; float* im; HD void operator()(int idx, int, int, float r, float i) const { re[pidx(idx)] = r; im[pidx(idx)] = i; } };

HD float hy_sc_ut(const bf16_t* u, const float* sw3, float sb, int t) {
    float acc = sb;
    if (t > 0) acc += sw3[0] * bf2f(u[t - 1]);
    acc += sw3[1] * bf2f(u[t]);
    if (t < SEQ - 1) acc += sw3[2] * bf2f(u[t + 1]);
    return acc;
}

HD void hyena_channel(const Params& p, int c, float* lds) {
    HY_DECL;
    float* re = lds; float* im = lds + FPAD;
    const LdsIn lin{re, im}; const LdsOut lout{re, im};
    float nrm[2];
#pragma unroll
    for (int o = 0; o < 2; ++o) {
        const float* hf = p.HFT + (size_t)((0 * 2 + o) * D_CH + c) * SEQ; const float* hb = p.HFT + (size_t)((1 * 2 + o) * D_CH + c) * SEQ;
        FOR_T { float sacc = 0.f; for (int i = 0; i < SEQ / 256; ++i) sacc += fabsf(hf[tid + 256 * i]) + fabsf(hb[tid + 256 * i]); re[tid] = sacc; }
        HSYNC;
        { float tot = 0.f; for (int i = 0; i < 256; ++i) tot += re[i]; nrm[o] = tot + EPS; }
        HSYNC;
    }
    float sw[3][3], sbv[3];
#pragma unroll
    for (int q = 0; q < 3; ++q) { sbv[q] = p.hy_short_b[q * D_CH + c];
#pragma unroll
        for (int kk = 0; kk < 3; ++kk) sw[q][kk] = p.hy_short_w[kk * 3 * D_CH + q * D_CH + c]; }
#pragma unroll
    for (int o = 0; o < 2; ++o) {
        const float* hf = p.HFT + (size_t)((0 * 2 + o) * D_CH + c) * SEQ; const float* hb = p.HFT + (size_t)((1 * 2 + o) * D_CH + c) * SEQ;
        const float inv = 1.0f / nrm[o]; const float hbias = p.hy_bias[o * D_CH + c];
        FOR_T { pass_load<8, NB8>(tid, HST(tid), [&](int idx, float& r, float& i) __attribute__((always_inline)) { r = idx < SEQ ? hf[idx] * inv : (idx == SEQ ? 0.f : hb[FN - idx] * inv); i = 0.f; });
                pass_compute<8, NB8>(tid, HST(tid), 1, lout); }
        HSYNC;
        FOR_T { pass_load<8, NB8>(tid, HST(tid), lin); } HSYNC; FOR_T { pass_compute<8, NB8>(tid, HST(tid), 8, lout); } HSYNC;
        FOR_T { pass_load<8, NB8>(tid, HST(tid), lin); } HSYNC; FOR_T { pass_compute<8, NB8>(tid, HST(tid), 64, lout); } HSYNC;
        FOR_T { pass_load<R4, NB4>(tid, HST(tid), lin);
                HySt& s = HST(tid); pass_compute<R4, NB4>(tid, s, NS4, [&](int, int b, int rr, float r, float i) __attribute__((always_inline)) { s.kr[b + NB4 * rr] = r; s.ki[b + NB4 * rr] = i; }); }
        HSYNC;
        for (int bp = 0; bp < BATCH / 2; ++bp) {
            const int b0 = 2 * bp, b1 = 2 * bp + 1;
            const bf16_t* u0 = p.UT + ((size_t)b0 * 3 * D_CH + c) * SEQ; const bf16_t* u1 = p.UT + ((size_t)b1 * 3 * D_CH + c) * SEQ;
            const float* z0 = p.Z1 + ((size_t)b0 * D_CH + c) * SEQ; const float* z1 = p.Z1 + ((size_t)b1 * D_CH + c) * SEQ;
            auto zval = [&](int b, int t) __attribute__((always_inline)) { return o == 0 ? hy_sc_ut(b == b0 ? u0 : u1, sw[0], sbv[0], t) : (b == b0 ? z0 : z1)[t]; };
            FOR_T { pass_load<8, NB8>(tid, HST(tid), [&](int idx, float& r, float& i) __attribute__((always_inline)) { if (idx < SEQ) { r = zval(b0, idx); i = zval(b1, idx); } else { r = 0.f; i = 0.f; } });
                    pass_compute<8, NB8>(tid, HST(tid), 1, lout); }
            HSYNC;
            FOR_T { pass_load<8, NB8>(tid, HST(tid), lin); } HSYNC; FOR_T { pass_compute<8, NB8>(tid, HST(tid), 8, lout); } HSYNC;
            FOR_T { pass_load<8, NB8>(tid, HST(tid), lin); } HSYNC; FOR_T { pass_compute<8, NB8>(tid, HST(tid), 64, lout); } HSYNC;
            FOR_T { pass_load<R4, NB4>(tid, HST(tid), lin); } HSYNC;
            FOR_T { HySt& s = HST(tid); pass_compute<R4, NB4>(tid, s, NS4, [&](int idx, int b, int rr, float r, float i) __attribute__((always_inline)) { const float kr = s.kr[b + NB4 * rr], ki = s.ki[b + NB4 * rr];
                        re[pidx(idx)] = r * kr - i * ki; im[pidx(idx)] = -(r * ki + i * kr); }); }
            HSYNC;
            FOR_T { pass_load<8, NB8>(tid, HST(tid), lin); } HSYNC; FOR_T { pass_compute<8, NB8>(tid, HST(tid), 1, lout); } HSYNC;
            FOR_T { pass_load<8, NB8>(tid, HST(tid), lin); } HSYNC; FOR_T { pass_compute<8, NB8>(tid, HST(tid), 8, lout); } HSYNC;
            FOR_T { pass_load<8, NB8>(tid, HST(tid), lin); } HSYNC; FOR_T { pass_compute<8, NB8>(tid, HST(tid), 64, lout); } HSYNC;
            FOR_T { pass_load<R4, NB4>(tid, HST(tid), lin);
                    const bf16_t* g0 = p.UT + ((size_t)b0 * 3 * D_CH + (o + 1) * D_CH + c) * SEQ; const bf16_t* g1 = p.UT + ((size_t)b1 * 3 * D_CH + (o + 1) * D_CH + c) * SEQ;
                    pass_compute<R4, NB4>(tid, HST(tid), NS4, [&](int idx, int, int, float r, float i) __attribute__((always_inline)) {
                        if (idx < SEQ) {
                            const float y0 = r * (1.0f / FN), y1 = -i * (1.0f / FN);
                            const float zn0 = hy_sc_ut(g0, sw[o + 1], sbv[o + 1], idx) * (y0 + zval(b0, idx) * hbias);
                            const float zn1 = hy_sc_ut(g1, sw[o + 1], sbv[o + 1], idx) * (y1 + zval(b1, idx) * hbias);
                            if (o == 0) { p.Z1[((size_t)b0 * D_CH + c) * SEQ + idx] = zn0; p.Z1[((size_t)b1 * D_CH + c) * SEQ + idx] = zn1; }
                            else { HY_OUT(b0, idx, zn0); HY_OUT(b1, idx, zn1); }
                        } }); }
            HSYNC;
        }
    }
    HY_FREE;
}
constexpr int MOD_ITEMS = DEPTH * (6 * D_MODEL / 64);
__device__ __forceinline__ void mod_item(const Params& p, char* lds, int item) {
    float* sc = (float*)lds;
    float* red = sc + 5 * D_MODEL;
    const int tid = threadIdx.x, l = item / (6 * D_MODEL / 64), j0 = (item % (6 * D_MODEL / 64)) * 64;
    for (int i = tid; i < 5 * D_MODEL; i += NTHREADS) { const int r = i / D_MODEL, k = i % D_MODEL; const float v = r < BATCH ? p.c[r * D_MODEL + k] : p.c_ctx[k]; sc[i] = silu_f(v); }
    __syncthreads();
    const int col = tid & 63, kp = tid >> 6;
    const float* w = p.w_ada + ((size_t)l * D_MODEL + kp * 256) * 6 * D_MODEL + j0 + col;
    float a0 = 0.f, a1 = 0.f, a2 = 0.f, a3 = 0.f, a4 = 0.f;
#pragma unroll 8
    for (int k = 0; k < 256; ++k) { const float wv = w[(size_t)k * 6 * D_MODEL]; const int kk = kp * 256 + k;
        a0 += sc[kk] * wv; a1 += sc[D_MODEL + kk] * wv; a2 += sc[2 * D_MODEL + kk] * wv; a3 += sc[3 * D_MODEL + kk] * wv; a4 += sc[4 * D_MODEL + kk] * wv; }
    red[(kp * 5 + 0) * 64 + col] = a0; red[(kp * 5 + 1) * 64 + col] = a1; red[(kp * 5 + 2) * 64 + col] = a2; red[(kp * 5 + 3) * 64 + col] = a3; red[(kp * 5 + 4) * 64 + col] = a4;
    __syncthreads();
    for (int i = tid; i < 5 * 64; i += NTHREADS) { const int r = i / 64, cc = i % 64;
        const float v = red[(0 * 5 + r) * 64 + cc] + red[(1 * 5 + r) * 64 + cc] + red[(2 * 5 + r) * 64 + cc] + red[(3 * 5 + r) * 64 + cc];
        p.mod[((size_t)(l * (BATCH + 1) + r)) * 6 * D_MODEL + j0 + cc] = v + p.b_ada[l * 6 * D_MODEL + j0 + cc]; }
    __syncthreads();
}
__device__ __forceinline__ void d_hy_filt(const Params& p) {
    GS_LOOP(i, (long)D_CH * SEQ) {
        const int t = i % SEQ, cg = i / SEQ, col = cg * 4;
        f32x4 acc = *(const f32x4*)(p.hy_b3 + col);
        const f32x4* hrow = (const f32x4*)(p.h2 + (size_t)t * HY_FFN);
#pragma unroll 4
        for (int k4 = 0; k4 < HY_FFN / 4; ++k4) { const f32x4 hv = hrow[k4];
#pragma unroll
            for (int kk = 0; kk < 4; ++kk) acc += *(const f32x4*)(p.hy_w3 + (size_t)(k4 * 4 + kk) * 4 * D_CH + col) * hv[kk]; }
#pragma unroll
        for (int q = 0; q < 4; ++q) p.HFT[(size_t)(col + q) * SEQ + t] = acc[q] * hy_decay(t, (col + q) % D_CH);
    }
}
__device__ __forceinline__ void ph_norm(const Params& p, int l, int which, int nrows, int bid, int nb) {
    const int lane = threadIdx.x & 63, wid = threadIdx.x >> 6;
    for (int row = bid * 4 + wid; row < nrows; row += nb * 4) {
        const float* xr = which == 0 ? xrow_in(p, l, row) : xrow_cur(p, row);
        const float* g = p.norm_g + (l * 2 + which) * D_MODEL; const float* sh = modp(p, l, row, which * 3 + 0); const float* sc = modp(p, l, row, which * 3 + 1);
        f32x4 v[4]; float ss = 0.f;
#pragma unroll
        for (int j = 0; j < 4; ++j) { v[j] = *(const f32x4*)(xr + j * 256 + lane * 4); ss += v[j][0] * v[j][0] + v[j][1] * v[j][1] + v[j][2] * v[j][2] + v[j][3] * v[j][3]; }
        const float rstd = 1.0f / sqrtf(wave_sum(ss) * (1.0f / D_MODEL) + EPS);
#pragma unroll
        for (int j = 0; j < 4; ++j) { const int c = j * 256 + lane * 4; const f32x4 o = v[j] * rstd * *(const f32x4*)(g + c) * (*(const f32x4*)(sc + c) + 1.0f) + *(const f32x4*)(sh + c);
            store4bf(p.hbuf + (size_t)row * D_MODEL + c, o); }
    }
}
__device__ __forceinline__ void ph_router(const Params& p, char* lds, int l, int nrows, int bid, int nb) {
    const int lane = threadIdx.x & 63, wid = threadIdx.x >> 6;
    float* wr_s = (float*)lds;
    for (int i = threadIdx.x; i < D_MODEL * 16 / 4; i += NTHREADS) ((f32x4*)wr_s)[i] = ((const f32x4*)p.w_router)[i];
    __syncthreads();
    for (int row = bid * 4 + wid; row < nrows; row += nb * 4) {
        const float* xr = xrow_cur(p, row);
        const float* g = p.norm_g + (l * 2 + 1) * D_MODEL; const float* sh = modp(p, l, row, 3); const float* sc = modp(p, l, row, 4);
        f32x4 v[4]; float ss = 0.f;
#pragma unroll
        for (int j = 0; j < 4; ++j) { v[j] = *(const f32x4*)(xr + j * 256 + lane * 4); ss += v[j][0] * v[j][0] + v[j][1] * v[j][1] + v[j][2] * v[j][2] + v[j][3] * v[j][3]; }
        const float rstd = 1.0f / sqrtf(wave_sum(ss) * (1.0f / D_MODEL) + EPS);
        float lg[16];
#pragma unroll
        for (int e = 0; e < 16; ++e) lg[e] = 0.f;
#pragma unroll
        for (int j = 0; j < 4; ++j) { const int c = j * 256 + lane * 4; const f32x4 o = v[j] * rstd * *(const f32x4*)(g + c) * (*(const f32x4*)(sc + c) + 1.0f) + *(const f32x4*)(sh + c);
            store4bf(p.hbuf + (size_t)row * D_MODEL + c, o);
#pragma unroll
            for (int r = 0; r < 4; ++r) { const float* w = wr_s + (c + r) * 16;
#pragma unroll
                for (int e4 = 0; e4 < 4; ++e4) { const f32x4 wv = *(const f32x4*)(w + e4 * 4); lg[e4 * 4 + 0] += o[r] * wv[0]; lg[e4 * 4 + 1] += o[r] * wv[1]; lg[e4 * 4 + 2] += o[r] * wv[2]; lg[e4 * 4 + 3] += o[r] * wv[3]; } }
            asm volatile("" ::: "memory"); }
#pragma unroll
        for (int e = 0; e < 16; ++e) lg[e] = wave_sum(lg[e]);
        if (lane == 0) {
            int gbest = 0, a = 0, bb = 1; float gbs = -1e30f, wa = 0.f, wb = 0.f;
#pragma unroll
            for (int gI = 0; gI < 4; ++gI) {
                float m1 = -1e30f, m2 = -1e30f, s1 = 0.f, s2 = 0.f; int i1 = 0, i2 = 0;
#pragma unroll
                for (int j = 0; j < 4; ++j) { float sgv = sigmoid_f(lg[gI * 4 + j]); float vv = sgv + p.b_router[gI * 4 + j];
                    if (vv > m1) { m2 = m1; i2 = i1; s2 = s1; m1 = vv; i1 = j; s1 = sgv; } else if (vv > m2) { m2 = vv; i2 = j; s2 = sgv; } }
                float gs = m1 + m2;
                if (gs > gbs) { gbs = gs; gbest = gI; if (i1 < i2) { a = i1; bb = i2; wa = s1; wb = s2; } else { a = i2; bb = i1; wa = s2; wb = s1; } }
            }
            const float inv = 1.0f / (wa + wb);
            const int pidx = a == 0 ? bb - 1 : (a == 1 ? bb + 1 : 5);
            const int pr = gbest * 6 + pidx;
            const int pos = atomicAdd(p.cnt + l * 32 + pr, 1);
            p.list[(size_t)pr * TT + pos] = row;
            p.tokw[row * 2 + 0] = wa * inv; p.tokw[row * 2 + 1] = wb * inv;
        }
    }
    __syncthreads();
}
__device__ __forceinline__ void ph_final(const Params& p, int bid, int nb) {
    const int lane = threadIdx.x & 63, wid = threadIdx.x >> 6;
    for (int row = bid * 4 + wid; row < TX; row += nb * 4) {
        float* xr = p.out + (size_t)row * D_MODEL;
        f32x4 v[4]; float ss = 0.f;
#pragma unroll
        for (int j = 0; j < 4; ++j) { v[j] = *(const f32x4*)(xr + j * 256 + lane * 4); ss += v[j][0] * v[j][0] + v[j][1] * v[j][1] + v[j][2] * v[j][2] + v[j][3] * v[j][3]; }
        const float rstd = 1.0f / sqrtf(wave_sum(ss) * (1.0f / D_MODEL) + EPS);
#pragma unroll
        for (int j = 0; j < 4; ++j) { const int c = j * 256 + lane * 4; *(f32x4*)(xr + c) = v[j] * rstd * *(const f32x4*)(p.final_g + c); }
    }
}

#define XB_TMO      128
#define XB_XCNT(j)  (256  + 64 * (j))
#define XB_XSUB(j)  (1280 + 64 * (j))
#define XB_XGEN(j)  (2304 + 64 * (j))
#define XB_TOP      3328
#define XB_TOPGEN   3392
#define XCD_BAR_WORDS 3456
#define XB_SPIN_CAP (1u << 20)
__device__ __forceinline__ unsigned xb_ld(unsigned* p)              { return __hip_atomic_load(p, __ATOMIC_RELAXED, __HIP_MEMORY_SCOPE_AGENT); }
__device__ __forceinline__ unsigned xb_add(unsigned* p, unsigned v) { return __hip_atomic_fetch_add(p, v, __ATOMIC_RELAXED, __HIP_MEMORY_SCOPE_AGENT); }
__device__ __forceinline__ unsigned xb_xcc_id() { return (unsigned)__builtin_amdgcn_s_getreg((3 << 11) | 20) & 0xFu; }
#define XB_SPIN(cond, bar) do { unsigned _sp = 0; while (cond) { __builtin_amdgcn_s_sleep(1); \
    if ((++_sp & 255u) == 0u) { if (xb_ld(&(bar)[XB_TMO])) break; if (_sp > XB_SPIN_CAP) { atomicAdd(&(bar)[XB_TMO], 1u); break; } } } } while (0)
struct XcdBarrier { unsigned* bar; unsigned x; volatile LAS unsigned* st; };
__device__ __forceinline__ XcdBarrier xcd_barrier_post(unsigned* bar, volatile LAS unsigned* st) {
    XcdBarrier b; b.bar = bar; b.x = xb_xcc_id(); b.st = st;
    if (threadIdx.x == 0) (void)xb_add(&bar[XB_XCNT(b.x)], 1u);
    return b;
}
__device__ __forceinline__ void xcd_barrier_complete(unsigned* bar, unsigned x, unsigned& nloc, unsigned& nx) {
    const unsigned G = gridDim.x * gridDim.y * gridDim.z;
    unsigned sum, cnt, mine, sp = 0u;
    for (;;) {
        sum = 0u; cnt = 0u; mine = 0u;
#pragma unroll
        for (unsigned j = 0; j < 16; ++j) { const unsigned c = xb_ld(&bar[XB_XCNT(j)]); sum += c; cnt += (c > 0u) ? 1u : 0u; mine = (j == x) ? c : mine; }
        if (sum == G) break;
        __builtin_amdgcn_s_sleep(1);
        if ((++sp & 255u) == 0u) { if (xb_ld(&bar[XB_TMO])) break; if (sp > XB_SPIN_CAP) { atomicAdd(&bar[XB_TMO], 1u); break; } }
    }
    nloc = mine > 0u ? mine : 1u; nx = cnt > 0u ? cnt : 1u;
}
__device__ __forceinline__ void xcd_barrier(const XcdBarrier& b) {
    asm volatile("s_waitcnt vmcnt(0)" ::: "memory");
    __syncthreads();
    if (threadIdx.x == 0) {
        unsigned* bar = b.bar;
        __builtin_amdgcn_s_waitcnt(0);
        unsigned nloc = b.st[0], nx = b.st[1];
        if (nloc == 0u) { xcd_barrier_complete(bar, b.x, nloc, nx); b.st[0] = nloc; b.st[1] = nx; }
        const unsigned old = xb_add(&bar[XB_XSUB(b.x)], 1u);
        const unsigned gen = old / nloc;
        if (old + 1u == (gen + 1u) * nloc) {
            __builtin_amdgcn_fence(__ATOMIC_RELEASE, "agent");
            asm volatile("s_waitcnt vmcnt(0)" ::: "memory");
            const unsigned og = xb_add(&bar[XB_TOP], 1u);
            const unsigned tg = og / nx;
            if (og + 1u == (tg + 1u) * nx) xb_add(&bar[XB_TOPGEN], 1u);
            else XB_SPIN(xb_ld(&bar[XB_TOPGEN]) == tg, bar);
            __builtin_amdgcn_fence(__ATOMIC_ACQUIRE, "agent");
            xb_add(&bar[XB_XGEN(b.x)], 1u);
            asm volatile("s_waitcnt vmcnt(0)" ::: "memory");
        } else {
            XB_SPIN(xb_ld(&bar[XB_XGEN(b.x)]) == gen, bar);
            __builtin_amdgcn_fence(__ATOMIC_ACQUIRE, "agent");
            asm volatile("s_waitcnt vmcnt(0)" ::: "memory");
        }
    }
    __syncthreads();
}

__device__ __forceinline__ void ph_mix1(const Params& p, char* lds, int bid, int nb) {
    for (int u = bid; u < NU_LAT + D_CH; u += nb) {
        if (u < NU_LAT) { const int blk = u % (SEQ / 128), h = (u / (SEQ / 128)) % 8, b = u / (8 * (SEQ / 128)); const int s0 = blk * 128;
            attn_unit<0>(lds, p.QC + (size_t)(b * SEQ + s0) * 512 + h * 64, p.KC + (size_t)(b * 2 + h / 4) * LKV * 64, p.VCt + (size_t)(b * 2 + h / 4) * 64 * LKV,
                         p.Y + (size_t)(b * SEQ + s0) * 1024 + h * 64, s0, CTX_LEN / 64, 0, SEQ / 64, 0.f, false, nullptr); }
        else hyena_channel(p, u - NU_LAT, (float*)lds);
    }
}
enum { PH_PREP = 0, PH_NORM0, PH_INPROJ0, PH_ATTN0, PH_OUT0, PH_ROUTE0, PH_UP0, PH_DOWN0, PH_NORM1, PH_INPROJ1, PH_MIX1, PH_OUT1, PH_ROUTE1, PH_UP1, PH_DOWN1, PH_FINAL, PH_COUNT };
__global__ void __launch_bounds__(NTHREADS, 2) mega(Params p, int lo, int hi) {
    extern __shared__ __attribute__((aligned(16))) char lds[];
    const int bid = blockIdx.x, nb = gridDim.x;
    volatile LAS unsigned* st = (volatile LAS unsigned*)(lds + LDS_BYTES - 16);
    if (threadIdx.x < 4) st[threadIdx.x] = 0u;
    __syncthreads();
    XcdBarrier bar; bar.bar = p.bar; bar.x = 0; bar.st = st;
    if (hi - lo > 1) bar = xcd_barrier_post(p.bar, st);
#define PHASE(PH, body) if (lo <= (PH) && (PH) < hi) { body; if ((PH) + 1 < hi) xcd_barrier(bar); }
    PHASE(PH_PREP, { for (int it = bid; it < MOD_ITEMS + CVT_TOTAL; it += nb) { if (it < MOD_ITEMS) mod_item(p, lds, it); else cvt_item(p, lds, it - MOD_ITEMS); } d_rope(p); d_hy_h1(p); })
    PHASE(PH_NORM0, { ph_norm(p, 0, 0, TT, bid, nb); d_hy_h2(p); })
    PHASE(PH_INPROJ0, { ph_inproj<0>(p, lds, bid, nb); d_hy_filt(p); })
    PHASE(PH_ATTN0, ph_attn0(p, lds, bid, nb))
    PHASE(PH_OUT0, ph_outproj<0>(p, lds, bid, nb))
    PHASE(PH_ROUTE0, ph_router(p, lds, 0, TT, bid, nb))
    PHASE(PH_UP0, ph_moe_up(p, lds, 0, bid, nb))
    PHASE(PH_DOWN0, ph_moe_down(p, lds, 0, bid, nb))
    PHASE(PH_NORM1, ph_norm(p, 1, 0, TT, bid, nb))
    PHASE(PH_INPROJ1, ph_inproj<1>(p, lds, bid, nb))
    PHASE(PH_MIX1, ph_mix1(p, lds, bid, nb))
    PHASE(PH_OUT1, ph_outproj<1>(p, lds, bid, nb))
    PHASE(PH_ROUTE1, ph_router(p, lds, 1, TX, bid, nb))
    PHASE(PH_UP1, ph_moe_up(p, lds, 1, bid, nb))
    PHASE(PH_DOWN1, ph_moe_down(p, lds, 1, bid, nb))
    PHASE(PH_FINAL, ph_final(p, bid, nb))
}
extern "C" void kernel_launch(void* const* d_in, const int* in_sizes, int n_in, void* d_out, int out_size, void* d_ws, size_t ws_size, hipStream_t stream) {
    static int grid = 0;
    if (grid == 0) {
        int dev = 0, cus = 0;
        if (hipGetDevice(&dev) != hipSuccess || hipDeviceGetAttribute(&cus, hipDeviceAttributeMultiprocessorCount, dev) != hipSuccess) { fprintf(stderr, "kernel_launch: device query failed\n"); grid = -1; return; }
        if (hipFuncSetAttribute((const void*)mega, hipFuncAttributeMaxDynamicSharedMemorySize, LDS_BYTES) != hipSuccess) { fprintf(stderr, "kernel_launch: hipFuncSetAttribute failed\n"); grid = -1; return; }
        grid = 2 * cus;
    }
    if (grid < 0) return;
    Params p{};
    size_t need = setup_ws(p, (char*)d_ws);
    if (n_in != 32 || need > ws_size || out_size != TX * D_MODEL) { fprintf(stderr, "kernel_launch: bad config n_in %d ws %zu need %zu out %d\n", n_in, ws_size, need, out_size); return; }
    fill_inputs(p, d_in, d_out);
    hipMemsetAsync(p.bar, 0, 64 * 1024 + 256, stream);
#ifdef PER_PHASE
    for (int ph = 0; ph < PH_COUNT; ++ph) mega<<<dim3(grid), dim3(NTHREADS), LDS_BYTES, stream>>>(p, ph, ph + 1);
#else
    mega<<<dim3(grid), dim3(NTHREADS), LDS_BYTES, stream>>>(p, 0, PH_COUNT);
#endif
}
```

```cpp
#include <hip/hip_runtime.h>
#include <cstdio>
#include <math.h>
#include <stdint.h>
#include <string.h>

#ifdef CPU_TEST
#define HD
#define GLOBAL
struct U3 { unsigned x, y, z; };
static thread_local U3 threadIdx, blockIdx, blockDim, gridDim;
static inline int atomicAdd(int* p, int v) { return __sync_fetch_and_add(p, v); }
#else
#define HD __device__ __forceinline__
#define GLOBAL __global__ __launch_bounds__(256)
#endif

#if defined(HY_TEST)
constexpr int D_MODEL = 64, BATCH = 2, SEQ = 4096, GRID_W = 64, CTX_LEN = 64, D_CH = 4, D_EXPERT = 64;
#elif defined(SMALL_CFG)
constexpr int D_MODEL = 128, BATCH = 2, SEQ = 512, GRID_W = 32, CTX_LEN = 64, D_CH = 32, D_EXPERT = 64;
#else
constexpr int D_MODEL = 1024, BATCH = 4, SEQ = 4096, GRID_W = 64, CTX_LEN = 256, D_CH = 512, D_EXPERT = 512;
#endif
constexpr int DEPTH = 2, HEAD_DIM = 64;
constexpr int GRID_H = SEQ / GRID_W;
constexpr int A_WINDOW = 128;
constexpr int B_WIN_H = 8, B_WIN_W = 16;
constexpr int HY_BANDS = 16, HY_EMB = 33, HY_FFN = 64;
constexpr int EVEN_IN = 2304, EVEN_OUT = 1024;
constexpr int ODD_IN = 768 + 3 * D_CH, ODD_OUT = 512 + D_CH;
constexpr int N_EXPERTS = 16;
constexpr int TX = BATCH * SEQ, TC = BATCH * CTX_LEN, TT = TX + TC;
constexpr int LKV = CTX_LEN + SEQ;
constexpr int NPAIR = 24;
constexpr int HE_W = 2 * D_EXPERT;
constexpr float EPS = 1e-6f;
constexpr float ATTN_SCALE = 0.125f;

typedef unsigned short bf16_t;
HD bf16_t f2bf(float f) { unsigned u; __builtin_memcpy(&u, &f, 4); u = (u + 0x7fffu + ((u >> 16) & 1u)) >> 16; return (bf16_t)u; }
HD float bf2f(bf16_t h) { unsigned u = ((unsigned)h) << 16; float f; __builtin_memcpy(&f, &u, 4); return f; }
HD float silu_f(float x) { return x / (1.0f + expf(-x)); }
HD float sigmoid_f(float x) { return 1.0f / (1.0f + expf(-x)); }

struct Params {
    const float *x, *c, *ctx, *c_ctx, *w_ada, *b_ada, *norm_g, *final_g, *w_in_even, *w_out_even, *a_sink, *b_rpb;
    const float *w_in_odd, *w_out_odd, *c_qnorm, *c_knorm, *hy_short_w, *hy_short_b, *hy_w1, *hy_b1, *hy_f1, *hy_w2;
    const float *hy_b2, *hy_f2, *hy_w3, *hy_b3, *hy_bias, *w_router, *b_router, *moe_wg, *moe_wu, *moe_wd;
    float* out;
    float* XC;
    float* mod;
    float* ropet;
    float* h1;
    float* h2;
    float* HFT;
    float* hnorm;
    bf16_t* hbuf;
    bf16_t *QA, *KA, *VAt, *QB, *KB, *VBt;
    bf16_t *QC, *KC, *VCt, *UT;
    bf16_t* Y;
    bf16_t* YHT;
    float* Z1;
    bf16_t* HE;
    int* cnt;
    int* list;
    float* tokw;
    bf16_t *Wt_in_even, *Wt_out_even, *Wt_in_odd, *Wt_out_odd, *Wt_gu, *Wt_d;
    unsigned* bar;
    int* rpair;
    int* bh;
};

#define GS_LOOP(i, n) for (long i = (long)blockIdx.x * blockDim.x + threadIdx.x; i < (long)(n); i += (long)gridDim.x * blockDim.x)

HD const float* xrow_in(const Params& p, int l, int row) {
    if (l == 0) return row < TX ? p.x + (size_t)row * D_MODEL : p.ctx + (size_t)(row - TX) * D_MODEL;
    return row < TX ? p.out + (size_t)row * D_MODEL : p.XC + (size_t)(row - TX) * D_MODEL;
}
HD float* xrow_cur(const Params& p, int row) { return row < TX ? p.out + (size_t)row * D_MODEL : p.XC + (size_t)(row - TX) * D_MODEL; }
HD int row_mod(int row) { return row < TX ? row / SEQ : BATCH; }
HD const float* modp(const Params& p, int l, int row, int which) { return p.mod + ((size_t)(l * (BATCH + 1) + row_mod(row)) * 6 + which) * D_MODEL; }

GLOBAL void nk_mod(Params p) {
    GS_LOOP(i, DEPTH * (BATCH + 1) * 6 * D_MODEL) {
        int j = i % (6 * D_MODEL); int r = (i / (6 * D_MODEL)) % (BATCH + 1); int l = i / (6 * D_MODEL * (BATCH + 1));
        const float* cv = r < BATCH ? p.c + r * D_MODEL : p.c_ctx;
        const float* w = p.w_ada + (size_t)l * D_MODEL * 6 * D_MODEL;
        float acc = 0.f;
        for (int k = 0; k < D_MODEL; ++k) acc += silu_f(cv[k]) * w[(size_t)k * 6 * D_MODEL + j];
        p.mod[i] = acc + p.b_ada[l * 6 * D_MODEL + j];
    }
}
HD void d_rope(const Params& p) {
    GS_LOOP(i, 64 * 16) {
        int pos = i / 16, k = i % 16;
        float inv = powf(10000.0f, -(float)(2 * k) / 32.0f);
        float a = (float)pos * inv;
        p.ropet[pos * 32 + k] = cosf(a); p.ropet[pos * 32 + 16 + k] = sinf(a);
    }
}
HD void d_hy_h1(const Params& p) {
    GS_LOOP(i, SEQ * HY_FFN) {
        int t = i / HY_FFN, k = i % HY_FFN;
        float tn = (float)t / (float)(SEQ - 1);
        float acc = tn * p.hy_w1[0 * HY_FFN + k];
        for (int b = 0; b < HY_BANDS; ++b) {
            float band = 1e-4f + (float)b * ((float)(HY_BANDS - 1) - 1e-4f) / (float)(HY_BANDS - 1);
            float ang = 2.0f * 3.14159265358979323846f * (float)t * band / (float)SEQ;
            acc += cosf(ang) * p.hy_w1[(1 + b) * HY_FFN + k] + sinf(ang) * p.hy_w1[(1 + HY_BANDS + b) * HY_FFN + k];
        }
        p.h1[i] = sinf(p.hy_f1[k] * (acc + p.hy_b1[k]));
    }
}
HD void d_hy_h2(const Params& p) {
    GS_LOOP(i, SEQ * HY_FFN) {
        int t = i / HY_FFN, j = i % HY_FFN;
        float acc = 0.f;
        for (int k = 0; k < HY_FFN; ++k) acc += p.h1[t * HY_FFN + k] * p.hy_w2[k * HY_FFN + j];
        p.h2[i] = sinf(p.hy_f2[j] * (acc + p.hy_b2[j]));
    }
}
HD float hy_decay(int t, int c) {
    const float mind = logf(1e-2f) / 1.5f, maxd = logf(1e-2f) / 0.3f;
    float delta = fabsf(mind + (float)c * (maxd - mind) / (float)(D_CH - 1));
    float tn = (float)t / (float)(SEQ - 1);
    return expf(-tn * delta);
}
GLOBAL void nk_hy_filt(Params p) {
    GS_LOOP(i, 4 * D_CH * SEQ) {
        int t = i % SEQ, col = i / SEQ, c = col % D_CH;
        float acc = p.hy_b3[col];
        for (int k = 0; k < HY_FFN; ++k) acc += p.h2[t * HY_FFN + k] * p.hy_w3[k * 4 * D_CH + col];
        p.HFT[i] = acc * hy_decay(t, c);
    }
}
GLOBAL void nk_hy_norm(Params p) {
    GS_LOOP(i, 2 * D_CH) {
        int o = i / D_CH, c = i % D_CH;
        float s = 0.f;
        for (int dir = 0; dir < 2; ++dir) { const float* h = p.HFT + (size_t)((dir * 2 + o) * D_CH + c) * SEQ; for (int t = 0; t < SEQ; ++t) s += fabsf(h[t]); }
        p.hnorm[i] = s + EPS;
    }
}
GLOBAL void nk_zero_cnt(Params p) { GS_LOOP(i, 64) p.cnt[i] = 0; }

GLOBAL void nk_norm(Params p, int l, int which, int nrows) {
    GS_LOOP(row, nrows) {
        const float* xr = which == 0 ? xrow_in(p, l, (int)row) : xrow_cur(p, (int)row);
        float ss = 0.f;
        for (int k = 0; k < D_MODEL; ++k) ss += xr[k] * xr[k];
        float rstd = 1.0f / sqrtf(ss / D_MODEL + EPS);
        const float* g = p.norm_g + (l * 2 + which) * D_MODEL;
        const float* sh = modp(p, l, (int)row, which * 3 + 0); const float* sc = modp(p, l, (int)row, which * 3 + 1);
        for (int k = 0; k < D_MODEL; ++k) p.hbuf[row * D_MODEL + k] = f2bf(xr[k] * rstd * g[k] * (1.0f + sc[k]) + sh[k]);
    }
}

HD float dot_row(const bf16_t* a, const float* W, int ldw, int col, int K) {
    float acc = 0.f;
    for (int k = 0; k < K; ++k) acc += bf2f(a[k]) * W[(size_t)k * ldw + col];
    return acc;
}
HD float rope_apply(const Params& p, float v, float partner, int d, int s) {
    int half = d >> 5, dd = d & 31, k = dd & 15;
    int pos = half == 0 ? s / GRID_W : s % GRID_W;
    float c = p.ropet[pos * 32 + k], sn = p.ropet[pos * 32 + 16 + k];
    return dd < 16 ? v * c - partner * sn : v * c + partner * sn;
}

GLOBAL void nk_inproj_even(Params p) {
    GS_LOOP(i, (long)TT * EVEN_IN) {
        int row = i / EVEN_IN, col = i % EVEN_IN;
        const bf16_t* a = p.hbuf + (size_t)row * D_MODEL;
        float v = dot_row(a, p.w_in_even, EVEN_IN, col, D_MODEL);
        bool lat = row < TX; int b = lat ? row / SEQ : (row - TX) / CTX_LEN; int s = lat ? row % SEQ : (row - TX) % CTX_LEN;
        int pos = lat ? CTX_LEN + s : s;
        if (col < 640) {
            int d = col & 63;
            if (lat) { int pc = (d & 31) < 16 ? col + 16 : col - 16; float pv = dot_row(a, p.w_in_even, EVEN_IN, pc, D_MODEL); v = rope_apply(p, v, pv, d, s); }
            if (col < 512) p.QA[(size_t)row * 512 + col] = f2bf(v);
            else { int h = (col - 512) >> 6; p.KA[((size_t)(b * 2 + h) * LKV + pos) * 64 + d] = f2bf(v); }
        } else if (col < 768) { int h = (col - 640) >> 6, d = col & 63; p.VAt[((size_t)(b * 2 + h) * 64 + d) * LKV + pos] = f2bf(v); }
        else if (col < 1280) p.QB[(size_t)row * 512 + (col - 768)] = f2bf(v);
        else if (col < 1792) { int h = (col - 1280) >> 6, d = col & 63; p.KB[((size_t)(b * 8 + h) * LKV + pos) * 64 + d] = f2bf(v); }
        else { int h = (col - 1792) >> 6, d = col & 63; p.VBt[((size_t)(b * 8 + h) * 64 + d) * LKV + pos] = f2bf(v); }
    }
}

struct OSM { float m, l; };
#define ATT_BEGIN() float q[64], acc[64]; for (int d = 0; d < 64; ++d) { q[d] = bf2f(qp[d]) * ATTN_SCALE; acc[d] = 0.f; } float m_ = -1e30f, l_ = 0.f;
#define ATT_KEY(Kp, Vt, key, bias) do { const bf16_t* kk_ = (Kp) + (size_t)(key) * 64; float s_ = (bias); for (int d = 0; d < 64; ++d) s_ += q[d] * bf2f(kk_[d]); \
    float mn_ = fmaxf(m_, s_); float f_ = expf(m_ - mn_), pe_ = expf(s_ - mn_); l_ = l_ * f_ + pe_; \
    for (int d = 0; d < 64; ++d) acc[d] = acc[d] * f_ + pe_ * bf2f((Vt)[(size_t)d * LKV + (key)]); m_ = mn_; } while (0)
#define ATT_SINK(sv) do { float s_ = (sv); float mn_ = fmaxf(m_, s_); float f_ = expf(m_ - mn_); l_ = l_ * f_ + expf(s_ - mn_); for (int d = 0; d < 64; ++d) acc[d] *= f_; m_ = mn_; } while (0)

GLOBAL void nk_attnA(Params p) {
    GS_LOOP(i, (long)TX * 8) {
        int h = i % 8, row = i / 8, b = row / SEQ, s = row % SEQ, kvh = h / 4;
        const bf16_t* qp = p.QA + (size_t)row * 512 + h * 64;
        const bf16_t* Kp = p.KA + (size_t)(b * 2 + kvh) * LKV * 64; const bf16_t* Vt = p.VAt + (size_t)(b * 2 + kvh) * 64 * LKV;
        ATT_BEGIN();
        for (int j = 0; j < CTX_LEN; ++j) ATT_KEY(Kp, Vt, j, 0.f);
        int lo = s - A_WINDOW < 0 ? 0 : s - A_WINDOW, hi = s + A_WINDOW > SEQ - 1 ? SEQ - 1 : s + A_WINDOW;
        for (int j = lo; j <= hi; ++j) ATT_KEY(Kp, Vt, CTX_LEN + j, 0.f);
        ATT_SINK(p.a_sink[h]);
        for (int d = 0; d < 64; ++d) p.Y[(size_t)row * 1024 + h * 64 + d] = f2bf(acc[d] / l_);
    }
}
GLOBAL void nk_attnB(Params p) {
    GS_LOOP(i, (long)TX * 8) {
        int h = i % 8, row = i / 8, b = row / SEQ, s = row % SEQ, r = s / GRID_W, cq = s % GRID_W;
        const bf16_t* qp = p.QB + (size_t)row * 512 + h * 64;
        const bf16_t* Kp = p.KB + (size_t)(b * 8 + h) * LKV * 64; const bf16_t* Vt = p.VBt + (size_t)(b * 8 + h) * 64 * LKV;
        ATT_BEGIN();
        for (int j = 0; j < CTX_LEN; ++j) ATT_KEY(Kp, Vt, j, 0.f);
        int kh = B_WIN_H < GRID_H ? B_WIN_H : GRID_H;
        int rs = r - kh / 2; if (rs < 0) rs = 0; if (rs > GRID_H - kh) rs = GRID_H - kh;
        int cs = cq - B_WIN_W / 2; if (cs < 0) cs = 0; if (cs > GRID_W - B_WIN_W) cs = GRID_W - B_WIN_W;
        for (int kr = rs; kr < rs + kh; ++kr)
            for (int kc = cs; kc < cs + B_WIN_W; ++kc) {
                int dr = kr - r, dc = kc - cq;
                float bias = p.b_rpb[(h * (2 * B_WIN_H - 1) + dr + B_WIN_H - 1) * (2 * B_WIN_W - 1) + dc + B_WIN_W - 1];
                ATT_KEY(Kp, Vt, CTX_LEN + kr * GRID_W + kc, bias);
            }
        for (int d = 0; d < 64; ++d) p.Y[(size_t)row * 1024 + 512 + h * 64 + d] = f2bf(acc[d] / l_);
    }
}
GLOBAL void nk_attn_ctx(Params p) {
    GS_LOOP(i, (long)TC * 16) {
        int hh = i % 16, rc = i / 16, ty = hh / 8, h = hh % 8, b = rc / CTX_LEN; int row = TX + rc;
        const bf16_t* qp = (ty == 0 ? p.QA : p.QB) + (size_t)row * 512 + h * 64;
        const bf16_t* Kp = ty == 0 ? p.KA + (size_t)(b * 2 + h / 4) * LKV * 64 : p.KB + (size_t)(b * 8 + h) * LKV * 64;
        const bf16_t* Vt = ty == 0 ? p.VAt + (size_t)(b * 2 + h / 4) * 64 * LKV : p.VBt + (size_t)(b * 8 + h) * 64 * LKV;
        ATT_BEGIN();
        for (int j = 0; j < CTX_LEN; ++j) ATT_KEY(Kp, Vt, j, 0.f);
        if (ty == 0) ATT_SINK(p.a_sink[h]);
        for (int d = 0; d < 64; ++d) p.Y[(size_t)row * 1024 + ty * 512 + h * 64 + d] = f2bf(acc[d] / l_);
    }
}
GLOBAL void nk_attnC(Params p) {
    GS_LOOP(i, (long)TX * 8) {
        int h = i % 8, row = i / 8, b = row / SEQ, kvh = h / 4;
        const bf16_t* qp = p.QC + (size_t)row * 512 + h * 64;
        const bf16_t* Kp = p.KC + (size_t)(b * 2 + kvh) * LKV * 64; const bf16_t* Vt = p.VCt + (size_t)(b * 2 + kvh) * 64 * LKV;
        ATT_BEGIN();
        for (int j = 0; j < LKV; ++j) ATT_KEY(Kp, Vt, j, 0.f);
        for (int d = 0; d < 64; ++d) p.Y[(size_t)row * 1024 + h * 64 + d] = f2bf(acc[d] / l_);
    }
}

GLOBAL void nk_outproj_even(Params p) {
    GS_LOOP(i, (long)TT * D_MODEL) {
        int row = i / D_MODEL, col = i % D_MODEL;
        float acc = dot_row(p.Y + (size_t)row * 1024, p.w_out_even, D_MODEL, col, EVEN_OUT);
        xrow_cur(p, row)[col] = xrow_in(p, 0, row)[col] + modp(p, 0, row, 2)[col] * acc;
    }
}
GLOBAL void nk_outproj_odd(Params p) {
    GS_LOOP(i, (long)TX * D_MODEL) {
        int row = i / D_MODEL, col = i % D_MODEL, b = row / SEQ, s = row % SEQ;
        float acc = dot_row(p.Y + (size_t)row * 1024, p.w_out_odd, D_MODEL, col, 512);
        for (int c = 0; c < D_CH; ++c) acc += bf2f(p.YHT[((size_t)b * D_CH + c) * SEQ + s]) * p.w_out_odd[(size_t)(512 + c) * D_MODEL + col];
        p.out[i] = p.out[i] + modp(p, 1, row, 2)[col] * acc;
    }
}

GLOBAL void nk_router(Params p, int l, int nrows) {
    GS_LOOP(row, nrows) {
        const float* xr = xrow_cur(p, (int)row);
        float ss = 0.f;
        for (int k = 0; k < D_MODEL; ++k) ss += xr[k] * xr[k];
        float rstd = 1.0f / sqrtf(ss / D_MODEL + EPS);
        const float* g = p.norm_g + (l * 2 + 1) * D_MODEL; const float* sh = modp(p, l, (int)row, 3); const float* sc = modp(p, l, (int)row, 4);
        float lg[16];
#pragma unroll
        for (int e = 0; e < 16; ++e) lg[e] = 0.f;
        for (int k = 0; k < D_MODEL; ++k) { float hv = xr[k] * rstd * g[k] * (1.0f + sc[k]) + sh[k];
#pragma unroll
            for (int e = 0; e < 16; ++e) lg[e] += hv * p.w_router[k * 16 + e]; }
        int gbest = 0, a = 0, bb = 1; float gbs = -1e30f, wa = 0.f, wb = 0.f;
#pragma unroll
        for (int gI = 0; gI < 4; ++gI) {
            float m1 = -1e30f, m2 = -1e30f, s1 = 0.f, s2 = 0.f; int i1 = 0, i2 = 0;
#pragma unroll
            for (int j = 0; j < 4; ++j) { float sgv = sigmoid_f(lg[gI * 4 + j]); float v = sgv + p.b_router[gI * 4 + j];
                if (v > m1) { m2 = m1; i2 = i1; s2 = s1; m1 = v; i1 = j; s1 = sgv; } else if (v > m2) { m2 = v; i2 = j; s2 = sgv; } }
            float gs = m1 + m2;
            if (gs > gbs) { gbs = gs; gbest = gI; if (i1 < i2) { a = i1; bb = i2; wa = s1; wb = s2; } else { a = i2; bb = i1; wa = s2; wb = s1; } }
        }
        float inv = 1.0f / (wa + wb);
        int pidx = a == 0 ? bb - 1 : (a == 1 ? bb + 1 : 5);
        int pr = gbest * 6 + pidx;
        int pos = atomicAdd(p.cnt + l * 32 + pr, 1);
        p.list[(size_t)pr * TT + pos] = (int)row;
        p.tokw[row * 2 + 0] = wa * inv; p.tokw[row * 2 + 1] = wb * inv;
    }
}
HD void pair_experts(int pr, int& e1, int& e2) { int g = pr / 6, q = pr % 6; int a = q < 3 ? 0 : (q < 5 ? 1 : 2); int b = q < 3 ? q + 1 : (q < 5 ? q - 1 : 3); e1 = g * 4 + a; e2 = g * 4 + b; }
HD bool slot_lookup(const Params& p, int l, int slot, int& pr, int& row) { int acc = 0; for (int q = 0; q < NPAIR; ++q) { int c = p.cnt[l * 32 + q]; if (slot < acc + c) { pr = q; row = p.list[(size_t)q * TT + (slot - acc)]; return true; } acc += c; } return false; }
GLOBAL void nk_moe_up(Params p, int l, int nrows) {
    GS_LOOP(i, (long)nrows * HE_W) {
        int slot = i / HE_W, j = i % HE_W, k = j / D_EXPERT, jj = j % D_EXPERT; int pr, row; if (!slot_lookup(p, l, slot, pr, row)) continue;
        int e1, e2; pair_experts(pr, e1, e2); int e = k == 0 ? e1 : e2;
        const bf16_t* a = p.hbuf + (size_t)row * D_MODEL;
        const float* wg = p.moe_wg + (size_t)(l * N_EXPERTS + e) * D_MODEL * D_EXPERT; const float* wu = p.moe_wu + (size_t)(l * N_EXPERTS + e) * D_MODEL * D_EXPERT;
        float g = dot_row(a, wg, D_EXPERT, jj, D_MODEL), u = dot_row(a, wu, D_EXPERT, jj, D_MODEL);
        p.HE[(size_t)row * HE_W + j] = f2bf(p.tokw[row * 2 + k] * silu_f(g) * u);
    }
}
GLOBAL void nk_moe_down(Params p, int l, int nrows) {
    GS_LOOP(i, (long)nrows * D_MODEL) {
        int slot = i / D_MODEL, col = i % D_MODEL; int pr, row; if (!slot_lookup(p, l, slot, pr, row)) continue;
        int e1, e2; pair_experts(pr, e1, e2);
        const bf16_t* a = p.HE + (size_t)row * HE_W;
        float acc = dot_row(a, p.moe_wd + (size_t)(l * N_EXPERTS + e1) * D_EXPERT * D_MODEL, D_MODEL, col, D_EXPERT)
                  + dot_row(a + D_EXPERT, p.moe_wd + (size_t)(l * N_EXPERTS + e2) * D_EXPERT * D_MODEL, D_MODEL, col, D_EXPERT);
        float* xr = xrow_cur(p, row);
        xr[col] = xr[col] + modp(p, l, row, 5)[col] * acc;
    }
}

GLOBAL void nk_inproj_odd_qk(Params p) {
    GS_LOOP(i, (long)TT * 10) {
        int row = i / 10, hu = i % 10; const bf16_t* a = p.hbuf + (size_t)row * D_MODEL;
        bool lat = row < TX; int b = lat ? row / SEQ : (row - TX) / CTX_LEN; int s = lat ? row % SEQ : (row - TX) % CTX_LEN; int pos = lat ? CTX_LEN + s : s;
        int col0 = hu * 64;
        float v[64]; float ss = 0.f;
        for (int d = 0; d < 64; ++d) { v[d] = dot_row(a, p.w_in_odd, ODD_IN, col0 + d, D_MODEL); ss += v[d] * v[d]; }
        float rstd = 1.0f / sqrtf(ss / 64.0f + EPS);
        const float* gn = hu < 8 ? p.c_qnorm : p.c_knorm;
        for (int d = 0; d < 64; ++d) v[d] = v[d] * rstd * gn[d];
        for (int d = 0; d < 64; ++d) {
            float o = v[d];
            if (lat) { int pd = (d & 31) < 16 ? d + 16 : d - 16; o = rope_apply(p, v[d], v[pd], d, s); }
            if (hu < 8) p.QC[(size_t)row * 512 + col0 + d] = f2bf(o);
            else p.KC[((size_t)(b * 2 + (hu - 8)) * LKV + pos) * 64 + d] = f2bf(o);
        }
    }
}
GLOBAL void nk_inproj_odd_vu(Params p) {
    GS_LOOP(i, (long)TT * (ODD_IN - 640)) {
        int row = i / (ODD_IN - 640), col = 640 + i % (ODD_IN - 640); const bf16_t* a = p.hbuf + (size_t)row * D_MODEL;
        bool lat = row < TX; int b = lat ? row / SEQ : (row - TX) / CTX_LEN; int s = lat ? row % SEQ : (row - TX) % CTX_LEN; int pos = lat ? CTX_LEN + s : s;
        if (col >= 768 && !lat) continue;
        float v = dot_row(a, p.w_in_odd, ODD_IN, col, D_MODEL);
        if (col < 768) { int h = (col - 640) >> 6, d = col & 63; p.VCt[((size_t)(b * 2 + h) * 64 + d) * LKV + pos] = f2bf(v); }
        else p.UT[((size_t)b * 3 * D_CH + (col - 768)) * SEQ + s] = f2bf(v);
    }
}

HD float hy_sc(const Params& p, int b, int ch, int t) {
    const bf16_t* u = p.UT + ((size_t)b * 3 * D_CH + ch) * SEQ;
    float acc = p.hy_short_b[ch];
    for (int kk = 0; kk < 3; ++kk) { int tt = t + kk - 1; if (tt >= 0 && tt < SEQ) acc += p.hy_short_w[kk * 3 * D_CH + ch] * bf2f(u[tt]); }
    return acc;
}
GLOBAL void nk_hy_conv(Params p, int o) {
    GS_LOOP(i, (long)BATCH * D_CH * SEQ) {
        int n = i % SEQ, c = (i / SEQ) % D_CH, b = i / ((long)SEQ * D_CH);
        const float* hf = p.HFT + (size_t)((0 * 2 + o) * D_CH + c) * SEQ; const float* hb = p.HFT + (size_t)((1 * 2 + o) * D_CH + c) * SEQ;
        float inv = 1.0f / p.hnorm[o * D_CH + c];
        float acc = 0.f;
        for (int m = 0; m < SEQ; ++m) {
            float z = o == 0 ? hy_sc(p, b, c, m) : p.Z1[((size_t)b * D_CH + c) * SEQ + m];
            int d = n - m; float hv = d >= 0 ? hf[d] : hb[-d];
            acc += hv * z;
        }
        acc *= inv;
        float zn = o == 0 ? hy_sc(p, b, c, n) : p.Z1[((size_t)b * D_CH + c) * SEQ + n];
        float g = hy_sc(p, b, (o + 1) * D_CH + c, n);
        float r = g * (acc + zn * p.hy_bias[o * D_CH + c]);
        if (o == 0) p.Z1[i] = r; else p.YHT[i] = f2bf(r);
    }
}

GLOBAL void nk_final(Params p) {
    GS_LOOP(row, TX) {
        float* xr = p.out + (size_t)row * D_MODEL; float ss = 0.f;
        for (int k = 0; k < D_MODEL; ++k) ss += xr[k] * xr[k];
        float rstd = 1.0f / sqrtf(ss / D_MODEL + EPS);
        for (int k = 0; k < D_MODEL; ++k) xr[k] = xr[k] * rstd * p.final_g[k];
    }
}
GLOBAL void nk_yht_to_y(Params p) {
    GS_LOOP(i, (long)TX * D_CH) { int row = i / D_CH, c = i % D_CH, b = row / SEQ, s = row % SEQ; p.Y[(size_t)row * 1024 + 512 + c] = p.YHT[((size_t)b * D_CH + c) * SEQ + s]; }
}

GLOBAL void nk_rope(Params p) { d_rope(p); }
GLOBAL void nk_hy_h1(Params p) { d_hy_h1(p); }
GLOBAL void nk_hy_h2(Params p) { d_hy_h2(p); }
static inline size_t al256(size_t x) { return (x + 255) & ~(size_t)255; }
static size_t setup_ws(Params& p, char* ws) {
    size_t o = 0;
    auto take = [&](size_t bytes) { char* r = ws + o; o += al256(bytes); return r; };
    p.bar = (unsigned*)take(64 * 1024);
    p.cnt = (int*)take(256);
    p.XC = (float*)take((size_t)TC * D_MODEL * 4);
    p.mod = (float*)take((size_t)DEPTH * (BATCH + 1) * 6 * D_MODEL * 4);
    p.ropet = (float*)take(64 * 32 * 4);
    p.h1 = (float*)take((size_t)SEQ * 64 * 4);
    p.h2 = (float*)take((size_t)SEQ * 64 * 4);
    p.HFT = (float*)take((size_t)4 * D_CH * SEQ * 4);
    p.hnorm = (float*)take(2 * D_CH * 4);
    p.list = (int*)take((size_t)NPAIR * TT * 4);
    p.tokw = (float*)take((size_t)TT * 2 * 4);
    p.rpair = (int*)take((size_t)TT * 4);
    p.bh = (int*)take((size_t)2048 * 32 * 4);
    size_t hb = (size_t)TT * D_MODEL * 2, z1 = (size_t)BATCH * D_CH * SEQ * 4;
    char* r0 = take(hb > z1 ? hb : z1); p.hbuf = (bf16_t*)r0; p.Z1 = (float*)r0;
    size_t q = al256((size_t)TT * 512 * 2), kva = al256((size_t)BATCH * 2 * LKV * 64 * 2), kvb = al256((size_t)BATCH * 8 * LKV * 64 * 2), ut = al256((size_t)BATCH * 3 * D_CH * SEQ * 2);
    size_t l0 = 2 * q + 2 * kva + 2 * kvb, l1 = q + 2 * kva + ut;
    char* R = take(l0 > l1 ? l0 : l1);
    p.QA = (bf16_t*)R; p.KA = (bf16_t*)(R + q); p.VAt = (bf16_t*)(R + q + kva); p.QB = (bf16_t*)(R + q + 2 * kva); p.KB = (bf16_t*)(R + 2 * q + 2 * kva); p.VBt = (bf16_t*)(R + 2 * q + 2 * kva + kvb);
    p.QC = (bf16_t*)R; p.KC = (bf16_t*)(R + q); p.VCt = (bf16_t*)(R + q + kva); p.UT = (bf16_t*)(R + q + 2 * kva);
    size_t yb = (size_t)TT * 1024 * 2, heb = (size_t)TT * HE_W * 2;
    char* r1 = take(yb > heb ? yb : heb); p.Y = (bf16_t*)r1; p.HE = (bf16_t*)r1;
    p.YHT = (bf16_t*)take((size_t)BATCH * D_CH * SEQ * 2);
    p.Wt_in_even = (bf16_t*)take((size_t)EVEN_IN * D_MODEL * 2);
    p.Wt_out_even = (bf16_t*)take((size_t)D_MODEL * EVEN_OUT * 2);
    p.Wt_in_odd = (bf16_t*)take((size_t)ODD_IN * D_MODEL * 2);
    p.Wt_out_odd = (bf16_t*)take((size_t)D_MODEL * ODD_OUT * 2);
    p.Wt_gu = (bf16_t*)take((size_t)DEPTH * N_EXPERTS * 2 * D_EXPERT * D_MODEL * 2);
    p.Wt_d = (bf16_t*)take((size_t)DEPTH * N_EXPERTS * D_MODEL * D_EXPERT * 2);
    return o;
}
static void fill_inputs(Params& p, void* const* d_in, void* d_out) {
    const float** f = (const float**)&p.x;
    for (int i = 0; i < 32; ++i) f[i] = (const float*)d_in[i];
    p.out = (float*)d_out;
}
#define LAS __attribute__((address_space(3)))
typedef short bf16x8 __attribute__((ext_vector_type(8)));
typedef float f32x4 __attribute__((ext_vector_type(4)));
typedef float f32x16 __attribute__((ext_vector_type(16)));
typedef unsigned u32x4 __attribute__((ext_vector_type(4)));
typedef unsigned u32x2 __attribute__((ext_vector_type(2)));

constexpr int NTHREADS = 256;
constexpr int LDS_BYTES = 69632;
constexpr int MT_ALL = TT / 128, MT_LAT = TX / 128;

__device__ __forceinline__ unsigned pk2bf(float lo, float hi) { return (unsigned)f2bf(lo) | ((unsigned)f2bf(hi) << 16); }
__device__ __forceinline__ float wave_sum(float v) {
#pragma unroll
    for (int o = 1; o < 64; o <<= 1) v += __shfl_xor(v, o);
    return v;
}

template <class DstF>
__device__ __forceinline__ void cvt_wave_item(float* scr, const float* W, int N, int k0, int n0, int lane, const DstF& dst) {
#pragma unroll
    for (int i = 0; i < 32; ++i) { const int kk = 2 * i + (lane >> 5); scr[kk * 33 + (lane & 31)] = W[(size_t)(k0 + kk) * N + n0 + (lane & 31)]; }
    asm volatile("s_waitcnt lgkmcnt(0)" ::: "memory");
    const int c = lane & 7;
#pragma unroll
    for (int j = 0; j < 4; ++j) { const int n = (lane >> 3) + 8 * j; const float* s = scr + (8 * c) * 33 + n;
        u32x4 v; v.x = pk2bf(s[0 * 33], s[1 * 33]); v.y = pk2bf(s[2 * 33], s[3 * 33]); v.z = pk2bf(s[4 * 33], s[5 * 33]); v.w = pk2bf(s[6 * 33], s[7 * 33]);
        *(u32x4*)(dst(n0 + n) + k0 + 8 * c) = v; }
    asm volatile("s_waitcnt lgkmcnt(0)" ::: "memory");
}
__device__ __forceinline__ void cvt_plain(float* scr, const float* W, bf16_t* Wt, int K, int N, int item, int lane) {
    const int nb = N / 32, kb = item / nb, nbi = item % nb;
    cvt_wave_item(scr, W, N, kb * 64, nbi * 32, lane, [&](int n) { return Wt + (size_t)n * K; });
}
constexpr int CVT_IN = (D_MODEL / 64) * (EVEN_IN / 32), CVT_OUT = (D_MODEL / 64) * (D_MODEL / 32), CVT_GU1 = (D_MODEL / 64) * (D_EXPERT / 32), CVT_D1 = (D_EXPERT / 64) * (D_MODEL / 32);
constexpr int CVT_GU = DEPTH * N_EXPERTS * 2 * CVT_GU1, CVT_D = DEPTH * N_EXPERTS * CVT_D1;
constexpr int CVT_TOTAL = 2 * CVT_IN + 2 * CVT_OUT + CVT_GU + CVT_D;
constexpr int CVT_EARLY = 2 * CVT_IN + 2 * CVT_OUT;
__device__ __forceinline__ void cvt_item(const Params& p, float* scr, int it, int lane) {
    if (it < CVT_IN) { cvt_plain(scr, p.w_in_even, p.Wt_in_even, D_MODEL, EVEN_IN, it, lane); return; } it -= CVT_IN;
    if (it < CVT_IN) { cvt_plain(scr, p.w_in_odd, p.Wt_in_odd, D_MODEL, ODD_IN, it, lane); return; } it -= CVT_IN;
    if (it < CVT_OUT) { cvt_plain(scr, p.w_out_even, p.Wt_out_even, EVEN_OUT, D_MODEL, it, lane); return; } it -= CVT_OUT;
    if (it < CVT_OUT) { cvt_plain(scr, p.w_out_odd, p.Wt_out_odd, ODD_OUT, D_MODEL, it, lane); return; } it -= CVT_OUT;
    if (it < CVT_GU) {
        const int le = it / (2 * CVT_GU1), r = it % (2 * CVT_GU1), half = r / CVT_GU1, r2 = r % CVT_GU1; const int nb = D_EXPERT / 32, kb = r2 / nb, nbi = r2 % nb;
        const float* W = (half ? p.moe_wu : p.moe_wg) + (size_t)le * D_MODEL * D_EXPERT; bf16_t* Wt = p.Wt_gu + (size_t)le * 2 * D_EXPERT * D_MODEL;
        cvt_wave_item(scr, W, D_EXPERT, kb * 64, nbi * 32, lane, [&](int n) { return Wt + (size_t)(32 * (n >> 4) + 16 * half + (n & 15)) * D_MODEL; });
        return; } it -= CVT_GU;
    { const int le = it / CVT_D1, r = it % CVT_D1; cvt_plain(scr, p.moe_wd + (size_t)le * D_EXPERT * D_MODEL, p.Wt_d + (size_t)le * D_MODEL * D_EXPERT, D_EXPERT, D_MODEL, r, lane); }
}
__device__ __forceinline__ void cvt_range(const Params& p, char* lds, int lo, int hi, int bid, int nb) {
    const int lane = threadIdx.x & 63, wid = __builtin_amdgcn_readfirstlane(threadIdx.x >> 6);
    float* scr = (float*)lds + wid * (64 * 33);
    for (int it = lo + bid * 4 + wid; it < hi; it += nb * 4) cvt_item(p, scr, it, lane);
}

struct TileGeom { int tid, lane, wid, wr, wc, l15, q, srow, schunk;
    __device__ __forceinline__ int drow(int i) const { return wid * 32 + i * 8 + (lane >> 3); }
    __device__ __forceinline__ int dchunk(int i) const { return (lane & 7) ^ (((lane >> 4) + 4 * i) & 7); } };
__device__ __forceinline__ TileGeom tile_geom() { TileGeom g; g.tid = threadIdx.x; g.lane = g.tid & 63; g.wid = __builtin_amdgcn_readfirstlane(g.tid >> 6); g.wr = g.wid >> 1; g.wc = g.wid & 1; g.l15 = g.lane & 15; g.q = g.lane >> 4; g.srow = g.tid >> 3; g.schunk = g.tid & 7; return g; }

template <class ALoad, class BLoad>
__device__ __forceinline__ void gemm_mainloop(char* lds, const TileGeom& g, int nk, const ALoad& AL, const BLoad& BL, f32x4 (&acc)[4][4]) {
#pragma unroll
    for (int i = 0; i < 4; ++i)
#pragma unroll
        for (int j = 0; j < 4; ++j) acc[i][j] = (f32x4){0.f, 0.f, 0.f, 0.f};
    const int swz = g.l15 >> 1;
    const int aofs = (g.wr * 64 + g.l15) * 128 + ((g.q ^ swz) << 4);
    const int bofs = 32768 + (g.wc * 64 + g.l15) * 128 + ((g.q ^ swz) << 4);
    LAS char* l3 = (LAS char*)lds;
    const int dbase = g.wid * 4096;
#define GEMM_STAGE(kt_, buf_) do { _Pragma("unroll") for (int i_ = 0; i_ < 4; ++i_) { \
        __builtin_amdgcn_global_load_lds((const unsigned*)AL(i_, (kt_)), (LAS unsigned*)(l3 + (buf_) + dbase + i_ * 1024), 16, 0, 0); \
        __builtin_amdgcn_global_load_lds((const unsigned*)BL(i_, (kt_)), (LAS unsigned*)(l3 + 32768 + (buf_) + dbase + i_ * 1024), 16, 0, 0); } } while (0)
    GEMM_STAGE(0, 0);
    __syncthreads();
    for (int kt = 0; kt < nk; ++kt) {
        const int cur = (kt & 1) * 16384, nxt = 16384 - cur;
        if (kt + 1 < nk) GEMM_STAGE(kt + 1, nxt);
#pragma unroll
        for (int kk = 0; kk < 2; ++kk) {
            bf16x8 af[4], bfr[4];
#pragma unroll
            for (int i = 0; i < 4; ++i) { af[i] = *(const bf16x8*)(lds + cur + ((aofs + i * 2048) ^ (kk * 64))); bfr[i] = *(const bf16x8*)(lds + cur + ((bofs + i * 2048) ^ (kk * 64))); }
#pragma unroll
            for (int mi = 0; mi < 4; ++mi)
#pragma unroll
                for (int ni = 0; ni < 4; ++ni) acc[mi][ni] = __builtin_amdgcn_mfma_f32_16x16x32_bf16(bfr[ni], af[mi], acc[mi][ni], 0, 0, 0);
        }
        __syncthreads();
    }
#undef GEMM_STAGE
}

template <class DstF>
__device__ __forceinline__ void store_transposed(char* lds, const TileGeom& g, const f32x4 (&acc)[4][4], const DstF& dst) {
    bf16_t* T = (bf16_t*)lds;
#pragma unroll
    for (int mi = 0; mi < 4; ++mi)
#pragma unroll
        for (int ni = 0; ni < 4; ++ni)
#pragma unroll
            for (int r = 0; r < 4; ++r) T[(g.wc * 64 + ni * 16 + g.q * 4 + r) * 136 + g.wr * 64 + mi * 16 + g.l15] = f2bf(acc[mi][ni][r]);
    __syncthreads();
    { int col = g.tid >> 1, half = g.tid & 1; bf16_t* d = dst(col) + half * 64; const bf16_t* s = T + col * 136 + half * 64;
#pragma unroll
      for (int j = 0; j < 8; ++j) *(u32x4*)(d + j * 8) = *(const u32x4*)(s + j * 8); }
    __syncthreads();
}
__device__ __forceinline__ void store4bf(bf16_t* d, const f32x4& v) { u32x2 w; w.x = pk2bf(v[0], v[1]); w.y = pk2bf(v[2], v[3]); *(u32x2*)d = w; }
__device__ __forceinline__ void rope_head(const Params& p, f32x4 (&a)[4], int s, int q) {
    const int pr = s / GRID_W, pc = s % GRID_W;
    const f32x4 cr = *(const f32x4*)(p.ropet + pr * 32 + q * 4), sr = *(const f32x4*)(p.ropet + pr * 32 + 16 + q * 4);
    const f32x4 cc = *(const f32x4*)(p.ropet + pc * 32 + q * 4), sc = *(const f32x4*)(p.ropet + pc * 32 + 16 + q * 4);
    f32x4 x1 = a[0], x2 = a[1]; a[0] = x1 * cr - x2 * sr; a[1] = x2 * cr + x1 * sr;
    x1 = a[2]; x2 = a[3]; a[2] = x1 * cc - x2 * sc; a[3] = x2 * cc + x1 * sc;
}

template <int LAYER>
__device__ __forceinline__ void inproj_tile(const Params& p, char* lds, int mt, int nt) {
    const TileGeom g = tile_geom();
    const bf16_t* Abase = p.hbuf + (size_t)(mt * 128) * D_MODEL;
    const bf16_t* Bbase = (LAYER == 0 ? p.Wt_in_even : p.Wt_in_odd) + (size_t)(nt * 128) * D_MODEL;
    f32x4 acc[4][4];
    gemm_mainloop(lds, g, D_MODEL / 64, [&](int i, int kt) { return Abase + (size_t)g.drow(i) * D_MODEL + kt * 64 + g.dchunk(i) * 8; }, [&](int i, int kt) { return Bbase + (size_t)g.drow(i) * D_MODEL + kt * 64 + g.dchunk(i) * 8; }, acc);
    const bool lat = mt < MT_LAT; const int row0 = mt * 128;
    const int b = lat ? row0 / SEQ : (row0 - TX) / CTX_LEN, s0 = lat ? row0 % SEQ : (row0 - TX) % CTX_LEN, pos0 = lat ? CTX_LEN + s0 : s0;
    int kind;
    bf16_t* base; int h0 = 0, qcol0 = 0, nh = 2;
    if (LAYER == 0) {
        if (nt < 4) { kind = 0; base = p.QA; qcol0 = nt * 128; }
        else if (nt == 4) { kind = 1; base = p.KA; h0 = 0; nh = 2; }
        else if (nt == 5) { kind = 2; base = p.VAt; h0 = 0; nh = 2; }
        else if (nt < 10) { kind = 0; base = p.QB; qcol0 = (nt - 6) * 128; }
        else if (nt < 14) { kind = 1; base = p.KB; h0 = (nt - 10) * 2; nh = 8; }
        else { kind = 2; base = p.VBt; h0 = (nt - 14) * 2; nh = 8; }
    } else {
        if (nt < 4) { kind = 0; base = p.QC; qcol0 = nt * 128; }
        else if (nt == 4) { kind = 1; base = p.KC; h0 = 0; nh = 2; }
        else if (nt == 5) { kind = 2; base = p.VCt; h0 = 0; nh = 2; }
        else { kind = 3; base = p.UT; }
    }
    if (kind <= 1) {
        const bool rope = lat && (LAYER == 1 || nt <= 4);
#pragma unroll
        for (int mi = 0; mi < 4; ++mi) {
            const int rowl = g.wr * 64 + mi * 16 + g.l15;
            if (LAYER == 1) {
                float ss = 0.f;
#pragma unroll
                for (int ni = 0; ni < 4; ++ni) ss += acc[mi][ni][0] * acc[mi][ni][0] + acc[mi][ni][1] * acc[mi][ni][1] + acc[mi][ni][2] * acc[mi][ni][2] + acc[mi][ni][3] * acc[mi][ni][3];
                ss += __shfl_xor(ss, 16); ss += __shfl_xor(ss, 32);
                const float rstd = 1.0f / sqrtf(ss * (1.0f / 64.0f) + EPS);
                const float* gn = kind == 0 ? p.c_qnorm : p.c_knorm;
#pragma unroll
                for (int ni = 0; ni < 4; ++ni) acc[mi][ni] = acc[mi][ni] * rstd * *(const f32x4*)(gn + ni * 16 + g.q * 4);
            }
            if (rope) rope_head(p, acc[mi], s0 + rowl, g.q);
            bf16_t* d = kind == 0 ? base + (size_t)(row0 + rowl) * 512 + qcol0 + g.wc * 64 + g.q * 4
                                  : base + ((size_t)(b * nh + h0 + g.wc) * LKV + pos0 + rowl) * 64 + g.q * 4;
#pragma unroll
            for (int ni = 0; ni < 4; ++ni) store4bf(d + ni * 16, acc[mi][ni]);
        }
    } else if (kind == 2) {
        store_transposed(lds, g, acc, [&](int col) { return base + ((size_t)(b * nh + h0 + (col >> 6)) * 64 + (col & 63)) * LKV + pos0; });
    } else {
        store_transposed(lds, g, acc, [&](int col) { return base + ((size_t)b * 3 * D_CH + (nt - 6) * 128 + col) * SEQ + s0; });
    }
}
template <int LAYER>
__device__ __forceinline__ void ph_inproj(const Params& p, char* lds, int bid, int nb) {
    constexpr int NT = 18;
    if (LAYER == 0) { for (int t = bid; t < MT_ALL * NT; t += nb) inproj_tile<0>(p, lds, t / NT, t % NT); }
    else {
        const int n_lat = MT_LAT * NT, n_all = n_lat + (MT_ALL - MT_LAT) * 2;
        for (int t = bid; t < n_all; t += nb) { if (t < n_lat) inproj_tile<1>(p, lds, t / NT, t % NT); else { int u = t - n_lat; inproj_tile<1>(p, lds, MT_LAT + u / 2, 4 + u % 2); } }
    }
}

template <int LAYER>
__device__ __forceinline__ void outproj_tile(const Params& p, char* lds, int mt, int nt) {
    const TileGeom g = tile_geom();
    const bf16_t* Abase = p.Y + (size_t)(mt * 128) * 1024;
    const bf16_t* Bbase = (LAYER == 0 ? p.Wt_out_even : p.Wt_out_odd) + (size_t)(nt * 128) * 1024;
    f32x4 acc[4][4];
    gemm_mainloop(lds, g, 16, [&](int i, int kt) { return Abase + (size_t)g.drow(i) * 1024 + kt * 64 + g.dchunk(i) * 8; }, [&](int i, int kt) { return Bbase + (size_t)g.drow(i) * 1024 + kt * 64 + g.dchunk(i) * 8; }, acc);
    const int row0 = mt * 128;
#pragma unroll
    for (int mi = 0; mi < 4; ++mi) {
        const int row = row0 + g.wr * 64 + mi * 16 + g.l15;
        const float* xin = xrow_in(p, LAYER, row); float* xo = xrow_cur(p, row); const float* gate = modp(p, LAYER, row, 2);
#pragma unroll
        for (int ni = 0; ni < 4; ++ni) { const int col = nt * 128 + g.wc * 64 + ni * 16 + g.q * 4;
            *(f32x4*)(xo + col) = *(const f32x4*)(xin + col) + *(const f32x4*)(gate + col) * acc[mi][ni]; }
    }
}

template <int LAYER>
__device__ __forceinline__ void ph_outproj(const Params& p, char* lds, int bid, int nb) {
    const int nmt = LAYER == 0 ? MT_ALL : MT_LAT;
    for (int t = bid; t < nmt * 8; t += nb) outproj_tile<LAYER>(p, lds, t / 8, t % 8);
}

template <int NTN>
__device__ __forceinline__ bool moe_tile_lookup(const int* cnt, int t, int& pr, int& mt, int& nt, int& n) {
    int acc = 0;
    for (int q = 0; q < NPAIR; ++q) { const int c = cnt[q]; const int tiles = ((c + 127) >> 7) * NTN; if (t < acc + tiles) { pr = q; const int u = t - acc; mt = u / NTN; nt = u % NTN; n = c; return true; } acc += tiles; }
    return false;
}
__device__ __forceinline__ void moe_up_tile(const Params& p, char* lds, int l, int pr, int mt, int nt, int n) {
    const TileGeom g = tile_geom();
    int e1, e2; pair_experts(pr, e1, e2); const int k = nt >> 3, e = k ? e2 : e1;
    const int* lst = p.list + (size_t)pr * TT + mt * 128;
    const int navail = n - mt * 128;
    const bf16_t* arow[4];
#pragma unroll
    for (int i = 0; i < 4; ++i) { int r = g.drow(i); if (r >= navail) r = navail - 1; arow[i] = p.hbuf + (size_t)lst[r] * D_MODEL + g.dchunk(i) * 8; }
    const bf16_t* Bbase = p.Wt_gu + ((size_t)(l * N_EXPERTS + e) * 2 * D_EXPERT + (nt & 7) * 128) * D_MODEL;
    f32x4 acc[4][4];
    gemm_mainloop(lds, g, D_MODEL / 64, [&](int i, int kt) { return arow[i] + kt * 64; }, [&](int i, int kt) { return Bbase + (size_t)g.drow(i) * D_MODEL + kt * 64 + g.dchunk(i) * 8; }, acc);
#pragma unroll
    for (int mi = 0; mi < 4; ++mi) {
        const int rl = g.wr * 64 + mi * 16 + g.l15;
        if (rl < navail) {
            const int row = lst[rl]; const float w = p.tokw[row * 2 + k];
            bf16_t* d = p.HE + (size_t)row * HE_W + k * D_EXPERT + (nt & 7) * 64 + g.wc * 32 + g.q * 4;
#pragma unroll
            for (int h2 = 0; h2 < 2; ++h2) { f32x4 gg = acc[mi][2 * h2], uu = acc[mi][2 * h2 + 1], o;
#pragma unroll
                for (int r = 0; r < 4; ++r) o[r] = w * (gg[r] / (1.0f + __expf(-gg[r]))) * uu[r];
                store4bf(d + h2 * 16, o); }
        }
    }
}
template <bool DUMMY = false>
__device__ __forceinline__ void moe_down_tile(const Params& p, char* lds, int l, int pr, int mt, int nt, int n) {
    const TileGeom g = tile_geom();
    int e1, e2; pair_experts(pr, e1, e2);
    const int* lst = p.list + (size_t)pr * TT + mt * 128;
    const int navail = n - mt * 128;
    const bf16_t* arow[4];
#pragma unroll
    for (int i = 0; i < 4; ++i) { int r = g.drow(i); if (r >= navail) r = navail - 1; arow[i] = p.HE + (size_t)lst[r] * HE_W + g.dchunk(i) * 8; }
    const bf16_t* B1 = p.Wt_d + ((size_t)(l * N_EXPERTS + e1) * D_MODEL + nt * 128) * D_EXPERT;
    const bf16_t* B2 = p.Wt_d + ((size_t)(l * N_EXPERTS + e2) * D_MODEL + nt * 128) * D_EXPERT;
    constexpr int KT1 = D_EXPERT / 64;
    f32x4 acc[4][4];
    gemm_mainloop(lds, g, HE_W / 64, [&](int i, int kt) { return arow[i] + kt * 64; },
                  [&](int i, int kt) { return (kt < KT1 ? B1 + kt * 64 : B2 + (kt - KT1) * 64) + (size_t)g.drow(i) * D_EXPERT + g.dchunk(i) * 8; }, acc);
#pragma unroll
    for (int mi = 0; mi < 4; ++mi) {
        const int rl = g.wr * 64 + mi * 16 + g.l15;
        if (rl < navail) {
            const int row = lst[rl]; float* xo = xrow_cur(p, row); const float* gate = modp(p, l, row, 5);
#pragma unroll
            for (int ni = 0; ni < 4; ++ni) { const int col = nt * 128 + g.wc * 64 + ni * 16 + g.q * 4; float* dst = DUMMY ? (float*)p.QA + (size_t)row * D_MODEL : xo; *(f32x4*)(dst + col) = *(const f32x4*)(xo + col) + *(const f32x4*)(gate + col) * acc[mi][ni]; }
        }
    }
}
__device__ __forceinline__ void ph_moe_up(const Params& p, char* lds, int l, int bid, int nb) {
    int pr, mt, nt, n; for (int t = bid; moe_tile_lookup<16>(p.cnt + l * 32, t, pr, mt, nt, n); t += nb) moe_up_tile(p, lds, l, pr, mt, nt, n);
}
template <bool DUMMY = false>
__device__ __forceinline__ void ph_moe_down(const Params& p, char* lds, int l, int bid, int nb) {
    int pr, mt, nt, n; for (int t = bid; moe_tile_lookup<8>(p.cnt + l * 32, t, pr, mt, nt, n); t += nb) moe_down_tile<DUMMY>(p, lds, l, pr, mt, nt, n);
}
typedef float f32x2 __attribute__((ext_vector_type(2)));
typedef __bf16 bf16x2_t __attribute__((ext_vector_type(2)));
__device__ __forceinline__ unsigned cvtpk(float lo, float hi) { f32x2 v = {lo, hi}; bf16x2_t b = __builtin_convertvector(v, bf16x2_t); return __builtin_bit_cast(unsigned, b); }
__device__ __forceinline__ int crow(int r, int hi) { return (r & 3) + 8 * (r >> 2) + 4 * hi; }
constexpr float LOG2E = 1.4426950408889634f;
constexpr float QK_C = ATTN_SCALE * LOG2E;
constexpr float NEG_BIG = -1e30f;

template <int MODE>
__device__ __forceinline__ void attn_unit(char* lds, const bf16_t* Qp, const bf16_t* Kp, const bf16_t* Vt, bf16_t* Op, int s0, int nctx, int lt0, int nlat, float sink2, bool has_sink, const float* rpb_h) {
    const int tid = threadIdx.x, lane = tid & 63, wid = __builtin_amdgcn_readfirstlane(tid >> 6), l31 = lane & 31, hi = lane >> 5;
    float* bias_s = (float*)(lds + 32768);
    if (MODE == 2) { for (int i = tid; i < 15 * 31; i += NTHREADS) bias_s[i] = rpb_h[i] * LOG2E; }
    const int ntiles = nctx + nlat;
    const int srow0 = tid >> 3, schunk = tid & 7;
    const int swzw = (srow0 >> 1) & 7;
    const int wofs = srow0 * 128 + ((schunk ^ swzw) << 4);
    const bool vswap0 = (srow0 >> 4) & 1;
    const int x = (l31 >> 1) & 7;
    const int kofs = l31 * 128 + ((hi ^ x) << 4);
    const int vofs = 16384 + l31 * 128 + ((0 ^ x) << 4) + 8 * (hi ^ (l31 >> 4));
    bf16x8 qf[4];
    { const bf16_t* qr = Qp + (size_t)(wid * 32 + l31) * 512 + hi * 8;
#pragma unroll
      for (int s = 0; s < 4; ++s) qf[s] = *(const bf16x8*)(qr + s * 16); }
    auto tile_pos = [&](int j) { return j < nctx ? 64 * j : CTX_LEN + 64 * (lt0 + j - nctx); };
    u32x4 rk[2], rv[2];
    auto gload = [&](int j) { const int pos = tile_pos(j);
#pragma unroll
        for (int i = 0; i < 2; ++i) { rk[i] = *(const u32x4*)(Kp + (size_t)(pos + srow0 + 32 * i) * 64 + schunk * 8); rv[i] = *(const u32x4*)(Vt + (size_t)(srow0 + 32 * i) * LKV + pos + schunk * 8); } };
    auto lstore = [&](int buf) {
#pragma unroll
        for (int i = 0; i < 2; ++i) { *(u32x4*)(lds + buf * 8192 + wofs + i * 4096) = rk[i]; u32x4 v = rv[i]; if (vswap0) v = (u32x4){v.z, v.w, v.x, v.y}; *(u32x4*)(lds + 16384 + buf * 8192 + wofs + i * 4096) = v; } };
    f32x16 o0 = {}, o1 = {};
    float m = NEG_BIG, l = 0.f;
    const int sq = s0 + wid * 32 + l31;
    int rq = 0, cq = 0, rsq = 0, csq = 0;
    if (MODE == 2) { rq = sq / GRID_W; cq = sq % GRID_W; rsq = rq - B_WIN_H / 2; rsq = rsq < 0 ? 0 : (rsq > GRID_H - B_WIN_H ? GRID_H - B_WIN_H : rsq); csq = cq - B_WIN_W / 2; csq = csq < 0 ? 0 : (csq > GRID_W - B_WIN_W ? GRID_W - B_WIN_W : csq); }
    gload(0); lstore(0);
    __syncthreads();
    for (int j = 0; j < ntiles; ++j) {
        const int buf = j & 1; const bool more = j + 1 < ntiles;
        if (more) gload(j + 1);
        const char* Kb = lds + buf * 8192; const char* Vb = lds + buf * 8192;
        f32x16 p0 = {}, p1 = {};
#pragma unroll
        for (int s = 0; s < 4; ++s) {
            const bf16x8 k0 = *(const bf16x8*)(Kb + (kofs ^ (s << 5))); const bf16x8 k1 = *(const bf16x8*)(Kb + 4096 + (kofs ^ (s << 5)));
            p0 = __builtin_amdgcn_mfma_f32_32x32x16_bf16(k0, qf[s], p0, 0, 0, 0); p1 = __builtin_amdgcn_mfma_f32_32x32x16_bf16(k1, qf[s], p1, 0, 0, 0);
        }
        float tmax = NEG_BIG;
        if (MODE == 0 || j < nctx) {
#pragma unroll
            for (int r = 0; r < 16; ++r) { p0[r] *= QK_C; p1[r] *= QK_C; tmax = fmaxf(tmax, fmaxf(p0[r], p1[r])); }
        } else if (MODE == 1) {
            const int sk0 = 64 * (lt0 + j - nctx);
#pragma unroll
            for (int r = 0; r < 16; ++r) { const int d0 = sk0 + crow(r, hi) - sq, d1 = d0 + 32;
                p0[r] = (d0 >= -A_WINDOW && d0 <= A_WINDOW) ? p0[r] * QK_C : NEG_BIG; p1[r] = (d1 >= -A_WINDOW && d1 <= A_WINDOW) ? p1[r] * QK_C : NEG_BIG; tmax = fmaxf(tmax, fmaxf(p0[r], p1[r])); }
        } else {
            const int kr = lt0 + j - nctx; const bool rowok = kr >= rsq && kr < rsq + B_WIN_H;
            const float* brow = bias_s + (kr - rq + B_WIN_H - 1) * 31 + (B_WIN_W - 1) - cq;
#pragma unroll
            for (int r = 0; r < 16; ++r) { const int kc0 = crow(r, hi), kc1 = kc0 + 32;
                const bool ok0 = rowok && kc0 >= csq && kc0 < csq + B_WIN_W, ok1 = rowok && kc1 >= csq && kc1 < csq + B_WIN_W;
                p0[r] = ok0 ? p0[r] * QK_C + brow[kc0] : NEG_BIG; p1[r] = ok1 ? p1[r] * QK_C + brow[kc1] : NEG_BIG; tmax = fmaxf(tmax, fmaxf(p0[r], p1[r])); }
        }
        tmax = fmaxf(tmax, __shfl_xor(tmax, 32));
        const float mn = fmaxf(m, tmax), alpha = __builtin_amdgcn_exp2f(m - mn); m = mn;
        float ls = 0.f;
#pragma unroll
        for (int r = 0; r < 16; ++r) { p0[r] = __builtin_amdgcn_exp2f(p0[r] - mn); p1[r] = __builtin_amdgcn_exp2f(p1[r] - mn); ls += p0[r] + p1[r]; }
        l = l * alpha + ls;
#pragma unroll
        for (int r = 0; r < 16; ++r) { o0[r] *= alpha; o1[r] *= alpha; }
        bf16x8 pf[4];
        { u32x4 w;
          w.x = cvtpk(p0[0], p0[1]); w.y = cvtpk(p0[2], p0[3]); w.z = cvtpk(p0[4], p0[5]); w.w = cvtpk(p0[6], p0[7]); pf[0] = __builtin_bit_cast(bf16x8, w);
          w.x = cvtpk(p0[8], p0[9]); w.y = cvtpk(p0[10], p0[11]); w.z = cvtpk(p0[12], p0[13]); w.w = cvtpk(p0[14], p0[15]); pf[1] = __builtin_bit_cast(bf16x8, w);
          w.x = cvtpk(p1[0], p1[1]); w.y = cvtpk(p1[2], p1[3]); w.z = cvtpk(p1[4], p1[5]); w.w = cvtpk(p1[6], p1[7]); pf[2] = __builtin_bit_cast(bf16x8, w);
          w.x = cvtpk(p1[8], p1[9]); w.y = cvtpk(p1[10], p1[11]); w.z = cvtpk(p1[12], p1[13]); w.w = cvtpk(p1[14], p1[15]); pf[3] = __builtin_bit_cast(bf16x8, w); }
#pragma unroll
        for (int s = 0; s < 4; ++s) {
            const int a0 = vofs ^ (s << 5);
            u32x2 va = *(const u32x2*)(Vb + a0), vb = *(const u32x2*)(Vb + (a0 ^ 16));
            u32x2 vc = *(const u32x2*)(Vb + 4096 + a0), vd = *(const u32x2*)(Vb + 4096 + (a0 ^ 16));
            const bf16x8 f0 = __builtin_bit_cast(bf16x8, (u32x4){va.x, va.y, vb.x, vb.y}), f1 = __builtin_bit_cast(bf16x8, (u32x4){vc.x, vc.y, vd.x, vd.y});
            o0 = __builtin_amdgcn_mfma_f32_32x32x16_bf16(f0, pf[s], o0, 0, 0, 0); o1 = __builtin_amdgcn_mfma_f32_32x32x16_bf16(f1, pf[s], o1, 0, 0, 0);
        }
        if (more) lstore(buf ^ 1);
        __syncthreads();
    }
    l += __shfl_xor(l, 32);
    if (has_sink) l += __builtin_amdgcn_exp2f(sink2 - m);
    const float inv = 1.0f / l;
    bf16_t* orow = Op + (size_t)(wid * 32 + l31) * 1024;
#pragma unroll
    for (int g4 = 0; g4 < 4; ++g4) {
        u32x2 w; w.x = cvtpk(o0[g4 * 4 + 0] * inv, o0[g4 * 4 + 1] * inv); w.y = cvtpk(o0[g4 * 4 + 2] * inv, o0[g4 * 4 + 3] * inv); *(u32x2*)(orow + 8 * g4 + 4 * hi) = w;
        w.x = cvtpk(o1[g4 * 4 + 0] * inv, o1[g4 * 4 + 1] * inv); w.y = cvtpk(o1[g4 * 4 + 2] * inv, o1[g4 * 4 + 3] * inv); *(u32x2*)(orow + 32 + 8 * g4 + 4 * hi) = w;
    }
}

constexpr int NU_LAT = BATCH * 8 * (SEQ / 128);
constexpr int NU_CTX = BATCH * 8 * (CTX_LEN / 128);
__device__ __forceinline__ void ph_attn0(const Params& p, char* lds, int bid, int nb) {
    for (int u = bid; u < 2 * NU_LAT + 2 * NU_CTX; u += nb) {
        if (u < NU_LAT) {
            const int blk = u % (SEQ / 128), h = (u / (SEQ / 128)) % 8, b = u / (8 * (SEQ / 128)); const int s0 = blk * 128, r0 = s0 / GRID_W;
            int rs0 = r0 - 4; rs0 = rs0 < 0 ? 0 : (rs0 > GRID_H - 8 ? GRID_H - 8 : rs0); int rs1 = r0 + 1 - 4; rs1 = rs1 < 0 ? 0 : (rs1 > GRID_H - 8 ? GRID_H - 8 : rs1);
            attn_unit<2>(lds, p.QB + (size_t)(b * SEQ + s0) * 512 + h * 64, p.KB + (size_t)(b * 8 + h) * LKV * 64, p.VBt + (size_t)(b * 8 + h) * 64 * LKV,
                         p.Y + (size_t)(b * SEQ + s0) * 1024 + 512 + h * 64, s0, CTX_LEN / 64, rs0, rs1 + 8 - rs0, 0.f, false, p.b_rpb + h * 15 * 31);
        } else if (u < 2 * NU_LAT) {
            const int v = u - NU_LAT; const int blk = v % (SEQ / 128), h = (v / (SEQ / 128)) % 8, b = v / (8 * (SEQ / 128)); const int s0 = blk * 128;
            int t0 = (s0 - 128) / 64; if (t0 < 0) t0 = 0; int t1 = (s0 + 255) / 64; if (t1 > SEQ / 64 - 1) t1 = SEQ / 64 - 1;
            attn_unit<1>(lds, p.QA + (size_t)(b * SEQ + s0) * 512 + h * 64, p.KA + (size_t)(b * 2 + h / 4) * LKV * 64, p.VAt + (size_t)(b * 2 + h / 4) * 64 * LKV,
                         p.Y + (size_t)(b * SEQ + s0) * 1024 + h * 64, s0, CTX_LEN / 64, t0, t1 - t0 + 1, p.a_sink[h] * LOG2E, true, nullptr);
        } else {
            const int v = u - 2 * NU_LAT; const int ty = v / NU_CTX, w = v % NU_CTX; const int blk = w % (CTX_LEN / 128), h = (w / (CTX_LEN / 128)) % 8, b = w / (8 * (CTX_LEN / 128));
            const int row0 = TX + b * CTX_LEN + blk * 128;
            if (ty == 0) attn_unit<0>(lds, p.QA + (size_t)row0 * 512 + h * 64, p.KA + (size_t)(b * 2 + h / 4) * LKV * 64, p.VAt + (size_t)(b * 2 + h / 4) * 64 * LKV, p.Y + (size_t)row0 * 1024 + h * 64, 0, CTX_LEN / 64, 0, 0, p.a_sink[h] * LOG2E, true, nullptr);
            else attn_unit<0>(lds, p.QB + (size_t)row0 * 512 + h * 64, p.KB + (size_t)(b * 8 + h) * LKV * 64, p.VBt + (size_t)(b * 8 + h) * 64 * LKV, p.Y + (size_t)row0 * 1024 + 512 + h * 64, 0, CTX_LEN / 64, 0, 0, 0.f, false, nullptr);
        }
    }
}
__device__ __forceinline__ void ph_attnC(const Params& p, char* lds, int bid, int nb) {
    for (int u = bid; u < NU_LAT; u += nb) {
        const int blk = u % (SEQ / 128), h = (u / (SEQ / 128)) % 8, b = u / (8 * (SEQ / 128)); const int s0 = blk * 128;
        attn_unit<0>(lds, p.QC + (size_t)(b * SEQ + s0) * 512 + h * 64, p.KC + (size_t)(b * 2 + h / 4) * LKV * 64, p.VCt + (size_t)(b * 2 + h / 4) * 64 * LKV,
                     p.Y + (size_t)(b * SEQ + s0) * 1024 + h * 64, s0, CTX_LEN / 64, 0, SEQ / 64, 0.f, false, nullptr);
    }
}
#ifdef HY_TEST
#define HY_OUT(b, t, v) p.YHT[((size_t)(b) * D_CH + c) * SEQ + (t)] = f2bf(v)
#else
#define HY_OUT(b, t, v) p.Y[((size_t)(b) * SEQ + (t)) * 1024 + 512 + c] = f2bf(v)
#endif
#ifdef CPU_TEST
#define FOR_T for (int tid = 0; tid < 256; ++tid)
#define HSYNC
#define HST(t) st[t]
#define HY_DECL HySt* st = new HySt[256]
#define HY_FREE delete[] st
static inline void sincos_rev(float a, float& c, float& s) { c = cosf(6.283185307179586f * a); s = sinf(6.283185307179586f * a); }
#else
__device__ __forceinline__ int hy_launder(int v) { asm volatile("" : "+v"(v)); return v; }
#define FOR_T if (const int tid = hy_launder((int)threadIdx.x); true)
#define HSYNC __syncthreads()
#define HST(t) st
#define HY_DECL HySt st
#define HY_FREE
__device__ __forceinline__ void sincos_rev(float a, float& c, float& s) { c = __builtin_amdgcn_cosf(a); s = __builtin_amdgcn_sinf(a); }
#endif
constexpr int FN = 2 * SEQ;
constexpr int FPAD = FN + (FN >> 5);
#if !defined(SMALL_CFG)
static_assert(FN == 8192, "pass plan 8,8,8,16 is for N = 8192");
constexpr int R4 = 16;
constexpr int NS4 = 512;
#else
constexpr int R4 = 2;
constexpr int NS4 = 512;
#endif
constexpr int NB8 = FN / 8 / 256;
constexpr int NB4 = FN / R4 / 256;
constexpr int EPT = FN / 256;
struct HySt { float xr[EPT], xi[EPT], kr[EPT], ki[EPT]; };
HD int pidx(int i) { return i + (i >> 5); }

constexpr float W16C[8] = {1.0f, 0.9238795325112867f, 0.7071067811865476f, 0.3826834323650898f, 0.0f, -0.3826834323650898f, -0.7071067811865476f, -0.9238795325112867f};
constexpr float W16S[8] = {0.0f, -0.3826834323650898f, -0.7071067811865476f, -0.9238795325112867f, -1.0f, -0.9238795325112867f, -0.7071067811865476f, -0.3826834323650898f};
template <int R> HD void fft_reg(float* xr, float* xi) {
    constexpr int LG = R == 16 ? 4 : (R == 8 ? 3 : (R == 4 ? 2 : 1));
#pragma unroll
    for (int sg = 0; sg < LG; ++sg) {
        const int h = (R / 2) >> sg;
#pragma unroll
        for (int pr = 0; pr < R / 2; ++pr) {
            const int blk = (pr / h) * 2 * h, i = pr % h;
            const int a = blk + i, b = blk + i + h;
            const float ar = xr[a], ai = xi[a], br = xr[b], bi = xi[b];
            xr[a] = ar + br; xi[a] = ai + bi;
            const float tr = ar - br, ti = ai - bi;
            const int tw = i * (8 / h);
            if (tw == 0) { xr[b] = tr; xi[b] = ti; }
            else if (tw == 4) { xr[b] = ti; xi[b] = -tr; }
            else { const float c = W16C[tw & 7], s = W16S[tw & 7]; xr[b] = tr * c - ti * s; xi[b] = tr * s + ti * c; }
        }
    }
}
template <int R> HD constexpr int bitrev(int i) { int r = 0; for (int b = 1; b < R; b <<= 1) { r = (r << 1) | (i & 1); i >>= 1; } return r; }

template <int R, int NB, class In> HD void pass_load(int tid, HySt& s, const In& in) {
#pragma unroll
    for (int b = 0; b < NB; ++b)
#pragma unroll
        for (int r = 0; r < R; ++r) in(tid + 256 * b + (FN / R) * r, s.xr[b * R + r], s.xi[b * R + r]);
}
template <int R, int NB, class Out> HD void pass_compute(int tid, HySt& s, int Ns, const Out& out) {
#pragma unroll
    for (int b = 0; b < NB; ++b) {
        const int j = tid + 256 * b, k = j & (Ns - 1);
        float* xr = s.xr + b * R; float* xi = s.xi + b * R;
        if (Ns > 1) {
            float wc, ws; sincos_rev(-(float)k / (float)(Ns * R), wc, ws);
            float cr = wc, ci = ws;
#pragma unroll
            for (int r = 1; r < R; ++r) {
                const float vr = xr[r], vi = xi[r]; xr[r] = vr * cr - vi * ci; xi[r] = vr * ci + vi * cr;
                const float nr = cr * wc - ci * ws, ni = cr * ws + ci * wc; cr = nr; ci = ni;
            }
        }
        fft_reg<R>(xr, xi);
        const int j0 = (j - k) * R + k;
#pragma unroll
        for (int i = 0; i < R; ++i) out(j0 + bitrev<R>(i) * Ns, b, bitrev<R>(i), xr[i], xi[i]);
    }
}
struct LdsIn { const float* re; const float* im; HD void operator()(int idx, float& r, float& i) const { r = re[pidx(idx)]; i = im[pidx(idx)]; } };
struct LdsOut { float* re; float* im; HD void operator()(int idx, int, int, float r, float i) const { re[pidx(idx)] = r; im[pidx(idx)] = i; } };

HD float hy_sc_ut(const bf16_t* u, const float* sw3, float sb, int t) {
    float acc = sb;
    if (t > 0) acc += sw3[0] * bf2f(u[t - 1]);
    acc += sw3[1] * bf2f(u[t]);
    if (t < SEQ - 1) acc += sw3[2] * bf2f(u[t + 1]);
    return acc;
}

HD void hyena_channel(const Params& p, int c, float* lds) {
    HY_DECL;
    float* re = lds; float* im = lds + FPAD;
    const LdsIn lin{re, im}; const LdsOut lout{re, im};
    float nrm[2];
#pragma unroll
    for (int o = 0; o < 2; ++o) {
        const float* hf = p.HFT + (size_t)((0 * 2 + o) * D_CH + c) * SEQ; const float* hb = p.HFT + (size_t)((1 * 2 + o) * D_CH + c) * SEQ;
        FOR_T { float sacc = 0.f; for (int i = 0; i < SEQ / 256; ++i) sacc += fabsf(hf[tid + 256 * i]) + fabsf(hb[tid + 256 * i]); re[tid] = sacc; }
        HSYNC;
        { float tot = 0.f; for (int i = 0; i < 256; ++i) tot += re[i]; nrm[o] = tot + EPS; }
        HSYNC;
    }
    float sw[3][3], sbv[3];
#pragma unroll
    for (int q = 0; q < 3; ++q) { sbv[q] = p.hy_short_b[q * D_CH + c];
#pragma unroll
        for (int kk = 0; kk < 3; ++kk) sw[q][kk] = p.hy_short_w[kk * 3 * D_CH + q * D_CH + c]; }
#pragma unroll
    for (int o = 0; o < 2; ++o) {
        const float* hf = p.HFT + (size_t)((0 * 2 + o) * D_CH + c) * SEQ; const float* hb = p.HFT + (size_t)((1 * 2 + o) * D_CH + c) * SEQ;
        const float inv = 1.0f / nrm[o]; const float hbias = p.hy_bias[o * D_CH + c];
        FOR_T { pass_load<8, NB8>(tid, HST(tid), [&](int idx, float& r, float& i) __attribute__((always_inline)) { r = idx < SEQ ? hf[idx] * inv : (idx == SEQ ? 0.f : hb[FN - idx] * inv); i = 0.f; });
                pass_compute<8, NB8>(tid, HST(tid), 1, lout); }
        HSYNC;
        FOR_T { pass_load<8, NB8>(tid, HST(tid), lin); } HSYNC; FOR_T { pass_compute<8, NB8>(tid, HST(tid), 8, lout); } HSYNC;
        FOR_T { pass_load<8, NB8>(tid, HST(tid), lin); } HSYNC; FOR_T { pass_compute<8, NB8>(tid, HST(tid), 64, lout); } HSYNC;
        FOR_T { pass_load<R4, NB4>(tid, HST(tid), lin);
                HySt& s = HST(tid); pass_compute<R4, NB4>(tid, s, NS4, [&](int, int b, int rr, float r, float i) __attribute__((always_inline)) { s.kr[b + NB4 * rr] = r; s.ki[b + NB4 * rr] = i; }); }
        HSYNC;
        for (int bp = 0; bp < BATCH / 2; ++bp) {
            const int b0 = 2 * bp, b1 = 2 * bp + 1;
            const bf16_t* u0 = p.UT + ((size_t)b0 * 3 * D_CH + c) * SEQ; const bf16_t* u1 = p.UT + ((size_t)b1 * 3 * D_CH + c) * SEQ;
            const float* z0 = p.Z1 + ((size_t)b0 * D_CH + c) * SEQ; const float* z1 = p.Z1 + ((size_t)b1 * D_CH + c) * SEQ;
            auto zval = [&](int b, int t) __attribute__((always_inline)) { return o == 0 ? hy_sc_ut(b == b0 ? u0 : u1, sw[0], sbv[0], t) : (b == b0 ? z0 : z1)[t]; };
            FOR_T { pass_load<8, NB8>(tid, HST(tid), [&](int idx, float& r, float& i) __attribute__((always_inline)) { if (idx < SEQ) { r = zval(b0, idx); i = zval(b1, idx); } else { r = 0.f; i = 0.f; } });
                    pass_compute<8, NB8>(tid, HST(tid), 1, lout); }
            HSYNC;
            FOR_T { pass_load<8, NB8>(tid, HST(tid), lin); } HSYNC; FOR_T { pass_compute<8, NB8>(tid, HST(tid), 8, lout); } HSYNC;
            FOR_T { pass_load<8, NB8>(tid, HST(tid), lin); } HSYNC; FOR_T { pass_compute<8, NB8>(tid, HST(tid), 64, lout); } HSYNC;
            FOR_T { pass_load<R4, NB4>(tid, HST(tid), lin); } HSYNC;
            FOR_T { HySt& s = HST(tid); pass_compute<R4, NB4>(tid, s, NS4, [&](int idx, int b, int rr, float r, float i) __attribute__((always_inline)) { const float kr = s.kr[b + NB4 * rr], ki = s.ki[b + NB4 * rr];
                        re[pidx(idx)] = r * kr - i * ki; im[pidx(idx)] = -(r * ki + i * kr); }); }
            HSYNC;
            FOR_T { pass_load<8, NB8>(tid, HST(tid), lin); } HSYNC; FOR_T { pass_compute<8, NB8>(tid, HST(tid), 1, lout); } HSYNC;
            FOR_T { pass_load<8, NB8>(tid, HST(tid), lin); } HSYNC; FOR_T { pass_compute<8, NB8>(tid, HST(tid), 8, lout); } HSYNC;
            FOR_T { pass_load<8, NB8>(tid, HST(tid), lin); } HSYNC; FOR_T { pass_compute<8, NB8>(tid, HST(tid), 64, lout); } HSYNC;
            FOR_T { pass_load<R4, NB4>(tid, HST(tid), lin);
                    const bf16_t* g0 = p.UT + ((size_t)b0 * 3 * D_CH + (o + 1) * D_CH + c) * SEQ; const bf16_t* g1 = p.UT + ((size_t)b1 * 3 * D_CH + (o + 1) * D_CH + c) * SEQ;
                    pass_compute<R4, NB4>(tid, HST(tid), NS4, [&](int idx, int, int, float r, float i) __attribute__((always_inline)) {
                        if (idx < SEQ) {
                            const float y0 = r * (1.0f / FN), y1 = -i * (1.0f / FN);
                            const float zn0 = hy_sc_ut(g0, sw[o + 1], sbv[o + 1], idx) * (y0 + zval(b0, idx) * hbias);
                            const float zn1 = hy_sc_ut(g1, sw[o + 1], sbv[o + 1], idx) * (y1 + zval(b1, idx) * hbias);
                            if (o == 0) { p.Z1[((size_t)b0 * D_CH + c) * SEQ + idx] = zn0; p.Z1[((size_t)b1 * D_CH + c) * SEQ + idx] = zn1; }
                            else { HY_OUT(b0, idx, zn0); HY_OUT(b1, idx, zn1); }
                        } }); }
            HSYNC;
        }
    }
    HY_FREE;
}
constexpr int MOD_ITEMS = DEPTH * (6 * D_MODEL / 64);
__device__ __forceinline__ void mod_item(const Params& p, char* lds, int item) {
    float* sc = (float*)lds;
    float* red = sc + 5 * D_MODEL;
    const int tid = threadIdx.x, l = item / (6 * D_MODEL / 64), j0 = (item % (6 * D_MODEL / 64)) * 64;
    for (int i = tid; i < 5 * D_MODEL; i += NTHREADS) { const int r = i / D_MODEL, k = i % D_MODEL; const float v = r < BATCH ? p.c[r * D_MODEL + k] : p.c_ctx[k]; sc[i] = silu_f(v); }
    __syncthreads();
    const int col = tid & 63, kp = tid >> 6;
    const float* w = p.w_ada + ((size_t)l * D_MODEL + kp * 256) * 6 * D_MODEL + j0 + col;
    float a0 = 0.f, a1 = 0.f, a2 = 0.f, a3 = 0.f, a4 = 0.f;
#pragma unroll 8
    for (int k = 0; k < 256; ++k) { const float wv = w[(size_t)k * 6 * D_MODEL]; const int kk = kp * 256 + k;
        a0 += sc[kk] * wv; a1 += sc[D_MODEL + kk] * wv; a2 += sc[2 * D_MODEL + kk] * wv; a3 += sc[3 * D_MODEL + kk] * wv; a4 += sc[4 * D_MODEL + kk] * wv; }
    red[(kp * 5 + 0) * 64 + col] = a0; red[(kp * 5 + 1) * 64 + col] = a1; red[(kp * 5 + 2) * 64 + col] = a2; red[(kp * 5 + 3) * 64 + col] = a3; red[(kp * 5 + 4) * 64 + col] = a4;
    __syncthreads();
    for (int i = tid; i < 5 * 64; i += NTHREADS) { const int r = i / 64, cc = i % 64;
        const float v = red[(0 * 5 + r) * 64 + cc] + red[(1 * 5 + r) * 64 + cc] + red[(2 * 5 + r) * 64 + cc] + red[(3 * 5 + r) * 64 + cc];
        p.mod[((size_t)(l * (BATCH + 1) + r)) * 6 * D_MODEL + j0 + cc] = v + p.b_ada[l * 6 * D_MODEL + j0 + cc]; }
    __syncthreads();
}
constexpr int FILT_ITEMS = (SEQ / 256) * (4 * D_CH / 64);
__device__ __forceinline__ void filt_item(const Params& p, int item) {
    const int tb = item % (SEQ / 256), cb = item / (SEQ / 256); const int t = tb * 256 + threadIdx.x, col0 = cb * 64;
    f32x4 h[16];
#pragma unroll
    for (int i = 0; i < 16; ++i) h[i] = *(const f32x4*)(p.h2 + (size_t)t * HY_FFN + i * 4);
    const float tn = (float)t / (float)(SEQ - 1);
    const float mind = logf(1e-2f) / 1.5f, maxd = logf(1e-2f) / 0.3f;
    for (int cc = 0; cc < 64; ++cc) {
        const int col = col0 + cc; const float* w = p.hy_w3 + col;
        float acc = p.hy_b3[col];
#pragma unroll
        for (int i = 0; i < 16; ++i) { acc += h[i][0] * w[(size_t)(4 * i + 0) * 4 * D_CH]; acc += h[i][1] * w[(size_t)(4 * i + 1) * 4 * D_CH]; acc += h[i][2] * w[(size_t)(4 * i + 2) * 4 * D_CH]; acc += h[i][3] * w[(size_t)(4 * i + 3) * 4 * D_CH]; }
        const float delta = fabsf(mind + (float)(col % D_CH) * (maxd - mind) / (float)(D_CH - 1));
        p.HFT[(size_t)col * SEQ + t] = acc * expf(-tn * delta);
    }
}
__device__ __forceinline__ void ph_norm(const Params& p, int l, int which, int nrows, int bid, int nb) {
    const int lane = threadIdx.x & 63, wid = threadIdx.x >> 6;
    for (int row = bid * 4 + wid; row < nrows; row += nb * 4) {
        const float* xr = which == 0 ? xrow_in(p, l, row) : xrow_cur(p, row);
        const float* g = p.norm_g + (l * 2 + which) * D_MODEL; const float* sh = modp(p, l, row, which * 3 + 0); const float* sc = modp(p, l, row, which * 3 + 1);
        f32x4 v[4]; float ss = 0.f;
#pragma unroll
        for (int j = 0; j < 4; ++j) { v[j] = *(const f32x4*)(xr + j * 256 + lane * 4); ss += v[j][0] * v[j][0] + v[j][1] * v[j][1] + v[j][2] * v[j][2] + v[j][3] * v[j][3]; }
        const float rstd = 1.0f / sqrtf(wave_sum(ss) * (1.0f / D_MODEL) + EPS);
#pragma unroll
        for (int j = 0; j < 4; ++j) { const int c = j * 256 + lane * 4; const f32x4 o = v[j] * rstd * *(const f32x4*)(g + c) * (*(const f32x4*)(sc + c) + 1.0f) + *(const f32x4*)(sh + c);
            store4bf(p.hbuf + (size_t)row * D_MODEL + c, o); }
    }
}
__device__ __forceinline__ void ph_route_a(const Params& p, char* lds, int l, int nrows, int bid, int nb) {
    const int lane = threadIdx.x & 63, wid = threadIdx.x >> 6;
    float* wr_s = (float*)lds; int* hist = (int*)(lds + 65536);
    for (int i = threadIdx.x; i < D_MODEL * 4; i += NTHREADS) { const int k = i >> 2, ch = i & 3; ((f32x4*)wr_s)[k * 4 + (ch ^ ((k >> 2) & 3))] = ((const f32x4*)p.w_router)[i]; }
    if (threadIdx.x < 32) hist[threadIdx.x] = 0;
    __syncthreads();
    const int sw = (lane >> 2) & 3;
    const float* g = p.norm_g + (l * 2 + 1) * D_MODEL;
    const int RPB = (nrows + nb - 1) / nb, r0 = bid * RPB;
    for (int j = wid; j < RPB; j += 4) {
        const int row = r0 + j; if (row >= nrows) break;
        const float* xr = xrow_cur(p, row); const float* sh = modp(p, l, row, 3); const float* sc = modp(p, l, row, 4);
        float v[16]; float ss = 0.f;
#pragma unroll
        for (int i = 0; i < 16; ++i) { v[i] = xr[lane + 64 * i]; ss += v[i] * v[i]; }
        const float rstd = 1.0f / sqrtf(wave_sum(ss) * (1.0f / D_MODEL) + EPS);
        float lg[16];
#pragma unroll
        for (int e = 0; e < 16; ++e) lg[e] = 0.f;
#pragma unroll
        for (int i = 0; i < 16; ++i) { const int k = lane + 64 * i; const float o = v[i] * rstd * g[k] * (sc[k] + 1.0f) + sh[k];
            p.hbuf[(size_t)row * D_MODEL + k] = f2bf(o);
            const f32x4* w4 = (const f32x4*)(wr_s + k * 16);
#pragma unroll
            for (int e4 = 0; e4 < 4; ++e4) { const f32x4 wv = w4[e4 ^ sw]; lg[e4 * 4 + 0] += o * wv[0]; lg[e4 * 4 + 1] += o * wv[1]; lg[e4 * 4 + 2] += o * wv[2]; lg[e4 * 4 + 3] += o * wv[3]; }
            if (i & 1) __builtin_amdgcn_sched_barrier(0); }
#pragma unroll
        for (int e = 0; e < 16; ++e) lg[e] = wave_sum(lg[e]);
        if (lane == 0) {
            int gbest = 0, a = 0, bb = 1; float gbs = -1e30f, wa = 0.f, wb = 0.f;
#pragma unroll
            for (int gI = 0; gI < 4; ++gI) {
                float m1 = -1e30f, m2 = -1e30f, s1 = 0.f, s2 = 0.f; int i1 = 0, i2 = 0;
#pragma unroll
                for (int jj = 0; jj < 4; ++jj) { float sgv = sigmoid_f(lg[gI * 4 + jj]); float vv = sgv + p.b_router[gI * 4 + jj];
                    if (vv > m1) { m2 = m1; i2 = i1; s2 = s1; m1 = vv; i1 = jj; s1 = sgv; } else if (vv > m2) { m2 = vv; i2 = jj; s2 = sgv; } }
                float gs = m1 + m2;
                if (gs > gbs) { gbs = gs; gbest = gI; if (i1 < i2) { a = i1; bb = i2; wa = s1; wb = s2; } else { a = i2; bb = i1; wa = s2; wb = s1; } }
            }
            const float inv = 1.0f / (wa + wb);
            const int pidx = a == 0 ? bb - 1 : (a == 1 ? bb + 1 : 5);
            const int pr = gbest * 6 + pidx;
            p.rpair[row] = pr; p.tokw[row * 2 + 0] = wa * inv; p.tokw[row * 2 + 1] = wb * inv;
            atomicAdd(&hist[pr], 1);
        }
    }
    __syncthreads();
    if (threadIdx.x < 32) p.bh[bid * 32 + threadIdx.x] = hist[threadIdx.x];
}
__device__ __forceinline__ void ph_route_b(const Params& p, char* lds, int l, int nrows, int bid, int nb) {
    int* sb = (int*)lds;
    const int t = threadIdx.x, pr = t & 31, part = t >> 5;
    { int s_before = 0, s_all = 0; const int b0 = (part * nb) >> 3, b1 = ((part + 1) * nb) >> 3;
      for (int b = b0; b < b1; ++b) { const int c = p.bh[b * 32 + pr]; s_all += c; if (b < bid) s_before += c; }
      sb[part * 32 + pr] = s_before; sb[256 + part * 32 + pr] = s_all; }
    __syncthreads();
    if (t < 32) { int a = 0, c = 0;
#pragma unroll
        for (int q = 0; q < 8; ++q) { a += sb[q * 32 + t]; c += sb[256 + q * 32 + t]; }
        sb[512 + t] = a; sb[544 + t] = c; if (bid == 0) p.cnt[l * 32 + t] = c; }
    const int RPB = (nrows + nb - 1) / nb, row = bid * RPB + t; const bool act = t < RPB && row < nrows;
    int myp = 0; if (act) { myp = p.rpair[row]; sb[576 + t] = myp; }
    __syncthreads();
    if (act) { int rank = 0; for (int j = 0; j < t; ++j) rank += (sb[576 + j] == myp) ? 1 : 0; p.list[(size_t)myp * TT + sb[512 + myp] + rank] = row; }
    __syncthreads();
}
__device__ __forceinline__ void ph_final(const Params& p, int bid, int nb) {
    const int lane = threadIdx.x & 63, wid = threadIdx.x >> 6;
    for (int row = bid * 4 + wid; row < TX; row += nb * 4) {
        float* xr = p.out + (size_t)row * D_MODEL;
        f32x4 v[4]; float ss = 0.f;
#pragma unroll
        for (int j = 0; j < 4; ++j) { v[j] = *(const f32x4*)(xr + j * 256 + lane * 4); ss += v[j][0] * v[j][0] + v[j][1] * v[j][1] + v[j][2] * v[j][2] + v[j][3] * v[j][3]; }
        const float rstd = 1.0f / sqrtf(wave_sum(ss) * (1.0f / D_MODEL) + EPS);
#pragma unroll
        for (int j = 0; j < 4; ++j) { const int c = j * 256 + lane * 4; *(f32x4*)(xr + c) = v[j] * rstd * *(const f32x4*)(p.final_g + c); }
    }
}

#define XB_TMO      128
#define XB_XCNT(j)  (256  + 64 * (j))
#define XB_XSUB(j)  (1280 + 64 * (j))
#define XB_XGEN(j)  (2304 + 64 * (j))
#define XB_TOP      3328
#define XB_TOPGEN   3392
#define XCD_BAR_WORDS 3456
#define XB_SPIN_CAP (1u << 20)
__device__ __forceinline__ unsigned xb_ld(unsigned* p)              { return __hip_atomic_load(p, __ATOMIC_RELAXED, __HIP_MEMORY_SCOPE_AGENT); }
__device__ __forceinline__ unsigned xb_add(unsigned* p, unsigned v) { return __hip_atomic_fetch_add(p, v, __ATOMIC_RELAXED, __HIP_MEMORY_SCOPE_AGENT); }
__device__ __forceinline__ unsigned xb_xcc_id() { return (unsigned)__builtin_amdgcn_s_getreg((3 << 11) | 20) & 0xFu; }
#define XB_SPIN(cond, bar) do { unsigned _sp = 0; while (cond) { __builtin_amdgcn_s_sleep(1); \
    if ((++_sp & 255u) == 0u) { if (xb_ld(&(bar)[XB_TMO])) break; if (_sp > XB_SPIN_CAP) { atomicAdd(&(bar)[XB_TMO], 1u); break; } } } } while (0)
struct XcdBarrier { unsigned* bar; unsigned x; volatile LAS unsigned* st; };
__device__ __forceinline__ XcdBarrier xcd_barrier_post(unsigned* bar, volatile LAS unsigned* st) {
    XcdBarrier b; b.bar = bar; b.x = xb_xcc_id(); b.st = st;
    if (threadIdx.x == 0) (void)xb_add(&bar[XB_XCNT(b.x)], 1u);
    return b;
}
__device__ __forceinline__ void xcd_barrier_complete(unsigned* bar, unsigned x, unsigned& nloc, unsigned& nx) {
    const unsigned G = gridDim.x * gridDim.y * gridDim.z;
    unsigned sum, cnt, mine, sp = 0u;
    for (;;) {
        sum = 0u; cnt = 0u; mine = 0u;
#pragma unroll
        for (unsigned j = 0; j < 16; ++j) { const unsigned c = xb_ld(&bar[XB_XCNT(j)]); sum += c; cnt += (c > 0u) ? 1u : 0u; mine = (j == x) ? c : mine; }
        if (sum == G) break;
        __builtin_amdgcn_s_sleep(1);
        if ((++sp & 255u) == 0u) { if (xb_ld(&bar[XB_TMO])) break; if (sp > XB_SPIN_CAP) { atomicAdd(&bar[XB_TMO], 1u); break; } }
    }
    nloc = mine > 0u ? mine : 1u; nx = cnt > 0u ? cnt : 1u;
}
__device__ __forceinline__ void xcd_barrier(const XcdBarrier& b) {
    asm volatile("s_waitcnt vmcnt(0)" ::: "memory");
    __syncthreads();
    if (threadIdx.x == 0) {
        unsigned* bar = b.bar;
        __builtin_amdgcn_s_waitcnt(0);
        unsigned nloc = b.st[0], nx = b.st[1];
        if (nloc == 0u) { xcd_barrier_complete(bar, b.x, nloc, nx); b.st[0] = nloc; b.st[1] = nx; }
        const unsigned old = xb_add(&bar[XB_XSUB(b.x)], 1u);
        const unsigned gen = old / nloc;
        if (old + 1u == (gen + 1u) * nloc) {
            __builtin_amdgcn_fence(__ATOMIC_RELEASE, "agent");
            asm volatile("s_waitcnt vmcnt(0)" ::: "memory");
            const unsigned og = xb_add(&bar[XB_TOP], 1u);
            const unsigned tg = og / nx;
            if (og + 1u == (tg + 1u) * nx) xb_add(&bar[XB_TOPGEN], 1u);
            else XB_SPIN(xb_ld(&bar[XB_TOPGEN]) == tg, bar);
            __builtin_amdgcn_fence(__ATOMIC_ACQUIRE, "agent");
            xb_add(&bar[XB_XGEN(b.x)], 1u);
            asm volatile("s_waitcnt vmcnt(0)" ::: "memory");
        } else {
            XB_SPIN(xb_ld(&bar[XB_XGEN(b.x)]) == gen, bar);
            __builtin_amdgcn_fence(__ATOMIC_ACQUIRE, "agent");
            asm volatile("s_waitcnt vmcnt(0)" ::: "memory");
        }
    }
    __syncthreads();
}

__device__ __forceinline__ void ph_mix1(const Params& p, char* lds, int bid, int nb) {
    for (int u = bid; u < NU_LAT + D_CH; u += nb) {
        if (u < NU_LAT) { const int blk = u % (SEQ / 128), h = (u / (SEQ / 128)) % 8, b = u / (8 * (SEQ / 128)); const int s0 = blk * 128;
            attn_unit<0>(lds, p.QC + (size_t)(b * SEQ + s0) * 512 + h * 64, p.KC + (size_t)(b * 2 + h / 4) * LKV * 64, p.VCt + (size_t)(b * 2 + h / 4) * 64 * LKV,
                         p.Y + (size_t)(b * SEQ + s0) * 1024 + h * 64, s0, CTX_LEN / 64, 0, SEQ / 64, 0.f, false, nullptr); }
        else hyena_channel(p, u - NU_LAT, (float*)lds);
    }
}
#ifndef PROBE
#define PROBE 0
#endif
enum { PH_PREP = 0, PH_NORM0, PH_INPROJ0, PH_ATTN0, PH_OUT0, PH_ROUTE0, PH_ROUTEB0, PH_UP0, PH_DOWN0, PH_NORM1, PH_INPROJ1, PH_MIX1, PH_OUT1, PH_ROUTE1, PH_ROUTEB1, PH_UP1, PH_DOWN1, PH_FINAL, PH_COUNT };
__global__ void __launch_bounds__(NTHREADS, 2) mega(Params p, int lo, int hi) {
    extern __shared__ __attribute__((aligned(16))) char lds[];
    const int bid = blockIdx.x, nb = gridDim.x;
    volatile LAS unsigned* st = (volatile LAS unsigned*)(lds + LDS_BYTES - 16);
    if (threadIdx.x < 4) st[threadIdx.x] = 0u;
    __syncthreads();
    XcdBarrier bar; bar.bar = p.bar; bar.x = 0; bar.st = st;
    if (hi - lo > 1) bar = xcd_barrier_post(p.bar, st);
#ifdef PROBE_PA
    unsigned long long ts_prev = __builtin_amdgcn_s_memrealtime(), t_a = 0, t_b = 0;
#define STAMP(PH) if (bid == 0 && threadIdx.x == 0) { const unsigned long long now_ = __builtin_amdgcn_s_memrealtime(); if ((PH) == PROBE_PA) t_a = now_ - ts_prev; if ((PH) == PROBE_PB) t_b = now_ - ts_prev; ts_prev = now_; }
#else
#define STAMP(PH)
#endif
#define PHASE(PH, body) if (lo <= (PH) && (PH) < hi) { body; if ((PH) + 1 < hi) xcd_barrier(bar); STAMP(PH) }
    PHASE(PH_PREP, { for (int it = bid; it < MOD_ITEMS; it += nb) mod_item(p, lds, it); cvt_range(p, lds, 0, CVT_EARLY, bid, nb); d_rope(p); d_hy_h1(p); })
#if PROBE == 7
    PHASE(PH_NORM0, { ph_norm(p, 0, 0, TT, bid, nb); ph_norm(p, 0, 0, TT, bid, nb); ph_norm(p, 0, 0, TT, bid, nb); d_hy_h2(p); })
#else
    PHASE(PH_NORM0, { ph_norm(p, 0, 0, TT, bid, nb); d_hy_h2(p); })
#endif
#if PROBE == 1
    PHASE(PH_INPROJ0, { ph_inproj<0>(p, lds, bid, nb); __syncthreads(); ph_inproj<0>(p, lds, bid, nb); for (int it = bid; it < FILT_ITEMS; it += nb) filt_item(p, it); })
#else
    PHASE(PH_INPROJ0, { ph_inproj<0>(p, lds, bid, nb); for (int it = bid; it < FILT_ITEMS; it += nb) filt_item(p, it); })
#endif
#if PROBE == 2
    PHASE(PH_ATTN0, { ph_attn0(p, lds, bid, nb); __syncthreads(); ph_attn0(p, lds, bid, nb); })
#else
    PHASE(PH_ATTN0, { if (bid & 1) { cvt_range(p, lds, CVT_EARLY, CVT_TOTAL, bid, nb); __syncthreads(); ph_attn0(p, lds, bid, nb); } else { ph_attn0(p, lds, bid, nb); __syncthreads(); cvt_range(p, lds, CVT_EARLY, CVT_TOTAL, bid, nb); } })
#endif
#if PROBE == 10
    PHASE(PH_OUT0, { ph_outproj<0>(p, lds, bid, nb); __syncthreads(); ph_outproj<0>(p, lds, bid, nb); })
#elif PROBE == 11
    PHASE(PH_OUT0, { for (int i_ = 0; i_ < 10; ++i_) xcd_barrier(bar); ph_outproj<0>(p, lds, bid, nb); })
#else
    PHASE(PH_OUT0, ph_outproj<0>(p, lds, bid, nb))
#endif
    PHASE(PH_ROUTE0, ph_route_a(p, lds, 0, TT, bid, nb))
    PHASE(PH_ROUTEB0, ph_route_b(p, lds, 0, TT, bid, nb))
#if PROBE == 9
    PHASE(PH_UP0, { ph_moe_up(p, lds, 0, bid, nb); __syncthreads(); ph_moe_up(p, lds, 0, bid, nb); })
#else
    PHASE(PH_UP0, ph_moe_up(p, lds, 0, bid, nb))
#endif
#if PROBE == 12
    PHASE(PH_DOWN0, { ph_moe_down<true>(p, lds, 0, bid, nb); __syncthreads(); ph_moe_down(p, lds, 0, bid, nb); })
#else
    PHASE(PH_DOWN0, ph_moe_down(p, lds, 0, bid, nb))
#endif
    PHASE(PH_NORM1, ph_norm(p, 1, 0, TT, bid, nb))
    PHASE(PH_INPROJ1, ph_inproj<1>(p, lds, bid, nb))
#if PROBE == 3
    PHASE(PH_MIX1, { ph_attnC(p, lds, bid, nb); __syncthreads(); ph_mix1(p, lds, bid, nb); })
#elif PROBE == 4
    PHASE(PH_MIX1, { for (int c = bid; c < D_CH; c += nb) hyena_channel(p, c, (float*)lds); __syncthreads(); ph_mix1(p, lds, bid, nb); })
#else
    PHASE(PH_MIX1, ph_mix1(p, lds, bid, nb))
#endif
    PHASE(PH_OUT1, ph_outproj<1>(p, lds, bid, nb))
    PHASE(PH_ROUTE1, ph_route_a(p, lds, 1, TX, bid, nb))
    PHASE(PH_ROUTEB1, ph_route_b(p, lds, 1, TX, bid, nb))
    PHASE(PH_UP1, ph_moe_up(p, lds, 1, bid, nb))
    PHASE(PH_DOWN1, ph_moe_down(p, lds, 1, bid, nb))
    PHASE(PH_FINAL, ph_final(p, bid, nb))
#ifdef PROBE_PA
    if (bid == 0 && threadIdx.x == 0) {
        const unsigned long long delay = 2 * t_a + 204800ull * ((t_b + 200) / 400); const unsigned long long t0 = __builtin_amdgcn_s_memrealtime();
        while (__builtin_amdgcn_s_memrealtime() - t0 < delay) __builtin_amdgcn_s_sleep(32);
    }
#endif
}
extern "C" void kernel_launch(void* const* d_in, const int* in_sizes, int n_in, void* d_out, int out_size, void* d_ws, size_t ws_size, hipStream_t stream) {
    static int grid = 0;
    if (grid == 0) {
        int dev = 0, cus = 0;
        if (hipGetDevice(&dev) != hipSuccess || hipDeviceGetAttribute(&cus, hipDeviceAttributeMultiprocessorCount, dev) != hipSuccess) { fprintf(stderr, "kernel_launch: device query failed\n"); grid = -1; return; }
        if (hipFuncSetAttribute((const void*)mega, hipFuncAttributeMaxDynamicSharedMemorySize, LDS_BYTES) != hipSuccess) { fprintf(stderr, "kernel_launch: hipFuncSetAttribute failed\n"); grid = -1; return; }
        grid = 2 * cus;
    }
    if (grid < 0) return;
    Params p{};
    size_t need = setup_ws(p, (char*)d_ws);
    if (n_in != 32 || need > ws_size || out_size != TX * D_MODEL) { fprintf(stderr, "kernel_launch: bad config n_in %d ws %zu need %zu out %d\n", n_in, ws_size, need, out_size); return; }
    fill_inputs(p, d_in, d_out);
    hipMemsetAsync(p.bar, 0, 64 * 1024 + 256, stream);
#ifdef PER_PHASE
    for (int ph = 0; ph < PH_COUNT; ++ph) mega<<<dim3(grid), dim3(NTHREADS), LDS_BYTES, stream>>>(p, ph, ph + 1);
#else
    mega<<<dim3(grid), dim3(NTHREADS), LDS_BYTES, stream>>>(p, 0, PH_COUNT);
#endif
}
```

```cpp
#include <hip/hip_runtime.h>
#include <cstdio>
#include <math.h>
#include <stdint.h>
#include <string.h>

#ifdef CPU_TEST
#define HD
#define GLOBAL
struct U3 { unsigned x, y, z; };
static thread_local U3 threadIdx, blockIdx, blockDim, gridDim;
static inline int atomicAdd(int* p, int v) { return __sync_fetch_and_add(p, v); }
#else
#define HD __device__ __forceinline__
#define GLOBAL __global__ __launch_bounds__(256)
#endif

#if defined(HY_TEST)
constexpr int D_MODEL = 64, BATCH = 2, SEQ = 4096, GRID_W = 64, CTX_LEN = 64, D_CH = 4, D_EXPERT = 64;
#elif defined(SMALL_CFG)
constexpr int D_MODEL = 128, BATCH = 2, SEQ = 512, GRID_W = 32, CTX_LEN = 64, D_CH = 32, D_EXPERT = 64;
#else
constexpr int D_MODEL = 1024, BATCH = 4, SEQ = 4096, GRID_W = 64, CTX_LEN = 256, D_CH = 512, D_EXPERT = 512;
#endif
constexpr int DEPTH = 2, HEAD_DIM = 64;
constexpr int GRID_H = SEQ / GRID_W;
constexpr int A_WINDOW = 128;
constexpr int B_WIN_H = 8, B_WIN_W = 16;
constexpr int HY_BANDS = 16, HY_EMB = 33, HY_FFN = 64;
constexpr int EVEN_IN = 2304, EVEN_OUT = 1024;
constexpr int ODD_IN = 768 + 3 * D_CH, ODD_OUT = 512 + D_CH;
constexpr int N_EXPERTS = 16;
constexpr int TX = BATCH * SEQ, TC = BATCH * CTX_LEN, TT = TX + TC;
constexpr int LKV = CTX_LEN + SEQ;
constexpr int NPAIR = 24;
constexpr int HE_W = 2 * D_EXPERT;
constexpr float EPS = 1e-6f;
constexpr float ATTN_SCALE = 0.125f;

typedef unsigned short bf16_t;
HD bf16_t f2bf(float f) { unsigned u; __builtin_memcpy(&u, &f, 4); u = (u + 0x7fffu + ((u >> 16) & 1u)) >> 16; return (bf16_t)u; }
HD float bf2f(bf16_t h) { unsigned u = ((unsigned)h) << 16; float f; __builtin_memcpy(&f, &u, 4); return f; }
HD float silu_f(float x) { return x / (1.0f + expf(-x)); }
HD float sigmoid_f(float x) { return 1.0f / (1.0f + expf(-x)); }

struct Params {
    const float *x, *c, *ctx, *c_ctx, *w_ada, *b_ada, *norm_g, *final_g, *w_in_even, *w_out_even, *a_sink, *b_rpb;
    const float *w_in_odd, *w_out_odd, *c_qnorm, *c_knorm, *hy_short_w, *hy_short_b, *hy_w1, *hy_b1, *hy_f1, *hy_w2;
    const float *hy_b2, *hy_f2, *hy_w3, *hy_b3, *hy_bias, *w_router, *b_router, *moe_wg, *moe_wu, *moe_wd;
    float* out;
    float* XC;
    float* mod;
    float* ropet;
    float* h1;
    float* h2;
    float* HFT;
    float* hnorm;
    bf16_t* hbuf;
    bf16_t *QA, *KA, *VAt, *QB, *KB, *VBt;
    bf16_t *QC, *KC, *VCt, *UT;
    bf16_t* Y;
    bf16_t* YHT;
    float* Z1;
    bf16_t* HE;
    int* cnt;
    int* list;
    float* tokw;
    bf16_t *Wt_in_even, *Wt_out_even, *Wt_in_odd, *Wt_out_odd, *Wt_gu, *Wt_d;
    unsigned* bar;
    int* rpair;
    int* bh;
};

#define GS_LOOP(i, n) for (long i = (long)blockIdx.x * blockDim.x + threadIdx.x; i < (long)(n); i += (long)gridDim.x * blockDim.x)

HD const float* xrow_in(const Params& p, int l, int row) {
    if (l == 0) return row < TX ? p.x + (size_t)row * D_MODEL : p.ctx + (size_t)(row - TX) * D_MODEL;
    return row < TX ? p.out + (size_t)row * D_MODEL : p.XC + (size_t)(row - TX) * D_MODEL;
}
HD float* xrow_cur(const Params& p, int row) { return row < TX ? p.out + (size_t)row * D_MODEL : p.XC + (size_t)(row - TX) * D_MODEL; }
HD int row_mod(int row) { return row < TX ? row / SEQ : BATCH; }
HD const float* modp(const Params& p, int l, int row, int which) { return p.mod + ((size_t)(l * (BATCH + 1) + row_mod(row)) * 6 + which) * D_MODEL; }

GLOBAL void nk_mod(Params p) {
    GS_LOOP(i, DEPTH * (BATCH + 1) * 6 * D_MODEL) {
        int j = i % (6 * D_MODEL); int r = (i / (6 * D_MODEL)) % (BATCH + 1); int l = i / (6 * D_MODEL * (BATCH + 1));
        const float* cv = r < BATCH ? p.c + r * D_MODEL : p.c_ctx;
        const float* w = p.w_ada + (size_t)l * D_MODEL * 6 * D_MODEL;
        float acc = 0.f;
        for (int k = 0; k < D_MODEL; ++k) acc += silu_f(cv[k]) * w[(size_t)k * 6 * D_MODEL + j];
        p.mod[i] = acc + p.b_ada[l * 6 * D_MODEL + j];
    }
}
HD void d_rope(const Params& p) {
    GS_LOOP(i, 64 * 16) {
        int pos = i / 16, k = i % 16;
        float inv = powf(10000.0f, -(float)(2 * k) / 32.0f);
        float a = (float)pos * inv;
        p.ropet[pos * 32 + k] = cosf(a); p.ropet[pos * 32 + 16 + k] = sinf(a);
    }
}
HD void d_hy_h1(const Params& p) {
    GS_LOOP(i, SEQ * HY_FFN) {
        int t = i / HY_FFN, k = i % HY_FFN;
        float tn = (float)t / (float)(SEQ - 1);
        float acc = tn * p.hy_w1[0 * HY_FFN + k];
        for (int b = 0; b < HY_BANDS; ++b) {
            float band = 1e-4f + (float)b * ((float)(HY_BANDS - 1) - 1e-4f) / (float)(HY_BANDS - 1);
            float ang = 2.0f * 3.14159265358979323846f * (float)t * band / (float)SEQ;
            acc += cosf(ang) * p.hy_w1[(1 + b) * HY_FFN + k] + sinf(ang) * p.hy_w1[(1 + HY_BANDS + b) * HY_FFN + k];
        }
        p.h1[i] = sinf(p.hy_f1[k] * (acc + p.hy_b1[k]));
    }
}
HD void d_hy_h2(const Params& p) {
    GS_LOOP(i, SEQ * HY_FFN) {
        int t = i / HY_FFN, j = i % HY_FFN;
        float acc = 0.f;
        for (int k = 0; k < HY_FFN; ++k) acc += p.h1[t * HY_FFN + k] * p.hy_w2[k * HY_FFN + j];
        p.h2[i] = sinf(p.hy_f2[j] * (acc + p.hy_b2[j]));
    }
}
HD float hy_decay(int t, int c) {
    const float mind = logf(1e-2f) / 1.5f, maxd = logf(1e-2f) / 0.3f;
    float delta = fabsf(mind + (float)c * (maxd - mind) / (float)(D_CH - 1));
    float tn = (float)t / (float)(SEQ - 1);
    return expf(-tn * delta);
}
GLOBAL void nk_hy_filt(Params p) {
    GS_LOOP(i, 4 * D_CH * SEQ) {
        int t = i % SEQ, col = i / SEQ, c = col % D_CH;
        float acc = p.hy_b3[col];
        for (int k = 0; k < HY_FFN; ++k) acc += p.h2[t * HY_FFN + k] * p.hy_w3[k * 4 * D_CH + col];
        p.HFT[i] = acc * hy_decay(t, c);
    }
}
GLOBAL void nk_hy_norm(Params p) {
    GS_LOOP(i, 2 * D_CH) {
        int o = i / D_CH, c = i % D_CH;
        float s = 0.f;
        for (int dir = 0; dir < 2; ++dir) { const float* h = p.HFT + (size_t)((dir * 2 + o) * D_CH + c) * SEQ; for (int t = 0; t < SEQ; ++t) s += fabsf(h[t]); }
        p.hnorm[i] = s + EPS;
    }
}
GLOBAL void nk_zero_cnt(Params p) { GS_LOOP(i, 64) p.cnt[i] = 0; }

GLOBAL void nk_norm(Params p, int l, int which, int nrows) {
    GS_LOOP(row, nrows) {
        const float* xr = which == 0 ? xrow_in(p, l, (int)row) : xrow_cur(p, (int)row);
        float ss = 0.f;
        for (int k = 0; k < D_MODEL; ++k) ss += xr[k] * xr[k];
        float rstd = 1.0f / sqrtf(ss / D_MODEL + EPS);
        const float* g = p.norm_g + (l * 2 + which) * D_MODEL;
        const float* sh = modp(p, l, (int)row, which * 3 + 0); const float* sc = modp(p, l, (int)row, which * 3 + 1);
        for (int k = 0; k < D_MODEL; ++k) p.hbuf[row * D_MODEL + k] = f2bf(xr[k] * rstd * g[k] * (1.0f + sc[k]) + sh[k]);
    }
}

HD float dot_row(const bf16_t* a, const float* W, int ldw, int col, int K) {
    float acc = 0.f;
    for (int k = 0; k < K; ++k) acc += bf2f(a[k]) * W[(size_t)k * ldw + col];
    return acc;
}
HD float rope_apply(const Params& p, float v, float partner, int d, int s) {
    int half = d >> 5, dd = d & 31, k = dd & 15;
    int pos = half == 0 ? s / GRID_W : s % GRID_W;
    float c = p.ropet[pos * 32 + k], sn = p.ropet[pos * 32 + 16 + k];
    return dd < 16 ? v * c - partner * sn : v * c + partner * sn;
}

GLOBAL void nk_inproj_even(Params p) {
    GS_LOOP(i, (long)TT * EVEN_IN) {
        int row = i / EVEN_IN, col = i % EVEN_IN;
        const bf16_t* a = p.hbuf + (size_t)row * D_MODEL;
        float v = dot_row(a, p.w_in_even, EVEN_IN, col, D_MODEL);
        bool lat = row < TX; int b = lat ? row / SEQ : (row - TX) / CTX_LEN; int s = lat ? row % SEQ : (row - TX) % CTX_LEN;
        int pos = lat ? CTX_LEN + s : s;
        if (col < 640) {
            int d = col & 63;
            if (lat) { int pc = (d & 31) < 16 ? col + 16 : col - 16; float pv = dot_row(a, p.w_in_even, EVEN_IN, pc, D_MODEL); v = rope_apply(p, v, pv, d, s); }
            if (col < 512) p.QA[(size_t)row * 512 + col] = f2bf(v);
            else { int h = (col - 512) >> 6; p.KA[((size_t)(b * 2 + h) * LKV + pos) * 64 + d] = f2bf(v); }
        } else if (col < 768) { int h = (col - 640) >> 6, d = col & 63; p.VAt[((size_t)(b * 2 + h) * 64 + d) * LKV + pos] = f2bf(v); }
        else if (col < 1280) p.QB[(size_t)row * 512 + (col - 768)] = f2bf(v);
        else if (col < 1792) { int h = (col - 1280) >> 6, d = col & 63; p.KB[((size_t)(b * 8 + h) * LKV + pos) * 64 + d] = f2bf(v); }
        else { int h = (col - 1792) >> 6, d = col & 63; p.VBt[((size_t)(b * 8 + h) * 64 + d) * LKV + pos] = f2bf(v); }
    }
}

struct OSM { float m, l; };
#define ATT_BEGIN() float q[64], acc[64]; for (int d = 0; d < 64; ++d) { q[d] = bf2f(qp[d]) * ATTN_SCALE; acc[d] = 0.f; } float m_ = -1e30f, l_ = 0.f;
#define ATT_KEY(Kp, Vt, key, bias) do { const bf16_t* kk_ = (Kp) + (size_t)(key) * 64; float s_ = (bias); for (int d = 0; d < 64; ++d) s_ += q[d] * bf2f(kk_[d]); \
    float mn_ = fmaxf(m_, s_); float f_ = expf(m_ - mn_), pe_ = expf(s_ - mn_); l_ = l_ * f_ + pe_; \
    for (int d = 0; d < 64; ++d) acc[d] = acc[d] * f_ + pe_ * bf2f((Vt)[(size_t)d * LKV + (key)]); m_ = mn_; } while (0)
#define ATT_SINK(sv) do { float s_ = (sv); float mn_ = fmaxf(m_, s_); float f_ = expf(m_ - mn_); l_ = l_ * f_ + expf(s_ - mn_); for (int d = 0; d < 64; ++d) acc[d] *= f_; m_ = mn_; } while (0)

GLOBAL void nk_attnA(Params p) {
    GS_LOOP(i, (long)TX * 8) {
        int h = i % 8, row = i / 8, b = row / SEQ, s = row % SEQ, kvh = h / 4;
        const bf16_t* qp = p.QA + (size_t)row * 512 + h * 64;
        const bf16_t* Kp = p.KA + (size_t)(b * 2 + kvh) * LKV * 64; const bf16_t* Vt = p.VAt + (size_t)(b * 2 + kvh) * 64 * LKV;
        ATT_BEGIN();
        for (int j = 0; j < CTX_LEN; ++j) ATT_KEY(Kp, Vt, j, 0.f);
        int lo = s - A_WINDOW < 0 ? 0 : s - A_WINDOW, hi = s + A_WINDOW > SEQ - 1 ? SEQ - 1 : s + A_WINDOW;
        for (int j = lo; j <= hi; ++j) ATT_KEY(Kp, Vt, CTX_LEN + j, 0.f);
        ATT_SINK(p.a_sink[h]);
        for (int d = 0; d < 64; ++d) p.Y[(size_t)row * 1024 + h * 64 + d] = f2bf(acc[d] / l_);
    }
}
GLOBAL void nk_attnB(Params p) {
    GS_LOOP(i, (long)TX * 8) {
        int h = i % 8, row = i / 8, b = row / SEQ, s = row % SEQ, r = s / GRID_W, cq = s % GRID_W;
        const bf16_t* qp = p.QB + (size_t)row * 512 + h * 64;
        const bf16_t* Kp = p.KB + (size_t)(b * 8 + h) * LKV * 64; const bf16_t* Vt = p.VBt + (size_t)(b * 8 + h) * 64 * LKV;
        ATT_BEGIN();
        for (int j = 0; j < CTX_LEN; ++j) ATT_KEY(Kp, Vt, j, 0.f);
        int kh = B_WIN_H < GRID_H ? B_WIN_H : GRID_H;
        int rs = r - kh / 2; if (rs < 0) rs = 0; if (rs > GRID_H - kh) rs = GRID_H - kh;
        int cs = cq - B_WIN_W / 2; if (cs < 0) cs = 0; if (cs > GRID_W - B_WIN_W) cs = GRID_W - B_WIN_W;
        for (int kr = rs; kr < rs + kh; ++kr)
            for (int kc = cs; kc < cs + B_WIN_W; ++kc) {
                int dr = kr - r, dc = kc - cq;
                float bias = p.b_rpb[(h * (2 * B_WIN_H - 1) + dr + B_WIN_H - 1) * (2 * B_WIN_W - 1) + dc + B_WIN_W - 1];
                ATT_KEY(Kp, Vt, CTX_LEN + kr * GRID_W + kc, bias);
            }
        for (int d = 0; d < 64; ++d) p.Y[(size_t)row * 1024 + 512 + h * 64 + d] = f2bf(acc[d] / l_);
    }
}
GLOBAL void nk_attn_ctx(Params p) {
    GS_LOOP(i, (long)TC * 16) {
        int hh = i % 16, rc = i / 16, ty = hh / 8, h = hh % 8, b = rc / CTX_LEN; int row = TX + rc;
        const bf16_t* qp = (ty == 0 ? p.QA : p.QB) + (size_t)row * 512 + h * 64;
        const bf16_t* Kp = ty == 0 ? p.KA + (size_t)(b * 2 + h / 4) * LKV * 64 : p.KB + (size_t)(b * 8 + h) * LKV * 64;
        const bf16_t* Vt = ty == 0 ? p.VAt + (size_t)(b * 2 + h / 4) * 64 * LKV : p.VBt + (size_t)(b * 8 + h) * 64 * LKV;
        ATT_BEGIN();
        for (int j = 0; j < CTX_LEN; ++j) ATT_KEY(Kp, Vt, j, 0.f);
        if (ty == 0) ATT_SINK(p.a_sink[h]);
        for (int d = 0; d < 64; ++d) p.Y[(size_t)row * 1024 + ty * 512 + h * 64 + d] = f2bf(acc[d] / l_);
    }
}
GLOBAL void nk_attnC(Params p) {
    GS_LOOP(i, (long)TX * 8) {
        int h = i % 8, row = i / 8, b = row / SEQ, kvh = h / 4;
        const bf16_t* qp = p.QC + (size_t)row * 512 + h * 64;
        const bf16_t* Kp = p.KC + (size_t)(b * 2 + kvh) * LKV * 64; const bf16_t* Vt = p.VCt + (size_t)(b * 2 + kvh) * 64 * LKV;
        ATT_BEGIN();
        for (int j = 0; j < LKV; ++j) ATT_KEY(Kp, Vt, j, 0.f);
        for (int d = 0; d < 64; ++d) p.Y[(size_t)row * 1024 + h * 64 + d] = f2bf(acc[d] / l_);
    }
}

GLOBAL void nk_outproj_even(Params p) {
    GS_LOOP(i, (long)TT * D_MODEL) {
        int row = i / D_MODEL, col = i % D_MODEL;
        float acc = dot_row(p.Y + (size_t)row * 1024, p.w_out_even, D_MODEL, col, EVEN_OUT);
        xrow_cur(p, row)[col] = xrow_in(p, 0, row)[col] + modp(p, 0, row, 2)[col] * acc;
    }
}
GLOBAL void nk_outproj_odd(Params p) {
    GS_LOOP(i, (long)TX * D_MODEL) {
        int row = i / D_MODEL, col = i % D_MODEL, b = row / SEQ, s = row % SEQ;
        float acc = dot_row(p.Y + (size_t)row * 1024, p.w_out_odd, D_MODEL, col, 512);
        for (int c = 0; c < D_CH; ++c) acc += bf2f(p.YHT[((size_t)b * D_CH + c) * SEQ + s]) * p.w_out_odd[(size_t)(512 + c) * D_MODEL + col];
        p.out[i] = p.out[i] + modp(p, 1, row, 2)[col] * acc;
    }
}

GLOBAL void nk_router(Params p, int l, int nrows) {
    GS_LOOP(row, nrows) {
        const float* xr = xrow_cur(p, (int)row);
        float ss = 0.f;
        for (int k = 0; k < D_MODEL; ++k) ss += xr[k] * xr[k];
        float rstd = 1.0f / sqrtf(ss / D_MODEL + EPS);
        const float* g = p.norm_g + (l * 2 + 1) * D_MODEL; const float* sh = modp(p, l, (int)row, 3); const float* sc = modp(p, l, (int)row, 4);
        float lg[16];
#pragma unroll
        for (int e = 0; e < 16; ++e) lg[e] = 0.f;
        for (int k = 0; k < D_MODEL; ++k) { float hv = xr[k] * rstd * g[k] * (1.0f + sc[k]) + sh[k];
#pragma unroll
            for (int e = 0; e < 16; ++e) lg[e] += hv * p.w_router[k * 16 + e]; }
        int gbest = 0, a = 0, bb = 1; float gbs = -1e30f, wa = 0.f, wb = 0.f;
#pragma unroll
        for (int gI = 0; gI < 4; ++gI) {
            float m1 = -1e30f, m2 = -1e30f, s1 = 0.f, s2 = 0.f; int i1 = 0, i2 = 0;
#pragma unroll
            for (int j = 0; j < 4; ++j) { float sgv = sigmoid_f(lg[gI * 4 + j]); float v = sgv + p.b_router[gI * 4 + j];
                if (v > m1) { m2 = m1; i2 = i1; s2 = s1; m1 = v; i1 = j; s1 = sgv; } else if (v > m2) { m2 = v; i2 = j; s2 = sgv; } }
            float gs = m1 + m2;
            if (gs > gbs) { gbs = gs; gbest = gI; if (i1 < i2) { a = i1; bb = i2; wa = s1; wb = s2; } else { a = i2; bb = i1; wa = s2; wb = s1; } }
        }
        float inv = 1.0f / (wa + wb);
        int pidx = a == 0 ? bb - 1 : (a == 1 ? bb + 1 : 5);
        int pr = gbest * 6 + pidx;
        int pos = atomicAdd(p.cnt + l * 32 + pr, 1);
        p.list[(size_t)pr * TT + pos] = (int)row;
        p.tokw[row * 2 + 0] = wa * inv; p.tokw[row * 2 + 1] = wb * inv;
    }
}
HD void pair_experts(int pr, int& e1, int& e2) { int g = pr / 6, q = pr % 6; int a = q < 3 ? 0 : (q < 5 ? 1 : 2); int b = q < 3 ? q + 1 : (q < 5 ? q - 1 : 3); e1 = g * 4 + a; e2 = g * 4 + b; }
HD bool slot_lookup(const Params& p, int l, int slot, int& pr, int& row) { int acc = 0; for (int q = 0; q < NPAIR; ++q) { int c = p.cnt[l * 32 + q]; if (slot < acc + c) { pr = q; row = p.list[(size_t)q * TT + (slot - acc)]; return true; } acc += c; } return false; }
GLOBAL void nk_moe_up(Params p, int l, int nrows) {
    GS_LOOP(i, (long)nrows * HE_W) {
        int slot = i / HE_W, j = i % HE_W, k = j / D_EXPERT, jj = j % D_EXPERT; int pr, row; if (!slot_lookup(p, l, slot, pr, row)) continue;
        int e1, e2; pair_experts(pr, e1, e2); int e = k == 0 ? e1 : e2;
        const bf16_t* a = p.hbuf + (size_t)row * D_MODEL;
        const float* wg = p.moe_wg + (size_t)(l * N_EXPERTS + e) * D_MODEL * D_EXPERT; const float* wu = p.moe_wu + (size_t)(l * N_EXPERTS + e) * D_MODEL * D_EXPERT;
        float g = dot_row(a, wg, D_EXPERT, jj, D_MODEL), u = dot_row(a, wu, D_EXPERT, jj, D_MODEL);
        p.HE[(size_t)row * HE_W + j] = f2bf(p.tokw[row * 2 + k] * silu_f(g) * u);
    }
}
GLOBAL void nk_moe_down(Params p, int l, int nrows) {
    GS_LOOP(i, (long)nrows * D_MODEL) {
        int slot = i / D_MODEL, col = i % D_MODEL; int pr, row; if (!slot_lookup(p, l, slot, pr, row)) continue;
        int e1, e2; pair_experts(pr, e1, e2);
        const bf16_t* a = p.HE + (size_t)row * HE_W;
        float acc = dot_row(a, p.moe_wd + (size_t)(l * N_EXPERTS + e1) * D_EXPERT * D_MODEL, D_MODEL, col, D_EXPERT)
                  + dot_row(a + D_EXPERT, p.moe_wd + (size_t)(l * N_EXPERTS + e2) * D_EXPERT * D_MODEL, D_MODEL, col, D_EXPERT);
        float* xr = xrow_cur(p, row);
        xr[col] = xr[col] + modp(p, l, row, 5)[col] * acc;
    }
}

GLOBAL void nk_inproj_odd_qk(Params p) {
    GS_LOOP(i, (long)TT * 10) {
        int row = i / 10, hu = i % 10; const bf16_t* a = p.hbuf + (size_t)row * D_MODEL;
        bool lat = row < TX; int b = lat ? row / SEQ : (row - TX) / CTX_LEN; int s = lat ? row % SEQ : (row - TX) % CTX_LEN; int pos = lat ? CTX_LEN + s : s;
        int col0 = hu * 64;
        float v[64]; float ss = 0.f;
        for (int d = 0; d < 64; ++d) { v[d] = dot_row(a, p.w_in_odd, ODD_IN, col0 + d, D_MODEL); ss += v[d] * v[d]; }
        float rstd = 1.0f / sqrtf(ss / 64.0f + EPS);
        const float* gn = hu < 8 ? p.c_qnorm : p.c_knorm;
        for (int d = 0; d < 64; ++d) v[d] = v[d] * rstd * gn[d];
        for (int d = 0; d < 64; ++d) {
            float o = v[d];
            if (lat) { int pd = (d & 31) < 16 ? d + 16 : d - 16; o = rope_apply(p, v[d], v[pd], d, s); }
            if (hu < 8) p.QC[(size_t)row * 512 + col0 + d] = f2bf(o);
            else p.KC[((size_t)(b * 2 + (hu - 8)) * LKV + pos) * 64 + d] = f2bf(o);
        }
    }
}
GLOBAL void nk_inproj_odd_vu(Params p) {
    GS_LOOP(i, (long)TT * (ODD_IN - 640)) {
        int row = i / (ODD_IN - 640), col = 640 + i % (ODD_IN - 640); const bf16_t* a = p.hbuf + (size_t)row * D_MODEL;
        bool lat = row < TX; int b = lat ? row / SEQ : (row - TX) / CTX_LEN; int s = lat ? row % SEQ : (row - TX) % CTX_LEN; int pos = lat ? CTX_LEN + s : s;
        if (col >= 768 && !lat) continue;
        float v = dot_row(a, p.w_in_odd, ODD_IN, col, D_MODEL);
        if (col < 768) { int h = (col - 640) >> 6, d = col & 63; p.VCt[((size_t)(b * 2 + h) * 64 + d) * LKV + pos] = f2bf(v); }
        else p.UT[((size_t)b * 3 * D_CH + (col - 768)) * SEQ + s] = f2bf(v);
    }
}

HD float hy_sc(const Params& p, int b, int ch, int t) {
    const bf16_t* u = p.UT + ((size_t)b * 3 * D_CH + ch) * SEQ;
    float acc = p.hy_short_b[ch];
    for (int kk = 0; kk < 3; ++kk) { int tt = t + kk - 1; if (tt >= 0 && tt < SEQ) acc += p.hy_short_w[kk * 3 * D_CH + ch] * bf2f(u[tt]); }
    return acc;
}
GLOBAL void nk_hy_conv(Params p, int o) {
    GS_LOOP(i, (long)BATCH * D_CH * SEQ) {
        int n = i % SEQ, c = (i / SEQ) % D_CH, b = i / ((long)SEQ * D_CH);
        const float* hf = p.HFT + (size_t)((0 * 2 + o) * D_CH + c) * SEQ; const float* hb = p.HFT + (size_t)((1 * 2 + o) * D_CH + c) * SEQ;
        float inv = 1.0f / p.hnorm[o * D_CH + c];
        float acc = 0.f;
        for (int m = 0; m < SEQ; ++m) {
            float z = o == 0 ? hy_sc(p, b, c, m) : p.Z1[((size_t)b * D_CH + c) * SEQ + m];
            int d = n - m; float hv = d >= 0 ? hf[d] : hb[-d];
            acc += hv * z;
        }
        acc *= inv;
        float zn = o == 0 ? hy_sc(p, b, c, n) : p.Z1[((size_t)b * D_CH + c) * SEQ + n];
        float g = hy_sc(p, b, (o + 1) * D_CH + c, n);
        float r = g * (acc + zn * p.hy_bias[o * D_CH + c]);
        if (o == 0) p.Z1[i] = r; else p.YHT[i] = f2bf(r);
    }
}

GLOBAL void nk_final(Params p) {
    GS_LOOP(row, TX) {
        float* xr = p.out + (size_t)row * D_MODEL; float ss = 0.f;
        for (int k = 0; k < D_MODEL; ++k) ss += xr[k] * xr[k];
        float rstd = 1.0f / sqrtf(ss / D_MODEL + EPS);
        for (int k = 0; k < D_MODEL; ++k) xr[k] = xr[k] * rstd * p.final_g[k];
    }
}
GLOBAL void nk_yht_to_y(Params p) {
    GS_LOOP(i, (long)TX * D_CH) { int row = i / D_CH, c = i % D_CH, b = row / SEQ, s = row % SEQ; p.Y[(size_t)row * 1024 + 512 + c] = p.YHT[((size_t)b * D_CH + c) * SEQ + s]; }
}

GLOBAL void nk_rope(Params p) { d_rope(p); }
GLOBAL void nk_hy_h1(Params p) { d_hy_h1(p); }
GLOBAL void nk_hy_h2(Params p) { d_hy_h2(p); }
static inline size_t al256(size_t x) { return (x + 255) & ~(size_t)255; }
static size_t setup_ws(Params& p, char* ws) {
    size_t o = 0;
    auto take = [&](size_t bytes) { char* r = ws + o; o += al256(bytes); return r; };
    p.bar = (unsigned*)take(64 * 1024);
    p.cnt = (int*)take(256);
    p.XC = (float*)take((size_t)TC * D_MODEL * 4);
    p.mod = (float*)take((size_t)DEPTH * (BATCH + 1) * 6 * D_MODEL * 4);
    p.ropet = (float*)take(64 * 32 * 4);
    p.h1 = (float*)take((size_t)SEQ * 64 * 4);
    p.h2 = (float*)take((size_t)SEQ * 64 * 4);
    p.HFT = (float*)take((size_t)4 * D_CH * SEQ * 4);
    p.hnorm = (float*)take(2 * D_CH * 4);
    p.list = (int*)take((size_t)NPAIR * TT * 4);
    p.tokw = (float*)take((size_t)TT * 2 * 4);
    p.rpair = (int*)take((size_t)TT * 4);
    p.bh = (int*)take((size_t)2048 * 32 * 4);
    size_t hb = (size_t)TT * D_MODEL * 2, z1 = (size_t)BATCH * D_CH * SEQ * 4;
    char* r0 = take(hb > z1 ? hb : z1); p.hbuf = (bf16_t*)r0; p.Z1 = (float*)r0;
    size_t q = al256((size_t)TT * 512 * 2), kva = al256((size_t)BATCH * 2 * LKV * 64 * 2), kvb = al256((size_t)BATCH * 8 * LKV * 64 * 2), ut = al256((size_t)BATCH * 3 * D_CH * SEQ * 2);
    size_t l0 = 2 * q + 2 * kva + 2 * kvb, l1 = q + 2 * kva + ut;
    char* R = take(l0 > l1 ? l0 : l1);
    p.QA = (bf16_t*)R; p.KA = (bf16_t*)(R + q); p.VAt = (bf16_t*)(R + q + kva); p.QB = (bf16_t*)(R + q + 2 * kva); p.KB = (bf16_t*)(R + 2 * q + 2 * kva); p.VBt = (bf16_t*)(R + 2 * q + 2 * kva + kvb);
    p.QC = (bf16_t*)R; p.KC = (bf16_t*)(R + q); p.VCt = (bf16_t*)(R + q + kva); p.UT = (bf16_t*)(R + q + 2 * kva);
    size_t yb = (size_t)TT * 1024 * 2, heb = (size_t)TT * HE_W * 2;
    char* r1 = take(yb > heb ? yb : heb); p.Y = (bf16_t*)r1; p.HE = (bf16_t*)r1;
    p.YHT = (bf16_t*)take((size_t)BATCH * D_CH * SEQ * 2);
    p.Wt_in_even = (bf16_t*)take((size_t)EVEN_IN * D_MODEL * 2);
    p.Wt_out_even = (bf16_t*)take((size_t)D_MODEL * EVEN_OUT * 2);
    p.Wt_in_odd = (bf16_t*)take((size_t)ODD_IN * D_MODEL * 2);
    p.Wt_out_odd = (bf16_t*)take((size_t)D_MODEL * ODD_OUT * 2);
    p.Wt_gu = (bf16_t*)take((size_t)DEPTH * N_EXPERTS * 2 * D_EXPERT * D_MODEL * 2);
    p.Wt_d = (bf16_t*)take((size_t)DEPTH * N_EXPERTS * D_MODEL * D_EXPERT * 2);
    return o;
}
static void fill_inputs(Params& p, void* const* d_in, void* d_out) {
    const float** f = (const float**)&p.x;
    for (int i = 0; i < 32; ++i) f[i] = (const float*)d_in[i];
    p.out = (float*)d_out;
}
#define LAS __attribute__((address_space(3)))
typedef short bf16x8 __attribute__((ext_vector_type(8)));
typedef float f32x4 __attribute__((ext_vector_type(4)));
typedef float f32x16 __attribute__((ext_vector_type(16)));
typedef unsigned u32x4 __attribute__((ext_vector_type(4)));
typedef unsigned u32x2 __attribute__((ext_vector_type(2)));

constexpr int NTHREADS = 256;
constexpr int LDS_BYTES = 69632;
constexpr int MT_ALL = TT / 128, MT_LAT = TX / 128;

__device__ __forceinline__ unsigned pk2bf(float lo, float hi) { return (unsigned)f2bf(lo) | ((unsigned)f2bf(hi) << 16); }
__device__ __forceinline__ float wave_sum(float v) {
#pragma unroll
    for (int o = 1; o < 64; o <<= 1) v += __shfl_xor(v, o);
    return v;
}

template <class DstF>
__device__ __forceinline__ void cvt_block_item(char* lds, const float* W, int N, int k0, int n0, const DstF& dst) {
    float* T = (float*)lds; const int tid = threadIdx.x;
    f32x4 v[16];
#pragma unroll
    for (int i = 0; i < 16; ++i) v[i] = *(const f32x4*)(W + (size_t)(k0 + (tid >> 6) + 4 * i) * N + n0 + 4 * (tid & 63));
#pragma unroll
    for (int i = 0; i < 16; ++i) *(f32x4*)(T + ((tid >> 6) + 4 * i) * 260 + 4 * (tid & 63)) = v[i];
    __syncthreads();
    bf16_t* d = dst(n0 + tid) + k0; const float* s = T + tid;
#pragma unroll
    for (int c = 0; c < 8; ++c) { u32x4 w; w.x = pk2bf(s[(8 * c + 0) * 260], s[(8 * c + 1) * 260]); w.y = pk2bf(s[(8 * c + 2) * 260], s[(8 * c + 3) * 260]);
        w.z = pk2bf(s[(8 * c + 4) * 260], s[(8 * c + 5) * 260]); w.w = pk2bf(s[(8 * c + 6) * 260], s[(8 * c + 7) * 260]); *(u32x4*)(d + 8 * c) = w; }
    __syncthreads();
}
__device__ __forceinline__ void cvt_plain(char* lds, const float* W, bf16_t* Wt, int K, int N, int item) {
    const int nb = N / 256, kb = item / nb, nbi = item % nb;
    cvt_block_item(lds, W, N, kb * 64, nbi * 256, [&](int n) { return Wt + (size_t)n * K; });
}
constexpr int CVT_IN = (D_MODEL / 64) * (EVEN_IN / 256), CVT_OUT = (D_MODEL / 64) * (D_MODEL / 256), CVT_GU1 = (D_MODEL / 64) * (D_EXPERT / 256), CVT_D1 = (D_EXPERT / 64) * (D_MODEL / 256);
constexpr int CVT_GU = DEPTH * N_EXPERTS * 2 * CVT_GU1, CVT_D = DEPTH * N_EXPERTS * CVT_D1;
constexpr int CVT_TOTAL = 2 * CVT_IN + 2 * CVT_OUT + CVT_GU + CVT_D;
constexpr int CVT_EARLY = 2 * CVT_IN + 2 * CVT_OUT;
static_assert(EVEN_IN % 256 == 0 && ODD_IN % 256 == 0 && D_EXPERT % 256 == 0, "conversion tile");
__device__ __forceinline__ void cvt_item(const Params& p, char* lds, int it) {
    if (it < CVT_IN) { cvt_plain(lds, p.w_in_even, p.Wt_in_even, D_MODEL, EVEN_IN, it); return; } it -= CVT_IN;
    if (it < CVT_IN) { cvt_plain(lds, p.w_in_odd, p.Wt_in_odd, D_MODEL, ODD_IN, it); return; } it -= CVT_IN;
    if (it < CVT_OUT) { cvt_plain(lds, p.w_out_even, p.Wt_out_even, EVEN_OUT, D_MODEL, it); return; } it -= CVT_OUT;
    if (it < CVT_OUT) { cvt_plain(lds, p.w_out_odd, p.Wt_out_odd, ODD_OUT, D_MODEL, it); return; } it -= CVT_OUT;
    if (it < CVT_GU) {
        const int le = it / (2 * CVT_GU1), r = it % (2 * CVT_GU1), half = r / CVT_GU1, r2 = r % CVT_GU1; const int nb = D_EXPERT / 256, kb = r2 / nb, nbi = r2 % nb;
        const float* W = (half ? p.moe_wu : p.moe_wg) + (size_t)le * D_MODEL * D_EXPERT; bf16_t* Wt = p.Wt_gu + (size_t)le * 2 * D_EXPERT * D_MODEL;
        cvt_block_item(lds, W, D_EXPERT, kb * 64, nbi * 256, [&](int n) { return Wt + (size_t)(32 * (n >> 4) + 16 * half + (n & 15)) * D_MODEL; });
        return; } it -= CVT_GU;
    { const int le = it / CVT_D1, r = it % CVT_D1; cvt_plain(lds, p.moe_wd + (size_t)le * D_EXPERT * D_MODEL, p.Wt_d + (size_t)le * D_MODEL * D_EXPERT, D_EXPERT, D_MODEL, r); }
}
__device__ __forceinline__ void cvt_range(const Params& p, char* lds, int lo, int hi, int bid, int nb) {
    for (int it = lo + bid; it < hi; it += nb) cvt_item(p, lds, it);
}

struct TileGeom { int tid, lane, wid, wr, wc, l15, q, srow, schunk;
    __device__ __forceinline__ int drow(int i) const { return wid * 32 + i * 8 + (lane >> 3); }
    __device__ __forceinline__ int dchunk(int i) const { return (lane & 7) ^ (((lane >> 4) + 4 * i) & 7); } };
__device__ __forceinline__ TileGeom tile_geom() { TileGeom g; g.tid = threadIdx.x; g.lane = g.tid & 63; g.wid = __builtin_amdgcn_readfirstlane(g.tid >> 6); g.wr = g.wid >> 1; g.wc = g.wid & 1; g.l15 = g.lane & 15; g.q = g.lane >> 4; g.srow = g.tid >> 3; g.schunk = g.tid & 7; return g; }

template <class ALoad, class BLoad>
__device__ __forceinline__ void gemm_mainloop(char* lds, const TileGeom& g, int nk, const ALoad& AL, const BLoad& BL, f32x4 (&acc)[4][4]) {
#pragma unroll
    for (int i = 0; i < 4; ++i)
#pragma unroll
        for (int j = 0; j < 4; ++j) acc[i][j] = (f32x4){0.f, 0.f, 0.f, 0.f};
    const int swz = g.l15 >> 1;
    const int aofs = (g.wr * 64 + g.l15) * 128 + ((g.q ^ swz) << 4);
    const int bofs = 32768 + (g.wc * 64 + g.l15) * 128 + ((g.q ^ swz) << 4);
    LAS char* l3 = (LAS char*)lds;
    const int dbase = g.wid * 4096;
#define GEMM_STAGE(kt_, buf_) do { _Pragma("unroll") for (int i_ = 0; i_ < 4; ++i_) { \
        __builtin_amdgcn_global_load_lds((const unsigned*)AL(i_, (kt_)), (LAS unsigned*)(l3 + (buf_) + dbase + i_ * 1024), 16, 0, 0); \
        __builtin_amdgcn_global_load_lds((const unsigned*)BL(i_, (kt_)), (LAS unsigned*)(l3 + 32768 + (buf_) + dbase + i_ * 1024), 16, 0, 0); } } while (0)
    GEMM_STAGE(0, 0);
    __syncthreads();
    for (int kt = 0; kt < nk; ++kt) {
        const int cur = (kt & 1) * 16384, nxt = 16384 - cur;
        if (kt + 1 < nk) GEMM_STAGE(kt + 1, nxt);
#pragma unroll
        for (int kk = 0; kk < 2; ++kk) {
            bf16x8 af[4], bfr[4];
#pragma unroll
            for (int i = 0; i < 4; ++i) { af[i] = *(const bf16x8*)(lds + cur + ((aofs + i * 2048) ^ (kk * 64))); bfr[i] = *(const bf16x8*)(lds + cur + ((bofs + i * 2048) ^ (kk * 64))); }
#pragma unroll
            for (int mi = 0; mi < 4; ++mi)
#pragma unroll
                for (int ni = 0; ni < 4; ++ni) acc[mi][ni] = __builtin_amdgcn_mfma_f32_16x16x32_bf16(bfr[ni], af[mi], acc[mi][ni], 0, 0, 0);
        }
        __syncthreads();
    }
#undef GEMM_STAGE
}

template <class DstF>
__device__ __forceinline__ void store_transposed(char* lds, const TileGeom& g, const f32x4 (&acc)[4][4], const DstF& dst) {
    bf16_t* T = (bf16_t*)lds;
#pragma unroll
    for (int mi = 0; mi < 4; ++mi)
#pragma unroll
        for (int ni = 0; ni < 4; ++ni)
#pragma unroll
            for (int r = 0; r < 4; ++r) T[(g.wc * 64 + ni * 16 + g.q * 4 + r) * 136 + g.wr * 64 + mi * 16 + g.l15] = f2bf(acc[mi][ni][r]);
    __syncthreads();
    { int col = g.tid >> 1, half = g.tid & 1; bf16_t* d = dst(col) + half * 64; const bf16_t* s = T + col * 136 + half * 64;
#pragma unroll
      for (int j = 0; j < 8; ++j) *(u32x4*)(d + j * 8) = *(const u32x4*)(s + j * 8); }
    __syncthreads();
}
__device__ __forceinline__ void store4bf(bf16_t* d, const f32x4& v) { u32x2 w; w.x = pk2bf(v[0], v[1]); w.y = pk2bf(v[2], v[3]); *(u32x2*)d = w; }
__device__ __forceinline__ void rope_head(const Params& p, f32x4 (&a)[4], int s, int q) {
    const int pr = s / GRID_W, pc = s % GRID_W;
    const f32x4 cr = *(const f32x4*)(p.ropet + pr * 32 + q * 4), sr = *(const f32x4*)(p.ropet + pr * 32 + 16 + q * 4);
    const f32x4 cc = *(const f32x4*)(p.ropet + pc * 32 + q * 4), sc = *(const f32x4*)(p.ropet + pc * 32 + 16 + q * 4);
    f32x4 x1 = a[0], x2 = a[1]; a[0] = x1 * cr - x2 * sr; a[1] = x2 * cr + x1 * sr;
    x1 = a[2]; x2 = a[3]; a[2] = x1 * cc - x2 * sc; a[3] = x2 * cc + x1 * sc;
}

template <int LAYER>
__device__ __forceinline__ void inproj_tile(const Params& p, char* lds, int mt, int nt) {
    const TileGeom g = tile_geom();
    const bf16_t* Abase = p.hbuf + (size_t)(mt * 128) * D_MODEL;
    const bf16_t* Bbase = (LAYER == 0 ? p.Wt_in_even : p.Wt_in_odd) + (size_t)(nt * 128) * D_MODEL;
    f32x4 acc[4][4];
    gemm_mainloop(lds, g, D_MODEL / 64, [&](int i, int kt) { return Abase + (size_t)g.drow(i) * D_MODEL + kt * 64 + g.dchunk(i) * 8; }, [&](int i, int kt) { return Bbase + (size_t)g.drow(i) * D_MODEL + kt * 64 + g.dchunk(i) * 8; }, acc);
    const bool lat = mt < MT_LAT; const int row0 = mt * 128;
    const int b = lat ? row0 / SEQ : (row0 - TX) / CTX_LEN, s0 = lat ? row0 % SEQ : (row0 - TX) % CTX_LEN, pos0 = lat ? CTX_LEN + s0 : s0;
    int kind;
    bf16_t* base; int h0 = 0, qcol0 = 0, nh = 2;
    if (LAYER == 0) {
        if (nt < 4) { kind = 0; base = p.QA; qcol0 = nt * 128; }
        else if (nt == 4) { kind = 1; base = p.KA; h0 = 0; nh = 2; }
        else if (nt == 5) { kind = 2; base = p.VAt; h0 = 0; nh = 2; }
        else if (nt < 10) { kind = 0; base = p.QB; qcol0 = (nt - 6) * 128; }
        else if (nt < 14) { kind = 1; base = p.KB; h0 = (nt - 10) * 2; nh = 8; }
        else { kind = 2; base = p.VBt; h0 = (nt - 14) * 2; nh = 8; }
    } else {
        if (nt < 4) { kind = 0; base = p.QC; qcol0 = nt * 128; }
        else if (nt == 4) { kind = 1; base = p.KC; h0 = 0; nh = 2; }
        else if (nt == 5) { kind = 2; base = p.VCt; h0 = 0; nh = 2; }
        else { kind = 3; base = p.UT; }
    }
    if (kind <= 1) {
        const bool rope = lat && (LAYER == 1 || nt <= 4);
#pragma unroll
        for (int mi = 0; mi < 4; ++mi) {
            const int rowl = g.wr * 64 + mi * 16 + g.l15;
            if (LAYER == 1) {
                float ss = 0.f;
#pragma unroll
                for (int ni = 0; ni < 4; ++ni) ss += acc[mi][ni][0] * acc[mi][ni][0] + acc[mi][ni][1] * acc[mi][ni][1] + acc[mi][ni][2] * acc[mi][ni][2] + acc[mi][ni][3] * acc[mi][ni][3];
                ss += __shfl_xor(ss, 16); ss += __shfl_xor(ss, 32);
                const float rstd = 1.0f / sqrtf(ss * (1.0f / 64.0f) + EPS);
                const float* gn = kind == 0 ? p.c_qnorm : p.c_knorm;
#pragma unroll
                for (int ni = 0; ni < 4; ++ni) acc[mi][ni] = acc[mi][ni] * rstd * *(const f32x4*)(gn + ni * 16 + g.q * 4);
            }
            if (rope) rope_head(p, acc[mi], s0 + rowl, g.q);
            bf16_t* d = kind == 0 ? base + (size_t)(row0 + rowl) * 512 + qcol0 + g.wc * 64 + g.q * 4
                                  : base + ((size_t)(b * nh + h0 + g.wc) * LKV + pos0 + rowl) * 64 + g.q * 4;
#pragma unroll
            for (int ni = 0; ni < 4; ++ni) store4bf(d + ni * 16, acc[mi][ni]);
        }
    } else if (kind == 2) {
        store_transposed(lds, g, acc, [&](int col) { return base + ((size_t)(b * nh + h0 + (col >> 6)) * 64 + (col & 63)) * LKV + pos0; });
    } else {
        store_transposed(lds, g, acc, [&](int col) { return base + ((size_t)b * 3 * D_CH + (nt - 6) * 128 + col) * SEQ + s0; });
    }
}
template <int LAYER>
__device__ __forceinline__ void ph_inproj(const Params& p, char* lds, int bid, int nb) {
    constexpr int NT = 18;
    if (LAYER == 0) { for (int t = bid; t < MT_ALL * NT; t += nb) inproj_tile<0>(p, lds, t / NT, t % NT); }
    else {
        const int n_lat = MT_LAT * NT, n_all = n_lat + (MT_ALL - MT_LAT) * 2;
        for (int t = bid; t < n_all; t += nb) { if (t < n_lat) inproj_tile<1>(p, lds, t / NT, t % NT); else { int u = t - n_lat; inproj_tile<1>(p, lds, MT_LAT + u / 2, 4 + u % 2); } }
    }
}

template <int LAYER>
__device__ __forceinline__ void outproj_tile(const Params& p, char* lds, int mt, int nt) {
    const TileGeom g = tile_geom();
    const bf16_t* Abase = p.Y + (size_t)(mt * 128) * 1024;
    const bf16_t* Bbase = (LAYER == 0 ? p.Wt_out_even : p.Wt_out_odd) + (size_t)(nt * 128) * 1024;
    f32x4 acc[4][4];
    gemm_mainloop(lds, g, 16, [&](int i, int kt) { return Abase + (size_t)g.drow(i) * 1024 + kt * 64 + g.dchunk(i) * 8; }, [&](int i, int kt) { return Bbase + (size_t)g.drow(i) * 1024 + kt * 64 + g.dchunk(i) * 8; }, acc);
    const int row0 = mt * 128;
#pragma unroll
    for (int mi = 0; mi < 4; ++mi) {
        const int row = row0 + g.wr * 64 + mi * 16 + g.l15;
        const float* xin = xrow_in(p, LAYER, row); float* xo = xrow_cur(p, row); const float* gate = modp(p, LAYER, row, 2);
#pragma unroll
        for (int ni = 0; ni < 4; ++ni) { const int col = nt * 128 + g.wc * 64 + ni * 16 + g.q * 4;
            *(f32x4*)(xo + col) = *(const f32x4*)(xin + col) + *(const f32x4*)(gate + col) * acc[mi][ni]; }
    }
}

template <int LAYER>
__device__ __forceinline__ void ph_outproj(const Params& p, char* lds, int bid, int nb) {
    const int nmt = LAYER == 0 ? MT_ALL : MT_LAT;
    for (int t = bid; t < nmt * 8; t += nb) outproj_tile<LAYER>(p, lds, t / 8, t % 8);
}

template <int NTN>
__device__ __forceinline__ bool moe_tile_lookup(const int* cnt, int t, int& pr, int& mt, int& nt, int& n) {
    int acc = 0;
    for (int q = 0; q < NPAIR; ++q) { const int c = cnt[q]; const int tiles = ((c + 127) >> 7) * NTN; if (t < acc + tiles) { pr = q; const int u = t - acc; mt = u / NTN; nt = u % NTN; n = c; return true; } acc += tiles; }
    return false;
}
__device__ __forceinline__ void moe_up_tile(const Params& p, char* lds, int l, int pr, int mt, int nt, int n) {
    const TileGeom g = tile_geom();
    int e1, e2; pair_experts(pr, e1, e2); const int k = nt >> 3, e = k ? e2 : e1;
    const int* lst = p.list + (size_t)pr * TT + mt * 128;
    const int navail = n - mt * 128;
    const bf16_t* arow[4];
#pragma unroll
    for (int i = 0; i < 4; ++i) { int r = g.drow(i); if (r >= navail) r = navail - 1; arow[i] = p.hbuf + (size_t)lst[r] * D_MODEL + g.dchunk(i) * 8; }
    const bf16_t* Bbase = p.Wt_gu + ((size_t)(l * N_EXPERTS + e) * 2 * D_EXPERT + (nt & 7) * 128) * D_MODEL;
    f32x4 acc[4][4];
    gemm_mainloop(lds, g, D_MODEL / 64, [&](int i, int kt) { return arow[i] + kt * 64; }, [&](int i, int kt) { return Bbase + (size_t)g.drow(i) * D_MODEL + kt * 64 + g.dchunk(i) * 8; }, acc);
#pragma unroll
    for (int mi = 0; mi < 4; ++mi) {
        const int rl = g.wr * 64 + mi * 16 + g.l15;
        if (rl < navail) {
            const int row = lst[rl]; const float w = p.tokw[row * 2 + k];
            bf16_t* d = p.HE + (size_t)row * HE_W + k * D_EXPERT + (nt & 7) * 64 + g.wc * 32 + g.q * 4;
#pragma unroll
            for (int h2 = 0; h2 < 2; ++h2) { f32x4 gg = acc[mi][2 * h2], uu = acc[mi][2 * h2 + 1], o;
#pragma unroll
                for (int r = 0; r < 4; ++r) o[r] = w * (gg[r] / (1.0f + __expf(-gg[r]))) * uu[r];
                store4bf(d + h2 * 16, o); }
        }
    }
}
template <bool DUMMY = false>
__device__ __forceinline__ void moe_down_tile(const Params& p, char* lds, int l, int pr, int mt, int nt, int n) {
    const TileGeom g = tile_geom();
    int e1, e2; pair_experts(pr, e1, e2);
    const int* lst = p.list + (size_t)pr * TT + mt * 128;
    const int navail = n - mt * 128;
    const bf16_t* arow[4];
#pragma unroll
    for (int i = 0; i < 4; ++i) { int r = g.drow(i); if (r >= navail) r = navail - 1; arow[i] = p.HE + (size_t)lst[r] * HE_W + g.dchunk(i) * 8; }
    const bf16_t* B1 = p.Wt_d + ((size_t)(l * N_EXPERTS + e1) * D_MODEL + nt * 128) * D_EXPERT;
    const bf16_t* B2 = p.Wt_d + ((size_t)(l * N_EXPERTS + e2) * D_MODEL + nt * 128) * D_EXPERT;
    constexpr int KT1 = D_EXPERT / 64;
    f32x4 acc[4][4];
    gemm_mainloop(lds, g, HE_W / 64, [&](int i, int kt) { return arow[i] + kt * 64; },
                  [&](int i, int kt) { return (kt < KT1 ? B1 + kt * 64 : B2 + (kt - KT1) * 64) + (size_t)g.drow(i) * D_EXPERT + g.dchunk(i) * 8; }, acc);
#pragma unroll
    for (int mi = 0; mi < 4; ++mi) {
        const int rl = g.wr * 64 + mi * 16 + g.l15;
        if (rl < navail) {
            const int row = lst[rl]; float* xo = xrow_cur(p, row); const float* gate = modp(p, l, row, 5);
#pragma unroll
            for (int ni = 0; ni < 4; ++ni) { const int col = nt * 128 + g.wc * 64 + ni * 16 + g.q * 4; float* dst = DUMMY ? (float*)p.QA + (size_t)row * D_MODEL : xo; *(f32x4*)(dst + col) = *(const f32x4*)(xo + col) + *(const f32x4*)(gate + col) * acc[mi][ni]; }
        }
    }
}
__device__ __forceinline__ void ph_moe_up(const Params& p, char* lds, int l, int bid, int nb) {
    int pr, mt, nt, n; for (int t = bid; moe_tile_lookup<16>(p.cnt + l * 32, t, pr, mt, nt, n); t += nb) moe_up_tile(p, lds, l, pr, mt, nt, n);
}
template <bool DUMMY = false>
__device__ __forceinline__ void ph_moe_down(const Params& p, char* lds, int l, int bid, int nb) {
    int pr, mt, nt, n; for (int t = bid; moe_tile_lookup<8>(p.cnt + l * 32, t, pr, mt, nt, n); t += nb) moe_down_tile<DUMMY>(p, lds, l, pr, mt, nt, n);
}
typedef float f32x2 __attribute__((ext_vector_type(2)));
typedef __bf16 bf16x2_t __attribute__((ext_vector_type(2)));
__device__ __forceinline__ unsigned cvtpk(float lo, float hi) { f32x2 v = {lo, hi}; bf16x2_t b = __builtin_convertvector(v, bf16x2_t); return __builtin_bit_cast(unsigned, b); }
__device__ __forceinline__ int crow(int r, int hi) { return (r & 3) + 8 * (r >> 2) + 4 * hi; }
constexpr float LOG2E = 1.4426950408889634f;
constexpr float QK_C = ATTN_SCALE * LOG2E;
constexpr float NEG_BIG = -1e30f;

template <int MODE>
__device__ __forceinline__ void attn_unit(char* lds, const bf16_t* Qp, const bf16_t* Kp, const bf16_t* Vt, bf16_t* Op, int s0, int nctx, int lt0, int nlat, float sink2, bool has_sink, const float* rpb_h) {
    const int tid = threadIdx.x, lane = tid & 63, wid = __builtin_amdgcn_readfirstlane(tid >> 6), l31 = lane & 31, hi = lane >> 5;
    float* bias_s = (float*)(lds + 32768);
    if (MODE == 2) { for (int i = tid; i < 15 * 31; i += NTHREADS) bias_s[i] = rpb_h[i] * LOG2E; }
    const int ntiles = nctx + nlat;
    const int srow0 = tid >> 3, schunk = tid & 7;
    const int swzw = (srow0 >> 1) & 7;
    const int wofs = srow0 * 128 + ((schunk ^ swzw) << 4);
    const bool vswap0 = (srow0 >> 4) & 1;
    const int x = (l31 >> 1) & 7;
    const int kofs = l31 * 128 + ((hi ^ x) << 4);
    const int vofs = 16384 + l31 * 128 + ((0 ^ x) << 4) + 8 * (hi ^ (l31 >> 4));
    bf16x8 qf[4];
    { const bf16_t* qr = Qp + (size_t)(wid * 32 + l31) * 512 + hi * 8;
#pragma unroll
      for (int s = 0; s < 4; ++s) qf[s] = *(const bf16x8*)(qr + s * 16); }
    auto tile_pos = [&](int j) { return j < nctx ? 64 * j : CTX_LEN + 64 * (lt0 + j - nctx); };
    u32x4 rk[2], rv[2];
    auto gload = [&](int j) { const int pos = tile_pos(j);
#pragma unroll
        for (int i = 0; i < 2; ++i) { rk[i] = *(const u32x4*)(Kp + (size_t)(pos + srow0 + 32 * i) * 64 + schunk * 8); rv[i] = *(const u32x4*)(Vt + (size_t)(srow0 + 32 * i) * LKV + pos + schunk * 8); } };
    auto lstore = [&](int buf) {
#pragma unroll
        for (int i = 0; i < 2; ++i) { *(u32x4*)(lds + buf * 8192 + wofs + i * 4096) = rk[i]; u32x4 v = rv[i]; if (vswap0) v = (u32x4){v.z, v.w, v.x, v.y}; *(u32x4*)(lds + 16384 + buf * 8192 + wofs + i * 4096) = v; } };
    f32x16 o0 = {}, o1 = {};
    float m = NEG_BIG, l = 0.f;
    const int sq = s0 + wid * 32 + l31;
    int rq = 0, cq = 0, rsq = 0, csq = 0;
    if (MODE == 2) { rq = sq / GRID_W; cq = sq % GRID_W; rsq = rq - B_WIN_H / 2; rsq = rsq < 0 ? 0 : (rsq > GRID_H - B_WIN_H ? GRID_H - B_WIN_H : rsq); csq = cq - B_WIN_W / 2; csq = csq < 0 ? 0 : (csq > GRID_W - B_WIN_W ? GRID_W - B_WIN_W : csq); }
    gload(0); lstore(0);
    __syncthreads();
    for (int j = 0; j < ntiles; ++j) {
        const int buf = j & 1; const bool more = j + 1 < ntiles;
        if (more) gload(j + 1);
        const char* Kb = lds + buf * 8192; const char* Vb = lds + buf * 8192;
        f32x16 p0 = {}, p1 = {};
#pragma unroll
        for (int s = 0; s < 4; ++s) {
            const bf16x8 k0 = *(const bf16x8*)(Kb + (kofs ^ (s << 5))); const bf16x8 k1 = *(const bf16x8*)(Kb + 4096 + (kofs ^ (s << 5)));
            p0 = __builtin_amdgcn_mfma_f32_32x32x16_bf16(k0, qf[s], p0, 0, 0, 0); p1 = __builtin_amdgcn_mfma_f32_32x32x16_bf16(k1, qf[s], p1, 0, 0, 0);
        }
        float tmax = NEG_BIG;
        if (MODE == 0 || j < nctx) {
#pragma unroll
            for (int r = 0; r < 16; ++r) { p0[r] *= QK_C; p1[r] *= QK_C; tmax = fmaxf(tmax, fmaxf(p0[r], p1[r])); }
        } else if (MODE == 1) {
            const int sk0 = 64 * (lt0 + j - nctx);
#pragma unroll
            for (int r = 0; r < 16; ++r) { const int d0 = sk0 + crow(r, hi) - sq, d1 = d0 + 32;
                p0[r] = (d0 >= -A_WINDOW && d0 <= A_WINDOW) ? p0[r] * QK_C : NEG_BIG; p1[r] = (d1 >= -A_WINDOW && d1 <= A_WINDOW) ? p1[r] * QK_C : NEG_BIG; tmax = fmaxf(tmax, fmaxf(p0[r], p1[r])); }
        } else {
            const int kr = lt0 + j - nctx; const bool rowok = kr >= rsq && kr < rsq + B_WIN_H;
            const float* brow = bias_s + (kr - rq + B_WIN_H - 1) * 31 + (B_WIN_W - 1) - cq;
#pragma unroll
            for (int r = 0; r < 16; ++r) { const int kc0 = crow(r, hi), kc1 = kc0 + 32;
                const bool ok0 = rowok && kc0 >= csq && kc0 < csq + B_WIN_W, ok1 = rowok && kc1 >= csq && kc1 < csq + B_WIN_W;
                p0[r] = ok0 ? p0[r] * QK_C + brow[kc0] : NEG_BIG; p1[r] = ok1 ? p1[r] * QK_C + brow[kc1] : NEG_BIG; tmax = fmaxf(tmax, fmaxf(p0[r], p1[r])); }
        }
        tmax = fmaxf(tmax, __shfl_xor(tmax, 32));
        const float mn = fmaxf(m, tmax), alpha = __builtin_amdgcn_exp2f(m - mn); m = mn;
        float ls = 0.f;
#pragma unroll
        for (int r = 0; r < 16; ++r) { p0[r] = __builtin_amdgcn_exp2f(p0[r] - mn); p1[r] = __builtin_amdgcn_exp2f(p1[r] - mn); ls += p0[r] + p1[r]; }
        l = l * alpha + ls;
#pragma unroll
        for (int r = 0; r < 16; ++r) { o0[r] *= alpha; o1[r] *= alpha; }
        bf16x8 pf[4];
        { u32x4 w;
          w.x = cvtpk(p0[0], p0[1]); w.y = cvtpk(p0[2], p0[3]); w.z = cvtpk(p0[4], p0[5]); w.w = cvtpk(p0[6], p0[7]); pf[0] = __builtin_bit_cast(bf16x8, w);
          w.x = cvtpk(p0[8], p0[9]); w.y = cvtpk(p0[10], p0[11]); w.z = cvtpk(p0[12], p0[13]); w.w = cvtpk(p0[14], p0[15]); pf[1] = __builtin_bit_cast(bf16x8, w);
          w.x = cvtpk(p1[0], p1[1]); w.y = cvtpk(p1[2], p1[3]); w.z = cvtpk(p1[4], p1[5]); w.w = cvtpk(p1[6], p1[7]); pf[2] = __builtin_bit_cast(bf16x8, w);
          w.x = cvtpk(p1[8], p1[9]); w.y = cvtpk(p1[10], p1[11]); w.z = cvtpk(p1[12], p1[13]); w.w = cvtpk(p1[14], p1[15]); pf[3] = __builtin_bit_cast(bf16x8, w); }
#pragma unroll
        for (int s = 0; s < 4; ++s) {
            const int a0 = vofs ^ (s << 5);
            u32x2 va = *(const u32x2*)(Vb + a0), vb = *(const u32x2*)(Vb + (a0 ^ 16));
            u32x2 vc = *(const u32x2*)(Vb + 4096 + a0), vd = *(const u32x2*)(Vb + 4096 + (a0 ^ 16));
            const bf16x8 f0 = __builtin_bit_cast(bf16x8, (u32x4){va.x, va.y, vb.x, vb.y}), f1 = __builtin_bit_cast(bf16x8, (u32x4){vc.x, vc.y, vd.x, vd.y});
            o0 = __builtin_amdgcn_mfma_f32_32x32x16_bf16(f0, pf[s], o0, 0, 0, 0); o1 = __builtin_amdgcn_mfma_f32_32x32x16_bf16(f1, pf[s], o1, 0, 0, 0);
        }
        if (more) lstore(buf ^ 1);
        __syncthreads();
    }
    l += __shfl_xor(l, 32);
    if (has_sink) l += __builtin_amdgcn_exp2f(sink2 - m);
    const float inv = 1.0f / l;
    bf16_t* orow = Op + (size_t)(wid * 32 + l31) * 1024;
#pragma unroll
    for (int g4 = 0; g4 < 4; ++g4) {
        u32x2 w; w.x = cvtpk(o0[g4 * 4 + 0] * inv, o0[g4 * 4 + 1] * inv); w.y = cvtpk(o0[g4 * 4 + 2] * inv, o0[g4 * 4 + 3] * inv); *(u32x2*)(orow + 8 * g4 + 4 * hi) = w;
        w.x = cvtpk(o1[g4 * 4 + 0] * inv, o1[g4 * 4 + 1] * inv); w.y = cvtpk(o1[g4 * 4 + 2] * inv, o1[g4 * 4 + 3] * inv); *(u32x2*)(orow + 32 + 8 * g4 + 4 * hi) = w;
    }
}

constexpr int NU_LAT = BATCH * 8 * (SEQ / 128);
constexpr int NU_CTX = BATCH * 8 * (CTX_LEN / 128);
__device__ __forceinline__ void ph_attn0(const Params& p, char* lds, int bid, int nb) {
    for (int u = bid; u < 2 * NU_LAT + 2 * NU_CTX; u += nb) {
        if (u < NU_LAT) {
            const int blk = u % (SEQ / 128), h = (u / (SEQ / 128)) % 8, b = u / (8 * (SEQ / 128)); const int s0 = blk * 128, r0 = s0 / GRID_W;
            int rs0 = r0 - 4; rs0 = rs0 < 0 ? 0 : (rs0 > GRID_H - 8 ? GRID_H - 8 : rs0); int rs1 = r0 + 1 - 4; rs1 = rs1 < 0 ? 0 : (rs1 > GRID_H - 8 ? GRID_H - 8 : rs1);
            attn_unit<2>(lds, p.QB + (size_t)(b * SEQ + s0) * 512 + h * 64, p.KB + (size_t)(b * 8 + h) * LKV * 64, p.VBt + (size_t)(b * 8 + h) * 64 * LKV,
                         p.Y + (size_t)(b * SEQ + s0) * 1024 + 512 + h * 64, s0, CTX_LEN / 64, rs0, rs1 + 8 - rs0, 0.f, false, p.b_rpb + h * 15 * 31);
        } else if (u < 2 * NU_LAT) {
            const int v = u - NU_LAT; const int blk = v % (SEQ / 128), h = (v / (SEQ / 128)) % 8, b = v / (8 * (SEQ / 128)); const int s0 = blk * 128;
            int t0 = (s0 - 128) / 64; if (t0 < 0) t0 = 0; int t1 = (s0 + 255) / 64; if (t1 > SEQ / 64 - 1) t1 = SEQ / 64 - 1;
            attn_unit<1>(lds, p.QA + (size_t)(b * SEQ + s0) * 512 + h * 64, p.KA + (size_t)(b * 2 + h / 4) * LKV * 64, p.VAt + (size_t)(b * 2 + h / 4) * 64 * LKV,
                         p.Y + (size_t)(b * SEQ + s0) * 1024 + h * 64, s0, CTX_LEN / 64, t0, t1 - t0 + 1, p.a_sink[h] * LOG2E, true, nullptr);
        } else {
            const int v = u - 2 * NU_LAT; const int ty = v / NU_CTX, w = v % NU_CTX; const int blk = w % (CTX_LEN / 128), h = (w / (CTX_LEN / 128)) % 8, b = w / (8 * (CTX_LEN / 128));
            const int row0 = TX + b * CTX_LEN + blk * 128;
            if (ty == 0) attn_unit<0>(lds, p.QA + (size_t)row0 * 512 + h * 64, p.KA + (size_t)(b * 2 + h / 4) * LKV * 64, p.VAt + (size_t)(b * 2 + h / 4) * 64 * LKV, p.Y + (size_t)row0 * 1024 + h * 64, 0, CTX_LEN / 64, 0, 0, p.a_sink[h] * LOG2E, true, nullptr);
            else attn_unit<0>(lds, p.QB + (size_t)row0 * 512 + h * 64, p.KB + (size_t)(b * 8 + h) * LKV * 64, p.VBt + (size_t)(b * 8 + h) * 64 * LKV, p.Y + (size_t)row0 * 1024 + 512 + h * 64, 0, CTX_LEN / 64, 0, 0, 0.f, false, nullptr);
        }
    }
}
__device__ __forceinline__ void ph_attnC(const Params& p, char* lds, int bid, int nb) {
    for (int u = bid; u < NU_LAT; u += nb) {
        const int blk = u % (SEQ / 128), h = (u / (SEQ / 128)) % 8, b = u / (8 * (SEQ / 128)); const int s0 = blk * 128;
        attn_unit<0>(lds, p.QC + (size_t)(b * SEQ + s0) * 512 + h * 64, p.KC + (size_t)(b * 2 + h / 4) * LKV * 64, p.VCt + (size_t)(b * 2 + h / 4) * 64 * LKV,
                     p.Y + (size_t)(b * SEQ + s0) * 1024 + h * 64, s0, CTX_LEN / 64, 0, SEQ / 64, 0.f, false, nullptr);
    }
}
#ifdef HY_TEST
#define HY_OUT(b, t, v) p.YHT[((size_t)(b) * D_CH + c) * SEQ + (t)] = f2bf(v)
#else
#define HY_OUT(b, t, v) p.Y[((size_t)(b) * SEQ + (t)) * 1024 + 512 + c] = f2bf(v)
#endif
#ifdef CPU_TEST
#define FOR_T for (int tid = 0; tid < 256; ++tid)
#define HSYNC
#define HST(t) st[t]
#define HY_DECL HySt* st = new HySt[256]
#define HY_FREE delete[] st
static inline void sincos_rev(float a, float& c, float& s) { c = cosf(6.283185307179586f * a); s = sinf(6.283185307179586f * a); }
#else
__device__ __forceinline__ int hy_launder(int v) { asm volatile("" : "+v"(v)); return v; }
#define FOR_T if (const int tid = hy_launder((int)threadIdx.x); true)
#define HSYNC __syncthreads()
#define HST(t) st
#define HY_DECL HySt st
#define HY_FREE
__device__ __forceinline__ void sincos_rev(float a, float& c, float& s) { c = __builtin_amdgcn_cosf(a); s = __builtin_amdgcn_sinf(a); }
#endif
constexpr int FN = 2 * SEQ;
constexpr int FPAD = FN + (FN >> 5);
#if !defined(SMALL_CFG)
static_assert(FN == 8192, "pass plan 8,8,8,16 is for N = 8192");
constexpr int R4 = 16;
constexpr int NS4 = 512;
#else
constexpr int R4 = 2;
constexpr int NS4 = 512;
#endif
constexpr int NB8 = FN / 8 / 256;
constexpr int NB4 = FN / R4 / 256;
constexpr int EPT = FN / 256;
struct HySt { float xr[EPT], xi[EPT], kr[EPT], ki[EPT]; };
HD int pidx(int i) { return i + (i >> 5); }

constexpr float W16C[8] = {1.0f, 0.9238795325112867f, 0.7071067811865476f, 0.3826834323650898f, 0.0f, -0.3826834323650898f, -0.7071067811865476f, -0.9238795325112867f};
constexpr float W16S[8] = {0.0f, -0.3826834323650898f, -0.7071067811865476f, -0.9238795325112867f, -1.0f, -0.9238795325112867f, -0.7071067811865476f, -0.3826834323650898f};
template <int R> HD void fft_reg(float* xr, float* xi) {
    constexpr int LG = R == 16 ? 4 : (R == 8 ? 3 : (R == 4 ? 2 : 1));
#pragma unroll
    for (int sg = 0; sg < LG; ++sg) {
        const int h = (R / 2) >> sg;
#pragma unroll
        for (int pr = 0; pr < R / 2; ++pr) {
            const int blk = (pr / h) * 2 * h, i = pr % h;
            const int a = blk + i, b = blk + i + h;
            const float ar = xr[a], ai = xi[a], br = xr[b], bi = xi[b];
            xr[a] = ar + br; xi[a] = ai + bi;
            const float tr = ar - br, ti = ai - bi;
            const int tw = i * (8 / h);
            if (tw == 0) { xr[b] = tr; xi[b] = ti; }
            else if (tw == 4) { xr[b] = ti; xi[b] = -tr; }
            else { const float c = W16C[tw & 7], s = W16S[tw & 7]; xr[b] = tr * c - ti * s; xi[b] = tr * s + ti * c; }
        }
    }
}
template <int R> HD constexpr int bitrev(int i) { int r = 0; for (int b = 1; b < R; b <<= 1) { r = (r << 1) | (i & 1); i >>= 1; } return r; }

template <int R, int NB, class In> HD void pass_load(int tid, HySt& s, const In& in) {
#pragma unroll
    for (int b = 0; b < NB; ++b)
#pragma unroll
        for (int r = 0; r < R; ++r) in(tid + 256 * b + (FN / R) * r, s.xr[b * R + r], s.xi[b * R + r]);
}
template <int R, int NB, class Out> HD void pass_compute(int tid, HySt& s, int Ns, const Out& out) {
#pragma unroll
    for (int b = 0; b < NB; ++b) {
        const int j = tid + 256 * b, k = j & (Ns - 1);
        float* xr = s.xr + b * R; float* xi = s.xi + b * R;
        if (Ns > 1) {
            float wc, ws; sincos_rev(-(float)k / (float)(Ns * R), wc, ws);
            float cr = wc, ci = ws;
#pragma unroll
            for (int r = 1; r < R; ++r) {
                const float vr = xr[r], vi = xi[r]; xr[r] = vr * cr - vi * ci; xi[r] = vr * ci + vi * cr;
                const float nr = cr * wc - ci * ws, ni = cr * ws + ci * wc; cr = nr; ci = ni;
            }
        }
        fft_reg<R>(xr, xi);
        const int j0 = (j - k) * R + k;
#pragma unroll
        for (int i = 0; i < R; ++i) out(j0 + bitrev<R>(i) * Ns, b, bitrev<R>(i), xr[i], xi[i]);
    }
}
struct LdsIn { const float* re; const float* im; HD void operator()(int idx, float& r, float& i) const { r = re[pidx(idx)]; i = im[pidx(idx)]; } };
struct LdsOut { float* re; float* im; HD void operator()(int idx, int, int, float r, float i) const { re[pidx(idx)] = r; im[pidx(idx)] = i; } };

HD float hy_sc_ut(const bf16_t* u, const float* sw3, float sb, int t) {
    float acc = sb;
    if (t > 0) acc += sw3[0] * bf2f(u[t - 1]);
    acc += sw3[1] * bf2f(u[t]);
    if (t < SEQ - 1) acc += sw3[2] * bf2f(u[t + 1]);
    return acc;
}

HD void hyena_channel(const Params& p, int c, float* lds) {
    HY_DECL;
    float* re = lds; float* im = lds + FPAD;
    const LdsIn lin{re, im}; const LdsOut lout{re, im};
    float nrm[2];
#pragma unroll
    for (int o = 0; o < 2; ++o) {
        const float* hf = p.HFT + (size_t)((0 * 2 + o) * D_CH + c) * SEQ; const float* hb = p.HFT + (size_t)((1 * 2 + o) * D_CH + c) * SEQ;
        FOR_T { float sacc = 0.f; for (int i = 0; i < SEQ / 256; ++i) sacc += fabsf(hf[tid + 256 * i]) + fabsf(hb[tid + 256 * i]); re[tid] = sacc; }
        HSYNC;
        { float tot = 0.f; for (int i = 0; i < 256; ++i) tot += re[i]; nrm[o] = tot + EPS; }
        HSYNC;
    }
    float sw[3][3], sbv[3];
#pragma unroll
    for (int q = 0; q < 3; ++q) { sbv[q] = p.hy_short_b[q * D_CH + c];
#pragma unroll
        for (int kk = 0; kk < 3; ++kk) sw[q][kk] = p.hy_short_w[kk * 3 * D_CH + q * D_CH + c]; }
#pragma unroll
    for (int o = 0; o < 2; ++o) {
        const float* hf = p.HFT + (size_t)((0 * 2 + o) * D_CH + c) * SEQ; const float* hb = p.HFT + (size_t)((1 * 2 + o) * D_CH + c) * SEQ;
        const float inv = 1.0f / nrm[o]; const float hbias = p.hy_bias[o * D_CH + c];
        FOR_T { pass_load<8, NB8>(tid, HST(tid), [&](int idx, float& r, float& i) __attribute__((always_inline)) { r = idx < SEQ ? hf[idx] * inv : (idx == SEQ ? 0.f : hb[FN - idx] * inv); i = 0.f; });
                pass_compute<8, NB8>(tid, HST(tid), 1, lout); }
        HSYNC;
        FOR_T { pass_load<8, NB8>(tid, HST(tid), lin); } HSYNC; FOR_T { pass_compute<8, NB8>(tid, HST(tid), 8, lout); } HSYNC;
        FOR_T { pass_load<8, NB8>(tid, HST(tid), lin); } HSYNC; FOR_T { pass_compute<8, NB8>(tid, HST(tid), 64, lout); } HSYNC;
        FOR_T { pass_load<R4, NB4>(tid, HST(tid), lin);
                HySt& s = HST(tid); pass_compute<R4, NB4>(tid, s, NS4, [&](int, int b, int rr, float r, float i) __attribute__((always_inline)) { s.kr[b + NB4 * rr] = r; s.ki[b + NB4 * rr] = i; }); }
        HSYNC;
        for (int bp = 0; bp < BATCH / 2; ++bp) {
            const int b0 = 2 * bp, b1 = 2 * bp + 1;
            const bf16_t* u0 = p.UT + ((size_t)b0 * 3 * D_CH + c) * SEQ; const bf16_t* u1 = p.UT + ((size_t)b1 * 3 * D_CH + c) * SEQ;
            const float* z0 = p.Z1 + ((size_t)b0 * D_CH + c) * SEQ; const float* z1 = p.Z1 + ((size_t)b1 * D_CH + c) * SEQ;
            auto zval = [&](int b, int t) __attribute__((always_inline)) { return o == 0 ? hy_sc_ut(b == b0 ? u0 : u1, sw[0], sbv[0], t) : (b == b0 ? z0 : z1)[t]; };
            FOR_T { pass_load<8, NB8>(tid, HST(tid), [&](int idx, float& r, float& i) __attribute__((always_inline)) { if (idx < SEQ) { r = zval(b0, idx); i = zval(b1, idx); } else { r = 0.f; i = 0.f; } });
                    pass_compute<8, NB8>(tid, HST(tid), 1, lout); }
            HSYNC;
            FOR_T { pass_load<8, NB8>(tid, HST(tid), lin); } HSYNC; FOR_T { pass_compute<8, NB8>(tid, HST(tid), 8, lout); } HSYNC;
            FOR_T { pass_load<8, NB8>(tid, HST(tid), lin); } HSYNC; FOR_T { pass_compute<8, NB8>(tid, HST(tid), 64, lout); } HSYNC;
            FOR_T { pass_load<R4, NB4>(tid, HST(tid), lin); } HSYNC;
            FOR_T { HySt& s = HST(tid); pass_compute<R4, NB4>(tid, s, NS4, [&](int idx, int b, int rr, float r, float i) __attribute__((always_inline)) { const float kr = s.kr[b + NB4 * rr], ki = s.ki[b + NB4 * rr];
                        re[pidx(idx)] = r * kr - i * ki; im[pidx(idx)] = -(r * ki + i * kr); }); }
            HSYNC;
            FOR_T { pass_load<8, NB8>(tid, HST(tid), lin); } HSYNC; FOR_T { pass_compute<8, NB8>(tid, HST(tid), 1, lout); } HSYNC;
            FOR_T { pass_load<8, NB8>(tid, HST(tid), lin); } HSYNC; FOR_T { pass_compute<8, NB8>(tid, HST(tid), 8, lout); } HSYNC;
            FOR_T { pass_load<8, NB8>(tid, HST(tid), lin); } HSYNC; FOR_T { pass_compute<8, NB8>(tid, HST(tid), 64, lout); } HSYNC;
            FOR_T { pass_load<R4, NB4>(tid, HST(tid), lin);
                    const bf16_t* g0 = p.UT + ((size_t)b0 * 3 * D_CH + (o + 1) * D_CH + c) * SEQ; const bf16_t* g1 = p.UT + ((size_t)b1 * 3 * D_CH + (o + 1) * D_CH + c) * SEQ;
                    pass_compute<R4, NB4>(tid, HST(tid), NS4, [&](int idx, int, int, float r, float i) __attribute__((always_inline)) {
                        if (idx < SEQ) {
                            const float y0 = r * (1.0f / FN), y1 = -i * (1.0f / FN);
                            const float zn0 = hy_sc_ut(g0, sw[o + 1], sbv[o + 1], idx) * (y0 + zval(b0, idx) * hbias);
                            const float zn1 = hy_sc_ut(g1, sw[o + 1], sbv[o + 1], idx) * (y1 + zval(b1, idx) * hbias);
                            if (o == 0) { p.Z1[((size_t)b0 * D_CH + c) * SEQ + idx] = zn0; p.Z1[((size_t)b1 * D_CH + c) * SEQ + idx] = zn1; }
                            else { HY_OUT(b0, idx, zn0); HY_OUT(b1, idx, zn1); }
                        } }); }
            HSYNC;
        }
    }
    HY_FREE;
}
constexpr int MOD_ITEMS = DEPTH * (6 * D_MODEL / 64);
__device__ __forceinline__ void mod_item(const Params& p, char* lds, int item) {
    float* sc = (float*)lds;
    float* red = sc + 5 * D_MODEL;
    const int tid = threadIdx.x, l = item / (6 * D_MODEL / 64), j0 = (item % (6 * D_MODEL / 64)) * 64;
    for (int i = tid; i < 5 * D_MODEL; i += NTHREADS) { const int r = i / D_MODEL, k = i % D_MODEL; const float v = r < BATCH ? p.c[r * D_MODEL + k] : p.c_ctx[k]; sc[i] = silu_f(v); }
    __syncthreads();
    const int col = tid & 63, kp = tid >> 6;
    const float* w = p.w_ada + ((size_t)l * D_MODEL + kp * 256) * 6 * D_MODEL + j0 + col;
    float a0 = 0.f, a1 = 0.f, a2 = 0.f, a3 = 0.f, a4 = 0.f;
#pragma unroll 8
    for (int k = 0; k < 256; ++k) { const float wv = w[(size_t)k * 6 * D_MODEL]; const int kk = kp * 256 + k;
        a0 += sc[kk] * wv; a1 += sc[D_MODEL + kk] * wv; a2 += sc[2 * D_MODEL + kk] * wv; a3 += sc[3 * D_MODEL + kk] * wv; a4 += sc[4 * D_MODEL + kk] * wv; }
    red[(kp * 5 + 0) * 64 + col] = a0; red[(kp * 5 + 1) * 64 + col] = a1; red[(kp * 5 + 2) * 64 + col] = a2; red[(kp * 5 + 3) * 64 + col] = a3; red[(kp * 5 + 4) * 64 + col] = a4;
    __syncthreads();
    for (int i = tid; i < 5 * 64; i += NTHREADS) { const int r = i / 64, cc = i % 64;
        const float v = red[(0 * 5 + r) * 64 + cc] + red[(1 * 5 + r) * 64 + cc] + red[(2 * 5 + r) * 64 + cc] + red[(3 * 5 + r) * 64 + cc];
        p.mod[((size_t)(l * (BATCH + 1) + r)) * 6 * D_MODEL + j0 + cc] = v + p.b_ada[l * 6 * D_MODEL + j0 + cc]; }
    __syncthreads();
}
constexpr int FILT_ITEMS = (SEQ / 256) * (4 * D_CH / 64);
__device__ __forceinline__ void filt_item(const Params& p, char* lds, int item) {
    float* ws = (float*)lds;
    const int tid = threadIdx.x, tb = item % (SEQ / 256), cb = item / (SEQ / 256); const int t = tb * 256 + tid, col0 = cb * 64;
#pragma unroll
    for (int i = 0; i < 16; ++i) { const int k = i * 4 + (tid >> 6), cc = tid & 63; ws[cc * 68 + k] = p.hy_w3[(size_t)k * 4 * D_CH + col0 + cc]; }
    f32x4 h[16];
#pragma unroll
    for (int i = 0; i < 16; ++i) h[i] = *(const f32x4*)(p.h2 + (size_t)t * HY_FFN + i * 4);
    __syncthreads();
    const float tn = (float)t / (float)(SEQ - 1);
    const float mind = logf(1e-2f) / 1.5f, maxd = logf(1e-2f) / 0.3f;
#pragma unroll 2
    for (int cc = 0; cc < 64; ++cc) {
        const int col = col0 + cc; const f32x4* w = (const f32x4*)(ws + cc * 68);
        float acc = p.hy_b3[col];
#pragma unroll
        for (int i = 0; i < 16; ++i) { const f32x4 wv = w[i]; acc += h[i][0] * wv[0] + h[i][1] * wv[1] + h[i][2] * wv[2] + h[i][3] * wv[3]; }
        const float delta = fabsf(mind + (float)(col % D_CH) * (maxd - mind) / (float)(D_CH - 1));
        p.HFT[(size_t)col * SEQ + t] = acc * expf(-tn * delta);
    }
    __syncthreads();
}
__device__ __forceinline__ void ph_norm(const Params& p, int l, int which, int nrows, int bid, int nb) {
    const int lane = threadIdx.x & 63, wid = threadIdx.x >> 6;
    for (int row = bid * 4 + wid; row < nrows; row += nb * 4) {
        const float* xr = which == 0 ? xrow_in(p, l, row) : xrow_cur(p, row);
        const float* g = p.norm_g + (l * 2 + which) * D_MODEL; const float* sh = modp(p, l, row, which * 3 + 0); const float* sc = modp(p, l, row, which * 3 + 1);
        f32x4 v[4]; float ss = 0.f;
#pragma unroll
        for (int j = 0; j < 4; ++j) { v[j] = *(const f32x4*)(xr + j * 256 + lane * 4); ss += v[j][0] * v[j][0] + v[j][1] * v[j][1] + v[j][2] * v[j][2] + v[j][3] * v[j][3]; }
        const float rstd = 1.0f / sqrtf(wave_sum(ss) * (1.0f / D_MODEL) + EPS);
#pragma unroll
        for (int j = 0; j < 4; ++j) { const int c = j * 256 + lane * 4; const f32x4 o = v[j] * rstd * *(const f32x4*)(g + c) * (*(const f32x4*)(sc + c) + 1.0f) + *(const f32x4*)(sh + c);
            store4bf(p.hbuf + (size_t)row * D_MODEL + c, o); }
    }
}
__device__ __forceinline__ void ph_route_a(const Params& p, char* lds, int l, int nrows, int bid, int nb) {
    const int lane = threadIdx.x & 63, wid = threadIdx.x >> 6;
    float* wr_s = (float*)lds; int* hist = (int*)(lds + 65536);
    for (int i = threadIdx.x; i < D_MODEL * 4; i += NTHREADS) { const int k = i >> 2, ch = i & 3; ((f32x4*)wr_s)[k * 4 + (ch ^ ((k >> 2) & 3))] = ((const f32x4*)p.w_router)[i]; }
    if (threadIdx.x < 32) hist[threadIdx.x] = 0;
    __syncthreads();
    const int sw = (lane >> 2) & 3;
    const float* g = p.norm_g + (l * 2 + 1) * D_MODEL;
    const int RPB = (nrows + nb - 1) / nb, r0 = bid * RPB;
    for (int j = wid; j < RPB; j += 4) {
        const int row = r0 + j; if (row >= nrows) break;
        const float* xr = xrow_cur(p, row); const float* sh = modp(p, l, row, 3); const float* sc = modp(p, l, row, 4);
        float v[16]; float ss = 0.f;
#pragma unroll
        for (int i = 0; i < 16; ++i) { v[i] = xr[lane + 64 * i]; ss += v[i] * v[i]; }
        const float rstd = 1.0f / sqrtf(wave_sum(ss) * (1.0f / D_MODEL) + EPS);
        float lg[16];
#pragma unroll
        for (int e = 0; e < 16; ++e) lg[e] = 0.f;
#pragma unroll
        for (int i = 0; i < 16; ++i) { const int k = lane + 64 * i; const float o = v[i] * rstd * g[k] * (sc[k] + 1.0f) + sh[k];
            p.hbuf[(size_t)row * D_MODEL + k] = f2bf(o);
            const f32x4* w4 = (const f32x4*)(wr_s + k * 16);
#pragma unroll
            for (int e4 = 0; e4 < 4; ++e4) { const f32x4 wv = w4[e4 ^ sw]; lg[e4 * 4 + 0] += o * wv[0]; lg[e4 * 4 + 1] += o * wv[1]; lg[e4 * 4 + 2] += o * wv[2]; lg[e4 * 4 + 3] += o * wv[3]; }
            if (i & 1) __builtin_amdgcn_sched_barrier(0); }
#pragma unroll
        for (int e = 0; e < 16; ++e) lg[e] = wave_sum(lg[e]);
        if (lane == 0) {
            int gbest = 0, a = 0, bb = 1; float gbs = -1e30f, wa = 0.f, wb = 0.f;
#pragma unroll
            for (int gI = 0; gI < 4; ++gI) {
                float m1 = -1e30f, m2 = -1e30f, s1 = 0.f, s2 = 0.f; int i1 = 0, i2 = 0;
#pragma unroll
                for (int jj = 0; jj < 4; ++jj) { float sgv = sigmoid_f(lg[gI * 4 + jj]); float vv = sgv + p.b_router[gI * 4 + jj];
                    if (vv > m1) { m2 = m1; i2 = i1; s2 = s1; m1 = vv; i1 = jj; s1 = sgv; } else if (vv > m2) { m2 = vv; i2 = jj; s2 = sgv; } }
                float gs = m1 + m2;
                if (gs > gbs) { gbs = gs; gbest = gI; if (i1 < i2) { a = i1; bb = i2; wa = s1; wb = s2; } else { a = i2; bb = i1; wa = s2; wb = s1; } }
            }
            const float inv = 1.0f / (wa + wb);
            const int pidx = a == 0 ? bb - 1 : (a == 1 ? bb + 1 : 5);
            const int pr = gbest * 6 + pidx;
            p.rpair[row] = pr; p.tokw[row * 2 + 0] = wa * inv; p.tokw[row * 2 + 1] = wb * inv;
            atomicAdd(&hist[pr], 1);
        }
    }
    __syncthreads();
    if (threadIdx.x < 32) p.bh[bid * 32 + threadIdx.x] = hist[threadIdx.x];
}
__device__ __forceinline__ void ph_route_b(const Params& p, char* lds, int l, int nrows, int bid, int nb) {
    int* sb = (int*)lds;
    const int t = threadIdx.x, pr = t & 31, part = t >> 5;
    { int s_before = 0, s_all = 0; const int b0 = (part * nb) >> 3, b1 = ((part + 1) * nb) >> 3;
      for (int b = b0; b < b1; ++b) { const int c = p.bh[b * 32 + pr]; s_all += c; if (b < bid) s_before += c; }
      sb[part * 32 + pr] = s_before; sb[256 + part * 32 + pr] = s_all; }
    __syncthreads();
    if (t < 32) { int a = 0, c = 0;
#pragma unroll
        for (int q = 0; q < 8; ++q) { a += sb[q * 32 + t]; c += sb[256 + q * 32 + t]; }
        sb[512 + t] = a; sb[544 + t] = c; if (bid == 0) p.cnt[l * 32 + t] = c; }
    const int RPB = (nrows + nb - 1) / nb, row = bid * RPB + t; const bool act = t < RPB && row < nrows;
    int myp = 0; if (act) { myp = p.rpair[row]; sb[576 + t] = myp; }
    __syncthreads();
    if (act) { int rank = 0; for (int j = 0; j < t; ++j) rank += (sb[576 + j] == myp) ? 1 : 0; p.list[(size_t)myp * TT + sb[512 + myp] + rank] = row; }
    __syncthreads();
}
__device__ __forceinline__ void ph_final(const Params& p, int bid, int nb) {
    const int lane = threadIdx.x & 63, wid = threadIdx.x >> 6;
    for (int row = bid * 4 + wid; row < TX; row += nb * 4) {
        float* xr = p.out + (size_t)row * D_MODEL;
        f32x4 v[4]; float ss = 0.f;
#pragma unroll
        for (int j = 0; j < 4; ++j) { v[j] = *(const f32x4*)(xr + j * 256 + lane * 4); ss += v[j][0] * v[j][0] + v[j][1] * v[j][1] + v[j][2] * v[j][2] + v[j][3] * v[j][3]; }
        const float rstd = 1.0f / sqrtf(wave_sum(ss) * (1.0f / D_MODEL) + EPS);
#pragma unroll
        for (int j = 0; j < 4; ++j) { const int c = j * 256 + lane * 4; *(f32x4*)(xr + c) = v[j] * rstd * *(const f32x4*)(p.final_g + c); }
    }
}

#define XB_TMO      128
#define XB_XCNT(j)  (256  + 64 * (j))
#define XB_XSUB(j)  (1280 + 64 * (j))
#define XB_XGEN(j)  (2304 + 64 * (j))
#define XB_TOP      3328
#define XB_TOPGEN   3392
#define XCD_BAR_WORDS 3456
#define XB_SPIN_CAP (1u << 20)
__device__ __forceinline__ unsigned xb_ld(unsigned* p)              { return __hip_atomic_load(p, __ATOMIC_RELAXED, __HIP_MEMORY_SCOPE_AGENT); }
__device__ __forceinline__ unsigned xb_add(unsigned* p, unsigned v) { return __hip_atomic_fetch_add(p, v, __ATOMIC_RELAXED, __HIP_MEMORY_SCOPE_AGENT); }
__device__ __forceinline__ unsigned xb_xcc_id() { return (unsigned)__builtin_amdgcn_s_getreg((3 << 11) | 20) & 0xFu; }
#define XB_SPIN(cond, bar) do { unsigned _sp = 0; while (cond) { __builtin_amdgcn_s_sleep(1); \
    if ((++_sp & 255u) == 0u) { if (xb_ld(&(bar)[XB_TMO])) break; if (_sp > XB_SPIN_CAP) { atomicAdd(&(bar)[XB_TMO], 1u); break; } } } } while (0)
struct XcdBarrier { unsigned* bar; unsigned x; volatile LAS unsigned* st; };
__device__ __forceinline__ XcdBarrier xcd_barrier_post(unsigned* bar, volatile LAS unsigned* st) {
    XcdBarrier b; b.bar = bar; b.x = xb_xcc_id(); b.st = st;
    if (threadIdx.x == 0) (void)xb_add(&bar[XB_XCNT(b.x)], 1u);
    return b;
}
__device__ __forceinline__ void xcd_barrier_complete(unsigned* bar, unsigned x, unsigned& nloc, unsigned& nx) {
    const unsigned G = gridDim.x * gridDim.y * gridDim.z;
    unsigned sum, cnt, mine, sp = 0u;
    for (;;) {
        sum = 0u; cnt = 0u; mine = 0u;
#pragma unroll
        for (unsigned j = 0; j < 16; ++j) { const unsigned c = xb_ld(&bar[XB_XCNT(j)]); sum += c; cnt += (c > 0u) ? 1u : 0u; mine = (j == x) ? c : mine; }
        if (sum == G) break;
        __builtin_amdgcn_s_sleep(1);
        if ((++sp & 255u) == 0u) { if (xb_ld(&bar[XB_TMO])) break; if (sp > XB_SPIN_CAP) { atomicAdd(&bar[XB_TMO], 1u); break; } }
    }
    nloc = mine > 0u ? mine : 1u; nx = cnt > 0u ? cnt : 1u;
}
__device__ __forceinline__ void xcd_barrier(const XcdBarrier& b) {
    asm volatile("s_waitcnt vmcnt(0)" ::: "memory");
    __syncthreads();
    if (threadIdx.x == 0) {
        unsigned* bar = b.bar;
        __builtin_amdgcn_s_waitcnt(0);
        unsigned nloc = b.st[0], nx = b.st[1];
        if (nloc == 0u) { xcd_barrier_complete(bar, b.x, nloc, nx); b.st[0] = nloc; b.st[1] = nx; }
        const unsigned old = xb_add(&bar[XB_XSUB(b.x)], 1u);
        const unsigned gen = old / nloc;
        if (old + 1u == (gen + 1u) * nloc) {
            __builtin_amdgcn_fence(__ATOMIC_RELEASE, "agent");
            asm volatile("s_waitcnt vmcnt(0)" ::: "memory");
            const unsigned og = xb_add(&bar[XB_TOP], 1u);
            const unsigned tg = og / nx;
            if (og + 1u == (tg + 1u) * nx) xb_add(&bar[XB_TOPGEN], 1u);
            else XB_SPIN(xb_ld(&bar[XB_TOPGEN]) == tg, bar);
            __builtin_amdgcn_fence(__ATOMIC_ACQUIRE, "agent");
            xb_add(&bar[XB_XGEN(b.x)], 1u);
            asm volatile("s_waitcnt vmcnt(0)" ::: "memory");
        } else {
            XB_SPIN(xb_ld(&bar[XB_XGEN(b.x)]) == gen, bar);
            __builtin_amdgcn_fence(__ATOMIC_ACQUIRE, "agent");
            asm volatile("s_waitcnt vmcnt(0)" ::: "memory");
        }
    }
    __syncthreads();
}

__device__ __forceinline__ void ph_mix1(const Params& p, char* lds, int bid, int nb) {
    for (int u = bid; u < NU_LAT + D_CH; u += nb) {
        if (u < NU_LAT) { const int blk = u % (SEQ / 128), h = (u / (SEQ / 128)) % 8, b = u / (8 * (SEQ / 128)); const int s0 = blk * 128;
            attn_unit<0>(lds, p.QC + (size_t)(b * SEQ + s0) * 512 + h * 64, p.KC + (size_t)(b * 2 + h / 4) * LKV * 64, p.VCt + (size_t)(b * 2 + h / 4) * 64 * LKV,
                         p.Y + (size_t)(b * SEQ + s0) * 1024 + h * 64, s0, CTX_LEN / 64, 0, SEQ / 64, 0.f, false, nullptr); }
        else hyena_channel(p, u - NU_LAT, (float*)lds);
    }
}
#ifndef PROBE
#define PROBE 0
#endif
enum { PH_PREP = 0, PH_NORM0, PH_INPROJ0, PH_ATTN0, PH_OUT0, PH_ROUTE0, PH_ROUTEB0, PH_UP0, PH_DOWN0, PH_NORM1, PH_INPROJ1, PH_MIX1, PH_OUT1, PH_ROUTE1, PH_ROUTEB1, PH_UP1, PH_DOWN1, PH_FINAL, PH_COUNT };
__global__ void __launch_bounds__(NTHREADS, 2) mega(Params p, int lo, int hi) {
    extern __shared__ __attribute__((aligned(16))) char lds[];
    const int bid = blockIdx.x, nb = gridDim.x;
    volatile LAS unsigned* st = (volatile LAS unsigned*)(lds + LDS_BYTES - 16);
    if (threadIdx.x < 4) st[threadIdx.x] = 0u;
    __syncthreads();
    XcdBarrier bar; bar.bar = p.bar; bar.x = 0; bar.st = st;
    if (hi - lo > 1) bar = xcd_barrier_post(p.bar, st);
#ifdef PROBE_PA
    unsigned long long ts_prev = __builtin_amdgcn_s_memrealtime(), t_a = 0, t_b = 0;
#define STAMP(PH) if (bid == 0 && threadIdx.x == 0) { const unsigned long long now_ = __builtin_amdgcn_s_memrealtime(); if ((PH) == PROBE_PA) t_a = now_ - ts_prev; if ((PH) == PROBE_PB) t_b = now_ - ts_prev; ts_prev = now_; }
#else
#define STAMP(PH)
#endif
#define PHASE(PH, body) if (lo <= (PH) && (PH) < hi) { body; if ((PH) + 1 < hi) xcd_barrier(bar); STAMP(PH) }
    PHASE(PH_PREP, { for (int it = bid; it < MOD_ITEMS; it += nb) mod_item(p, lds, it); cvt_range(p, lds, 0, CVT_EARLY, bid, nb); d_rope(p); d_hy_h1(p); })
#if PROBE == 7
    PHASE(PH_NORM0, { ph_norm(p, 0, 0, TT, bid, nb); ph_norm(p, 0, 0, TT, bid, nb); ph_norm(p, 0, 0, TT, bid, nb); d_hy_h2(p); })
#else
    PHASE(PH_NORM0, { ph_norm(p, 0, 0, TT, bid, nb); d_hy_h2(p); })
#endif
#if PROBE == 1
    PHASE(PH_INPROJ0, { ph_inproj<0>(p, lds, bid, nb); __syncthreads(); ph_inproj<0>(p, lds, bid, nb); for (int it = bid; it < FILT_ITEMS; it += nb) filt_item(p, lds, it); })
#else
    PHASE(PH_INPROJ0, { ph_inproj<0>(p, lds, bid, nb); for (int it = bid; it < FILT_ITEMS; it += nb) filt_item(p, lds, it); })
#endif
#if PROBE == 2
    PHASE(PH_ATTN0, { ph_attn0(p, lds, bid, nb); __syncthreads(); ph_attn0(p, lds, bid, nb); })
#else
    PHASE(PH_ATTN0, { if (bid & 1) { cvt_range(p, lds, CVT_EARLY, CVT_TOTAL, bid, nb); __syncthreads(); ph_attn0(p, lds, bid, nb); } else { ph_attn0(p, lds, bid, nb); __syncthreads(); cvt_range(p, lds, CVT_EARLY, CVT_TOTAL, bid, nb); } })
#endif
#if PROBE == 10
    PHASE(PH_OUT0, { ph_outproj<0>(p, lds, bid, nb); __syncthreads(); ph_outproj<0>(p, lds, bid, nb); })
#elif PROBE == 11
    PHASE(PH_OUT0, { for (int i_ = 0; i_ < 10; ++i_) xcd_barrier(bar); ph_outproj<0>(p, lds, bid, nb); })
#else
    PHASE(PH_OUT0, ph_outproj<0>(p, lds, bid, nb))
#endif
    PHASE(PH_ROUTE0, ph_route_a(p, lds, 0, TT, bid, nb))
    PHASE(PH_ROUTEB0, ph_route_b(p, lds, 0, TT, bid, nb))
#if PROBE == 9
    PHASE(PH_UP0, { ph_moe_up(p, lds, 0, bid, nb); __syncthreads(); ph_moe_up(p, lds, 0, bid, nb); })
#else
    PHASE(PH_UP0, ph_moe_up(p, lds, 0, bid, nb))
#endif
#if PROBE == 12
    PHASE(PH_DOWN0, { ph_moe_down<true>(p, lds, 0, bid, nb); __syncthreads(); ph_moe_down(p, lds, 0, bid, nb); })
#else
    PHASE(PH_DOWN0, ph_moe_down(p, lds, 0, bid, nb))
#endif
    PHASE(PH_NORM1, ph_norm(p, 1, 0, TT, bid, nb))
    PHASE(PH_INPROJ1, ph_inproj<1>(p, lds, bid, nb))
#if PROBE == 3
    PHASE(PH_MIX1, { ph_attnC(p, lds, bid, nb); __syncthreads(); ph_mix1(p, lds, bid, nb); })
#elif PROBE == 4
    PHASE(PH_MIX1, { for (int c = bid; c < D_CH; c += nb) hyena_channel(p, c, (float*)lds); __syncthreads(); ph_mix1(p, lds, bid, nb); })
#else
    PHASE(PH_MIX1, ph_mix1(p, lds, bid, nb))
#endif
    PHASE(PH_OUT1, ph_outproj<1>(p, lds, bid, nb))
    PHASE(PH_ROUTE1, ph_route_a(p, lds, 1, TX, bid, nb))
    PHASE(PH_ROUTEB1, ph_route_b(p, lds, 1, TX, bid, nb))
    PHASE(PH_UP1, ph_moe_up(p, lds, 1, bid, nb))
    PHASE(PH_DOWN1, ph_moe_down(p, lds, 1, bid, nb))
    PHASE(PH_FINAL, ph_final(p, bid, nb))
#ifdef PROBE_PA
    if (bid == 0 && threadIdx.x == 0) {
        const unsigned long long delay = 2 * t_a + 204800ull * ((t_b + 200) / 400); const unsigned long long t0 = __builtin_amdgcn_s_memrealtime();
        while (__builtin_amdgcn_s_memrealtime() - t0 < delay) __builtin_amdgcn_s_sleep(32);
    }
#endif
}
extern "C" void kernel_launch(void* const* d_in, const int* in_sizes, int n_in, void* d_out, int out_size, void* d_ws, size_t ws_size, hipStream_t stream) {
    static int grid = 0;
    if (grid == 0) {
        int dev = 0, cus = 0;
        if (hipGetDevice(&dev) != hipSuccess || hipDeviceGetAttribute(&cus, hipDeviceAttributeMultiprocessorCount, dev) != hipSuccess) { fprintf(stderr, "kernel_launch: device query failed\n"); grid = -1; return; }
        if (hipFuncSetAttribute((const void*)mega, hipFuncAttributeMaxDynamicSharedMemorySize, LDS_BYTES) != hipSuccess) { fprintf(stderr, "kernel_launch: hipFuncSetAttribute failed\n"); grid = -1; return; }
        grid = 2 * cus;
    }
    if (grid < 0) return;
    Params p{};
    size_t need = setup_ws(p, (char*)d_ws);
    if (n_in != 32 || need > ws_size || out_size != TX * D_MODEL) { fprintf(stderr, "kernel_launch: bad config n_in %d ws %zu need %zu out %d\n", n_in, ws_size, need, out_size); return; }
    fill_inputs(p, d_in, d_out);
    hipMemsetAsync(p.bar, 0, 64 * 1024 + 256, stream);
#ifdef PER_PHASE
    for (int ph = 0; ph < PH_COUNT; ++ph) mega<<<dim3(grid), dim3(NTHREADS), LDS_BYTES, stream>>>(p, ph, ph + 1);
#else
    mega<<<dim3(grid), dim3(NTHREADS), LDS_BYTES, stream>>>(p, 0, PH_COUNT);
#endif
}
```

```cpp
#include <hip/hip_runtime.h>
#include <cstdio>
#include <math.h>
#include <stdint.h>
#include <string.h>

#ifdef CPU_TEST
#define HD
#define GLOBAL
struct U3 { unsigned x, y, z; };
static thread_local U3 threadIdx, blockIdx, blockDim, gridDim;
static inline int atomicAdd(int* p, int v) { return __sync_fetch_and_add(p, v); }
#else
#define HD __device__ __forceinline__
#define GLOBAL __global__ __launch_bounds__(256)
#endif

#if defined(HY_TEST)
constexpr int D_MODEL = 64, BATCH = 2, SEQ = 4096, GRID_W = 64, CTX_LEN = 64, D_CH = 4, D_EXPERT = 64;
#elif defined(SMALL_CFG)
constexpr int D_MODEL = 128, BATCH = 2, SEQ = 512, GRID_W = 32, CTX_LEN = 64, D_CH = 32, D_EXPERT = 64;
#else
constexpr int D_MODEL = 1024, BATCH = 4, SEQ = 4096, GRID_W = 64, CTX_LEN = 256, D_CH = 512, D_EXPERT = 512;
#endif
constexpr int DEPTH = 2, HEAD_DIM = 64;
constexpr int GRID_H = SEQ / GRID_W;
constexpr int A_WINDOW = 128;
constexpr int B_WIN_H = 8, B_WIN_W = 16;
constexpr int HY_BANDS = 16, HY_EMB = 33, HY_FFN = 64;
constexpr int EVEN_IN = 2304, EVEN_OUT = 1024;
constexpr int ODD_IN = 768 + 3 * D_CH, ODD_OUT = 512 + D_CH;
constexpr int N_EXPERTS = 16;
constexpr int TX = BATCH * SEQ, TC = BATCH * CTX_LEN, TT = TX + TC;
constexpr int LKV = CTX_LEN + SEQ;
constexpr int NPAIR = 24;
constexpr int HE_W = 2 * D_EXPERT;
constexpr float EPS = 1e-6f;
constexpr float ATTN_SCALE = 0.125f;

typedef unsigned short bf16_t;
HD bf16_t f2bf(float f) { unsigned u; __builtin_memcpy(&u, &f, 4); u = (u + 0x7fffu + ((u >> 16) & 1u)) >> 16; return (bf16_t)u; }
HD float bf2f(bf16_t h) { unsigned u = ((unsigned)h) << 16; float f; __builtin_memcpy(&f, &u, 4); return f; }
HD float silu_f(float x) { return x / (1.0f + expf(-x)); }
HD float sigmoid_f(float x) { return 1.0f / (1.0f + expf(-x)); }

struct Params {
    const float *x, *c, *ctx, *c_ctx, *w_ada, *b_ada, *norm_g, *final_g, *w_in_even, *w_out_even, *a_sink, *b_rpb;
    const float *w_in_odd, *w_out_odd, *c_qnorm, *c_knorm, *hy_short_w, *hy_short_b, *hy_w1, *hy_b1, *hy_f1, *hy_w2;
    const float *hy_b2, *hy_f2, *hy_w3, *hy_b3, *hy_bias, *w_router, *b_router, *moe_wg, *moe_wu, *moe_wd;
    float* out;
    float* XC;
    float* mod;
    float* ropet;
    float* h1;
    float* h2;
    float* HFT;
    float* hnorm;
    bf16_t* hbuf;
    bf16_t *QA, *KA, *VAt, *QB, *KB, *VBt;
    bf16_t *QC, *KC, *VCt, *UT;
    bf16_t* Y;
    bf16_t* YHT;
    float* Z1;
    bf16_t* HE;
    int* cnt;
    int* list;
    float* tokw;
    bf16_t *Wt_in_even, *Wt_out_even, *Wt_in_odd, *Wt_out_odd, *Wt_gu, *Wt_d;
    unsigned* bar;
    int* rpair;
    int* bh;
};

#define GS_LOOP(i, n) for (long i = (long)blockIdx.x * blockDim.x + threadIdx.x; i < (long)(n); i += (long)gridDim.x * blockDim.x)

HD const float* xrow_in(const Params& p, int l, int row) {
    if (l == 0) return row < TX ? p.x + (size_t)row * D_MODEL : p.ctx + (size_t)(row - TX) * D_MODEL;
    return row < TX ? p.out + (size_t)row * D_MODEL : p.XC + (size_t)(row - TX) * D_MODEL;
}
HD float* xrow_cur(const Params& p, int row) { return row < TX ? p.out + (size_t)row * D_MODEL : p.XC + (size_t)(row - TX) * D_MODEL; }
HD int row_mod(int row) { return row < TX ? row / SEQ : BATCH; }
HD const float* modp(const Params& p, int l, int row, int which) { return p.mod + ((size_t)(l * (BATCH + 1) + row_mod(row)) * 6 + which) * D_MODEL; }

GLOBAL void nk_mod(Params p) {
    GS_LOOP(i, DEPTH * (BATCH + 1) * 6 * D_MODEL) {
        int j = i % (6 * D_MODEL); int r = (i / (6 * D_MODEL)) % (BATCH + 1); int l = i / (6 * D_MODEL * (BATCH + 1));
        const float* cv = r < BATCH ? p.c + r * D_MODEL : p.c_ctx;
        const float* w = p.w_ada + (size_t)l * D_MODEL * 6 * D_MODEL;
        float acc = 0.f;
        for (int k = 0; k < D_MODEL; ++k) acc += silu_f(cv[k]) * w[(size_t)k * 6 * D_MODEL + j];
        p.mod[i] = acc + p.b_ada[l * 6 * D_MODEL + j];
    }
}
HD void d_rope(const Params& p) {
    GS_LOOP(i, 64 * 16) {
        int pos = i / 16, k = i % 16;
        float inv = powf(10000.0f, -(float)(2 * k) / 32.0f);
        float a = (float)pos * inv;
        p.ropet[pos * 32 + k] = cosf(a); p.ropet[pos * 32 + 16 + k] = sinf(a);
    }
}
HD void d_hy_h1(const Params& p) {
    GS_LOOP(i, SEQ * HY_FFN) {
        int t = i / HY_FFN, k = i % HY_FFN;
        float tn = (float)t / (float)(SEQ - 1);
        float acc = tn * p.hy_w1[0 * HY_FFN + k];
        for (int b = 0; b < HY_BANDS; ++b) {
            float band = 1e-4f + (float)b * ((float)(HY_BANDS - 1) - 1e-4f) / (float)(HY_BANDS - 1);
            float ang = 2.0f * 3.14159265358979323846f * (float)t * band / (float)SEQ;
            acc += cosf(ang) * p.hy_w1[(1 + b) * HY_FFN + k] + sinf(ang) * p.hy_w1[(1 + HY_BANDS + b) * HY_FFN + k];
        }
        p.h1[i] = sinf(p.hy_f1[k] * (acc + p.hy_b1[k]));
    }
}
HD void d_hy_h2(const Params& p) {
    GS_LOOP(i, SEQ * HY_FFN) {
        int t = i / HY_FFN, j = i % HY_FFN;
        float acc = 0.f;
        for (int k = 0; k < HY_FFN; ++k) acc += p.h1[t * HY_FFN + k] * p.hy_w2[k * HY_FFN + j];
        p.h2[i] = sinf(p.hy_f2[j] * (acc + p.hy_b2[j]));
    }
}
HD float hy_decay(int t, int c) {
    const float mind = logf(1e-2f) / 1.5f, maxd = logf(1e-2f) / 0.3f;
    float delta = fabsf(mind + (float)c * (maxd - mind) / (float)(D_CH - 1));
    float tn = (float)t / (float)(SEQ - 1);
    return expf(-tn * delta);
}
GLOBAL void nk_hy_filt(Params p) {
    GS_LOOP(i, 4 * D_CH * SEQ) {
        int t = i % SEQ, col = i / SEQ, c = col % D_CH;
        float acc = p.hy_b3[col];
        for (int k = 0; k < HY_FFN; ++k) acc += p.h2[t * HY_FFN + k] * p.hy_w3[k * 4 * D_CH + col];
        p.HFT[i] = acc * hy_decay(t, c);
    }
}
GLOBAL void nk_hy_norm(Params p) {
    GS_LOOP(i, 2 * D_CH) {
        int o = i / D_CH, c = i % D_CH;
        float s = 0.f;
        for (int dir = 0; dir < 2; ++dir) { const float* h = p.HFT + (size_t)((dir * 2 + o) * D_CH + c) * SEQ; for (int t = 0; t < SEQ; ++t) s += fabsf(h[t]); }
        p.hnorm[i] = s + EPS;
    }
}
GLOBAL void nk_zero_cnt(Params p) { GS_LOOP(i, 64) p.cnt[i] = 0; }

GLOBAL void nk_norm(Params p, int l, int which, int nrows) {
    GS_LOOP(row, nrows) {
        const float* xr = which == 0 ? xrow_in(p, l, (int)row) : xrow_cur(p, (int)row);
        float ss = 0.f;
        for (int k = 0; k < D_MODEL; ++k) ss += xr[k] * xr[k];
        float rstd = 1.0f / sqrtf(ss / D_MODEL + EPS);
        const float* g = p.norm_g + (l * 2 + which) * D_MODEL;
        const float* sh = modp(p, l, (int)row, which * 3 + 0); const float* sc = modp(p, l, (int)row, which * 3 + 1);
        for (int k = 0; k < D_MODEL; ++k) p.hbuf[row * D_MODEL + k] = f2bf(xr[k] * rstd * g[k] * (1.0f + sc[k]) + sh[k]);
    }
}

HD float dot_row(const bf16_t* a, const float* W, int ldw, int col, int K) {
    float acc = 0.f;
    for (int k = 0; k < K; ++k) acc += bf2f(a[k]) * W[(size_t)k * ldw + col];
    return acc;
}
HD float rope_apply(const Params& p, float v, float partner, int d, int s) {
    int half = d >> 5, dd = d & 31, k = dd & 15;
    int pos = half == 0 ? s / GRID_W : s % GRID_W;
    float c = p.ropet[pos * 32 + k], sn = p.ropet[pos * 32 + 16 + k];
    return dd < 16 ? v * c - partner * sn : v * c + partner * sn;
}

GLOBAL void nk_inproj_even(Params p) {
    GS_LOOP(i, (long)TT * EVEN_IN) {
        int row = i / EVEN_IN, col = i % EVEN_IN;
        const bf16_t* a = p.hbuf + (size_t)row * D_MODEL;
        float v = dot_row(a, p.w_in_even, EVEN_IN, col, D_MODEL);
        bool lat = row < TX; int b = lat ? row / SEQ : (row - TX) / CTX_LEN; int s = lat ? row % SEQ : (row - TX) % CTX_LEN;
        int pos = lat ? CTX_LEN + s : s;
        if (col < 640) {
            int d = col & 63;
            if (lat) { int pc = (d & 31) < 16 ? col + 16 : col - 16; float pv = dot_row(a, p.w_in_even, EVEN_IN, pc, D_MODEL); v = rope_apply(p, v, pv, d, s); }
            if (col < 512) p.QA[(size_t)row * 512 + col] = f2bf(v);
            else { int h = (col - 512) >> 6; p.KA[((size_t)(b * 2 + h) * LKV + pos) * 64 + d] = f2bf(v); }
        } else if (col < 768) { int h = (col - 640) >> 6, d = col & 63; p.VAt[((size_t)(b * 2 + h) * 64 + d) * LKV + pos] = f2bf(v); }
        else if (col < 1280) p.QB[(size_t)row * 512 + (col - 768)] = f2bf(v);
        else if (col < 1792) { int h = (col - 1280) >> 6, d = col & 63; p.KB[((size_t)(b * 8 + h) * LKV + pos) * 64 + d] = f2bf(v); }
        else { int h = (col - 1792) >> 6, d = col & 63; p.VBt[((size_t)(b * 8 + h) * 64 + d) * LKV + pos] = f2bf(v); }
    }
}

struct OSM { float m, l; };
#define ATT_BEGIN() float q[64], acc[64]; for (int d = 0; d < 64; ++d) { q[d] = bf2f(qp[d]) * ATTN_SCALE; acc[d] = 0.f; } float m_ = -1e30f, l_ = 0.f;
#define ATT_KEY(Kp, Vt, key, bias) do { const bf16_t* kk_ = (Kp) + (size_t)(key) * 64; float s_ = (bias); for (int d = 0; d < 64; ++d) s_ += q[d] * bf2f(kk_[d]); \
    float mn_ = fmaxf(m_, s_); float f_ = expf(m_ - mn_), pe_ = expf(s_ - mn_); l_ = l_ * f_ + pe_; \
    for (int d = 0; d < 64; ++d) acc[d] = acc[d] * f_ + pe_ * bf2f((Vt)[(size_t)d * LKV + (key)]); m_ = mn_; } while (0)
#define ATT_SINK(sv) do { float s_ = (sv); float mn_ = fmaxf(m_, s_); float f_ = expf(m_ - mn_); l_ = l_ * f_ + expf(s_ - mn_); for (int d = 0; d < 64; ++d) acc[d] *= f_; m_ = mn_; } while (0)

GLOBAL void nk_attnA(Params p) {
    GS_LOOP(i, (long)TX * 8) {
        int h = i % 8, row = i / 8, b = row / SEQ, s = row % SEQ, kvh = h / 4;
        const bf16_t* qp = p.QA + (size_t)row * 512 + h * 64;
        const bf16_t* Kp = p.KA + (size_t)(b * 2 + kvh) * LKV * 64; const bf16_t* Vt = p.VAt + (size_t)(b * 2 + kvh) * 64 * LKV;
        ATT_BEGIN();
        for (int j = 0; j < CTX_LEN; ++j) ATT_KEY(Kp, Vt, j, 0.f);
        int lo = s - A_WINDOW < 0 ? 0 : s - A_WINDOW, hi = s + A_WINDOW > SEQ - 1 ? SEQ - 1 : s + A_WINDOW;
        for (int j = lo; j <= hi; ++j) ATT_KEY(Kp, Vt, CTX_LEN + j, 0.f);
        ATT_SINK(p.a_sink[h]);
        for (int d = 0; d < 64; ++d) p.Y[(size_t)row * 1024 + h * 64 + d] = f2bf(acc[d] / l_);
    }
}
GLOBAL void nk_attnB(Params p) {
    GS_LOOP(i, (long)TX * 8) {
        int h = i % 8, row = i / 8, b = row / SEQ, s = row % SEQ, r = s / GRID_W, cq = s % GRID_W;
        const bf16_t* qp = p.QB + (size_t)row * 512 + h * 64;
        const bf16_t* Kp = p.KB + (size_t)(b * 8 + h) * LKV * 64; const bf16_t* Vt = p.VBt + (size_t)(b * 8 + h) * 64 * LKV;
        ATT_BEGIN();
        for (int j = 0; j < CTX_LEN; ++j) ATT_KEY(Kp, Vt, j, 0.f);
        int kh = B_WIN_H < GRID_H ? B_WIN_H : GRID_H;
        int rs = r - kh / 2; if (rs < 0) rs = 0; if (rs > GRID_H - kh) rs = GRID_H - kh;
        int cs = cq - B_WIN_W / 2; if (cs < 0) cs = 0; if (cs > GRID_W - B_WIN_W) cs = GRID_W - B_WIN_W;
        for (int kr = rs; kr < rs + kh; ++kr)
            for (int kc = cs; kc < cs + B_WIN_W; ++kc) {
                int dr = kr - r, dc = kc - cq;
                float bias = p.b_rpb[(h * (2 * B_WIN_H - 1) + dr + B_WIN_H - 1) * (2 * B_WIN_W - 1) + dc + B_WIN_W - 1];
                ATT_KEY(Kp, Vt, CTX_LEN + kr * GRID_W + kc, bias);
            }
        for (int d = 0; d < 64; ++d) p.Y[(size_t)row * 1024 + 512 + h * 64 + d] = f2bf(acc[d] / l_);
    }
}
GLOBAL void nk_attn_ctx(Params p) {
    GS_LOOP(i, (long)TC * 16) {
        int hh = i % 16, rc = i / 16, ty = hh / 8, h = hh % 8, b = rc / CTX_LEN; int row = TX + rc;
        const bf16_t* qp = (ty == 0 ? p.QA : p.QB) + (size_t)row * 512 + h * 64;
        const bf16_t* Kp = ty == 0 ? p.KA + (size_t)(b * 2 + h / 4) * LKV * 64 : p.KB + (size_t)(b * 8 + h) * LKV * 64;
        const bf16_t* Vt = ty == 0 ? p.VAt + (size_t)(b * 2 + h / 4) * 64 * LKV : p.VBt + (size_t)(b * 8 + h) * 64 * LKV;
        ATT_BEGIN();
        for (int j = 0; j < CTX_LEN; ++j) ATT_KEY(Kp, Vt, j, 0.f);
        if (ty == 0) ATT_SINK(p.a_sink[h]);
        for (int d = 0; d < 64; ++d) p.Y[(size_t)row * 1024 + ty * 512 + h * 64 + d] = f2bf(acc[d] / l_);
    }
}
GLOBAL void nk_attnC(Params p) {
    GS_LOOP(i, (long)TX * 8) {
        int h = i % 8, row = i / 8, b = row / SEQ, kvh = h / 4;
        const bf16_t* qp = p.QC + (size_t)row * 512 + h * 64;
        const bf16_t* Kp = p.KC + (size_t)(b * 2 + kvh) * LKV * 64; const bf16_t* Vt = p.VCt + (size_t)(b * 2 + kvh) * 64 * LKV;
        ATT_BEGIN();
        for (int j = 0; j < LKV; ++j) ATT_KEY(Kp, Vt, j, 0.f);
        for (int d = 0; d < 64; ++d) p.Y[(size_t)row * 1024 + h * 64 + d] = f2bf(acc[d] / l_);
    }
}

GLOBAL void nk_outproj_even(Params p) {
    GS_LOOP(i, (long)TT * D_MODEL) {
        int row = i / D_MODEL, col = i % D_MODEL;
        float acc = dot_row(p.Y + (size_t)row * 1024, p.w_out_even, D_MODEL, col, EVEN_OUT);
        xrow_cur(p, row)[col] = xrow_in(p, 0, row)[col] + modp(p, 0, row, 2)[col] * acc;
    }
}
GLOBAL void nk_outproj_odd(Params p) {
    GS_LOOP(i, (long)TX * D_MODEL) {
        int row = i / D_MODEL, col = i % D_MODEL, b = row / SEQ, s = row % SEQ;
        float acc = dot_row(p.Y + (size_t)row * 1024, p.w_out_odd, D_MODEL, col, 512);
        for (int c = 0; c < D_CH; ++c) acc += bf2f(p.YHT[((size_t)b * D_CH + c) * SEQ + s]) * p.w_out_odd[(size_t)(512 + c) * D_MODEL + col];
        p.out[i] = p.out[i] + modp(p, 1, row, 2)[col] * acc;
    }
}

GLOBAL void nk_router(Params p, int l, int nrows) {
    GS_LOOP(row, nrows) {
        const float* xr = xrow_cur(p, (int)row);
        float ss = 0.f;
        for (int k = 0; k < D_MODEL; ++k) ss += xr[k] * xr[k];
        float rstd = 1.0f / sqrtf(ss / D_MODEL + EPS);
        const float* g = p.norm_g + (l * 2 + 1) * D_MODEL; const float* sh = modp(p, l, (int)row, 3); const float* sc = modp(p, l, (int)row, 4);
        float lg[16];
#pragma unroll
        for (int e = 0; e < 16; ++e) lg[e] = 0.f;
        for (int k = 0; k < D_MODEL; ++k) { float hv = xr[k] * rstd * g[k] * (1.0f + sc[k]) + sh[k];
#pragma unroll
            for (int e = 0; e < 16; ++e) lg[e] += hv * p.w_router[k * 16 + e]; }
        int gbest = 0, a = 0, bb = 1; float gbs = -1e30f, wa = 0.f, wb = 0.f;
#pragma unroll
        for (int gI = 0; gI < 4; ++gI) {
            float m1 = -1e30f, m2 = -1e30f, s1 = 0.f, s2 = 0.f; int i1 = 0, i2 = 0;
#pragma unroll
            for (int j = 0; j < 4; ++j) { float sgv = sigmoid_f(lg[gI * 4 + j]); float v = sgv + p.b_router[gI * 4 + j];
                if (v > m1) { m2 = m1; i2 = i1; s2 = s1; m1 = v; i1 = j; s1 = sgv; } else if (v > m2) { m2 = v; i2 = j; s2 = sgv; } }
            float gs = m1 + m2;
            if (gs > gbs) { gbs = gs; gbest = gI; if (i1 < i2) { a = i1; bb = i2; wa = s1; wb = s2; } else { a = i2; bb = i1; wa = s2; wb = s1; } }
        }
        float inv = 1.0f / (wa + wb);
        int pidx = a == 0 ? bb - 1 : (a == 1 ? bb + 1 : 5);
        int pr = gbest * 6 + pidx;
        int pos = atomicAdd(p.cnt + l * 32 + pr, 1);
        p.list[(size_t)pr * TT + pos] = (int)row;
        p.tokw[row * 2 + 0] = wa * inv; p.tokw[row * 2 + 1] = wb * inv;
    }
}
HD void pair_experts(int pr, int& e1, int& e2) { int g = pr / 6, q = pr % 6; int a = q < 3 ? 0 : (q < 5 ? 1 : 2); int b = q < 3 ? q + 1 : (q < 5 ? q - 1 : 3); e1 = g * 4 + a; e2 = g * 4 + b; }
HD bool slot_lookup(const Params& p, int l, int slot, int& pr, int& row) { int acc = 0; for (int q = 0; q < NPAIR; ++q) { int c = p.cnt[l * 32 + q]; if (slot < acc + c) { pr = q; row = p.list[(size_t)q * TT + (slot - acc)]; return true; } acc += c; } return false; }
GLOBAL void nk_moe_up(Params p, int l, int nrows) {
    GS_LOOP(i, (long)nrows * HE_W) {
        int slot = i / HE_W, j = i % HE_W, k = j / D_EXPERT, jj = j % D_EXPERT; int pr, row; if (!slot_lookup(p, l, slot, pr, row)) continue;
        int e1, e2; pair_experts(pr, e1, e2); int e = k == 0 ? e1 : e2;
        const bf16_t* a = p.hbuf + (size_t)row * D_MODEL;
        const float* wg = p.moe_wg + (size_t)(l * N_EXPERTS + e) * D_MODEL * D_EXPERT; const float* wu = p.moe_wu + (size_t)(l * N_EXPERTS + e) * D_MODEL * D_EXPERT;
        float g = dot_row(a, wg, D_EXPERT, jj, D_MODEL), u = dot_row(a, wu, D_EXPERT, jj, D_MODEL);
        p.HE[(size_t)row * HE_W + j] = f2bf(p.tokw[row * 2 + k] * silu_f(g) * u);
    }
}
GLOBAL void nk_moe_down(Params p, int l, int nrows) {
    GS_LOOP(i, (long)nrows * D_MODEL) {
        int slot = i / D_MODEL, col = i % D_MODEL; int pr, row; if (!slot_lookup(p, l, slot, pr, row)) continue;
        int e1, e2; pair_experts(pr, e1, e2);
        const bf16_t* a = p.HE + (size_t)row * HE_W;
        float acc = dot_row(a, p.moe_wd + (size_t)(l * N_EXPERTS + e1) * D_EXPERT * D_MODEL, D_MODEL, col, D_EXPERT)
                  + dot_row(a + D_EXPERT, p.moe_wd + (size_t)(l * N_EXPERTS + e2) * D_EXPERT * D_MODEL, D_MODEL, col, D_EXPERT);
        float* xr = xrow_cur(p, row);
        xr[col] = xr[col] + modp(p, l, row, 5)[col] * acc;
    }
}

GLOBAL void nk_inproj_odd_qk(Params p) {
    GS_LOOP(i, (long)TT * 10) {
        int row = i / 10, hu = i % 10; const bf16_t* a = p.hbuf + (size_t)row * D_MODEL;
        bool lat = row < TX; int b = lat ? row / SEQ : (row - TX) / CTX_LEN; int s = lat ? row % SEQ : (row - TX) % CTX_LEN; int pos = lat ? CTX_LEN + s : s;
        int col0 = hu * 64;
        float v[64]; float ss = 0.f;
        for (int d = 0; d < 64; ++d) { v[d] = dot_row(a, p.w_in_odd, ODD_IN, col0 + d, D_MODEL); ss += v[d] * v[d]; }
        float rstd = 1.0f / sqrtf(ss / 64.0f + EPS);
        const float* gn = hu < 8 ? p.c_qnorm : p.c_knorm;
        for (int d = 0; d < 64; ++d) v[d] = v[d] * rstd * gn[d];
        for (int d = 0; d < 64; ++d) {
            float o = v[d];
            if (lat) { int pd = (d & 31) < 16 ? d + 16 : d - 16; o = rope_apply(p, v[d], v[pd], d, s); }
            if (hu < 8) p.QC[(size_t)row * 512 + col0 + d] = f2bf(o);
            else p.KC[((size_t)(b * 2 + (hu - 8)) * LKV + pos) * 64 + d] = f2bf(o);
        }
    }
}
GLOBAL void nk_inproj_odd_vu(Params p) {
    GS_LOOP(i, (long)TT * (ODD_IN - 640)) {
        int row = i / (ODD_IN - 640), col = 640 + i % (ODD_IN - 640); const bf16_t* a = p.hbuf + (size_t)row * D_MODEL;
        bool lat = row < TX; int b = lat ? row / SEQ : (row - TX) / CTX_LEN; int s = lat ? row % SEQ : (row - TX) % CTX_LEN; int pos = lat ? CTX_LEN + s : s;
        if (col >= 768 && !lat) continue;
        float v = dot_row(a, p.w_in_odd, ODD_IN, col, D_MODEL);
        if (col < 768) { int h = (col - 640) >> 6, d = col & 63; p.VCt[((size_t)(b * 2 + h) * 64 + d) * LKV + pos] = f2bf(v); }
        else p.UT[((size_t)b * 3 * D_CH + (col - 768)) * SEQ + s] = f2bf(v);
    }
}

HD float hy_sc(const Params& p, int b, int ch, int t) {
    const bf16_t* u = p.UT + ((size_t)b * 3 * D_CH + ch) * SEQ;
    float acc = p.hy_short_b[ch];
    for (int kk = 0; kk < 3; ++kk) { int tt = t + kk - 1; if (tt >= 0 && tt < SEQ) acc += p.hy_short_w[kk * 3 * D_CH + ch] * bf2f(u[tt]); }
    return acc;
}
GLOBAL void nk_hy_conv(Params p, int o) {
    GS_LOOP(i, (long)BATCH * D_CH * SEQ) {
        int n = i % SEQ, c = (i / SEQ) % D_CH, b = i / ((long)SEQ * D_CH);
        const float* hf = p.HFT + (size_t)((0 * 2 + o) * D_CH + c) * SEQ; const float* hb = p.HFT + (size_t)((1 * 2 + o) * D_CH + c) * SEQ;
        float inv = 1.0f / p.hnorm[o * D_CH + c];
        float acc = 0.f;
        for (int m = 0; m < SEQ; ++m) {
            float z = o == 0 ? hy_sc(p, b, c, m) : p.Z1[((size_t)b * D_CH + c) * SEQ + m];
            int d = n - m; float hv = d >= 0 ? hf[d] : hb[-d];
            acc += hv * z;
        }
        acc *= inv;
        float zn = o == 0 ? hy_sc(p, b, c, n) : p.Z1[((size_t)b * D_CH + c) * SEQ + n];
        float g = hy_sc(p, b, (o + 1) * D_CH + c, n);
        float r = g * (acc + zn * p.hy_bias[o * D_CH + c]);
        if (o == 0) p.Z1[i] = r; else p.YHT[i] = f2bf(r);
    }
}

GLOBAL void nk_final(Params p) {
    GS_LOOP(row, TX) {
        float* xr = p.out + (size_t)row * D_MODEL; float ss = 0.f;
        for (int k = 0; k < D_MODEL; ++k) ss += xr[k] * xr[k];
        float rstd = 1.0f / sqrtf(ss / D_MODEL + EPS);
        for (int k = 0; k < D_MODEL; ++k) xr[k] = xr[k] * rstd * p.final_g[k];
    }
}
GLOBAL void nk_yht_to_y(Params p) {
    GS_LOOP(i, (long)TX * D_CH) { int row = i / D_CH, c = i % D_CH, b = row / SEQ, s = row % SEQ; p.Y[(size_t)row * 1024 + 512 + c] = p.YHT[((size_t)b * D_CH + c) * SEQ + s]; }
}

GLOBAL void nk_rope(Params p) { d_rope(p); }
GLOBAL void nk_hy_h1(Params p) { d_hy_h1(p); }
GLOBAL void nk_hy_h2(Params p) { d_hy_h2(p); }
static inline size_t al256(size_t x) { return (x + 255) & ~(size_t)255; }
static size_t setup_ws(Params& p, char* ws) {
    size_t o = 0;
    auto take = [&](size_t bytes) { char* r = ws + o; o += al256(bytes); return r; };
    p.bar = (unsigned*)take(64 * 1024);
    p.cnt = (int*)take(256);
    p.XC = (float*)take((size_t)TC * D_MODEL * 4);
    p.mod = (float*)take((size_t)DEPTH * (BATCH + 1) * 6 * D_MODEL * 4);
    p.ropet = (float*)take(64 * 32 * 4);
    p.h1 = (float*)take((size_t)SEQ * 64 * 4);
    p.h2 = (float*)take((size_t)SEQ * 64 * 4);
    p.HFT = (float*)take((size_t)4 * D_CH * SEQ * 4);
    p.hnorm = (float*)take(2 * D_CH * 4);
    p.list = (int*)take((size_t)NPAIR * TT * 4);
    p.tokw = (float*)take((size_t)TT * 2 * 4);
    p.rpair = (int*)take((size_t)TT * 4);
    p.bh = (int*)take((size_t)2048 * 32 * 4);
    size_t hb = (size_t)TT * D_MODEL * 2, z1 = (size_t)BATCH * D_CH * SEQ * 4;
    char* r0 = take(hb > z1 ? hb : z1); p.hbuf = (bf16_t*)r0; p.Z1 = (float*)r0;
    size_t q = al256((size_t)TT * 512 * 2), kva = al256((size_t)BATCH * 2 * LKV * 64 * 2), kvb = al256((size_t)BATCH * 8 * LKV * 64 * 2), ut = al256((size_t)BATCH * 3 * D_CH * SEQ * 2);
    size_t l0 = 2 * q + 2 * kva + 2 * kvb, l1 = q + 2 * kva + ut;
    char* R = take(l0 > l1 ? l0 : l1);
    p.QA = (bf16_t*)R; p.KA = (bf16_t*)(R + q); p.VAt = (bf16_t*)(R + q + kva); p.QB = (bf16_t*)(R + q + 2 * kva); p.KB = (bf16_t*)(R + 2 * q + 2 * kva); p.VBt = (bf16_t*)(R + 2 * q + 2 * kva + kvb);
    p.QC = (bf16_t*)R; p.KC = (bf16_t*)(R + q); p.VCt = (bf16_t*)(R + q + kva); p.UT = (bf16_t*)(R + q + 2 * kva);
    size_t yb = (size_t)TT * 1024 * 2, heb = (size_t)TT * HE_W * 2;
    char* r1 = take(yb > heb ? yb : heb); p.Y = (bf16_t*)r1; p.HE = (bf16_t*)r1;
    p.YHT = (bf16_t*)take((size_t)BATCH * D_CH * SEQ * 2);
    p.Wt_in_even = (bf16_t*)take((size_t)EVEN_IN * D_MODEL * 2);
    p.Wt_out_even = (bf16_t*)take((size_t)D_MODEL * EVEN_OUT * 2);
    p.Wt_in_odd = (bf16_t*)take((size_t)ODD_IN * D_MODEL * 2);
    p.Wt_out_odd = (bf16_t*)take((size_t)D_MODEL * ODD_OUT * 2);
    p.Wt_gu = (bf16_t*)take((size_t)DEPTH * N_EXPERTS * 2 * D_EXPERT * D_MODEL * 2);
    p.Wt_d = (bf16_t*)take((size_t)DEPTH * N_EXPERTS * D_MODEL * D_EXPERT * 2);
    return o;
}
static void fill_inputs(Params& p, void* const* d_in, void* d_out) {
    const float** f = (const float**)&p.x;
    for (int i = 0; i < 32; ++i) f[i] = (const float*)d_in[i];
    p.out = (float*)d_out;
}
#define LAS __attribute__((address_space(3)))
typedef short bf16x8 __attribute__((ext_vector_type(8)));
typedef float f32x4 __attribute__((ext_vector_type(4)));
typedef float f32x16 __attribute__((ext_vector_type(16)));
typedef unsigned u32x4 __attribute__((ext_vector_type(4)));
typedef unsigned u32x2 __attribute__((ext_vector_type(2)));

constexpr int NTHREADS = 256;
constexpr int LDS_BYTES = 69632;
constexpr int MT_ALL = TT / 128, MT_LAT = TX / 128;

__device__ __forceinline__ unsigned pk2bf(float lo, float hi) { return (unsigned)f2bf(lo) | ((unsigned)f2bf(hi) << 16); }
__device__ __forceinline__ float wave_sum(float v) {
#pragma unroll
    for (int o = 1; o < 64; o <<= 1) v += __shfl_xor(v, o);
    return v;
}

template <class DstF>
__device__ __forceinline__ void cvt_block_item(char* lds, const float* W, int N, int k0, int n0, const DstF& dst) {
    float* T = (float*)lds; const int tid = threadIdx.x;
    f32x4 v[16];
#pragma unroll
    for (int i = 0; i < 16; ++i) v[i] = *(const f32x4*)(W + (size_t)(k0 + (tid >> 6) + 4 * i) * N + n0 + 4 * (tid & 63));
#pragma unroll
    for (int i = 0; i < 16; ++i) *(f32x4*)(T + ((tid >> 6) + 4 * i) * 260 + 4 * (tid & 63)) = v[i];
    __syncthreads();
    bf16_t* d = dst(n0 + tid) + k0; const float* s = T + tid;
#pragma unroll
    for (int c = 0; c < 8; ++c) { u32x4 w; w.x = pk2bf(s[(8 * c + 0) * 260], s[(8 * c + 1) * 260]); w.y = pk2bf(s[(8 * c + 2) * 260], s[(8 * c + 3) * 260]);
        w.z = pk2bf(s[(8 * c + 4) * 260], s[(8 * c + 5) * 260]); w.w = pk2bf(s[(8 * c + 6) * 260], s[(8 * c + 7) * 260]); *(u32x4*)(d + 8 * c) = w; }
    __syncthreads();
}
__device__ __forceinline__ void cvt_plain(char* lds, const float* W, bf16_t* Wt, int K, int N, int item) {
    const int nb = N / 256, kb = item / nb, nbi = item % nb;
    cvt_block_item(lds, W, N, kb * 64, nbi * 256, [&](int n) { return Wt + (size_t)n * K; });
}
constexpr int CVT_IN = (D_MODEL / 64) * (EVEN_IN / 256), CVT_OUT = (D_MODEL / 64) * (D_MODEL / 256), CVT_GU1 = (D_MODEL / 64) * (D_EXPERT / 256), CVT_D1 = (D_EXPERT / 64) * (D_MODEL / 256);
constexpr int CVT_GU = DEPTH * N_EXPERTS * 2 * CVT_GU1, CVT_D = DEPTH * N_EXPERTS * CVT_D1;
constexpr int CVT_TOTAL = 2 * CVT_IN + 2 * CVT_OUT + CVT_GU + CVT_D;
constexpr int CVT_EARLY = 2 * CVT_IN + 2 * CVT_OUT;
static_assert(EVEN_IN % 256 == 0 && ODD_IN % 256 == 0 && D_EXPERT % 256 == 0, "conversion tile");
__device__ __forceinline__ void cvt_item(const Params& p, char* lds, int it) {
    if (it < CVT_IN) { cvt_plain(lds, p.w_in_even, p.Wt_in_even, D_MODEL, EVEN_IN, it); return; } it -= CVT_IN;
    if (it < CVT_IN) { cvt_plain(lds, p.w_in_odd, p.Wt_in_odd, D_MODEL, ODD_IN, it); return; } it -= CVT_IN;
    if (it < CVT_OUT) { cvt_plain(lds, p.w_out_even, p.Wt_out_even, EVEN_OUT, D_MODEL, it); return; } it -= CVT_OUT;
    if (it < CVT_OUT) { cvt_plain(lds, p.w_out_odd, p.Wt_out_odd, ODD_OUT, D_MODEL, it); return; } it -= CVT_OUT;
    if (it < CVT_GU) {
        const int le = it / (2 * CVT_GU1), r = it % (2 * CVT_GU1), half = r / CVT_GU1, r2 = r % CVT_GU1; const int nb = D_EXPERT / 256, kb = r2 / nb, nbi = r2 % nb;
        const float* W = (half ? p.moe_wu : p.moe_wg) + (size_t)le * D_MODEL * D_EXPERT; bf16_t* Wt = p.Wt_gu + (size_t)le * 2 * D_EXPERT * D_MODEL;
        cvt_block_item(lds, W, D_EXPERT, kb * 64, nbi * 256, [&](int n) { return Wt + (size_t)(32 * (n >> 4) + 16 * half + (n & 15)) * D_MODEL; });
        return; } it -= CVT_GU;
    { const int le = it / CVT_D1, r = it % CVT_D1; cvt_plain(lds, p.moe_wd + (size_t)le * D_EXPERT * D_MODEL, p.Wt_d + (size_t)le * D_MODEL * D_EXPERT, D_EXPERT, D_MODEL, r); }
}
__device__ __forceinline__ void cvt_range(const Params& p, char* lds, int lo, int hi, int bid, int nb) {
    for (int it = lo + bid; it < hi; it += nb) cvt_item(p, lds, it);
}

struct TileGeom { int tid, lane, wid, wr, wc, l15, q, srow, schunk;
    __device__ __forceinline__ int drow(int i) const { return wid * 32 + i * 8 + (lane >> 3); }
    __device__ __forceinline__ int dchunk(int i) const { return (lane & 7) ^ (((lane >> 4) + 4 * i) & 7); } };
__device__ __forceinline__ TileGeom tile_geom() { TileGeom g; g.tid = threadIdx.x; g.lane = g.tid & 63; g.wid = __builtin_amdgcn_readfirstlane(g.tid >> 6); g.wr = g.wid >> 1; g.wc = g.wid & 1; g.l15 = g.lane & 15; g.q = g.lane >> 4; g.srow = g.tid >> 3; g.schunk = g.tid & 7; return g; }

template <class ALoad, class BLoad>
__device__ __forceinline__ void gemm_mainloop(char* lds, const TileGeom& g, int nk, const ALoad& AL, const BLoad& BL, f32x4 (&acc)[4][4]) {
#pragma unroll
    for (int i = 0; i < 4; ++i)
#pragma unroll
        for (int j = 0; j < 4; ++j) acc[i][j] = (f32x4){0.f, 0.f, 0.f, 0.f};
    const int swz = g.l15 >> 1;
    const int aofs = (g.wr * 64 + g.l15) * 128 + ((g.q ^ swz) << 4);
    const int bofs = 32768 + (g.wc * 64 + g.l15) * 128 + ((g.q ^ swz) << 4);
    LAS char* l3 = (LAS char*)lds;
    const int dbase = g.wid * 4096;
#define GEMM_STAGE(kt_, buf_) do { _Pragma("unroll") for (int i_ = 0; i_ < 4; ++i_) { \
        __builtin_amdgcn_global_load_lds((const unsigned*)AL(i_, (kt_)), (LAS unsigned*)(l3 + (buf_) + dbase + i_ * 1024), 16, 0, 0); \
        __builtin_amdgcn_global_load_lds((const unsigned*)BL(i_, (kt_)), (LAS unsigned*)(l3 + 32768 + (buf_) + dbase + i_ * 1024), 16, 0, 0); } } while (0)
    GEMM_STAGE(0, 0);
    __syncthreads();
    for (int kt = 0; kt < nk; ++kt) {
        const int cur = (kt & 1) * 16384, nxt = 16384 - cur;
        if (kt + 1 < nk) GEMM_STAGE(kt + 1, nxt);
#pragma unroll
        for (int kk = 0; kk < 2; ++kk) {
            bf16x8 af[4], bfr[4];
#pragma unroll
            for (int i = 0; i < 4; ++i) { af[i] = *(const bf16x8*)(lds + cur + ((aofs + i * 2048) ^ (kk * 64))); bfr[i] = *(const bf16x8*)(lds + cur + ((bofs + i * 2048) ^ (kk * 64))); }
#pragma unroll
            for (int mi = 0; mi < 4; ++mi)
#pragma unroll
                for (int ni = 0; ni < 4; ++ni) acc[mi][ni] = __builtin_amdgcn_mfma_f32_16x16x32_bf16(bfr[ni], af[mi], acc[mi][ni], 0, 0, 0);
        }
        __syncthreads();
    }
#undef GEMM_STAGE
}

template <class DstF>
__device__ __forceinline__ void store_transposed(char* lds, const TileGeom& g, const f32x4 (&acc)[4][4], const DstF& dst) {
    bf16_t* T = (bf16_t*)lds;
#pragma unroll
    for (int mi = 0; mi < 4; ++mi)
#pragma unroll
        for (int ni = 0; ni < 4; ++ni)
#pragma unroll
            for (int r = 0; r < 4; ++r) T[(g.wc * 64 + ni * 16 + g.q * 4 + r) * 136 + g.wr * 64 + mi * 16 + g.l15] = f2bf(acc[mi][ni][r]);
    __syncthreads();
    { int col = g.tid >> 1, half = g.tid & 1; bf16_t* d = dst(col) + half * 64; const bf16_t* s = T + col * 136 + half * 64;
#pragma unroll
      for (int j = 0; j < 8; ++j) *(u32x4*)(d + j * 8) = *(const u32x4*)(s + j * 8); }
    __syncthreads();
}
__device__ __forceinline__ void store4bf(bf16_t* d, const f32x4& v) { u32x2 w; w.x = pk2bf(v[0], v[1]); w.y = pk2bf(v[2], v[3]); *(u32x2*)d = w; }
__device__ __forceinline__ void rope_head(const Params& p, f32x4 (&a)[4], int s, int q) {
    const int pr = s / GRID_W, pc = s % GRID_W;
    const f32x4 cr = *(const f32x4*)(p.ropet + pr * 32 + q * 4), sr = *(const f32x4*)(p.ropet + pr * 32 + 16 + q * 4);
    const f32x4 cc = *(const f32x4*)(p.ropet + pc * 32 + q * 4), sc = *(const f32x4*)(p.ropet + pc * 32 + 16 + q * 4);
    f32x4 x1 = a[0], x2 = a[1]; a[0] = x1 * cr - x2 * sr; a[1] = x2 * cr + x1 * sr;
    x1 = a[2]; x2 = a[3]; a[2] = x1 * cc - x2 * sc; a[3] = x2 * cc + x1 * sc;
}

template <int LAYER>
__device__ __forceinline__ void inproj_tile(const Params& p, char* lds, int mt, int nt) {
    const TileGeom g = tile_geom();
    const bf16_t* Abase = p.hbuf + (size_t)(mt * 128) * D_MODEL;
    const bf16_t* Bbase = (LAYER == 0 ? p.Wt_in_even : p.Wt_in_odd) + (size_t)(nt * 128) * D_MODEL;
    f32x4 acc[4][4];
    gemm_mainloop(lds, g, D_MODEL / 64, [&](int i, int kt) { return Abase + (size_t)g.drow(i) * D_MODEL + kt * 64 + g.dchunk(i) * 8; }, [&](int i, int kt) { return Bbase + (size_t)g.drow(i) * D_MODEL + kt * 64 + g.dchunk(i) * 8; }, acc);
    const bool lat = mt < MT_LAT; const int row0 = mt * 128;
    const int b = lat ? row0 / SEQ : (row0 - TX) / CTX_LEN, s0 = lat ? row0 % SEQ : (row0 - TX) % CTX_LEN, pos0 = lat ? CTX_LEN + s0 : s0;
    int kind;
    bf16_t* base; int h0 = 0, qcol0 = 0, nh = 2;
    if (LAYER == 0) {
        if (nt < 4) { kind = 0; base = p.QA; qcol0 = nt * 128; }
        else if (nt == 4) { kind = 1; base = p.KA; h0 = 0; nh = 2; }
        else if (nt == 5) { kind = 2; base = p.VAt; h0 = 0; nh = 2; }
        else if (nt < 10) { kind = 0; base = p.QB; qcol0 = (nt - 6) * 128; }
        else if (nt < 14) { kind = 1; base = p.KB; h0 = (nt - 10) * 2; nh = 8; }
        else { kind = 2; base = p.VBt; h0 = (nt - 14) * 2; nh = 8; }
    } else {
        if (nt < 4) { kind = 0; base = p.QC; qcol0 = nt * 128; }
        else if (nt == 4) { kind = 1; base = p.KC; h0 = 0; nh = 2; }
        else if (nt == 5) { kind = 2; base = p.VCt; h0 = 0; nh = 2; }
        else { kind = 3; base = p.UT; }
    }
    if (kind <= 1) {
        const bool rope = lat && (LAYER == 1 || nt <= 4);
#pragma unroll
        for (int mi = 0; mi < 4; ++mi) {
            const int rowl = g.wr * 64 + mi * 16 + g.l15;
            if (LAYER == 1) {
                float ss = 0.f;
#pragma unroll
                for (int ni = 0; ni < 4; ++ni) ss += acc[mi][ni][0] * acc[mi][ni][0] + acc[mi][ni][1] * acc[mi][ni][1] + acc[mi][ni][2] * acc[mi][ni][2] + acc[mi][ni][3] * acc[mi][ni][3];
                ss += __shfl_xor(ss, 16); ss += __shfl_xor(ss, 32);
                const float rstd = 1.0f / sqrtf(ss * (1.0f / 64.0f) + EPS);
                const float* gn = kind == 0 ? p.c_qnorm : p.c_knorm;
#pragma unroll
                for (int ni = 0; ni < 4; ++ni) acc[mi][ni] = acc[mi][ni] * rstd * *(const f32x4*)(gn + ni * 16 + g.q * 4);
            }
            if (rope) rope_head(p, acc[mi], s0 + rowl, g.q);
            bf16_t* d = kind == 0 ? base + (size_t)(row0 + rowl) * 512 + qcol0 + g.wc * 64 + g.q * 4
                                  : base + ((size_t)(b * nh + h0 + g.wc) * LKV + pos0 + rowl) * 64 + g.q * 4;
#pragma unroll
            for (int ni = 0; ni < 4; ++ni) store4bf(d + ni * 16, acc[mi][ni]);
        }
    } else if (kind == 2) {
        store_transposed(lds, g, acc, [&](int col) { return base + ((size_t)(b * nh + h0 + (col >> 6)) * 64 + (col & 63)) * LKV + pos0; });
    } else {
        store_transposed(lds, g, acc, [&](int col) { return base + ((size_t)b * 3 * D_CH + (nt - 6) * 128 + col) * SEQ + s0; });
    }
}
template <int LAYER>
__device__ __forceinline__ void ph_inproj(const Params& p, char* lds, int bid, int nb) {
    constexpr int NT = 18;
    if (LAYER == 0) { for (int t = bid; t < MT_ALL * NT; t += nb) inproj_tile<0>(p, lds, t / NT, t % NT); }
    else {
        const int n_lat = MT_LAT * NT, n_all = n_lat + (MT_ALL - MT_LAT) * 2;
        for (int t = bid; t < n_all; t += nb) { if (t < n_lat) inproj_tile<1>(p, lds, t / NT, t % NT); else { int u = t - n_lat; inproj_tile<1>(p, lds, MT_LAT + u / 2, 4 + u % 2); } }
    }
}

template <int LAYER>
__device__ __forceinline__ void outproj_tile(const Params& p, char* lds, int mt, int nt) {
    const TileGeom g = tile_geom();
    const bf16_t* Abase = p.Y + (size_t)(mt * 128) * 1024;
    const bf16_t* Bbase = (LAYER == 0 ? p.Wt_out_even : p.Wt_out_odd) + (size_t)(nt * 128) * 1024;
    f32x4 acc[4][4];
    gemm_mainloop(lds, g, 16, [&](int i, int kt) { return Abase + (size_t)g.drow(i) * 1024 + kt * 64 + g.dchunk(i) * 8; }, [&](int i, int kt) { return Bbase + (size_t)g.drow(i) * 1024 + kt * 64 + g.dchunk(i) * 8; }, acc);
    const int row0 = mt * 128;
#pragma unroll
    for (int mi = 0; mi < 4; ++mi) {
        const int row = row0 + g.wr * 64 + mi * 16 + g.l15;
        const float* xin = xrow_in(p, LAYER, row); float* xo = xrow_cur(p, row); const float* gate = modp(p, LAYER, row, 2);
#pragma unroll
        for (int ni = 0; ni < 4; ++ni) { const int col = nt * 128 + g.wc * 64 + ni * 16 + g.q * 4;
            *(f32x4*)(xo + col) = *(const f32x4*)(xin + col) + *(const f32x4*)(gate + col) * acc[mi][ni]; }
    }
}

template <int LAYER>
__device__ __forceinline__ void ph_outproj(const Params& p, char* lds, int bid, int nb) {
    const int nmt = LAYER == 0 ? MT_ALL : MT_LAT;
    for (int t = bid; t < nmt * 8; t += nb) outproj_tile<LAYER>(p, lds, t / 8, t % 8);
}

template <int NTN>
__device__ __forceinline__ bool moe_tile_lookup(const int* cnt, int t, int& pr, int& mt, int& nt, int& n) {
    int acc = 0;
    for (int q = 0; q < NPAIR; ++q) { const int c = cnt[q]; const int tiles = ((c + 127) >> 7) * NTN; if (t < acc + tiles) { pr = q; const int u = t - acc; mt = u / NTN; nt = u % NTN; n = c; return true; } acc += tiles; }
    return false;
}
__device__ __forceinline__ void moe_up_tile(const Params& p, char* lds, int l, int pr, int mt, int nt, int n) {
    const TileGeom g = tile_geom();
    int e1, e2; pair_experts(pr, e1, e2); const int k = nt >> 3, e = k ? e2 : e1;
    const int* lst = p.list + (size_t)pr * TT + mt * 128;
    const int navail = n - mt * 128;
    const bf16_t* arow[4];
#pragma unroll
    for (int i = 0; i < 4; ++i) { int r = g.drow(i); if (r >= navail) r = navail - 1; arow[i] = p.hbuf + (size_t)lst[r] * D_MODEL + g.dchunk(i) * 8; }
    const bf16_t* Bbase = p.Wt_gu + ((size_t)(l * N_EXPERTS + e) * 2 * D_EXPERT + (nt & 7) * 128) * D_MODEL;
    f32x4 acc[4][4];
    gemm_mainloop(lds, g, D_MODEL / 64, [&](int i, int kt) { return arow[i] + kt * 64; }, [&](int i, int kt) { return Bbase + (size_t)g.drow(i) * D_MODEL + kt * 64 + g.dchunk(i) * 8; }, acc);
#pragma unroll
    for (int mi = 0; mi < 4; ++mi) {
        const int rl = g.wr * 64 + mi * 16 + g.l15;
        if (rl < navail) {
            const int row = lst[rl]; const float w = p.tokw[row * 2 + k];
            bf16_t* d = p.HE + (size_t)row * HE_W + k * D_EXPERT + (nt & 7) * 64 + g.wc * 32 + g.q * 4;
#pragma unroll
            for (int h2 = 0; h2 < 2; ++h2) { f32x4 gg = acc[mi][2 * h2], uu = acc[mi][2 * h2 + 1], o;
#pragma unroll
                for (int r = 0; r < 4; ++r) o[r] = w * (gg[r] / (1.0f + __expf(-gg[r]))) * uu[r];
                store4bf(d + h2 * 16, o); }
        }
    }
}
template <bool DUMMY = false>
__device__ __forceinline__ void moe_down_tile(const Params& p, char* lds, int l, int pr, int mt, int nt, int n) {
    const TileGeom g = tile_geom();
    int e1, e2; pair_experts(pr, e1, e2);
    const int* lst = p.list + (size_t)pr * TT + mt * 128;
    const int navail = n - mt * 128;
    const bf16_t* arow[4];
#pragma unroll
    for (int i = 0; i < 4; ++i) { int r = g.drow(i); if (r >= navail) r = navail - 1; arow[i] = p.HE + (size_t)lst[r] * HE_W + g.dchunk(i) * 8; }
    const bf16_t* B1 = p.Wt_d + ((size_t)(l * N_EXPERTS + e1) * D_MODEL + nt * 128) * D_EXPERT;
    const bf16_t* B2 = p.Wt_d + ((size_t)(l * N_EXPERTS + e2) * D_MODEL + nt * 128) * D_EXPERT;
    constexpr int KT1 = D_EXPERT / 64;
    f32x4 acc[4][4];
    gemm_mainloop(lds, g, HE_W / 64, [&](int i, int kt) { return arow[i] + kt * 64; },
                  [&](int i, int kt) { return (kt < KT1 ? B1 + kt * 64 : B2 + (kt - KT1) * 64) + (size_t)g.drow(i) * D_EXPERT + g.dchunk(i) * 8; }, acc);
#pragma unroll
    for (int mi = 0; mi < 4; ++mi) {
        const int rl = g.wr * 64 + mi * 16 + g.l15;
        if (rl < navail) {
            const int row = lst[rl]; float* xo = xrow_cur(p, row); const float* gate = modp(p, l, row, 5);
#pragma unroll
            for (int ni = 0; ni < 4; ++ni) { const int col = nt * 128 + g.wc * 64 + ni * 16 + g.q * 4; float* dst = DUMMY ? (float*)p.QA + (size_t)row * D_MODEL : xo; *(f32x4*)(dst + col) = *(const f32x4*)(xo + col) + *(const f32x4*)(gate + col) * acc[mi][ni]; }
        }
    }
}
__device__ __forceinline__ void ph_moe_up(const Params& p, char* lds, int l, int bid, int nb) {
    int pr, mt, nt, n; for (int t = bid; moe_tile_lookup<16>(p.cnt + l * 32, t, pr, mt, nt, n); t += nb) moe_up_tile(p, lds, l, pr, mt, nt, n);
}
template <bool DUMMY = false>
__device__ __forceinline__ void ph_moe_down(const Params& p, char* lds, int l, int bid, int nb) {
    int pr, mt, nt, n; for (int t = bid; moe_tile_lookup<8>(p.cnt + l * 32, t, pr, mt, nt, n); t += nb) moe_down_tile<DUMMY>(p, lds, l, pr, mt, nt, n);
}
typedef float f32x2 __attribute__((ext_vector_type(2)));
typedef __bf16 bf16x2_t __attribute__((ext_vector_type(2)));
__device__ __forceinline__ unsigned cvtpk(float lo, float hi) { f32x2 v = {lo, hi}; bf16x2_t b = __builtin_convertvector(v, bf16x2_t); return __builtin_bit_cast(unsigned, b); }
__device__ __forceinline__ int crow(int r, int hi) { return (r & 3) + 8 * (r >> 2) + 4 * hi; }
constexpr float LOG2E = 1.4426950408889634f;
constexpr float QK_C = ATTN_SCALE * LOG2E;
constexpr float NEG_BIG = -1e30f;

template <int MODE>
__device__ __forceinline__ void attn_unit(char* lds, const bf16_t* Qp, const bf16_t* Kp, const bf16_t* Vt, bf16_t* Op, int s0, int nctx, int lt0, int nlat, float sink2, bool has_sink, const float* rpb_h) {
    const int tid = threadIdx.x, lane = tid & 63, wid = __builtin_amdgcn_readfirstlane(tid >> 6), l31 = lane & 31, hi = lane >> 5;
    float* bias_s = (float*)(lds + 32768);
    if (MODE == 2) { for (int i = tid; i < 15 * 31; i += NTHREADS) bias_s[i] = rpb_h[i] * LOG2E; }
    const int ntiles = nctx + nlat;
    const int srow0 = tid >> 3, schunk = tid & 7;
    const int swzw = (srow0 >> 1) & 7;
    const int wofs = srow0 * 128 + ((schunk ^ swzw) << 4);
    const bool vswap0 = (srow0 >> 4) & 1;
    const int x = (l31 >> 1) & 7;
    const int kofs = l31 * 128 + ((hi ^ x) << 4);
    const int vofs = 16384 + l31 * 128 + ((0 ^ x) << 4) + 8 * (hi ^ (l31 >> 4));
    bf16x8 qf[4];
    { const bf16_t* qr = Qp + (size_t)(wid * 32 + l31) * 512 + hi * 8;
#pragma unroll
      for (int s = 0; s < 4; ++s) qf[s] = *(const bf16x8*)(qr + s * 16); }
    auto tile_pos = [&](int j) { return j < nctx ? 64 * j : CTX_LEN + 64 * (lt0 + j - nctx); };
    u32x4 rk[2], rv[2];
    auto gload = [&](int j) { const int pos = tile_pos(j);
#pragma unroll
        for (int i = 0; i < 2; ++i) { rk[i] = *(const u32x4*)(Kp + (size_t)(pos + srow0 + 32 * i) * 64 + schunk * 8); rv[i] = *(const u32x4*)(Vt + (size_t)(srow0 + 32 * i) * LKV + pos + schunk * 8); } };
    auto lstore = [&](int buf) {
#pragma unroll
        for (int i = 0; i < 2; ++i) { *(u32x4*)(lds + buf * 8192 + wofs + i * 4096) = rk[i]; u32x4 v = rv[i]; if (vswap0) v = (u32x4){v.z, v.w, v.x, v.y}; *(u32x4*)(lds + 16384 + buf * 8192 + wofs + i * 4096) = v; } };
    f32x16 o0 = {}, o1 = {};
    float m = NEG_BIG, l = 0.f;
    const int sq = s0 + wid * 32 + l31;
    int rq = 0, cq = 0, rsq = 0, csq = 0;
    if (MODE == 2) { rq = sq / GRID_W; cq = sq % GRID_W; rsq = rq - B_WIN_H / 2; rsq = rsq < 0 ? 0 : (rsq > GRID_H - B_WIN_H ? GRID_H - B_WIN_H : rsq); csq = cq - B_WIN_W / 2; csq = csq < 0 ? 0 : (csq > GRID_W - B_WIN_W ? GRID_W - B_WIN_W : csq); }
    gload(0); lstore(0);
    __syncthreads();
    for (int j = 0; j < ntiles; ++j) {
        const int buf = j & 1; const bool more = j + 1 < ntiles;
        if (more) gload(j + 1);
        const char* Kb = lds + buf * 8192; const char* Vb = lds + buf * 8192;
        f32x16 p0 = {}, p1 = {};
#pragma unroll
        for (int s = 0; s < 4; ++s) {
            const bf16x8 k0 = *(const bf16x8*)(Kb + (kofs ^ (s << 5))); const bf16x8 k1 = *(const bf16x8*)(Kb + 4096 + (kofs ^ (s << 5)));
            p0 = __builtin_amdgcn_mfma_f32_32x32x16_bf16(k0, qf[s], p0, 0, 0, 0); p1 = __builtin_amdgcn_mfma_f32_32x32x16_bf16(k1, qf[s], p1, 0, 0, 0);
        }
        float tmax = NEG_BIG;
        if (MODE == 0 || j < nctx) {
#pragma unroll
            for (int r = 0; r < 16; ++r) { p0[r] *= QK_C; p1[r] *= QK_C; tmax = fmaxf(tmax, fmaxf(p0[r], p1[r])); }
        } else if (MODE == 1) {
            const int sk0 = 64 * (lt0 + j - nctx);
#pragma unroll
            for (int r = 0; r < 16; ++r) { const int d0 = sk0 + crow(r, hi) - sq, d1 = d0 + 32;
                p0[r] = (d0 >= -A_WINDOW && d0 <= A_WINDOW) ? p0[r] * QK_C : NEG_BIG; p1[r] = (d1 >= -A_WINDOW && d1 <= A_WINDOW) ? p1[r] * QK_C : NEG_BIG; tmax = fmaxf(tmax, fmaxf(p0[r], p1[r])); }
        } else {
            const int kr = lt0 + j - nctx; const bool rowok = kr >= rsq && kr < rsq + B_WIN_H;
            const float* brow = bias_s + (kr - rq + B_WIN_H - 1) * 31 + (B_WIN_W - 1) - cq;
#pragma unroll
            for (int r = 0; r < 16; ++r) { const int kc0 = crow(r, hi), kc1 = kc0 + 32;
                const bool ok0 = rowok && kc0 >= csq && kc0 < csq + B_WIN_W, ok1 = rowok && kc1 >= csq && kc1 < csq + B_WIN_W;
                p0[r] = ok0 ? p0[r] * QK_C + brow[kc0] : NEG_BIG; p1[r] = ok1 ? p1[r] * QK_C + brow[kc1] : NEG_BIG; tmax = fmaxf(tmax, fmaxf(p0[r], p1[r])); }
        }
        tmax = fmaxf(tmax, __shfl_xor(tmax, 32));
        const float mn = fmaxf(m, tmax), alpha = __builtin_amdgcn_exp2f(m - mn); m = mn;
        float ls = 0.f;
#pragma unroll
        for (int r = 0; r < 16; ++r) { p0[r] = __builtin_amdgcn_exp2f(p0[r] - mn); p1[r] = __builtin_amdgcn_exp2f(p1[r] - mn); ls += p0[r] + p1[r]; }
        l = l * alpha + ls;
#pragma unroll
        for (int r = 0; r < 16; ++r) { o0[r] *= alpha; o1[r] *= alpha; }
        bf16x8 pf[4];
        { u32x4 w;
          w.x = cvtpk(p0[0], p0[1]); w.y = cvtpk(p0[2], p0[3]); w.z = cvtpk(p0[4], p0[5]); w.w = cvtpk(p0[6], p0[7]); pf[0] = __builtin_bit_cast(bf16x8, w);
          w.x = cvtpk(p0[8], p0[9]); w.y = cvtpk(p0[10], p0[11]); w.z = cvtpk(p0[12], p0[13]); w.w = cvtpk(p0[14], p0[15]); pf[1] = __builtin_bit_cast(bf16x8, w);
          w.x = cvtpk(p1[0], p1[1]); w.y = cvtpk(p1[2], p1[3]); w.z = cvtpk(p1[4], p1[5]); w.w = cvtpk(p1[6], p1[7]); pf[2] = __builtin_bit_cast(bf16x8, w);
          w.x = cvtpk(p1[8], p1[9]); w.y = cvtpk(p1[10], p1[11]); w.z = cvtpk(p1[12], p1[13]); w.w = cvtpk(p1[14], p1[15]); pf[3] = __builtin_bit_cast(bf16x8, w); }
#pragma unroll
        for (int s = 0; s < 4; ++s) {
            const int a0 = vofs ^ (s << 5);
            u32x2 va = *(const u32x2*)(Vb + a0), vb = *(const u32x2*)(Vb + (a0 ^ 16));
            u32x2 vc = *(const u32x2*)(Vb + 4096 + a0), vd = *(const u32x2*)(Vb + 4096 + (a0 ^ 16));
            const bf16x8 f0 = __builtin_bit_cast(bf16x8, (u32x4){va.x, va.y, vb.x, vb.y}), f1 = __builtin_bit_cast(bf16x8, (u32x4){vc.x, vc.y, vd.x, vd.y});
            o0 = __builtin_amdgcn_mfma_f32_32x32x16_bf16(f0, pf[s], o0, 0, 0, 0); o1 = __builtin_amdgcn_mfma_f32_32x32x16_bf16(f1, pf[s], o1, 0, 0, 0);
        }
        if (more) lstore(buf ^ 1);
        __syncthreads();
    }
    l += __shfl_xor(l, 32);
    if (has_sink) l += __builtin_amdgcn_exp2f(sink2 - m);
    const float inv = 1.0f / l;
    bf16_t* orow = Op + (size_t)(wid * 32 + l31) * 1024;
#pragma unroll
    for (int g4 = 0; g4 < 4; ++g4) {
        u32x2 w; w.x = cvtpk(o0[g4 * 4 + 0] * inv, o0[g4 * 4 + 1] * inv); w.y = cvtpk(o0[g4 * 4 + 2] * inv, o0[g4 * 4 + 3] * inv); *(u32x2*)(orow + 8 * g4 + 4 * hi) = w;
        w.x = cvtpk(o1[g4 * 4 + 0] * inv, o1[g4 * 4 + 1] * inv); w.y = cvtpk(o1[g4 * 4 + 2] * inv, o1[g4 * 4 + 3] * inv); *(u32x2*)(orow + 32 + 8 * g4 + 4 * hi) = w;
    }
}

constexpr int NU_LAT = BATCH * 8 * (SEQ / 128);
constexpr int NU_CTX = BATCH * 8 * (CTX_LEN / 128);
__device__ __forceinline__ void ph_attn0(const Params& p, char* lds, int bid, int nb) {
    for (int u = bid; u < 2 * NU_LAT + 2 * NU_CTX; u += nb) {
        if (u < NU_LAT) {
            const int blk = u % (SEQ / 128), h = (u / (SEQ / 128)) % 8, b = u / (8 * (SEQ / 128)); const int s0 = blk * 128, r0 = s0 / GRID_W;
            int rs0 = r0 - 4; rs0 = rs0 < 0 ? 0 : (rs0 > GRID_H - 8 ? GRID_H - 8 : rs0); int rs1 = r0 + 1 - 4; rs1 = rs1 < 0 ? 0 : (rs1 > GRID_H - 8 ? GRID_H - 8 : rs1);
            attn_unit<2>(lds, p.QB + (size_t)(b * SEQ + s0) * 512 + h * 64, p.KB + (size_t)(b * 8 + h) * LKV * 64, p.VBt + (size_t)(b * 8 + h) * 64 * LKV,
                         p.Y + (size_t)(b * SEQ + s0) * 1024 + 512 + h * 64, s0, CTX_LEN / 64, rs0, rs1 + 8 - rs0, 0.f, false, p.b_rpb + h * 15 * 31);
        } else if (u < 2 * NU_LAT) {
            const int v = u - NU_LAT; const int blk = v % (SEQ / 128), h = (v / (SEQ / 128)) % 8, b = v / (8 * (SEQ / 128)); const int s0 = blk * 128;
            int t0 = (s0 - 128) / 64; if (t0 < 0) t0 = 0; int t1 = (s0 + 255) / 64; if (t1 > SEQ / 64 - 1) t1 = SEQ / 64 - 1;
            attn_unit<1>(lds, p.QA + (size_t)(b * SEQ + s0) * 512 + h * 64, p.KA + (size_t)(b * 2 + h / 4) * LKV * 64, p.VAt + (size_t)(b * 2 + h / 4) * 64 * LKV,
                         p.Y + (size_t)(b * SEQ + s0) * 1024 + h * 64, s0, CTX_LEN / 64, t0, t1 - t0 + 1, p.a_sink[h] * LOG2E, true, nullptr);
        } else {
            const int v = u - 2 * NU_LAT; const int ty = v / NU_CTX, w = v % NU_CTX; const int blk = w % (CTX_LEN / 128), h = (w / (CTX_LEN / 128)) % 8, b = w / (8 * (CTX_LEN / 128));
            const int row0 = TX + b * CTX_LEN + blk * 128;
            if (ty == 0) attn_unit<0>(lds, p.QA + (size_t)row0 * 512 + h * 64, p.KA + (size_t)(b * 2 + h / 4) * LKV * 64, p.VAt + (size_t)(b * 2 + h / 4) * 64 * LKV, p.Y + (size_t)row0 * 1024 + h * 64, 0, CTX_LEN / 64, 0, 0, p.a_sink[h] * LOG2E, true, nullptr);
            else attn_unit<0>(lds, p.QB + (size_t)row0 * 512 + h * 64, p.KB + (size_t)(b * 8 + h) * LKV * 64, p.VBt + (size_t)(b * 8 + h) * 64 * LKV, p.Y + (size_t)row0 * 1024 + 512 + h * 64, 0, CTX_LEN / 64, 0, 0, 0.f, false, nullptr);
        }
    }
}
__device__ __forceinline__ void ph_attnC(const Params& p, char* lds, int bid, int nb) {
    for (int u = bid; u < NU_LAT; u += nb) {
        const int blk = u % (SEQ / 128), h = (u / (SEQ / 128)) % 8, b = u / (8 * (SEQ / 128)); const int s0 = blk * 128;
        attn_unit<0>(lds, p.QC + (size_t)(b * SEQ + s0) * 512 + h * 64, p.KC + (size_t)(b * 2 + h / 4) * LKV * 64, p.VCt + (size_t)(b * 2 + h / 4) * 64 * LKV,
                     p.Y + (size_t)(b * SEQ + s0) * 1024 + h * 64, s0, CTX_LEN / 64, 0, SEQ / 64, 0.f, false, nullptr);
    }
}
#ifdef HY_TEST
#define HY_OUT(b, t, v) p.YHT[((size_t)(b) * D_CH + c) * SEQ + (t)] = f2bf(v)
#else
#define HY_OUT(b, t, v) p.YHT[((size_t)(b) * D_CH + c) * SEQ + (t)] = f2bf(v)
#endif
#ifdef CPU_TEST
#define FOR_T for (int tid = 0; tid < 256; ++tid)
#define HSYNC
#define HST(t) st[t]
#define HY_DECL HySt* st = new HySt[256]
#define HY_FREE delete[] st
static inline void sincos_rev(float a, float& c, float& s) { c = cosf(6.283185307179586f * a); s = sinf(6.283185307179586f * a); }
#else
__device__ __forceinline__ int hy_launder(int v) { asm volatile("" : "+v"(v)); return v; }
#define FOR_T if (const int tid = hy_launder((int)threadIdx.x); true)
#define HSYNC __syncthreads()
#define HST(t) st
#define HY_DECL HySt st
#define HY_FREE
__device__ __forceinline__ void sincos_rev(float a, float& c, float& s) { c = __builtin_amdgcn_cosf(a); s = __builtin_amdgcn_sinf(a); }
#endif
constexpr int FN = 2 * SEQ;
constexpr int FPAD = FN + (FN >> 5);
#if !defined(SMALL_CFG)
static_assert(FN == 8192, "pass plan 8,8,8,16 is for N = 8192");
constexpr int R4 = 16;
constexpr int NS4 = 512;
#else
constexpr int R4 = 2;
constexpr int NS4 = 512;
#endif
constexpr int NB8 = FN / 8 / 256;
constexpr int NB4 = FN / R4 / 256;
constexpr int EPT = FN / 256;
struct HySt { float xr[EPT], xi[EPT], kr[EPT], ki[EPT]; };
HD int pidx(int i) { return i + (i >> 5); }

constexpr float W16C[8] = {1.0f, 0.9238795325112867f, 0.7071067811865476f, 0.3826834323650898f, 0.0f, -0.3826834323650898f, -0.7071067811865476f, -0.9238795325112867f};
constexpr float W16S[8] = {0.0f, -0.3826834323650898f, -0.7071067811865476f, -0.9238795325112867f, -1.0f, -0.9238795325112867f, -0.7071067811865476f, -0.3826834323650898f};
template <int R> HD void fft_reg(float* xr, float* xi) {
    constexpr int LG = R == 16 ? 4 : (R == 8 ? 3 : (R == 4 ? 2 : 1));
#pragma unroll
    for (int sg = 0; sg < LG; ++sg) {
        const int h = (R / 2) >> sg;
#pragma unroll
        for (int pr = 0; pr < R / 2; ++pr) {
            const int blk = (pr / h) * 2 * h, i = pr % h;
            const int a = blk + i, b = blk + i + h;
            const float ar = xr[a], ai = xi[a], br = xr[b], bi = xi[b];
            xr[a] = ar + br; xi[a] = ai + bi;
            const float tr = ar - br, ti = ai - bi;
            const int tw = i * (8 / h);
            if (tw == 0) { xr[b] = tr; xi[b] = ti; }
            else if (tw == 4) { xr[b] = ti; xi[b] = -tr; }
            else { const float c = W16C[tw & 7], s = W16S[tw & 7]; xr[b] = tr * c - ti * s; xi[b] = tr * s + ti * c; }
        }
    }
}
template <int R> HD constexpr int bitrev(int i) { int r = 0; for (int b = 1; b < R; b <<= 1) { r = (r << 1) | (i & 1); i >>= 1; } return r; }

template <int R, int NB, class In> HD void pass_load(int tid, HySt& s, const In& in) {
#pragma unroll
    for (int b = 0; b < NB; ++b)
#pragma unroll
        for (int r = 0; r < R; ++r) in(tid + 256 * b + (FN / R) * r, s.xr[b * R + r], s.xi[b * R + r]);
}
template <int R, int NB, class Out> HD void pass_compute(int tid, HySt& s, int Ns, const Out& out) {
#pragma unroll
    for (int b = 0; b < NB; ++b) {
        const int j = tid + 256 * b, k = j & (Ns - 1);
        float* xr = s.xr + b * R; float* xi = s.xi + b * R;
        if (Ns > 1) {
            float wc, ws; sincos_rev(-(float)k / (float)(Ns * R), wc, ws);
            float cr = wc, ci = ws;
#pragma unroll
            for (int r = 1; r < R; ++r) {
                const float vr = xr[r], vi = xi[r]; xr[r] = vr * cr - vi * ci; xi[r] = vr * ci + vi * cr;
                const float nr = cr * wc - ci * ws, ni = cr * ws + ci * wc; cr = nr; ci = ni;
            }
        }
        fft_reg<R>(xr, xi);
        const int j0 = (j - k) * R + k;
#pragma unroll
        for (int i = 0; i < R; ++i) out(j0 + bitrev<R>(i) * Ns, b, bitrev<R>(i), xr[i], xi[i]);
    }
}
struct LdsIn { const float* re; const float* im; HD void operator()(int idx, float& r, float& i) const { r = re[pidx(idx)]; i = im[pidx(idx)]; } };
struct LdsOut { float* re; float* im; HD void operator()(int idx, int, int, float r, float i) const { re[pidx(idx)] = r; im[pidx(idx)] = i; } };

HD float hy_sc_ut(const bf16_t* u, const float* sw3, float sb, int t) {
    float acc = sb;
    if (t > 0) acc += sw3[0] * bf2f(u[t - 1]);
    acc += sw3[1] * bf2f(u[t]);
    if (t < SEQ - 1) acc += sw3[2] * bf2f(u[t + 1]);
    return acc;
}

HD void hyena_channel(const Params& p, int c, float* lds) {
    HY_DECL;
    float* re = lds; float* im = lds + FPAD;
    const LdsIn lin{re, im}; const LdsOut lout{re, im};
    float nrm[2];
#pragma unroll
    for (int o = 0; o < 2; ++o) {
        const float* hf = p.HFT + (size_t)((0 * 2 + o) * D_CH + c) * SEQ; const float* hb = p.HFT + (size_t)((1 * 2 + o) * D_CH + c) * SEQ;
        FOR_T { float sacc = 0.f; for (int i = 0; i < SEQ / 256; ++i) sacc += fabsf(hf[tid + 256 * i]) + fabsf(hb[tid + 256 * i]); re[tid] = sacc; }
        HSYNC;
        { float tot = 0.f; for (int i = 0; i < 256; ++i) tot += re[i]; nrm[o] = tot + EPS; }
        HSYNC;
    }
    float sw[3][3], sbv[3];
#pragma unroll
    for (int q = 0; q < 3; ++q) { sbv[q] = p.hy_short_b[q * D_CH + c];
#pragma unroll
        for (int kk = 0; kk < 3; ++kk) sw[q][kk] = p.hy_short_w[kk * 3 * D_CH + q * D_CH + c]; }
#pragma unroll 1
    for (int o = 0; o < 2; ++o) {
        const float* hf = p.HFT + (size_t)((0 * 2 + o) * D_CH + c) * SEQ; const float* hb = p.HFT + (size_t)((1 * 2 + o) * D_CH + c) * SEQ;
        const float inv = 1.0f / (o == 0 ? nrm[0] : nrm[1]); const float hbias = p.hy_bias[o * D_CH + c];
        float swg[3]; swg[0] = o == 0 ? sw[1][0] : sw[2][0]; swg[1] = o == 0 ? sw[1][1] : sw[2][1]; swg[2] = o == 0 ? sw[1][2] : sw[2][2]; const float sbg = o == 0 ? sbv[1] : sbv[2];
        FOR_T { pass_load<8, NB8>(tid, HST(tid), [&](int idx, float& r, float& i) __attribute__((always_inline)) { r = idx < SEQ ? hf[idx] * inv : (idx == SEQ ? 0.f : hb[FN - idx] * inv); i = 0.f; });
                pass_compute<8, NB8>(tid, HST(tid), 1, lout); }
        HSYNC;
        FOR_T { pass_load<8, NB8>(tid, HST(tid), lin); } HSYNC; FOR_T { pass_compute<8, NB8>(tid, HST(tid), 8, lout); } HSYNC;
        FOR_T { pass_load<8, NB8>(tid, HST(tid), lin); } HSYNC; FOR_T { pass_compute<8, NB8>(tid, HST(tid), 64, lout); } HSYNC;
        FOR_T { pass_load<R4, NB4>(tid, HST(tid), lin);
                HySt& s = HST(tid); pass_compute<R4, NB4>(tid, s, NS4, [&](int, int b, int rr, float r, float i) __attribute__((always_inline)) { s.kr[b + NB4 * rr] = r; s.ki[b + NB4 * rr] = i; }); }
        HSYNC;
        for (int bp = 0; bp < BATCH / 2; ++bp) {
            const int b0 = 2 * bp, b1 = 2 * bp + 1;
            const bf16_t* u0 = p.UT + ((size_t)b0 * 3 * D_CH + c) * SEQ; const bf16_t* u1 = p.UT + ((size_t)b1 * 3 * D_CH + c) * SEQ;
            const float* z0 = p.Z1 + ((size_t)b0 * D_CH + c) * SEQ; const float* z1 = p.Z1 + ((size_t)b1 * D_CH + c) * SEQ;
            auto zval = [&](int b, int t) __attribute__((always_inline)) { return o == 0 ? hy_sc_ut(b == b0 ? u0 : u1, sw[0], sbv[0], t) : (b == b0 ? z0 : z1)[t]; };
            FOR_T { pass_load<8, NB8>(tid, HST(tid), [&](int idx, float& r, float& i) __attribute__((always_inline)) { if (idx < SEQ) { r = zval(b0, idx); i = zval(b1, idx); } else { r = 0.f; i = 0.f; } });
                    pass_compute<8, NB8>(tid, HST(tid), 1, lout); }
            HSYNC;
            FOR_T { pass_load<8, NB8>(tid, HST(tid), lin); } HSYNC; FOR_T { pass_compute<8, NB8>(tid, HST(tid), 8, lout); } HSYNC;
            FOR_T { pass_load<8, NB8>(tid, HST(tid), lin); } HSYNC; FOR_T { pass_compute<8, NB8>(tid, HST(tid), 64, lout); } HSYNC;
            FOR_T { pass_load<R4, NB4>(tid, HST(tid), lin); } HSYNC;
            FOR_T { HySt& s = HST(tid); pass_compute<R4, NB4>(tid, s, NS4, [&](int idx, int b, int rr, float r, float i) __attribute__((always_inline)) { const float kr = s.kr[b + NB4 * rr], ki = s.ki[b + NB4 * rr];
                        re[pidx(idx)] = r * kr - i * ki; im[pidx(idx)] = -(r * ki + i * kr); }); }
            HSYNC;
            FOR_T { pass_load<8, NB8>(tid, HST(tid), lin); } HSYNC; FOR_T { pass_compute<8, NB8>(tid, HST(tid), 1, lout); } HSYNC;
            FOR_T { pass_load<8, NB8>(tid, HST(tid), lin); } HSYNC; FOR_T { pass_compute<8, NB8>(tid, HST(tid), 8, lout); } HSYNC;
            FOR_T { pass_load<8, NB8>(tid, HST(tid), lin); } HSYNC; FOR_T { pass_compute<8, NB8>(tid, HST(tid), 64, lout); } HSYNC;
            FOR_T { pass_load<R4, NB4>(tid, HST(tid), lin);
                    const bf16_t* g0 = p.UT + ((size_t)b0 * 3 * D_CH + (o + 1) * D_CH + c) * SEQ; const bf16_t* g1 = p.UT + ((size_t)b1 * 3 * D_CH + (o + 1) * D_CH + c) * SEQ;
                    pass_compute<R4, NB4>(tid, HST(tid), NS4, [&](int idx, int, int, float r, float i) __attribute__((always_inline)) {
                        if (idx < SEQ) {
                            const float y0 = r * (1.0f / FN), y1 = -i * (1.0f / FN);
                            const float zn0 = hy_sc_ut(g0, swg, sbg, idx) * (y0 + zval(b0, idx) * hbias);
                            const float zn1 = hy_sc_ut(g1, swg, sbg, idx) * (y1 + zval(b1, idx) * hbias);
                            if (o == 0) { p.Z1[((size_t)b0 * D_CH + c) * SEQ + idx] = zn0; p.Z1[((size_t)b1 * D_CH + c) * SEQ + idx] = zn1; }
                            else { HY_OUT(b0, idx, zn0); HY_OUT(b1, idx, zn1); }
                        } }); }
            HSYNC;
        }
    }
    HY_FREE;
}
constexpr int MOD_ITEMS = DEPTH * (6 * D_MODEL / 64);
__device__ __forceinline__ void mod_item(const Params& p, char* lds, int item) {
    float* sc = (float*)lds;
    float* red = sc + 5 * D_MODEL;
    const int tid = threadIdx.x, l = item / (6 * D_MODEL / 64), j0 = (item % (6 * D_MODEL / 64)) * 64;
    for (int i = tid; i < 5 * D_MODEL; i += NTHREADS) { const int r = i / D_MODEL, k = i % D_MODEL; const float v = r < BATCH ? p.c[r * D_MODEL + k] : p.c_ctx[k]; sc[i] = silu_f(v); }
    __syncthreads();
    const int col = tid & 63, kp = tid >> 6;
    const float* w = p.w_ada + ((size_t)l * D_MODEL + kp * 256) * 6 * D_MODEL + j0 + col;
    float a0 = 0.f, a1 = 0.f, a2 = 0.f, a3 = 0.f, a4 = 0.f;
#pragma unroll 8
    for (int k = 0; k < 256; ++k) { const float wv = w[(size_t)k * 6 * D_MODEL]; const int kk = kp * 256 + k;
        a0 += sc[kk] * wv; a1 += sc[D_MODEL + kk] * wv; a2 += sc[2 * D_MODEL + kk] * wv; a3 += sc[3 * D_MODEL + kk] * wv; a4 += sc[4 * D_MODEL + kk] * wv; }
    red[(kp * 5 + 0) * 64 + col] = a0; red[(kp * 5 + 1) * 64 + col] = a1; red[(kp * 5 + 2) * 64 + col] = a2; red[(kp * 5 + 3) * 64 + col] = a3; red[(kp * 5 + 4) * 64 + col] = a4;
    __syncthreads();
    for (int i = tid; i < 5 * 64; i += NTHREADS) { const int r = i / 64, cc = i % 64;
        const float v = red[(0 * 5 + r) * 64 + cc] + red[(1 * 5 + r) * 64 + cc] + red[(2 * 5 + r) * 64 + cc] + red[(3 * 5 + r) * 64 + cc];
        p.mod[((size_t)(l * (BATCH + 1) + r)) * 6 * D_MODEL + j0 + cc] = v + p.b_ada[l * 6 * D_MODEL + j0 + cc]; }
    __syncthreads();
}
constexpr int FILT_ITEMS = (SEQ / 256) * (4 * D_CH / 64);
__device__ __forceinline__ void filt_item(const Params& p, char* lds, int item) {
    float* ws = (float*)lds;
    const int tid = threadIdx.x, tb = item % (SEQ / 256), cb = item / (SEQ / 256); const int t = tb * 256 + tid, col0 = cb * 64;
#pragma unroll
    for (int i = 0; i < 16; ++i) { const int k = i * 4 + (tid >> 6), cc = tid & 63; ws[cc * 68 + k] = p.hy_w3[(size_t)k * 4 * D_CH + col0 + cc]; }
    f32x4 h[16];
#pragma unroll
    for (int i = 0; i < 16; ++i) h[i] = *(const f32x4*)(p.h2 + (size_t)t * HY_FFN + i * 4);
    __syncthreads();
    const float tn = (float)t / (float)(SEQ - 1);
    const float mind = logf(1e-2f) / 1.5f, maxd = logf(1e-2f) / 0.3f;
#pragma unroll 2
    for (int cc = 0; cc < 64; ++cc) {
        const int col = col0 + cc; const f32x4* w = (const f32x4*)(ws + cc * 68);
        float acc = p.hy_b3[col];
#pragma unroll
        for (int i = 0; i < 16; ++i) { const f32x4 wv = w[i]; acc += h[i][0] * wv[0] + h[i][1] * wv[1] + h[i][2] * wv[2] + h[i][3] * wv[3]; }
        const float delta = fabsf(mind + (float)(col % D_CH) * (maxd - mind) / (float)(D_CH - 1));
        p.HFT[(size_t)col * SEQ + t] = acc * expf(-tn * delta);
    }
    __syncthreads();
}
__device__ __forceinline__ void ph_norm(const Params& p, int l, int which, int nrows, int bid, int nb) {
    const int lane = threadIdx.x & 63, wid = threadIdx.x >> 6;
    for (int row = bid * 4 + wid; row < nrows; row += nb * 4) {
        const float* xr = which == 0 ? xrow_in(p, l, row) : xrow_cur(p, row);
        const float* g = p.norm_g + (l * 2 + which) * D_MODEL; const float* sh = modp(p, l, row, which * 3 + 0); const float* sc = modp(p, l, row, which * 3 + 1);
        f32x4 v[4]; float ss = 0.f;
#pragma unroll
        for (int j = 0; j < 4; ++j) { v[j] = *(const f32x4*)(xr + j * 256 + lane * 4); ss += v[j][0] * v[j][0] + v[j][1] * v[j][1] + v[j][2] * v[j][2] + v[j][3] * v[j][3]; }
        const float rstd = 1.0f / sqrtf(wave_sum(ss) * (1.0f / D_MODEL) + EPS);
#pragma unroll
        for (int j = 0; j < 4; ++j) { const int c = j * 256 + lane * 4; const f32x4 o = v[j] * rstd * *(const f32x4*)(g + c) * (*(const f32x4*)(sc + c) + 1.0f) + *(const f32x4*)(sh + c);
            store4bf(p.hbuf + (size_t)row * D_MODEL + c, o); }
    }
}
__device__ __forceinline__ void ph_route_a(const Params& p, char* lds, int l, int nrows, int bid, int nb) {
    const int lane = threadIdx.x & 63, wid = threadIdx.x >> 6;
    float* wr_s = (float*)lds; int* hist = (int*)(lds + 65536);
    for (int i = threadIdx.x; i < D_MODEL * 4; i += NTHREADS) { const int k = i >> 2, ch = i & 3; ((f32x4*)wr_s)[k * 4 + (ch ^ ((k >> 2) & 3))] = ((const f32x4*)p.w_router)[i]; }
    if (threadIdx.x < 32) hist[threadIdx.x] = 0;
    __syncthreads();
    const int sw = (lane >> 2) & 3;
    const float* g = p.norm_g + (l * 2 + 1) * D_MODEL;
    const int RPB = (nrows + nb - 1) / nb, r0 = bid * RPB;
    for (int j = wid; j < RPB; j += 4) {
        const int row = r0 + j; if (row >= nrows) break;
        const float* xr = xrow_cur(p, row); const float* sh = modp(p, l, row, 3); const float* sc = modp(p, l, row, 4);
        float v[16]; float ss = 0.f;
#pragma unroll
        for (int i = 0; i < 16; ++i) { v[i] = xr[lane + 64 * i]; ss += v[i] * v[i]; }
        const float rstd = 1.0f / sqrtf(wave_sum(ss) * (1.0f / D_MODEL) + EPS);
        float lg[16];
#pragma unroll
        for (int e = 0; e < 16; ++e) lg[e] = 0.f;
#pragma unroll
        for (int i = 0; i < 16; ++i) { const int k = lane + 64 * i; const float o = v[i] * rstd * g[k] * (sc[k] + 1.0f) + sh[k];
            p.hbuf[(size_t)row * D_MODEL + k] = f2bf(o);
            const f32x4* w4 = (const f32x4*)(wr_s + k * 16);
#pragma unroll
            for (int e4 = 0; e4 < 4; ++e4) { const f32x4 wv = w4[e4 ^ sw]; lg[e4 * 4 + 0] += o * wv[0]; lg[e4 * 4 + 1] += o * wv[1]; lg[e4 * 4 + 2] += o * wv[2]; lg[e4 * 4 + 3] += o * wv[3]; }
            if (i & 1) __builtin_amdgcn_sched_barrier(0); }
#pragma unroll
        for (int e = 0; e < 16; ++e) lg[e] = wave_sum(lg[e]);
        if (lane == 0) {
            int gbest = 0, a = 0, bb = 1; float gbs = -1e30f, wa = 0.f, wb = 0.f;
#pragma unroll
            for (int gI = 0; gI < 4; ++gI) {
                float m1 = -1e30f, m2 = -1e30f, s1 = 0.f, s2 = 0.f; int i1 = 0, i2 = 0;
#pragma unroll
                for (int jj = 0; jj < 4; ++jj) { float sgv = sigmoid_f(lg[gI * 4 + jj]); float vv = sgv + p.b_router[gI * 4 + jj];
                    if (vv > m1) { m2 = m1; i2 = i1; s2 = s1; m1 = vv; i1 = jj; s1 = sgv; } else if (vv > m2) { m2 = vv; i2 = jj; s2 = sgv; } }
                float gs = m1 + m2;
                if (gs > gbs) { gbs = gs; gbest = gI; if (i1 < i2) { a = i1; bb = i2; wa = s1; wb = s2; } else { a = i2; bb = i1; wa = s2; wb = s1; } }
            }
            const float inv = 1.0f / (wa + wb);
            const int pidx = a == 0 ? bb - 1 : (a == 1 ? bb + 1 : 5);
            const int pr = gbest * 6 + pidx;
            p.rpair[row] = pr; p.tokw[row * 2 + 0] = wa * inv; p.tokw[row * 2 + 1] = wb * inv;
            atomicAdd(&hist[pr], 1);
        }
    }
    __syncthreads();
    if (threadIdx.x < 32) p.bh[bid * 32 + threadIdx.x] = hist[threadIdx.x];
}
__device__ __forceinline__ void ph_route_b(const Params& p, char* lds, int l, int nrows, int bid, int nb) {
    int* sb = (int*)lds;
    const int t = threadIdx.x, pr = t & 31, part = t >> 5;
    { int s_before = 0, s_all = 0; const int b0 = (part * nb) >> 3, b1 = ((part + 1) * nb) >> 3;
      for (int b = b0; b < b1; ++b) { const int c = p.bh[b * 32 + pr]; s_all += c; if (b < bid) s_before += c; }
      sb[part * 32 + pr] = s_before; sb[256 + part * 32 + pr] = s_all; }
    __syncthreads();
    if (t < 32) { int a = 0, c = 0;
#pragma unroll
        for (int q = 0; q < 8; ++q) { a += sb[q * 32 + t]; c += sb[256 + q * 32 + t]; }
        sb[512 + t] = a; sb[544 + t] = c; if (bid == 0) p.cnt[l * 32 + t] = c; }
    const int RPB = (nrows + nb - 1) / nb, row = bid * RPB + t; const bool act = t < RPB && row < nrows;
    int myp = 0; if (act) { myp = p.rpair[row]; sb[576 + t] = myp; }
    __syncthreads();
    if (act) { int rank = 0; for (int j = 0; j < t; ++j) rank += (sb[576 + j] == myp) ? 1 : 0; p.list[(size_t)myp * TT + sb[512 + myp] + rank] = row; }
    __syncthreads();
}
__device__ __forceinline__ void ph_final(const Params& p, int bid, int nb) {
    const int lane = threadIdx.x & 63, wid = threadIdx.x >> 6;
    for (int row = bid * 4 + wid; row < TX; row += nb * 4) {
        float* xr = p.out + (size_t)row * D_MODEL;
        f32x4 v[4]; float ss = 0.f;
#pragma unroll
        for (int j = 0; j < 4; ++j) { v[j] = *(const f32x4*)(xr + j * 256 + lane * 4); ss += v[j][0] * v[j][0] + v[j][1] * v[j][1] + v[j][2] * v[j][2] + v[j][3] * v[j][3]; }
        const float rstd = 1.0f / sqrtf(wave_sum(ss) * (1.0f / D_MODEL) + EPS);
#pragma unroll
        for (int j = 0; j < 4; ++j) { const int c = j * 256 + lane * 4; *(f32x4*)(xr + c) = v[j] * rstd * *(const f32x4*)(p.final_g + c); }
    }
}

#define XB_TMO      128
#define XB_XCNT(j)  (256  + 64 * (j))
#define XB_XSUB(j)  (1280 + 64 * (j))
#define XB_XGEN(j)  (2304 + 64 * (j))
#define XB_TOP      3328
#define XB_TOPGEN   3392
#define XCD_BAR_WORDS 3456
#define XB_SPIN_CAP (1u << 20)
__device__ __forceinline__ unsigned xb_ld(unsigned* p)              { return __hip_atomic_load(p, __ATOMIC_RELAXED, __HIP_MEMORY_SCOPE_AGENT); }
__device__ __forceinline__ unsigned xb_add(unsigned* p, unsigned v) { return __hip_atomic_fetch_add(p, v, __ATOMIC_RELAXED, __HIP_MEMORY_SCOPE_AGENT); }
__device__ __forceinline__ unsigned xb_xcc_id() { return (unsigned)__builtin_amdgcn_s_getreg((3 << 11) | 20) & 0xFu; }
#define XB_SPIN(cond, bar) do { unsigned _sp = 0; while (cond) { __builtin_amdgcn_s_sleep(1); \
    if ((++_sp & 255u) == 0u) { if (xb_ld(&(bar)[XB_TMO])) break; if (_sp > XB_SPIN_CAP) { atomicAdd(&(bar)[XB_TMO], 1u); break; } } } } while (0)
struct XcdBarrier { unsigned* bar; unsigned x; volatile LAS unsigned* st; };
__device__ __forceinline__ XcdBarrier xcd_barrier_post(unsigned* bar, volatile LAS unsigned* st) {
    XcdBarrier b; b.bar = bar; b.x = xb_xcc_id(); b.st = st;
    if (threadIdx.x == 0) (void)xb_add(&bar[XB_XCNT(b.x)], 1u);
    return b;
}
__device__ __forceinline__ void xcd_barrier_complete(unsigned* bar, unsigned x, unsigned& nloc, unsigned& nx) {
    const unsigned G = gridDim.x * gridDim.y * gridDim.z;
    unsigned sum, cnt, mine, sp = 0u;
    for (;;) {
        sum = 0u; cnt = 0u; mine = 0u;
#pragma unroll
        for (unsigned j = 0; j < 16; ++j) { const unsigned c = xb_ld(&bar[XB_XCNT(j)]); sum += c; cnt += (c > 0u) ? 1u : 0u; mine = (j == x) ? c : mine; }
        if (sum == G) break;
        __builtin_amdgcn_s_sleep(1);
        if ((++sp & 255u) == 0u) { if (xb_ld(&bar[XB_TMO])) break; if (sp > XB_SPIN_CAP) { atomicAdd(&bar[XB_TMO], 1u); break; } }
    }
    nloc = mine > 0u ? mine : 1u; nx = cnt > 0u ? cnt : 1u;
}
__device__ __forceinline__ void xcd_barrier(const XcdBarrier& b) {
    asm volatile("s_waitcnt vmcnt(0)" ::: "memory");
    __syncthreads();
    if (threadIdx.x == 0) {
        unsigned* bar = b.bar;
        __builtin_amdgcn_s_waitcnt(0);
        unsigned nloc = b.st[0], nx = b.st[1];
        if (nloc == 0u) { xcd_barrier_complete(bar, b.x, nloc, nx); b.st[0] = nloc; b.st[1] = nx; }
        const unsigned old = xb_add(&bar[XB_XSUB(b.x)], 1u);
        const unsigned gen = old / nloc;
        if (old + 1u == (gen + 1u) * nloc) {
            __builtin_amdgcn_fence(__ATOMIC_RELEASE, "agent");
            asm volatile("s_waitcnt vmcnt(0)" ::: "memory");
            const unsigned og = xb_add(&bar[XB_TOP], 1u);
            const unsigned tg = og / nx;
            if (og + 1u == (tg + 1u) * nx) xb_add(&bar[XB_TOPGEN], 1u);
            else XB_SPIN(xb_ld(&bar[XB_TOPGEN]) == tg, bar);
            __builtin_amdgcn_fence(__ATOMIC_ACQUIRE, "agent");
            xb_add(&bar[XB_XGEN(b.x)], 1u);
            asm volatile("s_waitcnt vmcnt(0)" ::: "memory");
        } else {
            XB_SPIN(xb_ld(&bar[XB_XGEN(b.x)]) == gen, bar);
            __builtin_amdgcn_fence(__ATOMIC_ACQUIRE, "agent");
            asm volatile("s_waitcnt vmcnt(0)" ::: "memory");
        }
    }
    __syncthreads();
}

__device__ __forceinline__ void ph_mix1(const Params& p, char* lds, int bid, int nb, unsigned long long* tsplit = nullptr) {
    const bool hy_first = bid >= (nb >> 1);
    if (hy_first) { for (int c = bid - (nb >> 1); c < D_CH; c += nb) hyena_channel(p, c, (float*)lds); __syncthreads(); }
    for (int u = bid; u < NU_LAT; u += nb) { const int blk = u % (SEQ / 128), h = (u / (SEQ / 128)) % 8, b = u / (8 * (SEQ / 128)); const int s0 = blk * 128;
        attn_unit<0>(lds, p.QC + (size_t)(b * SEQ + s0) * 512 + h * 64, p.KC + (size_t)(b * 2 + h / 4) * LKV * 64, p.VCt + (size_t)(b * 2 + h / 4) * 64 * LKV,
                     p.Y + (size_t)(b * SEQ + s0) * 1024 + h * 64, s0, CTX_LEN / 64, 0, SEQ / 64, 0.f, false, nullptr); }
    if (tsplit) *tsplit = __builtin_amdgcn_s_memrealtime();
    if (!hy_first) { __syncthreads(); for (int c = bid + (nb >> 1); c < D_CH; c += nb) hyena_channel(p, c, (float*)lds); }
}
constexpr int TR_ITEMS = BATCH * (D_CH / 64) * (SEQ / 64);
__device__ __forceinline__ void tr_item(const Params& p, char* lds, int it) {
    bf16_t* T = (bf16_t*)lds; const int tid = threadIdx.x;
    const int sb = it % (SEQ / 64), cb = (it / (SEQ / 64)) % (D_CH / 64), b = it / ((SEQ / 64) * (D_CH / 64));
    { const int c = tid >> 2, q = tid & 3;
      const u32x4* src = (const u32x4*)(p.YHT + ((size_t)b * D_CH + cb * 64 + c) * SEQ + sb * 64 + q * 16);
      const u32x4 v0 = src[0], v1 = src[1]; unsigned* d = (unsigned*)(T + c * 66 + q * 16);
      d[0] = v0.x; d[1] = v0.y; d[2] = v0.z; d[3] = v0.w; d[4] = v1.x; d[5] = v1.y; d[6] = v1.z; d[7] = v1.w; }
    __syncthreads();
    { const int s = tid >> 2, q = tid & 3;
      unsigned w[8];
#pragma unroll
      for (int i = 0; i < 8; ++i) w[i] = (unsigned)T[(q * 16 + 2 * i) * 66 + s] | ((unsigned)T[(q * 16 + 2 * i + 1) * 66 + s] << 16);
      u32x4* dst = (u32x4*)(p.Y + ((size_t)b * SEQ + sb * 64 + s) * 1024 + 512 + cb * 64 + q * 16);
      dst[0] = (u32x4){w[0], w[1], w[2], w[3]}; dst[1] = (u32x4){w[4], w[5], w[6], w[7]}; }
    __syncthreads();
}
enum { PH_PREP = 0, PH_NORM0, PH_INPROJ0, PH_ATTN0, PH_OUT0, PH_ROUTE0, PH_ROUTEB0, PH_UP0, PH_DOWN0, PH_NORM1, PH_INPROJ1, PH_MIX1, PH_TR1, PH_OUT1, PH_ROUTE1, PH_ROUTEB1, PH_UP1, PH_DOWN1, PH_FINAL, PH_COUNT };
__global__ void __launch_bounds__(NTHREADS, 2) mega(Params p, int lo, int hi) {
    extern __shared__ __attribute__((aligned(16))) char lds[];
    const int bid = blockIdx.x, nb = gridDim.x;
    volatile LAS unsigned* st = (volatile LAS unsigned*)(lds + LDS_BYTES - 16);
    if (threadIdx.x < 4) st[threadIdx.x] = 0u;
    __syncthreads();
    XcdBarrier bar; bar.bar = p.bar; bar.x = 0; bar.st = st;
    if (hi - lo > 1) bar = xcd_barrier_post(p.bar, st);
#ifdef PROBE_PA
    unsigned long long ts_prev = __builtin_amdgcn_s_memrealtime(), t_a = 0, t_b = 0;
#define STAMP(PH) if (bid == 0 && threadIdx.x == 0) { const unsigned long long now_ = __builtin_amdgcn_s_memrealtime(); if ((PH) == PROBE_PA) t_a = now_ - ts_prev; if ((PH) == PROBE_PB) t_b = now_ - ts_prev; ts_prev = now_; }
#else
#define STAMP(PH)
#endif
#define PHASE(PH, body) if (lo <= (PH) && (PH) < hi) { body; if ((PH) + 1 < hi) xcd_barrier(bar); STAMP(PH) }
    PHASE(PH_PREP, { for (int it = bid; it < MOD_ITEMS; it += nb) mod_item(p, lds, it); cvt_range(p, lds, 0, CVT_EARLY, bid, nb); d_rope(p); d_hy_h1(p); })
#if PROBE == 7
    PHASE(PH_NORM0, { ph_norm(p, 0, 0, TT, bid, nb); ph_norm(p, 0, 0, TT, bid, nb); ph_norm(p, 0, 0, TT, bid, nb); d_hy_h2(p); })
#else
    PHASE(PH_NORM0, { ph_norm(p, 0, 0, TT, bid, nb); d_hy_h2(p); })
#endif
#if PROBE == 1
    PHASE(PH_INPROJ0, { ph_inproj<0>(p, lds, bid, nb); __syncthreads(); ph_inproj<0>(p, lds, bid, nb); for (int it = bid; it < FILT_ITEMS; it += nb) filt_item(p, lds, it); })
#else
    PHASE(PH_INPROJ0, { ph_inproj<0>(p, lds, bid, nb); for (int it = bid; it < FILT_ITEMS; it += nb) filt_item(p, lds, it); })
#endif
#if PROBE == 2
    PHASE(PH_ATTN0, { ph_attn0(p, lds, bid, nb); __syncthreads(); ph_attn0(p, lds, bid, nb); })
#else
    PHASE(PH_ATTN0, { if (bid & 1) { cvt_range(p, lds, CVT_EARLY, CVT_TOTAL, bid, nb); __syncthreads(); ph_attn0(p, lds, bid, nb); } else { ph_attn0(p, lds, bid, nb); __syncthreads(); cvt_range(p, lds, CVT_EARLY, CVT_TOTAL, bid, nb); } })
#endif
#if PROBE == 10
    PHASE(PH_OUT0, { ph_outproj<0>(p, lds, bid, nb); __syncthreads(); ph_outproj<0>(p, lds, bid, nb); })
#elif PROBE == 11
    PHASE(PH_OUT0, { for (int i_ = 0; i_ < 10; ++i_) xcd_barrier(bar); ph_outproj<0>(p, lds, bid, nb); })
#else
    PHASE(PH_OUT0, ph_outproj<0>(p, lds, bid, nb))
#endif
    PHASE(PH_ROUTE0, ph_route_a(p, lds, 0, TT, bid, nb))
    PHASE(PH_ROUTEB0, ph_route_b(p, lds, 0, TT, bid, nb))
#if PROBE == 9
    PHASE(PH_UP0, { ph_moe_up(p, lds, 0, bid, nb); __syncthreads(); ph_moe_up(p, lds, 0, bid, nb); })
#else
    PHASE(PH_UP0, ph_moe_up(p, lds, 0, bid, nb))
#endif
#if PROBE == 12
    PHASE(PH_DOWN0, { ph_moe_down<true>(p, lds, 0, bid, nb); __syncthreads(); ph_moe_down(p, lds, 0, bid, nb); })
#else
    PHASE(PH_DOWN0, ph_moe_down(p, lds, 0, bid, nb))
#endif
    PHASE(PH_NORM1, ph_norm(p, 1, 0, TT, bid, nb))
    PHASE(PH_INPROJ1, ph_inproj<1>(p, lds, bid, nb))
#if PROBE == 3
    PHASE(PH_MIX1, { ph_attnC(p, lds, bid, nb); __syncthreads(); ph_mix1(p, lds, bid, nb); })
#elif PROBE == 4
    PHASE(PH_MIX1, { for (int c = bid; c < D_CH; c += nb) hyena_channel(p, c, (float*)lds); __syncthreads(); ph_mix1(p, lds, bid, nb); })
#else
#if defined(PROBE_PA) && PROBE_PA == 100
    { unsigned long long tsp = 0, t0_ = __builtin_amdgcn_s_memrealtime(); ph_mix1(p, lds, bid, nb, &tsp); unsigned long long t1_ = __builtin_amdgcn_s_memrealtime(); if (bid == 0 && threadIdx.x == 0) { t_a = tsp - t0_; t_b = t1_ - tsp; } xcd_barrier(bar); }
#else
    PHASE(PH_MIX1, ph_mix1(p, lds, bid, nb))
#endif
#endif
    PHASE(PH_TR1, for (int it = bid; it < TR_ITEMS; it += nb) tr_item(p, lds, it))
    PHASE(PH_OUT1, ph_outproj<1>(p, lds, bid, nb))
    PHASE(PH_ROUTE1, ph_route_a(p, lds, 1, TX, bid, nb))
    PHASE(PH_ROUTEB1, ph_route_b(p, lds, 1, TX, bid, nb))
    PHASE(PH_UP1, ph_moe_up(p, lds, 1, bid, nb))
    PHASE(PH_DOWN1, ph_moe_down(p, lds, 1, bid, nb))
    PHASE(PH_FINAL, ph_final(p, bid, nb))
#ifdef PROBE_PA
    if (bid == 0 && threadIdx.x == 0) {
        const unsigned long long delay = 2 * t_a + 204800ull * ((t_b + 200) / 400); const unsigned long long t0 = __builtin_amdgcn_s_memrealtime();
        while (__builtin_amdgcn_s_memrealtime() - t0 < delay) __builtin_amdgcn_s_sleep(32);
    }
#endif
}
extern "C" void kernel_launch(void* const* d_in, const int* in_sizes, int n_in, void* d_out, int out_size, void* d_ws, size_t ws_size, hipStream_t stream) {
    static int grid = 0;
    if (grid == 0) {
        int dev = 0, cus = 0;
        if (hipGetDevice(&dev) != hipSuccess || hipDeviceGetAttribute(&cus, hipDeviceAttributeMultiprocessorCount, dev) != hipSuccess) { fprintf(stderr, "kernel_launch: device query failed\n"); grid = -1; return; }
        if (hipFuncSetAttribute((const void*)mega, hipFuncAttributeMaxDynamicSharedMemorySize, LDS_BYTES) != hipSuccess) { fprintf(stderr, "kernel_launch: hipFuncSetAttribute failed\n"); grid = -1; return; }
        grid = 2 * cus;
    }
    if (grid < 0) return;
    Params p{};
    size_t need = setup_ws(p, (char*)d_ws);
    if (n_in != 32 || need > ws_size || out_size != TX * D_MODEL) { fprintf(stderr, "kernel_launch: bad config n_in %d ws %zu need %zu out %d\n", n_in, ws_size, need, out_size); return; }
    fill_inputs(p, d_in, d_out);
    hipMemsetAsync(p.bar, 0, 64 * 1024 + 256, stream);
#ifdef PER_PHASE
    for (int ph = 0; ph < PH_COUNT; ++ph) mega<<<dim3(grid), dim3(NTHREADS), LDS_BYTES, stream>>>(p, ph, ph + 1);
#else
    mega<<<dim3(grid), dim3(NTHREADS), LDS_BYTES, stream>>>(p, 0, PH_COUNT);
#endif
}
```

```cpp
#include <hip/hip_runtime.h>
#include <cstdio>
#include <math.h>
#include <stdint.h>
#include <string.h>

#ifdef CPU_TEST
#define HD
#define GLOBAL
struct U3 { unsigned x, y, z; };
static thread_local U3 threadIdx, blockIdx, blockDim, gridDim;
static inline int atomicAdd(int* p, int v) { return __sync_fetch_and_add(p, v); }
#else
#define HD __device__ __forceinline__
#define GLOBAL __global__ __launch_bounds__(256)
#endif

#if defined(HY_TEST)
constexpr int D_MODEL = 64, BATCH = 2, SEQ = 4096, GRID_W = 64, CTX_LEN = 64, D_CH = 4, D_EXPERT = 64;
#elif defined(SMALL_CFG)
constexpr int D_MODEL = 128, BATCH = 2, SEQ = 512, GRID_W = 32, CTX_LEN = 64, D_CH = 32, D_EXPERT = 64;
#else
constexpr int D_MODEL = 1024, BATCH = 4, SEQ = 4096, GRID_W = 64, CTX_LEN = 256, D_CH = 512, D_EXPERT = 512;
#endif
constexpr int DEPTH = 2, HEAD_DIM = 64;
constexpr int GRID_H = SEQ / GRID_W;
constexpr int A_WINDOW = 128;
constexpr int B_WIN_H = 8, B_WIN_W = 16;
constexpr int HY_BANDS = 16, HY_EMB = 33, HY_FFN = 64;
constexpr int EVEN_IN = 2304, EVEN_OUT = 1024;
constexpr int ODD_IN = 768 + 3 * D_CH, ODD_OUT = 512 + D_CH;
constexpr int N_EXPERTS = 16;
constexpr int TX = BATCH * SEQ, TC = BATCH * CTX_LEN, TT = TX + TC;
constexpr int LKV = CTX_LEN + SEQ;
constexpr int NPAIR = 24;
constexpr int HE_W = 2 * D_EXPERT;
constexpr float EPS = 1e-6f;
constexpr float ATTN_SCALE = 0.125f;

typedef unsigned short bf16_t;
HD bf16_t f2bf(float f) { unsigned u; __builtin_memcpy(&u, &f, 4); u = (u + 0x7fffu + ((u >> 16) & 1u)) >> 16; return (bf16_t)u; }
HD float bf2f(bf16_t h) { unsigned u = ((unsigned)h) << 16; float f; __builtin_memcpy(&f, &u, 4); return f; }
HD float silu_f(float x) { return x / (1.0f + expf(-x)); }
HD float sigmoid_f(float x) { return 1.0f / (1.0f + expf(-x)); }

struct Params {
    const float *x, *c, *ctx, *c_ctx, *w_ada, *b_ada, *norm_g, *final_g, *w_in_even, *w_out_even, *a_sink, *b_rpb;
    const float *w_in_odd, *w_out_odd, *c_qnorm, *c_knorm, *hy_short_w, *hy_short_b, *hy_w1, *hy_b1, *hy_f1, *hy_w2;
    const float *hy_b2, *hy_f2, *hy_w3, *hy_b3, *hy_bias, *w_router, *b_router, *moe_wg, *moe_wu, *moe_wd;
    float* out;
    float* XC;
    float* mod;
    float* ropet;
    float* h1;
    float* h2;
    float* HFT;
    float* hnorm;
    bf16_t* hbuf;
    bf16_t *QA, *KA, *VAt, *QB, *KB, *VBt;
    bf16_t *QC, *KC, *VCt, *UT;
    bf16_t* Y;
    bf16_t* YHT;
    float* Z1;
    bf16_t* HE;
    int* cnt;
    int* list;
    float* tokw;
    bf16_t *Wt_in_even, *Wt_out_even, *Wt_in_odd, *Wt_out_odd, *Wt_gu, *Wt_d;
    unsigned* bar;
    int* rpair;
    int* bh;
};

#define GS_LOOP(i, n) for (long i = (long)blockIdx.x * blockDim.x + threadIdx.x; i < (long)(n); i += (long)gridDim.x * blockDim.x)

HD const float* xrow_in(const Params& p, int l, int row) {
    if (l == 0) return row < TX ? p.x + (size_t)row * D_MODEL : p.ctx + (size_t)(row - TX) * D_MODEL;
    return row < TX ? p.out + (size_t)row * D_MODEL : p.XC + (size_t)(row - TX) * D_MODEL;
}
HD float* xrow_cur(const Params& p, int row) { return row < TX ? p.out + (size_t)row * D_MODEL : p.XC + (size_t)(row - TX) * D_MODEL; }
HD int row_mod(int row) { return row < TX ? row / SEQ : BATCH; }
HD const float* modp(const Params& p, int l, int row, int which) { return p.mod + ((size_t)(l * (BATCH + 1) + row_mod(row)) * 6 + which) * D_MODEL; }

GLOBAL void nk_mod(Params p) {
    GS_LOOP(i, DEPTH * (BATCH + 1) * 6 * D_MODEL) {
        int j = i % (6 * D_MODEL); int r = (i / (6 * D_MODEL)) % (BATCH + 1); int l = i / (6 * D_MODEL * (BATCH + 1));
        const float* cv = r < BATCH ? p.c + r * D_MODEL : p.c_ctx;
        const float* w = p.w_ada + (size_t)l * D_MODEL * 6 * D_MODEL;
        float acc = 0.f;
        for (int k = 0; k < D_MODEL; ++k) acc += silu_f(cv[k]) * w[(size_t)k * 6 * D_MODEL + j];
        p.mod[i] = acc + p.b_ada[l * 6 * D_MODEL + j];
    }
}
HD void d_rope(const Params& p) {
    GS_LOOP(i, 64 * 16) {
        int pos = i / 16, k = i % 16;
        float inv = powf(10000.0f, -(float)(2 * k) / 32.0f);
        float a = (float)pos * inv;
        p.ropet[pos * 32 + k] = cosf(a); p.ropet[pos * 32 + 16 + k] = sinf(a);
    }
}
HD void d_hy_h1(const Params& p) {
    GS_LOOP(i, SEQ * HY_FFN) {
        int t = i / HY_FFN, k = i % HY_FFN;
        float tn = (float)t / (float)(SEQ - 1);
        float acc = tn * p.hy_w1[0 * HY_FFN + k];
        for (int b = 0; b < HY_BANDS; ++b) {
            float band = 1e-4f + (float)b * ((float)(HY_BANDS - 1) - 1e-4f) / (float)(HY_BANDS - 1);
            float ang = 2.0f * 3.14159265358979323846f * (float)t * band / (float)SEQ;
            acc += cosf(ang) * p.hy_w1[(1 + b) * HY_FFN + k] + sinf(ang) * p.hy_w1[(1 + HY_BANDS + b) * HY_FFN + k];
        }
        p.h1[i] = sinf(p.hy_f1[k] * (acc + p.hy_b1[k]));
    }
}
HD void d_hy_h2(const Params& p) {
    GS_LOOP(i, SEQ * HY_FFN) {
        int t = i / HY_FFN, j = i % HY_FFN;
        float acc = 0.f;
        for (int k = 0; k < HY_FFN; ++k) acc += p.h1[t * HY_FFN + k] * p.hy_w2[k * HY_FFN + j];
        p.h2[i] = sinf(p.hy_f2[j] * (acc + p.hy_b2[j]));
    }
}
HD float hy_decay(int t, int c) {
    const float mind = logf(1e-2f) / 1.5f, maxd = logf(1e-2f) / 0.3f;
    float delta = fabsf(mind + (float)c * (maxd - mind) / (float)(D_CH - 1));
    float tn = (float)t / (float)(SEQ - 1);
    return expf(-tn * delta);
}
GLOBAL void nk_hy_filt(Params p) {
    GS_LOOP(i, 4 * D_CH * SEQ) {
        int t = i % SEQ, col = i / SEQ, c = col % D_CH;
        float acc = p.hy_b3[col];
        for (int k = 0; k < HY_FFN; ++k) acc += p.h2[t * HY_FFN + k] * p.hy_w3[k * 4 * D_CH + col];
        p.HFT[i] = acc * hy_decay(t, c);
    }
}
GLOBAL void nk_hy_norm(Params p) {
    GS_LOOP(i, 2 * D_CH) {
        int o = i / D_CH, c = i % D_CH;
        float s = 0.f;
        for (int dir = 0; dir < 2; ++dir) { const float* h = p.HFT + (size_t)((dir * 2 + o) * D_CH + c) * SEQ; for (int t = 0; t < SEQ; ++t) s += fabsf(h[t]); }
        p.hnorm[i] = s + EPS;
    }
}
GLOBAL void nk_zero_cnt(Params p) { GS_LOOP(i, 64) p.cnt[i] = 0; }

GLOBAL void nk_norm(Params p, int l, int which, int nrows) {
    GS_LOOP(row, nrows) {
        const float* xr = which == 0 ? xrow_in(p, l, (int)row) : xrow_cur(p, (int)row);
        float ss = 0.f;
        for (int k = 0; k < D_MODEL; ++k) ss += xr[k] * xr[k];
        float rstd = 1.0f / sqrtf(ss / D_MODEL + EPS);
        const float* g = p.norm_g + (l * 2 + which) * D_MODEL;
        const float* sh = modp(p, l, (int)row, which * 3 + 0); const float* sc = modp(p, l, (int)row, which * 3 + 1);
        for (int k = 0; k < D_MODEL; ++k) p.hbuf[row * D_MODEL + k] = f2bf(xr[k] * rstd * g[k] * (1.0f + sc[k]) + sh[k]);
    }
}

HD float dot_row(const bf16_t* a, const float* W, int ldw, int col, int K) {
    float acc = 0.f;
    for (int k = 0; k < K; ++k) acc += bf2f(a[k]) * W[(size_t)k * ldw + col];
    return acc;
}
HD float rope_apply(const Params& p, float v, float partner, int d, int s) {
    int half = d >> 5, dd = d & 31, k = dd & 15;
    int pos = half == 0 ? s / GRID_W : s % GRID_W;
    float c = p.ropet[pos * 32 + k], sn = p.ropet[pos * 32 + 16 + k];
    return dd < 16 ? v * c - partner * sn : v * c + partner * sn;
}

GLOBAL void nk_inproj_even(Params p) {
    GS_LOOP(i, (long)TT * EVEN_IN) {
        int row = i / EVEN_IN, col = i % EVEN_IN;
        const bf16_t* a = p.hbuf + (size_t)row * D_MODEL;
        float v = dot_row(a, p.w_in_even, EVEN_IN, col, D_MODEL);
        bool lat = row < TX; int b = lat ? row / SEQ : (row - TX) / CTX_LEN; int s = lat ? row % SEQ : (row - TX) % CTX_LEN;
        int pos = lat ? CTX_LEN + s : s;
        if (col < 640) {
            int d = col & 63;
            if (lat) { int pc = (d & 31) < 16 ? col + 16 : col - 16; float pv = dot_row(a, p.w_in_even, EVEN_IN, pc, D_MODEL); v = rope_apply(p, v, pv, d, s); }
            if (col < 512) p.QA[(size_t)row * 512 + col] = f2bf(v);
            else { int h = (col - 512) >> 6; p.KA[((size_t)(b * 2 + h) * LKV + pos) * 64 + d] = f2bf(v); }
        } else if (col < 768) { int h = (col - 640) >> 6, d = col & 63; p.VAt[((size_t)(b * 2 + h) * 64 + d) * LKV + pos] = f2bf(v); }
        else if (col < 1280) p.QB[(size_t)row * 512 + (col - 768)] = f2bf(v);
        else if (col < 1792) { int h = (col - 1280) >> 6, d = col & 63; p.KB[((size_t)(b * 8 + h) * LKV + pos) * 64 + d] = f2bf(v); }
        else { int h = (col - 1792) >> 6, d = col & 63; p.VBt[((size_t)(b * 8 + h) * 64 + d) * LKV + pos] = f2bf(v); }
    }
}

struct OSM { float m, l; };
#define ATT_BEGIN() float q[64], acc[64]; for (int d = 0; d < 64; ++d) { q[d] = bf2f(qp[d]) * ATTN_SCALE; acc[d] = 0.f; } float m_ = -1e30f, l_ = 0.f;
#define ATT_KEY(Kp, Vt, key, bias) do { const bf16_t* kk_ = (Kp) + (size_t)(key) * 64; float s_ = (bias); for (int d = 0; d < 64; ++d) s_ += q[d] * bf2f(kk_[d]); \
    float mn_ = fmaxf(m_, s_); float f_ = expf(m_ - mn_), pe_ = expf(s_ - mn_); l_ = l_ * f_ + pe_; \
    for (int d = 0; d < 64; ++d) acc[d] = acc[d] * f_ + pe_ * bf2f((Vt)[(size_t)d * LKV + (key)]); m_ = mn_; } while (0)
#define ATT_SINK(sv) do { float s_ = (sv); float mn_ = fmaxf(m_, s_); float f_ = expf(m_ - mn_); l_ = l_ * f_ + expf(s_ - mn_); for (int d = 0; d < 64; ++d) acc[d] *= f_; m_ = mn_; } while (0)

GLOBAL void nk_attnA(Params p) {
    GS_LOOP(i, (long)TX * 8) {
        int h = i % 8, row = i / 8, b = row / SEQ, s = row % SEQ, kvh = h / 4;
        const bf16_t* qp = p.QA + (size_t)row * 512 + h * 64;
        const bf16_t* Kp = p.KA + (size_t)(b * 2 + kvh) * LKV * 64; const bf16_t* Vt = p.VAt + (size_t)(b * 2 + kvh) * 64 * LKV;
        ATT_BEGIN();
        for (int j = 0; j < CTX_LEN; ++j) ATT_KEY(Kp, Vt, j, 0.f);
        int lo = s - A_WINDOW < 0 ? 0 : s - A_WINDOW, hi = s + A_WINDOW > SEQ - 1 ? SEQ - 1 : s + A_WINDOW;
        for (int j = lo; j <= hi; ++j) ATT_KEY(Kp, Vt, CTX_LEN + j, 0.f);
        ATT_SINK(p.a_sink[h]);
        for (int d = 0; d < 64; ++d) p.Y[(size_t)row * 1024 + h * 64 + d] = f2bf(acc[d] / l_);
    }
}
GLOBAL void nk_attnB(Params p) {
    GS_LOOP(i, (long)TX * 8) {
        int h = i % 8, row = i / 8, b = row / SEQ, s = row % SEQ, r = s / GRID_W, cq = s % GRID_W;
        const bf16_t* qp = p.QB + (size_t)row * 512 + h * 64;
        const bf16_t* Kp = p.KB + (size_t)(b * 8 + h) * LKV * 64; const bf16_t* Vt = p.VBt + (size_t)(b * 8 + h) * 64 * LKV;
        ATT_BEGIN();
        for (int j = 0; j < CTX_LEN; ++j) ATT_KEY(Kp, Vt, j, 0.f);
        int kh = B_WIN_H < GRID_H ? B_WIN_H : GRID_H;
        int rs = r - kh / 2; if (rs < 0) rs = 0; if (rs > GRID_H - kh) rs = GRID_H - kh;
        int cs = cq - B_WIN_W / 2; if (cs < 0) cs = 0; if (cs > GRID_W - B_WIN_W) cs = GRID_W - B_WIN_W;
        for (int kr = rs; kr < rs + kh; ++kr)
            for (int kc = cs; kc < cs + B_WIN_W; ++kc) {
                int dr = kr - r, dc = kc - cq;
                float bias = p.b_rpb[(h * (2 * B_WIN_H - 1) + dr + B_WIN_H - 1) * (2 * B_WIN_W - 1) + dc + B_WIN_W - 1];
                ATT_KEY(Kp, Vt, CTX_LEN + kr * GRID_W + kc, bias);
            }
        for (int d = 0; d < 64; ++d) p.Y[(size_t)row * 1024 + 512 + h * 64 + d] = f2bf(acc[d] / l_);
    }
}
GLOBAL void nk_attn_ctx(Params p) {
    GS_LOOP(i, (long)TC * 16) {
        int hh = i % 16, rc = i / 16, ty = hh / 8, h = hh % 8, b = rc / CTX_LEN; int row = TX + rc;
        const bf16_t* qp = (ty == 0 ? p.QA : p.QB) + (size_t)row * 512 + h * 64;
        const bf16_t* Kp = ty == 0 ? p.KA + (size_t)(b * 2 + h / 4) * LKV * 64 : p.KB + (size_t)(b * 8 + h) * LKV * 64;
        const bf16_t* Vt = ty == 0 ? p.VAt + (size_t)(b * 2 + h / 4) * 64 * LKV : p.VBt + (size_t)(b * 8 + h) * 64 * LKV;
        ATT_BEGIN();
        for (int j = 0; j < CTX_LEN; ++j) ATT_KEY(Kp, Vt, j, 0.f);
        if (ty == 0) ATT_SINK(p.a_sink[h]);
        for (int d = 0; d < 64; ++d) p.Y[(size_t)row * 1024 + ty * 512 + h * 64 + d] = f2bf(acc[d] / l_);
    }
}
GLOBAL void nk_attnC(Params p) {
    GS_LOOP(i, (long)TX * 8) {
        int h = i % 8, row = i / 8, b = row / SEQ, kvh = h / 4;
        const bf16_t* qp = p.QC + (size_t)row * 512 + h * 64;
        const bf16_t* Kp = p.KC + (size_t)(b * 2 + kvh) * LKV * 64; const bf16_t* Vt = p.VCt + (size_t)(b * 2 + kvh) * 64 * LKV;
        ATT_BEGIN();
        for (int j = 0; j < LKV; ++j) ATT_KEY(Kp, Vt, j, 0.f);
        for (int d = 0; d < 64; ++d) p.Y[(size_t)row * 1024 + h * 64 + d] = f2bf(acc[d] / l_);
    }
}

GLOBAL void nk_outproj_even(Params p) {
    GS_LOOP(i, (long)TT * D_MODEL) {
        int row = i / D_MODEL, col = i % D_MODEL;
        float acc = dot_row(p.Y + (size_t)row * 1024, p.w_out_even, D_MODEL, col, EVEN_OUT);
        xrow_cur(p, row)[col] = xrow_in(p, 0, row)[col] + modp(p, 0, row, 2)[col] * acc;
    }
}
GLOBAL void nk_outproj_odd(Params p) {
    GS_LOOP(i, (long)TX * D_MODEL) {
        int row = i / D_MODEL, col = i % D_MODEL, b = row / SEQ, s = row % SEQ;
        float acc = dot_row(p.Y + (size_t)row * 1024, p.w_out_odd, D_MODEL, col, 512);
        for (int c = 0; c < D_CH; ++c) acc += bf2f(p.YHT[((size_t)b * D_CH + c) * SEQ + s]) * p.w_out_odd[(size_t)(512 + c) * D_MODEL + col];
        p.out[i] = p.out[i] + modp(p, 1, row, 2)[col] * acc;
    }
}

GLOBAL void nk_router(Params p, int l, int nrows) {
    GS_LOOP(row, nrows) {
        const float* xr = xrow_cur(p, (int)row);
        float ss = 0.f;
        for (int k = 0; k < D_MODEL; ++k) ss += xr[k] * xr[k];
        float rstd = 1.0f / sqrtf(ss / D_MODEL + EPS);
        const float* g = p.norm_g + (l * 2 + 1) * D_MODEL; const float* sh = modp(p, l, (int)row, 3); const float* sc = modp(p, l, (int)row, 4);
        float lg[16];
#pragma unroll
        for (int e = 0; e < 16; ++e) lg[e] = 0.f;
        for (int k = 0; k < D_MODEL; ++k) { float hv = xr[k] * rstd * g[k] * (1.0f + sc[k]) + sh[k];
#pragma unroll
            for (int e = 0; e < 16; ++e) lg[e] += hv * p.w_router[k * 16 + e]; }
        int gbest = 0, a = 0, bb = 1; float gbs = -1e30f, wa = 0.f, wb = 0.f;
#pragma unroll
        for (int gI = 0; gI < 4; ++gI) {
            float m1 = -1e30f, m2 = -1e30f, s1 = 0.f, s2 = 0.f; int i1 = 0, i2 = 0;
#pragma unroll
            for (int j = 0; j < 4; ++j) { float sgv = sigmoid_f(lg[gI * 4 + j]); float v = sgv + p.b_router[gI * 4 + j];
                if (v > m1) { m2 = m1; i2 = i1; s2 = s1; m1 = v; i1 = j; s1 = sgv; } else if (v > m2) { m2 = v; i2 = j; s2 = sgv; } }
            float gs = m1 + m2;
            if (gs > gbs) { gbs = gs; gbest = gI; if (i1 < i2) { a = i1; bb = i2; wa = s1; wb = s2; } else { a = i2; bb = i1; wa = s2; wb = s1; } }
        }
        float inv = 1.0f / (wa + wb);
        int pidx = a == 0 ? bb - 1 : (a == 1 ? bb + 1 : 5);
        int pr = gbest * 6 + pidx;
        int pos = atomicAdd(p.cnt + l * 32 + pr, 1);
        p.list[(size_t)pr * TT + pos] = (int)row;
        p.tokw[row * 2 + 0] = wa * inv; p.tokw[row * 2 + 1] = wb * inv;
    }
}
HD void pair_experts(int pr, int& e1, int& e2) { int g = pr / 6, q = pr % 6; int a = q < 3 ? 0 : (q < 5 ? 1 : 2); int b = q < 3 ? q + 1 : (q < 5 ? q - 1 : 3); e1 = g * 4 + a; e2 = g * 4 + b; }
HD bool slot_lookup(const Params& p, int l, int slot, int& pr, int& row) { int acc = 0; for (int q = 0; q < NPAIR; ++q) { int c = p.cnt[l * 32 + q]; if (slot < acc + c) { pr = q; row = p.list[(size_t)q * TT + (slot - acc)]; return true; } acc += c; } return false; }
GLOBAL void nk_moe_up(Params p, int l, int nrows) {
    GS_LOOP(i, (long)nrows * HE_W) {
        int slot = i / HE_W, j = i % HE_W, k = j / D_EXPERT, jj = j % D_EXPERT; int pr, row; if (!slot_lookup(p, l, slot, pr, row)) continue;
        int e1, e2; pair_experts(pr, e1, e2); int e = k == 0 ? e1 : e2;
        const bf16_t* a = p.hbuf + (size_t)row * D_MODEL;
        const float* wg = p.moe_wg + (size_t)(l * N_EXPERTS + e) * D_MODEL * D_EXPERT; const float* wu = p.moe_wu + (size_t)(l * N_EXPERTS + e) * D_MODEL * D_EXPERT;
        float g = dot_row(a, wg, D_EXPERT, jj, D_MODEL), u = dot_row(a, wu, D_EXPERT, jj, D_MODEL);
        p.HE[(size_t)row * HE_W + j] = f2bf(p.tokw[row * 2 + k] * silu_f(g) * u);
    }
}
GLOBAL void nk_moe_down(Params p, int l, int nrows) {
    GS_LOOP(i, (long)nrows * D_MODEL) {
        int slot = i / D_MODEL, col = i % D_MODEL; int pr, row; if (!slot_lookup(p, l, slot, pr, row)) continue;
        int e1, e2; pair_experts(pr, e1, e2);
        const bf16_t* a = p.HE + (size_t)row * HE_W;
        float acc = dot_row(a, p.moe_wd + (size_t)(l * N_EXPERTS + e1) * D_EXPERT * D_MODEL, D_MODEL, col, D_EXPERT)
                  + dot_row(a + D_EXPERT, p.moe_wd + (size_t)(l * N_EXPERTS + e2) * D_EXPERT * D_MODEL, D_MODEL, col, D_EXPERT);
        float* xr = xrow_cur(p, row);
        xr[col] = xr[col] + modp(p, l, row, 5)[col] * acc;
    }
}

GLOBAL void nk_inproj_odd_qk(Params p) {
    GS_LOOP(i, (long)TT * 10) {
        int row = i / 10, hu = i % 10; const bf16_t* a = p.hbuf + (size_t)row * D_MODEL;
        bool lat = row < TX; int b = lat ? row / SEQ : (row - TX) / CTX_LEN; int s = lat ? row % SEQ : (row - TX) % CTX_LEN; int pos = lat ? CTX_LEN + s : s;
        int col0 = hu * 64;
        float v[64]; float ss = 0.f;
        for (int d = 0; d < 64; ++d) { v[d] = dot_row(a, p.w_in_odd, ODD_IN, col0 + d, D_MODEL); ss += v[d] * v[d]; }
        float rstd = 1.0f / sqrtf(ss / 64.0f + EPS);
        const float* gn = hu < 8 ? p.c_qnorm : p.c_knorm;
        for (int d = 0; d < 64; ++d) v[d] = v[d] * rstd * gn[d];
        for (int d = 0; d < 64; ++d) {
            float o = v[d];
            if (lat) { int pd = (d & 31) < 16 ? d + 16 : d - 16; o = rope_apply(p, v[d], v[pd], d, s); }
            if (hu < 8) p.QC[(size_t)row * 512 + col0 + d] = f2bf(o);
            else p.KC[((size_t)(b * 2 + (hu - 8)) * LKV + pos) * 64 + d] = f2bf(o);
        }
    }
}
GLOBAL void nk_inproj_odd_vu(Params p) {
    GS_LOOP(i, (long)TT * (ODD_IN - 640)) {
        int row = i / (ODD_IN - 640), col = 640 + i % (ODD_IN - 640); const bf16_t* a = p.hbuf + (size_t)row * D_MODEL;
        bool lat = row < TX; int b = lat ? row / SEQ : (row - TX) / CTX_LEN; int s = lat ? row % SEQ : (row - TX) % CTX_LEN; int pos = lat ? CTX_LEN + s : s;
        if (col >= 768 && !lat) continue;
        float v = dot_row(a, p.w_in_odd, ODD_IN, col, D_MODEL);
        if (col < 768) { int h = (col - 640) >> 6, d = col & 63; p.VCt[((size_t)(b * 2 + h) * 64 + d) * LKV + pos] = f2bf(v); }
        else p.UT[((size_t)b * 3 * D_CH + (col - 768)) * SEQ + s] = f2bf(v);
    }
}

HD float hy_sc(const Params& p, int b, int ch, int t) {
    const bf16_t* u = p.UT + ((size_t)b * 3 * D_CH + ch) * SEQ;
    float acc = p.hy_short_b[ch];
    for (int kk = 0; kk < 3; ++kk) { int tt = t + kk - 1; if (tt >= 0 && tt < SEQ) acc += p.hy_short_w[kk * 3 * D_CH + ch] * bf2f(u[tt]); }
    return acc;
}
GLOBAL void nk_hy_conv(Params p, int o) {
    GS_LOOP(i, (long)BATCH * D_CH * SEQ) {
        int n = i % SEQ, c = (i / SEQ) % D_CH, b = i / ((long)SEQ * D_CH);
        const float* hf = p.HFT + (size_t)((0 * 2 + o) * D_CH + c) * SEQ; const float* hb = p.HFT + (size_t)((1 * 2 + o) * D_CH + c) * SEQ;
        float inv = 1.0f / p.hnorm[o * D_CH + c];
        float acc = 0.f;
        for (int m = 0; m < SEQ; ++m) {
            float z = o == 0 ? hy_sc(p, b, c, m) : p.Z1[((size_t)b * D_CH + c) * SEQ + m];
            int d = n - m; float hv = d >= 0 ? hf[d] : hb[-d];
            acc += hv * z;
        }
        acc *= inv;
        float zn = o == 0 ? hy_sc(p, b, c, n) : p.Z1[((size_t)b * D_CH + c) * SEQ + n];
        float g = hy_sc(p, b, (o + 1) * D_CH + c, n);
        float r = g * (acc + zn * p.hy_bias[o * D_CH + c]);
        if (o == 0) p.Z1[i] = r; else p.YHT[i] = f2bf(r);
    }
}

GLOBAL void nk_final(Params p) {
    GS_LOOP(row, TX) {
        float* xr = p.out + (size_t)row * D_MODEL; float ss = 0.f;
        for (int k = 0; k < D_MODEL; ++k) ss += xr[k] * xr[k];
        float rstd = 1.0f / sqrtf(ss / D_MODEL + EPS);
        for (int k = 0; k < D_MODEL; ++k) xr[k] = xr[k] * rstd * p.final_g[k];
    }
}
GLOBAL void nk_yht_to_y(Params p) {
    GS_LOOP(i, (long)TX * D_CH) { int row = i / D_CH, c = i % D_CH, b = row / SEQ, s = row % SEQ; p.Y[(size_t)row * 1024 + 512 + c] = p.YHT[((size_t)b * D_CH + c) * SEQ + s]; }
}

GLOBAL void nk_rope(Params p) { d_rope(p); }
GLOBAL void nk_hy_h1(Params p) { d_hy_h1(p); }
GLOBAL void nk_hy_h2(Params p) { d_hy_h2(p); }
static inline size_t al256(size_t x) { return (x + 255) & ~(size_t)255; }
static size_t setup_ws(Params& p, char* ws) {
    size_t o = 0;
    auto take = [&](size_t bytes) { char* r = ws + o; o += al256(bytes); return r; };
    p.bar = (unsigned*)take(64 * 1024);
    p.cnt = (int*)take(256);
    p.XC = (float*)take((size_t)TC * D_MODEL * 4);
    p.mod = (float*)take((size_t)DEPTH * (BATCH + 1) * 6 * D_MODEL * 4);
    p.ropet = (float*)take(64 * 32 * 4);
    p.h1 = (float*)take((size_t)SEQ * 64 * 4);
    p.h2 = (float*)take((size_t)SEQ * 64 * 4);
    p.HFT = (float*)take((size_t)4 * D_CH * SEQ * 4);
    p.hnorm = (float*)take(2 * D_CH * 4);
    p.list = (int*)take((size_t)NPAIR * TT * 4);
    p.tokw = (float*)take((size_t)TT * 2 * 4);
    p.rpair = (int*)take((size_t)TT * 4);
    p.bh = (int*)take((size_t)2048 * 32 * 4);
    size_t hb = (size_t)TT * D_MODEL * 2, z1 = (size_t)BATCH * D_CH * SEQ * 4;
    char* r0 = take(hb > z1 ? hb : z1); p.hbuf = (bf16_t*)r0; p.Z1 = (float*)r0;
    size_t q = al256((size_t)TT * 512 * 2), kva = al256((size_t)BATCH * 2 * LKV * 64 * 2), kvb = al256((size_t)BATCH * 8 * LKV * 64 * 2), ut = al256((size_t)BATCH * 3 * D_CH * SEQ * 2);
    size_t l0 = 2 * q + 2 * kva + 2 * kvb, l1 = q + 2 * kva + ut;
    char* R = take(l0 > l1 ? l0 : l1);
    p.QA = (bf16_t*)R; p.KA = (bf16_t*)(R + q); p.VAt = (bf16_t*)(R + q + kva); p.QB = (bf16_t*)(R + q + 2 * kva); p.KB = (bf16_t*)(R + 2 * q + 2 * kva); p.VBt = (bf16_t*)(R + 2 * q + 2 * kva + kvb);
    p.QC = (bf16_t*)R; p.KC = (bf16_t*)(R + q); p.VCt = (bf16_t*)(R + q + kva); p.UT = (bf16_t*)(R + q + 2 * kva);
    size_t yb = (size_t)TT * 1024 * 2, heb = (size_t)TT * HE_W * 2;
    char* r1 = take(yb > heb ? yb : heb); p.Y = (bf16_t*)r1; p.HE = (bf16_t*)r1;
    p.YHT = (bf16_t*)take((size_t)BATCH * D_CH * SEQ * 2);
    p.Wt_in_even = (bf16_t*)take((size_t)EVEN_IN * D_MODEL * 2);
    p.Wt_out_even = (bf16_t*)take((size_t)D_MODEL * EVEN_OUT * 2);
    p.Wt_in_odd = (bf16_t*)take((size_t)ODD_IN * D_MODEL * 2);
    p.Wt_out_odd = (bf16_t*)take((size_t)D_MODEL * ODD_OUT * 2);
    p.Wt_gu = (bf16_t*)take((size_t)DEPTH * N_EXPERTS * 2 * D_EXPERT * D_MODEL * 2);
    p.Wt_d = (bf16_t*)take((size_t)DEPTH * N_EXPERTS * D_MODEL * D_EXPERT * 2);
    return o;
}
static void fill_inputs(Params& p, void* const* d_in, void* d_out) {
    const float** f = (const float**)&p.x;
    for (int i = 0; i < 32; ++i) f[i] = (const float*)d_in[i];
    p.out = (float*)d_out;
}
#define LAS __attribute__((address_space(3)))
typedef short bf16x8 __attribute__((ext_vector_type(8)));
typedef float f32x4 __attribute__((ext_vector_type(4)));
typedef float f32x16 __attribute__((ext_vector_type(16)));
typedef unsigned u32x4 __attribute__((ext_vector_type(4)));
typedef unsigned u32x2 __attribute__((ext_vector_type(2)));

constexpr int NTHREADS = 256;
constexpr int LDS_BYTES = 69632;
constexpr int MT_ALL = TT / 128, MT_LAT = TX / 128;

__device__ __forceinline__ unsigned pk2bf(float lo, float hi) { return (unsigned)f2bf(lo) | ((unsigned)f2bf(hi) << 16); }
__device__ __forceinline__ float wave_sum(float v) {
#pragma unroll
    for (int o = 1; o < 64; o <<= 1) v += __shfl_xor(v, o);
    return v;
}

template <class DstF>
__device__ __forceinline__ void cvt_block_item(char* lds, const float* W, int N, int k0, int n0, const DstF& dst) {
    float* T = (float*)lds; const int tid = threadIdx.x;
    f32x4 v[16];
#pragma unroll
    for (int i = 0; i < 16; ++i) v[i] = *(const f32x4*)(W + (size_t)(k0 + (tid >> 6) + 4 * i) * N + n0 + 4 * (tid & 63));
#pragma unroll
    for (int i = 0; i < 16; ++i) *(f32x4*)(T + ((tid >> 6) + 4 * i) * 260 + 4 * (tid & 63)) = v[i];
    __syncthreads();
    bf16_t* d = dst(n0 + tid) + k0; const float* s = T + tid;
#pragma unroll
    for (int c = 0; c < 8; ++c) { u32x4 w; w.x = pk2bf(s[(8 * c + 0) * 260], s[(8 * c + 1) * 260]); w.y = pk2bf(s[(8 * c + 2) * 260], s[(8 * c + 3) * 260]);
        w.z = pk2bf(s[(8 * c + 4) * 260], s[(8 * c + 5) * 260]); w.w = pk2bf(s[(8 * c + 6) * 260], s[(8 * c + 7) * 260]); *(u32x4*)(d + 8 * c) = w; }
    __syncthreads();
}
__device__ __forceinline__ void cvt_plain(char* lds, const float* W, bf16_t* Wt, int K, int N, int item) {
    const int nb = N / 256, kb = item / nb, nbi = item % nb;
    cvt_block_item(lds, W, N, kb * 64, nbi * 256, [&](int n) { return Wt + (size_t)n * K; });
}
constexpr int CVT_IN = (D_MODEL / 64) * (EVEN_IN / 256), CVT_OUT = (D_MODEL / 64) * (D_MODEL / 256), CVT_GU1 = (D_MODEL / 64) * (D_EXPERT / 256), CVT_D1 = (D_EXPERT / 64) * (D_MODEL / 256);
constexpr int CVT_GU = DEPTH * N_EXPERTS * 2 * CVT_GU1, CVT_D = DEPTH * N_EXPERTS * CVT_D1;
constexpr int CVT_TOTAL = 2 * CVT_IN + 2 * CVT_OUT + CVT_GU + CVT_D;
constexpr int CVT_EARLY = 2 * CVT_IN + 2 * CVT_OUT;
static_assert(EVEN_IN % 256 == 0 && ODD_IN % 256 == 0 && D_EXPERT % 256 == 0, "conversion tile");
__device__ __forceinline__ void cvt_item(const Params& p, char* lds, int it) {
    if (it < CVT_IN) { cvt_plain(lds, p.w_in_even, p.Wt_in_even, D_MODEL, EVEN_IN, it); return; } it -= CVT_IN;
    if (it < CVT_IN) { cvt_plain(lds, p.w_in_odd, p.Wt_in_odd, D_MODEL, ODD_IN, it); return; } it -= CVT_IN;
    if (it < CVT_OUT) { cvt_plain(lds, p.w_out_even, p.Wt_out_even, EVEN_OUT, D_MODEL, it); return; } it -= CVT_OUT;
    if (it < CVT_OUT) { cvt_plain(lds, p.w_out_odd, p.Wt_out_odd, ODD_OUT, D_MODEL, it); return; } it -= CVT_OUT;
    if (it < CVT_GU) {
        const int le = it / (2 * CVT_GU1), r = it % (2 * CVT_GU1), half = r / CVT_GU1, r2 = r % CVT_GU1; const int nb = D_EXPERT / 256, kb = r2 / nb, nbi = r2 % nb;
        const float* W = (half ? p.moe_wu : p.moe_wg) + (size_t)le * D_MODEL * D_EXPERT; bf16_t* Wt = p.Wt_gu + (size_t)le * 2 * D_EXPERT * D_MODEL;
        cvt_block_item(lds, W, D_EXPERT, kb * 64, nbi * 256, [&](int n) { return Wt + (size_t)(32 * (n >> 4) + 16 * half + (n & 15)) * D_MODEL; });
        return; } it -= CVT_GU;
    { const int le = it / CVT_D1, r = it % CVT_D1; cvt_plain(lds, p.moe_wd + (size_t)le * D_EXPERT * D_MODEL, p.Wt_d + (size_t)le * D_MODEL * D_EXPERT, D_EXPERT, D_MODEL, r); }
}
__device__ __forceinline__ void cvt_range(const Params& p, char* lds, int lo, int hi, int bid, int nb) {
    for (int it = lo + bid; it < hi; it += nb) cvt_item(p, lds, it);
}

struct TileGeom { int tid, lane, wid, wr, wc, l15, q, srow, schunk;
    __device__ __forceinline__ int drow(int i) const { return wid * 32 + i * 8 + (lane >> 3); }
    __device__ __forceinline__ int dchunk(int i) const { return (lane & 7) ^ (((lane >> 4) + 4 * i) & 7); } };
__device__ __forceinline__ TileGeom tile_geom() { TileGeom g; g.tid = threadIdx.x; g.lane = g.tid & 63; g.wid = __builtin_amdgcn_readfirstlane(g.tid >> 6); g.wr = g.wid >> 1; g.wc = g.wid & 1; g.l15 = g.lane & 15; g.q = g.lane >> 4; g.srow = g.tid >> 3; g.schunk = g.tid & 7; return g; }

template <class ALoad, class BLoad>
__device__ __forceinline__ void gemm_mainloop(char* lds, const TileGeom& g, int nk, const ALoad& AL, const BLoad& BL, f32x4 (&acc)[4][4]) {
#pragma unroll
    for (int i = 0; i < 4; ++i)
#pragma unroll
        for (int j = 0; j < 4; ++j) acc[i][j] = (f32x4){0.f, 0.f, 0.f, 0.f};
    const int swz = g.l15 >> 1;
    const int aofs = (g.wr * 64 + g.l15) * 128 + ((g.q ^ swz) << 4);
    const int bofs = 32768 + (g.wc * 64 + g.l15) * 128 + ((g.q ^ swz) << 4);
    LAS char* l3 = (LAS char*)lds;
    const int dbase = g.wid * 4096;
#define GEMM_STAGE(kt_, buf_) do { _Pragma("unroll") for (int i_ = 0; i_ < 4; ++i_) { \
        __builtin_amdgcn_global_load_lds((const unsigned*)AL(i_, (kt_)), (LAS unsigned*)(l3 + (buf_) + dbase + i_ * 1024), 16, 0, 0); \
        __builtin_amdgcn_global_load_lds((const unsigned*)BL(i_, (kt_)), (LAS unsigned*)(l3 + 32768 + (buf_) + dbase + i_ * 1024), 16, 0, 0); } } while (0)
    GEMM_STAGE(0, 0);
    __syncthreads();
    for (int kt = 0; kt < nk; ++kt) {
        const int cur = (kt & 1) * 16384, nxt = 16384 - cur;
        if (kt + 1 < nk) GEMM_STAGE(kt + 1, nxt);
#pragma unroll
        for (int kk = 0; kk < 2; ++kk) {
            bf16x8 af[4], bfr[4];
#pragma unroll
            for (int i = 0; i < 4; ++i) { af[i] = *(const bf16x8*)(lds + cur + ((aofs + i * 2048) ^ (kk * 64))); bfr[i] = *(const bf16x8*)(lds + cur + ((bofs + i * 2048) ^ (kk * 64))); }
#pragma unroll
            for (int mi = 0; mi < 4; ++mi)
#pragma unroll
                for (int ni = 0; ni < 4; ++ni) acc[mi][ni] = __builtin_amdgcn_mfma_f32_16x16x32_bf16(bfr[ni], af[mi], acc[mi][ni], 0, 0, 0);
        }
        __syncthreads();
    }
#undef GEMM_STAGE
}

template <class DstF>
__device__ __forceinline__ void store_transposed(char* lds, const TileGeom& g, const f32x4 (&acc)[4][4], const DstF& dst) {
    bf16_t* T = (bf16_t*)lds;
#pragma unroll
    for (int mi = 0; mi < 4; ++mi)
#pragma unroll
        for (int ni = 0; ni < 4; ++ni)
#pragma unroll
            for (int r = 0; r < 4; ++r) T[(g.wc * 64 + ni * 16 + g.q * 4 + r) * 136 + g.wr * 64 + mi * 16 + g.l15] = f2bf(acc[mi][ni][r]);
    __syncthreads();
    { int col = g.tid >> 1, half = g.tid & 1; bf16_t* d = dst(col) + half * 64; const bf16_t* s = T + col * 136 + half * 64;
#pragma unroll
      for (int j = 0; j < 8; ++j) *(u32x4*)(d + j * 8) = *(const u32x4*)(s + j * 8); }
    __syncthreads();
}
__device__ __forceinline__ void store4bf(bf16_t* d, const f32x4& v) { u32x2 w; w.x = pk2bf(v[0], v[1]); w.y = pk2bf(v[2], v[3]); *(u32x2*)d = w; }
__device__ __forceinline__ void rope_head(const Params& p, f32x4 (&a)[4], int s, int q) {
    const int pr = s / GRID_W, pc = s % GRID_W;
    const f32x4 cr = *(const f32x4*)(p.ropet + pr * 32 + q * 4), sr = *(const f32x4*)(p.ropet + pr * 32 + 16 + q * 4);
    const f32x4 cc = *(const f32x4*)(p.ropet + pc * 32 + q * 4), sc = *(const f32x4*)(p.ropet + pc * 32 + 16 + q * 4);
    f32x4 x1 = a[0], x2 = a[1]; a[0] = x1 * cr - x2 * sr; a[1] = x2 * cr + x1 * sr;
    x1 = a[2]; x2 = a[3]; a[2] = x1 * cc - x2 * sc; a[3] = x2 * cc + x1 * sc;
}

template <int LAYER>
__device__ __forceinline__ void inproj_tile(const Params& p, char* lds, int mt, int nt) {
    const TileGeom g = tile_geom();
    const bf16_t* Abase = p.hbuf + (size_t)(mt * 128) * D_MODEL;
    const bf16_t* Bbase = (LAYER == 0 ? p.Wt_in_even : p.Wt_in_odd) + (size_t)(nt * 128) * D_MODEL;
    f32x4 acc[4][4];
    gemm_mainloop(lds, g, D_MODEL / 64, [&](int i, int kt) { return Abase + (size_t)g.drow(i) * D_MODEL + kt * 64 + g.dchunk(i) * 8; }, [&](int i, int kt) { return Bbase + (size_t)g.drow(i) * D_MODEL + kt * 64 + g.dchunk(i) * 8; }, acc);
    const bool lat = mt < MT_LAT; const int row0 = mt * 128;
    const int b = lat ? row0 / SEQ : (row0 - TX) / CTX_LEN, s0 = lat ? row0 % SEQ : (row0 - TX) % CTX_LEN, pos0 = lat ? CTX_LEN + s0 : s0;
    int kind;
    bf16_t* base; int h0 = 0, qcol0 = 0, nh = 2;
    if (LAYER == 0) {
        if (nt < 4) { kind = 0; base = p.QA; qcol0 = nt * 128; }
        else if (nt == 4) { kind = 1; base = p.KA; h0 = 0; nh = 2; }
        else if (nt == 5) { kind = 2; base = p.VAt; h0 = 0; nh = 2; }
        else if (nt < 10) { kind = 0; base = p.QB; qcol0 = (nt - 6) * 128; }
        else if (nt < 14) { kind = 1; base = p.KB; h0 = (nt - 10) * 2; nh = 8; }
        else { kind = 2; base = p.VBt; h0 = (nt - 14) * 2; nh = 8; }
    } else {
        if (nt < 4) { kind = 0; base = p.QC; qcol0 = nt * 128; }
        else if (nt == 4) { kind = 1; base = p.KC; h0 = 0; nh = 2; }
        else if (nt == 5) { kind = 2; base = p.VCt; h0 = 0; nh = 2; }
        else { kind = 3; base = p.UT; }
    }
    if (kind <= 1) {
        const bool rope = lat && (LAYER == 1 || nt <= 4);
#pragma unroll
        for (int mi = 0; mi < 4; ++mi) {
            const int rowl = g.wr * 64 + mi * 16 + g.l15;
            if (LAYER == 1) {
                float ss = 0.f;
#pragma unroll
                for (int ni = 0; ni < 4; ++ni) ss += acc[mi][ni][0] * acc[mi][ni][0] + acc[mi][ni][1] * acc[mi][ni][1] + acc[mi][ni][2] * acc[mi][ni][2] + acc[mi][ni][3] * acc[mi][ni][3];
                ss += __shfl_xor(ss, 16); ss += __shfl_xor(ss, 32);
                const float rstd = 1.0f / sqrtf(ss * (1.0f / 64.0f) + EPS);
                const float* gn = kind == 0 ? p.c_qnorm : p.c_knorm;
#pragma unroll
                for (int ni = 0; ni < 4; ++ni) acc[mi][ni] = acc[mi][ni] * rstd * *(const f32x4*)(gn + ni * 16 + g.q * 4);
            }
            if (rope) rope_head(p, acc[mi], s0 + rowl, g.q);
            bf16_t* d = kind == 0 ? base + (size_t)(row0 + rowl) * 512 + qcol0 + g.wc * 64 + g.q * 4
                                  : base + ((size_t)(b * nh + h0 + g.wc) * LKV + pos0 + rowl) * 64 + g.q * 4;
#pragma unroll
            for (int ni = 0; ni < 4; ++ni) store4bf(d + ni * 16, acc[mi][ni]);
        }
    } else if (kind == 2) {
        store_transposed(lds, g, acc, [&](int col) { return base + ((size_t)(b * nh + h0 + (col >> 6)) * 64 + (col & 63)) * LKV + pos0; });
    } else {
        store_transposed(lds, g, acc, [&](int col) { return base + ((size_t)b * 3 * D_CH + (nt - 6) * 128 + col) * SEQ + s0; });
    }
}
template <int LAYER>
__device__ __forceinline__ void ph_inproj(const Params& p, char* lds, int bid, int nb) {
    constexpr int NT = 18;
    if (LAYER == 0) { for (int t = bid; t < MT_ALL * NT; t += nb) inproj_tile<0>(p, lds, t / NT, t % NT); }
    else {
        const int n_lat = MT_LAT * NT, n_all = n_lat + (MT_ALL - MT_LAT) * 2;
        for (int t = bid; t < n_all; t += nb) { if (t < n_lat) inproj_tile<1>(p, lds, t / NT, t % NT); else { int u = t - n_lat; inproj_tile<1>(p, lds, MT_LAT + u / 2, 4 + u % 2); } }
    }
}

template <int LAYER>
__device__ __forceinline__ void outproj_tile(const Params& p, char* lds, int mt, int nt) {
    const TileGeom g = tile_geom();
    const bf16_t* Abase = p.Y + (size_t)(mt * 128) * 1024;
    const bf16_t* Bbase = (LAYER == 0 ? p.Wt_out_even : p.Wt_out_odd) + (size_t)(nt * 128) * 1024;
    f32x4 acc[4][4];
    gemm_mainloop(lds, g, 16, [&](int i, int kt) { return Abase + (size_t)g.drow(i) * 1024 + kt * 64 + g.dchunk(i) * 8; }, [&](int i, int kt) { return Bbase + (size_t)g.drow(i) * 1024 + kt * 64 + g.dchunk(i) * 8; }, acc);
    const int row0 = mt * 128;
#pragma unroll
    for (int mi = 0; mi < 4; ++mi) {
        const int row = row0 + g.wr * 64 + mi * 16 + g.l15;
        const float* xin = xrow_in(p, LAYER, row); float* xo = xrow_cur(p, row); const float* gate = modp(p, LAYER, row, 2);
#pragma unroll
        for (int ni = 0; ni < 4; ++ni) { const int col = nt * 128 + g.wc * 64 + ni * 16 + g.q * 4;
            *(f32x4*)(xo + col) = *(const f32x4*)(xin + col) + *(const f32x4*)(gate + col) * acc[mi][ni]; }
    }
}

template <int LAYER>
__device__ __forceinline__ void ph_outproj(const Params& p, char* lds, int bid, int nb) {
    const int nmt = LAYER == 0 ? MT_ALL : MT_LAT;
    for (int t = bid; t < nmt * 8; t += nb) outproj_tile<LAYER>(p, lds, t / 8, t % 8);
}

template <int NTN>
__device__ __forceinline__ bool moe_tile_lookup(const int* cnt, int t, int& pr, int& mt, int& nt, int& n) {
    int acc = 0;
    for (int q = 0; q < NPAIR; ++q) { const int c = cnt[q]; const int tiles = ((c + 127) >> 7) * NTN; if (t < acc + tiles) { pr = q; const int u = t - acc; mt = u / NTN; nt = u % NTN; n = c; return true; } acc += tiles; }
    return false;
}
__device__ __forceinline__ void moe_up_tile(const Params& p, char* lds, int l, int pr, int mt, int nt, int n) {
    const TileGeom g = tile_geom();
    int e1, e2; pair_experts(pr, e1, e2); const int k = nt >> 3, e = k ? e2 : e1;
    const int* lst = p.list + (size_t)pr * TT + mt * 128;
    const int navail = n - mt * 128;
    const bf16_t* arow[4];
#pragma unroll
    for (int i = 0; i < 4; ++i) { int r = g.drow(i); if (r >= navail) r = navail - 1; arow[i] = p.hbuf + (size_t)lst[r] * D_MODEL + g.dchunk(i) * 8; }
    const bf16_t* Bbase = p.Wt_gu + ((size_t)(l * N_EXPERTS + e) * 2 * D_EXPERT + (nt & 7) * 128) * D_MODEL;
    f32x4 acc[4][4];
    gemm_mainloop(lds, g, D_MODEL / 64, [&](int i, int kt) { return arow[i] + kt * 64; }, [&](int i, int kt) { return Bbase + (size_t)g.drow(i) * D_MODEL + kt * 64 + g.dchunk(i) * 8; }, acc);
#pragma unroll
    for (int mi = 0; mi < 4; ++mi) {
        const int rl = g.wr * 64 + mi * 16 + g.l15;
        if (rl < navail) {
            const int row = lst[rl]; const float w = p.tokw[row * 2 + k];
            bf16_t* d = p.HE + (size_t)row * HE_W + k * D_EXPERT + (nt & 7) * 64 + g.wc * 32 + g.q * 4;
#pragma unroll
            for (int h2 = 0; h2 < 2; ++h2) { f32x4 gg = acc[mi][2 * h2], uu = acc[mi][2 * h2 + 1], o;
#pragma unroll
                for (int r = 0; r < 4; ++r) o[r] = w * (gg[r] / (1.0f + __expf(-gg[r]))) * uu[r];
                store4bf(d + h2 * 16, o); }
        }
    }
}
template <bool DUMMY = false>
__device__ __forceinline__ void moe_down_tile(const Params& p, char* lds, int l, int pr, int mt, int nt, int n) {
    const TileGeom g = tile_geom();
    int e1, e2; pair_experts(pr, e1, e2);
    const int* lst = p.list + (size_t)pr * TT + mt * 128;
    const int navail = n - mt * 128;
    const bf16_t* arow[4];
#pragma unroll
    for (int i = 0; i < 4; ++i) { int r = g.drow(i); if (r >= navail) r = navail - 1; arow[i] = p.HE + (size_t)lst[r] * HE_W + g.dchunk(i) * 8; }
    const bf16_t* B1 = p.Wt_d + ((size_t)(l * N_EXPERTS + e1) * D_MODEL + nt * 128) * D_EXPERT;
    const bf16_t* B2 = p.Wt_d + ((size_t)(l * N_EXPERTS + e2) * D_MODEL + nt * 128) * D_EXPERT;
    constexpr int KT1 = D_EXPERT / 64;
    f32x4 acc[4][4];
    gemm_mainloop(lds, g, HE_W / 64, [&](int i, int kt) { return arow[i] + kt * 64; },
                  [&](int i, int kt) { return (kt < KT1 ? B1 + kt * 64 : B2 + (kt - KT1) * 64) + (size_t)g.drow(i) * D_EXPERT + g.dchunk(i) * 8; }, acc);
#pragma unroll
    for (int mi = 0; mi < 4; ++mi) {
        const int rl = g.wr * 64 + mi * 16 + g.l15;
        if (rl < navail) {
            const int row = lst[rl]; float* xo = xrow_cur(p, row); const float* gate = modp(p, l, row, 5);
#pragma unroll
            for (int ni = 0; ni < 4; ++ni) { const int col = nt * 128 + g.wc * 64 + ni * 16 + g.q * 4; float* dst = DUMMY ? (float*)p.QA + (size_t)row * D_MODEL : xo; *(f32x4*)(dst + col) = *(const f32x4*)(xo + col) + *(const f32x4*)(gate + col) * acc[mi][ni]; }
        }
    }
}
__device__ __forceinline__ void ph_moe_up(const Params& p, char* lds, int l, int bid, int nb) {
    int pr, mt, nt, n; for (int t = bid; moe_tile_lookup<16>(p.cnt + l * 32, t, pr, mt, nt, n); t += nb) moe_up_tile(p, lds, l, pr, mt, nt, n);
}
template <bool DUMMY = false>
__device__ __forceinline__ void ph_moe_down(const Params& p, char* lds, int l, int bid, int nb) {
    int pr, mt, nt, n; for (int t = bid; moe_tile_lookup<8>(p.cnt + l * 32, t, pr, mt, nt, n); t += nb) moe_down_tile<DUMMY>(p, lds, l, pr, mt, nt, n);
}
typedef float f32x2 __attribute__((ext_vector_type(2)));
typedef __bf16 bf16x2_t __attribute__((ext_vector_type(2)));
__device__ __forceinline__ unsigned cvtpk(float lo, float hi) { f32x2 v = {lo, hi}; bf16x2_t b = __builtin_convertvector(v, bf16x2_t); return __builtin_bit_cast(unsigned, b); }
__device__ __forceinline__ int crow(int r, int hi) { return (r & 3) + 8 * (r >> 2) + 4 * hi; }
constexpr float LOG2E = 1.4426950408889634f;
constexpr float QK_C = ATTN_SCALE * LOG2E;
constexpr float NEG_BIG = -1e30f;

template <int MODE>
__device__ __forceinline__ void attn_unit(char* lds, const bf16_t* Qp, const bf16_t* Kp, const bf16_t* Vt, bf16_t* Op, int s0, int nctx, int lt0, int nlat, float sink2, bool has_sink, const float* rpb_h) {
    int tid_ = threadIdx.x; asm volatile("" : "+v"(tid_));
    const int tid = tid_, lane = tid & 63, wid = __builtin_amdgcn_readfirstlane(tid >> 6), l31 = lane & 31, hi = lane >> 5;
    float* bias_s = (float*)(lds + 49152);
    if (MODE == 2) { for (int i = tid; i < 15 * 31; i += NTHREADS) bias_s[i] = rpb_h[i] * LOG2E; }
    const int ntiles = nctx + nlat;
    LAS char* l3 = (LAS char*)lds;
    const int drow0 = wid * 16 + (lane >> 3);
    const int dch0 = (lane & 7) ^ (((lane >> 4) + 0) & 7), dch1 = (lane & 7) ^ (((lane >> 4) + 4) & 7);
    const bf16_t* ksrc0 = Kp + (size_t)drow0 * 64 + dch0 * 8; const bf16_t* ksrc1 = Kp + (size_t)(drow0 + 8) * 64 + dch1 * 8;
    const bf16_t* vsrc0 = Vt + (size_t)drow0 * LKV + dch0 * 8; const bf16_t* vsrc1 = Vt + (size_t)(drow0 + 8) * LKV + dch1 * 8;
    const int ddst = wid * 2048;
    auto tile_pos = [&](int j) { return j < nctx ? 64 * j : CTX_LEN + 64 * (lt0 + j - nctx); };
#define ATT_DMA(j_, slot_) do { const int pos_ = tile_pos(j_); \
        __builtin_amdgcn_global_load_lds((const unsigned*)(ksrc0 + (size_t)pos_ * 64), (LAS unsigned*)(l3 + (slot_) * 8192 + ddst), 16, 0, 0); \
        __builtin_amdgcn_global_load_lds((const unsigned*)(ksrc1 + (size_t)pos_ * 64), (LAS unsigned*)(l3 + (slot_) * 8192 + ddst + 1024), 16, 0, 0); \
        __builtin_amdgcn_global_load_lds((const unsigned*)(vsrc0 + pos_), (LAS unsigned*)(l3 + 24576 + (slot_) * 8192 + ddst), 16, 0, 0); \
        __builtin_amdgcn_global_load_lds((const unsigned*)(vsrc1 + pos_), (LAS unsigned*)(l3 + 24576 + (slot_) * 8192 + ddst + 1024), 16, 0, 0); } while (0)
    const int x = (l31 >> 1) & 7;
    const int kofs = l31 * 128 + ((hi ^ x) << 4);
    const int vofs = 24576 + l31 * 128 + (x << 4) + 8 * hi;
    bf16x8 qf[4];
    { const bf16_t* qr = Qp + (size_t)(wid * 32 + l31) * 512 + hi * 8;
#pragma unroll
      for (int s = 0; s < 4; ++s) qf[s] = *(const bf16x8*)(qr + s * 16); }
    f32x16 o0 = {}, o1 = {};
    float m = NEG_BIG, l = 0.f;
    const int sq = s0 + wid * 32 + l31;
    int rq = 0, cq = 0, rsq = 0, csq = 0;
    if (MODE == 2) { rq = sq / GRID_W; cq = sq % GRID_W; rsq = rq - B_WIN_H / 2; rsq = rsq < 0 ? 0 : (rsq > GRID_H - B_WIN_H ? GRID_H - B_WIN_H : rsq); csq = cq - B_WIN_W / 2; csq = csq < 0 ? 0 : (csq > GRID_W - B_WIN_W ? GRID_W - B_WIN_W : csq); }
    ATT_DMA(0, 0);
    if (ntiles > 1) { ATT_DMA(1, 1); asm volatile("s_waitcnt vmcnt(4) lgkmcnt(0)" ::: "memory"); } else { asm volatile("s_waitcnt vmcnt(0) lgkmcnt(0)" ::: "memory"); }
    __builtin_amdgcn_s_barrier(); asm volatile("" ::: "memory");
    int slot = 0;
    for (int j = 0; j < ntiles; ++j) {
        const int slot2 = slot == 0 ? 2 : slot - 1;
        const bool pre = j + 2 < ntiles;
        if (pre) ATT_DMA(j + 2, slot2);
        const char* Kb = lds + slot * 8192; const char* Vb = lds + slot * 8192;
        f32x16 p0 = {}, p1 = {};
#pragma unroll
        for (int s = 0; s < 4; ++s) {
            const bf16x8 k0 = *(const bf16x8*)(Kb + (kofs ^ (s << 5))); const bf16x8 k1 = *(const bf16x8*)(Kb + 4096 + (kofs ^ (s << 5)));
            p0 = __builtin_amdgcn_mfma_f32_32x32x16_bf16(k0, qf[s], p0, 0, 0, 0); p1 = __builtin_amdgcn_mfma_f32_32x32x16_bf16(k1, qf[s], p1, 0, 0, 0);
        }
        float tmax = NEG_BIG;
        const bool plain = (MODE == 0 || j < nctx);
        if (plain) {
#pragma unroll
            for (int r = 0; r < 16; ++r) tmax = fmaxf(tmax, fmaxf(p0[r], p1[r]));
            tmax *= QK_C;
        } else if (MODE == 1) {
            const int sk0 = 64 * (lt0 + j - nctx);
#pragma unroll
            for (int r = 0; r < 16; ++r) { const int d0 = sk0 + crow(r, hi) - sq, d1 = d0 + 32;
                p0[r] = (d0 >= -A_WINDOW && d0 <= A_WINDOW) ? p0[r] * QK_C : NEG_BIG; p1[r] = (d1 >= -A_WINDOW && d1 <= A_WINDOW) ? p1[r] * QK_C : NEG_BIG; tmax = fmaxf(tmax, fmaxf(p0[r], p1[r])); }
        } else {
            const int kr = lt0 + j - nctx; const bool rowok = kr >= rsq && kr < rsq + B_WIN_H;
            const float* brow = bias_s + (kr - rq + B_WIN_H - 1) * 31 + (B_WIN_W - 1) - cq;
#pragma unroll
            for (int r = 0; r < 16; ++r) { const int kc0 = crow(r, hi), kc1 = kc0 + 32;
                const bool ok0 = rowok && kc0 >= csq && kc0 < csq + B_WIN_W, ok1 = rowok && kc1 >= csq && kc1 < csq + B_WIN_W;
                p0[r] = ok0 ? p0[r] * QK_C + brow[kc0] : NEG_BIG; p1[r] = ok1 ? p1[r] * QK_C + brow[kc1] : NEG_BIG; tmax = fmaxf(tmax, fmaxf(p0[r], p1[r])); }
        }
        tmax = fmaxf(tmax, __shfl_xor(tmax, 32));
        const float mn = fmaxf(m, tmax);
        if (__any(mn > m)) {
            const float alpha = __builtin_amdgcn_exp2f(m - mn); m = mn; l *= alpha;
#pragma unroll
            for (int r = 0; r < 16; ++r) { o0[r] *= alpha; o1[r] *= alpha; }
        }
        float ls = 0.f;
        if (plain) {
#pragma unroll
            for (int r = 0; r < 16; ++r) { p0[r] = __builtin_amdgcn_exp2f(__builtin_fmaf(p0[r], QK_C, -m)); p1[r] = __builtin_amdgcn_exp2f(__builtin_fmaf(p1[r], QK_C, -m)); ls += p0[r] + p1[r]; }
        } else {
#pragma unroll
            for (int r = 0; r < 16; ++r) { p0[r] = __builtin_amdgcn_exp2f(p0[r] - m); p1[r] = __builtin_amdgcn_exp2f(p1[r] - m); ls += p0[r] + p1[r]; }
        }
        l += ls;
        bf16x8 pf[4];
        { u32x4 w;
          w.x = cvtpk(p0[0], p0[1]); w.y = cvtpk(p0[2], p0[3]); w.z = cvtpk(p0[4], p0[5]); w.w = cvtpk(p0[6], p0[7]); pf[0] = __builtin_bit_cast(bf16x8, w);
          w.x = cvtpk(p0[8], p0[9]); w.y = cvtpk(p0[10], p0[11]); w.z = cvtpk(p0[12], p0[13]); w.w = cvtpk(p0[14], p0[15]); pf[1] = __builtin_bit_cast(bf16x8, w);
          w.x = cvtpk(p1[0], p1[1]); w.y = cvtpk(p1[2], p1[3]); w.z = cvtpk(p1[4], p1[5]); w.w = cvtpk(p1[6], p1[7]); pf[2] = __builtin_bit_cast(bf16x8, w);
          w.x = cvtpk(p1[8], p1[9]); w.y = cvtpk(p1[10], p1[11]); w.z = cvtpk(p1[12], p1[13]); w.w = cvtpk(p1[14], p1[15]); pf[3] = __builtin_bit_cast(bf16x8, w); }
#pragma unroll
        for (int s = 0; s < 4; ++s) {
            const int a0 = vofs ^ (s << 5);
            u32x2 va = *(const u32x2*)(Vb + a0), vb = *(const u32x2*)(Vb + (a0 ^ 16));
            u32x2 vc = *(const u32x2*)(Vb + 4096 + a0), vd = *(const u32x2*)(Vb + 4096 + (a0 ^ 16));
            const bf16x8 f0 = __builtin_bit_cast(bf16x8, (u32x4){va.x, va.y, vb.x, vb.y}), f1 = __builtin_bit_cast(bf16x8, (u32x4){vc.x, vc.y, vd.x, vd.y});
            o0 = __builtin_amdgcn_mfma_f32_32x32x16_bf16(f0, pf[s], o0, 0, 0, 0); o1 = __builtin_amdgcn_mfma_f32_32x32x16_bf16(f1, pf[s], o1, 0, 0, 0);
        }
        if (pre) asm volatile("s_waitcnt vmcnt(4) lgkmcnt(0)" ::: "memory"); else asm volatile("s_waitcnt vmcnt(0) lgkmcnt(0)" ::: "memory");
        __builtin_amdgcn_s_barrier(); asm volatile("" ::: "memory");
        slot = slot == 2 ? 0 : slot + 1;
    }
#undef ATT_DMA
    l += __shfl_xor(l, 32);
    if (has_sink) l += __builtin_amdgcn_exp2f(sink2 - m);
    const float inv = 1.0f / l;
    bf16_t* orow = Op + (size_t)(wid * 32 + l31) * 1024;
#pragma unroll
    for (int g4 = 0; g4 < 4; ++g4) {
        u32x2 w; w.x = cvtpk(o0[g4 * 4 + 0] * inv, o0[g4 * 4 + 1] * inv); w.y = cvtpk(o0[g4 * 4 + 2] * inv, o0[g4 * 4 + 3] * inv); *(u32x2*)(orow + 8 * g4 + 4 * hi) = w;
        w.x = cvtpk(o1[g4 * 4 + 0] * inv, o1[g4 * 4 + 1] * inv); w.y = cvtpk(o1[g4 * 4 + 2] * inv, o1[g4 * 4 + 3] * inv); *(u32x2*)(orow + 32 + 8 * g4 + 4 * hi) = w;
    }
    asm volatile("s_waitcnt vmcnt(0)" ::: "memory");
}

constexpr int NU_LAT = BATCH * 8 * (SEQ / 128);
constexpr int NU_CTX = BATCH * 8 * (CTX_LEN / 128);
__device__ __forceinline__ void ph_attn0(const Params& p, char* lds, int bid, int nb) {
    for (int u = bid; u < 2 * NU_LAT + 2 * NU_CTX; u += nb) {
        if (u < NU_LAT) {
            const int blk = u % (SEQ / 128), h = (u / (SEQ / 128)) % 8, b = u / (8 * (SEQ / 128)); const int s0 = blk * 128, r0 = s0 / GRID_W;
            int rs0 = r0 - 4; rs0 = rs0 < 0 ? 0 : (rs0 > GRID_H - 8 ? GRID_H - 8 : rs0); int rs1 = r0 + 1 - 4; rs1 = rs1 < 0 ? 0 : (rs1 > GRID_H - 8 ? GRID_H - 8 : rs1);
            attn_unit<2>(lds, p.QB + (size_t)(b * SEQ + s0) * 512 + h * 64, p.KB + (size_t)(b * 8 + h) * LKV * 64, p.VBt + (size_t)(b * 8 + h) * 64 * LKV,
                         p.Y + (size_t)(b * SEQ + s0) * 1024 + 512 + h * 64, s0, CTX_LEN / 64, rs0, rs1 + 8 - rs0, 0.f, false, p.b_rpb + h * 15 * 31);
        } else if (u < 2 * NU_LAT) {
            const int v = u - NU_LAT; const int blk = v % (SEQ / 128), h = (v / (SEQ / 128)) % 8, b = v / (8 * (SEQ / 128)); const int s0 = blk * 128;
            int t0 = (s0 - 128) / 64; if (t0 < 0) t0 = 0; int t1 = (s0 + 255) / 64; if (t1 > SEQ / 64 - 1) t1 = SEQ / 64 - 1;
            attn_unit<1>(lds, p.QA + (size_t)(b * SEQ + s0) * 512 + h * 64, p.KA + (size_t)(b * 2 + h / 4) * LKV * 64, p.VAt + (size_t)(b * 2 + h / 4) * 64 * LKV,
                         p.Y + (size_t)(b * SEQ + s0) * 1024 + h * 64, s0, CTX_LEN / 64, t0, t1 - t0 + 1, p.a_sink[h] * LOG2E, true, nullptr);
        } else {
            const int v = u - 2 * NU_LAT; const int ty = v / NU_CTX, w = v % NU_CTX; const int blk = w % (CTX_LEN / 128), h = (w / (CTX_LEN / 128)) % 8, b = w / (8 * (CTX_LEN / 128));
            const int row0 = TX + b * CTX_LEN + blk * 128;
            if (ty == 0) attn_unit<0>(lds, p.QA + (size_t)row0 * 512 + h * 64, p.KA + (size_t)(b * 2 + h / 4) * LKV * 64, p.VAt + (size_t)(b * 2 + h / 4) * 64 * LKV, p.Y + (size_t)row0 * 1024 + h * 64, 0, CTX_LEN / 64, 0, 0, p.a_sink[h] * LOG2E, true, nullptr);
            else attn_unit<0>(lds, p.QB + (size_t)row0 * 512 + h * 64, p.KB + (size_t)(b * 8 + h) * LKV * 64, p.VBt + (size_t)(b * 8 + h) * 64 * LKV, p.Y + (size_t)row0 * 1024 + 512 + h * 64, 0, CTX_LEN / 64, 0, 0, 0.f, false, nullptr);
        }
    }
}
__device__ __forceinline__ void ph_attnC(const Params& p, char* lds, int bid, int nb) {
    for (int u = bid; u < NU_LAT; u += nb) {
        const int blk = u % (SEQ / 128), h = (u / (SEQ / 128)) % 8, b = u / (8 * (SEQ / 128)); const int s0 = blk * 128;
        attn_unit<0>(lds, p.QC + (size_t)(b * SEQ + s0) * 512 + h * 64, p.KC + (size_t)(b * 2 + h / 4) * LKV * 64, p.VCt + (size_t)(b * 2 + h / 4) * 64 * LKV,
                     p.Y + (size_t)(b * SEQ + s0) * 1024 + h * 64, s0, CTX_LEN / 64, 0, SEQ / 64, 0.f, false, nullptr);
    }
}
#ifdef HY_TEST
#define HY_OUT(b, t, v) p.YHT[((size_t)(b) * D_CH + c) * SEQ + (t)] = f2bf(v)
#else
#define HY_OUT(b, t, v) p.YHT[((size_t)(b) * D_CH + c) * SEQ + (t)] = f2bf(v)
#endif
#ifdef CPU_TEST
#define FOR_T for (int tid = 0; tid < 256; ++tid)
#define HSYNC
#define HST(t) st[t]
#define HY_DECL HySt* st = new HySt[256]
#define HY_FREE delete[] st
static inline void sincos_rev(float a, float& c, float& s) { c = cosf(6.283185307179586f * a); s = sinf(6.283185307179586f * a); }
#else
__device__ __forceinline__ int hy_launder(int v) { asm volatile("" : "+v"(v)); return v; }
#define FOR_T if (const int tid = hy_launder((int)threadIdx.x); true)
#define HSYNC __syncthreads()
#define HST(t) st
#define HY_DECL HySt st
#define HY_FREE
__device__ __forceinline__ void sincos_rev(float a, float& c, float& s) { c = __builtin_amdgcn_cosf(a); s = __builtin_amdgcn_sinf(a); }
#endif
constexpr int FN = 2 * SEQ;
constexpr int FPAD = FN + (FN >> 5);
#if !defined(SMALL_CFG)
static_assert(FN == 8192, "pass plan 8,8,8,16 is for N = 8192");
constexpr int R4 = 16;
constexpr int NS4 = 512;
#else
constexpr int R4 = 2;
constexpr int NS4 = 512;
#endif
constexpr int NB8 = FN / 8 / 256;
constexpr int NB4 = FN / R4 / 256;
constexpr int EPT = FN / 256;
struct HySt { float xr[EPT], xi[EPT]; unsigned kp[EPT]; };
HD unsigned hy_pack(float r, float i) { return (unsigned)f2bf(r) | ((unsigned)f2bf(i) << 16); }
HD float hy_lo(unsigned v) { unsigned u = v << 16; float f; __builtin_memcpy(&f, &u, 4); return f; }
HD float hy_hi(unsigned v) { unsigned u = v & 0xffff0000u; float f; __builtin_memcpy(&f, &u, 4); return f; }
HD int pidx(int i) { return i + (i >> 5); }

constexpr float W16C[8] = {1.0f, 0.9238795325112867f, 0.7071067811865476f, 0.3826834323650898f, 0.0f, -0.3826834323650898f, -0.7071067811865476f, -0.9238795325112867f};
constexpr float W16S[8] = {0.0f, -0.3826834323650898f, -0.7071067811865476f, -0.9238795325112867f, -1.0f, -0.9238795325112867f, -0.7071067811865476f, -0.3826834323650898f};
template <int R> HD void fft_reg(float* xr, float* xi) {
    constexpr int LG = R == 16 ? 4 : (R == 8 ? 3 : (R == 4 ? 2 : 1));
#pragma unroll
    for (int sg = 0; sg < LG; ++sg) {
        const int h = (R / 2) >> sg;
#pragma unroll
        for (int pr = 0; pr < R / 2; ++pr) {
            const int blk = (pr / h) * 2 * h, i = pr % h;
            const int a = blk + i, b = blk + i + h;
            const float ar = xr[a], ai = xi[a], br = xr[b], bi = xi[b];
            xr[a] = ar + br; xi[a] = ai + bi;
            const float tr = ar - br, ti = ai - bi;
            const int tw = i * (8 / h);
            if (tw == 0) { xr[b] = tr; xi[b] = ti; }
            else if (tw == 4) { xr[b] = ti; xi[b] = -tr; }
            else { const float c = W16C[tw & 7], s = W16S[tw & 7]; xr[b] = tr * c - ti * s; xi[b] = tr * s + ti * c; }
        }
    }
}
template <int R> HD constexpr int bitrev(int i) { int r = 0; for (int b = 1; b < R; b <<= 1) { r = (r << 1) | (i & 1); i >>= 1; } return r; }

template <int R, int NB, class In> HD void pass_load(int tid, HySt& s, const In& in) {
#pragma unroll
    for (int b = 0; b < NB; ++b)
#pragma unroll
        for (int r = 0; r < R; ++r) in(tid + 256 * b + (FN / R) * r, r, s.xr[b * R + r], s.xi[b * R + r]);
}
template <int R, int NB, class Out> HD void pass_compute(int tid, HySt& s, int Ns, const Out& out) {
#pragma unroll
    for (int b = 0; b < NB; ++b) {
        const int j = tid + 256 * b, k = j & (Ns - 1);
        float* xr = s.xr + b * R; float* xi = s.xi + b * R;
        if (Ns > 1) {
            float wc, ws; sincos_rev(-(float)k / (float)(Ns * R), wc, ws);
            float cr = wc, ci = ws;
#pragma unroll
            for (int r = 1; r < R; ++r) {
                const float vr = xr[r], vi = xi[r]; xr[r] = vr * cr - vi * ci; xi[r] = vr * ci + vi * cr;
                const float nr = cr * wc - ci * ws, ni = cr * ws + ci * wc; cr = nr; ci = ni;
            }
        }
        fft_reg<R>(xr, xi);
        const int j0 = (j - k) * R + k;
#pragma unroll
        for (int i = 0; i < R; ++i) out(j0 + bitrev<R>(i) * Ns, b, bitrev<R>(i), xr[i], xi[i]);
    }
}
struct LdsIn { const float* re; const float* im; HD void operator()(int idx, int, float& r, float& i) const { r = re[pidx(idx)]; i = im[pidx(idx)]; } };
struct LdsOut { float* re; float* im; HD void operator()(int idx, int, int, float r, float i) const { re[pidx(idx)] = r; im[pidx(idx)] = i; } };

HD void hy_pre_load(const Params& p, int c, int b, int tid, float* lds) {
#pragma unroll
    for (int q = 0; q < 3; ++q) {
        const bf16_t* u = p.UT + ((size_t)b * 3 * D_CH + q * D_CH + c) * SEQ; const int t0 = tid * 16;
        const float w0 = p.hy_short_w[0 * 3 * D_CH + q * D_CH + c], w1 = p.hy_short_w[1 * 3 * D_CH + q * D_CH + c], w2 = p.hy_short_w[2 * 3 * D_CH + q * D_CH + c], sb = p.hy_short_b[q * D_CH + c];
        unsigned w[8];
        { const unsigned* u32p = (const unsigned*)(u + t0);
#pragma unroll
          for (int i = 0; i < 8; ++i) w[i] = u32p[i]; }
        float x[18];
        x[0] = t0 > 0 ? bf2f(u[t0 - 1]) : 0.f; x[17] = t0 + 16 < SEQ ? bf2f(u[t0 + 16]) : 0.f;
#pragma unroll
        for (int i = 0; i < 8; ++i) { x[1 + 2 * i] = bf2f((bf16_t)(w[i] & 0xffffu)); x[2 + 2 * i] = bf2f((bf16_t)(w[i] >> 16)); }
#pragma unroll
        for (int i = 0; i < 16; ++i) lds[q * SEQ + t0 + i] = sb + w0 * x[i] + w1 * x[i + 1] + w2 * x[i + 2];
    }
}
HD void hy_pre_store(const Params& p, int c, int b, int tid, const float* lds) {
#pragma unroll
    for (int q = 0; q < 3; ++q) {
        unsigned* u = (unsigned*)(p.UT + ((size_t)b * 3 * D_CH + q * D_CH + c) * SEQ + tid * 16);
#pragma unroll
        for (int i = 0; i < 8; ++i) u[i] = (unsigned)f2bf(lds[q * SEQ + tid + 256 * (2 * i)]) | ((unsigned)f2bf(lds[q * SEQ + tid + 256 * (2 * i + 1)]) << 16);
    }
}
HD void tm_load_bf16(const bf16_t* row, int tid, unsigned (&w)[8]) { const unsigned* q = (const unsigned*)(row + tid * 16);
#pragma unroll
    for (int i = 0; i < 8; ++i) w[i] = q[i]; }
HD float tm_get(const unsigned (&w)[8], int m) { return bf2f((bf16_t)((m & 1) ? (w[m >> 1] >> 16) : (w[m >> 1] & 0xffffu))); }
HD int tm_ofs(int idx) { return (idx & 255) * 16 + (idx >> 8); }

HD void hyena_channel(const Params& p, int c, float* lds) {
    HY_DECL;
    float* re = lds; float* im = lds + FPAD;
    const LdsIn lin{re, im}; const LdsOut lout{re, im};
    for (int b = 0; b < BATCH; ++b) { FOR_T { hy_pre_load(p, c, b, tid, lds); } HSYNC; FOR_T { hy_pre_store(p, c, b, tid, lds); } HSYNC; }
    float nrm[2];
#pragma unroll
    for (int o = 0; o < 2; ++o) {
        const float* hf = p.HFT + (size_t)((0 * 2 + o) * D_CH + c) * SEQ; const float* hb = p.HFT + (size_t)((1 * 2 + o) * D_CH + c) * SEQ;
        FOR_T { float sacc = 0.f; for (int i = 0; i < SEQ / 256; ++i) sacc += fabsf(hf[tid + 256 * i]) + fabsf(hb[tid + 256 * i]); re[tid] = sacc; }
        HSYNC;
        { float tot = 0.f; for (int i = 0; i < 256; ++i) tot += re[i]; nrm[o] = tot + EPS; }
        HSYNC;
    }
    float sw[3][3], sbv[3];
#pragma unroll
    for (int q = 0; q < 3; ++q) { sbv[q] = p.hy_short_b[q * D_CH + c];
#pragma unroll
        for (int kk = 0; kk < 3; ++kk) sw[q][kk] = p.hy_short_w[kk * 3 * D_CH + q * D_CH + c]; }
#pragma unroll 1
    for (int o = 0; o < 2; ++o) {
        const float* hf = p.HFT + (size_t)((0 * 2 + o) * D_CH + c) * SEQ; const float* hb = p.HFT + (size_t)((1 * 2 + o) * D_CH + c) * SEQ;
        const float inv = 1.0f / (o == 0 ? nrm[0] : nrm[1]); const float hbias = p.hy_bias[o * D_CH + c];
        float swg[3]; swg[0] = o == 0 ? sw[1][0] : sw[2][0]; swg[1] = o == 0 ? sw[1][1] : sw[2][1]; swg[2] = o == 0 ? sw[1][2] : sw[2][2]; const float sbg = o == 0 ? sbv[1] : sbv[2];
        FOR_T { pass_load<8, NB8>(tid, HST(tid), [&](int idx, int r8, float& r, float& i) __attribute__((always_inline)) { if (r8 < 4) r = hf[idx] * inv; else { const int q = FN - idx; const float hv = hb[q < SEQ ? q : 0]; r = q < SEQ ? hv * inv : 0.f; } i = 0.f; });
                pass_compute<8, NB8>(tid, HST(tid), 1, lout); }
        HSYNC;
        FOR_T { pass_load<8, NB8>(tid, HST(tid), lin); } HSYNC; FOR_T { pass_compute<8, NB8>(tid, HST(tid), 8, lout); } HSYNC;
        FOR_T { pass_load<8, NB8>(tid, HST(tid), lin); } HSYNC; FOR_T { pass_compute<8, NB8>(tid, HST(tid), 64, lout); } HSYNC;
        FOR_T { pass_load<R4, NB4>(tid, HST(tid), lin);
                HySt& s = HST(tid); pass_compute<R4, NB4>(tid, s, NS4, [&](int, int b, int rr, float r, float i) __attribute__((always_inline)) { s.kp[b + NB4 * rr] = hy_pack(r, i); }); }
        HSYNC;
        for (int bp = 0; bp < BATCH / 2; ++bp) {
            const int b0 = 2 * bp, b1 = 2 * bp + 1;
            const bf16_t* u0 = p.UT + ((size_t)b0 * 3 * D_CH + c) * SEQ; const bf16_t* u1 = p.UT + ((size_t)b1 * 3 * D_CH + c) * SEQ;
            const float* z0 = p.Z1 + ((size_t)b0 * D_CH + c) * SEQ; const float* z1 = p.Z1 + ((size_t)b1 * D_CH + c) * SEQ;
            auto zval = [&](int b, int t) __attribute__((always_inline)) { return o == 0 ? bf2f((b == b0 ? u0 : u1)[tm_ofs(t)]) : (b == b0 ? z0 : z1)[tm_ofs(t)]; };
            FOR_T { HySt& s = HST(tid);
                    if (o == 0) { unsigned w0[8], w1[8]; tm_load_bf16(u0, tid, w0); tm_load_bf16(u1, tid, w1);
#pragma unroll
                        for (int q = 0; q < 32; ++q) { const int b = q >> 3, r = q & 7; if (r < 4) { s.xr[q] = tm_get(w0, b + 4 * r); s.xi[q] = tm_get(w1, b + 4 * r); } else { s.xr[q] = 0.f; s.xi[q] = 0.f; } } }
                    else {
#pragma unroll
                        for (int q = 0; q < 32; ++q) { const int b = q >> 3, r = q & 7; if (r < 4) { s.xr[q] = z0[tid * 16 + b + 4 * r]; s.xi[q] = z1[tid * 16 + b + 4 * r]; } else { s.xr[q] = 0.f; s.xi[q] = 0.f; } } }
                    pass_compute<8, NB8>(tid, s, 1, lout); }
            HSYNC;
            FOR_T { pass_load<8, NB8>(tid, HST(tid), lin); } HSYNC; FOR_T { pass_compute<8, NB8>(tid, HST(tid), 8, lout); } HSYNC;
            FOR_T { pass_load<8, NB8>(tid, HST(tid), lin); } HSYNC; FOR_T { pass_compute<8, NB8>(tid, HST(tid), 64, lout); } HSYNC;
            FOR_T { pass_load<R4, NB4>(tid, HST(tid), lin); } HSYNC;
            FOR_T { HySt& s = HST(tid); pass_compute<R4, NB4>(tid, s, NS4, [&](int idx, int b, int rr, float r, float i) __attribute__((always_inline)) { const float kr = hy_lo(s.kp[b + NB4 * rr]), ki = hy_hi(s.kp[b + NB4 * rr]);
                        re[pidx(idx)] = r * kr - i * ki; im[pidx(idx)] = -(r * ki + i * kr); }); }
            HSYNC;
            FOR_T { pass_load<8, NB8>(tid, HST(tid), lin); } HSYNC; FOR_T { pass_compute<8, NB8>(tid, HST(tid), 1, lout); } HSYNC;
            FOR_T { pass_load<8, NB8>(tid, HST(tid), lin); } HSYNC; FOR_T { pass_compute<8, NB8>(tid, HST(tid), 8, lout); } HSYNC;
            FOR_T { pass_load<8, NB8>(tid, HST(tid), lin); } HSYNC; FOR_T { pass_compute<8, NB8>(tid, HST(tid), 64, lout); } HSYNC;
            FOR_T { pass_load<R4, NB4>(tid, HST(tid), lin); HySt& s = HST(tid); float yr[16], yi[16];
                    pass_compute<R4, NB4>(tid, s, NS4, [&](int, int b, int rr, float r, float i) __attribute__((always_inline)) { if (rr < 8) { yr[b + 2 * rr] = r * (1.0f / FN); yi[b + 2 * rr] = -i * (1.0f / FN); } });
                    const bf16_t* g0 = p.UT + ((size_t)b0 * 3 * D_CH + (o + 1) * D_CH + c) * SEQ; const bf16_t* g1 = p.UT + ((size_t)b1 * 3 * D_CH + (o + 1) * D_CH + c) * SEQ;
                    unsigned gw0[8], gw1[8]; tm_load_bf16(g0, tid, gw0); tm_load_bf16(g1, tid, gw1);
                    if (o == 0) { unsigned w0[8], w1[8]; tm_load_bf16(u0, tid, w0); tm_load_bf16(u1, tid, w1);
                        float* zo0 = p.Z1 + ((size_t)b0 * D_CH + c) * SEQ + tid * 16; float* zo1 = p.Z1 + ((size_t)b1 * D_CH + c) * SEQ + tid * 16;
#pragma unroll
                        for (int m = 0; m < 16; ++m) { zo0[m] = tm_get(gw0, m) * (yr[m] + tm_get(w0, m) * hbias); zo1[m] = tm_get(gw1, m) * (yi[m] + tm_get(w1, m) * hbias); } }
                    else {
#pragma unroll
                        for (int m = 0; m < 16; ++m) { const float zn0 = tm_get(gw0, m) * (yr[m] + z0[tid * 16 + m] * hbias), zn1 = tm_get(gw1, m) * (yi[m] + z1[tid * 16 + m] * hbias);
                            HY_OUT(b0, tid + 256 * m, zn0); HY_OUT(b1, tid + 256 * m, zn1); } } }
            HSYNC;
        }
    }
    HY_FREE;
}
constexpr int MOD_ITEMS = DEPTH * (6 * D_MODEL / 64);
__device__ __forceinline__ void mod_item(const Params& p, char* lds, int item) {
    float* sc = (float*)lds;
    float* red = sc + 5 * D_MODEL;
    const int tid = threadIdx.x, l = item / (6 * D_MODEL / 64), j0 = (item % (6 * D_MODEL / 64)) * 64;
    for (int i = tid; i < 5 * D_MODEL; i += NTHREADS) { const int r = i / D_MODEL, k = i % D_MODEL; const float v = r < BATCH ? p.c[r * D_MODEL + k] : p.c_ctx[k]; sc[i] = silu_f(v); }
    __syncthreads();
    const int col = tid & 63, kp = tid >> 6;
    const float* w = p.w_ada + ((size_t)l * D_MODEL + kp * 256) * 6 * D_MODEL + j0 + col;
    float a0 = 0.f, a1 = 0.f, a2 = 0.f, a3 = 0.f, a4 = 0.f;
#pragma unroll 8
    for (int k = 0; k < 256; ++k) { const float wv = w[(size_t)k * 6 * D_MODEL]; const int kk = kp * 256 + k;
        a0 += sc[kk] * wv; a1 += sc[D_MODEL + kk] * wv; a2 += sc[2 * D_MODEL + kk] * wv; a3 += sc[3 * D_MODEL + kk] * wv; a4 += sc[4 * D_MODEL + kk] * wv; }
    red[(kp * 5 + 0) * 64 + col] = a0; red[(kp * 5 + 1) * 64 + col] = a1; red[(kp * 5 + 2) * 64 + col] = a2; red[(kp * 5 + 3) * 64 + col] = a3; red[(kp * 5 + 4) * 64 + col] = a4;
    __syncthreads();
    for (int i = tid; i < 5 * 64; i += NTHREADS) { const int r = i / 64, cc = i % 64;
        const float v = red[(0 * 5 + r) * 64 + cc] + red[(1 * 5 + r) * 64 + cc] + red[(2 * 5 + r) * 64 + cc] + red[(3 * 5 + r) * 64 + cc];
        p.mod[((size_t)(l * (BATCH + 1) + r)) * 6 * D_MODEL + j0 + cc] = v + p.b_ada[l * 6 * D_MODEL + j0 + cc]; }
    __syncthreads();
}
constexpr int FILT_ITEMS = (SEQ / 256) * (4 * D_CH / 64);
__device__ __forceinline__ void filt_item(const Params& p, char* lds, int item) {
    float* ws = (float*)lds;
    const int tid = threadIdx.x, tb = item % (SEQ / 256), cb = item / (SEQ / 256); const int t = tb * 256 + tid, col0 = cb * 64;
#pragma unroll
    for (int i = 0; i < 16; ++i) { const int k = i * 4 + (tid >> 6), cc = tid & 63; ws[cc * 68 + k] = p.hy_w3[(size_t)k * 4 * D_CH + col0 + cc]; }
    f32x4 h[16];
#pragma unroll
    for (int i = 0; i < 16; ++i) h[i] = *(const f32x4*)(p.h2 + (size_t)t * HY_FFN + i * 4);
    __syncthreads();
    const float tn = (float)t / (float)(SEQ - 1);
    const float mind = logf(1e-2f) / 1.5f, maxd = logf(1e-2f) / 0.3f;
#pragma unroll 2
    for (int cc = 0; cc < 64; ++cc) {
        const int col = col0 + cc; const f32x4* w = (const f32x4*)(ws + cc * 68);
        float acc = p.hy_b3[col];
#pragma unroll
        for (int i = 0; i < 16; ++i) { const f32x4 wv = w[i]; acc += h[i][0] * wv[0] + h[i][1] * wv[1] + h[i][2] * wv[2] + h[i][3] * wv[3]; }
        const float delta = fabsf(mind + (float)(col % D_CH) * (maxd - mind) / (float)(D_CH - 1));
        p.HFT[(size_t)col * SEQ + t] = acc * expf(-tn * delta);
    }
    __syncthreads();
}
__device__ __forceinline__ void ph_norm(const Params& p, int l, int which, int nrows, int bid, int nb) {
    const int lane = threadIdx.x & 63, wid = threadIdx.x >> 6;
    for (int row = bid * 4 + wid; row < nrows; row += nb * 4) {
        const float* xr = which == 0 ? xrow_in(p, l, row) : xrow_cur(p, row);
        const float* g = p.norm_g + (l * 2 + which) * D_MODEL; const float* sh = modp(p, l, row, which * 3 + 0); const float* sc = modp(p, l, row, which * 3 + 1);
        f32x4 v[4]; float ss = 0.f;
#pragma unroll
        for (int j = 0; j < 4; ++j) { v[j] = *(const f32x4*)(xr + j * 256 + lane * 4); ss += v[j][0] * v[j][0] + v[j][1] * v[j][1] + v[j][2] * v[j][2] + v[j][3] * v[j][3]; }
        const float rstd = 1.0f / sqrtf(wave_sum(ss) * (1.0f / D_MODEL) + EPS);
#pragma unroll
        for (int j = 0; j < 4; ++j) { const int c = j * 256 + lane * 4; const f32x4 o = v[j] * rstd * *(const f32x4*)(g + c) * (*(const f32x4*)(sc + c) + 1.0f) + *(const f32x4*)(sh + c);
            store4bf(p.hbuf + (size_t)row * D_MODEL + c, o); }
    }
}
__device__ __forceinline__ void ph_route_a(const Params& p, char* lds, int l, int nrows, int bid, int nb) {
    const int lane = threadIdx.x & 63, wid = threadIdx.x >> 6;
    float* wr_s = (float*)lds; int* hist = (int*)(lds + 65536);
    for (int i = threadIdx.x; i < D_MODEL * 4; i += NTHREADS) { const int k = i >> 2, ch = i & 3; ((f32x4*)wr_s)[k * 4 + (ch ^ ((k >> 2) & 3))] = ((const f32x4*)p.w_router)[i]; }
    if (threadIdx.x < 32) hist[threadIdx.x] = 0;
    __syncthreads();
    const int sw = (lane >> 2) & 3;
    const float* g = p.norm_g + (l * 2 + 1) * D_MODEL;
    const int RPB = (nrows + nb - 1) / nb, r0 = bid * RPB;
    for (int j = wid; j < RPB; j += 4) {
        const int row = r0 + j; if (row >= nrows) break;
        const float* xr = xrow_cur(p, row); const float* sh = modp(p, l, row, 3); const float* sc = modp(p, l, row, 4);
        float v[16]; float ss = 0.f;
#pragma unroll
        for (int i = 0; i < 16; ++i) { v[i] = xr[lane + 64 * i]; ss += v[i] * v[i]; }
        const float rstd = 1.0f / sqrtf(wave_sum(ss) * (1.0f / D_MODEL) + EPS);
        float lg[16];
#pragma unroll
        for (int e = 0; e < 16; ++e) lg[e] = 0.f;
#pragma unroll
        for (int i = 0; i < 16; ++i) { const int k = lane + 64 * i; const float o = v[i] * rstd * g[k] * (sc[k] + 1.0f) + sh[k];
            p.hbuf[(size_t)row * D_MODEL + k] = f2bf(o);
            const f32x4* w4 = (const f32x4*)(wr_s + k * 16);
#pragma unroll
            for (int e4 = 0; e4 < 4; ++e4) { const f32x4 wv = w4[e4 ^ sw]; lg[e4 * 4 + 0] += o * wv[0]; lg[e4 * 4 + 1] += o * wv[1]; lg[e4 * 4 + 2] += o * wv[2]; lg[e4 * 4 + 3] += o * wv[3]; }
            if (i & 1) __builtin_amdgcn_sched_barrier(0); }
#pragma unroll
        for (int e = 0; e < 16; ++e) lg[e] = wave_sum(lg[e]);
        if (lane == 0) {
            int gbest = 0, a = 0, bb = 1; float gbs = -1e30f, wa = 0.f, wb = 0.f;
#pragma unroll
            for (int gI = 0; gI < 4; ++gI) {
                float m1 = -1e30f, m2 = -1e30f, s1 = 0.f, s2 = 0.f; int i1 = 0, i2 = 0;
#pragma unroll
                for (int jj = 0; jj < 4; ++jj) { float sgv = sigmoid_f(lg[gI * 4 + jj]); float vv = sgv + p.b_router[gI * 4 + jj];
                    if (vv > m1) { m2 = m1; i2 = i1; s2 = s1; m1 = vv; i1 = jj; s1 = sgv; } else if (vv > m2) { m2 = vv; i2 = jj; s2 = sgv; } }
                float gs = m1 + m2;
                if (gs > gbs) { gbs = gs; gbest = gI; if (i1 < i2) { a = i1; bb = i2; wa = s1; wb = s2; } else { a = i2; bb = i1; wa = s2; wb = s1; } }
            }
            const float inv = 1.0f / (wa + wb);
            const int pidx = a == 0 ? bb - 1 : (a == 1 ? bb + 1 : 5);
            const int pr = gbest * 6 + pidx;
            p.rpair[row] = pr; p.tokw[row * 2 + 0] = wa * inv; p.tokw[row * 2 + 1] = wb * inv;
            atomicAdd(&hist[pr], 1);
        }
    }
    __syncthreads();
    if (threadIdx.x < 32) p.bh[bid * 32 + threadIdx.x] = hist[threadIdx.x];
}
__device__ __forceinline__ void ph_route_b(const Params& p, char* lds, int l, int nrows, int bid, int nb) {
    int* sb = (int*)lds;
    const int t = threadIdx.x, pr = t & 31, part = t >> 5;
    { int s_before = 0, s_all = 0; const int b0 = (part * nb) >> 3, b1 = ((part + 1) * nb) >> 3;
      for (int b = b0; b < b1; ++b) { const int c = p.bh[b * 32 + pr]; s_all += c; if (b < bid) s_before += c; }
      sb[part * 32 + pr] = s_before; sb[256 + part * 32 + pr] = s_all; }
    __syncthreads();
    if (t < 32) { int a = 0, c = 0;
#pragma unroll
        for (int q = 0; q < 8; ++q) { a += sb[q * 32 + t]; c += sb[256 + q * 32 + t]; }
        sb[512 + t] = a; sb[544 + t] = c; if (bid == 0) p.cnt[l * 32 + t] = c; }
    const int RPB = (nrows + nb - 1) / nb, row = bid * RPB + t; const bool act = t < RPB && row < nrows;
    int myp = 0; if (act) { myp = p.rpair[row]; sb[576 + t] = myp; }
    __syncthreads();
    if (act) { int rank = 0; for (int j = 0; j < t; ++j) rank += (sb[576 + j] == myp) ? 1 : 0; p.list[(size_t)myp * TT + sb[512 + myp] + rank] = row; }
    __syncthreads();
}
__device__ __forceinline__ void ph_final(const Params& p, int bid, int nb) {
    const int lane = threadIdx.x & 63, wid = threadIdx.x >> 6;
    for (int row = bid * 4 + wid; row < TX; row += nb * 4) {
        float* xr = p.out + (size_t)row * D_MODEL;
        f32x4 v[4]; float ss = 0.f;
#pragma unroll
        for (int j = 0; j < 4; ++j) { v[j] = *(const f32x4*)(xr + j * 256 + lane * 4); ss += v[j][0] * v[j][0] + v[j][1] * v[j][1] + v[j][2] * v[j][2] + v[j][3] * v[j][3]; }
        const float rstd = 1.0f / sqrtf(wave_sum(ss) * (1.0f / D_MODEL) + EPS);
#pragma unroll
        for (int j = 0; j < 4; ++j) { const int c = j * 256 + lane * 4; *(f32x4*)(xr + c) = v[j] * rstd * *(const f32x4*)(p.final_g + c); }
    }
}

#define XB_TMO      128
#define XB_XCNT(j)  (256  + 64 * (j))
#define XB_XSUB(j)  (1280 + 64 * (j))
#define XB_XGEN(j)  (2304 + 64 * (j))
#define XB_TOP      3328
#define XB_TOPGEN   3392
#define XCD_BAR_WORDS 3456
#define XB_SPIN_CAP (1u << 20)
__device__ __forceinline__ unsigned xb_ld(unsigned* p)              { return __hip_atomic_load(p, __ATOMIC_RELAXED, __HIP_MEMORY_SCOPE_AGENT); }
__device__ __forceinline__ unsigned xb_add(unsigned* p, unsigned v) { return __hip_atomic_fetch_add(p, v, __ATOMIC_RELAXED, __HIP_MEMORY_SCOPE_AGENT); }
__device__ __forceinline__ unsigned xb_xcc_id() { return (unsigned)__builtin_amdgcn_s_getreg((3 << 11) | 20) & 0xFu; }
#define XB_SPIN(cond, bar) do { unsigned _sp = 0; while (cond) { __builtin_amdgcn_s_sleep(1); \
    if ((++_sp & 255u) == 0u) { if (xb_ld(&(bar)[XB_TMO])) break; if (_sp > XB_SPIN_CAP) { atomicAdd(&(bar)[XB_TMO], 1u); break; } } } } while (0)
struct XcdBarrier { unsigned* bar; unsigned x; volatile LAS unsigned* st; };
__device__ __forceinline__ XcdBarrier xcd_barrier_post(unsigned* bar, volatile LAS unsigned* st) {
    XcdBarrier b; b.bar = bar; b.x = xb_xcc_id(); b.st = st;
    if (threadIdx.x == 0) (void)xb_add(&bar[XB_XCNT(b.x)], 1u);
    return b;
}
__device__ __forceinline__ void xcd_barrier_complete(unsigned* bar, unsigned x, unsigned& nloc, unsigned& nx) {
    const unsigned G = gridDim.x * gridDim.y * gridDim.z;
    unsigned sum, cnt, mine, sp = 0u;
    for (;;) {
        sum = 0u; cnt = 0u; mine = 0u;
#pragma unroll
        for (unsigned j = 0; j < 16; ++j) { const unsigned c = xb_ld(&bar[XB_XCNT(j)]); sum += c; cnt += (c > 0u) ? 1u : 0u; mine = (j == x) ? c : mine; }
        if (sum == G) break;
        __builtin_amdgcn_s_sleep(1);
        if ((++sp & 255u) == 0u) { if (xb_ld(&bar[XB_TMO])) break; if (sp > XB_SPIN_CAP) { atomicAdd(&bar[XB_TMO], 1u); break; } }
    }
    nloc = mine > 0u ? mine : 1u; nx = cnt > 0u ? cnt : 1u;
}
__device__ __forceinline__ void xcd_barrier(const XcdBarrier& b) {
    asm volatile("s_waitcnt vmcnt(0)" ::: "memory");
    __syncthreads();
    if (threadIdx.x == 0) {
        unsigned* bar = b.bar;
        __builtin_amdgcn_s_waitcnt(0);
        unsigned nloc = b.st[0], nx = b.st[1];
        if (nloc == 0u) { xcd_barrier_complete(bar, b.x, nloc, nx); b.st[0] = nloc; b.st[1] = nx; }
        const unsigned old = xb_add(&bar[XB_XSUB(b.x)], 1u);
        const unsigned gen = old / nloc;
        if (old + 1u == (gen + 1u) * nloc) {
            __builtin_amdgcn_fence(__ATOMIC_RELEASE, "agent");
            asm volatile("s_waitcnt vmcnt(0)" ::: "memory");
            const unsigned og = xb_add(&bar[XB_TOP], 1u);
            const unsigned tg = og / nx;
            if (og + 1u == (tg + 1u) * nx) xb_add(&bar[XB_TOPGEN], 1u);
            else XB_SPIN(xb_ld(&bar[XB_TOPGEN]) == tg, bar);
            __builtin_amdgcn_fence(__ATOMIC_ACQUIRE, "agent");
            xb_add(&bar[XB_XGEN(b.x)], 1u);
            asm volatile("s_waitcnt vmcnt(0)" ::: "memory");
        } else {
            XB_SPIN(xb_ld(&bar[XB_XGEN(b.x)]) == gen, bar);
            __builtin_amdgcn_fence(__ATOMIC_ACQUIRE, "agent");
            asm volatile("s_waitcnt vmcnt(0)" ::: "memory");
        }
    }
    __syncthreads();
}

__device__ __forceinline__ void ph_mix1(const Params& p, char* lds, int bid, int nb, unsigned long long* tsplit = nullptr) {
    const bool hy_first = bid >= (nb >> 1);
    for (int rep = 0; rep < 3; ++rep) {
        if (rep == 1) {
            for (int u = bid; u < NU_LAT; u += nb) { const int blk = u % (SEQ / 128), h = (u / (SEQ / 128)) % 8, b = u / (8 * (SEQ / 128)); const int s0 = blk * 128;
                attn_unit<0>(lds, p.QC + (size_t)(b * SEQ + s0) * 512 + h * 64, p.KC + (size_t)(b * 2 + h / 4) * LKV * 64, p.VCt + (size_t)(b * 2 + h / 4) * 64 * LKV,
                             p.Y + (size_t)(b * SEQ + s0) * 1024 + h * 64, s0, CTX_LEN / 64, 0, SEQ / 64, 0.f, false, nullptr); }
            if (tsplit) *tsplit = __builtin_amdgcn_s_memrealtime();
        } else if ((rep == 0) == hy_first) {
            __syncthreads();
            for (int c = hy_first ? bid - (nb >> 1) : bid + (nb >> 1); c < D_CH; c += nb) hyena_channel(p, c, (float*)lds);
            __syncthreads();
        }
    }
}
constexpr int TR_ITEMS = BATCH * (D_CH / 64) * (SEQ / 64);
__device__ __forceinline__ void tr_item(const Params& p, char* lds, int it) {
    bf16_t* T = (bf16_t*)lds; const int tid = threadIdx.x;
    const int sb = it % (SEQ / 64), cb = (it / (SEQ / 64)) % (D_CH / 64), b = it / ((SEQ / 64) * (D_CH / 64));
    { const int c = tid >> 2, q = tid & 3;
      const u32x4* src = (const u32x4*)(p.YHT + ((size_t)b * D_CH + cb * 64 + c) * SEQ + sb * 64 + q * 16);
      const u32x4 v0 = src[0], v1 = src[1]; unsigned* d = (unsigned*)(T + c * 66 + q * 16);
      d[0] = v0.x; d[1] = v0.y; d[2] = v0.z; d[3] = v0.w; d[4] = v1.x; d[5] = v1.y; d[6] = v1.z; d[7] = v1.w; }
    __syncthreads();
    { const int s = tid >> 2, q = tid & 3;
      unsigned w[8];
#pragma unroll
      for (int i = 0; i < 8; ++i) w[i] = (unsigned)T[(q * 16 + 2 * i) * 66 + s] | ((unsigned)T[(q * 16 + 2 * i + 1) * 66 + s] << 16);
      u32x4* dst = (u32x4*)(p.Y + ((size_t)b * SEQ + sb * 64 + s) * 1024 + 512 + cb * 64 + q * 16);
      dst[0] = (u32x4){w[0], w[1], w[2], w[3]}; dst[1] = (u32x4){w[4], w[5], w[6], w[7]}; }
    __syncthreads();
}
enum { PH_PREP = 0, PH_NORM0, PH_INPROJ0, PH_ATTN0, PH_OUT0, PH_ROUTE0, PH_ROUTEB0, PH_UP0, PH_DOWN0, PH_NORM1, PH_INPROJ1, PH_MIX1, PH_TR1, PH_OUT1, PH_ROUTE1, PH_ROUTEB1, PH_UP1, PH_DOWN1, PH_FINAL, PH_COUNT };
typedef const __attribute__((address_space(4))) Params* KParams;
__global__ void __launch_bounds__(NTHREADS, 2) mega(Params p_arg, int lo, int hi) {
    extern __shared__ __attribute__((aligned(16))) char lds[];
    const int bid = blockIdx.x, nb = gridDim.x;
    volatile LAS unsigned* st = (volatile LAS unsigned*)(lds + LDS_BYTES - 16);
    if (threadIdx.x < 4) st[threadIdx.x] = 0u;
    __syncthreads();
    KParams kp = (KParams)__builtin_amdgcn_kernarg_segment_ptr();
    XcdBarrier bar; bar.bar = kp->bar; bar.x = 0; bar.st = st;
    if (hi - lo > 1) bar = xcd_barrier_post(kp->bar, st);
#ifdef PROBE_PA
    unsigned long long ts_prev = __builtin_amdgcn_s_memrealtime(), t_a = 0, t_b = 0;
#define STAMP(PH) if (bid == 0 && threadIdx.x == 0) { const unsigned long long now_ = __builtin_amdgcn_s_memrealtime(); if ((PH) == PROBE_PA) t_a = now_ - ts_prev; if ((PH) == PROBE_PB) t_b = now_ - ts_prev; ts_prev = now_; }
#else
#define STAMP(PH)
#endif
#define PHASE(PH, body) if (lo <= (PH) && (PH) < hi) { { KParams kq_ = kp; asm volatile("" : "+s"(kq_)); const Params& p = *(const Params*)kq_; body; } if ((PH) + 1 < hi) xcd_barrier(bar); STAMP(PH) }
    PHASE(PH_PREP, { for (int it = bid; it < MOD_ITEMS; it += nb) mod_item(p, lds, it); cvt_range(p, lds, 0, CVT_EARLY, bid, nb); d_rope(p); d_hy_h1(p); })
#if PROBE == 7
    PHASE(PH_NORM0, { ph_norm(p, 0, 0, TT, bid, nb); ph_norm(p, 0, 0, TT, bid, nb); ph_norm(p, 0, 0, TT, bid, nb); d_hy_h2(p); })
#else
    PHASE(PH_NORM0, { ph_norm(p, 0, 0, TT, bid, nb); d_hy_h2(p); })
#endif
#if PROBE == 1
    PHASE(PH_INPROJ0, { ph_inproj<0>(p, lds, bid, nb); __syncthreads(); ph_inproj<0>(p, lds, bid, nb); for (int it = bid; it < FILT_ITEMS; it += nb) filt_item(p, lds, it); })
#else
    PHASE(PH_INPROJ0, { ph_inproj<0>(p, lds, bid, nb); for (int it = bid; it < FILT_ITEMS; it += nb) filt_item(p, lds, it); })
#endif
#if PROBE == 2
    PHASE(PH_ATTN0, { ph_attn0(p, lds, bid, nb); __syncthreads(); ph_attn0(p, lds, bid, nb); })
#else
    PHASE(PH_ATTN0, { if (bid & 1) { cvt_range(p, lds, CVT_EARLY, CVT_TOTAL, bid, nb); __syncthreads(); ph_attn0(p, lds, bid, nb); } else { ph_attn0(p, lds, bid, nb); __syncthreads(); cvt_range(p, lds, CVT_EARLY, CVT_TOTAL, bid, nb); } })
#endif
#if PROBE == 10
    PHASE(PH_OUT0, { ph_outproj<0>(p, lds, bid, nb); __syncthreads(); ph_outproj<0>(p, lds, bid, nb); })
#elif PROBE == 11
    PHASE(PH_OUT0, { for (int i_ = 0; i_ < 10; ++i_) xcd_barrier(bar); ph_outproj<0>(p, lds, bid, nb); })
#else
    PHASE(PH_OUT0, ph_outproj<0>(p, lds, bid, nb))
#endif
    PHASE(PH_ROUTE0, ph_route_a(p, lds, 0, TT, bid, nb))
    PHASE(PH_ROUTEB0, ph_route_b(p, lds, 0, TT, bid, nb))
#if PROBE == 9
    PHASE(PH_UP0, { ph_moe_up(p, lds, 0, bid, nb); __syncthreads(); ph_moe_up(p, lds, 0, bid, nb); })
#else
    PHASE(PH_UP0, ph_moe_up(p, lds, 0, bid, nb))
#endif
#if PROBE == 12
    PHASE(PH_DOWN0, { ph_moe_down<true>(p, lds, 0, bid, nb); __syncthreads(); ph_moe_down(p, lds, 0, bid, nb); })
#else
    PHASE(PH_DOWN0, ph_moe_down(p, lds, 0, bid, nb))
#endif
    PHASE(PH_NORM1, ph_norm(p, 1, 0, TT, bid, nb))
    PHASE(PH_INPROJ1, ph_inproj<1>(p, lds, bid, nb))
#if PROBE == 3
    PHASE(PH_MIX1, { ph_attnC(p, lds, bid, nb); __syncthreads(); ph_mix1(p, lds, bid, nb); })
#elif PROBE == 4
    PHASE(PH_MIX1, { for (int c = bid; c < D_CH; c += nb) hyena_channel(p, c, (float*)lds); __syncthreads(); ph_mix1(p, lds, bid, nb); })
#else
#if defined(PROBE_PA) && PROBE_PA == 100
    { unsigned long long tsp = 0, t0_ = __builtin_amdgcn_s_memrealtime(); ph_mix1(p, lds, bid, nb, &tsp); unsigned long long t1_ = __builtin_amdgcn_s_memrealtime(); if (bid == 0 && threadIdx.x == 0) { t_a = tsp - t0_; t_b = t1_ - tsp; } xcd_barrier(bar); }
#else
    PHASE(PH_MIX1, ph_mix1(p, lds, bid, nb))
#endif
#endif
    PHASE(PH_TR1, for (int it = bid; it < TR_ITEMS; it += nb) tr_item(p, lds, it))
    PHASE(PH_OUT1, ph_outproj<1>(p, lds, bid, nb))
    PHASE(PH_ROUTE1, ph_route_a(p, lds, 1, TX, bid, nb))
    PHASE(PH_ROUTEB1, ph_route_b(p, lds, 1, TX, bid, nb))
    PHASE(PH_UP1, ph_moe_up(p, lds, 1, bid, nb))
    PHASE(PH_DOWN1, ph_moe_down(p, lds, 1, bid, nb))
    PHASE(PH_FINAL, ph_final(p, bid, nb))
#ifdef PROBE_PA
    if (bid == 0 && threadIdx.x == 0) {
        const unsigned long long delay = 2 * t_a + 204800ull * ((t_b + 200) / 400); const unsigned long long t0 = __builtin_amdgcn_s_memrealtime();
        while (__builtin_amdgcn_s_memrealtime() - t0 < delay) __builtin_amdgcn_s_sleep(32);
    }
#endif
}
extern "C" void kernel_launch(void* const* d_in, const int* in_sizes, int n_in, void* d_out, int out_size, void* d_ws, size_t ws_size, hipStream_t stream) {
    static int grid = 0;
    if (grid == 0) {
        int dev = 0, cus = 0;
        if (hipGetDevice(&dev) != hipSuccess || hipDeviceGetAttribute(&cus, hipDeviceAttributeMultiprocessorCount, dev) != hipSuccess) { fprintf(stderr, "kernel_launch: device query failed\n"); grid = -1; return; }
        if (hipFuncSetAttribute((const void*)mega, hipFuncAttributeMaxDynamicSharedMemorySize, LDS_BYTES) != hipSuccess) { fprintf(stderr, "kernel_launch: hipFuncSetAttribute failed\n"); grid = -1; return; }
        grid = 2 * cus;
    }
    if (grid < 0) return;
    Params p{};
    size_t need = setup_ws(p, (char*)d_ws);
    if (n_in != 32 || need > ws_size || out_size != TX * D_MODEL) { fprintf(stderr, "kernel_launch: bad config n_in %d ws %zu need %zu out %d\n", n_in, ws_size, need, out_size); return; }
    fill_inputs(p, d_in, d_out);
    hipMemsetAsync(p.bar, 0, 64 * 1024 + 256, stream);
#ifdef PER_PHASE
    for (int ph = 0; ph < PH_COUNT; ++ph) mega<<<dim3(grid), dim3(NTHREADS), LDS_BYTES, stream>>>(p, ph, ph + 1);
#else
    mega<<<dim3(grid), dim3(NTHREADS), LDS_BYTES, stream>>>(p, 0, PH_COUNT);
#endif
}
```

```cpp
#include <hip/hip_runtime.h>
#include <cstdio>
#include <math.h>
#include <stdint.h>
#include <string.h>

#ifdef CPU_TEST
#define HD
#define GLOBAL
struct U3 { unsigned x, y, z; };
static thread_local U3 threadIdx, blockIdx, blockDim, gridDim;
static inline int atomicAdd(int* p, int v) { return __sync_fetch_and_add(p, v); }
#else
#define HD __device__ __forceinline__
#define GLOBAL __global__ __launch_bounds__(256)
#endif

#if defined(HY_TEST)
constexpr int D_MODEL = 64, BATCH = 2, SEQ = 4096, GRID_W = 64, CTX_LEN = 64, D_CH = 4, D_EXPERT = 64;
#elif defined(SMALL_CFG)
constexpr int D_MODEL = 128, BATCH = 2, SEQ = 512, GRID_W = 32, CTX_LEN = 64, D_CH = 32, D_EXPERT = 64;
#else
constexpr int D_MODEL = 1024, BATCH = 4, SEQ = 4096, GRID_W = 64, CTX_LEN = 256, D_CH = 512, D_EXPERT = 512;
#endif
constexpr int DEPTH = 2, HEAD_DIM = 64;
constexpr int GRID_H = SEQ / GRID_W;
constexpr int A_WINDOW = 128;
constexpr int B_WIN_H = 8, B_WIN_W = 16;
constexpr int HY_BANDS = 16, HY_EMB = 33, HY_FFN = 64;
constexpr int EVEN_IN = 2304, EVEN_OUT = 1024;
constexpr int ODD_IN = 768 + 3 * D_CH, ODD_OUT = 512 + D_CH;
constexpr int N_EXPERTS = 16;
constexpr int TX = BATCH * SEQ, TC = BATCH * CTX_LEN, TT = TX + TC;
constexpr int LKV = CTX_LEN + SEQ;
constexpr int NPAIR = 24;
constexpr int HE_W = 2 * D_EXPERT;
constexpr float EPS = 1e-6f;
constexpr float ATTN_SCALE = 0.125f;

typedef unsigned short bf16_t;
HD bf16_t f2bf(float f) { unsigned u; __builtin_memcpy(&u, &f, 4); u = (u + 0x7fffu + ((u >> 16) & 1u)) >> 16; return (bf16_t)u; }
HD float bf2f(bf16_t h) { unsigned u = ((unsigned)h) << 16; float f; __builtin_memcpy(&f, &u, 4); return f; }
HD float silu_f(float x) { return x / (1.0f + expf(-x)); }
HD float sigmoid_f(float x) { return 1.0f / (1.0f + expf(-x)); }

struct Params {
    const float *x, *c, *ctx, *c_ctx, *w_ada, *b_ada, *norm_g, *final_g, *w_in_even, *w_out_even, *a_sink, *b_rpb;
    const float *w_in_odd, *w_out_odd, *c_qnorm, *c_knorm, *hy_short_w, *hy_short_b, *hy_w1, *hy_b1, *hy_f1, *hy_w2;
    const float *hy_b2, *hy_f2, *hy_w3, *hy_b3, *hy_bias, *w_router, *b_router, *moe_wg, *moe_wu, *moe_wd;
    float* out;
    float* XC;
    float* mod;
    float* ropet;
    float* h1;
    float* h2;
    float* HFT;
    float* hnorm;
    bf16_t* hbuf;
    bf16_t *QA, *KA, *VAt, *QB, *KB, *VBt;
    bf16_t *QC, *KC, *VCt, *UT;
    bf16_t* Y;
    bf16_t* YHT;
    float* Z1;
    bf16_t* HE;
    int* cnt;
    int* list;
    float* tokw;
    bf16_t *Wt_in_even, *Wt_out_even, *Wt_in_odd, *Wt_out_odd, *Wt_gu, *Wt_d;
    unsigned* bar;
    int* rpair;
    int* bh;
    float* rlog;
};

#define GS_LOOP(i, n) for (long i = (long)blockIdx.x * blockDim.x + threadIdx.x; i < (long)(n); i += (long)gridDim.x * blockDim.x)

HD const float* xrow_in(const Params& p, int l, int row) {
    if (l == 0) return row < TX ? p.x + (size_t)row * D_MODEL : p.ctx + (size_t)(row - TX) * D_MODEL;
    return row < TX ? p.out + (size_t)row * D_MODEL : p.XC + (size_t)(row - TX) * D_MODEL;
}
HD float* xrow_cur(const Params& p, int row) { return row < TX ? p.out + (size_t)row * D_MODEL : p.XC + (size_t)(row - TX) * D_MODEL; }
HD int row_mod(int row) { return row < TX ? row / SEQ : BATCH; }
HD const float* modp(const Params& p, int l, int row, int which) { return p.mod + ((size_t)(l * (BATCH + 1) + row_mod(row)) * 6 + which) * D_MODEL; }

GLOBAL void nk_mod(Params p) {
    GS_LOOP(i, DEPTH * (BATCH + 1) * 6 * D_MODEL) {
        int j = i % (6 * D_MODEL); int r = (i / (6 * D_MODEL)) % (BATCH + 1); int l = i / (6 * D_MODEL * (BATCH + 1));
        const float* cv = r < BATCH ? p.c + r * D_MODEL : p.c_ctx;
        const float* w = p.w_ada + (size_t)l * D_MODEL * 6 * D_MODEL;
        float acc = 0.f;
        for (int k = 0; k < D_MODEL; ++k) acc += silu_f(cv[k]) * w[(size_t)k * 6 * D_MODEL + j];
        p.mod[i] = acc + p.b_ada[l * 6 * D_MODEL + j];
    }
}
HD void d_rope(const Params& p) {
    GS_LOOP(i, 64 * 16) {
        int pos = i / 16, k = i % 16;
        float inv = powf(10000.0f, -(float)(2 * k) / 32.0f);
        float a = (float)pos * inv;
        p.ropet[pos * 32 + k] = cosf(a); p.ropet[pos * 32 + 16 + k] = sinf(a);
    }
}
HD void d_hy_h1(const Params& p) {
    GS_LOOP(i, SEQ * HY_FFN) {
        int t = i / HY_FFN, k = i % HY_FFN;
        float tn = (float)t / (float)(SEQ - 1);
        float acc = tn * p.hy_w1[0 * HY_FFN + k];
        for (int b = 0; b < HY_BANDS; ++b) {
            float band = 1e-4f + (float)b * ((float)(HY_BANDS - 1) - 1e-4f) / (float)(HY_BANDS - 1);
            float ang = 2.0f * 3.14159265358979323846f * (float)t * band / (float)SEQ;
            acc += cosf(ang) * p.hy_w1[(1 + b) * HY_FFN + k] + sinf(ang) * p.hy_w1[(1 + HY_BANDS + b) * HY_FFN + k];
        }
        p.h1[i] = sinf(p.hy_f1[k] * (acc + p.hy_b1[k]));
    }
}
HD void d_hy_h2(const Params& p) {
    GS_LOOP(i, SEQ * HY_FFN) {
        int t = i / HY_FFN, j = i % HY_FFN;
        float acc = 0.f;
        for (int k = 0; k < HY_FFN; ++k) acc += p.h1[t * HY_FFN + k] * p.hy_w2[k * HY_FFN + j];
        p.h2[i] = sinf(p.hy_f2[j] * (acc + p.hy_b2[j]));
    }
}
HD float hy_decay(int t, int c) {
    const float mind = logf(1e-2f) / 1.5f, maxd = logf(1e-2f) / 0.3f;
    float delta = fabsf(mind + (float)c * (maxd - mind) / (float)(D_CH - 1));
    float tn = (float)t / (float)(SEQ - 1);
    return expf(-tn * delta);
}
GLOBAL void nk_hy_filt(Params p) {
    GS_LOOP(i, 4 * D_CH * SEQ) {
        int t = i % SEQ, col = i / SEQ, c = col % D_CH;
        float acc = p.hy_b3[col];
        for (int k = 0; k < HY_FFN; ++k) acc += p.h2[t * HY_FFN + k] * p.hy_w3[k * 4 * D_CH + col];
        p.HFT[i] = acc * hy_decay(t, c);
    }
}
GLOBAL void nk_hy_norm(Params p) {
    GS_LOOP(i, 2 * D_CH) {
        int o = i / D_CH, c = i % D_CH;
        float s = 0.f;
        for (int dir = 0; dir < 2; ++dir) { const float* h = p.HFT + (size_t)((dir * 2 + o) * D_CH + c) * SEQ; for (int t = 0; t < SEQ; ++t) s += fabsf(h[t]); }
        p.hnorm[i] = s + EPS;
    }
}
GLOBAL void nk_zero_cnt(Params p) { GS_LOOP(i, 64) p.cnt[i] = 0; }

GLOBAL void nk_norm(Params p, int l, int which, int nrows) {
    GS_LOOP(row, nrows) {
        const float* xr = which == 0 ? xrow_in(p, l, (int)row) : xrow_cur(p, (int)row);
        float ss = 0.f;
        for (int k = 0; k < D_MODEL; ++k) ss += xr[k] * xr[k];
        float rstd = 1.0f / sqrtf(ss / D_MODEL + EPS);
        const float* g = p.norm_g + (l * 2 + which) * D_MODEL;
        const float* sh = modp(p, l, (int)row, which * 3 + 0); const float* sc = modp(p, l, (int)row, which * 3 + 1);
        for (int k = 0; k < D_MODEL; ++k) p.hbuf[row * D_MODEL + k] = f2bf(xr[k] * rstd * g[k] * (1.0f + sc[k]) + sh[k]);
    }
}

HD float dot_row(const bf16_t* a, const float* W, int ldw, int col, int K) {
    float acc = 0.f;
    for (int k = 0; k < K; ++k) acc += bf2f(a[k]) * W[(size_t)k * ldw + col];
    return acc;
}
HD float rope_apply(const Params& p, float v, float partner, int d, int s) {
    int half = d >> 5, dd = d & 31, k = dd & 15;
    int pos = half == 0 ? s / GRID_W : s % GRID_W;
    float c = p.ropet[pos * 32 + k], sn = p.ropet[pos * 32 + 16 + k];
    return dd < 16 ? v * c - partner * sn : v * c + partner * sn;
}

GLOBAL void nk_inproj_even(Params p) {
    GS_LOOP(i, (long)TT * EVEN_IN) {
        int row = i / EVEN_IN, col = i % EVEN_IN;
        const bf16_t* a = p.hbuf + (size_t)row * D_MODEL;
        float v = dot_row(a, p.w_in_even, EVEN_IN, col, D_MODEL);
        bool lat = row < TX; int b = lat ? row / SEQ : (row - TX) / CTX_LEN; int s = lat ? row % SEQ : (row - TX) % CTX_LEN;
        int pos = lat ? CTX_LEN + s : s;
        if (col < 640) {
            int d = col & 63;
            if (lat) { int pc = (d & 31) < 16 ? col + 16 : col - 16; float pv = dot_row(a, p.w_in_even, EVEN_IN, pc, D_MODEL); v = rope_apply(p, v, pv, d, s); }
            if (col < 512) p.QA[(size_t)row * 512 + col] = f2bf(v);
            else { int h = (col - 512) >> 6; p.KA[((size_t)(b * 2 + h) * LKV + pos) * 64 + d] = f2bf(v); }
        } else if (col < 768) { int h = (col - 640) >> 6, d = col & 63; p.VAt[((size_t)(b * 2 + h) * 64 + d) * LKV + pos] = f2bf(v); }
        else if (col < 1280) p.QB[(size_t)row * 512 + (col - 768)] = f2bf(v);
        else if (col < 1792) { int h = (col - 1280) >> 6, d = col & 63; p.KB[((size_t)(b * 8 + h) * LKV + pos) * 64 + d] = f2bf(v); }
        else { int h = (col - 1792) >> 6, d = col & 63; p.VBt[((size_t)(b * 8 + h) * 64 + d) * LKV + pos] = f2bf(v); }
    }
}

struct OSM { float m, l; };
#define ATT_BEGIN() float q[64], acc[64]; for (int d = 0; d < 64; ++d) { q[d] = bf2f(qp[d]) * ATTN_SCALE; acc[d] = 0.f; } float m_ = -1e30f, l_ = 0.f;
#define ATT_KEY(Kp, Vt, key, bias) do { const bf16_t* kk_ = (Kp) + (size_t)(key) * 64; float s_ = (bias); for (int d = 0; d < 64; ++d) s_ += q[d] * bf2f(kk_[d]); \
    float mn_ = fmaxf(m_, s_); float f_ = expf(m_ - mn_), pe_ = expf(s_ - mn_); l_ = l_ * f_ + pe_; \
    for (int d = 0; d < 64; ++d) acc[d] = acc[d] * f_ + pe_ * bf2f((Vt)[(size_t)d * LKV + (key)]); m_ = mn_; } while (0)
#define ATT_SINK(sv) do { float s_ = (sv); float mn_ = fmaxf(m_, s_); float f_ = expf(m_ - mn_); l_ = l_ * f_ + expf(s_ - mn_); for (int d = 0; d < 64; ++d) acc[d] *= f_; m_ = mn_; } while (0)

GLOBAL void nk_attnA(Params p) {
    GS_LOOP(i, (long)TX * 8) {
        int h = i % 8, row = i / 8, b = row / SEQ, s = row % SEQ, kvh = h / 4;
        const bf16_t* qp = p.QA + (size_t)row * 512 + h * 64;
        const bf16_t* Kp = p.KA + (size_t)(b * 2 + kvh) * LKV * 64; const bf16_t* Vt = p.VAt + (size_t)(b * 2 + kvh) * 64 * LKV;
        ATT_BEGIN();
        for (int j = 0; j < CTX_LEN; ++j) ATT_KEY(Kp, Vt, j, 0.f);
        int lo = s - A_WINDOW < 0 ? 0 : s - A_WINDOW, hi = s + A_WINDOW > SEQ - 1 ? SEQ - 1 : s + A_WINDOW;
        for (int j = lo; j <= hi; ++j) ATT_KEY(Kp, Vt, CTX_LEN + j, 0.f);
        ATT_SINK(p.a_sink[h]);
        for (int d = 0; d < 64; ++d) p.Y[(size_t)row * 1024 + h * 64 + d] = f2bf(acc[d] / l_);
    }
}
GLOBAL void nk_attnB(Params p) {
    GS_LOOP(i, (long)TX * 8) {
        int h = i % 8, row = i / 8, b = row / SEQ, s = row % SEQ, r = s / GRID_W, cq = s % GRID_W;
        const bf16_t* qp = p.QB + (size_t)row * 512 + h * 64;
        const bf16_t* Kp = p.KB + (size_t)(b * 8 + h) * LKV * 64; const bf16_t* Vt = p.VBt + (size_t)(b * 8 + h) * 64 * LKV;
        ATT_BEGIN();
        for (int j = 0; j < CTX_LEN; ++j) ATT_KEY(Kp, Vt, j, 0.f);
        int kh = B_WIN_H < GRID_H ? B_WIN_H : GRID_H;
        int rs = r - kh / 2; if (rs < 0) rs = 0; if (rs > GRID_H - kh) rs = GRID_H - kh;
        int cs = cq - B_WIN_W / 2; if (cs < 0) cs = 0; if (cs > GRID_W - B_WIN_W) cs = GRID_W - B_WIN_W;
        for (int kr = rs; kr < rs + kh; ++kr)
            for (int kc = cs; kc < cs + B_WIN_W; ++kc) {
                int dr = kr - r, dc = kc - cq;
                float bias = p.b_rpb[(h * (2 * B_WIN_H - 1) + dr + B_WIN_H - 1) * (2 * B_WIN_W - 1) + dc + B_WIN_W - 1];
                ATT_KEY(Kp, Vt, CTX_LEN + kr * GRID_W + kc, bias);
            }
        for (int d = 0; d < 64; ++d) p.Y[(size_t)row * 1024 + 512 + h * 64 + d] = f2bf(acc[d] / l_);
    }
}
GLOBAL void nk_attn_ctx(Params p) {
    GS_LOOP(i, (long)TC * 16) {
        int hh = i % 16, rc = i / 16, ty = hh / 8, h = hh % 8, b = rc / CTX_LEN; int row = TX + rc;
        const bf16_t* qp = (ty == 0 ? p.QA : p.QB) + (size_t)row * 512 + h * 64;
        const bf16_t* Kp = ty == 0 ? p.KA + (size_t)(b * 2 + h / 4) * LKV * 64 : p.KB + (size_t)(b * 8 + h) * LKV * 64;
        const bf16_t* Vt = ty == 0 ? p.VAt + (size_t)(b * 2 + h / 4) * 64 * LKV : p.VBt + (size_t)(b * 8 + h) * 64 * LKV;
        ATT_BEGIN();
        for (int j = 0; j < CTX_LEN; ++j) ATT_KEY(Kp, Vt, j, 0.f);
        if (ty == 0) ATT_SINK(p.a_sink[h]);
        for (int d = 0; d < 64; ++d) p.Y[(size_t)row * 1024 + ty * 512 + h * 64 + d] = f2bf(acc[d] / l_);
    }
}
GLOBAL void nk_attnC(Params p) {
    GS_LOOP(i, (long)TX * 8) {
        int h = i % 8, row = i / 8, b = row / SEQ, kvh = h / 4;
        const bf16_t* qp = p.QC + (size_t)row * 512 + h * 64;
        const bf16_t* Kp = p.KC + (size_t)(b * 2 + kvh) * LKV * 64; const bf16_t* Vt = p.VCt + (size_t)(b * 2 + kvh) * 64 * LKV;
        ATT_BEGIN();
        for (int j = 0; j < LKV; ++j) ATT_KEY(Kp, Vt, j, 0.f);
        for (int d = 0; d < 64; ++d) p.Y[(size_t)row * 1024 + h * 64 + d] = f2bf(acc[d] / l_);
    }
}

GLOBAL void nk_outproj_even(Params p) {
    GS_LOOP(i, (long)TT * D_MODEL) {
        int row = i / D_MODEL, col = i % D_MODEL;
        float acc = dot_row(p.Y + (size_t)row * 1024, p.w_out_even, D_MODEL, col, EVEN_OUT);
        xrow_cur(p, row)[col] = xrow_in(p, 0, row)[col] + modp(p, 0, row, 2)[col] * acc;
    }
}
GLOBAL void nk_outproj_odd(Params p) {
    GS_LOOP(i, (long)TX * D_MODEL) {
        int row = i / D_MODEL, col = i % D_MODEL, b = row / SEQ, s = row % SEQ;
        float acc = dot_row(p.Y + (size_t)row * 1024, p.w_out_odd, D_MODEL, col, 512);
        for (int c = 0; c < D_CH; ++c) acc += bf2f(p.YHT[((size_t)b * D_CH + c) * SEQ + s]) * p.w_out_odd[(size_t)(512 + c) * D_MODEL + col];
        p.out[i] = p.out[i] + modp(p, 1, row, 2)[col] * acc;
    }
}

GLOBAL void nk_router(Params p, int l, int nrows) {
    GS_LOOP(row, nrows) {
        const float* xr = xrow_cur(p, (int)row);
        float ss = 0.f;
        for (int k = 0; k < D_MODEL; ++k) ss += xr[k] * xr[k];
        float rstd = 1.0f / sqrtf(ss / D_MODEL + EPS);
        const float* g = p.norm_g + (l * 2 + 1) * D_MODEL; const float* sh = modp(p, l, (int)row, 3); const float* sc = modp(p, l, (int)row, 4);
        float lg[16];
#pragma unroll
        for (int e = 0; e < 16; ++e) lg[e] = 0.f;
        for (int k = 0; k < D_MODEL; ++k) { float hv = xr[k] * rstd * g[k] * (1.0f + sc[k]) + sh[k];
#pragma unroll
            for (int e = 0; e < 16; ++e) lg[e] += hv * p.w_router[k * 16 + e]; }
        int gbest = 0, a = 0, bb = 1; float gbs = -1e30f, wa = 0.f, wb = 0.f;
#pragma unroll
        for (int gI = 0; gI < 4; ++gI) {
            float m1 = -1e30f, m2 = -1e30f, s1 = 0.f, s2 = 0.f; int i1 = 0, i2 = 0;
#pragma unroll
            for (int j = 0; j < 4; ++j) { float sgv = sigmoid_f(lg[gI * 4 + j]); float v = sgv + p.b_router[gI * 4 + j];
                if (v > m1) { m2 = m1; i2 = i1; s2 = s1; m1 = v; i1 = j; s1 = sgv; } else if (v > m2) { m2 = v; i2 = j; s2 = sgv; } }
            float gs = m1 + m2;
            if (gs > gbs) { gbs = gs; gbest = gI; if (i1 < i2) { a = i1; bb = i2; wa = s1; wb = s2; } else { a = i2; bb = i1; wa = s2; wb = s1; } }
        }
        float inv = 1.0f / (wa + wb);
        int pidx = a == 0 ? bb - 1 : (a == 1 ? bb + 1 : 5);
        int pr = gbest * 6 + pidx;
        int pos = atomicAdd(p.cnt + l * 32 + pr, 1);
        p.list[(size_t)pr * TT + pos] = (int)row;
        p.tokw[row * 2 + 0] = wa * inv; p.tokw[row * 2 + 1] = wb * inv;
    }
}
HD void pair_experts(int pr, int& e1, int& e2) { int g = pr / 6, q = pr % 6; int a = q < 3 ? 0 : (q < 5 ? 1 : 2); int b = q < 3 ? q + 1 : (q < 5 ? q - 1 : 3); e1 = g * 4 + a; e2 = g * 4 + b; }
HD bool slot_lookup(const Params& p, int l, int slot, int& pr, int& row) { int acc = 0; for (int q = 0; q < NPAIR; ++q) { int c = p.cnt[l * 32 + q]; if (slot < acc + c) { pr = q; row = p.list[(size_t)q * TT + (slot - acc)]; return true; } acc += c; } return false; }
GLOBAL void nk_moe_up(Params p, int l, int nrows) {
    GS_LOOP(i, (long)nrows * HE_W) {
        int slot = i / HE_W, j = i % HE_W, k = j / D_EXPERT, jj = j % D_EXPERT; int pr, row; if (!slot_lookup(p, l, slot, pr, row)) continue;
        int e1, e2; pair_experts(pr, e1, e2); int e = k == 0 ? e1 : e2;
        const bf16_t* a = p.hbuf + (size_t)row * D_MODEL;
        const float* wg = p.moe_wg + (size_t)(l * N_EXPERTS + e) * D_MODEL * D_EXPERT; const float* wu = p.moe_wu + (size_t)(l * N_EXPERTS + e) * D_MODEL * D_EXPERT;
        float g = dot_row(a, wg, D_EXPERT, jj, D_MODEL), u = dot_row(a, wu, D_EXPERT, jj, D_MODEL);
        p.HE[(size_t)row * HE_W + j] = f2bf(p.tokw[row * 2 + k] * silu_f(g) * u);
    }
}
GLOBAL void nk_moe_down(Params p, int l, int nrows) {
    GS_LOOP(i, (long)nrows * D_MODEL) {
        int slot = i / D_MODEL, col = i % D_MODEL; int pr, row; if (!slot_lookup(p, l, slot, pr, row)) continue;
        int e1, e2; pair_experts(pr, e1, e2);
        const bf16_t* a = p.HE + (size_t)row * HE_W;
        float acc = dot_row(a, p.moe_wd + (size_t)(l * N_EXPERTS + e1) * D_EXPERT * D_MODEL, D_MODEL, col, D_EXPERT)
                  + dot_row(a + D_EXPERT, p.moe_wd + (size_t)(l * N_EXPERTS + e2) * D_EXPERT * D_MODEL, D_MODEL, col, D_EXPERT);
        float* xr = xrow_cur(p, row);
        xr[col] = xr[col] + modp(p, l, row, 5)[col] * acc;
    }
}

GLOBAL void nk_inproj_odd_qk(Params p) {
    GS_LOOP(i, (long)TT * 10) {
        int row = i / 10, hu = i % 10; const bf16_t* a = p.hbuf + (size_t)row * D_MODEL;
        bool lat = row < TX; int b = lat ? row / SEQ : (row - TX) / CTX_LEN; int s = lat ? row % SEQ : (row - TX) % CTX_LEN; int pos = lat ? CTX_LEN + s : s;
        int col0 = hu * 64;
        float v[64]; float ss = 0.f;
        for (int d = 0; d < 64; ++d) { v[d] = dot_row(a, p.w_in_odd, ODD_IN, col0 + d, D_MODEL); ss += v[d] * v[d]; }
        float rstd = 1.0f / sqrtf(ss / 64.0f + EPS);
        const float* gn = hu < 8 ? p.c_qnorm : p.c_knorm;
        for (int d = 0; d < 64; ++d) v[d] = v[d] * rstd * gn[d];
        for (int d = 0; d < 64; ++d) {
            float o = v[d];
            if (lat) { int pd = (d & 31) < 16 ? d + 16 : d - 16; o = rope_apply(p, v[d], v[pd], d, s); }
            if (hu < 8) p.QC[(size_t)row * 512 + col0 + d] = f2bf(o);
            else p.KC[((size_t)(b * 2 + (hu - 8)) * LKV + pos) * 64 + d] = f2bf(o);
        }
    }
}
GLOBAL void nk_inproj_odd_vu(Params p) {
    GS_LOOP(i, (long)TT * (ODD_IN - 640)) {
        int row = i / (ODD_IN - 640), col = 640 + i % (ODD_IN - 640); const bf16_t* a = p.hbuf + (size_t)row * D_MODEL;
        bool lat = row < TX; int b = lat ? row / SEQ : (row - TX) / CTX_LEN; int s = lat ? row % SEQ : (row - TX) % CTX_LEN; int pos = lat ? CTX_LEN + s : s;
        if (col >= 768 && !lat) continue;
        float v = dot_row(a, p.w_in_odd, ODD_IN, col, D_MODEL);
        if (col < 768) { int h = (col - 640) >> 6, d = col & 63; p.VCt[((size_t)(b * 2 + h) * 64 + d) * LKV + pos] = f2bf(v); }
        else p.UT[((size_t)b * 3 * D_CH + (col - 768)) * SEQ + s] = f2bf(v);
    }
}

HD float hy_sc(const Params& p, int b, int ch, int t) {
    const bf16_t* u = p.UT + ((size_t)b * 3 * D_CH + ch) * SEQ;
    float acc = p.hy_short_b[ch];
    for (int kk = 0; kk < 3; ++kk) { int tt = t + kk - 1; if (tt >= 0 && tt < SEQ) acc += p.hy_short_w[kk * 3 * D_CH + ch] * bf2f(u[tt]); }
    return acc;
}
GLOBAL void nk_hy_conv(Params p, int o) {
    GS_LOOP(i, (long)BATCH * D_CH * SEQ) {
        int n = i % SEQ, c = (i / SEQ) % D_CH, b = i / ((long)SEQ * D_CH);
        const float* hf = p.HFT + (size_t)((0 * 2 + o) * D_CH + c) * SEQ; const float* hb = p.HFT + (size_t)((1 * 2 + o) * D_CH + c) * SEQ;
        float inv = 1.0f / p.hnorm[o * D_CH + c];
        float acc = 0.f;
        for (int m = 0; m < SEQ; ++m) {
            float z = o == 0 ? hy_sc(p, b, c, m) : p.Z1[((size_t)b * D_CH + c) * SEQ + m];
            int d = n - m; float hv = d >= 0 ? hf[d] : hb[-d];
            acc += hv * z;
        }
        acc *= inv;
        float zn = o == 0 ? hy_sc(p, b, c, n) : p.Z1[((size_t)b * D_CH + c) * SEQ + n];
        float g = hy_sc(p, b, (o + 1) * D_CH + c, n);
        float r = g * (acc + zn * p.hy_bias[o * D_CH + c]);
        if (o == 0) p.Z1[i] = r; else p.YHT[i] = f2bf(r);
    }
}

GLOBAL void nk_final(Params p) {
    GS_LOOP(row, TX) {
        float* xr = p.out + (size_t)row * D_MODEL; float ss = 0.f;
        for (int k = 0; k < D_MODEL; ++k) ss += xr[k] * xr[k];
        float rstd = 1.0f / sqrtf(ss / D_MODEL + EPS);
        for (int k = 0; k < D_MODEL; ++k) xr[k] = xr[k] * rstd * p.final_g[k];
    }
}
GLOBAL void nk_yht_to_y(Params p) {
    GS_LOOP(i, (long)TX * D_CH) { int row = i / D_CH, c = i % D_CH, b = row / SEQ, s = row % SEQ; p.Y[(size_t)row * 1024 + 512 + c] = p.YHT[((size_t)b * D_CH + c) * SEQ + s]; }
}

GLOBAL void nk_rope(Params p) { d_rope(p); }
GLOBAL void nk_hy_h1(Params p) { d_hy_h1(p); }
GLOBAL void nk_hy_h2(Params p) { d_hy_h2(p); }
static inline size_t al256(size_t x) { return (x + 255) & ~(size_t)255; }
static size_t setup_ws(Params& p, char* ws) {
    size_t o = 0;
    auto take = [&](size_t bytes) { char* r = ws + o; o += al256(bytes); return r; };
    p.bar = (unsigned*)take(64 * 1024);
    p.cnt = (int*)take(256);
    p.XC = (float*)take((size_t)TC * D_MODEL * 4);
    p.mod = (float*)take((size_t)DEPTH * (BATCH + 1) * 6 * D_MODEL * 4);
    p.ropet = (float*)take(64 * 32 * 4);
    p.h1 = (float*)take((size_t)SEQ * 64 * 4);
    p.h2 = (float*)take((size_t)SEQ * 64 * 4);
    p.HFT = (float*)take((size_t)4 * D_CH * SEQ * 4);
    p.hnorm = (float*)take(2 * D_CH * 4);
    p.list = (int*)take((size_t)NPAIR * TT * 4);
    p.tokw = (float*)take((size_t)TT * 2 * 4);
    p.rpair = (int*)take((size_t)TT * 4);
    p.bh = (int*)take((size_t)2048 * 32 * 4);
    p.rlog = (float*)take((size_t)TT * 16 * 4);
    size_t hb = (size_t)TT * D_MODEL * 2, z1 = (size_t)BATCH * D_CH * SEQ * 4;
    char* r0 = take(hb > z1 ? hb : z1); p.hbuf = (bf16_t*)r0; p.Z1 = (float*)r0;
    size_t q = al256((size_t)TT * 512 * 2), kva = al256((size_t)BATCH * 2 * LKV * 64 * 2), kvb = al256((size_t)BATCH * 8 * LKV * 64 * 2), ut = al256((size_t)BATCH * 3 * D_CH * SEQ * 2);
    size_t l0 = 2 * q + 2 * kva + 2 * kvb, l1 = q + 2 * kva + ut;
    char* R = take(l0 > l1 ? l0 : l1);
    p.QA = (bf16_t*)R; p.KA = (bf16_t*)(R + q); p.VAt = (bf16_t*)(R + q + kva); p.QB = (bf16_t*)(R + q + 2 * kva); p.KB = (bf16_t*)(R + 2 * q + 2 * kva); p.VBt = (bf16_t*)(R + 2 * q + 2 * kva + kvb);
    p.QC = (bf16_t*)R; p.KC = (bf16_t*)(R + q); p.VCt = (bf16_t*)(R + q + kva); p.UT = (bf16_t*)(R + q + 2 * kva);
    size_t yb = (size_t)TT * 1024 * 2, heb = (size_t)TT * HE_W * 2;
    char* r1 = take(yb > heb ? yb : heb); p.Y = (bf16_t*)r1; p.HE = (bf16_t*)r1;
    p.YHT = (bf16_t*)take((size_t)BATCH * D_CH * SEQ * 2);
    p.Wt_in_even = (bf16_t*)take((size_t)EVEN_IN * D_MODEL * 2);
    p.Wt_out_even = (bf16_t*)take((size_t)D_MODEL * EVEN_OUT * 2);
    p.Wt_in_odd = (bf16_t*)take((size_t)ODD_IN * D_MODEL * 2);
    p.Wt_out_odd = (bf16_t*)take((size_t)D_MODEL * ODD_OUT * 2);
    p.Wt_gu = (bf16_t*)take((size_t)DEPTH * N_EXPERTS * 2 * D_EXPERT * D_MODEL * 2);
    p.Wt_d = (bf16_t*)take((size_t)DEPTH * N_EXPERTS * D_MODEL * D_EXPERT * 2);
    return o;
}
static void fill_inputs(Params& p, void* const* d_in, void* d_out) {
    const float** f = (const float**)&p.x;
    for (int i = 0; i < 32; ++i) f[i] = (const float*)d_in[i];
    p.out = (float*)d_out;
}
#define LAS __attribute__((address_space(3)))
typedef short bf16x8 __attribute__((ext_vector_type(8)));
typedef float f32x4 __attribute__((ext_vector_type(4)));
typedef float f32x16 __attribute__((ext_vector_type(16)));
typedef unsigned u32x4 __attribute__((ext_vector_type(4)));
typedef unsigned u32x2 __attribute__((ext_vector_type(2)));

constexpr int NTHREADS = 256;
constexpr int LDS_BYTES = 69632;
constexpr int MT_ALL = TT / 128, MT_LAT = TX / 128;

__device__ __forceinline__ unsigned pk2bf(float lo, float hi) { return (unsigned)f2bf(lo) | ((unsigned)f2bf(hi) << 16); }
__device__ __forceinline__ float wave_sum(float v) {
#pragma unroll
    for (int o = 1; o < 64; o <<= 1) v += __shfl_xor(v, o);
    return v;
}

template <class DstF>
__device__ __forceinline__ void cvt_block_item(char* lds, const float* W, int N, int k0, int n0, const DstF& dst) {
    float* T = (float*)lds; const int tid = threadIdx.x;
    f32x4 v[16];
#pragma unroll
    for (int i = 0; i < 16; ++i) v[i] = *(const f32x4*)(W + (size_t)(k0 + (tid >> 6) + 4 * i) * N + n0 + 4 * (tid & 63));
#pragma unroll
    for (int i = 0; i < 16; ++i) *(f32x4*)(T + ((tid >> 6) + 4 * i) * 260 + 4 * (tid & 63)) = v[i];
    __syncthreads();
    bf16_t* d = dst(n0 + tid) + k0; const float* s = T + tid;
#pragma unroll
    for (int c = 0; c < 8; ++c) { u32x4 w; w.x = pk2bf(s[(8 * c + 0) * 260], s[(8 * c + 1) * 260]); w.y = pk2bf(s[(8 * c + 2) * 260], s[(8 * c + 3) * 260]);
        w.z = pk2bf(s[(8 * c + 4) * 260], s[(8 * c + 5) * 260]); w.w = pk2bf(s[(8 * c + 6) * 260], s[(8 * c + 7) * 260]); *(u32x4*)(d + 8 * c) = w; }
    __syncthreads();
}
__device__ __forceinline__ void cvt_plain(char* lds, const float* W, bf16_t* Wt, int K, int N, int item) {
    const int nb = N / 256, kb = item / nb, nbi = item % nb;
    cvt_block_item(lds, W, N, kb * 64, nbi * 256, [&](int n) { return Wt + (size_t)n * K; });
}
constexpr int CVT_IN = (D_MODEL / 64) * (EVEN_IN / 256), CVT_OUT = (D_MODEL / 64) * (D_MODEL / 256), CVT_GU1 = (D_MODEL / 64) * (D_EXPERT / 256), CVT_D1 = (D_EXPERT / 64) * (D_MODEL / 256);
constexpr int CVT_GU = DEPTH * N_EXPERTS * 2 * CVT_GU1, CVT_D = DEPTH * N_EXPERTS * CVT_D1;
constexpr int CVT_TOTAL = 2 * CVT_IN + 2 * CVT_OUT + CVT_GU + CVT_D;
constexpr int CVT_EARLY = 2 * CVT_IN + 2 * CVT_OUT;
static_assert(EVEN_IN % 256 == 0 && ODD_IN % 256 == 0 && D_EXPERT % 256 == 0, "conversion tile");
__device__ __forceinline__ void cvt_item(const Params& p, char* lds, int it) {
    if (it < CVT_IN) { cvt_plain(lds, p.w_in_even, p.Wt_in_even, D_MODEL, EVEN_IN, it); return; } it -= CVT_IN;
    if (it < CVT_IN) { cvt_plain(lds, p.w_in_odd, p.Wt_in_odd, D_MODEL, ODD_IN, it); return; } it -= CVT_IN;
    if (it < CVT_OUT) { cvt_plain(lds, p.w_out_even, p.Wt_out_even, EVEN_OUT, D_MODEL, it); return; } it -= CVT_OUT;
    if (it < CVT_OUT) { cvt_plain(lds, p.w_out_odd, p.Wt_out_odd, ODD_OUT, D_MODEL, it); return; } it -= CVT_OUT;
    if (it < CVT_GU) {
        const int le = it / (2 * CVT_GU1), r = it % (2 * CVT_GU1), half = r / CVT_GU1, r2 = r % CVT_GU1; const int nb = D_EXPERT / 256, kb = r2 / nb, nbi = r2 % nb;
        const float* W = (half ? p.moe_wu : p.moe_wg) + (size_t)le * D_MODEL * D_EXPERT; bf16_t* Wt = p.Wt_gu + (size_t)le * 2 * D_EXPERT * D_MODEL;
        cvt_block_item(lds, W, D_EXPERT, kb * 64, nbi * 256, [&](int n) { return Wt + (size_t)(32 * (n >> 4) + 16 * half + (n & 15)) * D_MODEL; });
        return; } it -= CVT_GU;
    { const int le = it / CVT_D1, r = it % CVT_D1; cvt_plain(lds, p.moe_wd + (size_t)le * D_EXPERT * D_MODEL, p.Wt_d + (size_t)le * D_MODEL * D_EXPERT, D_EXPERT, D_MODEL, r); }
}
__device__ __forceinline__ void cvt_range(const Params& p, char* lds, int lo, int hi, int bid, int nb) {
    for (int it = lo + bid; it < hi; it += nb) cvt_item(p, lds, it);
}

struct TileGeom { int tid, lane, wid, wr, wc, l15, q, srow, schunk;
    __device__ __forceinline__ int drow(int i) const { return wid * 32 + i * 8 + (lane >> 3); }
    __device__ __forceinline__ int dchunk(int i) const { return (lane & 7) ^ (((lane >> 4) + 4 * i) & 7); } };
__device__ __forceinline__ TileGeom tile_geom() { TileGeom g; g.tid = threadIdx.x; g.lane = g.tid & 63; g.wid = __builtin_amdgcn_readfirstlane(g.tid >> 6); g.wr = g.wid >> 1; g.wc = g.wid & 1; g.l15 = g.lane & 15; g.q = g.lane >> 4; g.srow = g.tid >> 3; g.schunk = g.tid & 7; return g; }

template <class ALoad, class BLoad>
__device__ __forceinline__ void gemm_mainloop(char* lds, const TileGeom& g, int nk, const ALoad& AL, const BLoad& BL, f32x4 (&acc)[4][4]) {
#pragma unroll
    for (int i = 0; i < 4; ++i)
#pragma unroll
        for (int j = 0; j < 4; ++j) acc[i][j] = (f32x4){0.f, 0.f, 0.f, 0.f};
    const int swz = g.l15 >> 1;
    const int aofs = (g.wr * 64 + g.l15) * 128 + ((g.q ^ swz) << 4);
    const int bofs = 32768 + (g.wc * 64 + g.l15) * 128 + ((g.q ^ swz) << 4);
    LAS char* l3 = (LAS char*)lds;
    const int dbase = g.wid * 4096;
#define GEMM_STAGE(kt_, buf_) do { _Pragma("unroll") for (int i_ = 0; i_ < 4; ++i_) { \
        __builtin_amdgcn_global_load_lds((const unsigned*)AL(i_, (kt_)), (LAS unsigned*)(l3 + (buf_) + dbase + i_ * 1024), 16, 0, 0); \
        __builtin_amdgcn_global_load_lds((const unsigned*)BL(i_, (kt_)), (LAS unsigned*)(l3 + 32768 + (buf_) + dbase + i_ * 1024), 16, 0, 0); } } while (0)
    GEMM_STAGE(0, 0);
    __syncthreads();
    for (int kt = 0; kt < nk; ++kt) {
        const int cur = (kt & 1) * 16384, nxt = 16384 - cur;
        if (kt + 1 < nk) GEMM_STAGE(kt + 1, nxt);
#pragma unroll
        for (int kk = 0; kk < 2; ++kk) {
            bf16x8 af[4], bfr[4];
#pragma unroll
            for (int i = 0; i < 4; ++i) { af[i] = *(const bf16x8*)(lds + cur + ((aofs + i * 2048) ^ (kk * 64))); bfr[i] = *(const bf16x8*)(lds + cur + ((bofs + i * 2048) ^ (kk * 64))); }
#pragma unroll
            for (int mi = 0; mi < 4; ++mi)
#pragma unroll
                for (int ni = 0; ni < 4; ++ni) acc[mi][ni] = __builtin_amdgcn_mfma_f32_16x16x32_bf16(bfr[ni], af[mi], acc[mi][ni], 0, 0, 0);
        }
        __syncthreads();
    }
#undef GEMM_STAGE
}

template <class DstF>
__device__ __forceinline__ void store_transposed(char* lds, const TileGeom& g, const f32x4 (&acc)[4][4], const DstF& dst) {
    bf16_t* T = (bf16_t*)lds;
#pragma unroll
    for (int mi = 0; mi < 4; ++mi)
#pragma unroll
        for (int ni = 0; ni < 4; ++ni)
#pragma unroll
            for (int r = 0; r < 4; ++r) T[(g.wc * 64 + ni * 16 + g.q * 4 + r) * 136 + g.wr * 64 + mi * 16 + g.l15] = f2bf(acc[mi][ni][r]);
    __syncthreads();
    { int col = g.tid >> 1, half = g.tid & 1; bf16_t* d = dst(col) + half * 64; const bf16_t* s = T + col * 136 + half * 64;
#pragma unroll
      for (int j = 0; j < 8; ++j) *(u32x4*)(d + j * 8) = *(const u32x4*)(s + j * 8); }
    __syncthreads();
}
__device__ __forceinline__ void store4bf(bf16_t* d, const f32x4& v) { u32x2 w; w.x = pk2bf(v[0], v[1]); w.y = pk2bf(v[2], v[3]); *(u32x2*)d = w; }
__device__ __forceinline__ void rope_head(const Params& p, f32x4 (&a)[4], int s, int q) {
    const int pr = s / GRID_W, pc = s % GRID_W;
    const f32x4 cr = *(const f32x4*)(p.ropet + pr * 32 + q * 4), sr = *(const f32x4*)(p.ropet + pr * 32 + 16 + q * 4);
    const f32x4 cc = *(const f32x4*)(p.ropet + pc * 32 + q * 4), sc = *(const f32x4*)(p.ropet + pc * 32 + 16 + q * 4);
    f32x4 x1 = a[0], x2 = a[1]; a[0] = x1 * cr - x2 * sr; a[1] = x2 * cr + x1 * sr;
    x1 = a[2]; x2 = a[3]; a[2] = x1 * cc - x2 * sc; a[3] = x2 * cc + x1 * sc;
}

template <int LAYER>
__device__ __forceinline__ void inproj_tile(const Params& p, char* lds, int mt, int nt) {
    const TileGeom g = tile_geom();
    const bf16_t* Abase = p.hbuf + (size_t)(mt * 128) * D_MODEL;
    const bf16_t* Bbase = (LAYER == 0 ? p.Wt_in_even : p.Wt_in_odd) + (size_t)(nt * 128) * D_MODEL;
    f32x4 acc[4][4];
    gemm_mainloop(lds, g, D_MODEL / 64, [&](int i, int kt) { return Abase + (size_t)g.drow(i) * D_MODEL + kt * 64 + g.dchunk(i) * 8; }, [&](int i, int kt) { return Bbase + (size_t)g.drow(i) * D_MODEL + kt * 64 + g.dchunk(i) * 8; }, acc);
    const bool lat = mt < MT_LAT; const int row0 = mt * 128;
    const int b = lat ? row0 / SEQ : (row0 - TX) / CTX_LEN, s0 = lat ? row0 % SEQ : (row0 - TX) % CTX_LEN, pos0 = lat ? CTX_LEN + s0 : s0;
    int kind;
    bf16_t* base; int h0 = 0, qcol0 = 0, nh = 2;
    if (LAYER == 0) {
        if (nt < 4) { kind = 0; base = p.QA; qcol0 = nt * 128; }
        else if (nt == 4) { kind = 1; base = p.KA; h0 = 0; nh = 2; }
        else if (nt == 5) { kind = 2; base = p.VAt; h0 = 0; nh = 2; }
        else if (nt < 10) { kind = 0; base = p.QB; qcol0 = (nt - 6) * 128; }
        else if (nt < 14) { kind = 1; base = p.KB; h0 = (nt - 10) * 2; nh = 8; }
        else { kind = 2; base = p.VBt; h0 = (nt - 14) * 2; nh = 8; }
    } else {
        if (nt < 4) { kind = 0; base = p.QC; qcol0 = nt * 128; }
        else if (nt == 4) { kind = 1; base = p.KC; h0 = 0; nh = 2; }
        else if (nt == 5) { kind = 2; base = p.VCt; h0 = 0; nh = 2; }
        else { kind = 3; base = p.UT; }
    }
    if (kind <= 1) {
        const bool rope = lat && (LAYER == 1 || nt <= 4);
#pragma unroll
        for (int mi = 0; mi < 4; ++mi) {
            const int rowl = g.wr * 64 + mi * 16 + g.l15;
            if (LAYER == 1) {
                float ss = 0.f;
#pragma unroll
                for (int ni = 0; ni < 4; ++ni) ss += acc[mi][ni][0] * acc[mi][ni][0] + acc[mi][ni][1] * acc[mi][ni][1] + acc[mi][ni][2] * acc[mi][ni][2] + acc[mi][ni][3] * acc[mi][ni][3];
                ss += __shfl_xor(ss, 16); ss += __shfl_xor(ss, 32);
                const float rstd = 1.0f / sqrtf(ss * (1.0f / 64.0f) + EPS);
                const float* gn = kind == 0 ? p.c_qnorm : p.c_knorm;
#pragma unroll
                for (int ni = 0; ni < 4; ++ni) acc[mi][ni] = acc[mi][ni] * rstd * *(const f32x4*)(gn + ni * 16 + g.q * 4);
            }
            if (rope) rope_head(p, acc[mi], s0 + rowl, g.q);
            bf16_t* d = kind == 0 ? base + (size_t)(row0 + rowl) * 512 + qcol0 + g.wc * 64 + g.q * 4
                                  : base + ((size_t)(b * nh + h0 + g.wc) * LKV + pos0 + rowl) * 64 + g.q * 4;
#pragma unroll
            for (int ni = 0; ni < 4; ++ni) store4bf(d + ni * 16, acc[mi][ni]);
        }
    } else if (kind == 2) {
        store_transposed(lds, g, acc, [&](int col) { return base + ((size_t)(b * nh + h0 + (col >> 6)) * 64 + (col & 63)) * LKV + pos0; });
    } else {
        store_transposed(lds, g, acc, [&](int col) { return base + ((size_t)b * 3 * D_CH + (nt - 6) * 128 + col) * SEQ + s0; });
    }
}
template <int LAYER>
__device__ __forceinline__ void ph_inproj(const Params& p, char* lds, int bid, int nb) {
    constexpr int NT = 18;
    if (LAYER == 0) { for (int t = bid; t < MT_ALL * NT; t += nb) inproj_tile<0>(p, lds, t / NT, t % NT); }
    else {
        const int n_lat = MT_LAT * NT, n_all = n_lat + (MT_ALL - MT_LAT) * 2;
        for (int t = bid; t < n_all; t += nb) { if (t < n_lat) inproj_tile<1>(p, lds, t / NT, t % NT); else { int u = t - n_lat; inproj_tile<1>(p, lds, MT_LAT + u / 2, 4 + u % 2); } }
    }
}

template <int LAYER>
__device__ __forceinline__ void outproj_tile(const Params& p, char* lds, int mt, int nt) {
    const TileGeom g = tile_geom();
    const bf16_t* Abase = p.Y + (size_t)(mt * 128) * 1024;
    const bf16_t* Bbase = (LAYER == 0 ? p.Wt_out_even : p.Wt_out_odd) + (size_t)(nt * 128) * 1024;
    f32x4 acc[4][4];
    gemm_mainloop(lds, g, 16, [&](int i, int kt) { return Abase + (size_t)g.drow(i) * 1024 + kt * 64 + g.dchunk(i) * 8; }, [&](int i, int kt) { return Bbase + (size_t)g.drow(i) * 1024 + kt * 64 + g.dchunk(i) * 8; }, acc);
    const int row0 = mt * 128;
#pragma unroll
    for (int mi = 0; mi < 4; ++mi) {
        const int row = row0 + g.wr * 64 + mi * 16 + g.l15;
        const float* xin = xrow_in(p, LAYER, row); float* xo = xrow_cur(p, row); const float* gate = modp(p, LAYER, row, 2);
#pragma unroll
        for (int ni = 0; ni < 4; ++ni) { const int col = nt * 128 + g.wc * 64 + ni * 16 + g.q * 4;
            *(f32x4*)(xo + col) = *(const f32x4*)(xin + col) + *(const f32x4*)(gate + col) * acc[mi][ni]; }
    }
}

template <int LAYER>
__device__ __forceinline__ void ph_outproj(const Params& p, char* lds, int bid, int nb) {
    const int nmt = LAYER == 0 ? MT_ALL : MT_LAT;
    for (int t = bid; t < nmt * 8; t += nb) outproj_tile<LAYER>(p, lds, t / 8, t % 8);
}

template <int NTN>
__device__ __forceinline__ bool moe_tile_lookup(const int* cnt, int t, int& pr, int& mt, int& nt, int& n) {
    int acc = 0;
    for (int q = 0; q < NPAIR; ++q) { const int c = cnt[q]; const int tiles = ((c + 127) >> 7) * NTN; if (t < acc + tiles) { pr = q; const int u = t - acc; mt = u / NTN; nt = u % NTN; n = c; return true; } acc += tiles; }
    return false;
}
__device__ __forceinline__ void moe_up_tile(const Params& p, char* lds, int l, int pr, int mt, int nt, int n) {
    const TileGeom g = tile_geom();
    int e1, e2; pair_experts(pr, e1, e2); const int k = nt >> 3, e = k ? e2 : e1;
    const int* lst = p.list + (size_t)pr * TT + mt * 128;
    const int navail = n - mt * 128;
    const bf16_t* arow[4];
#pragma unroll
    for (int i = 0; i < 4; ++i) { int r = g.drow(i); if (r >= navail) r = navail - 1; arow[i] = p.hbuf + (size_t)lst[r] * D_MODEL + g.dchunk(i) * 8; }
    const bf16_t* Bbase = p.Wt_gu + ((size_t)(l * N_EXPERTS + e) * 2 * D_EXPERT + (nt & 7) * 128) * D_MODEL;
    f32x4 acc[4][4];
    gemm_mainloop(lds, g, D_MODEL / 64, [&](int i, int kt) { return arow[i] + kt * 64; }, [&](int i, int kt) { return Bbase + (size_t)g.drow(i) * D_MODEL + kt * 64 + g.dchunk(i) * 8; }, acc);
#pragma unroll
    for (int mi = 0; mi < 4; ++mi) {
        const int rl = g.wr * 64 + mi * 16 + g.l15;
        if (rl < navail) {
            const int row = lst[rl]; const float w = p.tokw[row * 2 + k];
            bf16_t* d = p.HE + (size_t)row * HE_W + k * D_EXPERT + (nt & 7) * 64 + g.wc * 32 + g.q * 4;
#pragma unroll
            for (int h2 = 0; h2 < 2; ++h2) { f32x4 gg = acc[mi][2 * h2], uu = acc[mi][2 * h2 + 1], o;
#pragma unroll
                for (int r = 0; r < 4; ++r) o[r] = w * (gg[r] / (1.0f + __expf(-gg[r]))) * uu[r];
                store4bf(d + h2 * 16, o); }
        }
    }
}
template <bool DUMMY = false>
__device__ __forceinline__ void moe_down_tile(const Params& p, char* lds, int l, int pr, int mt, int nt, int n) {
    const TileGeom g = tile_geom();
    int e1, e2; pair_experts(pr, e1, e2);
    const int* lst = p.list + (size_t)pr * TT + mt * 128;
    const int navail = n - mt * 128;
    const bf16_t* arow[4];
#pragma unroll
    for (int i = 0; i < 4; ++i) { int r = g.drow(i); if (r >= navail) r = navail - 1; arow[i] = p.HE + (size_t)lst[r] * HE_W + g.dchunk(i) * 8; }
    const bf16_t* B1 = p.Wt_d + ((size_t)(l * N_EXPERTS + e1) * D_MODEL + nt * 128) * D_EXPERT;
    const bf16_t* B2 = p.Wt_d + ((size_t)(l * N_EXPERTS + e2) * D_MODEL + nt * 128) * D_EXPERT;
    constexpr int KT1 = D_EXPERT / 64;
    f32x4 acc[4][4];
    gemm_mainloop(lds, g, HE_W / 64, [&](int i, int kt) { return arow[i] + kt * 64; },
                  [&](int i, int kt) { return (kt < KT1 ? B1 + kt * 64 : B2 + (kt - KT1) * 64) + (size_t)g.drow(i) * D_EXPERT + g.dchunk(i) * 8; }, acc);
#pragma unroll
    for (int mi = 0; mi < 4; ++mi) {
        const int rl = g.wr * 64 + mi * 16 + g.l15;
        if (rl < navail) {
            const int row = lst[rl]; float* xo = xrow_cur(p, row); const float* gate = modp(p, l, row, 5);
#pragma unroll
            for (int ni = 0; ni < 4; ++ni) { const int col = nt * 128 + g.wc * 64 + ni * 16 + g.q * 4; float* dst = DUMMY ? (float*)p.QA + (size_t)row * D_MODEL : xo; *(f32x4*)(dst + col) = *(const f32x4*)(xo + col) + *(const f32x4*)(gate + col) * acc[mi][ni]; }
        }
    }
}
__device__ __forceinline__ void ph_moe_up(const Params& p, char* lds, int l, int bid, int nb) {
    int pr, mt, nt, n; for (int t = bid; moe_tile_lookup<16>(p.cnt + l * 32, t, pr, mt, nt, n); t += nb) moe_up_tile(p, lds, l, pr, mt, nt, n);
}
template <bool DUMMY = false>
__device__ __forceinline__ void ph_moe_down(const Params& p, char* lds, int l, int bid, int nb) {
    int pr, mt, nt, n; for (int t = bid; moe_tile_lookup<8>(p.cnt + l * 32, t, pr, mt, nt, n); t += nb) moe_down_tile<DUMMY>(p, lds, l, pr, mt, nt, n);
}
typedef float f32x2 __attribute__((ext_vector_type(2)));
typedef __bf16 bf16x2_t __attribute__((ext_vector_type(2)));
__device__ __forceinline__ unsigned cvtpk(float lo, float hi) { f32x2 v = {lo, hi}; bf16x2_t b = __builtin_convertvector(v, bf16x2_t); return __builtin_bit_cast(unsigned, b); }
__device__ __forceinline__ int crow(int r, int hi) { return (r & 3) + 8 * (r >> 2) + 4 * hi; }
constexpr float LOG2E = 1.4426950408889634f;
constexpr float QK_C = ATTN_SCALE * LOG2E;
constexpr float NEG_BIG = -1e30f;

template <int MODE>
__device__ __forceinline__ void attn_unit(char* lds, const bf16_t* Qp, const bf16_t* Kp, const bf16_t* Vt, bf16_t* Op, int s0, int nctx, int lt0, int nlat, float sink2, bool has_sink, const float* rpb_h) {
    int tid_ = threadIdx.x; asm volatile("" : "+v"(tid_));
    const int tid = tid_, lane = tid & 63, wid = __builtin_amdgcn_readfirstlane(tid >> 6), l31 = lane & 31, hi = lane >> 5;
    float* bias_s = (float*)(lds + 49152);
    if (MODE == 2) { for (int i = tid; i < 15 * 31; i += NTHREADS) bias_s[i] = rpb_h[i] * LOG2E; }
    const int ntiles = nctx + nlat;
    LAS char* l3 = (LAS char*)lds;
    const int drow0 = wid * 16 + (lane >> 3);
    const int dch0 = (lane & 7) ^ (((lane >> 4) + 0) & 7), dch1 = (lane & 7) ^ (((lane >> 4) + 4) & 7);
    const bf16_t* ksrc0 = Kp + (size_t)drow0 * 64 + dch0 * 8; const bf16_t* ksrc1 = Kp + (size_t)(drow0 + 8) * 64 + dch1 * 8;
    const bf16_t* vsrc0 = Vt + (size_t)drow0 * LKV + dch0 * 8; const bf16_t* vsrc1 = Vt + (size_t)(drow0 + 8) * LKV + dch1 * 8;
    const int ddst = wid * 2048;
    auto tile_pos = [&](int j) { return j < nctx ? 64 * j : CTX_LEN + 64 * (lt0 + j - nctx); };
#define ATT_DMA(j_, slot_) do { const int pos_ = tile_pos(j_); \
        __builtin_amdgcn_global_load_lds((const unsigned*)(ksrc0 + (size_t)pos_ * 64), (LAS unsigned*)(l3 + (slot_) * 8192 + ddst), 16, 0, 0); \
        __builtin_amdgcn_global_load_lds((const unsigned*)(ksrc1 + (size_t)pos_ * 64), (LAS unsigned*)(l3 + (slot_) * 8192 + ddst + 1024), 16, 0, 0); \
        __builtin_amdgcn_global_load_lds((const unsigned*)(vsrc0 + pos_), (LAS unsigned*)(l3 + 24576 + (slot_) * 8192 + ddst), 16, 0, 0); \
        __builtin_amdgcn_global_load_lds((const unsigned*)(vsrc1 + pos_), (LAS unsigned*)(l3 + 24576 + (slot_) * 8192 + ddst + 1024), 16, 0, 0); } while (0)
    const int x = (l31 >> 1) & 7;
    const int kofs = l31 * 128 + ((hi ^ x) << 4);
    const int vofs = 24576 + l31 * 128 + (x << 4) + 8 * hi;
    bf16x8 qf[4];
    { const bf16_t* qr = Qp + (size_t)(wid * 32 + l31) * 512 + hi * 8;
#pragma unroll
      for (int s = 0; s < 4; ++s) qf[s] = *(const bf16x8*)(qr + s * 16); }
    f32x16 o0 = {}, o1 = {};
    float m = NEG_BIG, l = 0.f;
    const int sq = s0 + wid * 32 + l31;
    int rq = 0, cq = 0, rsq = 0, csq = 0;
    if (MODE == 2) { rq = sq / GRID_W; cq = sq % GRID_W; rsq = rq - B_WIN_H / 2; rsq = rsq < 0 ? 0 : (rsq > GRID_H - B_WIN_H ? GRID_H - B_WIN_H : rsq); csq = cq - B_WIN_W / 2; csq = csq < 0 ? 0 : (csq > GRID_W - B_WIN_W ? GRID_W - B_WIN_W : csq); }
    ATT_DMA(0, 0);
    if (ntiles > 1) { ATT_DMA(1, 1); asm volatile("s_waitcnt vmcnt(4) lgkmcnt(0)" ::: "memory"); } else { asm volatile("s_waitcnt vmcnt(0) lgkmcnt(0)" ::: "memory"); }
    __builtin_amdgcn_s_barrier(); asm volatile("" ::: "memory");
    int slot = 0;
    for (int j = 0; j < ntiles; ++j) {
        const int slot2 = slot == 0 ? 2 : slot - 1;
        const bool pre = j + 2 < ntiles;
        if (pre) ATT_DMA(j + 2, slot2);
        const char* Kb = lds + slot * 8192; const char* Vb = lds + slot * 8192;
        f32x16 p0 = {}, p1 = {};
#pragma unroll
        for (int s = 0; s < 4; ++s) {
            const bf16x8 k0 = *(const bf16x8*)(Kb + (kofs ^ (s << 5))); const bf16x8 k1 = *(const bf16x8*)(Kb + 4096 + (kofs ^ (s << 5)));
            p0 = __builtin_amdgcn_mfma_f32_32x32x16_bf16(k0, qf[s], p0, 0, 0, 0); p1 = __builtin_amdgcn_mfma_f32_32x32x16_bf16(k1, qf[s], p1, 0, 0, 0);
        }
        float tmax = NEG_BIG;
        const bool plain = (MODE == 0 || j < nctx);
        if (plain) {
#pragma unroll
            for (int r = 0; r < 16; ++r) tmax = fmaxf(tmax, fmaxf(p0[r], p1[r]));
            tmax *= QK_C;
        } else if (MODE == 1) {
            const int sk0 = 64 * (lt0 + j - nctx);
#pragma unroll
            for (int r = 0; r < 16; ++r) { const int d0 = sk0 + crow(r, hi) - sq, d1 = d0 + 32;
                p0[r] = (d0 >= -A_WINDOW && d0 <= A_WINDOW) ? p0[r] * QK_C : NEG_BIG; p1[r] = (d1 >= -A_WINDOW && d1 <= A_WINDOW) ? p1[r] * QK_C : NEG_BIG; tmax = fmaxf(tmax, fmaxf(p0[r], p1[r])); }
        } else {
            const int kr = lt0 + j - nctx; const bool rowok = kr >= rsq && kr < rsq + B_WIN_H;
            const float* brow = bias_s + (kr - rq + B_WIN_H - 1) * 31 + (B_WIN_W - 1) - cq;
#pragma unroll
            for (int r = 0; r < 16; ++r) { const int kc0 = crow(r, hi), kc1 = kc0 + 32;
                const bool ok0 = rowok && kc0 >= csq && kc0 < csq + B_WIN_W, ok1 = rowok && kc1 >= csq && kc1 < csq + B_WIN_W;
                p0[r] = ok0 ? p0[r] * QK_C + brow[kc0] : NEG_BIG; p1[r] = ok1 ? p1[r] * QK_C + brow[kc1] : NEG_BIG; tmax = fmaxf(tmax, fmaxf(p0[r], p1[r])); }
        }
        tmax = fmaxf(tmax, __shfl_xor(tmax, 32));
        const float mn = fmaxf(m, tmax);
        if (__any(mn > m)) {
            const float alpha = __builtin_amdgcn_exp2f(m - mn); m = mn; l *= alpha;
#pragma unroll
            for (int r = 0; r < 16; ++r) { o0[r] *= alpha; o1[r] *= alpha; }
        }
        float ls = 0.f;
        if (plain) {
#pragma unroll
            for (int r = 0; r < 16; ++r) { p0[r] = __builtin_amdgcn_exp2f(__builtin_fmaf(p0[r], QK_C, -m)); p1[r] = __builtin_amdgcn_exp2f(__builtin_fmaf(p1[r], QK_C, -m)); ls += p0[r] + p1[r]; }
        } else {
#pragma unroll
            for (int r = 0; r < 16; ++r) { p0[r] = __builtin_amdgcn_exp2f(p0[r] - m); p1[r] = __builtin_amdgcn_exp2f(p1[r] - m); ls += p0[r] + p1[r]; }
        }
        l += ls;
        bf16x8 pf[4];
        { u32x4 w;
          w.x = cvtpk(p0[0], p0[1]); w.y = cvtpk(p0[2], p0[3]); w.z = cvtpk(p0[4], p0[5]); w.w = cvtpk(p0[6], p0[7]); pf[0] = __builtin_bit_cast(bf16x8, w);
          w.x = cvtpk(p0[8], p0[9]); w.y = cvtpk(p0[10], p0[11]); w.z = cvtpk(p0[12], p0[13]); w.w = cvtpk(p0[14], p0[15]); pf[1] = __builtin_bit_cast(bf16x8, w);
          w.x = cvtpk(p1[0], p1[1]); w.y = cvtpk(p1[2], p1[3]); w.z = cvtpk(p1[4], p1[5]); w.w = cvtpk(p1[6], p1[7]); pf[2] = __builtin_bit_cast(bf16x8, w);
          w.x = cvtpk(p1[8], p1[9]); w.y = cvtpk(p1[10], p1[11]); w.z = cvtpk(p1[12], p1[13]); w.w = cvtpk(p1[14], p1[15]); pf[3] = __builtin_bit_cast(bf16x8, w); }
#pragma unroll
        for (int s = 0; s < 4; ++s) {
            const int a0 = vofs ^ (s << 5);
            u32x2 va = *(const u32x2*)(Vb + a0), vb = *(const u32x2*)(Vb + (a0 ^ 16));
            u32x2 vc = *(const u32x2*)(Vb + 4096 + a0), vd = *(const u32x2*)(Vb + 4096 + (a0 ^ 16));
            const bf16x8 f0 = __builtin_bit_cast(bf16x8, (u32x4){va.x, va.y, vb.x, vb.y}), f1 = __builtin_bit_cast(bf16x8, (u32x4){vc.x, vc.y, vd.x, vd.y});
            o0 = __builtin_amdgcn_mfma_f32_32x32x16_bf16(f0, pf[s], o0, 0, 0, 0); o1 = __builtin_amdgcn_mfma_f32_32x32x16_bf16(f1, pf[s], o1, 0, 0, 0);
        }
        if (pre) asm volatile("s_waitcnt vmcnt(4) lgkmcnt(0)" ::: "memory"); else asm volatile("s_waitcnt vmcnt(0) lgkmcnt(0)" ::: "memory");
        __builtin_amdgcn_s_barrier(); asm volatile("" ::: "memory");
        slot = slot == 2 ? 0 : slot + 1;
    }
#undef ATT_DMA
    l += __shfl_xor(l, 32);
    if (has_sink) l += __builtin_amdgcn_exp2f(sink2 - m);
    const float inv = 1.0f / l;
    bf16_t* orow = Op + (size_t)(wid * 32 + l31) * 1024;
#pragma unroll
    for (int g4 = 0; g4 < 4; ++g4) {
        u32x2 w; w.x = cvtpk(o0[g4 * 4 + 0] * inv, o0[g4 * 4 + 1] * inv); w.y = cvtpk(o0[g4 * 4 + 2] * inv, o0[g4 * 4 + 3] * inv); *(u32x2*)(orow + 8 * g4 + 4 * hi) = w;
        w.x = cvtpk(o1[g4 * 4 + 0] * inv, o1[g4 * 4 + 1] * inv); w.y = cvtpk(o1[g4 * 4 + 2] * inv, o1[g4 * 4 + 3] * inv); *(u32x2*)(orow + 32 + 8 * g4 + 4 * hi) = w;
    }
    asm volatile("s_waitcnt vmcnt(0)" ::: "memory");
}

constexpr int NU_LAT = BATCH * 8 * (SEQ / 128);
constexpr int NU_CTX = BATCH * 8 * (CTX_LEN / 128);
__device__ __forceinline__ void ph_attn0(const Params& p, char* lds, int bid, int nb) {
    for (int u = bid; u < 2 * NU_LAT + 2 * NU_CTX; u += nb) {
        if (u < NU_LAT) {
            const int blk = u % (SEQ / 128), h = (u / (SEQ / 128)) % 8, b = u / (8 * (SEQ / 128)); const int s0 = blk * 128, r0 = s0 / GRID_W;
            int rs0 = r0 - 4; rs0 = rs0 < 0 ? 0 : (rs0 > GRID_H - 8 ? GRID_H - 8 : rs0); int rs1 = r0 + 1 - 4; rs1 = rs1 < 0 ? 0 : (rs1 > GRID_H - 8 ? GRID_H - 8 : rs1);
            attn_unit<2>(lds, p.QB + (size_t)(b * SEQ + s0) * 512 + h * 64, p.KB + (size_t)(b * 8 + h) * LKV * 64, p.VBt + (size_t)(b * 8 + h) * 64 * LKV,
                         p.Y + (size_t)(b * SEQ + s0) * 1024 + 512 + h * 64, s0, CTX_LEN / 64, rs0, rs1 + 8 - rs0, 0.f, false, p.b_rpb + h * 15 * 31);
        } else if (u < 2 * NU_LAT) {
            const int v = u - NU_LAT; const int blk = v % (SEQ / 128), h = (v / (SEQ / 128)) % 8, b = v / (8 * (SEQ / 128)); const int s0 = blk * 128;
            int t0 = (s0 - 128) / 64; if (t0 < 0) t0 = 0; int t1 = (s0 + 255) / 64; if (t1 > SEQ / 64 - 1) t1 = SEQ / 64 - 1;
            attn_unit<1>(lds, p.QA + (size_t)(b * SEQ + s0) * 512 + h * 64, p.KA + (size_t)(b * 2 + h / 4) * LKV * 64, p.VAt + (size_t)(b * 2 + h / 4) * 64 * LKV,
                         p.Y + (size_t)(b * SEQ + s0) * 1024 + h * 64, s0, CTX_LEN / 64, t0, t1 - t0 + 1, p.a_sink[h] * LOG2E, true, nullptr);
        } else {
            const int v = u - 2 * NU_LAT; const int ty = v / NU_CTX, w = v % NU_CTX; const int blk = w % (CTX_LEN / 128), h = (w / (CTX_LEN / 128)) % 8, b = w / (8 * (CTX_LEN / 128));
            const int row0 = TX + b * CTX_LEN + blk * 128;
            if (ty == 0) attn_unit<0>(lds, p.QA + (size_t)row0 * 512 + h * 64, p.KA + (size_t)(b * 2 + h / 4) * LKV * 64, p.VAt + (size_t)(b * 2 + h / 4) * 64 * LKV, p.Y + (size_t)row0 * 1024 + h * 64, 0, CTX_LEN / 64, 0, 0, p.a_sink[h] * LOG2E, true, nullptr);
            else attn_unit<0>(lds, p.QB + (size_t)row0 * 512 + h * 64, p.KB + (size_t)(b * 8 + h) * LKV * 64, p.VBt + (size_t)(b * 8 + h) * 64 * LKV, p.Y + (size_t)row0 * 1024 + 512 + h * 64, 0, CTX_LEN / 64, 0, 0, 0.f, false, nullptr);
        }
    }
}
__device__ __forceinline__ void ph_attnC(const Params& p, char* lds, int bid, int nb) {
    for (int u = bid; u < NU_LAT; u += nb) {
        const int blk = u % (SEQ / 128), h = (u / (SEQ / 128)) % 8, b = u / (8 * (SEQ / 128)); const int s0 = blk * 128;
        attn_unit<0>(lds, p.QC + (size_t)(b * SEQ + s0) * 512 + h * 64, p.KC + (size_t)(b * 2 + h / 4) * LKV * 64, p.VCt + (size_t)(b * 2 + h / 4) * 64 * LKV,
                     p.Y + (size_t)(b * SEQ + s0) * 1024 + h * 64, s0, CTX_LEN / 64, 0, SEQ / 64, 0.f, false, nullptr);
    }
}
#ifdef HY_TEST
#define HY_OUT(b, t, v) p.YHT[((size_t)(b) * D_CH + c) * SEQ + (t)] = f2bf(v)
#else
#define HY_OUT(b, t, v) p.YHT[((size_t)(b) * D_CH + c) * SEQ + (t)] = f2bf(v)
#endif
#ifdef CPU_TEST
#define FOR_T for (int tid = 0; tid < 256; ++tid)
#define HSYNC
#define HST(t) st[t]
#define HY_DECL HySt* st = new HySt[256]
#define HY_FREE delete[] st
static inline void sincos_rev(float a, float& c, float& s) { c = cosf(6.283185307179586f * a); s = sinf(6.283185307179586f * a); }
#else
__device__ __forceinline__ int hy_launder(int v) { asm volatile("" : "+v"(v)); return v; }
#define FOR_T if (const int tid = hy_launder((int)threadIdx.x); true)
#define HSYNC __syncthreads()
#define HST(t) st
#define HY_DECL HySt st
#define HY_FREE
__device__ __forceinline__ void sincos_rev(float a, float& c, float& s) { c = __builtin_amdgcn_cosf(a); s = __builtin_amdgcn_sinf(a); }
#endif
constexpr int FN = 2 * SEQ;
constexpr int FPAD = FN + (FN >> 5);
#if !defined(SMALL_CFG)
static_assert(FN == 8192, "pass plan 8,8,8,16 is for N = 8192");
constexpr int R4 = 16;
constexpr int NS4 = 512;
#else
constexpr int R4 = 2;
constexpr int NS4 = 512;
#endif
constexpr int NB8 = FN / 8 / 256;
constexpr int NB4 = FN / R4 / 256;
constexpr int EPT = FN / 256;
struct HySt { float xr[EPT], xi[EPT]; unsigned kp[EPT]; };
HD unsigned hy_pack(float r, float i) { return (unsigned)f2bf(r) | ((unsigned)f2bf(i) << 16); }
HD float hy_lo(unsigned v) { unsigned u = v << 16; float f; __builtin_memcpy(&f, &u, 4); return f; }
HD float hy_hi(unsigned v) { unsigned u = v & 0xffff0000u; float f; __builtin_memcpy(&f, &u, 4); return f; }
HD int pidx(int i) { return i + (i >> 5); }

constexpr float W16C[8] = {1.0f, 0.9238795325112867f, 0.7071067811865476f, 0.3826834323650898f, 0.0f, -0.3826834323650898f, -0.7071067811865476f, -0.9238795325112867f};
constexpr float W16S[8] = {0.0f, -0.3826834323650898f, -0.7071067811865476f, -0.9238795325112867f, -1.0f, -0.9238795325112867f, -0.7071067811865476f, -0.3826834323650898f};
template <int R> HD void fft_reg(float* xr, float* xi) {
    constexpr int LG = R == 16 ? 4 : (R == 8 ? 3 : (R == 4 ? 2 : 1));
#pragma unroll
    for (int sg = 0; sg < LG; ++sg) {
        const int h = (R / 2) >> sg;
#pragma unroll
        for (int pr = 0; pr < R / 2; ++pr) {
            const int blk = (pr / h) * 2 * h, i = pr % h;
            const int a = blk + i, b = blk + i + h;
            const float ar = xr[a], ai = xi[a], br = xr[b], bi = xi[b];
            xr[a] = ar + br; xi[a] = ai + bi;
            const float tr = ar - br, ti = ai - bi;
            const int tw = i * (8 / h);
            if (tw == 0) { xr[b] = tr; xi[b] = ti; }
            else if (tw == 4) { xr[b] = ti; xi[b] = -tr; }
            else { const float c = W16C[tw & 7], s = W16S[tw & 7]; xr[b] = tr * c - ti * s; xi[b] = tr * s + ti * c; }
        }
    }
}
template <int R> HD constexpr int bitrev(int i) { int r = 0; for (int b = 1; b < R; b <<= 1) { r = (r << 1) | (i & 1); i >>= 1; } return r; }

template <int R, int NB, class In> HD void pass_load(int tid, HySt& s, const In& in) {
#pragma unroll
    for (int b = 0; b < NB; ++b)
#pragma unroll
        for (int r = 0; r < R; ++r) in(tid + 256 * b + (FN / R) * r, r, s.xr[b * R + r], s.xi[b * R + r]);
}
template <int R, int NB, class Out> HD void pass_compute(int tid, HySt& s, int Ns, const Out& out) {
#pragma unroll
    for (int b = 0; b < NB; ++b) {
        const int j = tid + 256 * b, k = j & (Ns - 1);
        float* xr = s.xr + b * R; float* xi = s.xi + b * R;
        if (Ns > 1) {
            float wc, ws; sincos_rev(-(float)k / (float)(Ns * R), wc, ws);
            float cr = wc, ci = ws;
#pragma unroll
            for (int r = 1; r < R; ++r) {
                const float vr = xr[r], vi = xi[r]; xr[r] = vr * cr - vi * ci; xi[r] = vr * ci + vi * cr;
                const float nr = cr * wc - ci * ws, ni = cr * ws + ci * wc; cr = nr; ci = ni;
            }
        }
        fft_reg<R>(xr, xi);
        const int j0 = (j - k) * R + k;
#pragma unroll
        for (int i = 0; i < R; ++i) out(j0 + bitrev<R>(i) * Ns, b, bitrev<R>(i), xr[i], xi[i]);
    }
}
struct LdsIn { const float* re; const float* im; HD void operator()(int idx, int, float& r, float& i) const { r = re[pidx(idx)]; i = im[pidx(idx)]; } };
struct LdsOut { float* re; float* im; HD void operator()(int idx, int, int, float r, float i) const { re[pidx(idx)] = r; im[pidx(idx)] = i; } };

HD void hy_pre_load(const Params& p, int c, int b, int tid, float* lds) {
#pragma unroll
    for (int q = 0; q < 3; ++q) {
        const bf16_t* u = p.UT + ((size_t)b * 3 * D_CH + q * D_CH + c) * SEQ; const int t0 = tid * 16;
        const float w0 = p.hy_short_w[0 * 3 * D_CH + q * D_CH + c], w1 = p.hy_short_w[1 * 3 * D_CH + q * D_CH + c], w2 = p.hy_short_w[2 * 3 * D_CH + q * D_CH + c], sb = p.hy_short_b[q * D_CH + c];
        unsigned w[8];
        { const unsigned* u32p = (const unsigned*)(u + t0);
#pragma unroll
          for (int i = 0; i < 8; ++i) w[i] = u32p[i]; }
        float x[18];
        x[0] = t0 > 0 ? bf2f(u[t0 - 1]) : 0.f; x[17] = t0 + 16 < SEQ ? bf2f(u[t0 + 16]) : 0.f;
#pragma unroll
        for (int i = 0; i < 8; ++i) { x[1 + 2 * i] = bf2f((bf16_t)(w[i] & 0xffffu)); x[2 + 2 * i] = bf2f((bf16_t)(w[i] >> 16)); }
#pragma unroll
        for (int i = 0; i < 16; ++i) lds[q * SEQ + t0 + i] = sb + w0 * x[i] + w1 * x[i + 1] + w2 * x[i + 2];
    }
}
HD void hy_pre_store(const Params& p, int c, int b, int tid, const float* lds) {
#pragma unroll
    for (int q = 0; q < 3; ++q) {
        unsigned* u = (unsigned*)(p.UT + ((size_t)b * 3 * D_CH + q * D_CH + c) * SEQ + tid * 16);
#pragma unroll
        for (int i = 0; i < 8; ++i) u[i] = (unsigned)f2bf(lds[q * SEQ + tid + 256 * (2 * i)]) | ((unsigned)f2bf(lds[q * SEQ + tid + 256 * (2 * i + 1)]) << 16);
    }
}
HD void tm_load_bf16(const bf16_t* row, int tid, unsigned (&w)[8]) { const unsigned* q = (const unsigned*)(row + tid * 16);
#pragma unroll
    for (int i = 0; i < 8; ++i) w[i] = q[i]; }
HD float tm_get(const unsigned (&w)[8], int m) { return bf2f((bf16_t)((m & 1) ? (w[m >> 1] >> 16) : (w[m >> 1] & 0xffffu))); }
HD int tm_ofs(int idx) { return (idx & 255) * 16 + (idx >> 8); }

HD void hyena_channel(const Params& p, int c, float* lds) {
    HY_DECL;
    float* re = lds; float* im = lds + FPAD;
    const LdsIn lin{re, im}; const LdsOut lout{re, im};
    for (int b = 0; b < BATCH; ++b) { FOR_T { hy_pre_load(p, c, b, tid, lds); } HSYNC; FOR_T { hy_pre_store(p, c, b, tid, lds); } HSYNC; }
    float nrm[2];
#pragma unroll
    for (int o = 0; o < 2; ++o) {
        const float* hf = p.HFT + (size_t)((0 * 2 + o) * D_CH + c) * SEQ; const float* hb = p.HFT + (size_t)((1 * 2 + o) * D_CH + c) * SEQ;
        FOR_T { float sacc = 0.f; for (int i = 0; i < SEQ / 256; ++i) sacc += fabsf(hf[tid + 256 * i]) + fabsf(hb[tid + 256 * i]); re[tid] = sacc; }
        HSYNC;
        { float tot = 0.f; for (int i = 0; i < 256; ++i) tot += re[i]; nrm[o] = tot + EPS; }
        HSYNC;
    }
    float sw[3][3], sbv[3];
#pragma unroll
    for (int q = 0; q < 3; ++q) { sbv[q] = p.hy_short_b[q * D_CH + c];
#pragma unroll
        for (int kk = 0; kk < 3; ++kk) sw[q][kk] = p.hy_short_w[kk * 3 * D_CH + q * D_CH + c]; }
#pragma unroll 1
    for (int o = 0; o < 2; ++o) {
        const float* hf = p.HFT + (size_t)((0 * 2 + o) * D_CH + c) * SEQ; const float* hb = p.HFT + (size_t)((1 * 2 + o) * D_CH + c) * SEQ;
        const float inv = 1.0f / (o == 0 ? nrm[0] : nrm[1]); const float hbias = p.hy_bias[o * D_CH + c];
        float swg[3]; swg[0] = o == 0 ? sw[1][0] : sw[2][0]; swg[1] = o == 0 ? sw[1][1] : sw[2][1]; swg[2] = o == 0 ? sw[1][2] : sw[2][2]; const float sbg = o == 0 ? sbv[1] : sbv[2];
        FOR_T { pass_load<8, NB8>(tid, HST(tid), [&](int idx, int r8, float& r, float& i) __attribute__((always_inline)) { if (r8 < 4) r = hf[idx] * inv; else { const int q = FN - idx; const float hv = hb[q < SEQ ? q : 0]; r = q < SEQ ? hv * inv : 0.f; } i = 0.f; });
                pass_compute<8, NB8>(tid, HST(tid), 1, lout); }
        HSYNC;
        FOR_T { pass_load<8, NB8>(tid, HST(tid), lin); } HSYNC; FOR_T { pass_compute<8, NB8>(tid, HST(tid), 8, lout); } HSYNC;
        FOR_T { pass_load<8, NB8>(tid, HST(tid), lin); } HSYNC; FOR_T { pass_compute<8, NB8>(tid, HST(tid), 64, lout); } HSYNC;
        FOR_T { pass_load<R4, NB4>(tid, HST(tid), lin);
                HySt& s = HST(tid); pass_compute<R4, NB4>(tid, s, NS4, [&](int, int b, int rr, float r, float i) __attribute__((always_inline)) { s.kp[b + NB4 * rr] = hy_pack(r, i); }); }
        HSYNC;
        for (int bp = 0; bp < BATCH / 2; ++bp) {
            const int b0 = 2 * bp, b1 = 2 * bp + 1;
            const bf16_t* u0 = p.UT + ((size_t)b0 * 3 * D_CH + c) * SEQ; const bf16_t* u1 = p.UT + ((size_t)b1 * 3 * D_CH + c) * SEQ;
            const float* z0 = p.Z1 + ((size_t)b0 * D_CH + c) * SEQ; const float* z1 = p.Z1 + ((size_t)b1 * D_CH + c) * SEQ;
            auto zval = [&](int b, int t) __attribute__((always_inline)) { return o == 0 ? bf2f((b == b0 ? u0 : u1)[tm_ofs(t)]) : (b == b0 ? z0 : z1)[tm_ofs(t)]; };
            FOR_T { HySt& s = HST(tid);
                    if (o == 0) { unsigned w0[8], w1[8]; tm_load_bf16(u0, tid, w0); tm_load_bf16(u1, tid, w1);
#pragma unroll
                        for (int q = 0; q < 32; ++q) { const int b = q >> 3, r = q & 7; if (r < 4) { s.xr[q] = tm_get(w0, b + 4 * r); s.xi[q] = tm_get(w1, b + 4 * r); } else { s.xr[q] = 0.f; s.xi[q] = 0.f; } } }
                    else {
#pragma unroll
                        for (int q = 0; q < 32; ++q) { const int b = q >> 3, r = q & 7; if (r < 4) { s.xr[q] = z0[tid * 16 + b + 4 * r]; s.xi[q] = z1[tid * 16 + b + 4 * r]; } else { s.xr[q] = 0.f; s.xi[q] = 0.f; } } }
                    pass_compute<8, NB8>(tid, s, 1, lout); }
            HSYNC;
            FOR_T { pass_load<8, NB8>(tid, HST(tid), lin); } HSYNC; FOR_T { pass_compute<8, NB8>(tid, HST(tid), 8, lout); } HSYNC;
            FOR_T { pass_load<8, NB8>(tid, HST(tid), lin); } HSYNC; FOR_T { pass_compute<8, NB8>(tid, HST(tid), 64, lout); } HSYNC;
            FOR_T { pass_load<R4, NB4>(tid, HST(tid), lin); } HSYNC;
            FOR_T { HySt& s = HST(tid); pass_compute<R4, NB4>(tid, s, NS4, [&](int idx, int b, int rr, float r, float i) __attribute__((always_inline)) { const float kr = hy_lo(s.kp[b + NB4 * rr]), ki = hy_hi(s.kp[b + NB4 * rr]);
                        re[pidx(idx)] = r * kr - i * ki; im[pidx(idx)] = -(r * ki + i * kr); }); }
            HSYNC;
            FOR_T { pass_load<8, NB8>(tid, HST(tid), lin); } HSYNC; FOR_T { pass_compute<8, NB8>(tid, HST(tid), 1, lout); } HSYNC;
            FOR_T { pass_load<8, NB8>(tid, HST(tid), lin); } HSYNC; FOR_T { pass_compute<8, NB8>(tid, HST(tid), 8, lout); } HSYNC;
            FOR_T { pass_load<8, NB8>(tid, HST(tid), lin); } HSYNC; FOR_T { pass_compute<8, NB8>(tid, HST(tid), 64, lout); } HSYNC;
            FOR_T { pass_load<R4, NB4>(tid, HST(tid), lin); HySt& s = HST(tid); float yr[16], yi[16];
                    pass_compute<R4, NB4>(tid, s, NS4, [&](int, int b, int rr, float r, float i) __attribute__((always_inline)) { if (rr < 8) { yr[b + 2 * rr] = r * (1.0f / FN); yi[b + 2 * rr] = -i * (1.0f / FN); } });
                    const bf16_t* g0 = p.UT + ((size_t)b0 * 3 * D_CH + (o + 1) * D_CH + c) * SEQ; const bf16_t* g1 = p.UT + ((size_t)b1 * 3 * D_CH + (o + 1) * D_CH + c) * SEQ;
                    unsigned gw0[8], gw1[8]; tm_load_bf16(g0, tid, gw0); tm_load_bf16(g1, tid, gw1);
                    if (o == 0) { unsigned w0[8], w1[8]; tm_load_bf16(u0, tid, w0); tm_load_bf16(u1, tid, w1);
                        float* zo0 = p.Z1 + ((size_t)b0 * D_CH + c) * SEQ + tid * 16; float* zo1 = p.Z1 + ((size_t)b1 * D_CH + c) * SEQ + tid * 16;
#pragma unroll
                        for (int m = 0; m < 16; ++m) { zo0[m] = tm_get(gw0, m) * (yr[m] + tm_get(w0, m) * hbias); zo1[m] = tm_get(gw1, m) * (yi[m] + tm_get(w1, m) * hbias); } }
                    else {
#pragma unroll
                        for (int m = 0; m < 16; ++m) { const float zn0 = tm_get(gw0, m) * (yr[m] + z0[tid * 16 + m] * hbias), zn1 = tm_get(gw1, m) * (yi[m] + z1[tid * 16 + m] * hbias);
                            HY_OUT(b0, tid + 256 * m, zn0); HY_OUT(b1, tid + 256 * m, zn1); } } }
            HSYNC;
        }
    }
    HY_FREE;
}
constexpr int MOD_ITEMS = DEPTH * (6 * D_MODEL / 64);
__device__ __forceinline__ void mod_item(const Params& p, char* lds, int item) {
    float* sc = (float*)lds;
    float* red = sc + 5 * D_MODEL;
    const int tid = threadIdx.x, l = item / (6 * D_MODEL / 64), j0 = (item % (6 * D_MODEL / 64)) * 64;
    for (int i = tid; i < 5 * D_MODEL; i += NTHREADS) { const int r = i / D_MODEL, k = i % D_MODEL; const float v = r < BATCH ? p.c[r * D_MODEL + k] : p.c_ctx[k]; sc[i] = silu_f(v); }
    __syncthreads();
    const int col = tid & 63, kp = tid >> 6;
    const float* w = p.w_ada + ((size_t)l * D_MODEL + kp * 256) * 6 * D_MODEL + j0 + col;
    float a0 = 0.f, a1 = 0.f, a2 = 0.f, a3 = 0.f, a4 = 0.f;
#pragma unroll 8
    for (int k = 0; k < 256; ++k) { const float wv = w[(size_t)k * 6 * D_MODEL]; const int kk = kp * 256 + k;
        a0 += sc[kk] * wv; a1 += sc[D_MODEL + kk] * wv; a2 += sc[2 * D_MODEL + kk] * wv; a3 += sc[3 * D_MODEL + kk] * wv; a4 += sc[4 * D_MODEL + kk] * wv; }
    red[(kp * 5 + 0) * 64 + col] = a0; red[(kp * 5 + 1) * 64 + col] = a1; red[(kp * 5 + 2) * 64 + col] = a2; red[(kp * 5 + 3) * 64 + col] = a3; red[(kp * 5 + 4) * 64 + col] = a4;
    __syncthreads();
    for (int i = tid; i < 5 * 64; i += NTHREADS) { const int r = i / 64, cc = i % 64;
        const float v = red[(0 * 5 + r) * 64 + cc] + red[(1 * 5 + r) * 64 + cc] + red[(2 * 5 + r) * 64 + cc] + red[(3 * 5 + r) * 64 + cc];
        p.mod[((size_t)(l * (BATCH + 1) + r)) * 6 * D_MODEL + j0 + cc] = v + p.b_ada[l * 6 * D_MODEL + j0 + cc]; }
    __syncthreads();
}
constexpr int FILT_ITEMS = (SEQ / 256) * (4 * D_CH / 64);
__device__ __forceinline__ void filt_item(const Params& p, char* lds, int item) {
    float* ws = (float*)lds;
    const int tid = threadIdx.x, tb = item % (SEQ / 256), cb = item / (SEQ / 256); const int t = tb * 256 + tid, col0 = cb * 64;
#pragma unroll
    for (int i = 0; i < 16; ++i) { const int k = i * 4 + (tid >> 6), cc = tid & 63; ws[cc * 68 + k] = p.hy_w3[(size_t)k * 4 * D_CH + col0 + cc]; }
    f32x4 h[16];
#pragma unroll
    for (int i = 0; i < 16; ++i) h[i] = *(const f32x4*)(p.h2 + (size_t)t * HY_FFN + i * 4);
    __syncthreads();
    const float tn = (float)t / (float)(SEQ - 1);
    const float mind = logf(1e-2f) / 1.5f, maxd = logf(1e-2f) / 0.3f;
#pragma unroll 2
    for (int cc = 0; cc < 64; ++cc) {
        const int col = col0 + cc; const f32x4* w = (const f32x4*)(ws + cc * 68);
        float acc = p.hy_b3[col];
#pragma unroll
        for (int i = 0; i < 16; ++i) { const f32x4 wv = w[i]; acc += h[i][0] * wv[0] + h[i][1] * wv[1] + h[i][2] * wv[2] + h[i][3] * wv[3]; }
        const float delta = fabsf(mind + (float)(col % D_CH) * (maxd - mind) / (float)(D_CH - 1));
        p.HFT[(size_t)col * SEQ + t] = acc * expf(-tn * delta);
    }
    __syncthreads();
}
__device__ __forceinline__ void ph_norm(const Params& p, int l, int which, int nrows, int bid, int nb) {
    const int lane = threadIdx.x & 63, wid = threadIdx.x >> 6;
    const float* g = p.norm_g + (l * 2 + which) * D_MODEL;
    for (int row = (bid * 4 + wid) * 2; row < nrows; row += nb * 8) {
        const int row1 = row + 1 < nrows ? row + 1 : row;
        const float* xa = which == 0 ? xrow_in(p, l, row) : xrow_cur(p, row); const float* xb = which == 0 ? xrow_in(p, l, row1) : xrow_cur(p, row1);
        f32x4 va[4], vb[4]; float sa = 0.f, sb = 0.f;
#pragma unroll
        for (int j = 0; j < 4; ++j) { va[j] = *(const f32x4*)(xa + j * 256 + lane * 4); vb[j] = *(const f32x4*)(xb + j * 256 + lane * 4); }
#pragma unroll
        for (int j = 0; j < 4; ++j) { sa += va[j][0] * va[j][0] + va[j][1] * va[j][1] + va[j][2] * va[j][2] + va[j][3] * va[j][3]; sb += vb[j][0] * vb[j][0] + vb[j][1] * vb[j][1] + vb[j][2] * vb[j][2] + vb[j][3] * vb[j][3]; }
        const float ra = 1.0f / sqrtf(wave_sum(sa) * (1.0f / D_MODEL) + EPS), rb = 1.0f / sqrtf(wave_sum(sb) * (1.0f / D_MODEL) + EPS);
        const float* sha = modp(p, l, row, which * 3 + 0); const float* sca = modp(p, l, row, which * 3 + 1);
        const float* shb = modp(p, l, row1, which * 3 + 0); const float* scb = modp(p, l, row1, which * 3 + 1);
#pragma unroll
        for (int j = 0; j < 4; ++j) { const int c = j * 256 + lane * 4; const f32x4 gv = *(const f32x4*)(g + c);
            store4bf(p.hbuf + (size_t)row * D_MODEL + c, va[j] * ra * gv * (*(const f32x4*)(sca + c) + 1.0f) + *(const f32x4*)(sha + c));
            if (row1 != row) store4bf(p.hbuf + (size_t)row1 * D_MODEL + c, vb[j] * rb * gv * (*(const f32x4*)(scb + c) + 1.0f) + *(const f32x4*)(shb + c)); }
    }
}
__device__ __forceinline__ void ph_route_a(const Params& p, char* lds, int l, int nrows, int bid, int nb) {
    const int lane = threadIdx.x & 63, wid = threadIdx.x >> 6;
    float* wr_s = (float*)lds; int* hist = (int*)(lds + 65536);
    for (int i = threadIdx.x; i < D_MODEL * 4; i += NTHREADS) { const int k = i >> 2, ch = i & 3; ((f32x4*)wr_s)[k * 4 + (ch ^ ((k >> 2) & 3))] = ((const f32x4*)p.w_router)[i]; }
    if (threadIdx.x < 32) hist[threadIdx.x] = 0;
    __syncthreads();
    const int sw = (lane >> 2) & 3;
    const float* g = p.norm_g + (l * 2 + 1) * D_MODEL;
    const int RPB = (nrows + nb - 1) / nb, r0 = bid * RPB;
    for (int j = wid; j < RPB; j += 4) {
        const int row = r0 + j; if (row >= nrows) break;
        const float* xr = xrow_cur(p, row); const float* sh = modp(p, l, row, 3); const float* sc = modp(p, l, row, 4);
        float v[16]; float ss = 0.f;
#pragma unroll
        for (int i = 0; i < 16; ++i) { v[i] = xr[lane + 64 * i]; ss += v[i] * v[i]; }
        const float rstd = 1.0f / sqrtf(wave_sum(ss) * (1.0f / D_MODEL) + EPS);
        float lg[16];
#pragma unroll
        for (int e = 0; e < 16; ++e) lg[e] = 0.f;
#pragma unroll
        for (int i = 0; i < 16; ++i) { const int k = lane + 64 * i; const float o = v[i] * rstd * g[k] * (sc[k] + 1.0f) + sh[k];
            p.hbuf[(size_t)row * D_MODEL + k] = f2bf(o);
            const f32x4* w4 = (const f32x4*)(wr_s + k * 16);
#pragma unroll
            for (int e4 = 0; e4 < 4; ++e4) { const f32x4 wv = w4[e4 ^ sw]; lg[e4 * 4 + 0] += o * wv[0]; lg[e4 * 4 + 1] += o * wv[1]; lg[e4 * 4 + 2] += o * wv[2]; lg[e4 * 4 + 3] += o * wv[3]; }
            if (i & 1) __builtin_amdgcn_sched_barrier(0); }
        {
#pragma unroll
            for (int i = 0; i < 8; ++i) { const float a = lg[i], b = lg[i + 8]; const bool up = (lane & 32) != 0; const float recv = __shfl_xor(up ? a : b, 32); lg[i] = (up ? b : a) + recv; }
#pragma unroll
            for (int i = 0; i < 4; ++i) { const float a = lg[i], b = lg[i + 4]; const bool up = (lane & 16) != 0; const float recv = __shfl_xor(up ? a : b, 16); lg[i] = (up ? b : a) + recv; }
#pragma unroll
            for (int i = 0; i < 2; ++i) { const float a = lg[i], b = lg[i + 2]; const bool up = (lane & 8) != 0; const float recv = __shfl_xor(up ? a : b, 8); lg[i] = (up ? b : a) + recv; }
            { const float a = lg[0], b = lg[1]; const bool up = (lane & 4) != 0; const float recv = __shfl_xor(up ? a : b, 4); lg[0] = (up ? b : a) + recv; }
            lg[0] += __shfl_xor(lg[0], 2); lg[0] += __shfl_xor(lg[0], 1);
            const float mine = lg[0];
#pragma unroll
            for (int e = 0; e < 16; ++e) lg[e] = __builtin_bit_cast(float, __builtin_amdgcn_readlane(__builtin_bit_cast(int, mine), 4 * e));
        }
        if (lane == 0) {
            int gbest = 0, a = 0, bb = 1; float gbs = -1e30f, wa = 0.f, wb = 0.f;
#pragma unroll
            for (int gI = 0; gI < 4; ++gI) {
                float m1 = -1e30f, m2 = -1e30f, s1 = 0.f, s2 = 0.f; int i1 = 0, i2 = 0;
#pragma unroll
                for (int jj = 0; jj < 4; ++jj) { float sgv = sigmoid_f(lg[gI * 4 + jj]); float vv = sgv + p.b_router[gI * 4 + jj];
                    if (vv > m1) { m2 = m1; i2 = i1; s2 = s1; m1 = vv; i1 = jj; s1 = sgv; } else if (vv > m2) { m2 = vv; i2 = jj; s2 = sgv; } }
                float gs = m1 + m2;
                if (gs > gbs) { gbs = gs; gbest = gI; if (i1 < i2) { a = i1; bb = i2; wa = s1; wb = s2; } else { a = i2; bb = i1; wa = s2; wb = s1; } }
            }
            const float inv = 1.0f / (wa + wb);
            const int pidx = a == 0 ? bb - 1 : (a == 1 ? bb + 1 : 5);
            const int pr = gbest * 6 + pidx;
            p.rpair[row] = pr; p.tokw[row * 2 + 0] = wa * inv; p.tokw[row * 2 + 1] = wb * inv;
            atomicAdd(&hist[pr], 1);
        }
    }
    __syncthreads();
    if (threadIdx.x < 32) p.bh[bid * 32 + threadIdx.x] = hist[threadIdx.x];
}
__device__ __forceinline__ void ph_route_b(const Params& p, char* lds, int l, int nrows, int bid, int nb) {
    int* sb = (int*)lds;
    const int t = threadIdx.x, pr = t & 31, part = t >> 5;
    { int s_before = 0, s_all = 0; const int b0 = (part * nb) >> 3, b1 = ((part + 1) * nb) >> 3;
      for (int b = b0; b < b1; ++b) { const int c = p.bh[b * 32 + pr]; s_all += c; if (b < bid) s_before += c; }
      sb[part * 32 + pr] = s_before; sb[256 + part * 32 + pr] = s_all; }
    __syncthreads();
    if (t < 32) { int a = 0, c = 0;
#pragma unroll
        for (int q = 0; q < 8; ++q) { a += sb[q * 32 + t]; c += sb[256 + q * 32 + t]; }
        sb[512 + t] = a; sb[544 + t] = c; if (bid == 0) p.cnt[l * 32 + t] = c; }
    const int RPB = (nrows + nb - 1) / nb, row = bid * RPB + t; const bool act = t < RPB && row < nrows;
    int myp = 0; if (act) { myp = p.rpair[row]; sb[576 + t] = myp; }
    __syncthreads();
    if (act) { int rank = 0; for (int j = 0; j < t; ++j) rank += (sb[576 + j] == myp) ? 1 : 0; p.list[(size_t)myp * TT + sb[512 + myp] + rank] = row; }
    __syncthreads();
}
__device__ __forceinline__ void ph_final(const Params& p, int bid, int nb) {
    const int lane = threadIdx.x & 63, wid = threadIdx.x >> 6;
    for (int row = (bid * 4 + wid) * 2; row < TX; row += nb * 8) {
        float* xa = p.out + (size_t)row * D_MODEL; float* xb = xa + D_MODEL;
        f32x4 va[4], vb[4]; float sa = 0.f, sb = 0.f;
#pragma unroll
        for (int j = 0; j < 4; ++j) { va[j] = *(const f32x4*)(xa + j * 256 + lane * 4); vb[j] = *(const f32x4*)(xb + j * 256 + lane * 4); }
#pragma unroll
        for (int j = 0; j < 4; ++j) { sa += va[j][0] * va[j][0] + va[j][1] * va[j][1] + va[j][2] * va[j][2] + va[j][3] * va[j][3]; sb += vb[j][0] * vb[j][0] + vb[j][1] * vb[j][1] + vb[j][2] * vb[j][2] + vb[j][3] * vb[j][3]; }
        const float ra = 1.0f / sqrtf(wave_sum(sa) * (1.0f / D_MODEL) + EPS), rb = 1.0f / sqrtf(wave_sum(sb) * (1.0f / D_MODEL) + EPS);
#pragma unroll
        for (int j = 0; j < 4; ++j) { const int c = j * 256 + lane * 4; const f32x4 gv = *(const f32x4*)(p.final_g + c); *(f32x4*)(xa + c) = va[j] * ra * gv; *(f32x4*)(xb + c) = vb[j] * rb * gv; }
    }
}

#define XB_TMO      128
#define XB_XCNT(j)  (256  + 64 * (j))
#define XB_XSUB(j)  (1280 + 64 * (j))
#define XB_XGEN(j)  (2304 + 64 * (j))
#define XB_TOP      3328
#define XB_TOPGEN   3392
#define XCD_BAR_WORDS 3456
#define XB_SPIN_CAP (1u << 20)
__device__ __forceinline__ unsigned xb_ld(unsigned* p)              { return __hip_atomic_load(p, __ATOMIC_RELAXED, __HIP_MEMORY_SCOPE_AGENT); }
__device__ __forceinline__ unsigned xb_add(unsigned* p, unsigned v) { return __hip_atomic_fetch_add(p, v, __ATOMIC_RELAXED, __HIP_MEMORY_SCOPE_AGENT); }
__device__ __forceinline__ unsigned xb_xcc_id() { return (unsigned)__builtin_amdgcn_s_getreg((3 << 11) | 20) & 0xFu; }
#define XB_SPIN(cond, bar) do { unsigned _sp = 0; while (cond) { __builtin_amdgcn_s_sleep(1); \
    if ((++_sp & 255u) == 0u) { if (xb_ld(&(bar)[XB_TMO])) break; if (_sp > XB_SPIN_CAP) { atomicAdd(&(bar)[XB_TMO], 1u); break; } } } } while (0)
struct XcdBarrier { unsigned* bar; unsigned x; volatile LAS unsigned* st; };
__device__ __forceinline__ XcdBarrier xcd_barrier_post(unsigned* bar, volatile LAS unsigned* st) {
    XcdBarrier b; b.bar = bar; b.x = xb_xcc_id(); b.st = st;
    if (threadIdx.x == 0) (void)xb_add(&bar[XB_XCNT(b.x)], 1u);
    return b;
}
__device__ __forceinline__ void xcd_barrier_complete(unsigned* bar, unsigned x, unsigned& nloc, unsigned& nx) {
    const unsigned G = gridDim.x * gridDim.y * gridDim.z;
    unsigned sum, cnt, mine, sp = 0u;
    for (;;) {
        sum = 0u; cnt = 0u; mine = 0u;
#pragma unroll
        for (unsigned j = 0; j < 16; ++j) { const unsigned c = xb_ld(&bar[XB_XCNT(j)]); sum += c; cnt += (c > 0u) ? 1u : 0u; mine = (j == x) ? c : mine; }
        if (sum == G) break;
        __builtin_amdgcn_s_sleep(1);
        if ((++sp & 255u) == 0u) { if (xb_ld(&bar[XB_TMO])) break; if (sp > XB_SPIN_CAP) { atomicAdd(&bar[XB_TMO], 1u); break; } }
    }
    nloc = mine > 0u ? mine : 1u; nx = cnt > 0u ? cnt : 1u;
}
__device__ __forceinline__ void xcd_barrier(const XcdBarrier& b) {
    asm volatile("s_waitcnt vmcnt(0)" ::: "memory");
    __syncthreads();
    if (threadIdx.x == 0) {
        unsigned* bar = b.bar;
        __builtin_amdgcn_s_waitcnt(0);
        unsigned nloc = b.st[0], nx = b.st[1];
        if (nloc == 0u) { xcd_barrier_complete(bar, b.x, nloc, nx); b.st[0] = nloc; b.st[1] = nx; }
        const unsigned old = xb_add(&bar[XB_XSUB(b.x)], 1u);
        const unsigned gen = old / nloc;
        if (old + 1u == (gen + 1u) * nloc) {
            __builtin_amdgcn_fence(__ATOMIC_RELEASE, "agent");
            asm volatile("s_waitcnt vmcnt(0)" ::: "memory");
            const unsigned og = xb_add(&bar[XB_TOP], 1u);
            const unsigned tg = og / nx;
            if (og + 1u == (tg + 1u) * nx) xb_add(&bar[XB_TOPGEN], 1u);
            else XB_SPIN(xb_ld(&bar[XB_TOPGEN]) == tg, bar);
            __builtin_amdgcn_fence(__ATOMIC_ACQUIRE, "agent");
            xb_add(&bar[XB_XGEN(b.x)], 1u);
            asm volatile("s_waitcnt vmcnt(0)" ::: "memory");
        } else {
            XB_SPIN(xb_ld(&bar[XB_XGEN(b.x)]) == gen, bar);
            __builtin_amdgcn_fence(__ATOMIC_ACQUIRE, "agent");
            asm volatile("s_waitcnt vmcnt(0)" ::: "memory");
        }
    }
    __syncthreads();
}

__device__ __forceinline__ void ph_mix1(const Params& p, char* lds, int bid, int nb, unsigned long long* tsplit = nullptr) {
    const bool hy_first = bid >= (nb >> 1);
    for (int rep = 0; rep < 3; ++rep) {
        if (rep == 1) {
            for (int u = bid; u < NU_LAT; u += nb) { const int blk = u % (SEQ / 128), h = (u / (SEQ / 128)) % 8, b = u / (8 * (SEQ / 128)); const int s0 = blk * 128;
                attn_unit<0>(lds, p.QC + (size_t)(b * SEQ + s0) * 512 + h * 64, p.KC + (size_t)(b * 2 + h / 4) * LKV * 64, p.VCt + (size_t)(b * 2 + h / 4) * 64 * LKV,
                             p.Y + (size_t)(b * SEQ + s0) * 1024 + h * 64, s0, CTX_LEN / 64, 0, SEQ / 64, 0.f, false, nullptr); }
            if (tsplit) *tsplit = __builtin_amdgcn_s_memrealtime();
        } else if ((rep == 0) == hy_first) {
            __syncthreads();
            for (int c = hy_first ? bid - (nb >> 1) : bid + (nb >> 1); c < D_CH; c += nb) hyena_channel(p, c, (float*)lds);
            __syncthreads();
        }
    }
}
constexpr int TR_ITEMS = BATCH * (D_CH / 64) * (SEQ / 64);
__device__ __forceinline__ void tr_item(const Params& p, char* lds, int it) {
    bf16_t* T = (bf16_t*)lds; const int tid = threadIdx.x;
    const int sb = it % (SEQ / 64), cb = (it / (SEQ / 64)) % (D_CH / 64), b = it / ((SEQ / 64) * (D_CH / 64));
    { const int c = tid >> 2, q = tid & 3;
      const u32x4* src = (const u32x4*)(p.YHT + ((size_t)b * D_CH + cb * 64 + c) * SEQ + sb * 64 + q * 16);
      const u32x4 v0 = src[0], v1 = src[1]; unsigned* d = (unsigned*)(T + c * 66 + q * 16);
      d[0] = v0.x; d[1] = v0.y; d[2] = v0.z; d[3] = v0.w; d[4] = v1.x; d[5] = v1.y; d[6] = v1.z; d[7] = v1.w; }
    __syncthreads();
    { const int s = tid >> 2, q = tid & 3;
      unsigned w[8];
#pragma unroll
      for (int i = 0; i < 8; ++i) w[i] = (unsigned)T[(q * 16 + 2 * i) * 66 + s] | ((unsigned)T[(q * 16 + 2 * i + 1) * 66 + s] << 16);
      u32x4* dst = (u32x4*)(p.Y + ((size_t)b * SEQ + sb * 64 + s) * 1024 + 512 + cb * 64 + q * 16);
      dst[0] = (u32x4){w[0], w[1], w[2], w[3]}; dst[1] = (u32x4){w[4], w[5], w[6], w[7]}; }
    __syncthreads();
}
enum { PH_PREP = 0, PH_NORM0, PH_INPROJ0, PH_ATTN0, PH_OUT0, PH_ROUTE0, PH_ROUTEB0, PH_UP0, PH_DOWN0, PH_NORM1, PH_INPROJ1, PH_MIX1, PH_TR1, PH_OUT1, PH_ROUTE1, PH_ROUTEB1, PH_UP1, PH_DOWN1, PH_FINAL, PH_COUNT };
typedef const __attribute__((address_space(4))) Params* KParams;
__global__ void __launch_bounds__(NTHREADS, 2) mega(Params p_arg, int lo, int hi) {
    extern __shared__ __attribute__((aligned(16))) char lds[];
    const int bid = blockIdx.x, nb = gridDim.x;
    volatile LAS unsigned* st = (volatile LAS unsigned*)(lds + LDS_BYTES - 16);
    if (threadIdx.x < 4) st[threadIdx.x] = 0u;
    __syncthreads();
    KParams kp = (KParams)__builtin_amdgcn_kernarg_segment_ptr();
    XcdBarrier bar; bar.bar = kp->bar; bar.x = 0; bar.st = st;
    if (hi - lo > 1) bar = xcd_barrier_post(kp->bar, st);
#ifdef PROBE_PA
    unsigned long long ts_prev = __builtin_amdgcn_s_memrealtime(), t_a = 0, t_b = 0;
#define STAMP(PH) if (bid == 0 && threadIdx.x == 0) { const unsigned long long now_ = __builtin_amdgcn_s_memrealtime(); if ((PH) == PROBE_PA) t_a = now_ - ts_prev; if ((PH) == PROBE_PB) t_b = now_ - ts_prev; ts_prev = now_; }
#else
#define STAMP(PH)
#endif
#define PHASE(PH, body) if (lo <= (PH) && (PH) < hi) { { KParams kq_ = kp; asm volatile("" : "+s"(kq_)); const Params& p = *(const Params*)kq_; body; } if ((PH) + 1 < hi) xcd_barrier(bar); STAMP(PH) }
    PHASE(PH_PREP, { if (nb > MOD_ITEMS + 64) { if (bid < MOD_ITEMS) mod_item(p, lds, bid); else cvt_range(p, lds, 0, CVT_EARLY, bid - MOD_ITEMS, nb - MOD_ITEMS); }
        else { for (int it = bid; it < MOD_ITEMS; it += nb) mod_item(p, lds, it); cvt_range(p, lds, 0, CVT_EARLY, bid, nb); }
        d_rope(p); d_hy_h1(p); })
#if PROBE == 7
    PHASE(PH_NORM0, { ph_norm(p, 0, 0, TT, bid, nb); ph_norm(p, 0, 0, TT, bid, nb); ph_norm(p, 0, 0, TT, bid, nb); d_hy_h2(p); })
#else
    PHASE(PH_NORM0, { ph_norm(p, 0, 0, TT, bid, nb); d_hy_h2(p); })
#endif
#if PROBE == 1
    PHASE(PH_INPROJ0, { ph_inproj<0>(p, lds, bid, nb); __syncthreads(); ph_inproj<0>(p, lds, bid, nb); })
#else
    PHASE(PH_INPROJ0, ph_inproj<0>(p, lds, bid, nb))
#endif
#if PROBE == 2
    PHASE(PH_ATTN0, { ph_attn0(p, lds, bid, nb); __syncthreads(); ph_attn0(p, lds, bid, nb); })
#else
    PHASE(PH_ATTN0, { if (bid & 1) { cvt_range(p, lds, CVT_EARLY, CVT_TOTAL, bid, nb); __syncthreads(); ph_attn0(p, lds, bid, nb); } else { ph_attn0(p, lds, bid, nb); __syncthreads(); cvt_range(p, lds, CVT_EARLY, CVT_TOTAL, bid, nb); } })
#endif
#if PROBE == 10
    PHASE(PH_OUT0, { ph_outproj<0>(p, lds, bid, nb); __syncthreads(); ph_outproj<0>(p, lds, bid, nb); })
#elif PROBE == 11
    PHASE(PH_OUT0, { for (int i_ = 0; i_ < 10; ++i_) xcd_barrier(bar); ph_outproj<0>(p, lds, bid, nb); })
#else
    PHASE(PH_OUT0, { ph_outproj<0>(p, lds, bid, nb);
        const int rem_ = (MT_ALL * 8) % nb; __syncthreads(); if (bid >= rem_) for (int it = bid - rem_; it < FILT_ITEMS; it += nb - rem_) filt_item(p, lds, it); })
#endif
    PHASE(PH_ROUTE0, ph_route_a(p, lds, 0, TT, bid, nb))
    PHASE(PH_ROUTEB0, ph_route_b(p, lds, 0, TT, bid, nb))
#if PROBE == 9
    PHASE(PH_UP0, { ph_moe_up(p, lds, 0, bid, nb); __syncthreads(); ph_moe_up(p, lds, 0, bid, nb); })
#else
    PHASE(PH_UP0, ph_moe_up(p, lds, 0, bid, nb))
#endif
#if PROBE == 12
    PHASE(PH_DOWN0, { ph_moe_down<true>(p, lds, 0, bid, nb); __syncthreads(); ph_moe_down(p, lds, 0, bid, nb); })
#else
    PHASE(PH_DOWN0, ph_moe_down(p, lds, 0, bid, nb))
#endif
    PHASE(PH_NORM1, ph_norm(p, 1, 0, TT, bid, nb))
    PHASE(PH_INPROJ1, ph_inproj<1>(p, lds, bid, nb))
#if PROBE == 3
    PHASE(PH_MIX1, { ph_attnC(p, lds, bid, nb); __syncthreads(); ph_mix1(p, lds, bid, nb); })
#elif PROBE == 4
    PHASE(PH_MIX1, { for (int c = bid; c < D_CH; c += nb) hyena_channel(p, c, (float*)lds); __syncthreads(); ph_mix1(p, lds, bid, nb); })
#else
#if defined(PROBE_PA) && PROBE_PA == 100
    { unsigned long long tsp = 0, t0_ = __builtin_amdgcn_s_memrealtime(); ph_mix1(p, lds, bid, nb, &tsp); unsigned long long t1_ = __builtin_amdgcn_s_memrealtime(); if (bid == 0 && threadIdx.x == 0) { t_a = tsp - t0_; t_b = t1_ - tsp; } xcd_barrier(bar); }
#else
    PHASE(PH_MIX1, ph_mix1(p, lds, bid, nb))
#endif
#endif
    PHASE(PH_TR1, for (int it = bid; it < TR_ITEMS; it += nb) tr_item(p, lds, it))
    PHASE(PH_OUT1, ph_outproj<1>(p, lds, bid, nb))
    PHASE(PH_ROUTE1, ph_route_a(p, lds, 1, TX, bid, nb))
    PHASE(PH_ROUTEB1, ph_route_b(p, lds, 1, TX, bid, nb))
    PHASE(PH_UP1, ph_moe_up(p, lds, 1, bid, nb))
    PHASE(PH_DOWN1, ph_moe_down(p, lds, 1, bid, nb))
    PHASE(PH_FINAL, ph_final(p, bid, nb))
#ifdef PROBE_PA
    if (bid == 0 && threadIdx.x == 0) {
        const unsigned long long delay = 2 * t_a + 204800ull * ((t_b + 200) / 400); const unsigned long long t0 = __builtin_amdgcn_s_memrealtime();
        while (__builtin_amdgcn_s_memrealtime() - t0 < delay) __builtin_amdgcn_s_sleep(32);
    }
#endif
}
extern "C" void kernel_launch(void* const* d_in, const int* in_sizes, int n_in, void* d_out, int out_size, void* d_ws, size_t ws_size, hipStream_t stream) {
    static int grid = 0;
    if (grid == 0) {
        int dev = 0, cus = 0;
        if (hipGetDevice(&dev) != hipSuccess || hipDeviceGetAttribute(&cus, hipDeviceAttributeMultiprocessorCount, dev) != hipSuccess) { fprintf(stderr, "kernel_launch: device query failed\n"); grid = -1; return; }
        if (hipFuncSetAttribute((const void*)mega, hipFuncAttributeMaxDynamicSharedMemorySize, LDS_BYTES) != hipSuccess) { fprintf(stderr, "kernel_launch: hipFuncSetAttribute failed\n"); grid = -1; return; }
        grid = 2 * cus;
    }
    if (grid < 0) return;
    Params p{};
    size_t need = setup_ws(p, (char*)d_ws);
    if (n_in != 32 || need > ws_size || out_size != TX * D_MODEL) { fprintf(stderr, "kernel_launch: bad config n_in %d ws %zu need %zu out %d\n", n_in, ws_size, need, out_size); return; }
    fill_inputs(p, d_in, d_out);
    hipMemsetAsync(p.bar, 0, 64 * 1024 + 256, stream);
#ifdef PER_PHASE
    for (int ph = 0; ph < PH_COUNT; ++ph) mega<<<dim3(grid), dim3(NTHREADS), LDS_BYTES, stream>>>(p, ph, ph + 1);
#else
    mega<<<dim3(grid), dim3(NTHREADS), LDS_BYTES, stream>>>(p, 0, PH_COUNT);
#endif
}
```

```cpp
#include <hip/hip_runtime.h>
#include <cstdio>
#include <math.h>
#include <stdint.h>
#include <string.h>

#ifdef CPU_TEST
#define HD
#define GLOBAL
struct U3 { unsigned x, y, z; };
static thread_local U3 threadIdx, blockIdx, blockDim, gridDim;
static inline int atomicAdd(int* p, int v) { return __sync_fetch_and_add(p, v); }
#else
#define HD __device__ __forceinline__
#define GLOBAL __global__ __launch_bounds__(256)
#endif

#if defined(HY_TEST)
constexpr int D_MODEL = 64, BATCH = 2, SEQ = 4096, GRID_W = 64, CTX_LEN = 64, D_CH = 4, D_EXPERT = 64;
#elif defined(SMALL_CFG)
constexpr int D_MODEL = 128, BATCH = 2, SEQ = 512, GRID_W = 32, CTX_LEN = 64, D_CH = 32, D_EXPERT = 64;
#else
constexpr int D_MODEL = 1024, BATCH = 4, SEQ = 4096, GRID_W = 64, CTX_LEN = 256, D_CH = 512, D_EXPERT = 512;
#endif
constexpr int DEPTH = 2, HEAD_DIM = 64;
constexpr int GRID_H = SEQ / GRID_W;
constexpr int A_WINDOW = 128;
constexpr int B_WIN_H = 8, B_WIN_W = 16;
constexpr int HY_BANDS = 16, HY_EMB = 33, HY_FFN = 64;
constexpr int EVEN_IN = 2304, EVEN_OUT = 1024;
constexpr int ODD_IN = 768 + 3 * D_CH, ODD_OUT = 512 + D_CH;
constexpr int N_EXPERTS = 16;
constexpr int TX = BATCH * SEQ, TC = BATCH * CTX_LEN, TT = TX + TC;
constexpr int LKV = CTX_LEN + SEQ;
constexpr int NPAIR = 24;
constexpr int HE_W = 2 * D_EXPERT;
constexpr float EPS = 1e-6f;
constexpr float ATTN_SCALE = 0.125f;

typedef unsigned short bf16_t;
HD bf16_t f2bf(float f) { unsigned u; __builtin_memcpy(&u, &f, 4); u = (u + 0x7fffu + ((u >> 16) & 1u)) >> 16; return (bf16_t)u; }
HD float bf2f(bf16_t h) { unsigned u = ((unsigned)h) << 16; float f; __builtin_memcpy(&f, &u, 4); return f; }
HD float silu_f(float x) { return x / (1.0f + expf(-x)); }
HD float sigmoid_f(float x) { return 1.0f / (1.0f + expf(-x)); }

struct Params {
    const float *x, *c, *ctx, *c_ctx, *w_ada, *b_ada, *norm_g, *final_g, *w_in_even, *w_out_even, *a_sink, *b_rpb;
    const float *w_in_odd, *w_out_odd, *c_qnorm, *c_knorm, *hy_short_w, *hy_short_b, *hy_w1, *hy_b1, *hy_f1, *hy_w2;
    const float *hy_b2, *hy_f2, *hy_w3, *hy_b3, *hy_bias, *w_router, *b_router, *moe_wg, *moe_wu, *moe_wd;
    float* out;
    float* XC;
    float* mod;
    float* ropet;
    float* h1;
    float* h2;
    float* HFT;
    float* hnorm;
    bf16_t* hbuf;
    bf16_t *QA, *KA, *VAt, *QB, *KB, *VBt;
    bf16_t *QC, *KC, *VCt, *UT;
    bf16_t* Y;
    bf16_t* YHT;
    float* Z1;
    bf16_t* HE;
    int* cnt;
    int* list;
    float* tokw;
    bf16_t *Wt_in_even, *Wt_out_even, *Wt_in_odd, *Wt_out_odd, *Wt_gu, *Wt_d;
    unsigned* bar;
    int* rpair;
    int* bh;
    float* rlog;
};

#define GS_LOOP(i, n) for (long i = (long)blockIdx.x * blockDim.x + threadIdx.x; i < (long)(n); i += (long)gridDim.x * blockDim.x)

HD const float* xrow_in(const Params& p, int l, int row) {
    if (l == 0) return row < TX ? p.x + (size_t)row * D_MODEL : p.ctx + (size_t)(row - TX) * D_MODEL;
    return row < TX ? p.out + (size_t)row * D_MODEL : p.XC + (size_t)(row - TX) * D_MODEL;
}
HD float* xrow_cur(const Params& p, int row) { return row < TX ? p.out + (size_t)row * D_MODEL : p.XC + (size_t)(row - TX) * D_MODEL; }
HD int row_mod(int row) { return row < TX ? row / SEQ : BATCH; }
HD const float* modp(const Params& p, int l, int row, int which) { return p.mod + ((size_t)(l * (BATCH + 1) + row_mod(row)) * 6 + which) * D_MODEL; }

GLOBAL void nk_mod(Params p) {
    GS_LOOP(i, DEPTH * (BATCH + 1) * 6 * D_MODEL) {
        int j = i % (6 * D_MODEL); int r = (i / (6 * D_MODEL)) % (BATCH + 1); int l = i / (6 * D_MODEL * (BATCH + 1));
        const float* cv = r < BATCH ? p.c + r * D_MODEL : p.c_ctx;
        const float* w = p.w_ada + (size_t)l * D_MODEL * 6 * D_MODEL;
        float acc = 0.f;
        for (int k = 0; k < D_MODEL; ++k) acc += silu_f(cv[k]) * w[(size_t)k * 6 * D_MODEL + j];
        p.mod[i] = acc + p.b_ada[l * 6 * D_MODEL + j];
    }
}
HD void d_rope(const Params& p) {
    GS_LOOP(i, 64 * 16) {
        int pos = i / 16, k = i % 16;
        float inv = powf(10000.0f, -(float)(2 * k) / 32.0f);
        float a = (float)pos * inv;
        p.ropet[pos * 32 + k] = cosf(a); p.ropet[pos * 32 + 16 + k] = sinf(a);
    }
}
HD void d_hy_h1(const Params& p) {
    GS_LOOP(i, SEQ * HY_FFN) {
        int t = i / HY_FFN, k = i % HY_FFN;
        float tn = (float)t / (float)(SEQ - 1);
        float acc = tn * p.hy_w1[0 * HY_FFN + k];
        for (int b = 0; b < HY_BANDS; ++b) {
            float band = 1e-4f + (float)b * ((float)(HY_BANDS - 1) - 1e-4f) / (float)(HY_BANDS - 1);
            float ang = 2.0f * 3.14159265358979323846f * (float)t * band / (float)SEQ;
            acc += cosf(ang) * p.hy_w1[(1 + b) * HY_FFN + k] + sinf(ang) * p.hy_w1[(1 + HY_BANDS + b) * HY_FFN + k];
        }
        p.h1[i] = sinf(p.hy_f1[k] * (acc + p.hy_b1[k]));
    }
}
HD void d_hy_h2(const Params& p) {
    GS_LOOP(i, SEQ * HY_FFN) {
        int t = i / HY_FFN, j = i % HY_FFN;
        float acc = 0.f;
        for (int k = 0; k < HY_FFN; ++k) acc += p.h1[t * HY_FFN + k] * p.hy_w2[k * HY_FFN + j];
        p.h2[i] = sinf(p.hy_f2[j] * (acc + p.hy_b2[j]));
    }
}
HD float hy_decay(int t, int c) {
    const float mind = logf(1e-2f) / 1.5f, maxd = logf(1e-2f) / 0.3f;
    float delta = fabsf(mind + (float)c * (maxd - mind) / (float)(D_CH - 1));
    float tn = (float)t / (float)(SEQ - 1);
    return expf(-tn * delta);
}
GLOBAL void nk_hy_filt(Params p) {
    GS_LOOP(i, 4 * D_CH * SEQ) {
        int t = i % SEQ, col = i / SEQ, c = col % D_CH;
        float acc = p.hy_b3[col];
        for (int k = 0; k < HY_FFN; ++k) acc += p.h2[t * HY_FFN + k] * p.hy_w3[k * 4 * D_CH + col];
        p.HFT[i] = acc * hy_decay(t, c);
    }
}
GLOBAL void nk_hy_norm(Params p) {
    GS_LOOP(i, 2 * D_CH) {
        int o = i / D_CH, c = i % D_CH;
        float s = 0.f;
        for (int dir = 0; dir < 2; ++dir) { const float* h = p.HFT + (size_t)((dir * 2 + o) * D_CH + c) * SEQ; for (int t = 0; t < SEQ; ++t) s += fabsf(h[t]); }
        p.hnorm[i] = s + EPS;
    }
}
GLOBAL void nk_zero_cnt(Params p) { GS_LOOP(i, 64) p.cnt[i] = 0; }

GLOBAL void nk_norm(Params p, int l, int which, int nrows) {
    GS_LOOP(row, nrows) {
        const float* xr = which == 0 ? xrow_in(p, l, (int)row) : xrow_cur(p, (int)row);
        float ss = 0.f;
        for (int k = 0; k < D_MODEL; ++k) ss += xr[k] * xr[k];
        float rstd = 1.0f / sqrtf(ss / D_MODEL + EPS);
        const float* g = p.norm_g + (l * 2 + which) * D_MODEL;
        const float* sh = modp(p, l, (int)row, which * 3 + 0); const float* sc = modp(p, l, (int)row, which * 3 + 1);
        for (int k = 0; k < D_MODEL; ++k) p.hbuf[row * D_MODEL + k] = f2bf(xr[k] * rstd * g[k] * (1.0f + sc[k]) + sh[k]);
    }
}

HD float dot_row(const bf16_t* a, const float* W, int ldw, int col, int K) {
    float acc = 0.f;
    for (int k = 0; k < K; ++k) acc += bf2f(a[k]) * W[(size_t)k * ldw + col];
    return acc;
}
HD float rope_apply(const Params& p, float v, float partner, int d, int s) {
    int half = d >> 5, dd = d & 31, k = dd & 15;
    int pos = half == 0 ? s / GRID_W : s % GRID_W;
    float c = p.ropet[pos * 32 + k], sn = p.ropet[pos * 32 + 16 + k];
    return dd < 16 ? v * c - partner * sn : v * c + partner * sn;
}

GLOBAL void nk_inproj_even(Params p) {
    GS_LOOP(i, (long)TT * EVEN_IN) {
        int row = i / EVEN_IN, col = i % EVEN_IN;
        const bf16_t* a = p.hbuf + (size_t)row * D_MODEL;
        float v = dot_row(a, p.w_in_even, EVEN_IN, col, D_MODEL);
        bool lat = row < TX; int b = lat ? row / SEQ : (row - TX) / CTX_LEN; int s = lat ? row % SEQ : (row - TX) % CTX_LEN;
        int pos = lat ? CTX_LEN + s : s;
        if (col < 640) {
            int d = col & 63;
            if (lat) { int pc = (d & 31) < 16 ? col + 16 : col - 16; float pv = dot_row(a, p.w_in_even, EVEN_IN, pc, D_MODEL); v = rope_apply(p, v, pv, d, s); }
            if (col < 512) p.QA[(size_t)row * 512 + col] = f2bf(v);
            else { int h = (col - 512) >> 6; p.KA[((size_t)(b * 2 + h) * LKV + pos) * 64 + d] = f2bf(v); }
        } else if (col < 768) { int h = (col - 640) >> 6, d = col & 63; p.VAt[((size_t)(b * 2 + h) * 64 + d) * LKV + pos] = f2bf(v); }
        else if (col < 1280) p.QB[(size_t)row * 512 + (col - 768)] = f2bf(v);
        else if (col < 1792) { int h = (col - 1280) >> 6, d = col & 63; p.KB[((size_t)(b * 8 + h) * LKV + pos) * 64 + d] = f2bf(v); }
        else { int h = (col - 1792) >> 6, d = col & 63; p.VBt[((size_t)(b * 8 + h) * 64 + d) * LKV + pos] = f2bf(v); }
    }
}

struct OSM { float m, l; };
#define ATT_BEGIN() float q[64], acc[64]; for (int d = 0; d < 64; ++d) { q[d] = bf2f(qp[d]) * ATTN_SCALE; acc[d] = 0.f; } float m_ = -1e30f, l_ = 0.f;
#define ATT_KEY(Kp, Vt, key, bias) do { const bf16_t* kk_ = (Kp) + (size_t)(key) * 64; float s_ = (bias); for (int d = 0; d < 64; ++d) s_ += q[d] * bf2f(kk_[d]); \
    float mn_ = fmaxf(m_, s_); float f_ = expf(m_ - mn_), pe_ = expf(s_ - mn_); l_ = l_ * f_ + pe_; \
    for (int d = 0; d < 64; ++d) acc[d] = acc[d] * f_ + pe_ * bf2f((Vt)[(size_t)d * LKV + (key)]); m_ = mn_; } while (0)
#define ATT_SINK(sv) do { float s_ = (sv); float mn_ = fmaxf(m_, s_); float f_ = expf(m_ - mn_); l_ = l_ * f_ + expf(s_ - mn_); for (int d = 0; d < 64; ++d) acc[d] *= f_; m_ = mn_; } while (0)

GLOBAL void nk_attnA(Params p) {
    GS_LOOP(i, (long)TX * 8) {
        int h = i % 8, row = i / 8, b = row / SEQ, s = row % SEQ, kvh = h / 4;
        const bf16_t* qp = p.QA + (size_t)row * 512 + h * 64;
        const bf16_t* Kp = p.KA + (size_t)(b * 2 + kvh) * LKV * 64; const bf16_t* Vt = p.VAt + (size_t)(b * 2 + kvh) * 64 * LKV;
        ATT_BEGIN();
        for (int j = 0; j < CTX_LEN; ++j) ATT_KEY(Kp, Vt, j, 0.f);
        int lo = s - A_WINDOW < 0 ? 0 : s - A_WINDOW, hi = s + A_WINDOW > SEQ - 1 ? SEQ - 1 : s + A_WINDOW;
        for (int j = lo; j <= hi; ++j) ATT_KEY(Kp, Vt, CTX_LEN + j, 0.f);
        ATT_SINK(p.a_sink[h]);
        for (int d = 0; d < 64; ++d) p.Y[(size_t)row * 1024 + h * 64 + d] = f2bf(acc[d] / l_);
    }
}
GLOBAL void nk_attnB(Params p) {
    GS_LOOP(i, (long)TX * 8) {
        int h = i % 8, row = i / 8, b = row / SEQ, s = row % SEQ, r = s / GRID_W, cq = s % GRID_W;
        const bf16_t* qp = p.QB + (size_t)row * 512 + h * 64;
        const bf16_t* Kp = p.KB + (size_t)(b * 8 + h) * LKV * 64; const bf16_t* Vt = p.VBt + (size_t)(b * 8 + h) * 64 * LKV;
        ATT_BEGIN();
        for (int j = 0; j < CTX_LEN; ++j) ATT_KEY(Kp, Vt, j, 0.f);
        int kh = B_WIN_H < GRID_H ? B_WIN_H : GRID_H;
        int rs = r - kh / 2; if (rs < 0) rs = 0; if (rs > GRID_H - kh) rs = GRID_H - kh;
        int cs = cq - B_WIN_W / 2; if (cs < 0) cs = 0; if (cs > GRID_W - B_WIN_W) cs = GRID_W - B_WIN_W;
        for (int kr = rs; kr < rs + kh; ++kr)
            for (int kc = cs; kc < cs + B_WIN_W; ++kc) {
                int dr = kr - r, dc = kc - cq;
                float bias = p.b_rpb[(h * (2 * B_WIN_H - 1) + dr + B_WIN_H - 1) * (2 * B_WIN_W - 1) + dc + B_WIN_W - 1];
                ATT_KEY(Kp, Vt, CTX_LEN + kr * GRID_W + kc, bias);
            }
        for (int d = 0; d < 64; ++d) p.Y[(size_t)row * 1024 + 512 + h * 64 + d] = f2bf(acc[d] / l_);
    }
}
GLOBAL void nk_attn_ctx(Params p) {
    GS_LOOP(i, (long)TC * 16) {
        int hh = i % 16, rc = i / 16, ty = hh / 8, h = hh % 8, b = rc / CTX_LEN; int row = TX + rc;
        const bf16_t* qp = (ty == 0 ? p.QA : p.QB) + (size_t)row * 512 + h * 64;
        const bf16_t* Kp = ty == 0 ? p.KA + (size_t)(b * 2 + h / 4) * LKV * 64 : p.KB + (size_t)(b * 8 + h) * LKV * 64;
        const bf16_t* Vt = ty == 0 ? p.VAt + (size_t)(b * 2 + h / 4) * 64 * LKV : p.VBt + (size_t)(b * 8 + h) * 64 * LKV;
        ATT_BEGIN();
        for (int j = 0; j < CTX_LEN; ++j) ATT_KEY(Kp, Vt, j, 0.f);
        if (ty == 0) ATT_SINK(p.a_sink[h]);
        for (int d = 0; d < 64; ++d) p.Y[(size_t)row * 1024 + ty * 512 + h * 64 + d] = f2bf(acc[d] / l_);
    }
}
GLOBAL void nk_attnC(Params p) {
    GS_LOOP(i, (long)TX * 8) {
        int h = i % 8, row = i / 8, b = row / SEQ, kvh = h / 4;
        const bf16_t* qp = p.QC + (size_t)row * 512 + h * 64;
        const bf16_t* Kp = p.KC + (size_t)(b * 2 + kvh) * LKV * 64; const bf16_t* Vt = p.VCt + (size_t)(b * 2 + kvh) * 64 * LKV;
        ATT_BEGIN();
        for (int j = 0; j < LKV; ++j) ATT_KEY(Kp, Vt, j, 0.f);
        for (int d = 0; d < 64; ++d) p.Y[(size_t)row * 1024 + h * 64 + d] = f2bf(acc[d] / l_);
    }
}

GLOBAL void nk_outproj_even(Params p) {
    GS_LOOP(i, (long)TT * D_MODEL) {
        int row = i / D_MODEL, col = i % D_MODEL;
        float acc = dot_row(p.Y + (size_t)row * 1024, p.w_out_even, D_MODEL, col, EVEN_OUT);
        xrow_cur(p, row)[col] = xrow_in(p, 0, row)[col] + modp(p, 0, row, 2)[col] * acc;
    }
}
GLOBAL void nk_outproj_odd(Params p) {
    GS_LOOP(i, (long)TX * D_MODEL) {
        int row = i / D_MODEL, col = i % D_MODEL, b = row / SEQ, s = row % SEQ;
        float acc = dot_row(p.Y + (size_t)row * 1024, p.w_out_odd, D_MODEL, col, 512);
        for (int c = 0; c < D_CH; ++c) acc += bf2f(p.YHT[((size_t)b * D_CH + c) * SEQ + s]) * p.w_out_odd[(size_t)(512 + c) * D_MODEL + col];
        p.out[i] = p.out[i] + modp(p, 1, row, 2)[col] * acc;
    }
}

GLOBAL void nk_router(Params p, int l, int nrows) {
    GS_LOOP(row, nrows) {
        const float* xr = xrow_cur(p, (int)row);
        float ss = 0.f;
        for (int k = 0; k < D_MODEL; ++k) ss += xr[k] * xr[k];
        float rstd = 1.0f / sqrtf(ss / D_MODEL + EPS);
        const float* g = p.norm_g + (l * 2 + 1) * D_MODEL; const float* sh = modp(p, l, (int)row, 3); const float* sc = modp(p, l, (int)row, 4);
        float lg[16];
#pragma unroll
        for (int e = 0; e < 16; ++e) lg[e] = 0.f;
        for (int k = 0; k < D_MODEL; ++k) { float hv = xr[k] * rstd * g[k] * (1.0f + sc[k]) + sh[k];
#pragma unroll
            for (int e = 0; e < 16; ++e) lg[e] += hv * p.w_router[k * 16 + e]; }
        int gbest = 0, a = 0, bb = 1; float gbs = -1e30f, wa = 0.f, wb = 0.f;
#pragma unroll
        for (int gI = 0; gI < 4; ++gI) {
            float m1 = -1e30f, m2 = -1e30f, s1 = 0.f, s2 = 0.f; int i1 = 0, i2 = 0;
#pragma unroll
            for (int j = 0; j < 4; ++j) { float sgv = sigmoid_f(lg[gI * 4 + j]); float v = sgv + p.b_router[gI * 4 + j];
                if (v > m1) { m2 = m1; i2 = i1; s2 = s1; m1 = v; i1 = j; s1 = sgv; } else if (v > m2) { m2 = v; i2 = j; s2 = sgv; } }
            float gs = m1 + m2;
            if (gs > gbs) { gbs = gs; gbest = gI; if (i1 < i2) { a = i1; bb = i2; wa = s1; wb = s2; } else { a = i2; bb = i1; wa = s2; wb = s1; } }
        }
        float inv = 1.0f / (wa + wb);
        int pidx = a == 0 ? bb - 1 : (a == 1 ? bb + 1 : 5);
        int pr = gbest * 6 + pidx;
        int pos = atomicAdd(p.cnt + l * 32 + pr, 1);
        p.list[(size_t)pr * TT + pos] = (int)row;
        p.tokw[row * 2 + 0] = wa * inv; p.tokw[row * 2 + 1] = wb * inv;
    }
}
HD void pair_experts(int pr, int& e1, int& e2) { int g = pr / 6, q = pr % 6; int a = q < 3 ? 0 : (q < 5 ? 1 : 2); int b = q < 3 ? q + 1 : (q < 5 ? q - 1 : 3); e1 = g * 4 + a; e2 = g * 4 + b; }
HD bool slot_lookup(const Params& p, int l, int slot, int& pr, int& row) { int acc = 0; for (int q = 0; q < NPAIR; ++q) { int c = p.cnt[l * 32 + q]; if (slot < acc + c) { pr = q; row = p.list[(size_t)q * TT + (slot - acc)]; return true; } acc += c; } return false; }
GLOBAL void nk_moe_up(Params p, int l, int nrows) {
    GS_LOOP(i, (long)nrows * HE_W) {
        int slot = i / HE_W, j = i % HE_W, k = j / D_EXPERT, jj = j % D_EXPERT; int pr, row; if (!slot_lookup(p, l, slot, pr, row)) continue;
        int e1, e2; pair_experts(pr, e1, e2); int e = k == 0 ? e1 : e2;
        const bf16_t* a = p.hbuf + (size_t)row * D_MODEL;
        const float* wg = p.moe_wg + (size_t)(l * N_EXPERTS + e) * D_MODEL * D_EXPERT; const float* wu = p.moe_wu + (size_t)(l * N_EXPERTS + e) * D_MODEL * D_EXPERT;
        float g = dot_row(a, wg, D_EXPERT, jj, D_MODEL), u = dot_row(a, wu, D_EXPERT, jj, D_MODEL);
        p.HE[(size_t)row * HE_W + j] = f2bf(p.tokw[row * 2 + k] * silu_f(g) * u);
    }
}
GLOBAL void nk_moe_down(Params p, int l, int nrows) {
    GS_LOOP(i, (long)nrows * D_MODEL) {
        int slot = i / D_MODEL, col = i % D_MODEL; int pr, row; if (!slot_lookup(p, l, slot, pr, row)) continue;
        int e1, e2; pair_experts(pr, e1, e2);
        const bf16_t* a = p.HE + (size_t)row * HE_W;
        float acc = dot_row(a, p.moe_wd + (size_t)(l * N_EXPERTS + e1) * D_EXPERT * D_MODEL, D_MODEL, col, D_EXPERT)
                  + dot_row(a + D_EXPERT, p.moe_wd + (size_t)(l * N_EXPERTS + e2) * D_EXPERT * D_MODEL, D_MODEL, col, D_EXPERT);
        float* xr = xrow_cur(p, row);
        xr[col] = xr[col] + modp(p, l, row, 5)[col] * acc;
    }
}

GLOBAL void nk_inproj_odd_qk(Params p) {
    GS_LOOP(i, (long)TT * 10) {
        int row = i / 10, hu = i % 10; const bf16_t* a = p.hbuf + (size_t)row * D_MODEL;
        bool lat = row < TX; int b = lat ? row / SEQ : (row - TX) / CTX_LEN; int s = lat ? row % SEQ : (row - TX) % CTX_LEN; int pos = lat ? CTX_LEN + s : s;
        int col0 = hu * 64;
        float v[64]; float ss = 0.f;
        for (int d = 0; d < 64; ++d) { v[d] = dot_row(a, p.w_in_odd, ODD_IN, col0 + d, D_MODEL); ss += v[d] * v[d]; }
        float rstd = 1.0f / sqrtf(ss / 64.0f + EPS);
        const float* gn = hu < 8 ? p.c_qnorm : p.c_knorm;
        for (int d = 0; d < 64; ++d) v[d] = v[d] * rstd * gn[d];
        for (int d = 0; d < 64; ++d) {
            float o = v[d];
            if (lat) { int pd = (d & 31) < 16 ? d + 16 : d - 16; o = rope_apply(p, v[d], v[pd], d, s); }
            if (hu < 8) p.QC[(size_t)row * 512 + col0 + d] = f2bf(o);
            else p.KC[((size_t)(b * 2 + (hu - 8)) * LKV + pos) * 64 + d] = f2bf(o);
        }
    }
}
GLOBAL void nk_inproj_odd_vu(Params p) {
    GS_LOOP(i, (long)TT * (ODD_IN - 640)) {
        int row = i / (ODD_IN - 640), col = 640 + i % (ODD_IN - 640); const bf16_t* a = p.hbuf + (size_t)row * D_MODEL;
        bool lat = row < TX; int b = lat ? row / SEQ : (row - TX) / CTX_LEN; int s = lat ? row % SEQ : (row - TX) % CTX_LEN; int pos = lat ? CTX_LEN + s : s;
        if (col >= 768 && !lat) continue;
        float v = dot_row(a, p.w_in_odd, ODD_IN, col, D_MODEL);
        if (col < 768) { int h = (col - 640) >> 6, d = col & 63; p.VCt[((size_t)(b * 2 + h) * 64 + d) * LKV + pos] = f2bf(v); }
        else p.UT[((size_t)b * 3 * D_CH + (col - 768)) * SEQ + s] = f2bf(v);
    }
}

HD float hy_sc(const Params& p, int b, int ch, int t) {
    const bf16_t* u = p.UT + ((size_t)b * 3 * D_CH + ch) * SEQ;
    float acc = p.hy_short_b[ch];
    for (int kk = 0; kk < 3; ++kk) { int tt = t + kk - 1; if (tt >= 0 && tt < SEQ) acc += p.hy_short_w[kk * 3 * D_CH + ch] * bf2f(u[tt]); }
    return acc;
}
GLOBAL void nk_hy_conv(Params p, int o) {
    GS_LOOP(i, (long)BATCH * D_CH * SEQ) {
        int n = i % SEQ, c = (i / SEQ) % D_CH, b = i / ((long)SEQ * D_CH);
        const float* hf = p.HFT + (size_t)((0 * 2 + o) * D_CH + c) * SEQ; const float* hb = p.HFT + (size_t)((1 * 2 + o) * D_CH + c) * SEQ;
        float inv = 1.0f / p.hnorm[o * D_CH + c];
        float acc = 0.f;
        for (int m = 0; m < SEQ; ++m) {
            float z = o == 0 ? hy_sc(p, b, c, m) : p.Z1[((size_t)b * D_CH + c) * SEQ + m];
            int d = n - m; float hv = d >= 0 ? hf[d] : hb[-d];
            acc += hv * z;
        }
        acc *= inv;
        float zn = o == 0 ? hy_sc(p, b, c, n) : p.Z1[((size_t)b * D_CH + c) * SEQ + n];
        float g = hy_sc(p, b, (o + 1) * D_CH + c, n);
        float r = g * (acc + zn * p.hy_bias[o * D_CH + c]);
        if (o == 0) p.Z1[i] = r; else p.YHT[i] = f2bf(r);
    }
}

GLOBAL void nk_final(Params p) {
    GS_LOOP(row, TX) {
        float* xr = p.out + (size_t)row * D_MODEL; float ss = 0.f;
        for (int k = 0; k < D_MODEL; ++k) ss += xr[k] * xr[k];
        float rstd = 1.0f / sqrtf(ss / D_MODEL + EPS);
        for (int k = 0; k < D_MODEL; ++k) xr[k] = xr[k] * rstd * p.final_g[k];
    }
}
GLOBAL void nk_yht_to_y(Params p) {
    GS_LOOP(i, (long)TX * D_CH) { int row = i / D_CH, c = i % D_CH, b = row / SEQ, s = row % SEQ; p.Y[(size_t)row * 1024 + 512 + c] = p.YHT[((size_t)b * D_CH + c) * SEQ + s]; }
}

GLOBAL void nk_rope(Params p) { d_rope(p); }
GLOBAL void nk_hy_h1(Params p) { d_hy_h1(p); }
GLOBAL void nk_hy_h2(Params p) { d_hy_h2(p); }
static inline size_t al256(size_t x) { return (x + 255) & ~(size_t)255; }
static size_t setup_ws(Params& p, char* ws) {
    size_t o = 0;
    auto take = [&](size_t bytes) { char* r = ws + o; o += al256(bytes); return r; };
    p.bar = (unsigned*)take(64 * 1024);
    p.cnt = (int*)take(256);
    p.XC = (float*)take((size_t)TC * D_MODEL * 4);
    p.mod = (float*)take((size_t)DEPTH * (BATCH + 1) * 6 * D_MODEL * 4);
    p.ropet = (float*)take(64 * 32 * 4);
    p.h1 = (float*)take((size_t)SEQ * 64 * 4);
    p.h2 = (float*)take((size_t)SEQ * 64 * 4);
    p.HFT = (float*)take((size_t)4 * D_CH * SEQ * 4);
    p.hnorm = (float*)take(2 * D_CH * 4);
    p.list = (int*)take((size_t)NPAIR * TT * 4);
    p.tokw = (float*)take((size_t)TT * 2 * 4);
    p.rpair = (int*)take((size_t)TT * 4);
    p.bh = (int*)take((size_t)2048 * 32 * 4);
    p.rlog = (float*)take((size_t)TT * 16 * 4);
    size_t hb = (size_t)TT * D_MODEL * 2, z1 = (size_t)BATCH * D_CH * SEQ * 4;
    char* r0 = take(hb > z1 ? hb : z1); p.hbuf = (bf16_t*)r0; p.Z1 = (float*)r0;
    size_t q = al256((size_t)TT * 512 * 2), kva = al256((size_t)BATCH * 2 * LKV * 64 * 2), kvb = al256((size_t)BATCH * 8 * LKV * 64 * 2), ut = al256((size_t)BATCH * 3 * D_CH * SEQ * 2);
    size_t l0 = 2 * q + 2 * kva + 2 * kvb, l1 = q + 2 * kva + ut;
    char* R = take(l0 > l1 ? l0 : l1);
    p.QA = (bf16_t*)R; p.KA = (bf16_t*)(R + q); p.VAt = (bf16_t*)(R + q + kva); p.QB = (bf16_t*)(R + q + 2 * kva); p.KB = (bf16_t*)(R + 2 * q + 2 * kva); p.VBt = (bf16_t*)(R + 2 * q + 2 * kva + kvb);
    p.QC = (bf16_t*)R; p.KC = (bf16_t*)(R + q); p.VCt = (bf16_t*)(R + q + kva); p.UT = (bf16_t*)(R + q + 2 * kva);
    size_t yb = (size_t)TT * 1024 * 2, heb = (size_t)TT * HE_W * 2;
    char* r1 = take(yb > heb ? yb : heb); p.Y = (bf16_t*)r1; p.HE = (bf16_t*)r1;
    p.YHT = (bf16_t*)take((size_t)BATCH * D_CH * SEQ * 2);
    p.Wt_in_even = (bf16_t*)take((size_t)EVEN_IN * D_MODEL * 2);
    p.Wt_out_even = (bf16_t*)take((size_t)D_MODEL * EVEN_OUT * 2);
    p.Wt_in_odd = (bf16_t*)take((size_t)ODD_IN * D_MODEL * 2);
    p.Wt_out_odd = (bf16_t*)take((size_t)D_MODEL * ODD_OUT * 2);
    p.Wt_gu = (bf16_t*)take((size_t)DEPTH * N_EXPERTS * 2 * D_EXPERT * D_MODEL * 2);
    p.Wt_d = (bf16_t*)take((size_t)DEPTH * N_EXPERTS * D_MODEL * D_EXPERT * 2);
    return o;
}
static void fill_inputs(Params& p, void* const* d_in, void* d_out) {
    const float** f = (const float**)&p.x;
    for (int i = 0; i < 32; ++i) f[i] = (const float*)d_in[i];
    p.out = (float*)d_out;
}
#define LAS __attribute__((address_space(3)))
typedef short bf16x8 __attribute__((ext_vector_type(8)));
typedef float f32x4 __attribute__((ext_vector_type(4)));
typedef float f32x16 __attribute__((ext_vector_type(16)));
typedef unsigned u32x4 __attribute__((ext_vector_type(4)));
typedef unsigned u32x2 __attribute__((ext_vector_type(2)));

constexpr int NTHREADS = 256;
constexpr int LDS_BYTES = 69632;
constexpr int MT_ALL = TT / 128, MT_LAT = TX / 128;

__device__ __forceinline__ unsigned pk2bf(float lo, float hi) { return (unsigned)f2bf(lo) | ((unsigned)f2bf(hi) << 16); }
__device__ __forceinline__ float wave_sum(float v) {
#pragma unroll
    for (int o = 1; o < 64; o <<= 1) v += __shfl_xor(v, o);
    return v;
}

template <class DstF>
__device__ __forceinline__ void cvt_block_item(char* lds, const float* W, int N, int k0, int n0, const DstF& dst) {
    float* T = (float*)lds; const int tid = threadIdx.x;
    f32x4 v[16];
#pragma unroll
    for (int i = 0; i < 16; ++i) v[i] = *(const f32x4*)(W + (size_t)(k0 + (tid >> 6) + 4 * i) * N + n0 + 4 * (tid & 63));
#pragma unroll
    for (int i = 0; i < 16; ++i) *(f32x4*)(T + ((tid >> 6) + 4 * i) * 260 + 4 * (tid & 63)) = v[i];
    __syncthreads();
    bf16_t* d = dst(n0 + tid) + k0; const float* s = T + tid;
#pragma unroll
    for (int c = 0; c < 8; ++c) { u32x4 w; w.x = pk2bf(s[(8 * c + 0) * 260], s[(8 * c + 1) * 260]); w.y = pk2bf(s[(8 * c + 2) * 260], s[(8 * c + 3) * 260]);
        w.z = pk2bf(s[(8 * c + 4) * 260], s[(8 * c + 5) * 260]); w.w = pk2bf(s[(8 * c + 6) * 260], s[(8 * c + 7) * 260]); *(u32x4*)(d + 8 * c) = w; }
    __syncthreads();
}
__device__ __forceinline__ void cvt_plain(char* lds, const float* W, bf16_t* Wt, int K, int N, int item) {
    const int nb = N / 256, kb = item / nb, nbi = item % nb;
    cvt_block_item(lds, W, N, kb * 64, nbi * 256, [&](int n) { return Wt + (size_t)n * K; });
}
constexpr int CVT_IN = (D_MODEL / 64) * (EVEN_IN / 256), CVT_OUT = (D_MODEL / 64) * (D_MODEL / 256), CVT_GU1 = (D_MODEL / 64) * (D_EXPERT / 256), CVT_D1 = (D_EXPERT / 64) * (D_MODEL / 256);
constexpr int CVT_GU = DEPTH * N_EXPERTS * 2 * CVT_GU1, CVT_D = DEPTH * N_EXPERTS * CVT_D1;
constexpr int CVT_TOTAL = 2 * CVT_IN + 2 * CVT_OUT + CVT_GU + CVT_D;
constexpr int CVT_EARLY = 2 * CVT_IN + 2 * CVT_OUT;
static_assert(EVEN_IN % 256 == 0 && ODD_IN % 256 == 0 && D_EXPERT % 256 == 0, "conversion tile");
__device__ __forceinline__ void cvt_item(const Params& p, char* lds, int it) {
    if (it < CVT_IN) { cvt_plain(lds, p.w_in_even, p.Wt_in_even, D_MODEL, EVEN_IN, it); return; } it -= CVT_IN;
    if (it < CVT_IN) { cvt_plain(lds, p.w_in_odd, p.Wt_in_odd, D_MODEL, ODD_IN, it); return; } it -= CVT_IN;
    if (it < CVT_OUT) { cvt_plain(lds, p.w_out_even, p.Wt_out_even, EVEN_OUT, D_MODEL, it); return; } it -= CVT_OUT;
    if (it < CVT_OUT) { cvt_plain(lds, p.w_out_odd, p.Wt_out_odd, ODD_OUT, D_MODEL, it); return; } it -= CVT_OUT;
    if (it < CVT_GU) {
        const int le = it / (2 * CVT_GU1), r = it % (2 * CVT_GU1), half = r / CVT_GU1, r2 = r % CVT_GU1; const int nb = D_EXPERT / 256, kb = r2 / nb, nbi = r2 % nb;
        const float* W = (half ? p.moe_wu : p.moe_wg) + (size_t)le * D_MODEL * D_EXPERT; bf16_t* Wt = p.Wt_gu + (size_t)le * 2 * D_EXPERT * D_MODEL;
        cvt_block_item(lds, W, D_EXPERT, kb * 64, nbi * 256, [&](int n) { return Wt + (size_t)(32 * (n >> 4) + 16 * half + (n & 15)) * D_MODEL; });
        return; } it -= CVT_GU;
    { const int le = it / CVT_D1, r = it % CVT_D1; cvt_plain(lds, p.moe_wd + (size_t)le * D_EXPERT * D_MODEL, p.Wt_d + (size_t)le * D_MODEL * D_EXPERT, D_EXPERT, D_MODEL, r); }
}
__device__ __forceinline__ void cvt_range(const Params& p, char* lds, int lo, int hi, int bid, int nb) {
    for (int it = lo + bid; it < hi; it += nb) cvt_item(p, lds, it);
}

struct TileGeom { int tid, lane, wid, wr, wc, l15, q, srow, schunk;
    __device__ __forceinline__ int drow(int i) const { return wid * 32 + i * 8 + (lane >> 3); }
    __device__ __forceinline__ int dchunk(int i) const { return (lane & 7) ^ (((lane >> 4) + 4 * i) & 7); } };
__device__ __forceinline__ TileGeom tile_geom() { TileGeom g; g.tid = threadIdx.x; g.lane = g.tid & 63; g.wid = __builtin_amdgcn_readfirstlane(g.tid >> 6); g.wr = g.wid >> 1; g.wc = g.wid & 1; g.l15 = g.lane & 15; g.q = g.lane >> 4; g.srow = g.tid >> 3; g.schunk = g.tid & 7; return g; }

template <class ALoad, class BLoad>
__device__ __forceinline__ void gemm_mainloop(char* lds, const TileGeom& g, int nk, const ALoad& AL, const BLoad& BL, f32x4 (&acc)[4][4]) {
#pragma unroll
    for (int i = 0; i < 4; ++i)
#pragma unroll
        for (int j = 0; j < 4; ++j) acc[i][j] = (f32x4){0.f, 0.f, 0.f, 0.f};
    const int swz = g.l15 >> 1;
    const int aofs = (g.wr * 64 + g.l15) * 128 + ((g.q ^ swz) << 4);
    const int bofs = 32768 + (g.wc * 64 + g.l15) * 128 + ((g.q ^ swz) << 4);
    LAS char* l3 = (LAS char*)lds;
    const int dbase = g.wid * 4096;
#define GEMM_STAGE(kt_, buf_) do { _Pragma("unroll") for (int i_ = 0; i_ < 4; ++i_) { \
        __builtin_amdgcn_global_load_lds((const unsigned*)AL(i_, (kt_)), (LAS unsigned*)(l3 + (buf_) + dbase + i_ * 1024), 16, 0, 0); \
        __builtin_amdgcn_global_load_lds((const unsigned*)BL(i_, (kt_)), (LAS unsigned*)(l3 + 32768 + (buf_) + dbase + i_ * 1024), 16, 0, 0); } } while (0)
    GEMM_STAGE(0, 0);
    __syncthreads();
    for (int kt = 0; kt < nk; ++kt) {
        const int cur = (kt & 1) * 16384, nxt = 16384 - cur;
        if (kt + 1 < nk) GEMM_STAGE(kt + 1, nxt);
#pragma unroll
        for (int kk = 0; kk < 2; ++kk) {
            bf16x8 af[4], bfr[4];
#pragma unroll
            for (int i = 0; i < 4; ++i) { af[i] = *(const bf16x8*)(lds + cur + ((aofs + i * 2048) ^ (kk * 64))); bfr[i] = *(const bf16x8*)(lds + cur + ((bofs + i * 2048) ^ (kk * 64))); }
#pragma unroll
            for (int mi = 0; mi < 4; ++mi)
#pragma unroll
                for (int ni = 0; ni < 4; ++ni) acc[mi][ni] = __builtin_amdgcn_mfma_f32_16x16x32_bf16(bfr[ni], af[mi], acc[mi][ni], 0, 0, 0);
        }
        __syncthreads();
    }
#undef GEMM_STAGE
}

template <class DstF>
__device__ __forceinline__ void store_transposed(char* lds, const TileGeom& g, const f32x4 (&acc)[4][4], const DstF& dst) {
    bf16_t* T = (bf16_t*)lds;
#pragma unroll
    for (int mi = 0; mi < 4; ++mi)
#pragma unroll
        for (int ni = 0; ni < 4; ++ni)
#pragma unroll
            for (int r = 0; r < 4; ++r) T[(g.wc * 64 + ni * 16 + g.q * 4 + r) * 136 + g.wr * 64 + mi * 16 + g.l15] = f2bf(acc[mi][ni][r]);
    __syncthreads();
    { int col = g.tid >> 1, half = g.tid & 1; bf16_t* d = dst(col) + half * 64; const bf16_t* s = T + col * 136 + half * 64;
#pragma unroll
      for (int j = 0; j < 8; ++j) *(u32x4*)(d + j * 8) = *(const u32x4*)(s + j * 8); }
    __syncthreads();
}
__device__ __forceinline__ void store4bf(bf16_t* d, const f32x4& v) { u32x2 w; w.x = pk2bf(v[0], v[1]); w.y = pk2bf(v[2], v[3]); *(u32x2*)d = w; }
__device__ __forceinline__ void rope_head(const Params& p, f32x4 (&a)[4], int s, int q) {
    const int pr = s / GRID_W, pc = s % GRID_W;
    const f32x4 cr = *(const f32x4*)(p.ropet + pr * 32 + q * 4), sr = *(const f32x4*)(p.ropet + pr * 32 + 16 + q * 4);
    const f32x4 cc = *(const f32x4*)(p.ropet + pc * 32 + q * 4), sc = *(const f32x4*)(p.ropet + pc * 32 + 16 + q * 4);
    f32x4 x1 = a[0], x2 = a[1]; a[0] = x1 * cr - x2 * sr; a[1] = x2 * cr + x1 * sr;
    x1 = a[2]; x2 = a[3]; a[2] = x1 * cc - x2 * sc; a[3] = x2 * cc + x1 * sc;
}

template <int LAYER>
__device__ __forceinline__ void inproj_tile(const Params& p, char* lds, int mt, int nt) {
    const TileGeom g = tile_geom();
    const bf16_t* Abase = p.hbuf + (size_t)(mt * 128) * D_MODEL;
    const bf16_t* Bbase = (LAYER == 0 ? p.Wt_in_even : p.Wt_in_odd) + (size_t)(nt * 128) * D_MODEL;
    f32x4 acc[4][4];
    gemm_mainloop(lds, g, D_MODEL / 64, [&](int i, int kt) { return Abase + (size_t)g.drow(i) * D_MODEL + kt * 64 + g.dchunk(i) * 8; }, [&](int i, int kt) { return Bbase + (size_t)g.drow(i) * D_MODEL + kt * 64 + g.dchunk(i) * 8; }, acc);
    const bool lat = mt < MT_LAT; const int row0 = mt * 128;
    const int b = lat ? row0 / SEQ : (row0 - TX) / CTX_LEN, s0 = lat ? row0 % SEQ : (row0 - TX) % CTX_LEN, pos0 = lat ? CTX_LEN + s0 : s0;
    int kind;
    bf16_t* base; int h0 = 0, qcol0 = 0, nh = 2;
    if (LAYER == 0) {
        if (nt < 4) { kind = 0; base = p.QA; qcol0 = nt * 128; }
        else if (nt == 4) { kind = 1; base = p.KA; h0 = 0; nh = 2; }
        else if (nt == 5) { kind = 2; base = p.VAt; h0 = 0; nh = 2; }
        else if (nt < 10) { kind = 0; base = p.QB; qcol0 = (nt - 6) * 128; }
        else if (nt < 14) { kind = 1; base = p.KB; h0 = (nt - 10) * 2; nh = 8; }
        else { kind = 2; base = p.VBt; h0 = (nt - 14) * 2; nh = 8; }
    } else {
        if (nt < 4) { kind = 0; base = p.QC; qcol0 = nt * 128; }
        else if (nt == 4) { kind = 1; base = p.KC; h0 = 0; nh = 2; }
        else if (nt == 5) { kind = 2; base = p.VCt; h0 = 0; nh = 2; }
        else { kind = 3; base = p.UT; }
    }
    if (kind <= 1) {
        const bool rope = lat && (LAYER == 1 || nt <= 4);
#pragma unroll
        for (int mi = 0; mi < 4; ++mi) {
            const int rowl = g.wr * 64 + mi * 16 + g.l15;
            if (LAYER == 1) {
                float ss = 0.f;
#pragma unroll
                for (int ni = 0; ni < 4; ++ni) ss += acc[mi][ni][0] * acc[mi][ni][0] + acc[mi][ni][1] * acc[mi][ni][1] + acc[mi][ni][2] * acc[mi][ni][2] + acc[mi][ni][3] * acc[mi][ni][3];
                ss += __shfl_xor(ss, 16); ss += __shfl_xor(ss, 32);
                const float rstd = 1.0f / sqrtf(ss * (1.0f / 64.0f) + EPS);
                const float* gn = kind == 0 ? p.c_qnorm : p.c_knorm;
#pragma unroll
                for (int ni = 0; ni < 4; ++ni) acc[mi][ni] = acc[mi][ni] * rstd * *(const f32x4*)(gn + ni * 16 + g.q * 4);
            }
            if (rope) rope_head(p, acc[mi], s0 + rowl, g.q);
            bf16_t* d = kind == 0 ? base + (size_t)(row0 + rowl) * 512 + qcol0 + g.wc * 64 + g.q * 4
                                  : base + ((size_t)(b * nh + h0 + g.wc) * LKV + pos0 + rowl) * 64 + g.q * 4;
#pragma unroll
            for (int ni = 0; ni < 4; ++ni) store4bf(d + ni * 16, acc[mi][ni]);
        }
    } else if (kind == 2) {
        store_transposed(lds, g, acc, [&](int col) { return base + ((size_t)(b * nh + h0 + (col >> 6)) * 64 + (col & 63)) * LKV + pos0; });
    } else {
        store_transposed(lds, g, acc, [&](int col) { return base + ((size_t)b * 3 * D_CH + (nt - 6) * 128 + col) * SEQ + s0; });
    }
}
template <int LAYER>
__device__ __forceinline__ void ph_inproj(const Params& p, char* lds, int bid, int nb) {
    constexpr int NT = 18;
    if (LAYER == 0) { for (int t = bid; t < MT_ALL * NT; t += nb) inproj_tile<0>(p, lds, t / NT, t % NT); }
    else {
        const int n_lat = MT_LAT * NT, n_all = n_lat + (MT_ALL - MT_LAT) * 2;
        for (int t = bid; t < n_all; t += nb) { if (t < n_lat) inproj_tile<1>(p, lds, t / NT, t % NT); else { int u = t - n_lat; inproj_tile<1>(p, lds, MT_LAT + u / 2, 4 + u % 2); } }
    }
}

template <int LAYER>
__device__ __forceinline__ void outproj_tile(const Params& p, char* lds, int mt, int nt) {
    const TileGeom g = tile_geom();
    const bf16_t* Abase = p.Y + (size_t)(mt * 128) * 1024;
    const bf16_t* Bbase = (LAYER == 0 ? p.Wt_out_even : p.Wt_out_odd) + (size_t)(nt * 128) * 1024;
    f32x4 acc[4][4];
    gemm_mainloop(lds, g, 16, [&](int i, int kt) { return Abase + (size_t)g.drow(i) * 1024 + kt * 64 + g.dchunk(i) * 8; }, [&](int i, int kt) { return Bbase + (size_t)g.drow(i) * 1024 + kt * 64 + g.dchunk(i) * 8; }, acc);
    const int row0 = mt * 128;
#pragma unroll
    for (int mi = 0; mi < 4; ++mi) {
        const int row = row0 + g.wr * 64 + mi * 16 + g.l15;
        const float* xin = xrow_in(p, LAYER, row); float* xo = xrow_cur(p, row); const float* gate = modp(p, LAYER, row, 2);
#pragma unroll
        for (int ni = 0; ni < 4; ++ni) { const int col = nt * 128 + g.wc * 64 + ni * 16 + g.q * 4;
            *(f32x4*)(xo + col) = *(const f32x4*)(xin + col) + *(const f32x4*)(gate + col) * acc[mi][ni]; }
    }
}

template <int LAYER>
__device__ __forceinline__ void ph_outproj(const Params& p, char* lds, int bid, int nb) {
    const int nmt = LAYER == 0 ? MT_ALL : MT_LAT;
    for (int t = bid; t < nmt * 8; t += nb) outproj_tile<LAYER>(p, lds, t / 8, t % 8);
}

template <int NTN>
__device__ __forceinline__ bool moe_tile_lookup(const int* cnt, int t, int& pr, int& mt, int& nt, int& n) {
    int acc = 0;
    for (int q = 0; q < NPAIR; ++q) { const int c = cnt[q]; const int tiles = ((c + 127) >> 7) * NTN; if (t < acc + tiles) { pr = q; const int u = t - acc; mt = u / NTN; nt = u % NTN; n = c; return true; } acc += tiles; }
    return false;
}
__device__ __forceinline__ void moe_up_tile(const Params& p, char* lds, int l, int pr, int mt, int nt, int n) {
    const TileGeom g = tile_geom();
    int e1, e2; pair_experts(pr, e1, e2); const int k = nt >> 3, e = k ? e2 : e1;
    const int* lst = p.list + (size_t)pr * TT + mt * 128;
    const int navail = n - mt * 128;
    const bf16_t* arow[4];
#pragma unroll
    for (int i = 0; i < 4; ++i) { int r = g.drow(i); if (r >= navail) r = navail - 1; arow[i] = p.hbuf + (size_t)lst[r] * D_MODEL + g.dchunk(i) * 8; }
    const bf16_t* Bbase = p.Wt_gu + ((size_t)(l * N_EXPERTS + e) * 2 * D_EXPERT + (nt & 7) * 128) * D_MODEL;
    f32x4 acc[4][4];
    gemm_mainloop(lds, g, D_MODEL / 64, [&](int i, int kt) { return arow[i] + kt * 64; }, [&](int i, int kt) { return Bbase + (size_t)g.drow(i) * D_MODEL + kt * 64 + g.dchunk(i) * 8; }, acc);
#pragma unroll
    for (int mi = 0; mi < 4; ++mi) {
        const int rl = g.wr * 64 + mi * 16 + g.l15;
        if (rl < navail) {
            const int row = lst[rl]; const float w = p.tokw[row * 2 + k];
            bf16_t* d = p.HE + (size_t)row * HE_W + k * D_EXPERT + (nt & 7) * 64 + g.wc * 32 + g.q * 4;
#pragma unroll
            for (int h2 = 0; h2 < 2; ++h2) { f32x4 gg = acc[mi][2 * h2], uu = acc[mi][2 * h2 + 1], o;
#pragma unroll
                for (int r = 0; r < 4; ++r) o[r] = w * (gg[r] / (1.0f + __expf(-gg[r]))) * uu[r];
                store4bf(d + h2 * 16, o); }
        }
    }
}
template <bool DUMMY = false>
__device__ __forceinline__ void moe_down_tile(const Params& p, char* lds, int l, int pr, int mt, int nt, int n) {
    const TileGeom g = tile_geom();
    int e1, e2; pair_experts(pr, e1, e2);
    const int* lst = p.list + (size_t)pr * TT + mt * 128;
    const int navail = n - mt * 128;
    const bf16_t* arow[4];
#pragma unroll
    for (int i = 0; i < 4; ++i) { int r = g.drow(i); if (r >= navail) r = navail - 1; arow[i] = p.HE + (size_t)lst[r] * HE_W + g.dchunk(i) * 8; }
    const bf16_t* B1 = p.Wt_d + ((size_t)(l * N_EXPERTS + e1) * D_MODEL + nt * 128) * D_EXPERT;
    const bf16_t* B2 = p.Wt_d + ((size_t)(l * N_EXPERTS + e2) * D_MODEL + nt * 128) * D_EXPERT;
    constexpr int KT1 = D_EXPERT / 64;
    f32x4 acc[4][4];
    gemm_mainloop(lds, g, HE_W / 64, [&](int i, int kt) { return arow[i] + kt * 64; },
                  [&](int i, int kt) { return (kt < KT1 ? B1 + kt * 64 : B2 + (kt - KT1) * 64) + (size_t)g.drow(i) * D_EXPERT + g.dchunk(i) * 8; }, acc);
#pragma unroll
    for (int mi = 0; mi < 4; ++mi) {
        const int rl = g.wr * 64 + mi * 16 + g.l15;
        if (rl < navail) {
            const int row = lst[rl]; float* xo = xrow_cur(p, row); const float* gate = modp(p, l, row, 5);
#pragma unroll
            for (int ni = 0; ni < 4; ++ni) { const int col = nt * 128 + g.wc * 64 + ni * 16 + g.q * 4; float* dst = DUMMY ? (float*)p.QA + (size_t)row * D_MODEL : xo; *(f32x4*)(dst + col) = *(const f32x4*)(xo + col) + *(const f32x4*)(gate + col) * acc[mi][ni]; }
        }
    }
}
__device__ __forceinline__ void ph_moe_up(const Params& p, char* lds, int l, int bid, int nb) {
    int pr, mt, nt, n; for (int t = bid; moe_tile_lookup<16>(p.cnt + l * 32, t, pr, mt, nt, n); t += nb) moe_up_tile(p, lds, l, pr, mt, nt, n);
}
template <bool DUMMY = false>
__device__ __forceinline__ void ph_moe_down(const Params& p, char* lds, int l, int bid, int nb) {
    int pr, mt, nt, n; for (int t = bid; moe_tile_lookup<8>(p.cnt + l * 32, t, pr, mt, nt, n); t += nb) moe_down_tile<DUMMY>(p, lds, l, pr, mt, nt, n);
}
typedef float f32x2 __attribute__((ext_vector_type(2)));
typedef __bf16 bf16x2_t __attribute__((ext_vector_type(2)));
__device__ __forceinline__ unsigned cvtpk(float lo, float hi) { f32x2 v = {lo, hi}; bf16x2_t b = __builtin_convertvector(v, bf16x2_t); return __builtin_bit_cast(unsigned, b); }
__device__ __forceinline__ int crow(int r, int hi) { return (r & 3) + 8 * (r >> 2) + 4 * hi; }
constexpr float LOG2E = 1.4426950408889634f;
constexpr float QK_C = ATTN_SCALE * LOG2E;
constexpr float NEG_BIG = -1e30f;

template <int MODE>
__device__ __forceinline__ void attn_unit(char* lds, const bf16_t* Qp, const bf16_t* Kp, const bf16_t* Vt, bf16_t* Op, int s0, int nctx, int lt0, int nlat, float sink2, bool has_sink, const float* rpb_h) {
    int tid_ = threadIdx.x; asm volatile("" : "+v"(tid_));
    const int tid = tid_, lane = tid & 63, wid = __builtin_amdgcn_readfirstlane(tid >> 6), l31 = lane & 31, hi = lane >> 5;
    float* bias_s = (float*)(lds + 49152);
    if (MODE == 2) { for (int i = tid; i < 15 * 31; i += NTHREADS) bias_s[i] = rpb_h[i] * LOG2E; }
    const int ntiles = nctx + nlat;
    LAS char* l3 = (LAS char*)lds;
    const int drow0 = wid * 16 + (lane >> 3);
    const int dch0 = (lane & 7) ^ (((lane >> 4) + 0) & 7), dch1 = (lane & 7) ^ (((lane >> 4) + 4) & 7);
    const bf16_t* ksrc0 = Kp + (size_t)drow0 * 64 + dch0 * 8; const bf16_t* ksrc1 = Kp + (size_t)(drow0 + 8) * 64 + dch1 * 8;
    const bf16_t* vsrc0 = Vt + (size_t)drow0 * LKV + dch0 * 8; const bf16_t* vsrc1 = Vt + (size_t)(drow0 + 8) * LKV + dch1 * 8;
    const int ddst = wid * 2048;
    auto tile_pos = [&](int j) { return j < nctx ? 64 * j : CTX_LEN + 64 * (lt0 + j - nctx); };
#define ATT_DMA(j_, slot_) do { const int pos_ = tile_pos(j_); \
        __builtin_amdgcn_global_load_lds((const unsigned*)(ksrc0 + (size_t)pos_ * 64), (LAS unsigned*)(l3 + (slot_) * 8192 + ddst), 16, 0, 0); \
        __builtin_amdgcn_global_load_lds((const unsigned*)(ksrc1 + (size_t)pos_ * 64), (LAS unsigned*)(l3 + (slot_) * 8192 + ddst + 1024), 16, 0, 0); \
        __builtin_amdgcn_global_load_lds((const unsigned*)(vsrc0 + pos_), (LAS unsigned*)(l3 + 24576 + (slot_) * 8192 + ddst), 16, 0, 0); \
        __builtin_amdgcn_global_load_lds((const unsigned*)(vsrc1 + pos_), (LAS unsigned*)(l3 + 24576 + (slot_) * 8192 + ddst + 1024), 16, 0, 0); } while (0)
    const int x = (l31 >> 1) & 7;
    const int kofs = l31 * 128 + ((hi ^ x) << 4);
    const int vofs = 24576 + l31 * 128 + (x << 4) + 8 * hi;
    bf16x8 qf[4];
    { const bf16_t* qr = Qp + (size_t)(wid * 32 + l31) * 512 + hi * 8;
#pragma unroll
      for (int s = 0; s < 4; ++s) qf[s] = *(const bf16x8*)(qr + s * 16); }
    f32x16 o0 = {}, o1 = {};
    float m = NEG_BIG, l = 0.f;
    const int sq = s0 + wid * 32 + l31;
    int rq = 0, cq = 0, rsq = 0, csq = 0;
    if (MODE == 2) { rq = sq / GRID_W; cq = sq % GRID_W; rsq = rq - B_WIN_H / 2; rsq = rsq < 0 ? 0 : (rsq > GRID_H - B_WIN_H ? GRID_H - B_WIN_H : rsq); csq = cq - B_WIN_W / 2; csq = csq < 0 ? 0 : (csq > GRID_W - B_WIN_W ? GRID_W - B_WIN_W : csq); }
    ATT_DMA(0, 0);
    if (ntiles > 1) { ATT_DMA(1, 1); asm volatile("s_waitcnt vmcnt(4) lgkmcnt(0)" ::: "memory"); } else { asm volatile("s_waitcnt vmcnt(0) lgkmcnt(0)" ::: "memory"); }
    __builtin_amdgcn_s_barrier(); asm volatile("" ::: "memory");
    int slot = 0;
    for (int j = 0; j < ntiles; ++j) {
        const int slot2 = slot == 0 ? 2 : slot - 1;
        const bool pre = j + 2 < ntiles;
        if (pre) ATT_DMA(j + 2, slot2);
        const char* Kb = lds + slot * 8192; const char* Vb = lds + slot * 8192;
        f32x16 p0 = {}, p1 = {};
#pragma unroll
        for (int s = 0; s < 4; ++s) {
            const bf16x8 k0 = *(const bf16x8*)(Kb + (kofs ^ (s << 5))); const bf16x8 k1 = *(const bf16x8*)(Kb + 4096 + (kofs ^ (s << 5)));
            p0 = __builtin_amdgcn_mfma_f32_32x32x16_bf16(k0, qf[s], p0, 0, 0, 0); p1 = __builtin_amdgcn_mfma_f32_32x32x16_bf16(k1, qf[s], p1, 0, 0, 0);
        }
        float tmax = NEG_BIG;
        const bool plain = (MODE == 0 || j < nctx);
        if (plain) {
#pragma unroll
            for (int r = 0; r < 16; ++r) tmax = fmaxf(tmax, fmaxf(p0[r], p1[r]));
            tmax *= QK_C;
        } else if (MODE == 1) {
            const int sk0 = 64 * (lt0 + j - nctx);
#pragma unroll
            for (int r = 0; r < 16; ++r) { const int d0 = sk0 + crow(r, hi) - sq, d1 = d0 + 32;
                p0[r] = (d0 >= -A_WINDOW && d0 <= A_WINDOW) ? p0[r] * QK_C : NEG_BIG; p1[r] = (d1 >= -A_WINDOW && d1 <= A_WINDOW) ? p1[r] * QK_C : NEG_BIG; tmax = fmaxf(tmax, fmaxf(p0[r], p1[r])); }
        } else {
            const int kr = lt0 + j - nctx; const bool rowok = kr >= rsq && kr < rsq + B_WIN_H;
            const float* brow = bias_s + (kr - rq + B_WIN_H - 1) * 31 + (B_WIN_W - 1) - cq;
#pragma unroll
            for (int r = 0; r < 16; ++r) { const int kc0 = crow(r, hi), kc1 = kc0 + 32;
                const bool ok0 = rowok && kc0 >= csq && kc0 < csq + B_WIN_W, ok1 = rowok && kc1 >= csq && kc1 < csq + B_WIN_W;
                p0[r] = ok0 ? p0[r] * QK_C + brow[kc0] : NEG_BIG; p1[r] = ok1 ? p1[r] * QK_C + brow[kc1] : NEG_BIG; tmax = fmaxf(tmax, fmaxf(p0[r], p1[r])); }
        }
        tmax = fmaxf(tmax, __shfl_xor(tmax, 32));
        const float mn = fmaxf(m, tmax);
        if (__any(mn > m)) {
            const float alpha = __builtin_amdgcn_exp2f(m - mn); m = mn; l *= alpha;
#pragma unroll
            for (int r = 0; r < 16; ++r) { o0[r] *= alpha; o1[r] *= alpha; }
        }
        float ls = 0.f;
        if (plain) {
#pragma unroll
            for (int r = 0; r < 16; ++r) { p0[r] = __builtin_amdgcn_exp2f(__builtin_fmaf(p0[r], QK_C, -m)); p1[r] = __builtin_amdgcn_exp2f(__builtin_fmaf(p1[r], QK_C, -m)); ls += p0[r] + p1[r]; }
        } else {
#pragma unroll
            for (int r = 0; r < 16; ++r) { p0[r] = __builtin_amdgcn_exp2f(p0[r] - m); p1[r] = __builtin_amdgcn_exp2f(p1[r] - m); ls += p0[r] + p1[r]; }
        }
        l += ls;
        bf16x8 pf[4];
        { u32x4 w;
          w.x = cvtpk(p0[0], p0[1]); w.y = cvtpk(p0[2], p0[3]); w.z = cvtpk(p0[4], p0[5]); w.w = cvtpk(p0[6], p0[7]); pf[0] = __builtin_bit_cast(bf16x8, w);
          w.x = cvtpk(p0[8], p0[9]); w.y = cvtpk(p0[10], p0[11]); w.z = cvtpk(p0[12], p0[13]); w.w = cvtpk(p0[14], p0[15]); pf[1] = __builtin_bit_cast(bf16x8, w);
          w.x = cvtpk(p1[0], p1[1]); w.y = cvtpk(p1[2], p1[3]); w.z = cvtpk(p1[4], p1[5]); w.w = cvtpk(p1[6], p1[7]); pf[2] = __builtin_bit_cast(bf16x8, w);
          w.x = cvtpk(p1[8], p1[9]); w.y = cvtpk(p1[10], p1[11]); w.z = cvtpk(p1[12], p1[13]); w.w = cvtpk(p1[14], p1[15]); pf[3] = __builtin_bit_cast(bf16x8, w); }
#pragma unroll
        for (int s = 0; s < 4; ++s) {
            const int a0 = vofs ^ (s << 5);
            u32x2 va = *(const u32x2*)(Vb + a0), vb = *(const u32x2*)(Vb + (a0 ^ 16));
            u32x2 vc = *(const u32x2*)(Vb + 4096 + a0), vd = *(const u32x2*)(Vb + 4096 + (a0 ^ 16));
            const bf16x8 f0 = __builtin_bit_cast(bf16x8, (u32x4){va.x, va.y, vb.x, vb.y}), f1 = __builtin_bit_cast(bf16x8, (u32x4){vc.x, vc.y, vd.x, vd.y});
            o0 = __builtin_amdgcn_mfma_f32_32x32x16_bf16(f0, pf[s], o0, 0, 0, 0); o1 = __builtin_amdgcn_mfma_f32_32x32x16_bf16(f1, pf[s], o1, 0, 0, 0);
        }
        if (pre) asm volatile("s_waitcnt vmcnt(4) lgkmcnt(0)" ::: "memory"); else asm volatile("s_waitcnt vmcnt(0) lgkmcnt(0)" ::: "memory");
        __builtin_amdgcn_s_barrier(); asm volatile("" ::: "memory");
        slot = slot == 2 ? 0 : slot + 1;
    }
#undef ATT_DMA
    l += __shfl_xor(l, 32);
    if (has_sink) l += __builtin_amdgcn_exp2f(sink2 - m);
    const float inv = 1.0f / l;
    bf16_t* orow = Op + (size_t)(wid * 32 + l31) * 1024;
#pragma unroll
    for (int g4 = 0; g4 < 4; ++g4) {
        u32x2 w; w.x = cvtpk(o0[g4 * 4 + 0] * inv, o0[g4 * 4 + 1] * inv); w.y = cvtpk(o0[g4 * 4 + 2] * inv, o0[g4 * 4 + 3] * inv); *(u32x2*)(orow + 8 * g4 + 4 * hi) = w;
        w.x = cvtpk(o1[g4 * 4 + 0] * inv, o1[g4 * 4 + 1] * inv); w.y = cvtpk(o1[g4 * 4 + 2] * inv, o1[g4 * 4 + 3] * inv); *(u32x2*)(orow + 32 + 8 * g4 + 4 * hi) = w;
    }
    asm volatile("s_waitcnt vmcnt(0)" ::: "memory");
}

constexpr int NU_LAT = BATCH * 8 * (SEQ / 128);
constexpr int NU_CTX = BATCH * 8 * (CTX_LEN / 128);
__device__ __forceinline__ void ph_attn0(const Params& p, char* lds, int bid, int nb) {
    for (int u = bid; u < 2 * NU_LAT + 2 * NU_CTX; u += nb) {
        if (u < NU_LAT) {
            const int blk = u % (SEQ / 128), h = (u / (SEQ / 128)) % 8, b = u / (8 * (SEQ / 128)); const int s0 = blk * 128, r0 = s0 / GRID_W;
            int rs0 = r0 - 4; rs0 = rs0 < 0 ? 0 : (rs0 > GRID_H - 8 ? GRID_H - 8 : rs0); int rs1 = r0 + 1 - 4; rs1 = rs1 < 0 ? 0 : (rs1 > GRID_H - 8 ? GRID_H - 8 : rs1);
            attn_unit<2>(lds, p.QB + (size_t)(b * SEQ + s0) * 512 + h * 64, p.KB + (size_t)(b * 8 + h) * LKV * 64, p.VBt + (size_t)(b * 8 + h) * 64 * LKV,
                         p.Y + (size_t)(b * SEQ + s0) * 1024 + 512 + h * 64, s0, CTX_LEN / 64, rs0, rs1 + 8 - rs0, 0.f, false, p.b_rpb + h * 15 * 31);
        } else if (u < 2 * NU_LAT) {
            const int v = u - NU_LAT; const int blk = v % (SEQ / 128), h = (v / (SEQ / 128)) % 8, b = v / (8 * (SEQ / 128)); const int s0 = blk * 128;
            int t0 = (s0 - 128) / 64; if (t0 < 0) t0 = 0; int t1 = (s0 + 255) / 64; if (t1 > SEQ / 64 - 1) t1 = SEQ / 64 - 1;
            attn_unit<1>(lds, p.QA + (size_t)(b * SEQ + s0) * 512 + h * 64, p.KA + (size_t)(b * 2 + h / 4) * LKV * 64, p.VAt + (size_t)(b * 2 + h / 4) * 64 * LKV,
                         p.Y + (size_t)(b * SEQ + s0) * 1024 + h * 64, s0, CTX_LEN / 64, t0, t1 - t0 + 1, p.a_sink[h] * LOG2E, true, nullptr);
        } else {
            const int v = u - 2 * NU_LAT; const int ty = v / NU_CTX, w = v % NU_CTX; const int blk = w % (CTX_LEN / 128), h = (w / (CTX_LEN / 128)) % 8, b = w / (8 * (CTX_LEN / 128));
            const int row0 = TX + b * CTX_LEN + blk * 128;
            if (ty == 0) attn_unit<0>(lds, p.QA + (size_t)row0 * 512 + h * 64, p.KA + (size_t)(b * 2 + h / 4) * LKV * 64, p.VAt + (size_t)(b * 2 + h / 4) * 64 * LKV, p.Y + (size_t)row0 * 1024 + h * 64, 0, CTX_LEN / 64, 0, 0, p.a_sink[h] * LOG2E, true, nullptr);
            else attn_unit<0>(lds, p.QB + (size_t)row0 * 512 + h * 64, p.KB + (size_t)(b * 8 + h) * LKV * 64, p.VBt + (size_t)(b * 8 + h) * 64 * LKV, p.Y + (size_t)row0 * 1024 + 512 + h * 64, 0, CTX_LEN / 64, 0, 0, 0.f, false, nullptr);
        }
    }
}
__device__ __forceinline__ void ph_attnC(const Params& p, char* lds, int bid, int nb) {
    for (int u = bid; u < NU_LAT; u += nb) {
        const int blk = u % (SEQ / 128), h = (u / (SEQ / 128)) % 8, b = u / (8 * (SEQ / 128)); const int s0 = blk * 128;
        attn_unit<0>(lds, p.QC + (size_t)(b * SEQ + s0) * 512 + h * 64, p.KC + (size_t)(b * 2 + h / 4) * LKV * 64, p.VCt + (size_t)(b * 2 + h / 4) * 64 * LKV,
                     p.Y + (size_t)(b * SEQ + s0) * 1024 + h * 64, s0, CTX_LEN / 64, 0, SEQ / 64, 0.f, false, nullptr);
    }
}
#ifdef HY_TEST
#define HY_OUT(b, t, v) p.YHT[((size_t)(b) * D_CH + c) * SEQ + (t)] = f2bf(v)
#else
#define HY_OUT(b, t, v) p.YHT[((size_t)(b) * D_CH + c) * SEQ + (t)] = f2bf(v)
#endif
#ifdef CPU_TEST
#define FOR_T for (int tid = 0; tid < 256; ++tid)
#define HSYNC
#define HST(t) st[t]
#define HY_DECL HySt* st = new HySt[256]
#define HY_FREE delete[] st
static inline void sincos_rev(float a, float& c, float& s) { c = cosf(6.283185307179586f * a); s = sinf(6.283185307179586f * a); }
#else
__device__ __forceinline__ int hy_launder(int v) { asm volatile("" : "+v"(v)); return v; }
#define FOR_T if (const int tid = hy_launder((int)threadIdx.x); true)
#define HSYNC __syncthreads()
#define HST(t) st
#define HY_DECL HySt st
#define HY_FREE
__device__ __forceinline__ void sincos_rev(float a, float& c, float& s) { c = __builtin_amdgcn_cosf(a); s = __builtin_amdgcn_sinf(a); }
#endif
constexpr int FN = 2 * SEQ;
constexpr int FPAD = FN + (FN >> 5);
#if !defined(SMALL_CFG)
static_assert(FN == 8192, "pass plan 8,8,8,16 is for N = 8192");
constexpr int R4 = 16;
constexpr int NS4 = 512;
#else
constexpr int R4 = 2;
constexpr int NS4 = 512;
#endif
constexpr int NB8 = FN / 8 / 256;
constexpr int NB4 = FN / R4 / 256;
constexpr int EPT = FN / 256;
struct HySt { float xr[EPT], xi[EPT]; unsigned kp[EPT]; };
HD unsigned hy_pack(float r, float i) { return (unsigned)f2bf(r) | ((unsigned)f2bf(i) << 16); }
HD float hy_lo(unsigned v) { unsigned u = v << 16; float f; __builtin_memcpy(&f, &u, 4); return f; }
HD float hy_hi(unsigned v) { unsigned u = v & 0xffff0000u; float f; __builtin_memcpy(&f, &u, 4); return f; }
HD int pidx(int i) { return i + (i >> 5); }

constexpr float W16C[8] = {1.0f, 0.9238795325112867f, 0.7071067811865476f, 0.3826834323650898f, 0.0f, -0.3826834323650898f, -0.7071067811865476f, -0.9238795325112867f};
constexpr float W16S[8] = {0.0f, -0.3826834323650898f, -0.7071067811865476f, -0.9238795325112867f, -1.0f, -0.9238795325112867f, -0.7071067811865476f, -0.3826834323650898f};
template <int R> HD void fft_reg(float* xr, float* xi) {
    constexpr int LG = R == 16 ? 4 : (R == 8 ? 3 : (R == 4 ? 2 : 1));
#pragma unroll
    for (int sg = 0; sg < LG; ++sg) {
        const int h = (R / 2) >> sg;
#pragma unroll
        for (int pr = 0; pr < R / 2; ++pr) {
            const int blk = (pr / h) * 2 * h, i = pr % h;
            const int a = blk + i, b = blk + i + h;
            const float ar = xr[a], ai = xi[a], br = xr[b], bi = xi[b];
            xr[a] = ar + br; xi[a] = ai + bi;
            const float tr = ar - br, ti = ai - bi;
            const int tw = i * (8 / h);
            if (tw == 0) { xr[b] = tr; xi[b] = ti; }
            else if (tw == 4) { xr[b] = ti; xi[b] = -tr; }
            else { const float c = W16C[tw & 7], s = W16S[tw & 7]; xr[b] = tr * c - ti * s; xi[b] = tr * s + ti * c; }
        }
    }
}
template <int R> HD constexpr int bitrev(int i) { int r = 0; for (int b = 1; b < R; b <<= 1) { r = (r << 1) | (i & 1); i >>= 1; } return r; }

template <int R, int NB, class In> HD void pass_load(int tid, HySt& s, const In& in) {
#pragma unroll
    for (int b = 0; b < NB; ++b)
#pragma unroll
        for (int r = 0; r < R; ++r) in(tid + 256 * b + (FN / R) * r, r, s.xr[b * R + r], s.xi[b * R + r]);
}
template <int R, int NB, class Out> HD void pass_compute(int tid, HySt& s, int Ns, const Out& out) {
#pragma unroll
    for (int b = 0; b < NB; ++b) {
        const int j = tid + 256 * b, k = j & (Ns - 1);
        float* xr = s.xr + b * R; float* xi = s.xi + b * R;
        if (Ns > 1) {
            float wc, ws; sincos_rev(-(float)k / (float)(Ns * R), wc, ws);
            float cr = wc, ci = ws;
#pragma unroll
            for (int r = 1; r < R; ++r) {
                const float vr = xr[r], vi = xi[r]; xr[r] = vr * cr - vi * ci; xi[r] = vr * ci + vi * cr;
                const float nr = cr * wc - ci * ws, ni = cr * ws + ci * wc; cr = nr; ci = ni;
            }
        }
        fft_reg<R>(xr, xi);
        const int j0 = (j - k) * R + k;
#pragma unroll
        for (int i = 0; i < R; ++i) out(j0 + bitrev<R>(i) * Ns, b, bitrev<R>(i), xr[i], xi[i]);
    }
}
struct LdsIn { const float* re; const float* im; HD void operator()(int idx, int, float& r, float& i) const { r = re[pidx(idx)]; i = im[pidx(idx)]; } };
struct LdsOut { float* re; float* im; HD void operator()(int idx, int, int, float r, float i) const { re[pidx(idx)] = r; im[pidx(idx)] = i; } };

HD void hy_pre_load(const Params& p, int c, int b, int tid, float* lds) {
#pragma unroll
    for (int q = 0; q < 3; ++q) {
        const bf16_t* u = p.UT + ((size_t)b * 3 * D_CH + q * D_CH + c) * SEQ; const int t0 = tid * 16;
        const float w0 = p.hy_short_w[0 * 3 * D_CH + q * D_CH + c], w1 = p.hy_short_w[1 * 3 * D_CH + q * D_CH + c], w2 = p.hy_short_w[2 * 3 * D_CH + q * D_CH + c], sb = p.hy_short_b[q * D_CH + c];
        unsigned w[8];
        { const unsigned* u32p = (const unsigned*)(u + t0);
#pragma unroll
          for (int i = 0; i < 8; ++i) w[i] = u32p[i]; }
        float x[18];
        x[0] = t0 > 0 ? bf2f(u[t0 - 1]) : 0.f; x[17] = t0 + 16 < SEQ ? bf2f(u[t0 + 16]) : 0.f;
#pragma unroll
        for (int i = 0; i < 8; ++i) { x[1 + 2 * i] = bf2f((bf16_t)(w[i] & 0xffffu)); x[2 + 2 * i] = bf2f((bf16_t)(w[i] >> 16)); }
#pragma unroll
        for (int i = 0; i < 16; ++i) lds[q * SEQ + t0 + i] = sb + w0 * x[i] + w1 * x[i + 1] + w2 * x[i + 2];
    }
}
HD void hy_pre_store(const Params& p, int c, int b, int tid, const float* lds) {
#pragma unroll
    for (int q = 0; q < 3; ++q) {
        unsigned* u = (unsigned*)(p.UT + ((size_t)b * 3 * D_CH + q * D_CH + c) * SEQ + tid * 16);
#pragma unroll
        for (int i = 0; i < 8; ++i) u[i] = (unsigned)f2bf(lds[q * SEQ + tid + 256 * (2 * i)]) | ((unsigned)f2bf(lds[q * SEQ + tid + 256 * (2 * i + 1)]) << 16);
    }
}
HD void tm_load_bf16(const bf16_t* row, int tid, unsigned (&w)[8]) { const unsigned* q = (const unsigned*)(row + tid * 16);
#pragma unroll
    for (int i = 0; i < 8; ++i) w[i] = q[i]; }
HD float tm_get(const unsigned (&w)[8], int m) { return bf2f((bf16_t)((m & 1) ? (w[m >> 1] >> 16) : (w[m >> 1] & 0xffffu))); }
HD int tm_ofs(int idx) { return (idx & 255) * 16 + (idx >> 8); }

HD void hyena_channel(const Params& p, int c, float* lds) {
    HY_DECL;
    float* re = lds; float* im = lds + FPAD;
    const LdsIn lin{re, im}; const LdsOut lout{re, im};
    for (int b = 0; b < BATCH; ++b) { FOR_T { hy_pre_load(p, c, b, tid, lds); } HSYNC; FOR_T { hy_pre_store(p, c, b, tid, lds); } HSYNC; }
    float nrm[2];
#pragma unroll
    for (int o = 0; o < 2; ++o) {
        const float* hf = p.HFT + (size_t)((0 * 2 + o) * D_CH + c) * SEQ; const float* hb = p.HFT + (size_t)((1 * 2 + o) * D_CH + c) * SEQ;
        FOR_T { float sacc = 0.f; for (int i = 0; i < SEQ / 256; ++i) sacc += fabsf(hf[tid + 256 * i]) + fabsf(hb[tid + 256 * i]); re[tid] = sacc; }
        HSYNC;
        { float tot = 0.f; for (int i = 0; i < 256; ++i) tot += re[i]; nrm[o] = tot + EPS; }
        HSYNC;
    }
    float sw[3][3], sbv[3];
#pragma unroll
    for (int q = 0; q < 3; ++q) { sbv[q] = p.hy_short_b[q * D_CH + c];
#pragma unroll
        for (int kk = 0; kk < 3; ++kk) sw[q][kk] = p.hy_short_w[kk * 3 * D_CH + q * D_CH + c]; }
#pragma unroll 1
    for (int o = 0; o < 2; ++o) {
        const float* hf = p.HFT + (size_t)((0 * 2 + o) * D_CH + c) * SEQ; const float* hb = p.HFT + (size_t)((1 * 2 + o) * D_CH + c) * SEQ;
        const float inv = 1.0f / (o == 0 ? nrm[0] : nrm[1]); const float hbias = p.hy_bias[o * D_CH + c];
        float swg[3]; swg[0] = o == 0 ? sw[1][0] : sw[2][0]; swg[1] = o == 0 ? sw[1][1] : sw[2][1]; swg[2] = o == 0 ? sw[1][2] : sw[2][2]; const float sbg = o == 0 ? sbv[1] : sbv[2];
        FOR_T { pass_load<8, NB8>(tid, HST(tid), [&](int idx, int r8, float& r, float& i) __attribute__((always_inline)) { if (r8 < 4) r = hf[idx] * inv; else { const int q = FN - idx; const float hv = hb[q < SEQ ? q : 0]; r = q < SEQ ? hv * inv : 0.f; } i = 0.f; });
                pass_compute<8, NB8>(tid, HST(tid), 1, lout); }
        HSYNC;
        FOR_T { pass_load<8, NB8>(tid, HST(tid), lin); } HSYNC; FOR_T { pass_compute<8, NB8>(tid, HST(tid), 8, lout); } HSYNC;
        FOR_T { pass_load<8, NB8>(tid, HST(tid), lin); } HSYNC; FOR_T { pass_compute<8, NB8>(tid, HST(tid), 64, lout); } HSYNC;
        FOR_T { pass_load<R4, NB4>(tid, HST(tid), lin);
                HySt& s = HST(tid); pass_compute<R4, NB4>(tid, s, NS4, [&](int, int b, int rr, float r, float i) __attribute__((always_inline)) { s.kp[b + NB4 * rr] = hy_pack(r, i); }); }
        HSYNC;
        for (int bp = 0; bp < BATCH / 2; ++bp) {
            const int b0 = 2 * bp, b1 = 2 * bp + 1;
            const bf16_t* u0 = p.UT + ((size_t)b0 * 3 * D_CH + c) * SEQ; const bf16_t* u1 = p.UT + ((size_t)b1 * 3 * D_CH + c) * SEQ;
            const float* z0 = p.Z1 + ((size_t)b0 * D_CH + c) * SEQ; const float* z1 = p.Z1 + ((size_t)b1 * D_CH + c) * SEQ;
            auto zval = [&](int b, int t) __attribute__((always_inline)) { return o == 0 ? bf2f((b == b0 ? u0 : u1)[tm_ofs(t)]) : (b == b0 ? z0 : z1)[tm_ofs(t)]; };
            FOR_T { HySt& s = HST(tid);
                    if (o == 0) { unsigned w0[8], w1[8]; tm_load_bf16(u0, tid, w0); tm_load_bf16(u1, tid, w1);
#pragma unroll
                        for (int q = 0; q < 32; ++q) { const int b = q >> 3, r = q & 7; if (r < 4) { s.xr[q] = tm_get(w0, b + 4 * r); s.xi[q] = tm_get(w1, b + 4 * r); } else { s.xr[q] = 0.f; s.xi[q] = 0.f; } } }
                    else {
#pragma unroll
                        for (int q = 0; q < 32; ++q) { const int b = q >> 3, r = q & 7; if (r < 4) { s.xr[q] = z0[tid * 16 + b + 4 * r]; s.xi[q] = z1[tid * 16 + b + 4 * r]; } else { s.xr[q] = 0.f; s.xi[q] = 0.f; } } }
                    pass_compute<8, NB8>(tid, s, 1, lout); }
            HSYNC;
            FOR_T { pass_load<8, NB8>(tid, HST(tid), lin); } HSYNC; FOR_T { pass_compute<8, NB8>(tid, HST(tid), 8, lout); } HSYNC;
            FOR_T { pass_load<8, NB8>(tid, HST(tid), lin); } HSYNC; FOR_T { pass_compute<8, NB8>(tid, HST(tid), 64, lout); } HSYNC;
            FOR_T { pass_load<R4, NB4>(tid, HST(tid), lin); } HSYNC;
            FOR_T { HySt& s = HST(tid); pass_compute<R4, NB4>(tid, s, NS4, [&](int idx, int b, int rr, float r, float i) __attribute__((always_inline)) { const float kr = hy_lo(s.kp[b + NB4 * rr]), ki = hy_hi(s.kp[b + NB4 * rr]);
                        re[pidx(idx)] = r * kr - i * ki; im[pidx(idx)] = -(r * ki + i * kr); }); }
            HSYNC;
            FOR_T { pass_load<8, NB8>(tid, HST(tid), lin); } HSYNC; FOR_T { pass_compute<8, NB8>(tid, HST(tid), 1, lout); } HSYNC;
            FOR_T { pass_load<8, NB8>(tid, HST(tid), lin); } HSYNC; FOR_T { pass_compute<8, NB8>(tid, HST(tid), 8, lout); } HSYNC;
            FOR_T { pass_load<8, NB8>(tid, HST(tid), lin); } HSYNC; FOR_T { pass_compute<8, NB8>(tid, HST(tid), 64, lout); } HSYNC;
            FOR_T { pass_load<R4, NB4>(tid, HST(tid), lin); HySt& s = HST(tid); float yr[16], yi[16];
                    pass_compute<R4, NB4>(tid, s, NS4, [&](int, int b, int rr, float r, float i) __attribute__((always_inline)) { if (rr < 8) { yr[b + 2 * rr] = r * (1.0f / FN); yi[b + 2 * rr] = -i * (1.0f / FN); } });
                    const bf16_t* g0 = p.UT + ((size_t)b0 * 3 * D_CH + (o + 1) * D_CH + c) * SEQ; const bf16_t* g1 = p.UT + ((size_t)b1 * 3 * D_CH + (o + 1) * D_CH + c) * SEQ;
                    unsigned gw0[8], gw1[8]; tm_load_bf16(g0, tid, gw0); tm_load_bf16(g1, tid, gw1);
                    if (o == 0) { unsigned w0[8], w1[8]; tm_load_bf16(u0, tid, w0); tm_load_bf16(u1, tid, w1);
                        float* zo0 = p.Z1 + ((size_t)b0 * D_CH + c) * SEQ + tid * 16; float* zo1 = p.Z1 + ((size_t)b1 * D_CH + c) * SEQ + tid * 16;
#pragma unroll
                        for (int m = 0; m < 16; ++m) { zo0[m] = tm_get(gw0, m) * (yr[m] + tm_get(w0, m) * hbias); zo1[m] = tm_get(gw1, m) * (yi[m] + tm_get(w1, m) * hbias); } }
                    else {
#pragma unroll
                        for (int m = 0; m < 16; ++m) { const float zn0 = tm_get(gw0, m) * (yr[m] + z0[tid * 16 + m] * hbias), zn1 = tm_get(gw1, m) * (yi[m] + z1[tid * 16 + m] * hbias);
                            HY_OUT(b0, tid + 256 * m, zn0); HY_OUT(b1, tid + 256 * m, zn1); } } }
            HSYNC;
        }
    }
    HY_FREE;
}
constexpr int MOD_ITEMS = DEPTH * (6 * D_MODEL / 64);
__device__ __forceinline__ void mod_item(const Params& p, char* lds, int item) {
    float* sc = (float*)lds;
    float* red = sc + 5 * D_MODEL;
    const int tid = threadIdx.x, l = item / (6 * D_MODEL / 64), j0 = (item % (6 * D_MODEL / 64)) * 64;
    for (int i = tid; i < 5 * D_MODEL; i += NTHREADS) { const int r = i / D_MODEL, k = i % D_MODEL; const float v = r < BATCH ? p.c[r * D_MODEL + k] : p.c_ctx[k]; sc[i] = silu_f(v); }
    __syncthreads();
    const int col = tid & 63, kp = tid >> 6;
    const float* w = p.w_ada + ((size_t)l * D_MODEL + kp * 256) * 6 * D_MODEL + j0 + col;
    float a0 = 0.f, a1 = 0.f, a2 = 0.f, a3 = 0.f, a4 = 0.f;
#pragma unroll 8
    for (int k = 0; k < 256; ++k) { const float wv = w[(size_t)k * 6 * D_MODEL]; const int kk = kp * 256 + k;
        a0 += sc[kk] * wv; a1 += sc[D_MODEL + kk] * wv; a2 += sc[2 * D_MODEL + kk] * wv; a3 += sc[3 * D_MODEL + kk] * wv; a4 += sc[4 * D_MODEL + kk] * wv; }
    red[(kp * 5 + 0) * 64 + col] = a0; red[(kp * 5 + 1) * 64 + col] = a1; red[(kp * 5 + 2) * 64 + col] = a2; red[(kp * 5 + 3) * 64 + col] = a3; red[(kp * 5 + 4) * 64 + col] = a4;
    __syncthreads();
    for (int i = tid; i < 5 * 64; i += NTHREADS) { const int r = i / 64, cc = i % 64;
        const float v = red[(0 * 5 + r) * 64 + cc] + red[(1 * 5 + r) * 64 + cc] + red[(2 * 5 + r) * 64 + cc] + red[(3 * 5 + r) * 64 + cc];
        p.mod[((size_t)(l * (BATCH + 1) + r)) * 6 * D_MODEL + j0 + cc] = v + p.b_ada[l * 6 * D_MODEL + j0 + cc]; }
    __syncthreads();
}
constexpr int FILT_ITEMS = (SEQ / 256) * (4 * D_CH / 64);
__device__ __forceinline__ void filt_item(const Params& p, char* lds, int item) {
    float* ws = (float*)lds;
    const int tid = threadIdx.x, tb = item % (SEQ / 256), cb = item / (SEQ / 256); const int t = tb * 256 + tid, col0 = cb * 64;
#pragma unroll
    for (int i = 0; i < 16; ++i) { const int k = i * 4 + (tid >> 6), cc = tid & 63; ws[cc * 68 + k] = p.hy_w3[(size_t)k * 4 * D_CH + col0 + cc]; }
    f32x4 h[16];
#pragma unroll
    for (int i = 0; i < 16; ++i) h[i] = *(const f32x4*)(p.h2 + (size_t)t * HY_FFN + i * 4);
    __syncthreads();
    const float tn = (float)t / (float)(SEQ - 1);
    const float mind = logf(1e-2f) / 1.5f, maxd = logf(1e-2f) / 0.3f;
#pragma unroll 2
    for (int cc = 0; cc < 64; ++cc) {
        const int col = col0 + cc; const f32x4* w = (const f32x4*)(ws + cc * 68);
        float acc = p.hy_b3[col];
#pragma unroll
        for (int i = 0; i < 16; ++i) { const f32x4 wv = w[i]; acc += h[i][0] * wv[0] + h[i][1] * wv[1] + h[i][2] * wv[2] + h[i][3] * wv[3]; }
        const float delta = fabsf(mind + (float)(col % D_CH) * (maxd - mind) / (float)(D_CH - 1));
        p.HFT[(size_t)col * SEQ + t] = acc * expf(-tn * delta);
    }
    __syncthreads();
}
__device__ __forceinline__ void ph_norm(const Params& p, int l, int which, int nrows, int bid, int nb) {
    const int lane = threadIdx.x & 63, wid = threadIdx.x >> 6;
    const float* g = p.norm_g + (l * 2 + which) * D_MODEL;
    for (int row = (bid * 4 + wid) * 2; row < nrows; row += nb * 8) {
        const int row1 = row + 1 < nrows ? row + 1 : row;
        const float* xa = which == 0 ? xrow_in(p, l, row) : xrow_cur(p, row); const float* xb = which == 0 ? xrow_in(p, l, row1) : xrow_cur(p, row1);
        f32x4 va[4], vb[4]; float sa = 0.f, sb = 0.f;
#pragma unroll
        for (int j = 0; j < 4; ++j) { va[j] = *(const f32x4*)(xa + j * 256 + lane * 4); vb[j] = *(const f32x4*)(xb + j * 256 + lane * 4); }
#pragma unroll
        for (int j = 0; j < 4; ++j) { sa += va[j][0] * va[j][0] + va[j][1] * va[j][1] + va[j][2] * va[j][2] + va[j][3] * va[j][3]; sb += vb[j][0] * vb[j][0] + vb[j][1] * vb[j][1] + vb[j][2] * vb[j][2] + vb[j][3] * vb[j][3]; }
        const float ra = 1.0f / sqrtf(wave_sum(sa) * (1.0f / D_MODEL) + EPS), rb = 1.0f / sqrtf(wave_sum(sb) * (1.0f / D_MODEL) + EPS);
        const float* sha = modp(p, l, row, which * 3 + 0); const float* sca = modp(p, l, row, which * 3 + 1);
        const float* shb = modp(p, l, row1, which * 3 + 0); const float* scb = modp(p, l, row1, which * 3 + 1);
#pragma unroll
        for (int j = 0; j < 4; ++j) { const int c = j * 256 + lane * 4; const f32x4 gv = *(const f32x4*)(g + c);
            store4bf(p.hbuf + (size_t)row * D_MODEL + c, va[j] * ra * gv * (*(const f32x4*)(sca + c) + 1.0f) + *(const f32x4*)(sha + c));
            if (row1 != row) store4bf(p.hbuf + (size_t)row1 * D_MODEL + c, vb[j] * rb * gv * (*(const f32x4*)(scb + c) + 1.0f) + *(const f32x4*)(shb + c)); }
    }
}
__device__ __forceinline__ void ph_route_a(const Params& p, char* lds, int l, int nrows, int bid, int nb) {
    const int lane = threadIdx.x & 63, wid = threadIdx.x >> 6;
    float* wr_s = (float*)lds; int* hist = (int*)(lds + 65536);
    for (int i = threadIdx.x; i < D_MODEL * 4; i += NTHREADS) { const int k = i >> 2, ch = i & 3; ((f32x4*)wr_s)[k * 4 + (ch ^ ((k >> 2) & 3))] = ((const f32x4*)p.w_router)[i]; }
    if (threadIdx.x < 32) hist[threadIdx.x] = 0;
    __syncthreads();
    const int sw = (lane >> 2) & 3;
    const float* g = p.norm_g + (l * 2 + 1) * D_MODEL;
    const int RPB = (nrows + nb - 1) / nb, r0 = bid * RPB;
    for (int j = wid; j < RPB; j += 4) {
        const int row = r0 + j; if (row >= nrows) break;
        const float* xr = xrow_cur(p, row); const float* sh = modp(p, l, row, 3); const float* sc = modp(p, l, row, 4);
        float v[16]; float ss = 0.f;
#pragma unroll
        for (int i = 0; i < 16; ++i) { v[i] = xr[lane + 64 * i]; ss += v[i] * v[i]; }
        const float rstd = 1.0f / sqrtf(wave_sum(ss) * (1.0f / D_MODEL) + EPS);
        float lg[16];
#pragma unroll
        for (int e = 0; e < 16; ++e) lg[e] = 0.f;
#pragma unroll
        for (int i = 0; i < 16; ++i) { const int k = lane + 64 * i; const float o = v[i] * rstd * g[k] * (sc[k] + 1.0f) + sh[k];
            p.hbuf[(size_t)row * D_MODEL + k] = f2bf(o);
            const f32x4* w4 = (const f32x4*)(wr_s + k * 16);
#pragma unroll
            for (int e4 = 0; e4 < 4; ++e4) { const f32x4 wv = w4[e4 ^ sw]; lg[e4 * 4 + 0] += o * wv[0]; lg[e4 * 4 + 1] += o * wv[1]; lg[e4 * 4 + 2] += o * wv[2]; lg[e4 * 4 + 3] += o * wv[3]; }
            if (i & 1) __builtin_amdgcn_sched_barrier(0); }
        {
#pragma unroll
            for (int i = 0; i < 8; ++i) { const float a = lg[i], b = lg[i + 8]; const bool up = (lane & 32) != 0; const float recv = __shfl_xor(up ? a : b, 32); lg[i] = (up ? b : a) + recv; }
#pragma unroll
            for (int i = 0; i < 4; ++i) { const float a = lg[i], b = lg[i + 4]; const bool up = (lane & 16) != 0; const float recv = __shfl_xor(up ? a : b, 16); lg[i] = (up ? b : a) + recv; }
#pragma unroll
            for (int i = 0; i < 2; ++i) { const float a = lg[i], b = lg[i + 2]; const bool up = (lane & 8) != 0; const float recv = __shfl_xor(up ? a : b, 8); lg[i] = (up ? b : a) + recv; }
            { const float a = lg[0], b = lg[1]; const bool up = (lane & 4) != 0; const float recv = __shfl_xor(up ? a : b, 4); lg[0] = (up ? b : a) + recv; }
            lg[0] += __shfl_xor(lg[0], 2); lg[0] += __shfl_xor(lg[0], 1);
            const float mine = lg[0];
#pragma unroll
            for (int e = 0; e < 16; ++e) lg[e] = __builtin_bit_cast(float, __builtin_amdgcn_readlane(__builtin_bit_cast(int, mine), 4 * e));
        }
        if (lane == 0) {
            int gbest = 0, a = 0, bb = 1; float gbs = -1e30f, wa = 0.f, wb = 0.f;
#pragma unroll
            for (int gI = 0; gI < 4; ++gI) {
                float m1 = -1e30f, m2 = -1e30f, s1 = 0.f, s2 = 0.f; int i1 = 0, i2 = 0;
#pragma unroll
                for (int jj = 0; jj < 4; ++jj) { float sgv = sigmoid_f(lg[gI * 4 + jj]); float vv = sgv + p.b_router[gI * 4 + jj];
                    if (vv > m1) { m2 = m1; i2 = i1; s2 = s1; m1 = vv; i1 = jj; s1 = sgv; } else if (vv > m2) { m2 = vv; i2 = jj; s2 = sgv; } }
                float gs = m1 + m2;
                if (gs > gbs) { gbs = gs; gbest = gI; if (i1 < i2) { a = i1; bb = i2; wa = s1; wb = s2; } else { a = i2; bb = i1; wa = s2; wb = s1; } }
            }
            const float inv = 1.0f / (wa + wb);
            const int pidx = a == 0 ? bb - 1 : (a == 1 ? bb + 1 : 5);
            const int pr = gbest * 6 + pidx;
            p.rpair[row] = pr; p.tokw[row * 2 + 0] = wa * inv; p.tokw[row * 2 + 1] = wb * inv;
            atomicAdd(&hist[pr], 1);
        }
    }
    __syncthreads();
    if (threadIdx.x < 32) p.bh[bid * 32 + threadIdx.x] = hist[threadIdx.x];
}
__device__ __forceinline__ void ph_route_b(const Params& p, char* lds, int l, int nrows, int bid, int nb) {
    int* sb = (int*)lds;
    const int t = threadIdx.x, pr = t & 31, part = t >> 5;
    { int s_before = 0, s_all = 0; const int b0 = (part * nb) >> 3, b1 = ((part + 1) * nb) >> 3;
      for (int b = b0; b < b1; ++b) { const int c = p.bh[b * 32 + pr]; s_all += c; if (b < bid) s_before += c; }
      sb[part * 32 + pr] = s_before; sb[256 + part * 32 + pr] = s_all; }
    __syncthreads();
    if (t < 32) { int a = 0, c = 0;
#pragma unroll
        for (int q = 0; q < 8; ++q) { a += sb[q * 32 + t]; c += sb[256 + q * 32 + t]; }
        sb[512 + t] = a; sb[544 + t] = c; if (bid == 0) p.cnt[l * 32 + t] = c; }
    const int RPB = (nrows + nb - 1) / nb, row = bid * RPB + t; const bool act = t < RPB && row < nrows;
    int myp = 0; if (act) { myp = p.rpair[row]; sb[576 + t] = myp; }
    __syncthreads();
    if (act) { int rank = 0; for (int j = 0; j < t; ++j) rank += (sb[576 + j] == myp) ? 1 : 0; p.list[(size_t)myp * TT + sb[512 + myp] + rank] = row; }
    __syncthreads();
}
__device__ __forceinline__ void ph_final(const Params& p, int bid, int nb) {
    const int lane = threadIdx.x & 63, wid = threadIdx.x >> 6;
    for (int row = (bid * 4 + wid) * 2; row < TX; row += nb * 8) {
        float* xa = p.out + (size_t)row * D_MODEL; float* xb = xa + D_MODEL;
        f32x4 va[4], vb[4]; float sa = 0.f, sb = 0.f;
#pragma unroll
        for (int j = 0; j < 4; ++j) { va[j] = *(const f32x4*)(xa + j * 256 + lane * 4); vb[j] = *(const f32x4*)(xb + j * 256 + lane * 4); }
#pragma unroll
        for (int j = 0; j < 4; ++j) { sa += va[j][0] * va[j][0] + va[j][1] * va[j][1] + va[j][2] * va[j][2] + va[j][3] * va[j][3]; sb += vb[j][0] * vb[j][0] + vb[j][1] * vb[j][1] + vb[j][2] * vb[j][2] + vb[j][3] * vb[j][3]; }
        const float ra = 1.0f / sqrtf(wave_sum(sa) * (1.0f / D_MODEL) + EPS), rb = 1.0f / sqrtf(wave_sum(sb) * (1.0f / D_MODEL) + EPS);
#pragma unroll
        for (int j = 0; j < 4; ++j) { const int c = j * 256 + lane * 4; const f32x4 gv = *(const f32x4*)(p.final_g + c); *(f32x4*)(xa + c) = va[j] * ra * gv; *(f32x4*)(xb + c) = vb[j] * rb * gv; }
    }
}

#define XB_TMO      128
#define XB_XCNT(j)  (256  + 64 * (j))
#define XB_XSUB(j)  (1280 + 64 * (j))
#define XB_XGEN(j)  (2304 + 64 * (j))
#define XB_TOP      3328
#define XB_TOPGEN   3392
#define XCD_BAR_WORDS 3456
#define XB_SPIN_CAP (1u << 20)
__device__ __forceinline__ unsigned xb_ld(unsigned* p)              { return __hip_atomic_load(p, __ATOMIC_RELAXED, __HIP_MEMORY_SCOPE_AGENT); }
__device__ __forceinline__ unsigned xb_add(unsigned* p, unsigned v) { return __hip_atomic_fetch_add(p, v, __ATOMIC_RELAXED, __HIP_MEMORY_SCOPE_AGENT); }
__device__ __forceinline__ unsigned xb_xcc_id() { return (unsigned)__builtin_amdgcn_s_getreg((3 << 11) | 20) & 0xFu; }
#define XB_SPIN(cond, bar) do { unsigned _sp = 0; while (cond) { __builtin_amdgcn_s_sleep(1); \
    if ((++_sp & 255u) == 0u) { if (xb_ld(&(bar)[XB_TMO])) break; if (_sp > XB_SPIN_CAP) { atomicAdd(&(bar)[XB_TMO], 1u); break; } } } } while (0)
struct XcdBarrier { unsigned* bar; unsigned x; volatile LAS unsigned* st; };
__device__ __forceinline__ XcdBarrier xcd_barrier_post(unsigned* bar, volatile LAS unsigned* st) {
    XcdBarrier b; b.bar = bar; b.x = xb_xcc_id(); b.st = st;
    if (threadIdx.x == 0) (void)xb_add(&bar[XB_XCNT(b.x)], 1u);
    return b;
}
__device__ __forceinline__ void xcd_barrier_complete(unsigned* bar, unsigned x, unsigned& nloc, unsigned& nx) {
    const unsigned G = gridDim.x * gridDim.y * gridDim.z;
    unsigned sum, cnt, mine, sp = 0u;
    for (;;) {
        sum = 0u; cnt = 0u; mine = 0u;
#pragma unroll
        for (unsigned j = 0; j < 16; ++j) { const unsigned c = xb_ld(&bar[XB_XCNT(j)]); sum += c; cnt += (c > 0u) ? 1u : 0u; mine = (j == x) ? c : mine; }
        if (sum == G) break;
        __builtin_amdgcn_s_sleep(1);
        if ((++sp & 255u) == 0u) { if (xb_ld(&bar[XB_TMO])) break; if (sp > XB_SPIN_CAP) { atomicAdd(&bar[XB_TMO], 1u); break; } }
    }
    nloc = mine > 0u ? mine : 1u; nx = cnt > 0u ? cnt : 1u;
}
__device__ __forceinline__ void xcd_barrier(const XcdBarrier& b) {
    asm volatile("s_waitcnt vmcnt(0)" ::: "memory");
    __syncthreads();
    if (threadIdx.x == 0) {
        unsigned* bar = b.bar;
        __builtin_amdgcn_s_waitcnt(0);
        unsigned nloc = b.st[0], nx = b.st[1];
        if (nloc == 0u) { xcd_barrier_complete(bar, b.x, nloc, nx); b.st[0] = nloc; b.st[1] = nx; }
        const unsigned old = xb_add(&bar[XB_XSUB(b.x)], 1u);
        const unsigned gen = old / nloc;
        if (old + 1u == (gen + 1u) * nloc) {
            __builtin_amdgcn_fence(__ATOMIC_RELEASE, "agent");
            asm volatile("s_waitcnt vmcnt(0)" ::: "memory");
            const unsigned og = xb_add(&bar[XB_TOP], 1u);
            const unsigned tg = og / nx;
            if (og + 1u == (tg + 1u) * nx) xb_add(&bar[XB_TOPGEN], 1u);
            else XB_SPIN(xb_ld(&bar[XB_TOPGEN]) == tg, bar);
            __builtin_amdgcn_fence(__ATOMIC_ACQUIRE, "agent");
            xb_add(&bar[XB_XGEN(b.x)], 1u);
            asm volatile("s_waitcnt vmcnt(0)" ::: "memory");
        } else {
            XB_SPIN(xb_ld(&bar[XB_XGEN(b.x)]) == gen, bar);
            __builtin_amdgcn_fence(__ATOMIC_ACQUIRE, "agent");
            asm volatile("s_waitcnt vmcnt(0)" ::: "memory");
        }
    }
    __syncthreads();
}

__device__ __forceinline__ void ph_mix1(const Params& p, char* lds, int bid, int nb, unsigned long long* tsplit = nullptr) {
    const bool hy_first = bid >= (nb >> 1);
    for (int rep = 0; rep < 3; ++rep) {
        if (rep == 1) {
            for (int u = bid; u < NU_LAT; u += nb) { const int blk = u % (SEQ / 128), h = (u / (SEQ / 128)) % 8, b = u / (8 * (SEQ / 128)); const int s0 = blk * 128;
                attn_unit<0>(lds, p.QC + (size_t)(b * SEQ + s0) * 512 + h * 64, p.KC + (size_t)(b * 2 + h / 4) * LKV * 64, p.VCt + (size_t)(b * 2 + h / 4) * 64 * LKV,
                             p.Y + (size_t)(b * SEQ + s0) * 1024 + h * 64, s0, CTX_LEN / 64, 0, SEQ / 64, 0.f, false, nullptr); }
            if (tsplit) *tsplit = __builtin_amdgcn_s_memrealtime();
        } else if ((rep == 0) == hy_first) {
            __syncthreads();
            for (int c = hy_first ? bid - (nb >> 1) : bid + (nb >> 1); c < D_CH; c += nb) hyena_channel(p, c, (float*)lds);
            __syncthreads();
        }
    }
}
constexpr int TR_ITEMS = BATCH * (D_CH / 64) * (SEQ / 64);
__device__ __forceinline__ void tr_item(const Params& p, char* lds, int it) {
    bf16_t* T = (bf16_t*)lds; const int tid = threadIdx.x;
    const int sb = it % (SEQ / 64), cb = (it / (SEQ / 64)) % (D_CH / 64), b = it / ((SEQ / 64) * (D_CH / 64));
    { const int c = tid >> 2, q = tid & 3;
      const u32x4* src = (const u32x4*)(p.YHT + ((size_t)b * D_CH + cb * 64 + c) * SEQ + sb * 64 + q * 16);
      const u32x4 v0 = src[0], v1 = src[1]; unsigned* d = (unsigned*)(T + c * 66 + q * 16);
      d[0] = v0.x; d[1] = v0.y; d[2] = v0.z; d[3] = v0.w; d[4] = v1.x; d[5] = v1.y; d[6] = v1.z; d[7] = v1.w; }
    __syncthreads();
    { const int s = tid >> 2, q = tid & 3;
      unsigned w[8];
#pragma unroll
      for (int i = 0; i < 8; ++i) w[i] = (unsigned)T[(q * 16 + 2 * i) * 66 + s] | ((unsigned)T[(q * 16 + 2 * i + 1) * 66 + s] << 16);
      u32x4* dst = (u32x4*)(p.Y + ((size_t)b * SEQ + sb * 64 + s) * 1024 + 512 + cb * 64 + q * 16);
      dst[0] = (u32x4){w[0], w[1], w[2], w[3]}; dst[1] = (u32x4){w[4], w[5], w[6], w[7]}; }
    __syncthreads();
}
enum { PH_PREP = 0, PH_NORM0, PH_INPROJ0, PH_ATTN0, PH_OUT0, PH_ROUTE0, PH_ROUTEB0, PH_UP0, PH_DOWN0, PH_NORM1, PH_INPROJ1, PH_MIX1, PH_TR1, PH_OUT1, PH_ROUTE1, PH_ROUTEB1, PH_UP1, PH_DOWN1, PH_FINAL, PH_COUNT };
typedef const __attribute__((address_space(4))) Params* KParams;
__global__ void __launch_bounds__(NTHREADS, 2) mega(Params p_arg, int lo, int hi) {
    extern __shared__ __attribute__((aligned(16))) char lds[];
    const int bid = blockIdx.x, nb = gridDim.x;
    volatile LAS unsigned* st = (volatile LAS unsigned*)(lds + LDS_BYTES - 16);
    if (threadIdx.x < 4) st[threadIdx.x] = 0u;
    __syncthreads();
    KParams kp = (KParams)__builtin_amdgcn_kernarg_segment_ptr();
    XcdBarrier bar; bar.bar = kp->bar; bar.x = 0; bar.st = st;
    if (hi - lo > 1) bar = xcd_barrier_post(kp->bar, st);
#ifdef PROBE_PA
    unsigned long long ts_prev = __builtin_amdgcn_s_memrealtime(), t_a = 0, t_b = 0;
#define STAMP(PH) if (bid == 0 && threadIdx.x == 0) { const unsigned long long now_ = __builtin_amdgcn_s_memrealtime(); if ((PH) == PROBE_PA) t_a = now_ - ts_prev; if ((PH) == PROBE_PB) t_b = now_ - ts_prev; ts_prev = now_; }
#else
#define STAMP(PH)
#endif
#define PHASE(PH, body) if (lo <= (PH) && (PH) < hi) { { KParams kq_ = kp; asm volatile("" : "+s"(kq_)); const Params& p = *(const Params*)kq_; body; } if ((PH) + 1 < hi) xcd_barrier(bar); STAMP(PH) }
    PHASE(PH_PREP, { if (nb > MOD_ITEMS + 64) { if (bid < MOD_ITEMS) mod_item(p, lds, bid); else cvt_range(p, lds, 0, CVT_EARLY, bid - MOD_ITEMS, nb - MOD_ITEMS); }
        else { for (int it = bid; it < MOD_ITEMS; it += nb) mod_item(p, lds, it); cvt_range(p, lds, 0, CVT_EARLY, bid, nb); }
        d_rope(p); d_hy_h1(p); })
#if PROBE == 7
    PHASE(PH_NORM0, { ph_norm(p, 0, 0, TT, bid, nb); ph_norm(p, 0, 0, TT, bid, nb); ph_norm(p, 0, 0, TT, bid, nb); d_hy_h2(p); })
#else
    PHASE(PH_NORM0, { ph_norm(p, 0, 0, TT, bid, nb); d_hy_h2(p); })
#endif
#if PROBE == 1
    PHASE(PH_INPROJ0, { ph_inproj<0>(p, lds, bid, nb); __syncthreads(); ph_inproj<0>(p, lds, bid, nb); })
#else
    PHASE(PH_INPROJ0, ph_inproj<0>(p, lds, bid, nb))
#endif
#if PROBE == 2
    PHASE(PH_ATTN0, { ph_attn0(p, lds, bid, nb); __syncthreads(); ph_attn0(p, lds, bid, nb); })
#else
    PHASE(PH_ATTN0, { if (bid >= (nb >> 1)) { cvt_range(p, lds, CVT_EARLY, CVT_TOTAL, bid, nb); __syncthreads(); ph_attn0(p, lds, bid, nb); } else { ph_attn0(p, lds, bid, nb); __syncthreads(); cvt_range(p, lds, CVT_EARLY, CVT_TOTAL, bid, nb); } })
#endif
#if PROBE == 10
    PHASE(PH_OUT0, { ph_outproj<0>(p, lds, bid, nb); __syncthreads(); ph_outproj<0>(p, lds, bid, nb); })
#elif PROBE == 11
    PHASE(PH_OUT0, { for (int i_ = 0; i_ < 10; ++i_) xcd_barrier(bar); ph_outproj<0>(p, lds, bid, nb); })
#else
    PHASE(PH_OUT0, { ph_outproj<0>(p, lds, bid, nb);
        const int rem_ = (MT_ALL * 8) % nb; __syncthreads(); if (bid >= rem_) for (int it = bid - rem_; it < FILT_ITEMS; it += nb - rem_) filt_item(p, lds, it); })
#endif
    PHASE(PH_ROUTE0, ph_route_a(p, lds, 0, TT, bid, nb))
    PHASE(PH_ROUTEB0, ph_route_b(p, lds, 0, TT, bid, nb))
#if PROBE == 9
    PHASE(PH_UP0, { ph_moe_up(p, lds, 0, bid, nb); __syncthreads(); ph_moe_up(p, lds, 0, bid, nb); })
#else
    PHASE(PH_UP0, ph_moe_up(p, lds, 0, bid, nb))
#endif
#if PROBE == 12
    PHASE(PH_DOWN0, { ph_moe_down<true>(p, lds, 0, bid, nb); __syncthreads(); ph_moe_down(p, lds, 0, bid, nb); })
#else
    PHASE(PH_DOWN0, ph_moe_down(p, lds, 0, bid, nb))
#endif
    PHASE(PH_NORM1, ph_norm(p, 1, 0, TT, bid, nb))
    PHASE(PH_INPROJ1, ph_inproj<1>(p, lds, bid, nb))
#if PROBE == 3
    PHASE(PH_MIX1, { ph_attnC(p, lds, bid, nb); __syncthreads(); ph_mix1(p, lds, bid, nb); })
#elif PROBE == 4
    PHASE(PH_MIX1, { for (int c = bid; c < D_CH; c += nb) hyena_channel(p, c, (float*)lds); __syncthreads(); ph_mix1(p, lds, bid, nb); })
#else
#if defined(PROBE_PA) && PROBE_PA == 100
    { unsigned long long tsp = 0, t0_ = __builtin_amdgcn_s_memrealtime(); ph_mix1(p, lds, bid, nb, &tsp); unsigned long long t1_ = __builtin_amdgcn_s_memrealtime(); if (bid == 0 && threadIdx.x == 0) { t_a = tsp - t0_; t_b = t1_ - tsp; } xcd_barrier(bar); }
#else
    PHASE(PH_MIX1, ph_mix1(p, lds, bid, nb))
#endif
#endif
    PHASE(PH_TR1, for (int it = bid; it < TR_ITEMS; it += nb) tr_item(p, lds, it))
    PHASE(PH_OUT1, ph_outproj<1>(p, lds, bid, nb))
    PHASE(PH_ROUTE1, ph_route_a(p, lds, 1, TX, bid, nb))
    PHASE(PH_ROUTEB1, ph_route_b(p, lds, 1, TX, bid, nb))
    PHASE(PH_UP1, ph_moe_up(p, lds, 1, bid, nb))
    PHASE(PH_DOWN1, ph_moe_down(p, lds, 1, bid, nb))
    PHASE(PH_FINAL, ph_final(p, bid, nb))
#ifdef PROBE_PA
    if (bid == 0 && threadIdx.x == 0) {
        const unsigned long long delay = 2 * t_a + 204800ull * ((t_b + 200) / 400); const unsigned long long t0 = __builtin_amdgcn_s_memrealtime();
        while (__builtin_amdgcn_s_memrealtime() - t0 < delay) __builtin_amdgcn_s_sleep(32);
    }
#endif
}
extern "C" void kernel_launch(void* const* d_in, const int* in_sizes, int n_in, void* d_out, int out_size, void* d_ws, size_t ws_size, hipStream_t stream) {
    static int grid = 0;
    if (grid == 0) {
        int dev = 0, cus = 0;
        if (hipGetDevice(&dev) != hipSuccess || hipDeviceGetAttribute(&cus, hipDeviceAttributeMultiprocessorCount, dev) != hipSuccess) { fprintf(stderr, "kernel_launch: device query failed\n"); grid = -1; return; }
        if (hipFuncSetAttribute((const void*)mega, hipFuncAttributeMaxDynamicSharedMemorySize, LDS_BYTES) != hipSuccess) { fprintf(stderr, "kernel_launch: hipFuncSetAttribute failed\n"); grid = -1; return; }
        grid = 2 * cus;
    }
    if (grid < 0) return;
    Params p{};
    size_t need = setup_ws(p, (char*)d_ws);
    if (n_in != 32 || need > ws_size || out_size != TX * D_MODEL) { fprintf(stderr, "kernel_launch: bad config n_in %d ws %zu need %zu out %d\n", n_in, ws_size, need, out_size); return; }
    fill_inputs(p, d_in, d_out);
    hipMemsetAsync(p.bar, 0, 64 * 1024 + 256, stream);
#ifdef PER_PHASE
    for (int ph = 0; ph < PH_COUNT; ++ph) mega<<<dim3(grid), dim3(NTHREADS), LDS_BYTES, stream>>>(p, ph, ph + 1);
#else
    mega<<<dim3(grid), dim3(NTHREADS), LDS_BYTES, stream>>>(p, 0, PH_COUNT);
#endif
}
```

```cpp
#include <hip/hip_runtime.h>
#include <cstdio>
#include <math.h>
#include <stdint.h>
#include <string.h>

#ifdef CPU_TEST
#define HD
#define GLOBAL
struct U3 { unsigned x, y, z; };
static thread_local U3 threadIdx, blockIdx, blockDim, gridDim;
static inline int atomicAdd(int* p, int v) { return __sync_fetch_and_add(p, v); }
#else
#define HD __device__ __forceinline__
#define GLOBAL __global__ __launch_bounds__(256)
#endif

#if defined(HY_TEST)
constexpr int D_MODEL = 64, BATCH = 2, SEQ = 4096, GRID_W = 64, CTX_LEN = 64, D_CH = 4, D_EXPERT = 64;
#elif defined(SMALL_CFG)
constexpr int D_MODEL = 128, BATCH = 2, SEQ = 512, GRID_W = 32, CTX_LEN = 64, D_CH = 32, D_EXPERT = 64;
#else
constexpr int D_MODEL = 1024, BATCH = 4, SEQ = 4096, GRID_W = 64, CTX_LEN = 256, D_CH = 512, D_EXPERT = 512;
#endif
constexpr int DEPTH = 2, HEAD_DIM = 64;
constexpr int GRID_H = SEQ / GRID_W;
constexpr int A_WINDOW = 128;
constexpr int B_WIN_H = 8, B_WIN_W = 16;
constexpr int HY_BANDS = 16, HY_EMB = 33, HY_FFN = 64;
constexpr int EVEN_IN = 2304, EVEN_OUT = 1024;
constexpr int ODD_IN = 768 + 3 * D_CH, ODD_OUT = 512 + D_CH;
constexpr int N_EXPERTS = 16;
constexpr int TX = BATCH * SEQ, TC = BATCH * CTX_LEN, TT = TX + TC;
constexpr int LKV = CTX_LEN + SEQ;
constexpr int NPAIR = 24;
constexpr int HE_W = 2 * D_EXPERT;
constexpr float EPS = 1e-6f;
constexpr float ATTN_SCALE = 0.125f;

typedef unsigned short bf16_t;
HD bf16_t f2bf(float f) { unsigned u; __builtin_memcpy(&u, &f, 4); u = (u + 0x7fffu + ((u >> 16) & 1u)) >> 16; return (bf16_t)u; }
HD float bf2f(bf16_t h) { unsigned u = ((unsigned)h) << 16; float f; __builtin_memcpy(&f, &u, 4); return f; }
HD float silu_f(float x) { return x / (1.0f + expf(-x)); }
HD float sigmoid_f(float x) { return 1.0f / (1.0f + expf(-x)); }

struct Params {
    const float *x, *c, *ctx, *c_ctx, *w_ada, *b_ada, *norm_g, *final_g, *w_in_even, *w_out_even, *a_sink, *b_rpb;
    const float *w_in_odd, *w_out_odd, *c_qnorm, *c_knorm, *hy_short_w, *hy_short_b, *hy_w1, *hy_b1, *hy_f1, *hy_w2;
    const float *hy_b2, *hy_f2, *hy_w3, *hy_b3, *hy_bias, *w_router, *b_router, *moe_wg, *moe_wu, *moe_wd;
    float* out;
    float* XC;
    float* mod;
    float* ropet;
    float* h1;
    float* h2;
    float* HFT;
    float* hnorm;
    bf16_t* hbuf;
    bf16_t *QA, *KA, *VAt, *QB, *KB, *VBt;
    bf16_t *QC, *KC, *VCt, *UT;
    bf16_t* Y;
    bf16_t* YHT;
    float* Z1;
    bf16_t* HE;
    int* cnt;
    int* list;
    float* tokw;
    bf16_t *Wt_in_even, *Wt_out_even, *Wt_in_odd, *Wt_out_odd, *Wt_gu, *Wt_d;
    unsigned* bar;
    int* rpair;
    int* bh;
    float* rlog;
};

#define GS_LOOP(i, n) for (long i = (long)blockIdx.x * blockDim.x + threadIdx.x; i < (long)(n); i += (long)gridDim.x * blockDim.x)

HD const float* xrow_in(const Params& p, int l, int row) {
    if (l == 0) return row < TX ? p.x + (size_t)row * D_MODEL : p.ctx + (size_t)(row - TX) * D_MODEL;
    return row < TX ? p.out + (size_t)row * D_MODEL : p.XC + (size_t)(row - TX) * D_MODEL;
}
HD float* xrow_cur(const Params& p, int row) { return row < TX ? p.out + (size_t)row * D_MODEL : p.XC + (size_t)(row - TX) * D_MODEL; }
HD int row_mod(int row) { return row < TX ? row / SEQ : BATCH; }
HD const float* modp(const Params& p, int l, int row, int which) { return p.mod + ((size_t)(l * (BATCH + 1) + row_mod(row)) * 6 + which) * D_MODEL; }

GLOBAL void nk_mod(Params p) {
    GS_LOOP(i, DEPTH * (BATCH + 1) * 6 * D_MODEL) {
        int j = i % (6 * D_MODEL); int r = (i / (6 * D_MODEL)) % (BATCH + 1); int l = i / (6 * D_MODEL * (BATCH + 1));
        const float* cv = r < BATCH ? p.c + r * D_MODEL : p.c_ctx;
        const float* w = p.w_ada + (size_t)l * D_MODEL * 6 * D_MODEL;
        float acc = 0.f;
        for (int k = 0; k < D_MODEL; ++k) acc += silu_f(cv[k]) * w[(size_t)k * 6 * D_MODEL + j];
        p.mod[i] = acc + p.b_ada[l * 6 * D_MODEL + j];
    }
}
HD void d_rope(const Params& p) {
    GS_LOOP(i, 64 * 16) {
        int pos = i / 16, k = i % 16;
        float inv = powf(10000.0f, -(float)(2 * k) / 32.0f);
        float a = (float)pos * inv;
        p.ropet[pos * 32 + k] = cosf(a); p.ropet[pos * 32 + 16 + k] = sinf(a);
    }
}
HD void d_hy_h1(const Params& p) {
    GS_LOOP(i, SEQ * HY_FFN) {
        int t = i / HY_FFN, k = i % HY_FFN;
        float tn = (float)t / (float)(SEQ - 1);
        float acc = tn * p.hy_w1[0 * HY_FFN + k];
        for (int b = 0; b < HY_BANDS; ++b) {
            float band = 1e-4f + (float)b * ((float)(HY_BANDS - 1) - 1e-4f) / (float)(HY_BANDS - 1);
            float ang = 2.0f * 3.14159265358979323846f * (float)t * band / (float)SEQ;
            acc += cosf(ang) * p.hy_w1[(1 + b) * HY_FFN + k] + sinf(ang) * p.hy_w1[(1 + HY_BANDS + b) * HY_FFN + k];
        }
        p.h1[i] = sinf(p.hy_f1[k] * (acc + p.hy_b1[k]));
    }
}
HD void d_hy_h2(const Params& p) {
    GS_LOOP(i, SEQ * HY_FFN) {
        int t = i / HY_FFN, j = i % HY_FFN;
        float acc = 0.f;
        for (int k = 0; k < HY_FFN; ++k) acc += p.h1[t * HY_FFN + k] * p.hy_w2[k * HY_FFN + j];
        p.h2[i] = sinf(p.hy_f2[j] * (acc + p.hy_b2[j]));
    }
}
HD float hy_decay(int t, int c) {
    const float mind = logf(1e-2f) / 1.5f, maxd = logf(1e-2f) / 0.3f;
    float delta = fabsf(mind + (float)c * (maxd - mind) / (float)(D_CH - 1));
    float tn = (float)t / (float)(SEQ - 1);
    return expf(-tn * delta);
}
GLOBAL void nk_hy_filt(Params p) {
    GS_LOOP(i, 4 * D_CH * SEQ) {
        int t = i % SEQ, col = i / SEQ, c = col % D_CH;
        float acc = p.hy_b3[col];
        for (int k = 0; k < HY_FFN; ++k) acc += p.h2[t * HY_FFN + k] * p.hy_w3[k * 4 * D_CH + col];
        p.HFT[i] = acc * hy_decay(t, c);
    }
}
GLOBAL void nk_hy_norm(Params p) {
    GS_LOOP(i, 2 * D_CH) {
        int o = i / D_CH, c = i % D_CH;
        float s = 0.f;
        for (int dir = 0; dir < 2; ++dir) { const float* h = p.HFT + (size_t)((dir * 2 + o) * D_CH + c) * SEQ; for (int t = 0; t < SEQ; ++t) s += fabsf(h[t]); }
        p.hnorm[i] = s + EPS;
    }
}
GLOBAL void nk_zero_cnt(Params p) { GS_LOOP(i, 64) p.cnt[i] = 0; }

GLOBAL void nk_norm(Params p, int l, int which, int nrows) {
    GS_LOOP(row, nrows) {
        const float* xr = which == 0 ? xrow_in(p, l, (int)row) : xrow_cur(p, (int)row);
        float ss = 0.f;
        for (int k = 0; k < D_MODEL; ++k) ss += xr[k] * xr[k];
        float rstd = 1.0f / sqrtf(ss / D_MODEL + EPS);
        const float* g = p.norm_g + (l * 2 + which) * D_MODEL;
        const float* sh = modp(p, l, (int)row, which * 3 + 0); const float* sc = modp(p, l, (int)row, which * 3 + 1);
        for (int k = 0; k < D_MODEL; ++k) p.hbuf[row * D_MODEL + k] = f2bf(xr[k] * rstd * g[k] * (1.0f + sc[k]) + sh[k]);
    }
}

HD float dot_row(const bf16_t* a, const float* W, int ldw, int col, int K) {
    float acc = 0.f;
    for (int k = 0; k < K; ++k) acc += bf2f(a[k]) * W[(size_t)k * ldw + col];
    return acc;
}
HD float rope_apply(const Params& p, float v, float partner, int d, int s) {
    int half = d >> 5, dd = d & 31, k = dd & 15;
    int pos = half == 0 ? s / GRID_W : s % GRID_W;
    float c = p.ropet[pos * 32 + k], sn = p.ropet[pos * 32 + 16 + k];
    return dd < 16 ? v * c - partner * sn : v * c + partner * sn;
}

GLOBAL void nk_inproj_even(Params p) {
    GS_LOOP(i, (long)TT * EVEN_IN) {
        int row = i / EVEN_IN, col = i % EVEN_IN;
        const bf16_t* a = p.hbuf + (size_t)row * D_MODEL;
        float v = dot_row(a, p.w_in_even, EVEN_IN, col, D_MODEL);
        bool lat = row < TX; int b = lat ? row / SEQ : (row - TX) / CTX_LEN; int s = lat ? row % SEQ : (row - TX) % CTX_LEN;
        int pos = lat ? CTX_LEN + s : s;
        if (col < 640) {
            int d = col & 63;
            if (lat) { int pc = (d & 31) < 16 ? col + 16 : col - 16; float pv = dot_row(a, p.w_in_even, EVEN_IN, pc, D_MODEL); v = rope_apply(p, v, pv, d, s); }
            if (col < 512) p.QA[(size_t)row * 512 + col] = f2bf(v);
            else { int h = (col - 512) >> 6; p.KA[((size_t)(b * 2 + h) * LKV + pos) * 64 + d] = f2bf(v); }
        } else if (col < 768) { int h = (col - 640) >> 6, d = col & 63; p.VAt[((size_t)(b * 2 + h) * 64 + d) * LKV + pos] = f2bf(v); }
        else if (col < 1280) p.QB[(size_t)row * 512 + (col - 768)] = f2bf(v);
        else if (col < 1792) { int h = (col - 1280) >> 6, d = col & 63; p.KB[((size_t)(b * 8 + h) * LKV + pos) * 64 + d] = f2bf(v); }
        else { int h = (col - 1792) >> 6, d = col & 63; p.VBt[((size_t)(b * 8 + h) * 64 + d) * LKV + pos] = f2bf(v); }
    }
}

struct OSM { float m, l; };
#define ATT_BEGIN() float q[64], acc[64]; for (int d = 0; d < 64; ++d) { q[d] = bf2f(qp[d]) * ATTN_SCALE; acc[d] = 0.f; } float m_ = -1e30f, l_ = 0.f;
#define ATT_KEY(Kp, Vt, key, bias) do { const bf16_t* kk_ = (Kp) + (size_t)(key) * 64; float s_ = (bias); for (int d = 0; d < 64; ++d) s_ += q[d] * bf2f(kk_[d]); \
    float mn_ = fmaxf(m_, s_); float f_ = expf(m_ - mn_), pe_ = expf(s_ - mn_); l_ = l_ * f_ + pe_; \
    for (int d = 0; d < 64; ++d) acc[d] = acc[d] * f_ + pe_ * bf2f((Vt)[(size_t)d * LKV + (key)]); m_ = mn_; } while (0)
#define ATT_SINK(sv) do { float s_ = (sv); float mn_ = fmaxf(m_, s_); float f_ = expf(m_ - mn_); l_ = l_ * f_ + expf(s_ - mn_); for (int d = 0; d < 64; ++d) acc[d] *= f_; m_ = mn_; } while (0)

GLOBAL void nk_attnA(Params p) {
    GS_LOOP(i, (long)TX * 8) {
        int h = i % 8, row = i / 8, b = row / SEQ, s = row % SEQ, kvh = h / 4;
        const bf16_t* qp = p.QA + (size_t)row * 512 + h * 64;
        const bf16_t* Kp = p.KA + (size_t)(b * 2 + kvh) * LKV * 64; const bf16_t* Vt = p.VAt + (size_t)(b * 2 + kvh) * 64 * LKV;
        ATT_BEGIN();
        for (int j = 0; j < CTX_LEN; ++j) ATT_KEY(Kp, Vt, j, 0.f);
        int lo = s - A_WINDOW < 0 ? 0 : s - A_WINDOW, hi = s + A_WINDOW > SEQ - 1 ? SEQ - 1 : s + A_WINDOW;
        for (int j = lo; j <= hi; ++j) ATT_KEY(Kp, Vt, CTX_LEN + j, 0.f);
        ATT_SINK(p.a_sink[h]);
        for (int d = 0; d < 64; ++d) p.Y[(size_t)row * 1024 + h * 64 + d] = f2bf(acc[d] / l_);
    }
}
GLOBAL void nk_attnB(Params p) {
    GS_LOOP(i, (long)TX * 8) {
        int h = i % 8, row = i / 8, b = row / SEQ, s = row % SEQ, r = s / GRID_W, cq = s % GRID_W;
        const bf16_t* qp = p.QB + (size_t)row * 512 + h * 64;
        const bf16_t* Kp = p.KB + (size_t)(b * 8 + h) * LKV * 64; const bf16_t* Vt = p.VBt + (size_t)(b * 8 + h) * 64 * LKV;
        ATT_BEGIN();
        for (int j = 0; j < CTX_LEN; ++j) ATT_KEY(Kp, Vt, j, 0.f);
        int kh = B_WIN_H < GRID_H ? B_WIN_H : GRID_H;
        int rs = r - kh / 2; if (rs < 0) rs = 0; if (rs > GRID_H - kh) rs = GRID_H - kh;
        int cs = cq - B_WIN_W / 2; if (cs < 0) cs = 0; if (cs > GRID_W - B_WIN_W) cs = GRID_W - B_WIN_W;
        for (int kr = rs; kr < rs + kh; ++kr)
            for (int kc = cs; kc < cs + B_WIN_W; ++kc) {
                int dr = kr - r, dc = kc - cq;
                float bias = p.b_rpb[(h * (2 * B_WIN_H - 1) + dr + B_WIN_H - 1) * (2 * B_WIN_W - 1) + dc + B_WIN_W - 1];
                ATT_KEY(Kp, Vt, CTX_LEN + kr * GRID_W + kc, bias);
            }
        for (int d = 0; d < 64; ++d) p.Y[(size_t)row * 1024 + 512 + h * 64 + d] = f2bf(acc[d] / l_);
    }
}
GLOBAL void nk_attn_ctx(Params p) {
    GS_LOOP(i, (long)TC * 16) {
        int hh = i % 16, rc = i / 16, ty = hh / 8, h = hh % 8, b = rc / CTX_LEN; int row = TX + rc;
        const bf16_t* qp = (ty == 0 ? p.QA : p.QB) + (size_t)row * 512 + h * 64;
        const bf16_t* Kp = ty == 0 ? p.KA + (size_t)(b * 2 + h / 4) * LKV * 64 : p.KB + (size_t)(b * 8 + h) * LKV * 64;
        const bf16_t* Vt = ty == 0 ? p.VAt + (size_t)(b * 2 + h / 4) * 64 * LKV : p.VBt + (size_t)(b * 8 + h) * 64 * LKV;
        ATT_BEGIN();
        for (int j = 0; j < CTX_LEN; ++j) ATT_KEY(Kp, Vt, j, 0.f);
        if (ty == 0) ATT_SINK(p.a_sink[h]);
        for (int d = 0; d < 64; ++d) p.Y[(size_t)row * 1024 + ty * 512 + h * 64 + d] = f2bf(acc[d] / l_);
    }
}
GLOBAL void nk_attnC(Params p) {
    GS_LOOP(i, (long)TX * 8) {
        int h = i % 8, row = i / 8, b = row / SEQ, kvh = h / 4;
        const bf16_t* qp = p.QC + (size_t)row * 512 + h * 64;
        const bf16_t* Kp = p.KC + (size_t)(b * 2 + kvh) * LKV * 64; const bf16_t* Vt = p.VCt + (size_t)(b * 2 + kvh) * 64 * LKV;
        ATT_BEGIN();
        for (int j = 0; j < LKV; ++j) ATT_KEY(Kp, Vt, j, 0.f);
        for (int d = 0; d < 64; ++d) p.Y[(size_t)row * 1024 + h * 64 + d] = f2bf(acc[d] / l_);
    }
}

GLOBAL void nk_outproj_even(Params p) {
    GS_LOOP(i, (long)TT * D_MODEL) {
        int row = i / D_MODEL, col = i % D_MODEL;
        float acc = dot_row(p.Y + (size_t)row * 1024, p.w_out_even, D_MODEL, col, EVEN_OUT);
        xrow_cur(p, row)[col] = xrow_in(p, 0, row)[col] + modp(p, 0, row, 2)[col] * acc;
    }
}
GLOBAL void nk_outproj_odd(Params p) {
    GS_LOOP(i, (long)TX * D_MODEL) {
        int row = i / D_MODEL, col = i % D_MODEL, b = row / SEQ, s = row % SEQ;
        float acc = dot_row(p.Y + (size_t)row * 1024, p.w_out_odd, D_MODEL, col, 512);
        for (int c = 0; c < D_CH; ++c) acc += bf2f(p.YHT[((size_t)b * D_CH + c) * SEQ + s]) * p.w_out_odd[(size_t)(512 + c) * D_MODEL + col];
        p.out[i] = p.out[i] + modp(p, 1, row, 2)[col] * acc;
    }
}

GLOBAL void nk_router(Params p, int l, int nrows) {
    GS_LOOP(row, nrows) {
        const float* xr = xrow_cur(p, (int)row);
        float ss = 0.f;
        for (int k = 0; k < D_MODEL; ++k) ss += xr[k] * xr[k];
        float rstd = 1.0f / sqrtf(ss / D_MODEL + EPS);
        const float* g = p.norm_g + (l * 2 + 1) * D_MODEL; const float* sh = modp(p, l, (int)row, 3); const float* sc = modp(p, l, (int)row, 4);
        float lg[16];
#pragma unroll
        for (int e = 0; e < 16; ++e) lg[e] = 0.f;
        for (int k = 0; k < D_MODEL; ++k) { float hv = xr[k] * rstd * g[k] * (1.0f + sc[k]) + sh[k];
#pragma unroll
            for (int e = 0; e < 16; ++e) lg[e] += hv * p.w_router[k * 16 + e]; }
        int gbest = 0, a = 0, bb = 1; float gbs = -1e30f, wa = 0.f, wb = 0.f;
#pragma unroll
        for (int gI = 0; gI < 4; ++gI) {
            float m1 = -1e30f, m2 = -1e30f, s1 = 0.f, s2 = 0.f; int i1 = 0, i2 = 0;
#pragma unroll
            for (int j = 0; j < 4; ++j) { float sgv = sigmoid_f(lg[gI * 4 + j]); float v = sgv + p.b_router[gI * 4 + j];
                if (v > m1) { m2 = m1; i2 = i1; s2 = s1; m1 = v; i1 = j; s1 = sgv; } else if (v > m2) { m2 = v; i2 = j; s2 = sgv; } }
            float gs = m1 + m2;
            if (gs > gbs) { gbs = gs; gbest = gI; if (i1 < i2) { a = i1; bb = i2; wa = s1; wb = s2; } else { a = i2; bb = i1; wa = s2; wb = s1; } }
        }
        float inv = 1.0f / (wa + wb);
        int pidx = a == 0 ? bb - 1 : (a == 1 ? bb + 1 : 5);
        int pr = gbest * 6 + pidx;
        int pos = atomicAdd(p.cnt + l * 32 + pr, 1);
        p.list[(size_t)pr * TT + pos] = (int)row;
        p.tokw[row * 2 + 0] = wa * inv; p.tokw[row * 2 + 1] = wb * inv;
    }
}
HD void pair_experts(int pr, int& e1, int& e2) { int g = pr / 6, q = pr % 6; int a = q < 3 ? 0 : (q < 5 ? 1 : 2); int b = q < 3 ? q + 1 : (q < 5 ? q - 1 : 3); e1 = g * 4 + a; e2 = g * 4 + b; }
HD bool slot_lookup(const Params& p, int l, int slot, int& pr, int& row) { int acc = 0; for (int q = 0; q < NPAIR; ++q) { int c = p.cnt[l * 32 + q]; if (slot < acc + c) { pr = q; row = p.list[(size_t)q * TT + (slot - acc)]; return true; } acc += c; } return false; }
GLOBAL void nk_moe_up(Params p, int l, int nrows) {
    GS_LOOP(i, (long)nrows * HE_W) {
        int slot = i / HE_W, j = i % HE_W, k = j / D_EXPERT, jj = j % D_EXPERT; int pr, row; if (!slot_lookup(p, l, slot, pr, row)) continue;
        int e1, e2; pair_experts(pr, e1, e2); int e = k == 0 ? e1 : e2;
        const bf16_t* a = p.hbuf + (size_t)row * D_MODEL;
        const float* wg = p.moe_wg + (size_t)(l * N_EXPERTS + e) * D_MODEL * D_EXPERT; const float* wu = p.moe_wu + (size_t)(l * N_EXPERTS + e) * D_MODEL * D_EXPERT;
        float g = dot_row(a, wg, D_EXPERT, jj, D_MODEL), u = dot_row(a, wu, D_EXPERT, jj, D_MODEL);
        p.HE[(size_t)row * HE_W + j] = f2bf(p.tokw[row * 2 + k] * silu_f(g) * u);
    }
}
GLOBAL void nk_moe_down(Params p, int l, int nrows) {
    GS_LOOP(i, (long)nrows * D_MODEL) {
        int slot = i / D_MODEL, col = i % D_MODEL; int pr, row; if (!slot_lookup(p, l, slot, pr, row)) continue;
        int e1, e2; pair_experts(pr, e1, e2);
        const bf16_t* a = p.HE + (size_t)row * HE_W;
        float acc = dot_row(a, p.moe_wd + (size_t)(l * N_EXPERTS + e1) * D_EXPERT * D_MODEL, D_MODEL, col, D_EXPERT)
                  + dot_row(a + D_EXPERT, p.moe_wd + (size_t)(l * N_EXPERTS + e2) * D_EXPERT * D_MODEL, D_MODEL, col, D_EXPERT);
        float* xr = xrow_cur(p, row);
        xr[col] = xr[col] + modp(p, l, row, 5)[col] * acc;
    }
}

GLOBAL void nk_inproj_odd_qk(Params p) {
    GS_LOOP(i, (long)TT * 10) {
        int row = i / 10, hu = i % 10; const bf16_t* a = p.hbuf + (size_t)row * D_MODEL;
        bool lat = row < TX; int b = lat ? row / SEQ : (row - TX) / CTX_LEN; int s = lat ? row % SEQ : (row - TX) % CTX_LEN; int pos = lat ? CTX_LEN + s : s;
        int col0 = hu * 64;
        float v[64]; float ss = 0.f;
        for (int d = 0; d < 64; ++d) { v[d] = dot_row(a, p.w_in_odd, ODD_IN, col0 + d, D_MODEL); ss += v[d] * v[d]; }
        float rstd = 1.0f / sqrtf(ss / 64.0f + EPS);
        const float* gn = hu < 8 ? p.c_qnorm : p.c_knorm;
        for (int d = 0; d < 64; ++d) v[d] = v[d] * rstd * gn[d];
        for (int d = 0; d < 64; ++d) {
            float o = v[d];
            if (lat) { int pd = (d & 31) < 16 ? d + 16 : d - 16; o = rope_apply(p, v[d], v[pd], d, s); }
            if (hu < 8) p.QC[(size_t)row * 512 + col0 + d] = f2bf(o);
            else p.KC[((size_t)(b * 2 + (hu - 8)) * LKV + pos) * 64 + d] = f2bf(o);
        }
    }
}
GLOBAL void nk_inproj_odd_vu(Params p) {
    GS_LOOP(i, (long)TT * (ODD_IN - 640)) {
        int row = i / (ODD_IN - 640), col = 640 + i % (ODD_IN - 640); const bf16_t* a = p.hbuf + (size_t)row * D_MODEL;
        bool lat = row < TX; int b = lat ? row / SEQ : (row - TX) / CTX_LEN; int s = lat ? row % SEQ : (row - TX) % CTX_LEN; int pos = lat ? CTX_LEN + s : s;
        if (col >= 768 && !lat) continue;
        float v = dot_row(a, p.w_in_odd, ODD_IN, col, D_MODEL);
        if (col < 768) { int h = (col - 640) >> 6, d = col & 63; p.VCt[((size_t)(b * 2 + h) * 64 + d) * LKV + pos] = f2bf(v); }
        else p.UT[((size_t)b * 3 * D_CH + (col - 768)) * SEQ + s] = f2bf(v);
    }
}

HD float hy_sc(const Params& p, int b, int ch, int t) {
    const bf16_t* u = p.UT + ((size_t)b * 3 * D_CH + ch) * SEQ;
    float acc = p.hy_short_b[ch];
    for (int kk = 0; kk < 3; ++kk) { int tt = t + kk - 1; if (tt >= 0 && tt < SEQ) acc += p.hy_short_w[kk * 3 * D_CH + ch] * bf2f(u[tt]); }
    return acc;
}
GLOBAL void nk_hy_conv(Params p, int o) {
    GS_LOOP(i, (long)BATCH * D_CH * SEQ) {
        int n = i % SEQ, c = (i / SEQ) % D_CH, b = i / ((long)SEQ * D_CH);
        const float* hf = p.HFT + (size_t)((0 * 2 + o) * D_CH + c) * SEQ; const float* hb = p.HFT + (size_t)((1 * 2 + o) * D_CH + c) * SEQ;
        float inv = 1.0f / p.hnorm[o * D_CH + c];
        float acc = 0.f;
        for (int m = 0; m < SEQ; ++m) {
            float z = o == 0 ? hy_sc(p, b, c, m) : p.Z1[((size_t)b * D_CH + c) * SEQ + m];
            int d = n - m; float hv = d >= 0 ? hf[d] : hb[-d];
            acc += hv * z;
        }
        acc *= inv;
        float zn = o == 0 ? hy_sc(p, b, c, n) : p.Z1[((size_t)b * D_CH + c) * SEQ + n];
        float g = hy_sc(p, b, (o + 1) * D_CH + c, n);
        float r = g * (acc + zn * p.hy_bias[o * D_CH + c]);
        if (o == 0) p.Z1[i] = r; else p.YHT[i] = f2bf(r);
    }
}

GLOBAL void nk_final(Params p) {
    GS_LOOP(row, TX) {
        float* xr = p.out + (size_t)row * D_MODEL; float ss = 0.f;
        for (int k = 0; k < D_MODEL; ++k) ss += xr[k] * xr[k];
        float rstd = 1.0f / sqrtf(ss / D_MODEL + EPS);
        for (int k = 0; k < D_MODEL; ++k) xr[k] = xr[k] * rstd * p.final_g[k];
    }
}
GLOBAL void nk_yht_to_y(Params p) {
    GS_LOOP(i, (long)TX * D_CH) { int row = i / D_CH, c = i % D_CH, b = row / SEQ, s = row % SEQ; p.Y[(size_t)row * 1024 + 512 + c] = p.YHT[((size_t)b * D_CH + c) * SEQ + s]; }
}

GLOBAL void nk_rope(Params p) { d_rope(p); }
GLOBAL void nk_hy_h1(Params p) { d_hy_h1(p); }
GLOBAL void nk_hy_h2(Params p) { d_hy_h2(p); }
static inline size_t al256(size_t x) { return (x + 255) & ~(size_t)255; }
static size_t setup_ws(Params& p, char* ws) {
    size_t o = 0;
    auto take = [&](size_t bytes) { char* r = ws + o; o += al256(bytes); return r; };
    p.bar = (unsigned*)take(64 * 1024);
    p.cnt = (int*)take(256);
    p.XC = (float*)take((size_t)TC * D_MODEL * 4);
    p.mod = (float*)take((size_t)DEPTH * (BATCH + 1) * 6 * D_MODEL * 4);
    p.ropet = (float*)take(64 * 32 * 4);
    p.h1 = (float*)take((size_t)SEQ * 64 * 4);
    p.h2 = (float*)take((size_t)SEQ * 64 * 4);
    p.HFT = (float*)take((size_t)4 * D_CH * SEQ * 4);
    p.hnorm = (float*)take(2 * D_CH * 4);
    p.list = (int*)take((size_t)NPAIR * TT * 4);
    p.tokw = (float*)take((size_t)TT * 2 * 4);
    p.rpair = (int*)take((size_t)TT * 4);
    p.bh = (int*)take((size_t)2048 * 32 * 4);
    p.rlog = (float*)take((size_t)TT * 16 * 4);
    size_t hb = (size_t)TT * D_MODEL * 2, z1 = (size_t)BATCH * D_CH * SEQ * 4;
    char* r0 = take(hb > z1 ? hb : z1); p.hbuf = (bf16_t*)r0; p.Z1 = (float*)r0;
    size_t q = al256((size_t)TT * 512 * 2), kva = al256((size_t)BATCH * 2 * LKV * 64 * 2), kvb = al256((size_t)BATCH * 8 * LKV * 64 * 2), ut = al256((size_t)BATCH * 3 * D_CH * SEQ * 2);
    size_t l0 = 2 * q + 2 * kva + 2 * kvb, l1 = q + 2 * kva + ut;
    char* R = take(l0 > l1 ? l0 : l1);
    p.QA = (bf16_t*)R; p.KA = (bf16_t*)(R + q); p.VAt = (bf16_t*)(R + q + kva); p.QB = (bf16_t*)(R + q + 2 * kva); p.KB = (bf16_t*)(R + 2 * q + 2 * kva); p.VBt = (bf16_t*)(R + 2 * q + 2 * kva + kvb);
    p.QC = (bf16_t*)R; p.KC = (bf16_t*)(R + q); p.VCt = (bf16_t*)(R + q + kva); p.UT = (bf16_t*)(R + q + 2 * kva);
    size_t yb = (size_t)TT * 1024 * 2, heb = (size_t)TT * HE_W * 2;
    char* r1 = take(yb > heb ? yb : heb); p.Y = (bf16_t*)r1; p.HE = (bf16_t*)r1;
    p.YHT = (bf16_t*)take((size_t)BATCH * D_CH * SEQ * 2);
    p.Wt_in_even = (bf16_t*)take((size_t)EVEN_IN * D_MODEL * 2);
    p.Wt_out_even = (bf16_t*)take((size_t)D_MODEL * EVEN_OUT * 2);
    p.Wt_in_odd = (bf16_t*)take((size_t)ODD_IN * D_MODEL * 2);
    p.Wt_out_odd = (bf16_t*)take((size_t)D_MODEL * ODD_OUT * 2);
    p.Wt_gu = (bf16_t*)take((size_t)DEPTH * N_EXPERTS * 2 * D_EXPERT * D_MODEL * 2);
    p.Wt_d = (bf16_t*)take((size_t)DEPTH * N_EXPERTS * D_MODEL * D_EXPERT * 2);
    return o;
}
static void fill_inputs(Params& p, void* const* d_in, void* d_out) {
    const float** f = (const float**)&p.x;
    for (int i = 0; i < 32; ++i) f[i] = (const float*)d_in[i];
    p.out = (float*)d_out;
}
#define LAS __attribute__((address_space(3)))
typedef short bf16x8 __attribute__((ext_vector_type(8)));
typedef float f32x4 __attribute__((ext_vector_type(4)));
typedef float f32x16 __attribute__((ext_vector_type(16)));
typedef unsigned u32x4 __attribute__((ext_vector_type(4)));
typedef unsigned u32x2 __attribute__((ext_vector_type(2)));

constexpr int NTHREADS = 256;
constexpr int LDS_BYTES = 69632;
constexpr int MT_ALL = TT / 128, MT_LAT = TX / 128;

__device__ __forceinline__ unsigned pk2bf(float lo, float hi) { return (unsigned)f2bf(lo) | ((unsigned)f2bf(hi) << 16); }
__device__ __forceinline__ float wave_sum(float v) {
#pragma unroll
    for (int o = 1; o < 64; o <<= 1) v += __shfl_xor(v, o);
    return v;
}

template <class DstF>
__device__ __forceinline__ void cvt_block_item(char* lds, const float* W, int N, int k0, int n0, const DstF& dst) {
    float* T = (float*)lds; const int tid = threadIdx.x;
    f32x4 v[16];
#pragma unroll
    for (int i = 0; i < 16; ++i) v[i] = *(const f32x4*)(W + (size_t)(k0 + (tid >> 6) + 4 * i) * N + n0 + 4 * (tid & 63));
#pragma unroll
    for (int i = 0; i < 16; ++i) *(f32x4*)(T + ((tid >> 6) + 4 * i) * 260 + 4 * (tid & 63)) = v[i];
    __syncthreads();
    bf16_t* d = dst(n0 + tid) + k0; const float* s = T + tid;
#pragma unroll
    for (int c = 0; c < 8; ++c) { u32x4 w; w.x = pk2bf(s[(8 * c + 0) * 260], s[(8 * c + 1) * 260]); w.y = pk2bf(s[(8 * c + 2) * 260], s[(8 * c + 3) * 260]);
        w.z = pk2bf(s[(8 * c + 4) * 260], s[(8 * c + 5) * 260]); w.w = pk2bf(s[(8 * c + 6) * 260], s[(8 * c + 7) * 260]); *(u32x4*)(d + 8 * c) = w; }
    __syncthreads();
}
__device__ __forceinline__ void cvt_plain(char* lds, const float* W, bf16_t* Wt, int K, int N, int item) {
    const int nb = N / 256, kb = item / nb, nbi = item % nb;
    cvt_block_item(lds, W, N, kb * 64, nbi * 256, [&](int n) { return Wt + (size_t)n * K; });
}
constexpr int CVT_IN = (D_MODEL / 64) * (EVEN_IN / 256), CVT_OUT = (D_MODEL / 64) * (D_MODEL / 256), CVT_GU1 = (D_MODEL / 64) * (D_EXPERT / 256), CVT_D1 = (D_EXPERT / 64) * (D_MODEL / 256);
constexpr int CVT_GU = DEPTH * N_EXPERTS * 2 * CVT_GU1, CVT_D = DEPTH * N_EXPERTS * CVT_D1;
constexpr int CVT_TOTAL = 2 * CVT_IN + 2 * CVT_OUT + CVT_GU + CVT_D;
constexpr int CVT_EARLY = 2 * CVT_IN + 2 * CVT_OUT;
static_assert(EVEN_IN % 256 == 0 && ODD_IN % 256 == 0 && D_EXPERT % 256 == 0, "conversion tile");
__device__ __forceinline__ void cvt_item(const Params& p, char* lds, int it) {
    if (it < CVT_IN) { cvt_plain(lds, p.w_in_even, p.Wt_in_even, D_MODEL, EVEN_IN, it); return; } it -= CVT_IN;
    if (it < CVT_IN) { cvt_plain(lds, p.w_in_odd, p.Wt_in_odd, D_MODEL, ODD_IN, it); return; } it -= CVT_IN;
    if (it < CVT_OUT) { cvt_plain(lds, p.w_out_even, p.Wt_out_even, EVEN_OUT, D_MODEL, it); return; } it -= CVT_OUT;
    if (it < CVT_OUT) { cvt_plain(lds, p.w_out_odd, p.Wt_out_odd, ODD_OUT, D_MODEL, it); return; } it -= CVT_OUT;
    if (it < CVT_GU) {
        const int le = it / (2 * CVT_GU1), r = it % (2 * CVT_GU1), half = r / CVT_GU1, r2 = r % CVT_GU1; const int nb = D_EXPERT / 256, kb = r2 / nb, nbi = r2 % nb;
        const float* W = (half ? p.moe_wu : p.moe_wg) + (size_t)le * D_MODEL * D_EXPERT; bf16_t* Wt = p.Wt_gu + (size_t)le * 2 * D_EXPERT * D_MODEL;
        cvt_block_item(lds, W, D_EXPERT, kb * 64, nbi * 256, [&](int n) { return Wt + (size_t)(32 * (n >> 4) + 16 * half + (n & 15)) * D_MODEL; });
        return; } it -= CVT_GU;
    { const int le = it / CVT_D1, r = it % CVT_D1; cvt_plain(lds, p.moe_wd + (size_t)le * D_EXPERT * D_MODEL, p.Wt_d + (size_t)le * D_MODEL * D_EXPERT, D_EXPERT, D_MODEL, r); }
}
__device__ __forceinline__ void cvt_range(const Params& p, char* lds, int lo, int hi, int bid, int nb) {
    for (int it = lo + bid; it < hi; it += nb) cvt_item(p, lds, it);
}

struct TileGeom { int tid, lane, wid, wr, wc, l15, q, srow, schunk;
    __device__ __forceinline__ int drow(int i) const { return wid * 32 + i * 8 + (lane >> 3); }
    __device__ __forceinline__ int dchunk(int i) const { return (lane & 7) ^ (((lane >> 4) + 4 * i) & 7); } };
__device__ __forceinline__ TileGeom tile_geom() { TileGeom g; g.tid = threadIdx.x; g.lane = g.tid & 63; g.wid = __builtin_amdgcn_readfirstlane(g.tid >> 6); g.wr = g.wid >> 1; g.wc = g.wid & 1; g.l15 = g.lane & 15; g.q = g.lane >> 4; g.srow = g.tid >> 3; g.schunk = g.tid & 7; return g; }

template <class ALoad, class BLoad>
__device__ __forceinline__ void gemm_mainloop(char* lds, const TileGeom& g, int nk, const ALoad& AL, const BLoad& BL, f32x4 (&acc)[4][4]) {
#pragma unroll
    for (int i = 0; i < 4; ++i)
#pragma unroll
        for (int j = 0; j < 4; ++j) acc[i][j] = (f32x4){0.f, 0.f, 0.f, 0.f};
    const int swz = g.l15 >> 1;
    const int aofs = (g.wr * 64 + g.l15) * 128 + ((g.q ^ swz) << 4);
    const int bofs = 32768 + (g.wc * 64 + g.l15) * 128 + ((g.q ^ swz) << 4);
    LAS char* l3 = (LAS char*)lds;
    const int dbase = g.wid * 4096;
#define GEMM_STAGE(kt_, buf_) do { _Pragma("unroll") for (int i_ = 0; i_ < 4; ++i_) { \
        __builtin_amdgcn_global_load_lds((const unsigned*)AL(i_, (kt_)), (LAS unsigned*)(l3 + (buf_) + dbase + i_ * 1024), 16, 0, 0); \
        __builtin_amdgcn_global_load_lds((const unsigned*)BL(i_, (kt_)), (LAS unsigned*)(l3 + 32768 + (buf_) + dbase + i_ * 1024), 16, 0, 0); } } while (0)
    GEMM_STAGE(0, 0);
    __syncthreads();
    for (int kt = 0; kt < nk; ++kt) {
        const int cur = (kt & 1) * 16384, nxt = 16384 - cur;
        if (kt + 1 < nk) GEMM_STAGE(kt + 1, nxt);
#pragma unroll
        for (int kk = 0; kk < 2; ++kk) {
            bf16x8 af[4], bfr[4];
#pragma unroll
            for (int i = 0; i < 4; ++i) { af[i] = *(const bf16x8*)(lds + cur + ((aofs + i * 2048) ^ (kk * 64))); bfr[i] = *(const bf16x8*)(lds + cur + ((bofs + i * 2048) ^ (kk * 64))); }
#pragma unroll
            for (int mi = 0; mi < 4; ++mi)
#pragma unroll
                for (int ni = 0; ni < 4; ++ni) acc[mi][ni] = __builtin_amdgcn_mfma_f32_16x16x32_bf16(bfr[ni], af[mi], acc[mi][ni], 0, 0, 0);
        }
        __syncthreads();
    }
#undef GEMM_STAGE
}

template <class DstF>
__device__ __forceinline__ void store_transposed(char* lds, const TileGeom& g, const f32x4 (&acc)[4][4], const DstF& dst) {
    bf16_t* T = (bf16_t*)lds;
#pragma unroll
    for (int mi = 0; mi < 4; ++mi)
#pragma unroll
        for (int ni = 0; ni < 4; ++ni)
#pragma unroll
            for (int r = 0; r < 4; ++r) T[(g.wc * 64 + ni * 16 + g.q * 4 + r) * 136 + g.wr * 64 + mi * 16 + g.l15] = f2bf(acc[mi][ni][r]);
    __syncthreads();
    { int col = g.tid >> 1, half = g.tid & 1; bf16_t* d = dst(col) + half * 64; const bf16_t* s = T + col * 136 + half * 64;
#pragma unroll
      for (int j = 0; j < 8; ++j) *(u32x4*)(d + j * 8) = *(const u32x4*)(s + j * 8); }
    __syncthreads();
}
__device__ __forceinline__ void store4bf(bf16_t* d, const f32x4& v) { u32x2 w; w.x = pk2bf(v[0], v[1]); w.y = pk2bf(v[2], v[3]); *(u32x2*)d = w; }
__device__ __forceinline__ void rope_head(const Params& p, f32x4 (&a)[4], int s, int q) {
    const int pr = s / GRID_W, pc = s % GRID_W;
    const f32x4 cr = *(const f32x4*)(p.ropet + pr * 32 + q * 4), sr = *(const f32x4*)(p.ropet + pr * 32 + 16 + q * 4);
    const f32x4 cc = *(const f32x4*)(p.ropet + pc * 32 + q * 4), sc = *(const f32x4*)(p.ropet + pc * 32 + 16 + q * 4);
    f32x4 x1 = a[0], x2 = a[1]; a[0] = x1 * cr - x2 * sr; a[1] = x2 * cr + x1 * sr;
    x1 = a[2]; x2 = a[3]; a[2] = x1 * cc - x2 * sc; a[3] = x2 * cc + x1 * sc;
}

template <int LAYER>
__device__ __forceinline__ void inproj_tile(const Params& p, char* lds, int mt, int nt) {
    const TileGeom g = tile_geom();
    const bf16_t* Abase = p.hbuf + (size_t)(mt * 128) * D_MODEL;
    const bf16_t* Bbase = (LAYER == 0 ? p.Wt_in_even : p.Wt_in_odd) + (size_t)(nt * 128) * D_MODEL;
    f32x4 acc[4][4];
    gemm_mainloop(lds, g, D_MODEL / 64, [&](int i, int kt) { return Abase + (size_t)g.drow(i) * D_MODEL + kt * 64 + g.dchunk(i) * 8; }, [&](int i, int kt) { return Bbase + (size_t)g.drow(i) * D_MODEL + kt * 64 + g.dchunk(i) * 8; }, acc);
    const bool lat = mt < MT_LAT; const int row0 = mt * 128;
    const int b = lat ? row0 / SEQ : (row0 - TX) / CTX_LEN, s0 = lat ? row0 % SEQ : (row0 - TX) % CTX_LEN, pos0 = lat ? CTX_LEN + s0 : s0;
    int kind;
    bf16_t* base; int h0 = 0, qcol0 = 0, nh = 2;
    if (LAYER == 0) {
        if (nt < 4) { kind = 0; base = p.QA; qcol0 = nt * 128; }
        else if (nt == 4) { kind = 1; base = p.KA; h0 = 0; nh = 2; }
        else if (nt == 5) { kind = 2; base = p.VAt; h0 = 0; nh = 2; }
        else if (nt < 10) { kind = 0; base = p.QB; qcol0 = (nt - 6) * 128; }
        else if (nt < 14) { kind = 1; base = p.KB; h0 = (nt - 10) * 2; nh = 8; }
        else { kind = 2; base = p.VBt; h0 = (nt - 14) * 2; nh = 8; }
    } else {
        if (nt < 4) { kind = 0; base = p.QC; qcol0 = nt * 128; }
        else if (nt == 4) { kind = 1; base = p.KC; h0 = 0; nh = 2; }
        else if (nt == 5) { kind = 2; base = p.VCt; h0 = 0; nh = 2; }
        else { kind = 3; base = p.UT; }
    }
    if (kind <= 1) {
        const bool rope = lat && (LAYER == 1 || nt <= 4);
#pragma unroll
        for (int mi = 0; mi < 4; ++mi) {
            const int rowl = g.wr * 64 + mi * 16 + g.l15;
            if (LAYER == 1) {
                float ss = 0.f;
#pragma unroll
                for (int ni = 0; ni < 4; ++ni) ss += acc[mi][ni][0] * acc[mi][ni][0] + acc[mi][ni][1] * acc[mi][ni][1] + acc[mi][ni][2] * acc[mi][ni][2] + acc[mi][ni][3] * acc[mi][ni][3];
                ss += __shfl_xor(ss, 16); ss += __shfl_xor(ss, 32);
                const float rstd = 1.0f / sqrtf(ss * (1.0f / 64.0f) + EPS);
                const float* gn = kind == 0 ? p.c_qnorm : p.c_knorm;
#pragma unroll
                for (int ni = 0; ni < 4; ++ni) acc[mi][ni] = acc[mi][ni] * rstd * *(const f32x4*)(gn + ni * 16 + g.q * 4);
            }
            if (rope) rope_head(p, acc[mi], s0 + rowl, g.q);
            bf16_t* d = kind == 0 ? base + (size_t)(row0 + rowl) * 512 + qcol0 + g.wc * 64 + g.q * 4
                                  : base + ((size_t)(b * nh + h0 + g.wc) * LKV + pos0 + rowl) * 64 + g.q * 4;
#pragma unroll
            for (int ni = 0; ni < 4; ++ni) store4bf(d + ni * 16, acc[mi][ni]);
        }
    } else if (kind == 2) {
        store_transposed(lds, g, acc, [&](int col) { return base + ((size_t)(b * nh + h0 + (col >> 6)) * 64 + (col & 63)) * LKV + pos0; });
    } else {
        store_transposed(lds, g, acc, [&](int col) { return base + ((size_t)b * 3 * D_CH + (nt - 6) * 128 + col) * SEQ + s0; });
    }
}
template <int LAYER>
__device__ __forceinline__ void ph_inproj(const Params& p, char* lds, int bid, int nb) {
    constexpr int NT = 18;
    if (LAYER == 0) { for (int t = bid; t < MT_ALL * NT; t += nb) inproj_tile<0>(p, lds, t / NT, t % NT); }
    else {
        const int n_lat = MT_LAT * NT, n_all = n_lat + (MT_ALL - MT_LAT) * 2;
        for (int t = bid; t < n_all; t += nb) { if (t < n_lat) inproj_tile<1>(p, lds, t / NT, t % NT); else { int u = t - n_lat; inproj_tile<1>(p, lds, MT_LAT + u / 2, 4 + u % 2); } }
    }
}

template <int LAYER>
__device__ __forceinline__ void outproj_tile(const Params& p, char* lds, int mt, int nt) {
    const TileGeom g = tile_geom();
    const bf16_t* Abase = p.Y + (size_t)(mt * 128) * 1024;
    const bf16_t* Bbase = (LAYER == 0 ? p.Wt_out_even : p.Wt_out_odd) + (size_t)(nt * 128) * 1024;
    f32x4 acc[4][4];
    gemm_mainloop(lds, g, 16, [&](int i, int kt) { return Abase + (size_t)g.drow(i) * 1024 + kt * 64 + g.dchunk(i) * 8; }, [&](int i, int kt) { return Bbase + (size_t)g.drow(i) * 1024 + kt * 64 + g.dchunk(i) * 8; }, acc);
    const int row0 = mt * 128;
#pragma unroll
    for (int mi = 0; mi < 4; ++mi) {
        const int row = row0 + g.wr * 64 + mi * 16 + g.l15;
        const float* xin = xrow_in(p, LAYER, row); float* xo = xrow_cur(p, row); const float* gate = modp(p, LAYER, row, 2);
#pragma unroll
        for (int ni = 0; ni < 4; ++ni) { const int col = nt * 128 + g.wc * 64 + ni * 16 + g.q * 4;
            *(f32x4*)(xo + col) = *(const f32x4*)(xin + col) + *(const f32x4*)(gate + col) * acc[mi][ni]; }
    }
}

template <int LAYER>
__device__ __forceinline__ void ph_outproj(const Params& p, char* lds, int bid, int nb) {
    const int nmt = LAYER == 0 ? MT_ALL : MT_LAT;
    for (int t = bid; t < nmt * 8; t += nb) outproj_tile<LAYER>(p, lds, t / 8, t % 8);
}

template <int NTN>
__device__ __forceinline__ bool moe_tile_lookup(const int* cnt, int t, int& pr, int& mt, int& nt, int& n) {
    int acc = 0;
    for (int q = 0; q < NPAIR; ++q) { const int c = __builtin_amdgcn_readfirstlane(cnt[q]); const int tiles = ((c + 127) >> 7) * NTN; if (t < acc + tiles) { pr = q; const int u = t - acc; mt = u / NTN; nt = u % NTN; n = c; return true; } acc += tiles; }
    return false;
}
__device__ __forceinline__ void moe_up_tile(const Params& p, char* lds, int l, int pr, int mt, int nt, int n) {
    const TileGeom g = tile_geom();
    int e1, e2; pair_experts(pr, e1, e2); const int k = nt >> 3, e = k ? e2 : e1;
    const int* lst = p.list + (size_t)pr * TT + mt * 128;
    const int navail = n - mt * 128;
    const bf16_t* arow[4];
#pragma unroll
    for (int i = 0; i < 4; ++i) { int r = g.drow(i); if (r >= navail) r = navail - 1; arow[i] = p.hbuf + (size_t)lst[r] * D_MODEL + g.dchunk(i) * 8; }
    const bf16_t* Bbase = p.Wt_gu + ((size_t)(l * N_EXPERTS + e) * 2 * D_EXPERT + (nt & 7) * 128) * D_MODEL;
    f32x4 acc[4][4];
    gemm_mainloop(lds, g, D_MODEL / 64, [&](int i, int kt) { return arow[i] + kt * 64; }, [&](int i, int kt) { return Bbase + (size_t)g.drow(i) * D_MODEL + kt * 64 + g.dchunk(i) * 8; }, acc);
#pragma unroll
    for (int mi = 0; mi < 4; ++mi) {
        const int rl = g.wr * 64 + mi * 16 + g.l15;
        if (rl < navail) {
            const int row = lst[rl]; const float w = p.tokw[row * 2 + k];
            bf16_t* d = p.HE + (size_t)row * HE_W + k * D_EXPERT + (nt & 7) * 64 + g.wc * 32 + g.q * 4;
#pragma unroll
            for (int h2 = 0; h2 < 2; ++h2) { f32x4 gg = acc[mi][2 * h2], uu = acc[mi][2 * h2 + 1], o;
#pragma unroll
                for (int r = 0; r < 4; ++r) o[r] = w * (gg[r] / (1.0f + __expf(-gg[r]))) * uu[r];
                store4bf(d + h2 * 16, o); }
        }
    }
}
template <bool DUMMY = false>
__device__ __forceinline__ void moe_down_tile(const Params& p, char* lds, int l, int pr, int mt, int nt, int n) {
    const TileGeom g = tile_geom();
    int e1, e2; pair_experts(pr, e1, e2);
    const int* lst = p.list + (size_t)pr * TT + mt * 128;
    const int navail = n - mt * 128;
    const bf16_t* arow[4];
#pragma unroll
    for (int i = 0; i < 4; ++i) { int r = g.drow(i); if (r >= navail) r = navail - 1; arow[i] = p.HE + (size_t)lst[r] * HE_W + g.dchunk(i) * 8; }
    const bf16_t* B1 = p.Wt_d + ((size_t)(l * N_EXPERTS + e1) * D_MODEL + nt * 128) * D_EXPERT;
    const bf16_t* B2 = p.Wt_d + ((size_t)(l * N_EXPERTS + e2) * D_MODEL + nt * 128) * D_EXPERT;
    constexpr int KT1 = D_EXPERT / 64;
    f32x4 acc[4][4];
    gemm_mainloop(lds, g, HE_W / 64, [&](int i, int kt) { return arow[i] + kt * 64; },
                  [&](int i, int kt) { return (kt < KT1 ? B1 + kt * 64 : B2 + (kt - KT1) * 64) + (size_t)g.drow(i) * D_EXPERT + g.dchunk(i) * 8; }, acc);
#pragma unroll
    for (int mi = 0; mi < 4; ++mi) {
        const int rl = g.wr * 64 + mi * 16 + g.l15;
        if (rl < navail) {
            const int row = lst[rl]; float* xo = xrow_cur(p, row); const float* gate = modp(p, l, row, 5);
#pragma unroll
            for (int ni = 0; ni < 4; ++ni) { const int col = nt * 128 + g.wc * 64 + ni * 16 + g.q * 4; float* dst = DUMMY ? (float*)p.QA + (size_t)row * D_MODEL : xo; *(f32x4*)(dst + col) = *(const f32x4*)(xo + col) + *(const f32x4*)(gate + col) * acc[mi][ni]; }
        }
    }
}
__device__ __forceinline__ void ph_moe_up(const Params& p, char* lds, int l, int bid, int nb) {
    int pr, mt, nt, n; for (int t = bid; moe_tile_lookup<16>(p.cnt + l * 32, t, pr, mt, nt, n); t += nb) moe_up_tile(p, lds, l, pr, mt, nt, n);
}
template <bool DUMMY = false>
__device__ __forceinline__ void ph_moe_down(const Params& p, char* lds, int l, int bid, int nb) {
    int pr, mt, nt, n; for (int t = bid; moe_tile_lookup<8>(p.cnt + l * 32, t, pr, mt, nt, n); t += nb) moe_down_tile<DUMMY>(p, lds, l, pr, mt, nt, n);
}
typedef float f32x2 __attribute__((ext_vector_type(2)));
typedef __bf16 bf16x2_t __attribute__((ext_vector_type(2)));
__device__ __forceinline__ unsigned cvtpk(float lo, float hi) { f32x2 v = {lo, hi}; bf16x2_t b = __builtin_convertvector(v, bf16x2_t); return __builtin_bit_cast(unsigned, b); }
__device__ __forceinline__ int crow(int r, int hi) { return (r & 3) + 8 * (r >> 2) + 4 * hi; }
constexpr float LOG2E = 1.4426950408889634f;
constexpr float QK_C = ATTN_SCALE * LOG2E;
constexpr float NEG_BIG = -1e30f;

__device__ __forceinline__ float max3f(float a, float b, float c) { float r; asm("v_max3_f32 %0, %1, %2, %3" : "=v"(r) : "v"(a), "v"(b), "v"(c)); return r; }
constexpr float ATT_THR = 8.0f;
template <int MODE>
__device__ __forceinline__ void attn_unit(char* lds, const bf16_t* Qp, const bf16_t* Kp, const bf16_t* Vt, bf16_t* Op, int s0, int nctx, int lt0, int nlat, float sink2, bool has_sink, const float* rpb_h) {
    int tid_ = threadIdx.x; asm volatile("" : "+v"(tid_));
    const int tid = tid_, lane = tid & 63, wid = __builtin_amdgcn_readfirstlane(tid >> 6), l31 = lane & 31, hi = lane >> 5;
    float* bias_s = (float*)(lds + 65536);
    if (MODE == 2) { for (int i = tid; i < 15 * 31; i += NTHREADS) bias_s[i] = rpb_h[i] * LOG2E; }
    const int ntiles = nctx + nlat;
    LAS char* l3 = (LAS char*)lds;
    const int drow0 = wid * 16 + (lane >> 3);
    const int dch0 = (lane & 7) ^ (((lane >> 4) + 0) & 7), dch1 = (lane & 7) ^ (((lane >> 4) + 4) & 7);
    const bf16_t* ksrc0 = Kp + (size_t)drow0 * 64 + dch0 * 8; const bf16_t* ksrc1 = Kp + (size_t)(drow0 + 8) * 64 + dch1 * 8;
    const bf16_t* vsrc0 = Vt + (size_t)drow0 * LKV + dch0 * 8; const bf16_t* vsrc1 = Vt + (size_t)(drow0 + 8) * LKV + dch1 * 8;
    const int ddst = wid * 2048;
    auto tile_pos = [&](int j) { return j < nctx ? 64 * j : CTX_LEN + 64 * (lt0 + j - nctx); };
#define ATT_DMA(j_, slot_) do { const int pos_ = tile_pos(j_); \
        __builtin_amdgcn_global_load_lds((const unsigned*)(ksrc0 + (size_t)pos_ * 64), (LAS unsigned*)(l3 + (slot_) * 8192 + ddst), 16, 0, 0); \
        __builtin_amdgcn_global_load_lds((const unsigned*)(ksrc1 + (size_t)pos_ * 64), (LAS unsigned*)(l3 + (slot_) * 8192 + ddst + 1024), 16, 0, 0); \
        __builtin_amdgcn_global_load_lds((const unsigned*)(vsrc0 + pos_), (LAS unsigned*)(l3 + 32768 + (slot_) * 8192 + ddst), 16, 0, 0); \
        __builtin_amdgcn_global_load_lds((const unsigned*)(vsrc1 + pos_), (LAS unsigned*)(l3 + 32768 + (slot_) * 8192 + ddst + 1024), 16, 0, 0); } while (0)
    const int x = (l31 >> 1) & 7;
    const int kofs = l31 * 128 + ((hi ^ x) << 4);
    const int vofs = 32768 + l31 * 128 + (x << 4) + 8 * hi;
    bf16x8 qf[4];
    { const bf16_t* qr = Qp + (size_t)(wid * 32 + l31) * 512 + hi * 8;
#pragma unroll
      for (int s = 0; s < 4; ++s) { const u32x4 raw = *(const u32x4*)(qr + s * 16); u32x4 sc;
#pragma unroll
          for (int e = 0; e < 4; ++e) { const float lo = __builtin_bit_cast(float, raw[e] << 16) * QK_C, hi2 = __builtin_bit_cast(float, raw[e] & 0xffff0000u) * QK_C; sc[e] = cvtpk(lo, hi2); }
          qf[s] = __builtin_bit_cast(bf16x8, sc); } }
#define ATT_WAIT(need_, last_) do { const int lastt_ = (last_) < ntiles - 1 ? (last_) : ntiles - 1; const int ahead_ = lastt_ - (need_); \
        if (ahead_ >= 2) asm volatile("s_waitcnt vmcnt(8) lgkmcnt(0)" ::: "memory"); else if (ahead_ == 1) asm volatile("s_waitcnt vmcnt(4) lgkmcnt(0)" ::: "memory"); \
        else asm volatile("s_waitcnt vmcnt(0) lgkmcnt(0)" ::: "memory"); } while (0)
    ATT_DMA(0, 0);
    if (ntiles > 1) ATT_DMA(1, 1);
    if (ntiles > 2) ATT_DMA(2, 2);
    f32x16 o0 = {}, o1 = {};
    f32x16 negm = {};
    float mref = 0.f, l = 0.f;
    const int sq = s0 + wid * 32 + l31;
    int rq = 0, cq = 0, rsq = 0, csq = 0;
    if (MODE == 2) { rq = sq / GRID_W; cq = sq % GRID_W; rsq = rq - B_WIN_H / 2; rsq = rsq < 0 ? 0 : (rsq > GRID_H - B_WIN_H ? GRID_H - B_WIN_H : rsq); csq = cq - B_WIN_W / 2; csq = csq < 0 ? 0 : (csq > GRID_W - B_WIN_W ? GRID_W - B_WIN_W : csq); }
    ATT_WAIT(0, 2);
    __builtin_amdgcn_s_barrier(); asm volatile("" ::: "memory");
    int slot = 0;
    for (int j = 0; j < ntiles; ++j) {
        const int slot1 = (slot + 1) & 3, slot3 = (slot + 3) & 3;
        if (j + 3 < ntiles) ATT_DMA(j + 3, slot3);
        const char* Kb = lds + slot * 8192; const char* Vb = lds + slot * 8192;
        f32x16 p0, p1;
#pragma unroll
        for (int s = 0; s < 4; ++s) {
            const bf16x8 k0 = *(const bf16x8*)(Kb + (kofs ^ (s << 5))); const bf16x8 k1 = *(const bf16x8*)(Kb + 4096 + (kofs ^ (s << 5)));
            if (s == 0) { p0 = __builtin_amdgcn_mfma_f32_32x32x16_bf16(k0, qf[0], negm, 0, 0, 0); p1 = __builtin_amdgcn_mfma_f32_32x32x16_bf16(k1, qf[0], negm, 0, 0, 0); }
            else { p0 = __builtin_amdgcn_mfma_f32_32x32x16_bf16(k0, qf[s], p0, 0, 0, 0); p1 = __builtin_amdgcn_mfma_f32_32x32x16_bf16(k1, qf[s], p1, 0, 0, 0); }
        }
        asm volatile("s_nop 15\n\ts_nop 7" : "+v"(p0), "+v"(p1));
        if (MODE == 1 && j >= nctx) {
            const int sk0 = 64 * (lt0 + j - nctx);
#pragma unroll
            for (int r = 0; r < 16; ++r) { const int d0 = sk0 + crow(r, hi) - sq, d1 = d0 + 32;
                p0[r] = (d0 >= -A_WINDOW && d0 <= A_WINDOW) ? p0[r] : NEG_BIG; p1[r] = (d1 >= -A_WINDOW && d1 <= A_WINDOW) ? p1[r] : NEG_BIG; }
        } else if (MODE == 2 && j >= nctx) {
            const int kr = lt0 + j - nctx; const bool rowok = kr >= rsq && kr < rsq + B_WIN_H;
            const float* brow = bias_s + (kr - rq + B_WIN_H - 1) * 31 + (B_WIN_W - 1) - cq;
#pragma unroll
            for (int r = 0; r < 16; ++r) { const int kc0 = crow(r, hi), kc1 = kc0 + 32;
                const bool ok0 = rowok && kc0 >= csq && kc0 < csq + B_WIN_W, ok1 = rowok && kc1 >= csq && kc1 < csq + B_WIN_W;
                p0[r] = ok0 ? p0[r] + brow[kc0] : NEG_BIG; p1[r] = ok1 ? p1[r] + brow[kc1] : NEG_BIG; }
        }
        float ta = max3f(p0[0], p0[1], p1[0]), tb = max3f(p0[2], p0[3], p1[1]); ta = max3f(ta, p1[2], p1[3]);
#pragma unroll
        for (int r = 4; r < 16; r += 4) { ta = max3f(ta, p0[r], p0[r + 1]); tb = max3f(tb, p0[r + 2], p0[r + 3]); ta = max3f(ta, p1[r], p1[r + 1]); tb = max3f(tb, p1[r + 2], p1[r + 3]); }
        float tmax = fmaxf(ta, tb); tmax = fmaxf(tmax, __shfl_xor(tmax, 32));
        if (j == 0 || __any(tmax > ATT_THR)) {
            const float dl = j == 0 ? tmax : fmaxf(tmax, 0.f);
            mref += dl;
#pragma unroll
            for (int r = 0; r < 16; ++r) { p0[r] -= dl; p1[r] -= dl; negm[r] = -mref; }
            if (j > 0) { const float f = __builtin_amdgcn_exp2f(-dl); l *= f;
#pragma unroll
                for (int r = 0; r < 16; ++r) { o0[r] *= f; o1[r] *= f; } }
        }
        f32x2 lsum = {0.f, 0.f};
#pragma unroll
        for (int r = 0; r < 16; r += 2) { p0[r] = __builtin_amdgcn_exp2f(p0[r]); p0[r + 1] = __builtin_amdgcn_exp2f(p0[r + 1]); p1[r] = __builtin_amdgcn_exp2f(p1[r]); p1[r + 1] = __builtin_amdgcn_exp2f(p1[r + 1]);
            lsum += (f32x2){p0[r], p0[r + 1]}; lsum += (f32x2){p1[r], p1[r + 1]}; }
        l += lsum.x + lsum.y;
        bf16x8 pf[4];
        { u32x4 w;
          w.x = cvtpk(p0[0], p0[1]); w.y = cvtpk(p0[2], p0[3]); w.z = cvtpk(p0[4], p0[5]); w.w = cvtpk(p0[6], p0[7]); pf[0] = __builtin_bit_cast(bf16x8, w);
          w.x = cvtpk(p0[8], p0[9]); w.y = cvtpk(p0[10], p0[11]); w.z = cvtpk(p0[12], p0[13]); w.w = cvtpk(p0[14], p0[15]); pf[1] = __builtin_bit_cast(bf16x8, w);
          w.x = cvtpk(p1[0], p1[1]); w.y = cvtpk(p1[2], p1[3]); w.z = cvtpk(p1[4], p1[5]); w.w = cvtpk(p1[6], p1[7]); pf[2] = __builtin_bit_cast(bf16x8, w);
          w.x = cvtpk(p1[8], p1[9]); w.y = cvtpk(p1[10], p1[11]); w.z = cvtpk(p1[12], p1[13]); w.w = cvtpk(p1[14], p1[15]); pf[3] = __builtin_bit_cast(bf16x8, w); }
#pragma unroll
        for (int s = 0; s < 4; ++s) {
            const int a0 = vofs ^ (s << 5);
            u32x2 va = *(const u32x2*)(Vb + a0), vb = *(const u32x2*)(Vb + (a0 ^ 16));
            u32x2 vc = *(const u32x2*)(Vb + 4096 + a0), vd = *(const u32x2*)(Vb + 4096 + (a0 ^ 16));
            const bf16x8 f0 = __builtin_bit_cast(bf16x8, (u32x4){va.x, va.y, vb.x, vb.y}), f1 = __builtin_bit_cast(bf16x8, (u32x4){vc.x, vc.y, vd.x, vd.y});
            o0 = __builtin_amdgcn_mfma_f32_32x32x16_bf16(f0, pf[s], o0, 0, 0, 0); o1 = __builtin_amdgcn_mfma_f32_32x32x16_bf16(f1, pf[s], o1, 0, 0, 0);
        }
        ATT_WAIT(j + 1, j + 3);
        __builtin_amdgcn_s_barrier(); asm volatile("" ::: "memory");
        slot = slot1;
    }
#undef ATT_DMA
#undef ATT_WAIT
    l += __shfl_xor(l, 32);
    if (has_sink) l += __builtin_amdgcn_exp2f(sink2 - mref);
    const float inv = 1.0f / l;
    bf16_t* orow = Op + (size_t)(wid * 32 + l31) * 1024;
#pragma unroll
    for (int g4 = 0; g4 < 4; ++g4) {
        u32x2 w; w.x = cvtpk(o0[g4 * 4 + 0] * inv, o0[g4 * 4 + 1] * inv); w.y = cvtpk(o0[g4 * 4 + 2] * inv, o0[g4 * 4 + 3] * inv); *(u32x2*)(orow + 8 * g4 + 4 * hi) = w;
        w.x = cvtpk(o1[g4 * 4 + 0] * inv, o1[g4 * 4 + 1] * inv); w.y = cvtpk(o1[g4 * 4 + 2] * inv, o1[g4 * 4 + 3] * inv); *(u32x2*)(orow + 32 + 8 * g4 + 4 * hi) = w;
    }
    asm volatile("s_waitcnt vmcnt(0)" ::: "memory");
}

constexpr int NU_LAT = BATCH * 8 * (SEQ / 128);
constexpr int NU_CTX = BATCH * 8 * (CTX_LEN / 128);
__device__ __forceinline__ void ph_attn0(const Params& p, char* lds, int bid, int nb) {
    int u = bid;
    for (; u < NU_LAT; u += nb) {
        const int blk = u % (SEQ / 128), h = (u / (SEQ / 128)) % 8, b = u / (8 * (SEQ / 128)); const int s0 = blk * 128, r0 = s0 / GRID_W;
        int rs0 = r0 - 4; rs0 = rs0 < 0 ? 0 : (rs0 > GRID_H - 8 ? GRID_H - 8 : rs0); int rs1 = r0 + 1 - 4; rs1 = rs1 < 0 ? 0 : (rs1 > GRID_H - 8 ? GRID_H - 8 : rs1);
        attn_unit<2>(lds, p.QB + (size_t)(b * SEQ + s0) * 512 + h * 64, p.KB + (size_t)(b * 8 + h) * LKV * 64, p.VBt + (size_t)(b * 8 + h) * 64 * LKV,
                     p.Y + (size_t)(b * SEQ + s0) * 1024 + 512 + h * 64, s0, CTX_LEN / 64, rs0, rs1 + 8 - rs0, 0.f, false, p.b_rpb + h * 15 * 31);
    }
    for (; u < 2 * NU_LAT; u += nb) {
        const int v = u - NU_LAT; const int blk = v % (SEQ / 128), h = (v / (SEQ / 128)) % 8, b = v / (8 * (SEQ / 128)); const int s0 = blk * 128;
        int t0 = (s0 - 128) / 64; if (t0 < 0) t0 = 0; int t1 = (s0 + 255) / 64; if (t1 > SEQ / 64 - 1) t1 = SEQ / 64 - 1;
        attn_unit<1>(lds, p.QA + (size_t)(b * SEQ + s0) * 512 + h * 64, p.KA + (size_t)(b * 2 + h / 4) * LKV * 64, p.VAt + (size_t)(b * 2 + h / 4) * 64 * LKV,
                     p.Y + (size_t)(b * SEQ + s0) * 1024 + h * 64, s0, CTX_LEN / 64, t0, t1 - t0 + 1, p.a_sink[h] * LOG2E, true, nullptr);
    }
    for (; u < 2 * NU_LAT + 2 * NU_CTX; u += nb) {
        const int v = u - 2 * NU_LAT; const int ty = v / NU_CTX, w = v % NU_CTX; const int blk = w % (CTX_LEN / 128), h = (w / (CTX_LEN / 128)) % 8, b = w / (8 * (CTX_LEN / 128));
        const int row0 = TX + b * CTX_LEN + blk * 128;
        const bf16_t* Qp = (ty == 0 ? p.QA : p.QB) + (size_t)row0 * 512 + h * 64;
        const bf16_t* Kp = ty == 0 ? p.KA + (size_t)(b * 2 + h / 4) * LKV * 64 : p.KB + (size_t)(b * 8 + h) * LKV * 64;
        const bf16_t* Vp = ty == 0 ? p.VAt + (size_t)(b * 2 + h / 4) * 64 * LKV : p.VBt + (size_t)(b * 8 + h) * 64 * LKV;
        attn_unit<0>(lds, Qp, Kp, Vp, p.Y + (size_t)row0 * 1024 + ty * 512 + h * 64, 0, CTX_LEN / 64, 0, 0, ty == 0 ? p.a_sink[h] * LOG2E : 0.f, ty == 0, nullptr);
    }
}
__device__ __forceinline__ void ph_attnC(const Params& p, char* lds, int bid, int nb) {
    for (int u = bid; u < NU_LAT; u += nb) {
        const int blk = u % (SEQ / 128), h = (u / (SEQ / 128)) % 8, b = u / (8 * (SEQ / 128)); const int s0 = blk * 128;
        attn_unit<0>(lds, p.QC + (size_t)(b * SEQ + s0) * 512 + h * 64, p.KC + (size_t)(b * 2 + h / 4) * LKV * 64, p.VCt + (size_t)(b * 2 + h / 4) * 64 * LKV,
                     p.Y + (size_t)(b * SEQ + s0) * 1024 + h * 64, s0, CTX_LEN / 64, 0, SEQ / 64, 0.f, false, nullptr);
    }
}
#ifdef HY_TEST
#define HY_OUT(b, t, v) p.YHT[((size_t)(b) * D_CH + c) * SEQ + (t)] = f2bf(v)
#else
#define HY_OUT(b, t, v) p.YHT[((size_t)(b) * D_CH + c) * SEQ + (t)] = f2bf(v)
#endif
#ifdef CPU_TEST
#define FOR_T for (int tid = 0; tid < 256; ++tid)
#define HSYNC
#define HST(t) st[t]
#define HY_DECL HySt* st = new HySt[256]
#define HY_FREE delete[] st
static inline void sincos_rev(float a, float& c, float& s) { c = cosf(6.283185307179586f * a); s = sinf(6.283185307179586f * a); }
#else
__device__ __forceinline__ int hy_launder(int v) { asm volatile("" : "+v"(v)); return v; }
#define FOR_T if (const int tid = hy_launder((int)threadIdx.x); true)
#define HSYNC __syncthreads()
#define HST(t) st
#define HY_DECL HySt st
#define HY_FREE
__device__ __forceinline__ void sincos_rev(float a, float& c, float& s) { c = __builtin_amdgcn_cosf(a); s = __builtin_amdgcn_sinf(a); }
#endif
constexpr int FN = 2 * SEQ;
constexpr int FPAD = FN + (FN >> 5);
#if !defined(SMALL_CFG)
static_assert(FN == 8192, "pass plan 8,8,8,16 is for N = 8192");
constexpr int R4 = 16;
constexpr int NS4 = 512;
#else
constexpr int R4 = 2;
constexpr int NS4 = 512;
#endif
constexpr int NB8 = FN / 8 / 256;
constexpr int NB4 = FN / R4 / 256;
constexpr int EPT = FN / 256;
struct HySt { float xr[EPT], xi[EPT]; unsigned kp[EPT]; };
HD unsigned hy_pack(float r, float i) { return (unsigned)f2bf(r) | ((unsigned)f2bf(i) << 16); }
HD float hy_lo(unsigned v) { unsigned u = v << 16; float f; __builtin_memcpy(&f, &u, 4); return f; }
HD float hy_hi(unsigned v) { unsigned u = v & 0xffff0000u; float f; __builtin_memcpy(&f, &u, 4); return f; }
HD int pidx(int i) { return i + (i >> 5); }

constexpr float W16C[8] = {1.0f, 0.9238795325112867f, 0.7071067811865476f, 0.3826834323650898f, 0.0f, -0.3826834323650898f, -0.7071067811865476f, -0.9238795325112867f};
constexpr float W16S[8] = {0.0f, -0.3826834323650898f, -0.7071067811865476f, -0.9238795325112867f, -1.0f, -0.9238795325112867f, -0.7071067811865476f, -0.3826834323650898f};
template <int R> HD void fft_reg(float* xr, float* xi) {
    constexpr int LG = R == 16 ? 4 : (R == 8 ? 3 : (R == 4 ? 2 : 1));
#pragma unroll
    for (int sg = 0; sg < LG; ++sg) {
        const int h = (R / 2) >> sg;
#pragma unroll
        for (int pr = 0; pr < R / 2; ++pr) {
            const int blk = (pr / h) * 2 * h, i = pr % h;
            const int a = blk + i, b = blk + i + h;
            const float ar = xr[a], ai = xi[a], br = xr[b], bi = xi[b];
            xr[a] = ar + br; xi[a] = ai + bi;
            const float tr = ar - br, ti = ai - bi;
            const int tw = i * (8 / h);
            if (tw == 0) { xr[b] = tr; xi[b] = ti; }
            else if (tw == 4) { xr[b] = ti; xi[b] = -tr; }
            else { const float c = W16C[tw & 7], s = W16S[tw & 7]; xr[b] = tr * c - ti * s; xi[b] = tr * s + ti * c; }
        }
    }
}
template <int R> HD constexpr int bitrev(int i) { int r = 0; for (int b = 1; b < R; b <<= 1) { r = (r << 1) | (i & 1); i >>= 1; } return r; }

template <int R, int NB, class In> HD void pass_load(int tid, HySt& s, const In& in) {
#pragma unroll
    for (int b = 0; b < NB; ++b)
#pragma unroll
        for (int r = 0; r < R; ++r) in(tid + 256 * b + (FN / R) * r, r, s.xr[b * R + r], s.xi[b * R + r]);
}
template <int R, int NB, class Out> HD void pass_compute(int tid, HySt& s, int Ns, const Out& out) {
#pragma unroll
    for (int b = 0; b < NB; ++b) {
        const int j = tid + 256 * b, k = j & (Ns - 1);
        float* xr = s.xr + b * R; float* xi = s.xi + b * R;
        if (Ns > 1) {
            float wc, ws; sincos_rev(-(float)k / (float)(Ns * R), wc, ws);
            float cr = wc, ci = ws;
#pragma unroll
            for (int r = 1; r < R; ++r) {
                const float vr = xr[r], vi = xi[r]; xr[r] = vr * cr - vi * ci; xi[r] = vr * ci + vi * cr;
                const float nr = cr * wc - ci * ws, ni = cr * ws + ci * wc; cr = nr; ci = ni;
            }
        }
        fft_reg<R>(xr, xi);
        const int j0 = (j - k) * R + k;
#pragma unroll
        for (int i = 0; i < R; ++i) out(j0 + bitrev<R>(i) * Ns, b, bitrev<R>(i), xr[i], xi[i]);
    }
}
struct LdsIn { const float* re; const float* im; HD void operator()(int idx, int, float& r, float& i) const { r = re[pidx(idx)]; i = im[pidx(idx)]; } };
struct LdsOut { float* re; float* im; HD void operator()(int idx, int, int, float r, float i) const { re[pidx(idx)] = r; im[pidx(idx)] = i; } };

HD void hy_pre_load(const Params& p, int c, int b, int tid, float* lds) {
#pragma unroll
    for (int q = 0; q < 3; ++q) {
        const bf16_t* u = p.UT + ((size_t)b * 3 * D_CH + q * D_CH + c) * SEQ; const int t0 = tid * 16;
        const float w0 = p.hy_short_w[0 * 3 * D_CH + q * D_CH + c], w1 = p.hy_short_w[1 * 3 * D_CH + q * D_CH + c], w2 = p.hy_short_w[2 * 3 * D_CH + q * D_CH + c], sb = p.hy_short_b[q * D_CH + c];
        unsigned w[8];
        { const unsigned* u32p = (const unsigned*)(u + t0);
#pragma unroll
          for (int i = 0; i < 8; ++i) w[i] = u32p[i]; }
        float x[18];
        x[0] = t0 > 0 ? bf2f(u[t0 - 1]) : 0.f; x[17] = t0 + 16 < SEQ ? bf2f(u[t0 + 16]) : 0.f;
#pragma unroll
        for (int i = 0; i < 8; ++i) { x[1 + 2 * i] = bf2f((bf16_t)(w[i] & 0xffffu)); x[2 + 2 * i] = bf2f((bf16_t)(w[i] >> 16)); }
#pragma unroll
        for (int i = 0; i < 16; ++i) lds[q * SEQ + t0 + i] = sb + w0 * x[i] + w1 * x[i + 1] + w2 * x[i + 2];
    }
}
HD void hy_pre_store(const Params& p, int c, int b, int tid, const float* lds) {
#pragma unroll
    for (int q = 0; q < 3; ++q) {
        unsigned* u = (unsigned*)(p.UT + ((size_t)b * 3 * D_CH + q * D_CH + c) * SEQ + tid * 16);
#pragma unroll
        for (int i = 0; i < 8; ++i) u[i] = (unsigned)f2bf(lds[q * SEQ + tid + 256 * (2 * i)]) | ((unsigned)f2bf(lds[q * SEQ + tid + 256 * (2 * i + 1)]) << 16);
    }
}
HD void tm_load_bf16(const bf16_t* row, int tid, unsigned (&w)[8]) { const unsigned* q = (const unsigned*)(row + tid * 16);
#pragma unroll
    for (int i = 0; i < 8; ++i) w[i] = q[i]; }
HD float tm_get(const unsigned (&w)[8], int m) { return bf2f((bf16_t)((m & 1) ? (w[m >> 1] >> 16) : (w[m >> 1] & 0xffffu))); }
HD int tm_ofs(int idx) { return (idx & 255) * 16 + (idx >> 8); }

HD void hyena_channel(const Params& p, int c, float* lds) {
    HY_DECL;
    float* re = lds; float* im = lds + FPAD;
    const LdsIn lin{re, im}; const LdsOut lout{re, im};
    for (int b = 0; b < BATCH; ++b) { FOR_T { hy_pre_load(p, c, b, tid, lds); } HSYNC; FOR_T { hy_pre_store(p, c, b, tid, lds); } HSYNC; }
    float nrm[2];
#pragma unroll
    for (int o = 0; o < 2; ++o) {
        const float* hf = p.HFT + (size_t)((0 * 2 + o) * D_CH + c) * SEQ; const float* hb = p.HFT + (size_t)((1 * 2 + o) * D_CH + c) * SEQ;
        FOR_T { float sacc = 0.f; for (int i = 0; i < SEQ / 256; ++i) sacc += fabsf(hf[tid + 256 * i]) + fabsf(hb[tid + 256 * i]); re[tid] = sacc; }
        HSYNC;
        { float tot = 0.f; for (int i = 0; i < 256; ++i) tot += re[i]; nrm[o] = tot + EPS; }
        HSYNC;
    }
    float sw[3][3], sbv[3];
#pragma unroll
    for (int q = 0; q < 3; ++q) { sbv[q] = p.hy_short_b[q * D_CH + c];
#pragma unroll
        for (int kk = 0; kk < 3; ++kk) sw[q][kk] = p.hy_short_w[kk * 3 * D_CH + q * D_CH + c]; }
#pragma unroll 1
    for (int o = 0; o < 2; ++o) {
        const float* hf = p.HFT + (size_t)((0 * 2 + o) * D_CH + c) * SEQ; const float* hb = p.HFT + (size_t)((1 * 2 + o) * D_CH + c) * SEQ;
        const float inv = 1.0f / (o == 0 ? nrm[0] : nrm[1]); const float hbias = p.hy_bias[o * D_CH + c];
        float swg[3]; swg[0] = o == 0 ? sw[1][0] : sw[2][0]; swg[1] = o == 0 ? sw[1][1] : sw[2][1]; swg[2] = o == 0 ? sw[1][2] : sw[2][2]; const float sbg = o == 0 ? sbv[1] : sbv[2];
        FOR_T { pass_load<8, NB8>(tid, HST(tid), [&](int idx, int r8, float& r, float& i) __attribute__((always_inline)) { if (r8 < 4) r = hf[idx] * inv; else { const int q = FN - idx; const float hv = hb[q < SEQ ? q : 0]; r = q < SEQ ? hv * inv : 0.f; } i = 0.f; });
                pass_compute<8, NB8>(tid, HST(tid), 1, lout); }
        HSYNC;
        FOR_T { pass_load<8, NB8>(tid, HST(tid), lin); } HSYNC; FOR_T { pass_compute<8, NB8>(tid, HST(tid), 8, lout); } HSYNC;
        FOR_T { pass_load<8, NB8>(tid, HST(tid), lin); } HSYNC; FOR_T { pass_compute<8, NB8>(tid, HST(tid), 64, lout); } HSYNC;
        FOR_T { pass_load<R4, NB4>(tid, HST(tid), lin);
                HySt& s = HST(tid); pass_compute<R4, NB4>(tid, s, NS4, [&](int, int b, int rr, float r, float i) __attribute__((always_inline)) { s.kp[b + NB4 * rr] = hy_pack(r, i); }); }
        HSYNC;
        for (int bp = 0; bp < BATCH / 2; ++bp) {
            const int b0 = 2 * bp, b1 = 2 * bp + 1;
            const bf16_t* u0 = p.UT + ((size_t)b0 * 3 * D_CH + c) * SEQ; const bf16_t* u1 = p.UT + ((size_t)b1 * 3 * D_CH + c) * SEQ;
            const float* z0 = p.Z1 + ((size_t)b0 * D_CH + c) * SEQ; const float* z1 = p.Z1 + ((size_t)b1 * D_CH + c) * SEQ;
            auto zval = [&](int b, int t) __attribute__((always_inline)) { return o == 0 ? bf2f((b == b0 ? u0 : u1)[tm_ofs(t)]) : (b == b0 ? z0 : z1)[tm_ofs(t)]; };
            FOR_T { HySt& s = HST(tid);
                    if (o == 0) { unsigned w0[8], w1[8]; tm_load_bf16(u0, tid, w0); tm_load_bf16(u1, tid, w1);
#pragma unroll
                        for (int q = 0; q < 32; ++q) { const int b = q >> 3, r = q & 7; if (r < 4) { s.xr[q] = tm_get(w0, b + 4 * r); s.xi[q] = tm_get(w1, b + 4 * r); } else { s.xr[q] = 0.f; s.xi[q] = 0.f; } } }
                    else {
#pragma unroll
                        for (int q = 0; q < 32; ++q) { const int b = q >> 3, r = q & 7; if (r < 4) { s.xr[q] = z0[tid * 16 + b + 4 * r]; s.xi[q] = z1[tid * 16 + b + 4 * r]; } else { s.xr[q] = 0.f; s.xi[q] = 0.f; } } }
                    pass_compute<8, NB8>(tid, s, 1, lout); }
            HSYNC;
            FOR_T { pass_load<8, NB8>(tid, HST(tid), lin); } HSYNC; FOR_T { pass_compute<8, NB8>(tid, HST(tid), 8, lout); } HSYNC;
            FOR_T { pass_load<8, NB8>(tid, HST(tid), lin); } HSYNC; FOR_T { pass_compute<8, NB8>(tid, HST(tid), 64, lout); } HSYNC;
            FOR_T { pass_load<R4, NB4>(tid, HST(tid), lin); } HSYNC;
            FOR_T { HySt& s = HST(tid); pass_compute<R4, NB4>(tid, s, NS4, [&](int idx, int b, int rr, float r, float i) __attribute__((always_inline)) { const float kr = hy_lo(s.kp[b + NB4 * rr]), ki = hy_hi(s.kp[b + NB4 * rr]);
                        re[pidx(idx)] = r * kr - i * ki; im[pidx(idx)] = -(r * ki + i * kr); }); }
            HSYNC;
            FOR_T { pass_load<8, NB8>(tid, HST(tid), lin); } HSYNC; FOR_T { pass_compute<8, NB8>(tid, HST(tid), 1, lout); } HSYNC;
            FOR_T { pass_load<8, NB8>(tid, HST(tid), lin); } HSYNC; FOR_T { pass_compute<8, NB8>(tid, HST(tid), 8, lout); } HSYNC;
            FOR_T { pass_load<8, NB8>(tid, HST(tid), lin); } HSYNC; FOR_T { pass_compute<8, NB8>(tid, HST(tid), 64, lout); } HSYNC;
            FOR_T { pass_load<R4, NB4>(tid, HST(tid), lin); HySt& s = HST(tid); float yr[16], yi[16];
                    pass_compute<R4, NB4>(tid, s, NS4, [&](int, int b, int rr, float r, float i) __attribute__((always_inline)) { if (rr < 8) { yr[b + 2 * rr] = r * (1.0f / FN); yi[b + 2 * rr] = -i * (1.0f / FN); } });
                    const bf16_t* g0 = p.UT + ((size_t)b0 * 3 * D_CH + (o + 1) * D_CH + c) * SEQ; const bf16_t* g1 = p.UT + ((size_t)b1 * 3 * D_CH + (o + 1) * D_CH + c) * SEQ;
                    unsigned gw0[8], gw1[8]; tm_load_bf16(g0, tid, gw0); tm_load_bf16(g1, tid, gw1);
                    if (o == 0) { unsigned w0[8], w1[8]; tm_load_bf16(u0, tid, w0); tm_load_bf16(u1, tid, w1);
                        float* zo0 = p.Z1 + ((size_t)b0 * D_CH + c) * SEQ + tid * 16; float* zo1 = p.Z1 + ((size_t)b1 * D_CH + c) * SEQ + tid * 16;
#pragma unroll
                        for (int m = 0; m < 16; ++m) { zo0[m] = tm_get(gw0, m) * (yr[m] + tm_get(w0, m) * hbias); zo1[m] = tm_get(gw1, m) * (yi[m] + tm_get(w1, m) * hbias); } }
                    else {
#pragma unroll
                        for (int m = 0; m < 16; ++m) { const float zn0 = tm_get(gw0, m) * (yr[m] + z0[tid * 16 + m] * hbias), zn1 = tm_get(gw1, m) * (yi[m] + z1[tid * 16 + m] * hbias);
                            HY_OUT(b0, tid + 256 * m, zn0); HY_OUT(b1, tid + 256 * m, zn1); } } }
            HSYNC;
        }
    }
    HY_FREE;
}
constexpr int MOD_ITEMS = DEPTH * (6 * D_MODEL / 64);
__device__ __forceinline__ void mod_item(const Params& p, char* lds, int item) {
    float* sc = (float*)lds;
    float* red = sc + 5 * D_MODEL;
    const int tid = threadIdx.x, l = item / (6 * D_MODEL / 64), j0 = (item % (6 * D_MODEL / 64)) * 64;
    for (int i = tid; i < 5 * D_MODEL; i += NTHREADS) { const int r = i / D_MODEL, k = i % D_MODEL; const float v = r < BATCH ? p.c[r * D_MODEL + k] : p.c_ctx[k]; sc[i] = silu_f(v); }
    __syncthreads();
    const int col = tid & 63, kp = tid >> 6;
    const float* w = p.w_ada + ((size_t)l * D_MODEL + kp * 256) * 6 * D_MODEL + j0 + col;
    float a0 = 0.f, a1 = 0.f, a2 = 0.f, a3 = 0.f, a4 = 0.f;
#pragma unroll 8
    for (int k = 0; k < 256; ++k) { const float wv = w[(size_t)k * 6 * D_MODEL]; const int kk = kp * 256 + k;
        a0 += sc[kk] * wv; a1 += sc[D_MODEL + kk] * wv; a2 += sc[2 * D_MODEL + kk] * wv; a3 += sc[3 * D_MODEL + kk] * wv; a4 += sc[4 * D_MODEL + kk] * wv; }
    red[(kp * 5 + 0) * 64 + col] = a0; red[(kp * 5 + 1) * 64 + col] = a1; red[(kp * 5 + 2) * 64 + col] = a2; red[(kp * 5 + 3) * 64 + col] = a3; red[(kp * 5 + 4) * 64 + col] = a4;
    __syncthreads();
    for (int i = tid; i < 5 * 64; i += NTHREADS) { const int r = i / 64, cc = i % 64;
        const float v = red[(0 * 5 + r) * 64 + cc] + red[(1 * 5 + r) * 64 + cc] + red[(2 * 5 + r) * 64 + cc] + red[(3 * 5 + r) * 64 + cc];
        p.mod[((size_t)(l * (BATCH + 1) + r)) * 6 * D_MODEL + j0 + cc] = v + p.b_ada[l * 6 * D_MODEL + j0 + cc]; }
    __syncthreads();
}
constexpr int FILT_ITEMS = (SEQ / 256) * (4 * D_CH / 64);
__device__ __forceinline__ void filt_item(const Params& p, char* lds, int item) {
    float* ws = (float*)lds;
    const int tid = threadIdx.x, tb = item % (SEQ / 256), cb = item / (SEQ / 256); const int t = tb * 256 + tid, col0 = cb * 64;
#pragma unroll
    for (int i = 0; i < 16; ++i) { const int k = i * 4 + (tid >> 6), cc = tid & 63; ws[cc * 68 + k] = p.hy_w3[(size_t)k * 4 * D_CH + col0 + cc]; }
    f32x4 h[16];
#pragma unroll
    for (int i = 0; i < 16; ++i) h[i] = *(const f32x4*)(p.h2 + (size_t)t * HY_FFN + i * 4);
    __syncthreads();
    const float tn = (float)t / (float)(SEQ - 1);
    const float mind = logf(1e-2f) / 1.5f, maxd = logf(1e-2f) / 0.3f;
#pragma unroll 2
    for (int cc = 0; cc < 64; ++cc) {
        const int col = col0 + cc; const f32x4* w = (const f32x4*)(ws + cc * 68);
        float acc = p.hy_b3[col];
#pragma unroll
        for (int i = 0; i < 16; ++i) { const f32x4 wv = w[i]; acc += h[i][0] * wv[0] + h[i][1] * wv[1] + h[i][2] * wv[2] + h[i][3] * wv[3]; }
        const float delta = fabsf(mind + (float)(col % D_CH) * (maxd - mind) / (float)(D_CH - 1));
        p.HFT[(size_t)col * SEQ + t] = acc * expf(-tn * delta);
    }
    __syncthreads();
}
__device__ __forceinline__ void ph_norm(const Params& p, int l, int which, int nrows, int bid, int nb) {
    const int lane = threadIdx.x & 63, wid = threadIdx.x >> 6;
    const float* g = p.norm_g + (l * 2 + which) * D_MODEL;
    for (int row = (bid * 4 + wid) * 2; row < nrows; row += nb * 8) {
        const int row1 = row + 1 < nrows ? row + 1 : row;
        const float* xa = which == 0 ? xrow_in(p, l, row) : xrow_cur(p, row); const float* xb = which == 0 ? xrow_in(p, l, row1) : xrow_cur(p, row1);
        f32x4 va[4], vb[4]; float sa = 0.f, sb = 0.f;
#pragma unroll
        for (int j = 0; j < 4; ++j) { va[j] = *(const f32x4*)(xa + j * 256 + lane * 4); vb[j] = *(const f32x4*)(xb + j * 256 + lane * 4); }
#pragma unroll
        for (int j = 0; j < 4; ++j) { sa += va[j][0] * va[j][0] + va[j][1] * va[j][1] + va[j][2] * va[j][2] + va[j][3] * va[j][3]; sb += vb[j][0] * vb[j][0] + vb[j][1] * vb[j][1] + vb[j][2] * vb[j][2] + vb[j][3] * vb[j][3]; }
        const float ra = 1.0f / sqrtf(wave_sum(sa) * (1.0f / D_MODEL) + EPS), rb = 1.0f / sqrtf(wave_sum(sb) * (1.0f / D_MODEL) + EPS);
        const float* sha = modp(p, l, row, which * 3 + 0); const float* sca = modp(p, l, row, which * 3 + 1);
        const float* shb = modp(p, l, row1, which * 3 + 0); const float* scb = modp(p, l, row1, which * 3 + 1);
#pragma unroll
        for (int j = 0; j < 4; ++j) { const int c = j * 256 + lane * 4; const f32x4 gv = *(const f32x4*)(g + c);
            store4bf(p.hbuf + (size_t)row * D_MODEL + c, va[j] * ra * gv * (*(const f32x4*)(sca + c) + 1.0f) + *(const f32x4*)(sha + c));
            if (row1 != row) store4bf(p.hbuf + (size_t)row1 * D_MODEL + c, vb[j] * rb * gv * (*(const f32x4*)(scb + c) + 1.0f) + *(const f32x4*)(shb + c)); }
    }
}
__device__ __forceinline__ void ph_route_a(const Params& p, char* lds, int l, int nrows, int bid, int nb) {
    const int lane = threadIdx.x & 63, wid = threadIdx.x >> 6;
    float* wr_s = (float*)lds; int* hist = (int*)(lds + 65536);
    for (int i = threadIdx.x; i < D_MODEL * 4; i += NTHREADS) { const int k = i >> 2, ch = i & 3; ((f32x4*)wr_s)[k * 4 + (ch ^ ((k >> 2) & 3))] = ((const f32x4*)p.w_router)[i]; }
    if (threadIdx.x < 32) hist[threadIdx.x] = 0;
    __syncthreads();
    const int sw = (lane >> 2) & 3;
    const float* g = p.norm_g + (l * 2 + 1) * D_MODEL;
    const int RPB = (nrows + nb - 1) / nb, r0 = bid * RPB;
    for (int j = wid; j < RPB; j += 4) {
        const int row = r0 + j; if (row >= nrows) break;
        const float* xr = xrow_cur(p, row); const float* sh = modp(p, l, row, 3); const float* sc = modp(p, l, row, 4);
        float v[16]; float ss = 0.f;
#pragma unroll
        for (int i = 0; i < 16; ++i) { v[i] = xr[lane + 64 * i]; ss += v[i] * v[i]; }
        const float rstd = 1.0f / sqrtf(wave_sum(ss) * (1.0f / D_MODEL) + EPS);
        float lg[16];
#pragma unroll
        for (int e = 0; e < 16; ++e) lg[e] = 0.f;
#pragma unroll
        for (int i = 0; i < 16; ++i) { const int k = lane + 64 * i; const float o = v[i] * rstd * g[k] * (sc[k] + 1.0f) + sh[k];
            p.hbuf[(size_t)row * D_MODEL + k] = f2bf(o);
            const f32x4* w4 = (const f32x4*)(wr_s + k * 16);
#pragma unroll
            for (int e4 = 0; e4 < 4; ++e4) { const f32x4 wv = w4[e4 ^ sw]; lg[e4 * 4 + 0] += o * wv[0]; lg[e4 * 4 + 1] += o * wv[1]; lg[e4 * 4 + 2] += o * wv[2]; lg[e4 * 4 + 3] += o * wv[3]; }
            if (i & 1) __builtin_amdgcn_sched_barrier(0); }
        {
#pragma unroll
            for (int i = 0; i < 8; ++i) { const float a = lg[i], b = lg[i + 8]; const bool up = (lane & 32) != 0; const float recv = __shfl_xor(up ? a : b, 32); lg[i] = (up ? b : a) + recv; }
#pragma unroll
            for (int i = 0; i < 4; ++i) { const float a = lg[i], b = lg[i + 4]; const bool up = (lane & 16) != 0; const float recv = __shfl_xor(up ? a : b, 16); lg[i] = (up ? b : a) + recv; }
#pragma unroll
            for (int i = 0; i < 2; ++i) { const float a = lg[i], b = lg[i + 2]; const bool up = (lane & 8) != 0; const float recv = __shfl_xor(up ? a : b, 8); lg[i] = (up ? b : a) + recv; }
            { const float a = lg[0], b = lg[1]; const bool up = (lane & 4) != 0; const float recv = __shfl_xor(up ? a : b, 4); lg[0] = (up ? b : a) + recv; }
            lg[0] += __shfl_xor(lg[0], 2); lg[0] += __shfl_xor(lg[0], 1);
            const float mine = lg[0];
#pragma unroll
            for (int e = 0; e < 16; ++e) lg[e] = __builtin_bit_cast(float, __builtin_amdgcn_readlane(__builtin_bit_cast(int, mine), 4 * e));
        }
        if (lane == 0) {
            int gbest = 0, a = 0, bb = 1; float gbs = -1e30f, wa = 0.f, wb = 0.f;
#pragma unroll
            for (int gI = 0; gI < 4; ++gI) {
                float m1 = -1e30f, m2 = -1e30f, s1 = 0.f, s2 = 0.f; int i1 = 0, i2 = 0;
#pragma unroll
                for (int jj = 0; jj < 4; ++jj) { float sgv = sigmoid_f(lg[gI * 4 + jj]); float vv = sgv + p.b_router[gI * 4 + jj];
                    if (vv > m1) { m2 = m1; i2 = i1; s2 = s1; m1 = vv; i1 = jj; s1 = sgv; } else if (vv > m2) { m2 = vv; i2 = jj; s2 = sgv; } }
                float gs = m1 + m2;
                if (gs > gbs) { gbs = gs; gbest = gI; if (i1 < i2) { a = i1; bb = i2; wa = s1; wb = s2; } else { a = i2; bb = i1; wa = s2; wb = s1; } }
            }
            const float inv = 1.0f / (wa + wb);
            const int pidx = a == 0 ? bb - 1 : (a == 1 ? bb + 1 : 5);
            const int pr = gbest * 6 + pidx;
            p.rpair[row] = pr; p.tokw[row * 2 + 0] = wa * inv; p.tokw[row * 2 + 1] = wb * inv;
            atomicAdd(&hist[pr], 1);
        }
    }
    __syncthreads();
    if (threadIdx.x < 32) p.bh[bid * 32 + threadIdx.x] = hist[threadIdx.x];
}
__device__ __forceinline__ void ph_route_b(const Params& p, char* lds, int l, int nrows, int bid, int nb) {
    int* sb = (int*)lds;
    const int t = threadIdx.x, pr = t & 31, part = t >> 5;
    { int s_before = 0, s_all = 0; const int b0 = (part * nb) >> 3, b1 = ((part + 1) * nb) >> 3;
      for (int b = b0; b < b1; ++b) { const int c = p.bh[b * 32 + pr]; s_all += c; if (b < bid) s_before += c; }
      sb[part * 32 + pr] = s_before; sb[256 + part * 32 + pr] = s_all; }
    __syncthreads();
    if (t < 32) { int a = 0, c = 0;
#pragma unroll
        for (int q = 0; q < 8; ++q) { a += sb[q * 32 + t]; c += sb[256 + q * 32 + t]; }
        sb[512 + t] = a; sb[544 + t] = c; if (bid == 0) p.cnt[l * 32 + t] = c; }
    const int RPB = (nrows + nb - 1) / nb, row = bid * RPB + t; const bool act = t < RPB && row < nrows;
    int myp = 0; if (act) { myp = p.rpair[row]; sb[576 + t] = myp; }
    __syncthreads();
    if (act) { int rank = 0; for (int j = 0; j < t; ++j) rank += (sb[576 + j] == myp) ? 1 : 0; p.list[(size_t)myp * TT + sb[512 + myp] + rank] = row; }
    __syncthreads();
}
__device__ __forceinline__ void ph_final(const Params& p, int bid, int nb) {
    const int lane = threadIdx.x & 63, wid = threadIdx.x >> 6;
    for (int row = (bid * 4 + wid) * 2; row < TX; row += nb * 8) {
        float* xa = p.out + (size_t)row * D_MODEL; float* xb = xa + D_MODEL;
        f32x4 va[4], vb[4]; float sa = 0.f, sb = 0.f;
#pragma unroll
        for (int j = 0; j < 4; ++j) { va[j] = *(const f32x4*)(xa + j * 256 + lane * 4); vb[j] = *(const f32x4*)(xb + j * 256 + lane * 4); }
#pragma unroll
        for (int j = 0; j < 4; ++j) { sa += va[j][0] * va[j][0] + va[j][1] * va[j][1] + va[j][2] * va[j][2] + va[j][3] * va[j][3]; sb += vb[j][0] * vb[j][0] + vb[j][1] * vb[j][1] + vb[j][2] * vb[j][2] + vb[j][3] * vb[j][3]; }
        const float ra = 1.0f / sqrtf(wave_sum(sa) * (1.0f / D_MODEL) + EPS), rb = 1.0f / sqrtf(wave_sum(sb) * (1.0f / D_MODEL) + EPS);
#pragma unroll
        for (int j = 0; j < 4; ++j) { const int c = j * 256 + lane * 4; const f32x4 gv = *(const f32x4*)(p.final_g + c); *(f32x4*)(xa + c) = va[j] * ra * gv; *(f32x4*)(xb + c) = vb[j] * rb * gv; }
    }
}

#define XB_TMO      128
#define XB_XCNT(j)  (256  + 64 * (j))
#define XB_XSUB(j)  (1280 + 64 * (j))
#define XB_XGEN(j)  (2304 + 64 * (j))
#define XB_TOP      3328
#define XB_TOPGEN   3392
#define XCD_BAR_WORDS 3456
#define XB_SPIN_CAP (1u << 20)
__device__ __forceinline__ unsigned xb_ld(unsigned* p)              { return __hip_atomic_load(p, __ATOMIC_RELAXED, __HIP_MEMORY_SCOPE_AGENT); }
__device__ __forceinline__ unsigned xb_add(unsigned* p, unsigned v) { return __hip_atomic_fetch_add(p, v, __ATOMIC_RELAXED, __HIP_MEMORY_SCOPE_AGENT); }
__device__ __forceinline__ unsigned xb_xcc_id() { return (unsigned)__builtin_amdgcn_s_getreg((3 << 11) | 20) & 0xFu; }
#define XB_SPIN(cond, bar) do { unsigned _sp = 0; while (cond) { __builtin_amdgcn_s_sleep(1); \
    if ((++_sp & 255u) == 0u) { if (xb_ld(&(bar)[XB_TMO])) break; if (_sp > XB_SPIN_CAP) { atomicAdd(&(bar)[XB_TMO], 1u); break; } } } } while (0)
struct XcdBarrier { unsigned* bar; unsigned x; volatile LAS unsigned* st; };
__device__ __forceinline__ XcdBarrier xcd_barrier_post(unsigned* bar, volatile LAS unsigned* st) {
    XcdBarrier b; b.bar = bar; b.x = xb_xcc_id(); b.st = st;
    if (threadIdx.x == 0) (void)xb_add(&bar[XB_XCNT(b.x)], 1u);
    return b;
}
__device__ __forceinline__ void xcd_barrier_complete(unsigned* bar, unsigned x, unsigned& nloc, unsigned& nx) {
    const unsigned G = gridDim.x * gridDim.y * gridDim.z;
    unsigned sum, cnt, mine, sp = 0u;
    for (;;) {
        sum = 0u; cnt = 0u; mine = 0u;
#pragma unroll
        for (unsigned j = 0; j < 16; ++j) { const unsigned c = xb_ld(&bar[XB_XCNT(j)]); sum += c; cnt += (c > 0u) ? 1u : 0u; mine = (j == x) ? c : mine; }
        if (sum == G) break;
        __builtin_amdgcn_s_sleep(1);
        if ((++sp & 255u) == 0u) { if (xb_ld(&bar[XB_TMO])) break; if (sp > XB_SPIN_CAP) { atomicAdd(&bar[XB_TMO], 1u); break; } }
    }
    nloc = mine > 0u ? mine : 1u; nx = cnt > 0u ? cnt : 1u;
}
__device__ __forceinline__ void xcd_barrier(const XcdBarrier& b) {
    asm volatile("s_waitcnt vmcnt(0)" ::: "memory");
    __syncthreads();
    if (threadIdx.x == 0) {
        unsigned* bar = b.bar;
        __builtin_amdgcn_s_waitcnt(0);
        unsigned nloc = b.st[0], nx = b.st[1];
        if (nloc == 0u) { xcd_barrier_complete(bar, b.x, nloc, nx); b.st[0] = nloc; b.st[1] = nx; }
        const unsigned old = xb_add(&bar[XB_XSUB(b.x)], 1u);
        const unsigned gen = old / nloc;
        if (old + 1u == (gen + 1u) * nloc) {
            __builtin_amdgcn_fence(__ATOMIC_RELEASE, "agent");
            asm volatile("s_waitcnt vmcnt(0)" ::: "memory");
            const unsigned og = xb_add(&bar[XB_TOP], 1u);
            const unsigned tg = og / nx;
            if (og + 1u == (tg + 1u) * nx) xb_add(&bar[XB_TOPGEN], 1u);
            else XB_SPIN(xb_ld(&bar[XB_TOPGEN]) == tg, bar);
            __builtin_amdgcn_fence(__ATOMIC_ACQUIRE, "agent");
            xb_add(&bar[XB_XGEN(b.x)], 1u);
            asm volatile("s_waitcnt vmcnt(0)" ::: "memory");
        } else {
            XB_SPIN(xb_ld(&bar[XB_XGEN(b.x)]) == gen, bar);
            __builtin_amdgcn_fence(__ATOMIC_ACQUIRE, "agent");
            asm volatile("s_waitcnt vmcnt(0)" ::: "memory");
        }
    }
    __syncthreads();
}

__device__ __forceinline__ void ph_mix1(const Params& p, char* lds, int bid, int nb, unsigned long long* tsplit = nullptr) {
    const bool hy_first = bid >= (nb >> 1);
    for (int rep = 0; rep < 3; ++rep) {
        if (rep == 1) {
            for (int u = bid; u < NU_LAT; u += nb) { const int blk = u % (SEQ / 128), h = (u / (SEQ / 128)) % 8, b = u / (8 * (SEQ / 128)); const int s0 = blk * 128;
                attn_unit<0>(lds, p.QC + (size_t)(b * SEQ + s0) * 512 + h * 64, p.KC + (size_t)(b * 2 + h / 4) * LKV * 64, p.VCt + (size_t)(b * 2 + h / 4) * 64 * LKV,
                             p.Y + (size_t)(b * SEQ + s0) * 1024 + h * 64, s0, CTX_LEN / 64, 0, SEQ / 64, 0.f, false, nullptr); }
            if (tsplit) *tsplit = __builtin_amdgcn_s_memrealtime();
        } else if ((rep == 0) == hy_first) {
            __syncthreads();
            for (int c = hy_first ? bid - (nb >> 1) : bid + (nb >> 1); c < D_CH; c += nb) hyena_channel(p, c, (float*)lds);
            __syncthreads();
        }
    }
}
constexpr int TR_ITEMS = BATCH * (D_CH / 64) * (SEQ / 64);
__device__ __forceinline__ void tr_item(const Params& p, char* lds, int it) {
    bf16_t* T = (bf16_t*)lds; const int tid = threadIdx.x;
    const int sb = it % (SEQ / 64), cb = (it / (SEQ / 64)) % (D_CH / 64), b = it / ((SEQ / 64) * (D_CH / 64));
    { const int c = tid >> 2, q = tid & 3;
      const u32x4* src = (const u32x4*)(p.YHT + ((size_t)b * D_CH + cb * 64 + c) * SEQ + sb * 64 + q * 16);
      const u32x4 v0 = src[0], v1 = src[1]; unsigned* d = (unsigned*)(T + c * 66 + q * 16);
      d[0] = v0.x; d[1] = v0.y; d[2] = v0.z; d[3] = v0.w; d[4] = v1.x; d[5] = v1.y; d[6] = v1.z; d[7] = v1.w; }
    __syncthreads();
    { const int s = tid >> 2, q = tid & 3;
      unsigned w[8];
#pragma unroll
      for (int i = 0; i < 8; ++i) w[i] = (unsigned)T[(q * 16 + 2 * i) * 66 + s] | ((unsigned)T[(q * 16 + 2 * i + 1) * 66 + s] << 16);
      u32x4* dst = (u32x4*)(p.Y + ((size_t)b * SEQ + sb * 64 + s) * 1024 + 512 + cb * 64 + q * 16);
      dst[0] = (u32x4){w[0], w[1], w[2], w[3]}; dst[1] = (u32x4){w[4], w[5], w[6], w[7]}; }
    __syncthreads();
}
enum { PH_PREP = 0, PH_NORM0, PH_INPROJ0, PH_ATTN0, PH_OUT0, PH_ROUTE0, PH_ROUTEB0, PH_UP0, PH_DOWN0, PH_NORM1, PH_INPROJ1, PH_MIX1, PH_HY1, PH_TR1, PH_OUT1, PH_ROUTE1, PH_ROUTEB1, PH_UP1, PH_DOWN1, PH_FINAL, PH_COUNT };
typedef const __attribute__((address_space(4))) Params* KParams;
__global__ void __launch_bounds__(NTHREADS, 2) mega(Params p_arg, int lo, int hi) {
    extern __shared__ __attribute__((aligned(16))) char lds[];
    const int bid = blockIdx.x, nb = gridDim.x;
    volatile LAS unsigned* st = (volatile LAS unsigned*)(lds + LDS_BYTES - 16);
    if (threadIdx.x < 4) st[threadIdx.x] = 0u;
    __syncthreads();
    KParams kp = (KParams)__builtin_amdgcn_kernarg_segment_ptr();
    XcdBarrier bar; bar.bar = kp->bar; bar.x = 0; bar.st = st;
    if (hi - lo > 1) bar = xcd_barrier_post(kp->bar, st);
#ifdef PROBE_PA
    unsigned long long ts_prev = __builtin_amdgcn_s_memrealtime(), t_a = 0, t_b = 0;
#define STAMP(PH) if (bid == 0 && threadIdx.x == 0) { const unsigned long long now_ = __builtin_amdgcn_s_memrealtime(); if ((PH) == PROBE_PA) t_a = now_ - ts_prev; if ((PH) == PROBE_PB) t_b = now_ - ts_prev; ts_prev = now_; }
#else
#define STAMP(PH)
#endif
#define PHASE(PH, body) if (lo <= (PH) && (PH) < hi) { { KParams kq_ = kp; asm volatile("" : "+s"(kq_)); const Params& p = *(const Params*)kq_; body; } if ((PH) + 1 < hi) xcd_barrier(bar); STAMP(PH) }
    PHASE(PH_PREP, { if (nb > MOD_ITEMS + 64) { if (bid < MOD_ITEMS) mod_item(p, lds, bid); else cvt_range(p, lds, 0, CVT_EARLY, bid - MOD_ITEMS, nb - MOD_ITEMS); }
        else { for (int it = bid; it < MOD_ITEMS; it += nb) mod_item(p, lds, it); cvt_range(p, lds, 0, CVT_EARLY, bid, nb); }
        d_rope(p); d_hy_h1(p); })
    PHASE(PH_NORM0, { ph_norm(p, 0, 0, TT, bid, nb); d_hy_h2(p); })
    PHASE(PH_INPROJ0, ph_inproj<0>(p, lds, bid, nb))
    PHASE(PH_ATTN0, { if (bid >= (nb >> 1)) { cvt_range(p, lds, CVT_EARLY, CVT_TOTAL, bid, nb); __syncthreads(); ph_attn0(p, lds, bid, nb); } else { ph_attn0(p, lds, bid, nb); __syncthreads(); cvt_range(p, lds, CVT_EARLY, CVT_TOTAL, bid, nb); } })
    PHASE(PH_OUT0, { ph_outproj<0>(p, lds, bid, nb);
        const int rem_ = (MT_ALL * 8) % nb; __syncthreads(); if (bid >= rem_) for (int it = bid - rem_; it < FILT_ITEMS; it += nb - rem_) filt_item(p, lds, it); })
    PHASE(PH_ROUTE0, ph_route_a(p, lds, 0, TT, bid, nb))
    PHASE(PH_ROUTEB0, ph_route_b(p, lds, 0, TT, bid, nb))
    PHASE(PH_UP0, ph_moe_up(p, lds, 0, bid, nb))
    PHASE(PH_DOWN0, ph_moe_down(p, lds, 0, bid, nb))
    PHASE(PH_NORM1, ph_norm(p, 1, 0, TT, bid, nb))
    PHASE(PH_INPROJ1, ph_inproj<1>(p, lds, bid, nb))
    PHASE(PH_MIX1, ph_attnC(p, lds, bid, nb))
    PHASE(PH_HY1, for (int c = bid; c < D_CH; c += nb) hyena_channel(p, c, (float*)lds))
    PHASE(PH_TR1, for (int it = bid; it < TR_ITEMS; it += nb) tr_item(p, lds, it))
    PHASE(PH_OUT1, ph_outproj<1>(p, lds, bid, nb))
    PHASE(PH_ROUTE1, ph_route_a(p, lds, 1, TX, bid, nb))
    PHASE(PH_ROUTEB1, ph_route_b(p, lds, 1, TX, bid, nb))
    PHASE(PH_UP1, ph_moe_up(p, lds, 1, bid, nb))
    PHASE(PH_DOWN1, ph_moe_down(p, lds, 1, bid, nb))
    PHASE(PH_FINAL, ph_final(p, bid, nb))
#ifdef PROBE_PA
    if (bid == 0 && threadIdx.x == 0) {
        const unsigned long long delay = 2 * t_a + 204800ull * ((t_b + 200) / 400); const unsigned long long t0 = __builtin_amdgcn_s_memrealtime();
        while (__builtin_amdgcn_s_memrealtime() - t0 < delay) __builtin_amdgcn_s_sleep(32);
    }
#endif
}
extern "C" void kernel_launch(void* const* d_in, const int* in_sizes, int n_in, void* d_out, int out_size, void* d_ws, size_t ws_size, hipStream_t stream) {
    static int grid = 0;
    if (grid == 0) {
        int dev = 0, cus = 0;
        if (hipGetDevice(&dev) != hipSuccess || hipDeviceGetAttribute(&cus, hipDeviceAttributeMultiprocessorCount, dev) != hipSuccess) { fprintf(stderr, "kernel_launch: device query failed\n"); grid = -1; return; }
        if (hipFuncSetAttribute((const void*)mega, hipFuncAttributeMaxDynamicSharedMemorySize, LDS_BYTES) != hipSuccess) { fprintf(stderr, "kernel_launch: hipFuncSetAttribute failed\n"); grid = -1; return; }
        grid = 2 * cus;
    }
    if (grid < 0) return;
    Params p{};
    size_t need = setup_ws(p, (char*)d_ws);
    if (n_in != 32 || need > ws_size || out_size != TX * D_MODEL) { fprintf(stderr, "kernel_launch: bad config n_in %d ws %zu need %zu out %d\n", n_in, ws_size, need, out_size); return; }
    fill_inputs(p, d_in, d_out);
    hipMemsetAsync(p.bar, 0, 64 * 1024 + 256, stream);
#ifdef PER_PHASE
    for (int ph = 0; ph < PH_COUNT; ++ph) mega<<<dim3(grid), dim3(NTHREADS), LDS_BYTES, stream>>>(p, ph, ph + 1);
#else
    mega<<<dim3(grid), dim3(NTHREADS), LDS_BYTES, stream>>>(p, 0, PH_COUNT);
#endif
}
```

```cpp
#include <hip/hip_runtime.h>
#include <cstdio>
#include <math.h>
#include <stdint.h>
#include <string.h>

#ifdef CPU_TEST
#define HD
#define GLOBAL
struct U3 { unsigned x, y, z; };
static thread_local U3 threadIdx, blockIdx, blockDim, gridDim;
static inline int atomicAdd(int* p, int v) { return __sync_fetch_and_add(p, v); }
#else
#define HD __device__ __forceinline__
#define GLOBAL __global__ __launch_bounds__(256)
#endif

#if defined(HY_TEST)
constexpr int D_MODEL = 64, BATCH = 2, SEQ = 4096, GRID_W = 64, CTX_LEN = 64, D_CH = 4, D_EXPERT = 64;
#elif defined(SMALL_CFG)
constexpr int D_MODEL = 128, BATCH = 2, SEQ = 512, GRID_W = 32, CTX_LEN = 64, D_CH = 32, D_EXPERT = 64;
#else
constexpr int D_MODEL = 1024, BATCH = 4, SEQ = 4096, GRID_W = 64, CTX_LEN = 256, D_CH = 512, D_EXPERT = 512;
#endif
constexpr int DEPTH = 2, HEAD_DIM = 64;
constexpr int GRID_H = SEQ / GRID_W;
constexpr int A_WINDOW = 128;
constexpr int B_WIN_H = 8, B_WIN_W = 16;
constexpr int HY_BANDS = 16, HY_EMB = 33, HY_FFN = 64;
constexpr int EVEN_IN = 2304, EVEN_OUT = 1024;
constexpr int ODD_IN = 768 + 3 * D_CH, ODD_OUT = 512 + D_CH;
constexpr int N_EXPERTS = 16;
constexpr int TX = BATCH * SEQ, TC = BATCH * CTX_LEN, TT = TX + TC;
constexpr int LKV = CTX_LEN + SEQ;
constexpr int NPAIR = 24;
constexpr int HE_W = 2 * D_EXPERT;
constexpr float EPS = 1e-6f;
constexpr float ATTN_SCALE = 0.125f;

typedef unsigned short bf16_t;
HD bf16_t f2bf(float f) { unsigned u; __builtin_memcpy(&u, &f, 4); u = (u + 0x7fffu + ((u >> 16) & 1u)) >> 16; return (bf16_t)u; }
HD float bf2f(bf16_t h) { unsigned u = ((unsigned)h) << 16; float f; __builtin_memcpy(&f, &u, 4); return f; }
HD float silu_f(float x) { return x / (1.0f + expf(-x)); }
HD float sigmoid_f(float x) { return 1.0f / (1.0f + expf(-x)); }

struct Params {
    const float *x, *c, *ctx, *c_ctx, *w_ada, *b_ada, *norm_g, *final_g, *w_in_even, *w_out_even, *a_sink, *b_rpb;
    const float *w_in_odd, *w_out_odd, *c_qnorm, *c_knorm, *hy_short_w, *hy_short_b, *hy_w1, *hy_b1, *hy_f1, *hy_w2;
    const float *hy_b2, *hy_f2, *hy_w3, *hy_b3, *hy_bias, *w_router, *b_router, *moe_wg, *moe_wu, *moe_wd;
    float* out;
    float* XC;
    float* mod;
    float* ropet;
    float* h1;
    float* h2;
    float* HFT;
    float* hnorm;
    bf16_t* hbuf;
    bf16_t *QA, *KA, *VAt, *QB, *KB, *VBt;
    bf16_t *QC, *KC, *VCt, *UT;
    bf16_t* Y;
    bf16_t* YHT;
    float* Z1;
    bf16_t* HE;
    int* cnt;
    int* list;
    float* tokw;
    bf16_t *Wt_in_even, *Wt_out_even, *Wt_in_odd, *Wt_out_odd, *Wt_gu, *Wt_d;
    unsigned* bar;
    int* rpair;
    int* bh;
    float* rlog;
};

#define GS_LOOP(i, n) for (long i = (long)blockIdx.x * blockDim.x + threadIdx.x; i < (long)(n); i += (long)gridDim.x * blockDim.x)

HD const float* xrow_in(const Params& p, int l, int row) {
    if (l == 0) return row < TX ? p.x + (size_t)row * D_MODEL : p.ctx + (size_t)(row - TX) * D_MODEL;
    return row < TX ? p.out + (size_t)row * D_MODEL : p.XC + (size_t)(row - TX) * D_MODEL;
}
HD float* xrow_cur(const Params& p, int row) { return row < TX ? p.out + (size_t)row * D_MODEL : p.XC + (size_t)(row - TX) * D_MODEL; }
HD int row_mod(int row) { return row < TX ? row / SEQ : BATCH; }
HD const float* modp(const Params& p, int l, int row, int which) { return p.mod + ((size_t)(l * (BATCH + 1) + row_mod(row)) * 6 + which) * D_MODEL; }

GLOBAL void nk_mod(Params p) {
    GS_LOOP(i, DEPTH * (BATCH + 1) * 6 * D_MODEL) {
        int j = i % (6 * D_MODEL); int r = (i / (6 * D_MODEL)) % (BATCH + 1); int l = i / (6 * D_MODEL * (BATCH + 1));
        const float* cv = r < BATCH ? p.c + r * D_MODEL : p.c_ctx;
        const float* w = p.w_ada + (size_t)l * D_MODEL * 6 * D_MODEL;
        float acc = 0.f;
        for (int k = 0; k < D_MODEL; ++k) acc += silu_f(cv[k]) * w[(size_t)k * 6 * D_MODEL + j];
        p.mod[i] = acc + p.b_ada[l * 6 * D_MODEL + j];
    }
}
HD void d_rope(const Params& p) {
    GS_LOOP(i, 64 * 16) {
        int pos = i / 16, k = i % 16;
        float inv = powf(10000.0f, -(float)(2 * k) / 32.0f);
        float a = (float)pos * inv;
        p.ropet[pos * 32 + k] = cosf(a); p.ropet[pos * 32 + 16 + k] = sinf(a);
    }
}
HD void d_hy_h1(const Params& p) {
    GS_LOOP(i, SEQ * HY_FFN) {
        int t = i / HY_FFN, k = i % HY_FFN;
        float tn = (float)t / (float)(SEQ - 1);
        float acc = tn * p.hy_w1[0 * HY_FFN + k];
        for (int b = 0; b < HY_BANDS; ++b) {
            float band = 1e-4f + (float)b * ((float)(HY_BANDS - 1) - 1e-4f) / (float)(HY_BANDS - 1);
            float ang = 2.0f * 3.14159265358979323846f * (float)t * band / (float)SEQ;
            acc += cosf(ang) * p.hy_w1[(1 + b) * HY_FFN + k] + sinf(ang) * p.hy_w1[(1 + HY_BANDS + b) * HY_FFN + k];
        }
        p.h1[i] = sinf(p.hy_f1[k] * (acc + p.hy_b1[k]));
    }
}
HD void d_hy_h2(const Params& p) {
    GS_LOOP(i, SEQ * HY_FFN) {
        int t = i / HY_FFN, j = i % HY_FFN;
        float acc = 0.f;
        for (int k = 0; k < HY_FFN; ++k) acc += p.h1[t * HY_FFN + k] * p.hy_w2[k * HY_FFN + j];
        p.h2[i] = sinf(p.hy_f2[j] * (acc + p.hy_b2[j]));
    }
}
HD float hy_decay(int t, int c) {
    const float mind = logf(1e-2f) / 1.5f, maxd = logf(1e-2f) / 0.3f;
    float delta = fabsf(mind + (float)c * (maxd - mind) / (float)(D_CH - 1));
    float tn = (float)t / (float)(SEQ - 1);
    return expf(-tn * delta);
}
GLOBAL void nk_hy_filt(Params p) {
    GS_LOOP(i, 4 * D_CH * SEQ) {
        int t = i % SEQ, col = i / SEQ, c = col % D_CH;
        float acc = p.hy_b3[col];
        for (int k = 0; k < HY_FFN; ++k) acc += p.h2[t * HY_FFN + k] * p.hy_w3[k * 4 * D_CH + col];
        p.HFT[i] = acc * hy_decay(t, c);
    }
}
GLOBAL void nk_hy_norm(Params p) {
    GS_LOOP(i, 2 * D_CH) {
        int o = i / D_CH, c = i % D_CH;
        float s = 0.f;
        for (int dir = 0; dir < 2; ++dir) { const float* h = p.HFT + (size_t)((dir * 2 + o) * D_CH + c) * SEQ; for (int t = 0; t < SEQ; ++t) s += fabsf(h[t]); }
        p.hnorm[i] = s + EPS;
    }
}
GLOBAL void nk_zero_cnt(Params p) { GS_LOOP(i, 64) p.cnt[i] = 0; }

GLOBAL void nk_norm(Params p, int l, int which, int nrows) {
    GS_LOOP(row, nrows) {
        const float* xr = which == 0 ? xrow_in(p, l, (int)row) : xrow_cur(p, (int)row);
        float ss = 0.f;
        for (int k = 0; k < D_MODEL; ++k) ss += xr[k] * xr[k];
        float rstd = 1.0f / sqrtf(ss / D_MODEL + EPS);
        const float* g = p.norm_g + (l * 2 + which) * D_MODEL;
        const float* sh = modp(p, l, (int)row, which * 3 + 0); const float* sc = modp(p, l, (int)row, which * 3 + 1);
        for (int k = 0; k < D_MODEL; ++k) p.hbuf[row * D_MODEL + k] = f2bf(xr[k] * rstd * g[k] * (1.0f + sc[k]) + sh[k]);
    }
}

HD float dot_row(const bf16_t* a, const float* W, int ldw, int col, int K) {
    float acc = 0.f;
    for (int k = 0; k < K; ++k) acc += bf2f(a[k]) * W[(size_t)k * ldw + col];
    return acc;
}
HD float rope_apply(const Params& p, float v, float partner, int d, int s) {
    int half = d >> 5, dd = d & 31, k = dd & 15;
    int pos = half == 0 ? s / GRID_W : s % GRID_W;
    float c = p.ropet[pos * 32 + k], sn = p.ropet[pos * 32 + 16 + k];
    return dd < 16 ? v * c - partner * sn : v * c + partner * sn;
}

GLOBAL void nk_inproj_even(Params p) {
    GS_LOOP(i, (long)TT * EVEN_IN) {
        int row = i / EVEN_IN, col = i % EVEN_IN;
        const bf16_t* a = p.hbuf + (size_t)row * D_MODEL;
        float v = dot_row(a, p.w_in_even, EVEN_IN, col, D_MODEL);
        bool lat = row < TX; int b = lat ? row / SEQ : (row - TX) / CTX_LEN; int s = lat ? row % SEQ : (row - TX) % CTX_LEN;
        int pos = lat ? CTX_LEN + s : s;
        if (col < 640) {
            int d = col & 63;
            if (lat) { int pc = (d & 31) < 16 ? col + 16 : col - 16; float pv = dot_row(a, p.w_in_even, EVEN_IN, pc, D_MODEL); v = rope_apply(p, v, pv, d, s); }
            if (col < 512) p.QA[(size_t)row * 512 + col] = f2bf(v);
            else { int h = (col - 512) >> 6; p.KA[((size_t)(b * 2 + h) * LKV + pos) * 64 + d] = f2bf(v); }
        } else if (col < 768) { int h = (col - 640) >> 6, d = col & 63; p.VAt[((size_t)(b * 2 + h) * 64 + d) * LKV + pos] = f2bf(v); }
        else if (col < 1280) p.QB[(size_t)row * 512 + (col - 768)] = f2bf(v);
        else if (col < 1792) { int h = (col - 1280) >> 6, d = col & 63; p.KB[((size_t)(b * 8 + h) * LKV + pos) * 64 + d] = f2bf(v); }
        else { int h = (col - 1792) >> 6, d = col & 63; p.VBt[((size_t)(b * 8 + h) * 64 + d) * LKV + pos] = f2bf(v); }
    }
}

struct OSM { float m, l; };
#define ATT_BEGIN() float q[64], acc[64]; for (int d = 0; d < 64; ++d) { q[d] = bf2f(qp[d]) * ATTN_SCALE; acc[d] = 0.f; } float m_ = -1e30f, l_ = 0.f;
#define ATT_KEY(Kp, Vt, key, bias) do { const bf16_t* kk_ = (Kp) + (size_t)(key) * 64; float s_ = (bias); for (int d = 0; d < 64; ++d) s_ += q[d] * bf2f(kk_[d]); \
    float mn_ = fmaxf(m_, s_); float f_ = expf(m_ - mn_), pe_ = expf(s_ - mn_); l_ = l_ * f_ + pe_; \
    for (int d = 0; d < 64; ++d) acc[d] = acc[d] * f_ + pe_ * bf2f((Vt)[(size_t)d * LKV + (key)]); m_ = mn_; } while (0)
#define ATT_SINK(sv) do { float s_ = (sv); float mn_ = fmaxf(m_, s_); float f_ = expf(m_ - mn_); l_ = l_ * f_ + expf(s_ - mn_); for (int d = 0; d < 64; ++d) acc[d] *= f_; m_ = mn_; } while (0)

GLOBAL void nk_attnA(Params p) {
    GS_LOOP(i, (long)TX * 8) {
        int h = i % 8, row = i / 8, b = row / SEQ, s = row % SEQ, kvh = h / 4;
        const bf16_t* qp = p.QA + (size_t)row * 512 + h * 64;
        const bf16_t* Kp = p.KA + (size_t)(b * 2 + kvh) * LKV * 64; const bf16_t* Vt = p.VAt + (size_t)(b * 2 + kvh) * 64 * LKV;
        ATT_BEGIN();
        for (int j = 0; j < CTX_LEN; ++j) ATT_KEY(Kp, Vt, j, 0.f);
        int lo = s - A_WINDOW < 0 ? 0 : s - A_WINDOW, hi = s + A_WINDOW > SEQ - 1 ? SEQ - 1 : s + A_WINDOW;
        for (int j = lo; j <= hi; ++j) ATT_KEY(Kp, Vt, CTX_LEN + j, 0.f);
        ATT_SINK(p.a_sink[h]);
        for (int d = 0; d < 64; ++d) p.Y[(size_t)row * 1024 + h * 64 + d] = f2bf(acc[d] / l_);
    }
}
GLOBAL void nk_attnB(Params p) {
    GS_LOOP(i, (long)TX * 8) {
        int h = i % 8, row = i / 8, b = row / SEQ, s = row % SEQ, r = s / GRID_W, cq = s % GRID_W;
        const bf16_t* qp = p.QB + (size_t)row * 512 + h * 64;
        const bf16_t* Kp = p.KB + (size_t)(b * 8 + h) * LKV * 64; const bf16_t* Vt = p.VBt + (size_t)(b * 8 + h) * 64 * LKV;
        ATT_BEGIN();
        for (int j = 0; j < CTX_LEN; ++j) ATT_KEY(Kp, Vt, j, 0.f);
        int kh = B_WIN_H < GRID_H ? B_WIN_H : GRID_H;
        int rs = r - kh / 2; if (rs < 0) rs = 0; if (rs > GRID_H - kh) rs = GRID_H - kh;
        int cs = cq - B_WIN_W / 2; if (cs < 0) cs = 0; if (cs > GRID_W - B_WIN_W) cs = GRID_W - B_WIN_W;
        for (int kr = rs; kr < rs + kh; ++kr)
            for (int kc = cs; kc < cs + B_WIN_W; ++kc) {
                int dr = kr - r, dc = kc - cq;
                float bias = p.b_rpb[(h * (2 * B_WIN_H - 1) + dr + B_WIN_H - 1) * (2 * B_WIN_W - 1) + dc + B_WIN_W - 1];
                ATT_KEY(Kp, Vt, CTX_LEN + kr * GRID_W + kc, bias);
            }
        for (int d = 0; d < 64; ++d) p.Y[(size_t)row * 1024 + 512 + h * 64 + d] = f2bf(acc[d] / l_);
    }
}
GLOBAL void nk_attn_ctx(Params p) {
    GS_LOOP(i, (long)TC * 16) {
        int hh = i % 16, rc = i / 16, ty = hh / 8, h = hh % 8, b = rc / CTX_LEN; int row = TX + rc;
        const bf16_t* qp = (ty == 0 ? p.QA : p.QB) + (size_t)row * 512 + h * 64;
        const bf16_t* Kp = ty == 0 ? p.KA + (size_t)(b * 2 + h / 4) * LKV * 64 : p.KB + (size_t)(b * 8 + h) * LKV * 64;
        const bf16_t* Vt = ty == 0 ? p.VAt + (size_t)(b * 2 + h / 4) * 64 * LKV : p.VBt + (size_t)(b * 8 + h) * 64 * LKV;
        ATT_BEGIN();
        for (int j = 0; j < CTX_LEN; ++j) ATT_KEY(Kp, Vt, j, 0.f);
        if (ty == 0) ATT_SINK(p.a_sink[h]);
        for (int d = 0; d < 64; ++d) p.Y[(size_t)row * 1024 + ty * 512 + h * 64 + d] = f2bf(acc[d] / l_);
    }
}
GLOBAL void nk_attnC(Params p) {
    GS_LOOP(i, (long)TX * 8) {
        int h = i % 8, row = i / 8, b = row / SEQ, kvh = h / 4;
        const bf16_t* qp = p.QC + (size_t)row * 512 + h * 64;
        const bf16_t* Kp = p.KC + (size_t)(b * 2 + kvh) * LKV * 64; const bf16_t* Vt = p.VCt + (size_t)(b * 2 + kvh) * 64 * LKV;
        ATT_BEGIN();
        for (int j = 0; j < LKV; ++j) ATT_KEY(Kp, Vt, j, 0.f);
        for (int d = 0; d < 64; ++d) p.Y[(size_t)row * 1024 + h * 64 + d] = f2bf(acc[d] / l_);
    }
}

GLOBAL void nk_outproj_even(Params p) {
    GS_LOOP(i, (long)TT * D_MODEL) {
        int row = i / D_MODEL, col = i % D_MODEL;
        float acc = dot_row(p.Y + (size_t)row * 1024, p.w_out_even, D_MODEL, col, EVEN_OUT);
        xrow_cur(p, row)[col] = xrow_in(p, 0, row)[col] + modp(p, 0, row, 2)[col] * acc;
    }
}
GLOBAL void nk_outproj_odd(Params p) {
    GS_LOOP(i, (long)TX * D_MODEL) {
        int row = i / D_MODEL, col = i % D_MODEL, b = row / SEQ, s = row % SEQ;
        float acc = dot_row(p.Y + (size_t)row * 1024, p.w_out_odd, D_MODEL, col, 512);
        for (int c = 0; c < D_CH; ++c) acc += bf2f(p.YHT[((size_t)b * D_CH + c) * SEQ + s]) * p.w_out_odd[(size_t)(512 + c) * D_MODEL + col];
        p.out[i] = p.out[i] + modp(p, 1, row, 2)[col] * acc;
    }
}

GLOBAL void nk_router(Params p, int l, int nrows) {
    GS_LOOP(row, nrows) {
        const float* xr = xrow_cur(p, (int)row);
        float ss = 0.f;
        for (int k = 0; k < D_MODEL; ++k) ss += xr[k] * xr[k];
        float rstd = 1.0f / sqrtf(ss / D_MODEL + EPS);
        const float* g = p.norm_g + (l * 2 + 1) * D_MODEL; const float* sh = modp(p, l, (int)row, 3); const float* sc = modp(p, l, (int)row, 4);
        float lg[16];
#pragma unroll
        for (int e = 0; e < 16; ++e) lg[e] = 0.f;
        for (int k = 0; k < D_MODEL; ++k) { float hv = xr[k] * rstd * g[k] * (1.0f + sc[k]) + sh[k];
#pragma unroll
            for (int e = 0; e < 16; ++e) lg[e] += hv * p.w_router[k * 16 + e]; }
        int gbest = 0, a = 0, bb = 1; float gbs = -1e30f, wa = 0.f, wb = 0.f;
#pragma unroll
        for (int gI = 0; gI < 4; ++gI) {
            float m1 = -1e30f, m2 = -1e30f, s1 = 0.f, s2 = 0.f; int i1 = 0, i2 = 0;
#pragma unroll
            for (int j = 0; j < 4; ++j) { float sgv = sigmoid_f(lg[gI * 4 + j]); float v = sgv + p.b_router[gI * 4 + j];
                if (v > m1) { m2 = m1; i2 = i1; s2 = s1; m1 = v; i1 = j; s1 = sgv; } else if (v > m2) { m2 = v; i2 = j; s2 = sgv; } }
            float gs = m1 + m2;
            if (gs > gbs) { gbs = gs; gbest = gI; if (i1 < i2) { a = i1; bb = i2; wa = s1; wb = s2; } else { a = i2; bb = i1; wa = s2; wb = s1; } }
        }
        float inv = 1.0f / (wa + wb);
        int pidx = a == 0 ? bb - 1 : (a == 1 ? bb + 1 : 5);
        int pr = gbest * 6 + pidx;
        int pos = atomicAdd(p.cnt + l * 32 + pr, 1);
        p.list[(size_t)pr * TT + pos] = (int)row;
        p.tokw[row * 2 + 0] = wa * inv; p.tokw[row * 2 + 1] = wb * inv;
    }
}
HD void pair_experts(int pr, int& e1, int& e2) { int g = pr / 6, q = pr % 6; int a = q < 3 ? 0 : (q < 5 ? 1 : 2); int b = q < 3 ? q + 1 : (q < 5 ? q - 1 : 3); e1 = g * 4 + a; e2 = g * 4 + b; }
HD bool slot_lookup(const Params& p, int l, int slot, int& pr, int& row) { int acc = 0; for (int q = 0; q < NPAIR; ++q) { int c = p.cnt[l * 32 + q]; if (slot < acc + c) { pr = q; row = p.list[(size_t)q * TT + (slot - acc)]; return true; } acc += c; } return false; }
GLOBAL void nk_moe_up(Params p, int l, int nrows) {
    GS_LOOP(i, (long)nrows * HE_W) {
        int slot = i / HE_W, j = i % HE_W, k = j / D_EXPERT, jj = j % D_EXPERT; int pr, row; if (!slot_lookup(p, l, slot, pr, row)) continue;
        int e1, e2; pair_experts(pr, e1, e2); int e = k == 0 ? e1 : e2;
        const bf16_t* a = p.hbuf + (size_t)row * D_MODEL;
        const float* wg = p.moe_wg + (size_t)(l * N_EXPERTS + e) * D_MODEL * D_EXPERT; const float* wu = p.moe_wu + (size_t)(l * N_EXPERTS + e) * D_MODEL * D_EXPERT;
        float g = dot_row(a, wg, D_EXPERT, jj, D_MODEL), u = dot_row(a, wu, D_EXPERT, jj, D_MODEL);
        p.HE[(size_t)row * HE_W + j] = f2bf(p.tokw[row * 2 + k] * silu_f(g) * u);
    }
}
GLOBAL void nk_moe_down(Params p, int l, int nrows) {
    GS_LOOP(i, (long)nrows * D_MODEL) {
        int slot = i / D_MODEL, col = i % D_MODEL; int pr, row; if (!slot_lookup(p, l, slot, pr, row)) continue;
        int e1, e2; pair_experts(pr, e1, e2);
        const bf16_t* a = p.HE + (size_t)row * HE_W;
        float acc = dot_row(a, p.moe_wd + (size_t)(l * N_EXPERTS + e1) * D_EXPERT * D_MODEL, D_MODEL, col, D_EXPERT)
                  + dot_row(a + D_EXPERT, p.moe_wd + (size_t)(l * N_EXPERTS + e2) * D_EXPERT * D_MODEL, D_MODEL, col, D_EXPERT);
        float* xr = xrow_cur(p, row);
        xr[col] = xr[col] + modp(p, l, row, 5)[col] * acc;
    }
}

GLOBAL void nk_inproj_odd_qk(Params p) {
    GS_LOOP(i, (long)TT * 10) {
        int row = i / 10, hu = i % 10; const bf16_t* a = p.hbuf + (size_t)row * D_MODEL;
        bool lat = row < TX; int b = lat ? row / SEQ : (row - TX) / CTX_LEN; int s = lat ? row % SEQ : (row - TX) % CTX_LEN; int pos = lat ? CTX_LEN + s : s;
        int col0 = hu * 64;
        float v[64]; float ss = 0.f;
        for (int d = 0; d < 64; ++d) { v[d] = dot_row(a, p.w_in_odd, ODD_IN, col0 + d, D_MODEL); ss += v[d] * v[d]; }
        float rstd = 1.0f / sqrtf(ss / 64.0f + EPS);
        const float* gn = hu < 8 ? p.c_qnorm : p.c_knorm;
        for (int d = 0; d < 64; ++d) v[d] = v[d] * rstd * gn[d];
        for (int d = 0; d < 64; ++d) {
            float o = v[d];
            if (lat) { int pd = (d & 31) < 16 ? d + 16 : d - 16; o = rope_apply(p, v[d], v[pd], d, s); }
            if (hu < 8) p.QC[(size_t)row * 512 + col0 + d] = f2bf(o);
            else p.KC[((size_t)(b * 2 + (hu - 8)) * LKV + pos) * 64 + d] = f2bf(o);
        }
    }
}
GLOBAL void nk_inproj_odd_vu(Params p) {
    GS_LOOP(i, (long)TT * (ODD_IN - 640)) {
        int row = i / (ODD_IN - 640), col = 640 + i % (ODD_IN - 640); const bf16_t* a = p.hbuf + (size_t)row * D_MODEL;
        bool lat = row < TX; int b = lat ? row / SEQ : (row - TX) / CTX_LEN; int s = lat ? row % SEQ : (row - TX) % CTX_LEN; int pos = lat ? CTX_LEN + s : s;
        if (col >= 768 && !lat) continue;
        float v = dot_row(a, p.w_in_odd, ODD_IN, col, D_MODEL);
        if (col < 768) { int h = (col - 640) >> 6, d = col & 63; p.VCt[((size_t)(b * 2 + h) * 64 + d) * LKV + pos] = f2bf(v); }
        else p.UT[((size_t)b * 3 * D_CH + (col - 768)) * SEQ + s] = f2bf(v);
    }
}

HD float hy_sc(const Params& p, int b, int ch, int t) {
    const bf16_t* u = p.UT + ((size_t)b * 3 * D_CH + ch) * SEQ;
    float acc = p.hy_short_b[ch];
    for (int kk = 0; kk < 3; ++kk) { int tt = t + kk - 1; if (tt >= 0 && tt < SEQ) acc += p.hy_short_w[kk * 3 * D_CH + ch] * bf2f(u[tt]); }
    return acc;
}
GLOBAL void nk_hy_conv(Params p, int o) {
    GS_LOOP(i, (long)BATCH * D_CH * SEQ) {
        int n = i % SEQ, c = (i / SEQ) % D_CH, b = i / ((long)SEQ * D_CH);
        const float* hf = p.HFT + (size_t)((0 * 2 + o) * D_CH + c) * SEQ; const float* hb = p.HFT + (size_t)((1 * 2 + o) * D_CH + c) * SEQ;
        float inv = 1.0f / p.hnorm[o * D_CH + c];
        float acc = 0.f;
        for (int m = 0; m < SEQ; ++m) {
            float z = o == 0 ? hy_sc(p, b, c, m) : p.Z1[((size_t)b * D_CH + c) * SEQ + m];
            int d = n - m; float hv = d >= 0 ? hf[d] : hb[-d];
            acc += hv * z;
        }
        acc *= inv;
        float zn = o == 0 ? hy_sc(p, b, c, n) : p.Z1[((size_t)b * D_CH + c) * SEQ + n];
        float g = hy_sc(p, b, (o + 1) * D_CH + c, n);
        float r = g * (acc + zn * p.hy_bias[o * D_CH + c]);
        if (o == 0) p.Z1[i] = r; else p.YHT[i] = f2bf(r);
    }
}

GLOBAL void nk_final(Params p) {
    GS_LOOP(row, TX) {
        float* xr = p.out + (size_t)row * D_MODEL; float ss = 0.f;
        for (int k = 0; k < D_MODEL; ++k) ss += xr[k] * xr[k];
        float rstd = 1.0f / sqrtf(ss / D_MODEL + EPS);
        for (int k = 0; k < D_MODEL; ++k) xr[k] = xr[k] * rstd * p.final_g[k];
    }
}
GLOBAL void nk_yht_to_y(Params p) {
    GS_LOOP(i, (long)TX * D_CH) { int row = i / D_CH, c = i % D_CH, b = row / SEQ, s = row % SEQ; p.Y[(size_t)row * 1024 + 512 + c] = p.YHT[((size_t)b * D_CH + c) * SEQ + s]; }
}

GLOBAL void nk_rope(Params p) { d_rope(p); }
GLOBAL void nk_hy_h1(Params p) { d_hy_h1(p); }
GLOBAL void nk_hy_h2(Params p) { d_hy_h2(p); }
static inline size_t al256(size_t x) { return (x + 255) & ~(size_t)255; }
static size_t setup_ws(Params& p, char* ws) {
    size_t o = 0;
    auto take = [&](size_t bytes) { char* r = ws + o; o += al256(bytes); return r; };
    p.bar = (unsigned*)take(64 * 1024);
    p.cnt = (int*)take(256);
    p.XC = (float*)take((size_t)TC * D_MODEL * 4);
    p.mod = (float*)take((size_t)DEPTH * (BATCH + 1) * 6 * D_MODEL * 4);
    p.ropet = (float*)take(64 * 32 * 4);
    p.h1 = (float*)take((size_t)SEQ * 64 * 4);
    p.h2 = (float*)take((size_t)SEQ * 64 * 4);
    p.HFT = (float*)take((size_t)4 * D_CH * SEQ * 4);
    p.hnorm = (float*)take(2 * D_CH * 4);
    p.list = (int*)take((size_t)NPAIR * TT * 4);
    p.tokw = (float*)take((size_t)TT * 2 * 4);
    p.rpair = (int*)take((size_t)TT * 4);
    p.bh = (int*)take((size_t)2048 * 32 * 4);
    p.rlog = (float*)take((size_t)TT * 16 * 4);
    size_t hb = (size_t)TT * D_MODEL * 2, z1 = (size_t)BATCH * D_CH * SEQ * 4;
    char* r0 = take(hb > z1 ? hb : z1); p.hbuf = (bf16_t*)r0; p.Z1 = (float*)r0;
    size_t q = al256((size_t)TT * 512 * 2), kva = al256((size_t)BATCH * 2 * LKV * 64 * 2), kvb = al256((size_t)BATCH * 8 * LKV * 64 * 2), ut = al256((size_t)BATCH * 3 * D_CH * SEQ * 2);
    size_t l0 = 2 * q + 2 * kva + 2 * kvb, l1 = q + 2 * kva + ut;
    char* R = take(l0 > l1 ? l0 : l1);
    p.QA = (bf16_t*)R; p.KA = (bf16_t*)(R + q); p.VAt = (bf16_t*)(R + q + kva); p.QB = (bf16_t*)(R + q + 2 * kva); p.KB = (bf16_t*)(R + 2 * q + 2 * kva); p.VBt = (bf16_t*)(R + 2 * q + 2 * kva + kvb);
    p.QC = (bf16_t*)R; p.KC = (bf16_t*)(R + q); p.VCt = (bf16_t*)(R + q + kva); p.UT = (bf16_t*)(R + q + 2 * kva);
    size_t yb = (size_t)TT * 1024 * 2, heb = (size_t)TT * HE_W * 2;
    char* r1 = take(yb > heb ? yb : heb); p.Y = (bf16_t*)r1; p.HE = (bf16_t*)r1;
    p.YHT = (bf16_t*)take((size_t)BATCH * D_CH * SEQ * 2);
    p.Wt_in_even = (bf16_t*)take((size_t)EVEN_IN * D_MODEL * 2);
    p.Wt_out_even = (bf16_t*)take((size_t)D_MODEL * EVEN_OUT * 2);
    p.Wt_in_odd = (bf16_t*)take((size_t)ODD_IN * D_MODEL * 2);
    p.Wt_out_odd = (bf16_t*)take((size_t)D_MODEL * ODD_OUT * 2);
    p.Wt_gu = (bf16_t*)take((size_t)DEPTH * N_EXPERTS * 2 * D_EXPERT * D_MODEL * 2);
    p.Wt_d = (bf16_t*)take((size_t)DEPTH * N_EXPERTS * D_MODEL * D_EXPERT * 2);
    return o;
}
static void fill_inputs(Params& p, void* const* d_in, void* d_out) {
    const float** f = (const float**)&p.x;
    for (int i = 0; i < 32; ++i) f[i] = (const float*)d_in[i];
    p.out = (float*)d_out;
}
#define LAS __attribute__((address_space(3)))
typedef short bf16x8 __attribute__((ext_vector_type(8)));
typedef float f32x4 __attribute__((ext_vector_type(4)));
typedef float f32x16 __attribute__((ext_vector_type(16)));
typedef unsigned u32x4 __attribute__((ext_vector_type(4)));
typedef unsigned u32x2 __attribute__((ext_vector_type(2)));

constexpr int NTHREADS = 256;
constexpr int LDS_BYTES = 69632;
constexpr int MT_ALL = TT / 128, MT_LAT = TX / 128;

__device__ __forceinline__ unsigned pk2bf(float lo, float hi) { return (unsigned)f2bf(lo) | ((unsigned)f2bf(hi) << 16); }
__device__ __forceinline__ float wave_sum(float v) {
#pragma unroll
    for (int o = 1; o < 64; o <<= 1) v += __shfl_xor(v, o);
    return v;
}

template <class DstF>
__device__ __forceinline__ void cvt_block_item(char* lds, const float* W, int N, int k0, int n0, const DstF& dst) {
    float* T = (float*)lds; const int tid = threadIdx.x;
    f32x4 v[16];
#pragma unroll
    for (int i = 0; i < 16; ++i) v[i] = *(const f32x4*)(W + (size_t)(k0 + (tid >> 6) + 4 * i) * N + n0 + 4 * (tid & 63));
#pragma unroll
    for (int i = 0; i < 16; ++i) *(f32x4*)(T + ((tid >> 6) + 4 * i) * 260 + 4 * (tid & 63)) = v[i];
    __syncthreads();
    bf16_t* d = dst(n0 + tid) + k0; const float* s = T + tid;
#pragma unroll
    for (int c = 0; c < 8; ++c) { u32x4 w; w.x = pk2bf(s[(8 * c + 0) * 260], s[(8 * c + 1) * 260]); w.y = pk2bf(s[(8 * c + 2) * 260], s[(8 * c + 3) * 260]);
        w.z = pk2bf(s[(8 * c + 4) * 260], s[(8 * c + 5) * 260]); w.w = pk2bf(s[(8 * c + 6) * 260], s[(8 * c + 7) * 260]); *(u32x4*)(d + 8 * c) = w; }
    __syncthreads();
}
__device__ __forceinline__ void cvt_plain(char* lds, const float* W, bf16_t* Wt, int K, int N, int item) {
    const int nb = N / 256, kb = item / nb, nbi = item % nb;
    cvt_block_item(lds, W, N, kb * 64, nbi * 256, [&](int n) { return Wt + (size_t)n * K; });
}
constexpr int CVT_IN = (D_MODEL / 64) * (EVEN_IN / 256), CVT_OUT = (D_MODEL / 64) * (D_MODEL / 256), CVT_GU1 = (D_MODEL / 64) * (D_EXPERT / 256), CVT_D1 = (D_EXPERT / 64) * (D_MODEL / 256);
constexpr int CVT_GU = DEPTH * N_EXPERTS * 2 * CVT_GU1, CVT_D = DEPTH * N_EXPERTS * CVT_D1;
constexpr int CVT_TOTAL = 2 * CVT_IN + 2 * CVT_OUT + CVT_GU + CVT_D;
constexpr int CVT_EARLY = 2 * CVT_IN + 2 * CVT_OUT;
static_assert(EVEN_IN % 256 == 0 && ODD_IN % 256 == 0 && D_EXPERT % 256 == 0, "conversion tile");
__device__ __forceinline__ void cvt_item(const Params& p, char* lds, int it) {
    if (it < CVT_IN) { cvt_plain(lds, p.w_in_even, p.Wt_in_even, D_MODEL, EVEN_IN, it); return; } it -= CVT_IN;
    if (it < CVT_IN) { cvt_plain(lds, p.w_in_odd, p.Wt_in_odd, D_MODEL, ODD_IN, it); return; } it -= CVT_IN;
    if (it < CVT_OUT) { cvt_plain(lds, p.w_out_even, p.Wt_out_even, EVEN_OUT, D_MODEL, it); return; } it -= CVT_OUT;
    if (it < CVT_OUT) { cvt_plain(lds, p.w_out_odd, p.Wt_out_odd, ODD_OUT, D_MODEL, it); return; } it -= CVT_OUT;
    if (it < CVT_GU) {
        const int le = it / (2 * CVT_GU1), r = it % (2 * CVT_GU1), half = r / CVT_GU1, r2 = r % CVT_GU1; const int nb = D_EXPERT / 256, kb = r2 / nb, nbi = r2 % nb;
        const float* W = (half ? p.moe_wu : p.moe_wg) + (size_t)le * D_MODEL * D_EXPERT; bf16_t* Wt = p.Wt_gu + (size_t)le * 2 * D_EXPERT * D_MODEL;
        cvt_block_item(lds, W, D_EXPERT, kb * 64, nbi * 256, [&](int n) { return Wt + (size_t)(32 * (n >> 4) + 16 * half + (n & 15)) * D_MODEL; });
        return; } it -= CVT_GU;
    { const int le = it / CVT_D1, r = it % CVT_D1; cvt_plain(lds, p.moe_wd + (size_t)le * D_EXPERT * D_MODEL, p.Wt_d + (size_t)le * D_MODEL * D_EXPERT, D_EXPERT, D_MODEL, r); }
}
__device__ __forceinline__ void cvt_range(const Params& p, char* lds, int lo, int hi, int bid, int nb) {
    for (int it = lo + bid; it < hi; it += nb) cvt_item(p, lds, it);
}

struct TileGeom { int tid, lane, wid, wr, wc, l15, q, srow, schunk;
    __device__ __forceinline__ int drow(int i) const { return wid * 32 + i * 8 + (lane >> 3); }
    __device__ __forceinline__ int dchunk(int i) const { return (lane & 7) ^ (((lane >> 4) + 4 * i) & 7); } };
__device__ __forceinline__ TileGeom tile_geom() { TileGeom g; g.tid = threadIdx.x; g.lane = g.tid & 63; g.wid = __builtin_amdgcn_readfirstlane(g.tid >> 6); g.wr = g.wid >> 1; g.wc = g.wid & 1; g.l15 = g.lane & 15; g.q = g.lane >> 4; g.srow = g.tid >> 3; g.schunk = g.tid & 7; return g; }

template <class ALoad, class BLoad>
__device__ __forceinline__ void gemm_mainloop(char* lds, const TileGeom& g, int nk, const ALoad& AL, const BLoad& BL, f32x4 (&acc)[4][4]) {
#pragma unroll
    for (int i = 0; i < 4; ++i)
#pragma unroll
        for (int j = 0; j < 4; ++j) acc[i][j] = (f32x4){0.f, 0.f, 0.f, 0.f};
    const int swz = g.l15 >> 1;
    const int aofs = (g.wr * 64 + g.l15) * 128 + ((g.q ^ swz) << 4);
    const int bofs = 32768 + (g.wc * 64 + g.l15) * 128 + ((g.q ^ swz) << 4);
    LAS char* l3 = (LAS char*)lds;
    const int dbase = g.wid * 4096;
#define GEMM_STAGE(kt_, buf_) do { _Pragma("unroll") for (int i_ = 0; i_ < 4; ++i_) { \
        __builtin_amdgcn_global_load_lds((const unsigned*)AL(i_, (kt_)), (LAS unsigned*)(l3 + (buf_) + dbase + i_ * 1024), 16, 0, 0); \
        __builtin_amdgcn_global_load_lds((const unsigned*)BL(i_, (kt_)), (LAS unsigned*)(l3 + 32768 + (buf_) + dbase + i_ * 1024), 16, 0, 0); } } while (0)
    GEMM_STAGE(0, 0);
    __syncthreads();
    for (int kt = 0; kt < nk; ++kt) {
        const int cur = (kt & 1) * 16384, nxt = 16384 - cur;
        if (kt + 1 < nk) GEMM_STAGE(kt + 1, nxt);
#pragma unroll
        for (int kk = 0; kk < 2; ++kk) {
            bf16x8 af[4], bfr[4];
#pragma unroll
            for (int i = 0; i < 4; ++i) { af[i] = *(const bf16x8*)(lds + cur + ((aofs + i * 2048) ^ (kk * 64))); bfr[i] = *(const bf16x8*)(lds + cur + ((bofs + i * 2048) ^ (kk * 64))); }
#pragma unroll
            for (int mi = 0; mi < 4; ++mi)
#pragma unroll
                for (int ni = 0; ni < 4; ++ni) acc[mi][ni] = __builtin_amdgcn_mfma_f32_16x16x32_bf16(bfr[ni], af[mi], acc[mi][ni], 0, 0, 0);
        }
        __syncthreads();
    }
#undef GEMM_STAGE
}

template <class DstF>
__device__ __forceinline__ void store_transposed(char* lds, const TileGeom& g, const f32x4 (&acc)[4][4], const DstF& dst) {
    bf16_t* T = (bf16_t*)lds;
#pragma unroll
    for (int mi = 0; mi < 4; ++mi)
#pragma unroll
        for (int ni = 0; ni < 4; ++ni)
#pragma unroll
            for (int r = 0; r < 4; ++r) T[(g.wc * 64 + ni * 16 + g.q * 4 + r) * 136 + g.wr * 64 + mi * 16 + g.l15] = f2bf(acc[mi][ni][r]);
    __syncthreads();
    { int col = g.tid >> 1, half = g.tid & 1; bf16_t* d = dst(col) + half * 64; const bf16_t* s = T + col * 136 + half * 64;
#pragma unroll
      for (int j = 0; j < 8; ++j) *(u32x4*)(d + j * 8) = *(const u32x4*)(s + j * 8); }
    __syncthreads();
}
__device__ __forceinline__ void store4bf(bf16_t* d, const f32x4& v) { u32x2 w; w.x = pk2bf(v[0], v[1]); w.y = pk2bf(v[2], v[3]); *(u32x2*)d = w; }
__device__ __forceinline__ void rope_head(const Params& p, f32x4 (&a)[4], int s, int q) {
    const int pr = s / GRID_W, pc = s % GRID_W;
    const f32x4 cr = *(const f32x4*)(p.ropet + pr * 32 + q * 4), sr = *(const f32x4*)(p.ropet + pr * 32 + 16 + q * 4);
    const f32x4 cc = *(const f32x4*)(p.ropet + pc * 32 + q * 4), sc = *(const f32x4*)(p.ropet + pc * 32 + 16 + q * 4);
    f32x4 x1 = a[0], x2 = a[1]; a[0] = x1 * cr - x2 * sr; a[1] = x2 * cr + x1 * sr;
    x1 = a[2]; x2 = a[3]; a[2] = x1 * cc - x2 * sc; a[3] = x2 * cc + x1 * sc;
}

template <int LAYER>
__device__ __forceinline__ void inproj_tile(const Params& p, char* lds, int mt, int nt) {
    const TileGeom g = tile_geom();
    const bf16_t* Abase = p.hbuf + (size_t)(mt * 128) * D_MODEL;
    const bf16_t* Bbase = (LAYER == 0 ? p.Wt_in_even : p.Wt_in_odd) + (size_t)(nt * 128) * D_MODEL;
    f32x4 acc[4][4];
    gemm_mainloop(lds, g, D_MODEL / 64, [&](int i, int kt) { return Abase + (size_t)g.drow(i) * D_MODEL + kt * 64 + g.dchunk(i) * 8; }, [&](int i, int kt) { return Bbase + (size_t)g.drow(i) * D_MODEL + kt * 64 + g.dchunk(i) * 8; }, acc);
    const bool lat = mt < MT_LAT; const int row0 = mt * 128;
    const int b = lat ? row0 / SEQ : (row0 - TX) / CTX_LEN, s0 = lat ? row0 % SEQ : (row0 - TX) % CTX_LEN, pos0 = lat ? CTX_LEN + s0 : s0;
    int kind;
    bf16_t* base; int h0 = 0, qcol0 = 0, nh = 2;
    if (LAYER == 0) {
        if (nt < 4) { kind = 0; base = p.QA; qcol0 = nt * 128; }
        else if (nt == 4) { kind = 1; base = p.KA; h0 = 0; nh = 2; }
        else if (nt == 5) { kind = 2; base = p.VAt; h0 = 0; nh = 2; }
        else if (nt < 10) { kind = 0; base = p.QB; qcol0 = (nt - 6) * 128; }
        else if (nt < 14) { kind = 1; base = p.KB; h0 = (nt - 10) * 2; nh = 8; }
        else { kind = 2; base = p.VBt; h0 = (nt - 14) * 2; nh = 8; }
    } else {
        if (nt < 4) { kind = 0; base = p.QC; qcol0 = nt * 128; }
        else if (nt == 4) { kind = 1; base = p.KC; h0 = 0; nh = 2; }
        else if (nt == 5) { kind = 2; base = p.VCt; h0 = 0; nh = 2; }
        else { kind = 3; base = p.UT; }
    }
    if (kind <= 1) {
        const bool rope = lat && (LAYER == 1 || nt <= 4);
#pragma unroll
        for (int mi = 0; mi < 4; ++mi) {
            const int rowl = g.wr * 64 + mi * 16 + g.l15;
            if (LAYER == 1) {
                float ss = 0.f;
#pragma unroll
                for (int ni = 0; ni < 4; ++ni) ss += acc[mi][ni][0] * acc[mi][ni][0] + acc[mi][ni][1] * acc[mi][ni][1] + acc[mi][ni][2] * acc[mi][ni][2] + acc[mi][ni][3] * acc[mi][ni][3];
                ss += __shfl_xor(ss, 16); ss += __shfl_xor(ss, 32);
                const float rstd = 1.0f / sqrtf(ss * (1.0f / 64.0f) + EPS);
                const float* gn = kind == 0 ? p.c_qnorm : p.c_knorm;
#pragma unroll
                for (int ni = 0; ni < 4; ++ni) acc[mi][ni] = acc[mi][ni] * rstd * *(const f32x4*)(gn + ni * 16 + g.q * 4);
            }
            if (rope) rope_head(p, acc[mi], s0 + rowl, g.q);
            bf16_t* d = kind == 0 ? base + (size_t)(row0 + rowl) * 512 + qcol0 + g.wc * 64 + g.q * 4
                                  : base + ((size_t)(b * nh + h0 + g.wc) * LKV + pos0 + rowl) * 64 + g.q * 4;
#pragma unroll
            for (int ni = 0; ni < 4; ++ni) store4bf(d + ni * 16, acc[mi][ni]);
        }
    } else if (kind == 2) {
        store_transposed(lds, g, acc, [&](int col) { return base + ((size_t)(b * nh + h0 + (col >> 6)) * 64 + (col & 63)) * LKV + pos0; });
    } else {
        store_transposed(lds, g, acc, [&](int col) { return base + ((size_t)b * 3 * D_CH + (nt - 6) * 128 + col) * SEQ + s0; });
    }
}
template <int LAYER>
__device__ __forceinline__ void ph_inproj(const Params& p, char* lds, int bid, int nb) {
    constexpr int NT = 18;
    const bool xl = (nb & 7) == 0; const int x = xl ? bid & 7 : 0, step = xl ? nb >> 3 : nb, mstep = xl ? 8 : 1;
    if (LAYER == 0) {
        for (int t = xl ? bid >> 3 : bid; ; t += step) { const int mt = (t / NT) * mstep + x, nt = t % NT; if (mt >= MT_ALL) break; inproj_tile<0>(p, lds, mt, nt); }
    } else {
        const int nlat_t = (MT_LAT / mstep) * NT;
        for (int t = xl ? bid >> 3 : bid; ; t += step) {
            int mt, nt;
            if (t < nlat_t) { mt = (t / NT) * mstep + x; nt = t % NT; }
            else { const int u = t - nlat_t; mt = MT_LAT + (u / 2) * mstep + x; nt = 4 + u % 2; if (mt >= MT_ALL) break; }
            inproj_tile<1>(p, lds, mt, nt);
        }
    }
}

template <int LAYER>
__device__ __forceinline__ void outproj_tile(const Params& p, char* lds, int mt, int nt) {
    const TileGeom g = tile_geom();
    const bf16_t* Abase = p.Y + (size_t)(mt * 128) * 1024;
    const bf16_t* Bbase = (LAYER == 0 ? p.Wt_out_even : p.Wt_out_odd) + (size_t)(nt * 128) * 1024;
    f32x4 acc[4][4];
    gemm_mainloop(lds, g, 16, [&](int i, int kt) { return Abase + (size_t)g.drow(i) * 1024 + kt * 64 + g.dchunk(i) * 8; }, [&](int i, int kt) { return Bbase + (size_t)g.drow(i) * 1024 + kt * 64 + g.dchunk(i) * 8; }, acc);
    const int row0 = mt * 128;
#pragma unroll
    for (int mi = 0; mi < 4; ++mi) {
        const int row = row0 + g.wr * 64 + mi * 16 + g.l15;
        const float* xin = xrow_in(p, LAYER, row); float* xo = xrow_cur(p, row); const float* gate = modp(p, LAYER, row, 2);
#pragma unroll
        for (int ni = 0; ni < 4; ++ni) { const int col = nt * 128 + g.wc * 64 + ni * 16 + g.q * 4;
            *(f32x4*)(xo + col) = *(const f32x4*)(xin + col) + *(const f32x4*)(gate + col) * acc[mi][ni]; }
    }
}

template <int LAYER>
__device__ __forceinline__ void ph_outproj(const Params& p, char* lds, int bid, int nb) {
    const int nmt = LAYER == 0 ? MT_ALL : MT_LAT;
    const bool xl = (nb & 7) == 0; const int x = xl ? bid & 7 : 0, step = xl ? nb >> 3 : nb, mstep = xl ? 8 : 1;
    for (int t = xl ? bid >> 3 : bid; ; t += step) { const int mt = (t / 8) * mstep + x, nt = t % 8; if (mt >= nmt) break; outproj_tile<LAYER>(p, lds, mt, nt); }
}

template <int NTN>
__device__ __forceinline__ bool moe_tile_lookup(const int* cnt, int t, int& pr, int& mt, int& nt, int& n) {
    int acc = 0;
    for (int q = 0; q < NPAIR; ++q) { const int c = __builtin_amdgcn_readfirstlane(cnt[q]); const int tiles = ((c + 127) >> 7) * NTN; if (t < acc + tiles) { pr = q; const int u = t - acc; mt = u / NTN; nt = u % NTN; n = c; return true; } acc += tiles; }
    return false;
}
template <int NTN>
__device__ __forceinline__ bool moe_tile_lookup_xcd(const int* cnt, int xcd, int t, int& pr, int& mt, int& nt, int& n) {
    int acc = 0;
#pragma unroll
    for (int i = 0; i < NPAIR / 8; ++i) { const int q = xcd + 8 * i; const int c = __builtin_amdgcn_readfirstlane(cnt[q]); const int tiles = ((c + 127) >> 7) * NTN;
        if (t < acc + tiles) { pr = q; const int u = t - acc; mt = u / NTN; nt = u % NTN; n = c; return true; } acc += tiles; }
    return false;
}
__device__ __forceinline__ void moe_up_tile(const Params& p, char* lds, int l, int pr, int mt, int nt, int n) {
    const TileGeom g = tile_geom();
    int e1, e2; pair_experts(pr, e1, e2); const int k = nt >> 3, e = k ? e2 : e1;
    const int* lst = p.list + (size_t)pr * TT + mt * 128;
    const int navail = n - mt * 128;
    const bf16_t* arow[4];
#pragma unroll
    for (int i = 0; i < 4; ++i) { int r = g.drow(i); if (r >= navail) r = navail - 1; arow[i] = p.hbuf + (size_t)lst[r] * D_MODEL + g.dchunk(i) * 8; }
    const bf16_t* Bbase = p.Wt_gu + ((size_t)(l * N_EXPERTS + e) * 2 * D_EXPERT + (nt & 7) * 128) * D_MODEL;
    f32x4 acc[4][4];
    gemm_mainloop(lds, g, D_MODEL / 64, [&](int i, int kt) { return arow[i] + kt * 64; }, [&](int i, int kt) { return Bbase + (size_t)g.drow(i) * D_MODEL + kt * 64 + g.dchunk(i) * 8; }, acc);
#pragma unroll
    for (int mi = 0; mi < 4; ++mi) {
        const int rl = g.wr * 64 + mi * 16 + g.l15;
        if (rl < navail) {
            const int row = lst[rl]; const float w = p.tokw[row * 2 + k];
            bf16_t* d = p.HE + (size_t)row * HE_W + k * D_EXPERT + (nt & 7) * 64 + g.wc * 32 + g.q * 4;
#pragma unroll
            for (int h2 = 0; h2 < 2; ++h2) { f32x4 gg = acc[mi][2 * h2], uu = acc[mi][2 * h2 + 1], o;
#pragma unroll
                for (int r = 0; r < 4; ++r) o[r] = w * (gg[r] / (1.0f + __expf(-gg[r]))) * uu[r];
                store4bf(d + h2 * 16, o); }
        }
    }
}
template <bool DUMMY = false>
__device__ __forceinline__ void moe_down_tile(const Params& p, char* lds, int l, int pr, int mt, int nt, int n) {
    const TileGeom g = tile_geom();
    int e1, e2; pair_experts(pr, e1, e2);
    const int* lst = p.list + (size_t)pr * TT + mt * 128;
    const int navail = n - mt * 128;
    const bf16_t* arow[4];
#pragma unroll
    for (int i = 0; i < 4; ++i) { int r = g.drow(i); if (r >= navail) r = navail - 1; arow[i] = p.HE + (size_t)lst[r] * HE_W + g.dchunk(i) * 8; }
    const bf16_t* B1 = p.Wt_d + ((size_t)(l * N_EXPERTS + e1) * D_MODEL + nt * 128) * D_EXPERT;
    const bf16_t* B2 = p.Wt_d + ((size_t)(l * N_EXPERTS + e2) * D_MODEL + nt * 128) * D_EXPERT;
    constexpr int KT1 = D_EXPERT / 64;
    f32x4 acc[4][4];
    gemm_mainloop(lds, g, HE_W / 64, [&](int i, int kt) { return arow[i] + kt * 64; },
                  [&](int i, int kt) { return (kt < KT1 ? B1 + kt * 64 : B2 + (kt - KT1) * 64) + (size_t)g.drow(i) * D_EXPERT + g.dchunk(i) * 8; }, acc);
#pragma unroll
    for (int mi = 0; mi < 4; ++mi) {
        const int rl = g.wr * 64 + mi * 16 + g.l15;
        if (rl < navail) {
            const int row = lst[rl]; float* xo = xrow_cur(p, row); const float* gate = modp(p, l, row, 5);
#pragma unroll
            for (int ni = 0; ni < 4; ++ni) { const int col = nt * 128 + g.wc * 64 + ni * 16 + g.q * 4; float* dst = DUMMY ? (float*)p.QA + (size_t)row * D_MODEL : xo; *(f32x4*)(dst + col) = *(const f32x4*)(xo + col) + *(const f32x4*)(gate + col) * acc[mi][ni]; }
        }
    }
}
__device__ __forceinline__ void ph_moe_up(const Params& p, char* lds, int l, int bid, int nb) {
    int pr, mt, nt, n; const bool xl = (nb & 7) == 0;
    for (int t = xl ? bid >> 3 : bid; xl ? moe_tile_lookup_xcd<16>(p.cnt + l * 32, bid & 7, t, pr, mt, nt, n) : moe_tile_lookup<16>(p.cnt + l * 32, t, pr, mt, nt, n); t += xl ? nb >> 3 : nb) moe_up_tile(p, lds, l, pr, mt, nt, n);
}
template <bool DUMMY = false>
__device__ __forceinline__ void ph_moe_down(const Params& p, char* lds, int l, int bid, int nb) {
    int pr, mt, nt, n; const bool xl = (nb & 7) == 0;
    for (int t = xl ? bid >> 3 : bid; xl ? moe_tile_lookup_xcd<8>(p.cnt + l * 32, bid & 7, t, pr, mt, nt, n) : moe_tile_lookup<8>(p.cnt + l * 32, t, pr, mt, nt, n); t += xl ? nb >> 3 : nb) moe_down_tile<DUMMY>(p, lds, l, pr, mt, nt, n);
}
typedef float f32x2 __attribute__((ext_vector_type(2)));
typedef __bf16 bf16x2_t __attribute__((ext_vector_type(2)));
__device__ __forceinline__ unsigned cvtpk(float lo, float hi) { f32x2 v = {lo, hi}; bf16x2_t b = __builtin_convertvector(v, bf16x2_t); return __builtin_bit_cast(unsigned, b); }
__device__ __forceinline__ int crow(int r, int hi) { return (r & 3) + 8 * (r >> 2) + 4 * hi; }
constexpr float LOG2E = 1.4426950408889634f;
constexpr float QK_C = ATTN_SCALE * LOG2E;
constexpr float NEG_BIG = -1e30f;

__device__ __forceinline__ float max3f(float a, float b, float c) { float r; asm("v_max3_f32 %0, %1, %2, %3" : "=v"(r) : "v"(a), "v"(b), "v"(c)); return r; }
constexpr float ATT_THR = 8.0f;
template <int MODE>
__device__ __forceinline__ void attn_unit(char* lds, const bf16_t* Qp, const bf16_t* Kp, const bf16_t* Vt, bf16_t* Op, int s0, int nctx, int lt0, int nlat, float sink2, bool has_sink, const float* rpb_h) {
    int tid_ = threadIdx.x; asm volatile("" : "+v"(tid_));
    const int tid = tid_, lane = tid & 63, wid = __builtin_amdgcn_readfirstlane(tid >> 6), l31 = lane & 31, hi = lane >> 5;
    float* bias_s = (float*)(lds + 65536);
    if (MODE == 2) { for (int i = tid; i < 15 * 31; i += NTHREADS) bias_s[i] = rpb_h[i] * LOG2E; }
    const int ntiles = nctx + nlat;
    LAS char* l3 = (LAS char*)lds;
    const int drow0 = wid * 16 + (lane >> 3);
    const int dch0 = (lane & 7) ^ (((lane >> 4) + 0) & 7), dch1 = (lane & 7) ^ (((lane >> 4) + 4) & 7);
    const bf16_t* ksrc0 = Kp + (size_t)drow0 * 64 + dch0 * 8; const bf16_t* ksrc1 = Kp + (size_t)(drow0 + 8) * 64 + dch1 * 8;
    const bf16_t* vsrc0 = Vt + (size_t)drow0 * LKV + dch0 * 8; const bf16_t* vsrc1 = Vt + (size_t)(drow0 + 8) * LKV + dch1 * 8;
    const int ddst = wid * 2048;
    auto tile_pos = [&](int j) { return j < nctx ? 64 * j : CTX_LEN + 64 * (lt0 + j - nctx); };
#define ATT_DMA(j_, slot_) do { const int pos_ = tile_pos(j_); \
        __builtin_amdgcn_global_load_lds((const unsigned*)(ksrc0 + (size_t)pos_ * 64), (LAS unsigned*)(l3 + (slot_) * 8192 + ddst), 16, 0, 0); \
        __builtin_amdgcn_global_load_lds((const unsigned*)(ksrc1 + (size_t)pos_ * 64), (LAS unsigned*)(l3 + (slot_) * 8192 + ddst + 1024), 16, 0, 0); \
        __builtin_amdgcn_global_load_lds((const unsigned*)(vsrc0 + pos_), (LAS unsigned*)(l3 + 32768 + (slot_) * 8192 + ddst), 16, 0, 0); \
        __builtin_amdgcn_global_load_lds((const unsigned*)(vsrc1 + pos_), (LAS unsigned*)(l3 + 32768 + (slot_) * 8192 + ddst + 1024), 16, 0, 0); } while (0)
    const int x = (l31 >> 1) & 7;
    const int kofs = l31 * 128 + ((hi ^ x) << 4);
    const int vofs = 32768 + l31 * 128 + (x << 4) + 8 * hi;
    bf16x8 qf[4];
    { const bf16_t* qr = Qp + (size_t)(wid * 32 + l31) * 512 + hi * 8;
#pragma unroll
      for (int s = 0; s < 4; ++s) { const u32x4 raw = *(const u32x4*)(qr + s * 16); u32x4 sc;
#pragma unroll
          for (int e = 0; e < 4; ++e) { const float lo = __builtin_bit_cast(float, raw[e] << 16) * QK_C, hi2 = __builtin_bit_cast(float, raw[e] & 0xffff0000u) * QK_C; sc[e] = cvtpk(lo, hi2); }
          qf[s] = __builtin_bit_cast(bf16x8, sc); } }
#define ATT_WAIT(need_, last_) do { const int lastt_ = (last_) < ntiles - 1 ? (last_) : ntiles - 1; const int ahead_ = lastt_ - (need_); \
        if (ahead_ >= 2) asm volatile("s_waitcnt vmcnt(8) lgkmcnt(0)" ::: "memory"); else if (ahead_ == 1) asm volatile("s_waitcnt vmcnt(4) lgkmcnt(0)" ::: "memory"); \
        else asm volatile("s_waitcnt vmcnt(0) lgkmcnt(0)" ::: "memory"); } while (0)
    ATT_DMA(0, 0);
    if (ntiles > 1) ATT_DMA(1, 1);
    if (ntiles > 2) ATT_DMA(2, 2);
    f32x16 o0 = {}, o1 = {};
    f32x16 negm = {};
    float mref = 0.f, l = 0.f;
    const int sq = s0 + wid * 32 + l31;
    int rq = 0, cq = 0, rsq = 0, csq = 0;
    if (MODE == 2) { rq = sq / GRID_W; cq = sq % GRID_W; rsq = rq - B_WIN_H / 2; rsq = rsq < 0 ? 0 : (rsq > GRID_H - B_WIN_H ? GRID_H - B_WIN_H : rsq); csq = cq - B_WIN_W / 2; csq = csq < 0 ? 0 : (csq > GRID_W - B_WIN_W ? GRID_W - B_WIN_W : csq); }
    ATT_WAIT(0, 2);
    __builtin_amdgcn_s_barrier(); asm volatile("" ::: "memory");
    int slot = 0;
    for (int j = 0; j < ntiles; ++j) {
        const int slot1 = (slot + 1) & 3, slot3 = (slot + 3) & 3;
        if (j + 3 < ntiles) ATT_DMA(j + 3, slot3);
        const char* Kb = lds + slot * 8192; const char* Vb = lds + slot * 8192;
        f32x16 p0, p1;
#pragma unroll
        for (int s = 0; s < 4; ++s) {
            const bf16x8 k0 = *(const bf16x8*)(Kb + (kofs ^ (s << 5))); const bf16x8 k1 = *(const bf16x8*)(Kb + 4096 + (kofs ^ (s << 5)));
            if (s == 0) { p0 = __builtin_amdgcn_mfma_f32_32x32x16_bf16(k0, qf[0], negm, 0, 0, 0); p1 = __builtin_amdgcn_mfma_f32_32x32x16_bf16(k1, qf[0], negm, 0, 0, 0); }
            else { p0 = __builtin_amdgcn_mfma_f32_32x32x16_bf16(k0, qf[s], p0, 0, 0, 0); p1 = __builtin_amdgcn_mfma_f32_32x32x16_bf16(k1, qf[s], p1, 0, 0, 0); }
        }
        asm volatile("s_nop 15\n\ts_nop 7" : "+v"(p0), "+v"(p1));
        if (MODE == 1 && j >= nctx) {
            const int sk0 = 64 * (lt0 + j - nctx);
#pragma unroll
            for (int r = 0; r < 16; ++r) { const int d0 = sk0 + crow(r, hi) - sq, d1 = d0 + 32;
                p0[r] = (d0 >= -A_WINDOW && d0 <= A_WINDOW) ? p0[r] : NEG_BIG; p1[r] = (d1 >= -A_WINDOW && d1 <= A_WINDOW) ? p1[r] : NEG_BIG; }
        } else if (MODE == 2 && j >= nctx) {
            const int kr = lt0 + j - nctx; const bool rowok = kr >= rsq && kr < rsq + B_WIN_H;
            const float* brow = bias_s + (kr - rq + B_WIN_H - 1) * 31 + (B_WIN_W - 1) - cq;
#pragma unroll
            for (int r = 0; r < 16; ++r) { const int kc0 = crow(r, hi), kc1 = kc0 + 32;
                const bool ok0 = rowok && kc0 >= csq && kc0 < csq + B_WIN_W, ok1 = rowok && kc1 >= csq && kc1 < csq + B_WIN_W;
                p0[r] = ok0 ? p0[r] + brow[kc0] : NEG_BIG; p1[r] = ok1 ? p1[r] + brow[kc1] : NEG_BIG; }
        }
        float ta = max3f(p0[0], p0[1], p1[0]), tb = max3f(p0[2], p0[3], p1[1]); ta = max3f(ta, p1[2], p1[3]);
#pragma unroll
        for (int r = 4; r < 16; r += 4) { ta = max3f(ta, p0[r], p0[r + 1]); tb = max3f(tb, p0[r + 2], p0[r + 3]); ta = max3f(ta, p1[r], p1[r + 1]); tb = max3f(tb, p1[r + 2], p1[r + 3]); }
        float tmax = fmaxf(ta, tb); tmax = fmaxf(tmax, __shfl_xor(tmax, 32));
        if (j == 0 || __any(tmax > ATT_THR)) {
            const float dl = j == 0 ? tmax : fmaxf(tmax, 0.f);
            mref += dl;
#pragma unroll
            for (int r = 0; r < 16; ++r) { p0[r] -= dl; p1[r] -= dl; negm[r] = -mref; }
            if (j > 0) { const float f = __builtin_amdgcn_exp2f(-dl); l *= f;
#pragma unroll
                for (int r = 0; r < 16; ++r) { o0[r] *= f; o1[r] *= f; } }
        }
        f32x2 lsum = {0.f, 0.f};
#pragma unroll
        for (int r = 0; r < 16; r += 2) { p0[r] = __builtin_amdgcn_exp2f(p0[r]); p0[r + 1] = __builtin_amdgcn_exp2f(p0[r + 1]); p1[r] = __builtin_amdgcn_exp2f(p1[r]); p1[r + 1] = __builtin_amdgcn_exp2f(p1[r + 1]);
            lsum += (f32x2){p0[r], p0[r + 1]}; lsum += (f32x2){p1[r], p1[r + 1]}; }
        l += lsum.x + lsum.y;
        bf16x8 pf[4];
        { u32x4 w;
          w.x = cvtpk(p0[0], p0[1]); w.y = cvtpk(p0[2], p0[3]); w.z = cvtpk(p0[4], p0[5]); w.w = cvtpk(p0[6], p0[7]); pf[0] = __builtin_bit_cast(bf16x8, w);
          w.x = cvtpk(p0[8], p0[9]); w.y = cvtpk(p0[10], p0[11]); w.z = cvtpk(p0[12], p0[13]); w.w = cvtpk(p0[14], p0[15]); pf[1] = __builtin_bit_cast(bf16x8, w);
          w.x = cvtpk(p1[0], p1[1]); w.y = cvtpk(p1[2], p1[3]); w.z = cvtpk(p1[4], p1[5]); w.w = cvtpk(p1[6], p1[7]); pf[2] = __builtin_bit_cast(bf16x8, w);
          w.x = cvtpk(p1[8], p1[9]); w.y = cvtpk(p1[10], p1[11]); w.z = cvtpk(p1[12], p1[13]); w.w = cvtpk(p1[14], p1[15]); pf[3] = __builtin_bit_cast(bf16x8, w); }
#pragma unroll
        for (int s = 0; s < 4; ++s) {
            const int a0 = vofs ^ (s << 5);
            u32x2 va = *(const u32x2*)(Vb + a0), vb = *(const u32x2*)(Vb + (a0 ^ 16));
            u32x2 vc = *(const u32x2*)(Vb + 4096 + a0), vd = *(const u32x2*)(Vb + 4096 + (a0 ^ 16));
            const bf16x8 f0 = __builtin_bit_cast(bf16x8, (u32x4){va.x, va.y, vb.x, vb.y}), f1 = __builtin_bit_cast(bf16x8, (u32x4){vc.x, vc.y, vd.x, vd.y});
            o0 = __builtin_amdgcn_mfma_f32_32x32x16_bf16(f0, pf[s], o0, 0, 0, 0); o1 = __builtin_amdgcn_mfma_f32_32x32x16_bf16(f1, pf[s], o1, 0, 0, 0);
        }
        ATT_WAIT(j + 1, j + 3);
        __builtin_amdgcn_s_barrier(); asm volatile("" ::: "memory");
        slot = slot1;
    }
#undef ATT_DMA
#undef ATT_WAIT
    l += __shfl_xor(l, 32);
    if (has_sink) l += __builtin_amdgcn_exp2f(sink2 - mref);
    const float inv = 1.0f / l;
    bf16_t* orow = Op + (size_t)(wid * 32 + l31) * 1024;
#pragma unroll
    for (int g4 = 0; g4 < 4; ++g4) {
        u32x2 w; w.x = cvtpk(o0[g4 * 4 + 0] * inv, o0[g4 * 4 + 1] * inv); w.y = cvtpk(o0[g4 * 4 + 2] * inv, o0[g4 * 4 + 3] * inv); *(u32x2*)(orow + 8 * g4 + 4 * hi) = w;
        w.x = cvtpk(o1[g4 * 4 + 0] * inv, o1[g4 * 4 + 1] * inv); w.y = cvtpk(o1[g4 * 4 + 2] * inv, o1[g4 * 4 + 3] * inv); *(u32x2*)(orow + 32 + 8 * g4 + 4 * hi) = w;
    }
    asm volatile("s_waitcnt vmcnt(0)" ::: "memory");
}

constexpr int NU_LAT = BATCH * 8 * (SEQ / 128);
constexpr int NU_CTX = BATCH * 8 * (CTX_LEN / 128);
static_assert(BATCH * 2 == 8, "the XCD-local unit order maps the 8 (batch, kv head) K/V streams onto the 8 XCD groups");
__device__ __forceinline__ void ph_attn0(const Params& p, char* lds, int bid, int nb) {
    const bool xl = (nb & 7) == 0; const int x = bid & 7, lb = bid >> 3, lstep = nb >> 3;
    constexpr int NQB = SEQ / 128;
    for (int v = xl ? lb : bid; v < (xl ? BATCH * NQB : NU_LAT); v += xl ? lstep : nb) {
        int blk, h, b; if (xl) { blk = v % NQB; b = v / NQB; h = x; } else { blk = v % NQB; h = (v / NQB) % 8; b = v / (8 * NQB); }
        const int s0 = blk * 128, r0 = s0 / GRID_W;
        int rs0 = r0 - 4; rs0 = rs0 < 0 ? 0 : (rs0 > GRID_H - 8 ? GRID_H - 8 : rs0); int rs1 = r0 + 1 - 4; rs1 = rs1 < 0 ? 0 : (rs1 > GRID_H - 8 ? GRID_H - 8 : rs1);
        attn_unit<2>(lds, p.QB + (size_t)(b * SEQ + s0) * 512 + h * 64, p.KB + (size_t)(b * 8 + h) * LKV * 64, p.VBt + (size_t)(b * 8 + h) * 64 * LKV,
                     p.Y + (size_t)(b * SEQ + s0) * 1024 + 512 + h * 64, s0, CTX_LEN / 64, rs0, rs1 + 8 - rs0, 0.f, false, p.b_rpb + h * 15 * 31);
    }
    for (int v = xl ? lb : bid; v < (xl ? 4 * NQB : NU_LAT); v += xl ? lstep : nb) {
        int blk, h, b; if (xl) { blk = v % NQB; b = x >> 1; h = (x & 1) * 4 + v / NQB; } else { blk = v % NQB; h = (v / NQB) % 8; b = v / (8 * NQB); }
        const int s0 = blk * 128;
        int t0 = (s0 - 128) / 64; if (t0 < 0) t0 = 0; int t1 = (s0 + 255) / 64; if (t1 > SEQ / 64 - 1) t1 = SEQ / 64 - 1;
        attn_unit<1>(lds, p.QA + (size_t)(b * SEQ + s0) * 512 + h * 64, p.KA + (size_t)(b * 2 + h / 4) * LKV * 64, p.VAt + (size_t)(b * 2 + h / 4) * 64 * LKV,
                     p.Y + (size_t)(b * SEQ + s0) * 1024 + h * 64, s0, CTX_LEN / 64, t0, t1 - t0 + 1, p.a_sink[h] * LOG2E, true, nullptr);
    }
    for (int u = bid; u < 2 * NU_CTX; u += nb) {
        const int ty = u / NU_CTX, w = u % NU_CTX; const int blk = w % (CTX_LEN / 128), h = (w / (CTX_LEN / 128)) % 8, b = w / (8 * (CTX_LEN / 128));
        const int row0 = TX + b * CTX_LEN + blk * 128;
        const bf16_t* Qp = (ty == 0 ? p.QA : p.QB) + (size_t)row0 * 512 + h * 64;
        const bf16_t* Kp = ty == 0 ? p.KA + (size_t)(b * 2 + h / 4) * LKV * 64 : p.KB + (size_t)(b * 8 + h) * LKV * 64;
        const bf16_t* Vp = ty == 0 ? p.VAt + (size_t)(b * 2 + h / 4) * 64 * LKV : p.VBt + (size_t)(b * 8 + h) * 64 * LKV;
        attn_unit<0>(lds, Qp, Kp, Vp, p.Y + (size_t)row0 * 1024 + ty * 512 + h * 64, 0, CTX_LEN / 64, 0, 0, ty == 0 ? p.a_sink[h] * LOG2E : 0.f, ty == 0, nullptr);
    }
}
__device__ __forceinline__ void ph_attnC(const Params& p, char* lds, int bid, int nb) {
    const bool xl = (nb & 7) == 0; const int x = bid & 7, lb = bid >> 3, lstep = nb >> 3;
    constexpr int NQB = SEQ / 128;
    for (int v = xl ? lb : bid; v < (xl ? 4 * NQB : NU_LAT); v += xl ? lstep : nb) {
        int blk, h, b; if (xl) { blk = v % NQB; b = x >> 1; h = (x & 1) * 4 + v / NQB; } else { blk = v % NQB; h = (v / NQB) % 8; b = v / (8 * NQB); }
        const int s0 = blk * 128;
        attn_unit<0>(lds, p.QC + (size_t)(b * SEQ + s0) * 512 + h * 64, p.KC + (size_t)(b * 2 + h / 4) * LKV * 64, p.VCt + (size_t)(b * 2 + h / 4) * 64 * LKV,
                     p.Y + (size_t)(b * SEQ + s0) * 1024 + h * 64, s0, CTX_LEN / 64, 0, SEQ / 64, 0.f, false, nullptr);
    }
}
#ifdef HY_TEST
#define HY_OUT(b, t, v) p.YHT[((size_t)(b) * D_CH + c) * SEQ + (t)] = f2bf(v)
#else
#define HY_OUT(b, t, v) p.YHT[((size_t)(b) * D_CH + c) * SEQ + (t)] = f2bf(v)
#endif
#ifdef CPU_TEST
#define FOR_T for (int tid = 0; tid < 256; ++tid)
#define HSYNC
#define HST(t) st[t]
#define HY_DECL HySt* st = new HySt[256]
#define HY_FREE delete[] st
static inline void sincos_rev(float a, float& c, float& s) { c = cosf(6.283185307179586f * a); s = sinf(6.283185307179586f * a); }
#else
__device__ __forceinline__ int hy_launder(int v) { asm volatile("" : "+v"(v)); return v; }
#define FOR_T if (const int tid = hy_launder((int)threadIdx.x); true)
#define HSYNC __syncthreads()
#define HST(t) st
#define HY_DECL HySt st
#define HY_FREE
__device__ __forceinline__ void sincos_rev(float a, float& c, float& s) { c = __builtin_amdgcn_cosf(a); s = __builtin_amdgcn_sinf(a); }
#endif
constexpr int FN = 2 * SEQ;
constexpr int FPAD = FN + (FN >> 5);
#if !defined(SMALL_CFG)
static_assert(FN == 8192, "pass plan 8,8,8,16 is for N = 8192");
constexpr int R4 = 16;
constexpr int NS4 = 512;
#else
constexpr int R4 = 2;
constexpr int NS4 = 512;
#endif
constexpr int NB8 = FN / 8 / 256;
constexpr int NB4 = FN / R4 / 256;
constexpr int EPT = FN / 256;
struct HySt { float xr[EPT], xi[EPT]; unsigned kp[EPT]; };
HD unsigned hy_pack(float r, float i) { return (unsigned)f2bf(r) | ((unsigned)f2bf(i) << 16); }
HD float hy_lo(unsigned v) { unsigned u = v << 16; float f; __builtin_memcpy(&f, &u, 4); return f; }
HD float hy_hi(unsigned v) { unsigned u = v & 0xffff0000u; float f; __builtin_memcpy(&f, &u, 4); return f; }
HD int pidx(int i) { return i + (i >> 5); }

constexpr float W16C[8] = {1.0f, 0.9238795325112867f, 0.7071067811865476f, 0.3826834323650898f, 0.0f, -0.3826834323650898f, -0.7071067811865476f, -0.9238795325112867f};
constexpr float W16S[8] = {0.0f, -0.3826834323650898f, -0.7071067811865476f, -0.9238795325112867f, -1.0f, -0.9238795325112867f, -0.7071067811865476f, -0.3826834323650898f};
template <int R> HD void fft_reg(float* xr, float* xi) {
    constexpr int LG = R == 16 ? 4 : (R == 8 ? 3 : (R == 4 ? 2 : 1));
#pragma unroll
    for (int sg = 0; sg < LG; ++sg) {
        const int h = (R / 2) >> sg;
#pragma unroll
        for (int pr = 0; pr < R / 2; ++pr) {
            const int blk = (pr / h) * 2 * h, i = pr % h;
            const int a = blk + i, b = blk + i + h;
            const float ar = xr[a], ai = xi[a], br = xr[b], bi = xi[b];
            xr[a] = ar + br; xi[a] = ai + bi;
            const float tr = ar - br, ti = ai - bi;
            const int tw = i * (8 / h);
            if (tw == 0) { xr[b] = tr; xi[b] = ti; }
            else if (tw == 4) { xr[b] = ti; xi[b] = -tr; }
            else { const float c = W16C[tw & 7], s = W16S[tw & 7]; xr[b] = tr * c - ti * s; xi[b] = tr * s + ti * c; }
        }
    }
}
template <int R> HD constexpr int bitrev(int i) { int r = 0; for (int b = 1; b < R; b <<= 1) { r = (r << 1) | (i & 1); i >>= 1; } return r; }

template <int R, int NB, class In> HD void pass_load(int tid, HySt& s, const In& in) {
#pragma unroll
    for (int b = 0; b < NB; ++b)
#pragma unroll
        for (int r = 0; r < R; ++r) in(tid + 256 * b + (FN / R) * r, r, s.xr[b * R + r], s.xi[b * R + r]);
}
template <int R, int NB, class Out> HD void pass_compute(int tid, HySt& s, int Ns, const Out& out) {
#pragma unroll
    for (int b = 0; b < NB; ++b) {
        const int j = tid + 256 * b, k = j & (Ns - 1);
        float* xr = s.xr + b * R; float* xi = s.xi + b * R;
        if (Ns > 1) {
            float wc, ws; sincos_rev(-(float)k / (float)(Ns * R), wc, ws);
            float cr = wc, ci = ws;
#pragma unroll
            for (int r = 1; r < R; ++r) {
                const float vr = xr[r], vi = xi[r]; xr[r] = vr * cr - vi * ci; xi[r] = vr * ci + vi * cr;
                const float nr = cr * wc - ci * ws, ni = cr * ws + ci * wc; cr = nr; ci = ni;
            }
        }
        fft_reg<R>(xr, xi);
        const int j0 = (j - k) * R + k;
#pragma unroll
        for (int i = 0; i < R; ++i) out(j0 + bitrev<R>(i) * Ns, b, bitrev<R>(i), xr[i], xi[i]);
    }
}
struct LdsIn { const float* re; const float* im; HD void operator()(int idx, int, float& r, float& i) const { r = re[pidx(idx)]; i = im[pidx(idx)]; } };
struct LdsOut { float* re; float* im; HD void operator()(int idx, int, int, float r, float i) const { re[pidx(idx)] = r; im[pidx(idx)] = i; } };

HD void hy_pre_load(const Params& p, int c, int b, int tid, float* lds) {
#pragma unroll
    for (int q = 0; q < 3; ++q) {
        const bf16_t* u = p.UT + ((size_t)b * 3 * D_CH + q * D_CH + c) * SEQ; const int t0 = tid * 16;
        const float w0 = p.hy_short_w[0 * 3 * D_CH + q * D_CH + c], w1 = p.hy_short_w[1 * 3 * D_CH + q * D_CH + c], w2 = p.hy_short_w[2 * 3 * D_CH + q * D_CH + c], sb = p.hy_short_b[q * D_CH + c];
        unsigned w[8];
        { const unsigned* u32p = (const unsigned*)(u + t0);
#pragma unroll
          for (int i = 0; i < 8; ++i) w[i] = u32p[i]; }
        float x[18];
        x[0] = t0 > 0 ? bf2f(u[t0 - 1]) : 0.f; x[17] = t0 + 16 < SEQ ? bf2f(u[t0 + 16]) : 0.f;
#pragma unroll
        for (int i = 0; i < 8; ++i) { x[1 + 2 * i] = bf2f((bf16_t)(w[i] & 0xffffu)); x[2 + 2 * i] = bf2f((bf16_t)(w[i] >> 16)); }
#pragma unroll
        for (int i = 0; i < 16; ++i) lds[q * SEQ + t0 + i] = sb + w0 * x[i] + w1 * x[i + 1] + w2 * x[i + 2];
    }
}
HD void hy_pre_store(const Params& p, int c, int b, int tid, const float* lds) {
#pragma unroll
    for (int q = 0; q < 3; ++q) {
        unsigned* u = (unsigned*)(p.UT + ((size_t)b * 3 * D_CH + q * D_CH + c) * SEQ + tid * 16);
#pragma unroll
        for (int i = 0; i < 8; ++i) u[i] = (unsigned)f2bf(lds[q * SEQ + tid + 256 * (2 * i)]) | ((unsigned)f2bf(lds[q * SEQ + tid + 256 * (2 * i + 1)]) << 16);
    }
}
HD void tm_load_bf16(const bf16_t* row, int tid, unsigned (&w)[8]) { const unsigned* q = (const unsigned*)(row + tid * 16);
#pragma unroll
    for (int i = 0; i < 8; ++i) w[i] = q[i]; }
HD float tm_get(const unsigned (&w)[8], int m) { return bf2f((bf16_t)((m & 1) ? (w[m >> 1] >> 16) : (w[m >> 1] & 0xffffu))); }
HD int tm_ofs(int idx) { return (idx & 255) * 16 + (idx >> 8); }

HD void hyena_channel(const Params& p, int c, float* lds) {
    HY_DECL;
    float* re = lds; float* im = lds + FPAD;
    const LdsIn lin{re, im}; const LdsOut lout{re, im};
    for (int b = 0; b < BATCH; ++b) { FOR_T { hy_pre_load(p, c, b, tid, lds); } HSYNC; FOR_T { hy_pre_store(p, c, b, tid, lds); } HSYNC; }
    float nrm[2];
#pragma unroll
    for (int o = 0; o < 2; ++o) {
        const float* hf = p.HFT + (size_t)((0 * 2 + o) * D_CH + c) * SEQ; const float* hb = p.HFT + (size_t)((1 * 2 + o) * D_CH + c) * SEQ;
        FOR_T { float sacc = 0.f; for (int i = 0; i < SEQ / 256; ++i) sacc += fabsf(hf[tid + 256 * i]) + fabsf(hb[tid + 256 * i]); re[tid] = sacc; }
        HSYNC;
        { float tot = 0.f; for (int i = 0; i < 256; ++i) tot += re[i]; nrm[o] = tot + EPS; }
        HSYNC;
    }
    float sw[3][3], sbv[3];
#pragma unroll
    for (int q = 0; q < 3; ++q) { sbv[q] = p.hy_short_b[q * D_CH + c];
#pragma unroll
        for (int kk = 0; kk < 3; ++kk) sw[q][kk] = p.hy_short_w[kk * 3 * D_CH + q * D_CH + c]; }
#pragma unroll 1
    for (int o = 0; o < 2; ++o) {
        const float* hf = p.HFT + (size_t)((0 * 2 + o) * D_CH + c) * SEQ; const float* hb = p.HFT + (size_t)((1 * 2 + o) * D_CH + c) * SEQ;
        const float inv = 1.0f / (o == 0 ? nrm[0] : nrm[1]); const float hbias = p.hy_bias[o * D_CH + c];
        float swg[3]; swg[0] = o == 0 ? sw[1][0] : sw[2][0]; swg[1] = o == 0 ? sw[1][1] : sw[2][1]; swg[2] = o == 0 ? sw[1][2] : sw[2][2]; const float sbg = o == 0 ? sbv[1] : sbv[2];
        FOR_T { pass_load<8, NB8>(tid, HST(tid), [&](int idx, int r8, float& r, float& i) __attribute__((always_inline)) { if (r8 < 4) r = hf[idx] * inv; else { const int q = FN - idx; const float hv = hb[q < SEQ ? q : 0]; r = q < SEQ ? hv * inv : 0.f; } i = 0.f; });
                pass_compute<8, NB8>(tid, HST(tid), 1, lout); }
        HSYNC;
        FOR_T { pass_load<8, NB8>(tid, HST(tid), lin); } HSYNC; FOR_T { pass_compute<8, NB8>(tid, HST(tid), 8, lout); } HSYNC;
        FOR_T { pass_load<8, NB8>(tid, HST(tid), lin); } HSYNC; FOR_T { pass_compute<8, NB8>(tid, HST(tid), 64, lout); } HSYNC;
        FOR_T { pass_load<R4, NB4>(tid, HST(tid), lin);
                HySt& s = HST(tid); pass_compute<R4, NB4>(tid, s, NS4, [&](int, int b, int rr, float r, float i) __attribute__((always_inline)) { s.kp[b + NB4 * rr] = hy_pack(r, i); }); }
        HSYNC;
        for (int bp = 0; bp < BATCH / 2; ++bp) {
            const int b0 = 2 * bp, b1 = 2 * bp + 1;
            const bf16_t* u0 = p.UT + ((size_t)b0 * 3 * D_CH + c) * SEQ; const bf16_t* u1 = p.UT + ((size_t)b1 * 3 * D_CH + c) * SEQ;
            const float* z0 = p.Z1 + ((size_t)b0 * D_CH + c) * SEQ; const float* z1 = p.Z1 + ((size_t)b1 * D_CH + c) * SEQ;
            auto zval = [&](int b, int t) __attribute__((always_inline)) { return o == 0 ? bf2f((b == b0 ? u0 : u1)[tm_ofs(t)]) : (b == b0 ? z0 : z1)[tm_ofs(t)]; };
            FOR_T { HySt& s = HST(tid);
                    if (o == 0) { unsigned w0[8], w1[8]; tm_load_bf16(u0, tid, w0); tm_load_bf16(u1, tid, w1);
#pragma unroll
                        for (int q = 0; q < 32; ++q) { const int b = q >> 3, r = q & 7; if (r < 4) { s.xr[q] = tm_get(w0, b + 4 * r); s.xi[q] = tm_get(w1, b + 4 * r); } else { s.xr[q] = 0.f; s.xi[q] = 0.f; } } }
                    else {
#pragma unroll
                        for (int q = 0; q < 32; ++q) { const int b = q >> 3, r = q & 7; if (r < 4) { s.xr[q] = z0[tid * 16 + b + 4 * r]; s.xi[q] = z1[tid * 16 + b + 4 * r]; } else { s.xr[q] = 0.f; s.xi[q] = 0.f; } } }
                    pass_compute<8, NB8>(tid, s, 1, lout); }
            HSYNC;
            FOR_T { pass_load<8, NB8>(tid, HST(tid), lin); } HSYNC; FOR_T { pass_compute<8, NB8>(tid, HST(tid), 8, lout); } HSYNC;
            FOR_T { pass_load<8, NB8>(tid, HST(tid), lin); } HSYNC; FOR_T { pass_compute<8, NB8>(tid, HST(tid), 64, lout); } HSYNC;
            FOR_T { pass_load<R4, NB4>(tid, HST(tid), lin); } HSYNC;
            FOR_T { HySt& s = HST(tid); pass_compute<R4, NB4>(tid, s, NS4, [&](int idx, int b, int rr, float r, float i) __attribute__((always_inline)) { const float kr = hy_lo(s.kp[b + NB4 * rr]), ki = hy_hi(s.kp[b + NB4 * rr]);
                        re[pidx(idx)] = r * kr - i * ki; im[pidx(idx)] = -(r * ki + i * kr); }); }
            HSYNC;
            FOR_T { pass_load<8, NB8>(tid, HST(tid), lin); } HSYNC; FOR_T { pass_compute<8, NB8>(tid, HST(tid), 1, lout); } HSYNC;
            FOR_T { pass_load<8, NB8>(tid, HST(tid), lin); } HSYNC; FOR_T { pass_compute<8, NB8>(tid, HST(tid), 8, lout); } HSYNC;
            FOR_T { pass_load<8, NB8>(tid, HST(tid), lin); } HSYNC; FOR_T { pass_compute<8, NB8>(tid, HST(tid), 64, lout); } HSYNC;
            FOR_T { pass_load<R4, NB4>(tid, HST(tid), lin); HySt& s = HST(tid); float yr[16], yi[16];
                    pass_compute<R4, NB4>(tid, s, NS4, [&](int, int b, int rr, float r, float i) __attribute__((always_inline)) { if (rr < 8) { yr[b + 2 * rr] = r * (1.0f / FN); yi[b + 2 * rr] = -i * (1.0f / FN); } });
                    const bf16_t* g0 = p.UT + ((size_t)b0 * 3 * D_CH + (o + 1) * D_CH + c) * SEQ; const bf16_t* g1 = p.UT + ((size_t)b1 * 3 * D_CH + (o + 1) * D_CH + c) * SEQ;
                    unsigned gw0[8], gw1[8]; tm_load_bf16(g0, tid, gw0); tm_load_bf16(g1, tid, gw1);
                    if (o == 0) { unsigned w0[8], w1[8]; tm_load_bf16(u0, tid, w0); tm_load_bf16(u1, tid, w1);
                        float* zo0 = p.Z1 + ((size_t)b0 * D_CH + c) * SEQ + tid * 16; float* zo1 = p.Z1 + ((size_t)b1 * D_CH + c) * SEQ + tid * 16;
#pragma unroll
                        for (int m = 0; m < 16; ++m) { zo0[m] = tm_get(gw0, m) * (yr[m] + tm_get(w0, m) * hbias); zo1[m] = tm_get(gw1, m) * (yi[m] + tm_get(w1, m) * hbias); } }
                    else {
#pragma unroll
                        for (int m = 0; m < 16; ++m) { const float zn0 = tm_get(gw0, m) * (yr[m] + z0[tid * 16 + m] * hbias), zn1 = tm_get(gw1, m) * (yi[m] + z1[tid * 16 + m] * hbias);
                            HY_OUT(b0, tid + 256 * m, zn0); HY_OUT(b1, tid + 256 * m, zn1); } } }
            HSYNC;
        }
    }
    HY_FREE;
}
constexpr int MOD_ITEMS = DEPTH * (6 * D_MODEL / 64);
__device__ __forceinline__ void mod_item(const Params& p, char* lds, int item) {
    float* sc = (float*)lds;
    float* red = sc + 5 * D_MODEL;
    const int tid = threadIdx.x, l = item / (6 * D_MODEL / 64), j0 = (item % (6 * D_MODEL / 64)) * 64;
    for (int i = tid; i < 5 * D_MODEL; i += NTHREADS) { const int r = i / D_MODEL, k = i % D_MODEL; const float v = r < BATCH ? p.c[r * D_MODEL + k] : p.c_ctx[k]; sc[i] = silu_f(v); }
    __syncthreads();
    const int col = tid & 63, kp = tid >> 6;
    const float* w = p.w_ada + ((size_t)l * D_MODEL + kp * 256) * 6 * D_MODEL + j0 + col;
    float a0 = 0.f, a1 = 0.f, a2 = 0.f, a3 = 0.f, a4 = 0.f;
#pragma unroll 8
    for (int k = 0; k < 256; ++k) { const float wv = w[(size_t)k * 6 * D_MODEL]; const int kk = kp * 256 + k;
        a0 += sc[kk] * wv; a1 += sc[D_MODEL + kk] * wv; a2 += sc[2 * D_MODEL + kk] * wv; a3 += sc[3 * D_MODEL + kk] * wv; a4 += sc[4 * D_MODEL + kk] * wv; }
    red[(kp * 5 + 0) * 64 + col] = a0; red[(kp * 5 + 1) * 64 + col] = a1; red[(kp * 5 + 2) * 64 + col] = a2; red[(kp * 5 + 3) * 64 + col] = a3; red[(kp * 5 + 4) * 64 + col] = a4;
    __syncthreads();
    for (int i = tid; i < 5 * 64; i += NTHREADS) { const int r = i / 64, cc = i % 64;
        const float v = red[(0 * 5 + r) * 64 + cc] + red[(1 * 5 + r) * 64 + cc] + red[(2 * 5 + r) * 64 + cc] + red[(3 * 5 + r) * 64 + cc];
        p.mod[((size_t)(l * (BATCH + 1) + r)) * 6 * D_MODEL + j0 + cc] = v + p.b_ada[l * 6 * D_MODEL + j0 + cc]; }
    __syncthreads();
}
constexpr int FILT_ITEMS = (SEQ / 256) * (4 * D_CH / 64);
__device__ __forceinline__ void filt_item(const Params& p, char* lds, int item) {
    float* ws = (float*)lds;
    const int tid = threadIdx.x, tb = item % (SEQ / 256), cb = item / (SEQ / 256); const int t = tb * 256 + tid, col0 = cb * 64;
#pragma unroll
    for (int i = 0; i < 16; ++i) { const int k = i * 4 + (tid >> 6), cc = tid & 63; ws[cc * 68 + k] = p.hy_w3[(size_t)k * 4 * D_CH + col0 + cc]; }
    f32x4 h[16];
#pragma unroll
    for (int i = 0; i < 16; ++i) h[i] = *(const f32x4*)(p.h2 + (size_t)t * HY_FFN + i * 4);
    __syncthreads();
    const float tn = (float)t / (float)(SEQ - 1);
    const float mind = logf(1e-2f) / 1.5f, maxd = logf(1e-2f) / 0.3f;
#pragma unroll 2
    for (int cc = 0; cc < 64; ++cc) {
        const int col = col0 + cc; const f32x4* w = (const f32x4*)(ws + cc * 68);
        float acc = p.hy_b3[col];
#pragma unroll
        for (int i = 0; i < 16; ++i) { const f32x4 wv = w[i]; acc += h[i][0] * wv[0] + h[i][1] * wv[1] + h[i][2] * wv[2] + h[i][3] * wv[3]; }
        const float delta = fabsf(mind + (float)(col % D_CH) * (maxd - mind) / (float)(D_CH - 1));
        p.HFT[(size_t)col * SEQ + t] = acc * expf(-tn * delta);
    }
    __syncthreads();
}
__device__ __forceinline__ void ph_norm(const Params& p, int l, int which, int nrows, int bid, int nb) {
    const int lane = threadIdx.x & 63, wid = threadIdx.x >> 6;
    const float* g = p.norm_g + (l * 2 + which) * D_MODEL;
    for (int row = (bid * 4 + wid) * 2; row < nrows; row += nb * 8) {
        const int row1 = row + 1 < nrows ? row + 1 : row;
        const float* xa = which == 0 ? xrow_in(p, l, row) : xrow_cur(p, row); const float* xb = which == 0 ? xrow_in(p, l, row1) : xrow_cur(p, row1);
        f32x4 va[4], vb[4]; float sa = 0.f, sb = 0.f;
#pragma unroll
        for (int j = 0; j < 4; ++j) { va[j] = *(const f32x4*)(xa + j * 256 + lane * 4); vb[j] = *(const f32x4*)(xb + j * 256 + lane * 4); }
#pragma unroll
        for (int j = 0; j < 4; ++j) { sa += va[j][0] * va[j][0] + va[j][1] * va[j][1] + va[j][2] * va[j][2] + va[j][3] * va[j][3]; sb += vb[j][0] * vb[j][0] + vb[j][1] * vb[j][1] + vb[j][2] * vb[j][2] + vb[j][3] * vb[j][3]; }
        const float ra = 1.0f / sqrtf(wave_sum(sa) * (1.0f / D_MODEL) + EPS), rb = 1.0f / sqrtf(wave_sum(sb) * (1.0f / D_MODEL) + EPS);
        const float* sha = modp(p, l, row, which * 3 + 0); const float* sca = modp(p, l, row, which * 3 + 1);
        const float* shb = modp(p, l, row1, which * 3 + 0); const float* scb = modp(p, l, row1, which * 3 + 1);
#pragma unroll
        for (int j = 0; j < 4; ++j) { const int c = j * 256 + lane * 4; const f32x4 gv = *(const f32x4*)(g + c);
            store4bf(p.hbuf + (size_t)row * D_MODEL + c, va[j] * ra * gv * (*(const f32x4*)(sca + c) + 1.0f) + *(const f32x4*)(sha + c));
            if (row1 != row) store4bf(p.hbuf + (size_t)row1 * D_MODEL + c, vb[j] * rb * gv * (*(const f32x4*)(scb + c) + 1.0f) + *(const f32x4*)(shb + c)); }
    }
}
__device__ __forceinline__ void ph_route_a(const Params& p, char* lds, int l, int nrows, int bid, int nb) {
    const int lane = threadIdx.x & 63, wid = threadIdx.x >> 6;
    float* wr_s = (float*)lds; int* hist = (int*)(lds + 65536);
    for (int i = threadIdx.x; i < D_MODEL * 4; i += NTHREADS) { const int k = i >> 2, ch = i & 3; ((f32x4*)wr_s)[k * 4 + (ch ^ ((k >> 2) & 3))] = ((const f32x4*)p.w_router)[i]; }
    if (threadIdx.x < 32) hist[threadIdx.x] = 0;
    __syncthreads();
    const int sw = (lane >> 2) & 3;
    const float* g = p.norm_g + (l * 2 + 1) * D_MODEL;
    const int RPB = (nrows + nb - 1) / nb, r0 = bid * RPB;
    for (int j = wid; j < RPB; j += 4) {
        const int row = r0 + j; if (row >= nrows) break;
        const float* xr = xrow_cur(p, row); const float* sh = modp(p, l, row, 3); const float* sc = modp(p, l, row, 4);
        float v[16]; float ss = 0.f;
#pragma unroll
        for (int i = 0; i < 16; ++i) { v[i] = xr[lane + 64 * i]; ss += v[i] * v[i]; }
        const float rstd = 1.0f / sqrtf(wave_sum(ss) * (1.0f / D_MODEL) + EPS);
        float lg[16];
#pragma unroll
        for (int e = 0; e < 16; ++e) lg[e] = 0.f;
#pragma unroll
        for (int i = 0; i < 16; ++i) { const int k = lane + 64 * i; const float o = v[i] * rstd * g[k] * (sc[k] + 1.0f) + sh[k];
            p.hbuf[(size_t)row * D_MODEL + k] = f2bf(o);
            const f32x4* w4 = (const f32x4*)(wr_s + k * 16);
#pragma unroll
            for (int e4 = 0; e4 < 4; ++e4) { const f32x4 wv = w4[e4 ^ sw]; lg[e4 * 4 + 0] += o * wv[0]; lg[e4 * 4 + 1] += o * wv[1]; lg[e4 * 4 + 2] += o * wv[2]; lg[e4 * 4 + 3] += o * wv[3]; }
            if (i & 1) __builtin_amdgcn_sched_barrier(0); }
        {
#pragma unroll
            for (int i = 0; i < 8; ++i) { const float a = lg[i], b = lg[i + 8]; const bool up = (lane & 32) != 0; const float recv = __shfl_xor(up ? a : b, 32); lg[i] = (up ? b : a) + recv; }
#pragma unroll
            for (int i = 0; i < 4; ++i) { const float a = lg[i], b = lg[i + 4]; const bool up = (lane & 16) != 0; const float recv = __shfl_xor(up ? a : b, 16); lg[i] = (up ? b : a) + recv; }
#pragma unroll
            for (int i = 0; i < 2; ++i) { const float a = lg[i], b = lg[i + 2]; const bool up = (lane & 8) != 0; const float recv = __shfl_xor(up ? a : b, 8); lg[i] = (up ? b : a) + recv; }
            { const float a = lg[0], b = lg[1]; const bool up = (lane & 4) != 0; const float recv = __shfl_xor(up ? a : b, 4); lg[0] = (up ? b : a) + recv; }
            lg[0] += __shfl_xor(lg[0], 2); lg[0] += __shfl_xor(lg[0], 1);
            const float mine = lg[0];
#pragma unroll
            for (int e = 0; e < 16; ++e) lg[e] = __builtin_bit_cast(float, __builtin_amdgcn_readlane(__builtin_bit_cast(int, mine), 4 * e));
        }
        if (lane == 0) {
            int gbest = 0, a = 0, bb = 1; float gbs = -1e30f, wa = 0.f, wb = 0.f;
#pragma unroll
            for (int gI = 0; gI < 4; ++gI) {
                float m1 = -1e30f, m2 = -1e30f, s1 = 0.f, s2 = 0.f; int i1 = 0, i2 = 0;
#pragma unroll
                for (int jj = 0; jj < 4; ++jj) { float sgv = sigmoid_f(lg[gI * 4 + jj]); float vv = sgv + p.b_router[gI * 4 + jj];
                    if (vv > m1) { m2 = m1; i2 = i1; s2 = s1; m1 = vv; i1 = jj; s1 = sgv; } else if (vv > m2) { m2 = vv; i2 = jj; s2 = sgv; } }
                float gs = m1 + m2;
                if (gs > gbs) { gbs = gs; gbest = gI; if (i1 < i2) { a = i1; bb = i2; wa = s1; wb = s2; } else { a = i2; bb = i1; wa = s2; wb = s1; } }
            }
            const float inv = 1.0f / (wa + wb);
            const int pidx = a == 0 ? bb - 1 : (a == 1 ? bb + 1 : 5);
            const int pr = gbest * 6 + pidx;
            p.rpair[row] = pr; p.tokw[row * 2 + 0] = wa * inv; p.tokw[row * 2 + 1] = wb * inv;
            atomicAdd(&hist[pr], 1);
        }
    }
    __syncthreads();
    if (threadIdx.x < 32) p.bh[bid * 32 + threadIdx.x] = hist[threadIdx.x];
}
__device__ __forceinline__ void ph_route_b(const Params& p, char* lds, int l, int nrows, int bid, int nb) {
    int* sb = (int*)lds;
    const int t = threadIdx.x, pr = t & 31, part = t >> 5;
    { int s_before = 0, s_all = 0; const int b0 = (part * nb) >> 3, b1 = ((part + 1) * nb) >> 3;
      for (int b = b0; b < b1; ++b) { const int c = p.bh[b * 32 + pr]; s_all += c; if (b < bid) s_before += c; }
      sb[part * 32 + pr] = s_before; sb[256 + part * 32 + pr] = s_all; }
    __syncthreads();
    if (t < 32) { int a = 0, c = 0;
#pragma unroll
        for (int q = 0; q < 8; ++q) { a += sb[q * 32 + t]; c += sb[256 + q * 32 + t]; }
        sb[512 + t] = a; sb[544 + t] = c; if (bid == 0) p.cnt[l * 32 + t] = c; }
    const int RPB = (nrows + nb - 1) / nb, row = bid * RPB + t; const bool act = t < RPB && row < nrows;
    int myp = 0; if (act) { myp = p.rpair[row]; sb[576 + t] = myp; }
    __syncthreads();
    if (act) { int rank = 0; for (int j = 0; j < t; ++j) rank += (sb[576 + j] == myp) ? 1 : 0; p.list[(size_t)myp * TT + sb[512 + myp] + rank] = row; }
    __syncthreads();
}
__device__ __forceinline__ void ph_final(const Params& p, int bid, int nb) {
    const int lane = threadIdx.x & 63, wid = threadIdx.x >> 6;
    for (int row = (bid * 4 + wid) * 2; row < TX; row += nb * 8) {
        float* xa = p.out + (size_t)row * D_MODEL; float* xb = xa + D_MODEL;
        f32x4 va[4], vb[4]; float sa = 0.f, sb = 0.f;
#pragma unroll
        for (int j = 0; j < 4; ++j) { va[j] = *(const f32x4*)(xa + j * 256 + lane * 4); vb[j] = *(const f32x4*)(xb + j * 256 + lane * 4); }
#pragma unroll
        for (int j = 0; j < 4; ++j) { sa += va[j][0] * va[j][0] + va[j][1] * va[j][1] + va[j][2] * va[j][2] + va[j][3] * va[j][3]; sb += vb[j][0] * vb[j][0] + vb[j][1] * vb[j][1] + vb[j][2] * vb[j][2] + vb[j][3] * vb[j][3]; }
        const float ra = 1.0f / sqrtf(wave_sum(sa) * (1.0f / D_MODEL) + EPS), rb = 1.0f / sqrtf(wave_sum(sb) * (1.0f / D_MODEL) + EPS);
#pragma unroll
        for (int j = 0; j < 4; ++j) { const int c = j * 256 + lane * 4; const f32x4 gv = *(const f32x4*)(p.final_g + c); *(f32x4*)(xa + c) = va[j] * ra * gv; *(f32x4*)(xb + c) = vb[j] * rb * gv; }
    }
}

#define XB_TMO      128
#define XB_XCNT(j)  (256  + 64 * (j))
#define XB_XSUB(j)  (1280 + 64 * (j))
#define XB_XGEN(j)  (2304 + 64 * (j))
#define XB_TOP      3328
#define XB_TOPGEN   3392
#define XCD_BAR_WORDS 3456
#define XB_SPIN_CAP (1u << 20)
__device__ __forceinline__ unsigned xb_ld(unsigned* p)              { return __hip_atomic_load(p, __ATOMIC_RELAXED, __HIP_MEMORY_SCOPE_AGENT); }
__device__ __forceinline__ unsigned xb_add(unsigned* p, unsigned v) { return __hip_atomic_fetch_add(p, v, __ATOMIC_RELAXED, __HIP_MEMORY_SCOPE_AGENT); }
__device__ __forceinline__ unsigned xb_xcc_id() { return (unsigned)__builtin_amdgcn_s_getreg((3 << 11) | 20) & 0xFu; }
#define XB_SPIN(cond, bar) do { unsigned _sp = 0; while (cond) { __builtin_amdgcn_s_sleep(1); \
    if ((++_sp & 255u) == 0u) { if (xb_ld(&(bar)[XB_TMO])) break; if (_sp > XB_SPIN_CAP) { atomicAdd(&(bar)[XB_TMO], 1u); break; } } } } while (0)
struct XcdBarrier { unsigned* bar; unsigned x; volatile LAS unsigned* st; };
__device__ __forceinline__ XcdBarrier xcd_barrier_post(unsigned* bar, volatile LAS unsigned* st) {
    XcdBarrier b; b.bar = bar; b.x = xb_xcc_id(); b.st = st;
    if (threadIdx.x == 0) (void)xb_add(&bar[XB_XCNT(b.x)], 1u);
    return b;
}
__device__ __forceinline__ void xcd_barrier_complete(unsigned* bar, unsigned x, unsigned& nloc, unsigned& nx) {
    const unsigned G = gridDim.x * gridDim.y * gridDim.z;
    unsigned sum, cnt, mine, sp = 0u;
    for (;;) {
        sum = 0u; cnt = 0u; mine = 0u;
#pragma unroll
        for (unsigned j = 0; j < 16; ++j) { const unsigned c = xb_ld(&bar[XB_XCNT(j)]); sum += c; cnt += (c > 0u) ? 1u : 0u; mine = (j == x) ? c : mine; }
        if (sum == G) break;
        __builtin_amdgcn_s_sleep(1);
        if ((++sp & 255u) == 0u) { if (xb_ld(&bar[XB_TMO])) break; if (sp > XB_SPIN_CAP) { atomicAdd(&bar[XB_TMO], 1u); break; } }
    }
    nloc = mine > 0u ? mine : 1u; nx = cnt > 0u ? cnt : 1u;
}
__device__ __forceinline__ void xcd_barrier(const XcdBarrier& b) {
    asm volatile("s_waitcnt vmcnt(0)" ::: "memory");
    __syncthreads();
    if (threadIdx.x == 0) {
        unsigned* bar = b.bar;
        __builtin_amdgcn_s_waitcnt(0);
        unsigned nloc = b.st[0], nx = b.st[1];
        if (nloc == 0u) { xcd_barrier_complete(bar, b.x, nloc, nx); b.st[0] = nloc; b.st[1] = nx; }
        const unsigned old = xb_add(&bar[XB_XSUB(b.x)], 1u);
        const unsigned gen = old / nloc;
        if (old + 1u == (gen + 1u) * nloc) {
            __builtin_amdgcn_fence(__ATOMIC_RELEASE, "agent");
            asm volatile("s_waitcnt vmcnt(0)" ::: "memory");
            const unsigned og = xb_add(&bar[XB_TOP], 1u);
            const unsigned tg = og / nx;
            if (og + 1u == (tg + 1u) * nx) xb_add(&bar[XB_TOPGEN], 1u);
            else XB_SPIN(xb_ld(&bar[XB_TOPGEN]) == tg, bar);
            __builtin_amdgcn_fence(__ATOMIC_ACQUIRE, "agent");
            xb_add(&bar[XB_XGEN(b.x)], 1u);
            asm volatile("s_waitcnt vmcnt(0)" ::: "memory");
        } else {
            XB_SPIN(xb_ld(&bar[XB_XGEN(b.x)]) == gen, bar);
            __builtin_amdgcn_fence(__ATOMIC_ACQUIRE, "agent");
            asm volatile("s_waitcnt vmcnt(0)" ::: "memory");
        }
    }
    __syncthreads();
}

__device__ __forceinline__ void ph_mix1(const Params& p, char* lds, int bid, int nb, unsigned long long* tsplit = nullptr) {
    const bool hy_first = bid >= (nb >> 1);
    for (int rep = 0; rep < 3; ++rep) {
        if (rep == 1) {
            for (int u = bid; u < NU_LAT; u += nb) { const int blk = u % (SEQ / 128), h = (u / (SEQ / 128)) % 8, b = u / (8 * (SEQ / 128)); const int s0 = blk * 128;
                attn_unit<0>(lds, p.QC + (size_t)(b * SEQ + s0) * 512 + h * 64, p.KC + (size_t)(b * 2 + h / 4) * LKV * 64, p.VCt + (size_t)(b * 2 + h / 4) * 64 * LKV,
                             p.Y + (size_t)(b * SEQ + s0) * 1024 + h * 64, s0, CTX_LEN / 64, 0, SEQ / 64, 0.f, false, nullptr); }
            if (tsplit) *tsplit = __builtin_amdgcn_s_memrealtime();
        } else if ((rep == 0) == hy_first) {
            __syncthreads();
            for (int c = hy_first ? bid - (nb >> 1) : bid + (nb >> 1); c < D_CH; c += nb) hyena_channel(p, c, (float*)lds);
            __syncthreads();
        }
    }
}
constexpr int TR_ITEMS = BATCH * (D_CH / 64) * (SEQ / 64);
__device__ __forceinline__ void tr_item(const Params& p, char* lds, int it) {
    bf16_t* T = (bf16_t*)lds; const int tid = threadIdx.x;
    const int sb = it % (SEQ / 64), cb = (it / (SEQ / 64)) % (D_CH / 64), b = it / ((SEQ / 64) * (D_CH / 64));
    { const int c = tid >> 2, q = tid & 3;
      const u32x4* src = (const u32x4*)(p.YHT + ((size_t)b * D_CH + cb * 64 + c) * SEQ + sb * 64 + q * 16);
      const u32x4 v0 = src[0], v1 = src[1]; unsigned* d = (unsigned*)(T + c * 66 + q * 16);
      d[0] = v0.x; d[1] = v0.y; d[2] = v0.z; d[3] = v0.w; d[4] = v1.x; d[5] = v1.y; d[6] = v1.z; d[7] = v1.w; }
    __syncthreads();
    { const int s = tid >> 2, q = tid & 3;
      unsigned w[8];
#pragma unroll
      for (int i = 0; i < 8; ++i) w[i] = (unsigned)T[(q * 16 + 2 * i) * 66 + s] | ((unsigned)T[(q * 16 + 2 * i + 1) * 66 + s] << 16);
      u32x4* dst = (u32x4*)(p.Y + ((size_t)b * SEQ + sb * 64 + s) * 1024 + 512 + cb * 64 + q * 16);
      dst[0] = (u32x4){w[0], w[1], w[2], w[3]}; dst[1] = (u32x4){w[4], w[5], w[6], w[7]}; }
    __syncthreads();
}
enum { PH_PREP = 0, PH_NORM0, PH_INPROJ0, PH_ATTN0, PH_OUT0, PH_ROUTE0, PH_ROUTEB0, PH_UP0, PH_DOWN0, PH_NORM1, PH_INPROJ1, PH_MIX1, PH_HY1, PH_TR1, PH_OUT1, PH_ROUTE1, PH_ROUTEB1, PH_UP1, PH_DOWN1, PH_FINAL, PH_COUNT };
typedef const __attribute__((address_space(4))) Params* KParams;
__global__ void __launch_bounds__(NTHREADS, 2) mega(Params p_arg, int lo, int hi) {
    extern __shared__ __attribute__((aligned(16))) char lds[];
    const int bid = blockIdx.x, nb = gridDim.x;
    volatile LAS unsigned* st = (volatile LAS unsigned*)(lds + LDS_BYTES - 16);
    if (threadIdx.x < 4) st[threadIdx.x] = 0u;
    __syncthreads();
    KParams kp = (KParams)__builtin_amdgcn_kernarg_segment_ptr();
    XcdBarrier bar; bar.bar = kp->bar; bar.x = 0; bar.st = st;
    if (hi - lo > 1) bar = xcd_barrier_post(kp->bar, st);
#ifdef PROBE_PA
    unsigned long long ts_prev = __builtin_amdgcn_s_memrealtime(), t_a = 0, t_b = 0;
#define STAMP(PH) if (bid == 0 && threadIdx.x == 0) { const unsigned long long now_ = __builtin_amdgcn_s_memrealtime(); if ((PH) == PROBE_PA) t_a = now_ - ts_prev; if ((PH) == PROBE_PB) t_b = now_ - ts_prev; ts_prev = now_; }
#else
#define STAMP(PH)
#endif
#define PHASE(PH, body) if (lo <= (PH) && (PH) < hi) { { KParams kq_ = kp; asm volatile("" : "+s"(kq_)); const Params& p = *(const Params*)kq_; body; } if ((PH) + 1 < hi) xcd_barrier(bar); STAMP(PH) }
    PHASE(PH_PREP, { if (nb > MOD_ITEMS + 64) { if (bid < MOD_ITEMS) mod_item(p, lds, bid); else cvt_range(p, lds, 0, CVT_EARLY, bid - MOD_ITEMS, nb - MOD_ITEMS); }
        else { for (int it = bid; it < MOD_ITEMS; it += nb) mod_item(p, lds, it); cvt_range(p, lds, 0, CVT_EARLY, bid, nb); }
        d_rope(p); d_hy_h1(p); })
    PHASE(PH_NORM0, { ph_norm(p, 0, 0, TT, bid, nb); d_hy_h2(p); })
    PHASE(PH_INPROJ0, ph_inproj<0>(p, lds, bid, nb))
    PHASE(PH_ATTN0, { if (bid >= (nb >> 1)) { cvt_range(p, lds, CVT_EARLY, CVT_TOTAL, bid, nb); __syncthreads(); ph_attn0(p, lds, bid, nb); } else { ph_attn0(p, lds, bid, nb); __syncthreads(); cvt_range(p, lds, CVT_EARLY, CVT_TOTAL, bid, nb); } })
    PHASE(PH_OUT0, { ph_outproj<0>(p, lds, bid, nb);
        __syncthreads(); { const int full_ = (nb & 7) == 0 ? ((MT_ALL / 8) * 8) % (nb >> 3) : 0;
          const int lb_ = bid >> 3; if ((nb & 7) != 0) { for (int it = bid; it < FILT_ITEMS; it += nb) filt_item(p, lds, it); }
          else if (lb_ >= full_) { for (int it = (lb_ - full_) * 8 + (bid & 7); it < FILT_ITEMS; it += nb - full_ * 8) filt_item(p, lds, it); } } })
    PHASE(PH_ROUTE0, ph_route_a(p, lds, 0, TT, bid, nb))
    PHASE(PH_ROUTEB0, ph_route_b(p, lds, 0, TT, bid, nb))
    PHASE(PH_UP0, ph_moe_up(p, lds, 0, bid, nb))
    PHASE(PH_DOWN0, ph_moe_down(p, lds, 0, bid, nb))
    PHASE(PH_NORM1, ph_norm(p, 1, 0, TT, bid, nb))
    PHASE(PH_INPROJ1, ph_inproj<1>(p, lds, bid, nb))
    PHASE(PH_MIX1, ph_attnC(p, lds, bid, nb))
    PHASE(PH_HY1, for (int c = bid; c < D_CH; c += nb) hyena_channel(p, c, (float*)lds))
    PHASE(PH_TR1, for (int it = bid; it < TR_ITEMS; it += nb) tr_item(p, lds, it))
    PHASE(PH_OUT1, ph_outproj<1>(p, lds, bid, nb))
    PHASE(PH_ROUTE1, ph_route_a(p, lds, 1, TX, bid, nb))
    PHASE(PH_ROUTEB1, ph_route_b(p, lds, 1, TX, bid, nb))
    PHASE(PH_UP1, ph_moe_up(p, lds, 1, bid, nb))
    PHASE(PH_DOWN1, ph_moe_down(p, lds, 1, bid, nb))
    PHASE(PH_FINAL, ph_final(p, bid, nb))
#ifdef PROBE_PA
    if (bid == 0 && threadIdx.x == 0) {
        const unsigned long long delay = 2 * t_a + 204800ull * ((t_b + 200) / 400); const unsigned long long t0 = __builtin_amdgcn_s_memrealtime();
        while (__builtin_amdgcn_s_memrealtime() - t0 < delay) __builtin_amdgcn_s_sleep(32);
    }
#endif
}
extern "C" void kernel_launch(void* const* d_in, const int* in_sizes, int n_in, void* d_out, int out_size, void* d_ws, size_t ws_size, hipStream_t stream) {
    static int grid = 0;
    if (grid == 0) {
        int dev = 0, cus = 0;
        if (hipGetDevice(&dev) != hipSuccess || hipDeviceGetAttribute(&cus, hipDeviceAttributeMultiprocessorCount, dev) != hipSuccess) { fprintf(stderr, "kernel_launch: device query failed\n"); grid = -1; return; }
        if (hipFuncSetAttribute((const void*)mega, hipFuncAttributeMaxDynamicSharedMemorySize, LDS_BYTES) != hipSuccess) { fprintf(stderr, "kernel_launch: hipFuncSetAttribute failed\n"); grid = -1; return; }
        grid = 2 * cus;
    }
    if (grid < 0) return;
    Params p{};
    size_t need = setup_ws(p, (char*)d_ws);
    if (n_in != 32 || need > ws_size || out_size != TX * D_MODEL) { fprintf(stderr, "kernel_launch: bad config n_in %d ws %zu need %zu out %d\n", n_in, ws_size, need, out_size); return; }
    fill_inputs(p, d_in, d_out);
    hipMemsetAsync(p.bar, 0, 64 * 1024 + 256, stream);
#ifdef PER_PHASE
    for (int ph = 0; ph < PH_COUNT; ++ph) mega<<<dim3(grid), dim3(NTHREADS), LDS_BYTES, stream>>>(p, ph, ph + 1);
#else
    mega<<<dim3(grid), dim3(NTHREADS), LDS_BYTES, stream>>>(p, 0, PH_COUNT);
#endif
}
```

```cpp
#include <hip/hip_runtime.h>
#include <cstdio>
#include <math.h>
#include <stdint.h>
#include <string.h>

#ifdef CPU_TEST
#define HD
#define GLOBAL
struct U3 { unsigned x, y, z; };
static thread_local U3 threadIdx, blockIdx, blockDim, gridDim;
static inline int atomicAdd(int* p, int v) { return __sync_fetch_and_add(p, v); }
#else
#define HD __device__ __forceinline__
#define GLOBAL __global__ __launch_bounds__(256)
#endif

#if defined(HY_TEST)
constexpr int D_MODEL = 64, BATCH = 2, SEQ = 4096, GRID_W = 64, CTX_LEN = 64, D_CH = 4, D_EXPERT = 64;
#elif defined(SMALL_CFG)
constexpr int D_MODEL = 128, BATCH = 2, SEQ = 512, GRID_W = 32, CTX_LEN = 64, D_CH = 32, D_EXPERT = 64;
#else
constexpr int D_MODEL = 1024, BATCH = 4, SEQ = 4096, GRID_W = 64, CTX_LEN = 256, D_CH = 512, D_EXPERT = 512;
#endif
constexpr int DEPTH = 2, HEAD_DIM = 64;
constexpr int GRID_H = SEQ / GRID_W;
constexpr int A_WINDOW = 128;
constexpr int B_WIN_H = 8, B_WIN_W = 16;
constexpr int HY_BANDS = 16, HY_EMB = 33, HY_FFN = 64;
constexpr int EVEN_IN = 2304, EVEN_OUT = 1024;
constexpr int ODD_IN = 768 + 3 * D_CH, ODD_OUT = 512 + D_CH;
constexpr int N_EXPERTS = 16;
constexpr int TX = BATCH * SEQ, TC = BATCH * CTX_LEN, TT = TX + TC;
constexpr int LKV = CTX_LEN + SEQ;
constexpr int NPAIR = 24;
constexpr int HE_W = 2 * D_EXPERT;
constexpr float EPS = 1e-6f;
constexpr float ATTN_SCALE = 0.125f;

typedef unsigned short bf16_t;
HD bf16_t f2bf(float f) { unsigned u; __builtin_memcpy(&u, &f, 4); u = (u + 0x7fffu + ((u >> 16) & 1u)) >> 16; return (bf16_t)u; }
HD float bf2f(bf16_t h) { unsigned u = ((unsigned)h) << 16; float f; __builtin_memcpy(&f, &u, 4); return f; }
HD float silu_f(float x) { return x / (1.0f + expf(-x)); }
HD float sigmoid_f(float x) { return 1.0f / (1.0f + expf(-x)); }

struct Params {
    const float *x, *c, *ctx, *c_ctx, *w_ada, *b_ada, *norm_g, *final_g, *w_in_even, *w_out_even, *a_sink, *b_rpb;
    const float *w_in_odd, *w_out_odd, *c_qnorm, *c_knorm, *hy_short_w, *hy_short_b, *hy_w1, *hy_b1, *hy_f1, *hy_w2;
    const float *hy_b2, *hy_f2, *hy_w3, *hy_b3, *hy_bias, *w_router, *b_router, *moe_wg, *moe_wu, *moe_wd;
    float* out;
    float* XC;
    float* mod;
    float* ropet;
    float* h1;
    float* h2;
    float* HFT;
    float* hnorm;
    bf16_t* hbuf;
    bf16_t *QA, *KA, *VAt, *QB, *KB, *VBt;
    bf16_t *QC, *KC, *VCt, *UT;
    bf16_t* Y;
    bf16_t* YHT;
    float* Z1;
    bf16_t* HE;
    int* cnt;
    int* list;
    float* tokw;
    bf16_t *Wt_in_even, *Wt_out_even, *Wt_in_odd, *Wt_out_odd, *Wt_gu, *Wt_d;
    unsigned* bar;
    int* rpair;
    int* bh;
    float* rlog;
};

#define GS_LOOP(i, n) for (long i = (long)blockIdx.x * blockDim.x + threadIdx.x; i < (long)(n); i += (long)gridDim.x * blockDim.x)

HD const float* xrow_in(const Params& p, int l, int row) {
    if (l == 0) return row < TX ? p.x + (size_t)row * D_MODEL : p.ctx + (size_t)(row - TX) * D_MODEL;
    return row < TX ? p.out + (size_t)row * D_MODEL : p.XC + (size_t)(row - TX) * D_MODEL;
}
HD float* xrow_cur(const Params& p, int row) { return row < TX ? p.out + (size_t)row * D_MODEL : p.XC + (size_t)(row - TX) * D_MODEL; }
HD int row_mod(int row) { return row < TX ? row / SEQ : BATCH; }
HD const float* modp(const Params& p, int l, int row, int which) { return p.mod + ((size_t)(l * (BATCH + 1) + row_mod(row)) * 6 + which) * D_MODEL; }

GLOBAL void nk_mod(Params p) {
    GS_LOOP(i, DEPTH * (BATCH + 1) * 6 * D_MODEL) {
        int j = i % (6 * D_MODEL); int r = (i / (6 * D_MODEL)) % (BATCH + 1); int l = i / (6 * D_MODEL * (BATCH + 1));
        const float* cv = r < BATCH ? p.c + r * D_MODEL : p.c_ctx;
        const float* w = p.w_ada + (size_t)l * D_MODEL * 6 * D_MODEL;
        float acc = 0.f;
        for (int k = 0; k < D_MODEL; ++k) acc += silu_f(cv[k]) * w[(size_t)k * 6 * D_MODEL + j];
        p.mod[i] = acc + p.b_ada[l * 6 * D_MODEL + j];
    }
}
HD void d_rope(const Params& p) {
    GS_LOOP(i, 64 * 16) {
        int pos = i / 16, k = i % 16;
        float inv = powf(10000.0f, -(float)(2 * k) / 32.0f);
        float a = (float)pos * inv;
        p.ropet[pos * 32 + k] = cosf(a); p.ropet[pos * 32 + 16 + k] = sinf(a);
    }
}
HD void d_hy_h1(const Params& p) {
    GS_LOOP(i, SEQ * HY_FFN) {
        int t = i / HY_FFN, k = i % HY_FFN;
        float tn = (float)t / (float)(SEQ - 1);
        float acc = tn * p.hy_w1[0 * HY_FFN + k];
        for (int b = 0; b < HY_BANDS; ++b) {
            float band = 1e-4f + (float)b * ((float)(HY_BANDS - 1) - 1e-4f) / (float)(HY_BANDS - 1);
            float ang = 2.0f * 3.14159265358979323846f * (float)t * band / (float)SEQ;
            acc += cosf(ang) * p.hy_w1[(1 + b) * HY_FFN + k] + sinf(ang) * p.hy_w1[(1 + HY_BANDS + b) * HY_FFN + k];
        }
        p.h1[i] = sinf(p.hy_f1[k] * (acc + p.hy_b1[k]));
    }
}
HD void d_hy_h2(const Params& p) {
    GS_LOOP(i, SEQ * HY_FFN) {
        int t = i / HY_FFN, j = i % HY_FFN;
        float acc = 0.f;
        for (int k = 0; k < HY_FFN; ++k) acc += p.h1[t * HY_FFN + k] * p.hy_w2[k * HY_FFN + j];
        p.h2[i] = sinf(p.hy_f2[j] * (acc + p.hy_b2[j]));
    }
}
HD float hy_decay(int t, int c) {
    const float mind = logf(1e-2f) / 1.5f, maxd = logf(1e-2f) / 0.3f;
    float delta = fabsf(mind + (float)c * (maxd - mind) / (float)(D_CH - 1));
    float tn = (float)t / (float)(SEQ - 1);
    return expf(-tn * delta);
}
GLOBAL void nk_hy_filt(Params p) {
    GS_LOOP(i, 4 * D_CH * SEQ) {
        int t = i % SEQ, col = i / SEQ, c = col % D_CH;
        float acc = p.hy_b3[col];
        for (int k = 0; k < HY_FFN; ++k) acc += p.h2[t * HY_FFN + k] * p.hy_w3[k * 4 * D_CH + col];
        p.HFT[i] = acc * hy_decay(t, c);
    }
}
GLOBAL void nk_hy_norm(Params p) {
    GS_LOOP(i, 2 * D_CH) {
        int o = i / D_CH, c = i % D_CH;
        float s = 0.f;
        for (int dir = 0; dir < 2; ++dir) { const float* h = p.HFT + (size_t)((dir * 2 + o) * D_CH + c) * SEQ; for (int t = 0; t < SEQ; ++t) s += fabsf(h[t]); }
        p.hnorm[i] = s + EPS;
    }
}
GLOBAL void nk_zero_cnt(Params p) { GS_LOOP(i, 64) p.cnt[i] = 0; }

GLOBAL void nk_norm(Params p, int l, int which, int nrows) {
    GS_LOOP(row, nrows) {
        const float* xr = which == 0 ? xrow_in(p, l, (int)row) : xrow_cur(p, (int)row);
        float ss = 0.f;
        for (int k = 0; k < D_MODEL; ++k) ss += xr[k] * xr[k];
        float rstd = 1.0f / sqrtf(ss / D_MODEL + EPS);
        const float* g = p.norm_g + (l * 2 + which) * D_MODEL;
        const float* sh = modp(p, l, (int)row, which * 3 + 0); const float* sc = modp(p, l, (int)row, which * 3 + 1);
        for (int k = 0; k < D_MODEL; ++k) p.hbuf[row * D_MODEL + k] = f2bf(xr[k] * rstd * g[k] * (1.0f + sc[k]) + sh[k]);
    }
}

HD float dot_row(const bf16_t* a, const float* W, int ldw, int col, int K) {
    float acc = 0.f;
    for (int k = 0; k < K; ++k) acc += bf2f(a[k]) * W[(size_t)k * ldw + col];
    return acc;
}
HD float rope_apply(const Params& p, float v, float partner, int d, int s) {
    int half = d >> 5, dd = d & 31, k = dd & 15;
    int pos = half == 0 ? s / GRID_W : s % GRID_W;
    float c = p.ropet[pos * 32 + k], sn = p.ropet[pos * 32 + 16 + k];
    return dd < 16 ? v * c - partner * sn : v * c + partner * sn;
}

GLOBAL void nk_inproj_even(Params p) {
    GS_LOOP(i, (long)TT * EVEN_IN) {
        int row = i / EVEN_IN, col = i % EVEN_IN;
        const bf16_t* a = p.hbuf + (size_t)row * D_MODEL;
        float v = dot_row(a, p.w_in_even, EVEN_IN, col, D_MODEL);
        bool lat = row < TX; int b = lat ? row / SEQ : (row - TX) / CTX_LEN; int s = lat ? row % SEQ : (row - TX) % CTX_LEN;
        int pos = lat ? CTX_LEN + s : s;
        if (col < 640) {
            int d = col & 63;
            if (lat) { int pc = (d & 31) < 16 ? col + 16 : col - 16; float pv = dot_row(a, p.w_in_even, EVEN_IN, pc, D_MODEL); v = rope_apply(p, v, pv, d, s); }
            if (col < 512) p.QA[(size_t)row * 512 + col] = f2bf(v);
            else { int h = (col - 512) >> 6; p.KA[((size_t)(b * 2 + h) * LKV + pos) * 64 + d] = f2bf(v); }
        } else if (col < 768) { int h = (col - 640) >> 6, d = col & 63; p.VAt[((size_t)(b * 2 + h) * 64 + d) * LKV + pos] = f2bf(v); }
        else if (col < 1280) p.QB[(size_t)row * 512 + (col - 768)] = f2bf(v);
        else if (col < 1792) { int h = (col - 1280) >> 6, d = col & 63; p.KB[((size_t)(b * 8 + h) * LKV + pos) * 64 + d] = f2bf(v); }
        else { int h = (col - 1792) >> 6, d = col & 63; p.VBt[((size_t)(b * 8 + h) * 64 + d) * LKV + pos] = f2bf(v); }
    }
}

struct OSM { float m, l; };
#define ATT_BEGIN() float q[64], acc[64]; for (int d = 0; d < 64; ++d) { q[d] = bf2f(qp[d]) * ATTN_SCALE; acc[d] = 0.f; } float m_ = -1e30f, l_ = 0.f;
#define ATT_KEY(Kp, Vt, key, bias) do { const bf16_t* kk_ = (Kp) + (size_t)(key) * 64; float s_ = (bias); for (int d = 0; d < 64; ++d) s_ += q[d] * bf2f(kk_[d]); \
    float mn_ = fmaxf(m_, s_); float f_ = expf(m_ - mn_), pe_ = expf(s_ - mn_); l_ = l_ * f_ + pe_; \
    for (int d = 0; d < 64; ++d) acc[d] = acc[d] * f_ + pe_ * bf2f((Vt)[(size_t)d * LKV + (key)]); m_ = mn_; } while (0)
#define ATT_SINK(sv) do { float s_ = (sv); float mn_ = fmaxf(m_, s_); float f_ = expf(m_ - mn_); l_ = l_ * f_ + expf(s_ - mn_); for (int d = 0; d < 64; ++d) acc[d] *= f_; m_ = mn_; } while (0)

GLOBAL void nk_attnA(Params p) {
    GS_LOOP(i, (long)TX * 8) {
        int h = i % 8, row = i / 8, b = row / SEQ, s = row % SEQ, kvh = h / 4;
        const bf16_t* qp = p.QA + (size_t)row * 512 + h * 64;
        const bf16_t* Kp = p.KA + (size_t)(b * 2 + kvh) * LKV * 64; const bf16_t* Vt = p.VAt + (size_t)(b * 2 + kvh) * 64 * LKV;
        ATT_BEGIN();
        for (int j = 0; j < CTX_LEN; ++j) ATT_KEY(Kp, Vt, j, 0.f);
        int lo = s - A_WINDOW < 0 ? 0 : s - A_WINDOW, hi = s + A_WINDOW > SEQ - 1 ? SEQ - 1 : s + A_WINDOW;
        for (int j = lo; j <= hi; ++j) ATT_KEY(Kp, Vt, CTX_LEN + j, 0.f);
        ATT_SINK(p.a_sink[h]);
        for (int d = 0; d < 64; ++d) p.Y[(size_t)row * 1024 + h * 64 + d] = f2bf(acc[d] / l_);
    }
}
GLOBAL void nk_attnB(Params p) {
    GS_LOOP(i, (long)TX * 8) {
        int h = i % 8, row = i / 8, b = row / SEQ, s = row % SEQ, r = s / GRID_W, cq = s % GRID_W;
        const bf16_t* qp = p.QB + (size_t)row * 512 + h * 64;
        const bf16_t* Kp = p.KB + (size_t)(b * 8 + h) * LKV * 64; const bf16_t* Vt = p.VBt + (size_t)(b * 8 + h) * 64 * LKV;
        ATT_BEGIN();
        for (int j = 0; j < CTX_LEN; ++j) ATT_KEY(Kp, Vt, j, 0.f);
        int kh = B_WIN_H < GRID_H ? B_WIN_H : GRID_H;
        int rs = r - kh / 2; if (rs < 0) rs = 0; if (rs > GRID_H - kh) rs = GRID_H - kh;
        int cs = cq - B_WIN_W / 2; if (cs < 0) cs = 0; if (cs > GRID_W - B_WIN_W) cs = GRID_W - B_WIN_W;
        for (int kr = rs; kr < rs + kh; ++kr)
            for (int kc = cs; kc < cs + B_WIN_W; ++kc) {
                int dr = kr - r, dc = kc - cq;
                float bias = p.b_rpb[(h * (2 * B_WIN_H - 1) + dr + B_WIN_H - 1) * (2 * B_WIN_W - 1) + dc + B_WIN_W - 1];
                ATT_KEY(Kp, Vt, CTX_LEN + kr * GRID_W + kc, bias);
            }
        for (int d = 0; d < 64; ++d) p.Y[(size_t)row * 1024 + 512 + h * 64 + d] = f2bf(acc[d] / l_);
    }
}
GLOBAL void nk_attn_ctx(Params p) {
    GS_LOOP(i, (long)TC * 16) {
        int hh = i % 16, rc = i / 16, ty = hh / 8, h = hh % 8, b = rc / CTX_LEN; int row = TX + rc;
        const bf16_t* qp = (ty == 0 ? p.QA : p.QB) + (size_t)row * 512 + h * 64;
        const bf16_t* Kp = ty == 0 ? p.KA + (size_t)(b * 2 + h / 4) * LKV * 64 : p.KB + (size_t)(b * 8 + h) * LKV * 64;
        const bf16_t* Vt = ty == 0 ? p.VAt + (size_t)(b * 2 + h / 4) * 64 * LKV : p.VBt + (size_t)(b * 8 + h) * 64 * LKV;
        ATT_BEGIN();
        for (int j = 0; j < CTX_LEN; ++j) ATT_KEY(Kp, Vt, j, 0.f);
        if (ty == 0) ATT_SINK(p.a_sink[h]);
        for (int d = 0; d < 64; ++d) p.Y[(size_t)row * 1024 + ty * 512 + h * 64 + d] = f2bf(acc[d] / l_);
    }
}
GLOBAL void nk_attnC(Params p) {
    GS_LOOP(i, (long)TX * 8) {
        int h = i % 8, row = i / 8, b = row / SEQ, kvh = h / 4;
        const bf16_t* qp = p.QC + (size_t)row * 512 + h * 64;
        const bf16_t* Kp = p.KC + (size_t)(b * 2 + kvh) * LKV * 64; const bf16_t* Vt = p.VCt + (size_t)(b * 2 + kvh) * 64 * LKV;
        ATT_BEGIN();
        for (int j = 0; j < LKV; ++j) ATT_KEY(Kp, Vt, j, 0.f);
        for (int d = 0; d < 64; ++d) p.Y[(size_t)row * 1024 + h * 64 + d] = f2bf(acc[d] / l_);
    }
}

GLOBAL void nk_outproj_even(Params p) {
    GS_LOOP(i, (long)TT * D_MODEL) {
        int row = i / D_MODEL, col = i % D_MODEL;
        float acc = dot_row(p.Y + (size_t)row * 1024, p.w_out_even, D_MODEL, col, EVEN_OUT);
        xrow_cur(p, row)[col] = xrow_in(p, 0, row)[col] + modp(p, 0, row, 2)[col] * acc;
    }
}
GLOBAL void nk_outproj_odd(Params p) {
    GS_LOOP(i, (long)TX * D_MODEL) {
        int row = i / D_MODEL, col = i % D_MODEL, b = row / SEQ, s = row % SEQ;
        float acc = dot_row(p.Y + (size_t)row * 1024, p.w_out_odd, D_MODEL, col, 512);
        for (int c = 0; c < D_CH; ++c) acc += bf2f(p.YHT[((size_t)b * D_CH + c) * SEQ + s]) * p.w_out_odd[(size_t)(512 + c) * D_MODEL + col];
        p.out[i] = p.out[i] + modp(p, 1, row, 2)[col] * acc;
    }
}

GLOBAL void nk_router(Params p, int l, int nrows) {
    GS_LOOP(row, nrows) {
        const float* xr = xrow_cur(p, (int)row);
        float ss = 0.f;
        for (int k = 0; k < D_MODEL; ++k) ss += xr[k] * xr[k];
        float rstd = 1.0f / sqrtf(ss / D_MODEL + EPS);
        const float* g = p.norm_g + (l * 2 + 1) * D_MODEL; const float* sh = modp(p, l, (int)row, 3); const float* sc = modp(p, l, (int)row, 4);
        float lg[16];
#pragma unroll
        for (int e = 0; e < 16; ++e) lg[e] = 0.f;
        for (int k = 0; k < D_MODEL; ++k) { float hv = xr[k] * rstd * g[k] * (1.0f + sc[k]) + sh[k];
#pragma unroll
            for (int e = 0; e < 16; ++e) lg[e] += hv * p.w_router[k * 16 + e]; }
        int gbest = 0, a = 0, bb = 1; float gbs = -1e30f, wa = 0.f, wb = 0.f;
#pragma unroll
        for (int gI = 0; gI < 4; ++gI) {
            float m1 = -1e30f, m2 = -1e30f, s1 = 0.f, s2 = 0.f; int i1 = 0, i2 = 0;
#pragma unroll
            for (int j = 0; j < 4; ++j) { float sgv = sigmoid_f(lg[gI * 4 + j]); float v = sgv + p.b_router[gI * 4 + j];
                if (v > m1) { m2 = m1; i2 = i1; s2 = s1; m1 = v; i1 = j; s1 = sgv; } else if (v > m2) { m2 = v; i2 = j; s2 = sgv; } }
            float gs = m1 + m2;
            if (gs > gbs) { gbs = gs; gbest = gI; if (i1 < i2) { a = i1; bb = i2; wa = s1; wb = s2; } else { a = i2; bb = i1; wa = s2; wb = s1; } }
        }
        float inv = 1.0f / (wa + wb);
        int pidx = a == 0 ? bb - 1 : (a == 1 ? bb + 1 : 5);
        int pr = gbest * 6 + pidx;
        int pos = atomicAdd(p.cnt + l * 32 + pr, 1);
        p.list[(size_t)pr * TT + pos] = (int)row;
        p.tokw[row * 2 + 0] = wa * inv; p.tokw[row * 2 + 1] = wb * inv;
    }
}
HD void pair_experts(int pr, int& e1, int& e2) { int g = pr / 6, q = pr % 6; int a = q < 3 ? 0 : (q < 5 ? 1 : 2); int b = q < 3 ? q + 1 : (q < 5 ? q - 1 : 3); e1 = g * 4 + a; e2 = g * 4 + b; }
HD bool slot_lookup(const Params& p, int l, int slot, int& pr, int& row) { int acc = 0; for (int q = 0; q < NPAIR; ++q) { int c = p.cnt[l * 32 + q]; if (slot < acc + c) { pr = q; row = p.list[(size_t)q * TT + (slot - acc)]; return true; } acc += c; } return false; }
GLOBAL void nk_moe_up(Params p, int l, int nrows) {
    GS_LOOP(i, (long)nrows * HE_W) {
        int slot = i / HE_W, j = i % HE_W, k = j / D_EXPERT, jj = j % D_EXPERT; int pr, row; if (!slot_lookup(p, l, slot, pr, row)) continue;
        int e1, e2; pair_experts(pr, e1, e2); int e = k == 0 ? e1 : e2;
        const bf16_t* a = p.hbuf + (size_t)row * D_MODEL;
        const float* wg = p.moe_wg + (size_t)(l * N_EXPERTS + e) * D_MODEL * D_EXPERT; const float* wu = p.moe_wu + (size_t)(l * N_EXPERTS + e) * D_MODEL * D_EXPERT;
        float g = dot_row(a, wg, D_EXPERT, jj, D_MODEL), u = dot_row(a, wu, D_EXPERT, jj, D_MODEL);
        p.HE[(size_t)row * HE_W + j] = f2bf(p.tokw[row * 2 + k] * silu_f(g) * u);
    }
}
GLOBAL void nk_moe_down(Params p, int l, int nrows) {
    GS_LOOP(i, (long)nrows * D_MODEL) {
        int slot = i / D_MODEL, col = i % D_MODEL; int pr, row; if (!slot_lookup(p, l, slot, pr, row)) continue;
        int e1, e2; pair_experts(pr, e1, e2);
        const bf16_t* a = p.HE + (size_t)row * HE_W;
        float acc = dot_row(a, p.moe_wd + (size_t)(l * N_EXPERTS + e1) * D_EXPERT * D_MODEL, D_MODEL, col, D_EXPERT)
                  + dot_row(a + D_EXPERT, p.moe_wd + (size_t)(l * N_EXPERTS + e2) * D_EXPERT * D_MODEL, D_MODEL, col, D_EXPERT);
        float* xr = xrow_cur(p, row);
        xr[col] = xr[col] + modp(p, l, row, 5)[col] * acc;
    }
}

GLOBAL void nk_inproj_odd_qk(Params p) {
    GS_LOOP(i, (long)TT * 10) {
        int row = i / 10, hu = i % 10; const bf16_t* a = p.hbuf + (size_t)row * D_MODEL;
        bool lat = row < TX; int b = lat ? row / SEQ : (row - TX) / CTX_LEN; int s = lat ? row % SEQ : (row - TX) % CTX_LEN; int pos = lat ? CTX_LEN + s : s;
        int col0 = hu * 64;
        float v[64]; float ss = 0.f;
        for (int d = 0; d < 64; ++d) { v[d] = dot_row(a, p.w_in_odd, ODD_IN, col0 + d, D_MODEL); ss += v[d] * v[d]; }
        float rstd = 1.0f / sqrtf(ss / 64.0f + EPS);
        const float* gn = hu < 8 ? p.c_qnorm : p.c_knorm;
        for (int d = 0; d < 64; ++d) v[d] = v[d] * rstd * gn[d];
        for (int d = 0; d < 64; ++d) {
            float o = v[d];
            if (lat) { int pd = (d & 31) < 16 ? d + 16 : d - 16; o = rope_apply(p, v[d], v[pd], d, s); }
            if (hu < 8) p.QC[(size_t)row * 512 + col0 + d] = f2bf(o);
            else p.KC[((size_t)(b * 2 + (hu - 8)) * LKV + pos) * 64 + d] = f2bf(o);
        }
    }
}
GLOBAL void nk_inproj_odd_vu(Params p) {
    GS_LOOP(i, (long)TT * (ODD_IN - 640)) {
        int row = i / (ODD_IN - 640), col = 640 + i % (ODD_IN - 640); const bf16_t* a = p.hbuf + (size_t)row * D_MODEL;
        bool lat = row < TX; int b = lat ? row / SEQ : (row - TX) / CTX_LEN; int s = lat ? row % SEQ : (row - TX) % CTX_LEN; int pos = lat ? CTX_LEN + s : s;
        if (col >= 768 && !lat) continue;
        float v = dot_row(a, p.w_in_odd, ODD_IN, col, D_MODEL);
        if (col < 768) { int h = (col - 640) >> 6, d = col & 63; p.VCt[((size_t)(b * 2 + h) * 64 + d) * LKV + pos] = f2bf(v); }
        else p.UT[((size_t)b * 3 * D_CH + (col - 768)) * SEQ + s] = f2bf(v);
    }
}

HD float hy_sc(const Params& p, int b, int ch, int t) {
    const bf16_t* u = p.UT + ((size_t)b * 3 * D_CH + ch) * SEQ;
    float acc = p.hy_short_b[ch];
    for (int kk = 0; kk < 3; ++kk) { int tt = t + kk - 1; if (tt >= 0 && tt < SEQ) acc += p.hy_short_w[kk * 3 * D_CH + ch] * bf2f(u[tt]); }
    return acc;
}
GLOBAL void nk_hy_conv(Params p, int o) {
    GS_LOOP(i, (long)BATCH * D_CH * SEQ) {
        int n = i % SEQ, c = (i / SEQ) % D_CH, b = i / ((long)SEQ * D_CH);
        const float* hf = p.HFT + (size_t)((0 * 2 + o) * D_CH + c) * SEQ; const float* hb = p.HFT + (size_t)((1 * 2 + o) * D_CH + c) * SEQ;
        float inv = 1.0f / p.hnorm[o * D_CH + c];
        float acc = 0.f;
        for (int m = 0; m < SEQ; ++m) {
            float z = o == 0 ? hy_sc(p, b, c, m) : p.Z1[((size_t)b * D_CH + c) * SEQ + m];
            int d = n - m; float hv = d >= 0 ? hf[d] : hb[-d];
            acc += hv * z;
        }
        acc *= inv;
        float zn = o == 0 ? hy_sc(p, b, c, n) : p.Z1[((size_t)b * D_CH + c) * SEQ + n];
        float g = hy_sc(p, b, (o + 1) * D_CH + c, n);
        float r = g * (acc + zn * p.hy_bias[o * D_CH + c]);
        if (o == 0) p.Z1[i] = r; else p.YHT[i] = f2bf(r);
    }
}

GLOBAL void nk_final(Params p) {
    GS_LOOP(row, TX) {
        float* xr = p.out + (size_t)row * D_MODEL; float ss = 0.f;
        for (int k = 0; k < D_MODEL; ++k) ss += xr[k] * xr[k];
        float rstd = 1.0f / sqrtf(ss / D_MODEL + EPS);
        for (int k = 0; k < D_MODEL; ++k) xr[k] = xr[k] * rstd * p.final_g[k];
    }
}
GLOBAL void nk_yht_to_y(Params p) {
    GS_LOOP(i, (long)TX * D_CH) { int row = i / D_CH, c = i % D_CH, b = row / SEQ, s = row % SEQ; p.Y[(size_t)row * 1024 + 512 + c] = p.YHT[((size_t)b * D_CH + c) * SEQ + s]; }
}

GLOBAL void nk_rope(Params p) { d_rope(p); }
GLOBAL void nk_hy_h1(Params p) { d_hy_h1(p); }
GLOBAL void nk_hy_h2(Params p) { d_hy_h2(p); }
static inline size_t al256(size_t x) { return (x + 255) & ~(size_t)255; }
static size_t setup_ws(Params& p, char* ws) {
    size_t o = 0;
    auto take = [&](size_t bytes) { char* r = ws + o; o += al256(bytes); return r; };
    p.bar = (unsigned*)take(64 * 1024);
    p.cnt = (int*)take(256);
    p.XC = (float*)take((size_t)TC * D_MODEL * 4);
    p.mod = (float*)take((size_t)DEPTH * (BATCH + 1) * 6 * D_MODEL * 4);
    p.ropet = (float*)take(64 * 32 * 4);
    p.h1 = (float*)take((size_t)SEQ * 64 * 4);
    p.h2 = (float*)take((size_t)SEQ * 64 * 4);
    p.HFT = (float*)take((size_t)4 * D_CH * SEQ * 4);
    p.hnorm = (float*)take(2 * D_CH * 4);
    p.list = (int*)take((size_t)NPAIR * TT * 4);
    p.tokw = (float*)take((size_t)TT * 2 * 4);
    p.rpair = (int*)take((size_t)TT * 4);
    p.bh = (int*)take((size_t)2048 * 32 * 4);
    p.rlog = (float*)take((size_t)TT * 16 * 4);
    size_t hb = (size_t)TT * D_MODEL * 2, z1 = (size_t)BATCH * D_CH * SEQ * 4;
    char* r0 = take(hb > z1 ? hb : z1); p.hbuf = (bf16_t*)r0; p.Z1 = (float*)r0;
    size_t q = al256((size_t)TT * 512 * 2), kva = al256((size_t)BATCH * 2 * LKV * 64 * 2), kvb = al256((size_t)BATCH * 8 * LKV * 64 * 2), ut = al256((size_t)BATCH * 3 * D_CH * SEQ * 2);
    size_t l0 = 2 * q + 2 * kva + 2 * kvb, l1 = q + 2 * kva + ut;
    char* R = take(l0 > l1 ? l0 : l1);
    p.QA = (bf16_t*)R; p.KA = (bf16_t*)(R + q); p.VAt = (bf16_t*)(R + q + kva); p.QB = (bf16_t*)(R + q + 2 * kva); p.KB = (bf16_t*)(R + 2 * q + 2 * kva); p.VBt = (bf16_t*)(R + 2 * q + 2 * kva + kvb);
    p.QC = (bf16_t*)R; p.KC = (bf16_t*)(R + q); p.VCt = (bf16_t*)(R + q + kva); p.UT = (bf16_t*)(R + q + 2 * kva);
    size_t yb = (size_t)TT * 1024 * 2, heb = (size_t)TT * HE_W * 2;
    char* r1 = take(yb > heb ? yb : heb); p.Y = (bf16_t*)r1; p.HE = (bf16_t*)r1;
    p.YHT = (bf16_t*)take((size_t)BATCH * D_CH * SEQ * 2);
    p.Wt_in_even = (bf16_t*)take((size_t)EVEN_IN * D_MODEL * 2);
    p.Wt_out_even = (bf16_t*)take((size_t)D_MODEL * EVEN_OUT * 2);
    p.Wt_in_odd = (bf16_t*)take((size_t)ODD_IN * D_MODEL * 2);
    p.Wt_out_odd = (bf16_t*)take((size_t)D_MODEL * ODD_OUT * 2);
    p.Wt_gu = (bf16_t*)take((size_t)DEPTH * N_EXPERTS * 2 * D_EXPERT * D_MODEL * 2);
    p.Wt_d = (bf16_t*)take((size_t)DEPTH * N_EXPERTS * D_MODEL * D_EXPERT * 2);
    return o;
}
static void fill_inputs(Params& p, void* const* d_in, void* d_out) {
    const float** f = (const float**)&p.x;
    for (int i = 0; i < 32; ++i) f[i] = (const float*)d_in[i];
    p.out = (float*)d_out;
}
#define LAS __attribute__((address_space(3)))
typedef short bf16x8 __attribute__((ext_vector_type(8)));
typedef float f32x4 __attribute__((ext_vector_type(4)));
typedef float f32x16 __attribute__((ext_vector_type(16)));
typedef unsigned u32x4 __attribute__((ext_vector_type(4)));
typedef unsigned u32x2 __attribute__((ext_vector_type(2)));

constexpr int NTHREADS = 256;
constexpr int LDS_BYTES = 69632;
constexpr int MT_ALL = TT / 128, MT_LAT = TX / 128;

__device__ __forceinline__ unsigned pk2bf(float lo, float hi) { return (unsigned)f2bf(lo) | ((unsigned)f2bf(hi) << 16); }
__device__ __forceinline__ float wave_sum(float v) {
#pragma unroll
    for (int o = 1; o < 64; o <<= 1) v += __shfl_xor(v, o);
    return v;
}

template <class DstF>
__device__ __forceinline__ void cvt_block_item(char* lds, const float* W, int N, int k0, int n0, const DstF& dst) {
    float* T = (float*)lds; const int tid = threadIdx.x;
    f32x4 v[16];
#pragma unroll
    for (int i = 0; i < 16; ++i) v[i] = *(const f32x4*)(W + (size_t)(k0 + (tid >> 6) + 4 * i) * N + n0 + 4 * (tid & 63));
#pragma unroll
    for (int i = 0; i < 16; ++i) *(f32x4*)(T + ((tid >> 6) + 4 * i) * 260 + 4 * (tid & 63)) = v[i];
    __syncthreads();
    bf16_t* d = dst(n0 + tid) + k0; const float* s = T + tid;
#pragma unroll
    for (int c = 0; c < 8; ++c) { u32x4 w; w.x = pk2bf(s[(8 * c + 0) * 260], s[(8 * c + 1) * 260]); w.y = pk2bf(s[(8 * c + 2) * 260], s[(8 * c + 3) * 260]);
        w.z = pk2bf(s[(8 * c + 4) * 260], s[(8 * c + 5) * 260]); w.w = pk2bf(s[(8 * c + 6) * 260], s[(8 * c + 7) * 260]); *(u32x4*)(d + 8 * c) = w; }
    __syncthreads();
}
__device__ __forceinline__ void cvt_plain(char* lds, const float* W, bf16_t* Wt, int K, int N, int item) {
    const int nb = N / 256, kb = item / nb, nbi = item % nb;
    cvt_block_item(lds, W, N, kb * 64, nbi * 256, [&](int n) { return Wt + (size_t)n * K; });
}
constexpr int CVT_IN = (D_MODEL / 64) * (EVEN_IN / 256), CVT_OUT = (D_MODEL / 64) * (D_MODEL / 256), CVT_GU1 = (D_MODEL / 64) * (D_EXPERT / 256), CVT_D1 = (D_EXPERT / 64) * (D_MODEL / 256);
constexpr int CVT_GU = DEPTH * N_EXPERTS * 2 * CVT_GU1, CVT_D = DEPTH * N_EXPERTS * CVT_D1;
constexpr int CVT_TOTAL = 2 * CVT_IN + 2 * CVT_OUT + CVT_GU + CVT_D;
constexpr int CVT_EARLY = 2 * CVT_IN + 2 * CVT_OUT;
static_assert(EVEN_IN % 256 == 0 && ODD_IN % 256 == 0 && D_EXPERT % 256 == 0, "conversion tile");
__device__ __forceinline__ void cvt_item(const Params& p, char* lds, int it) {
    if (it < CVT_IN) { cvt_plain(lds, p.w_in_even, p.Wt_in_even, D_MODEL, EVEN_IN, it); return; } it -= CVT_IN;
    if (it < CVT_IN) { cvt_plain(lds, p.w_in_odd, p.Wt_in_odd, D_MODEL, ODD_IN, it); return; } it -= CVT_IN;
    if (it < CVT_OUT) { cvt_plain(lds, p.w_out_even, p.Wt_out_even, EVEN_OUT, D_MODEL, it); return; } it -= CVT_OUT;
    if (it < CVT_OUT) { cvt_plain(lds, p.w_out_odd, p.Wt_out_odd, ODD_OUT, D_MODEL, it); return; } it -= CVT_OUT;
    if (it < CVT_GU) {
        const int le = it / (2 * CVT_GU1), r = it % (2 * CVT_GU1), half = r / CVT_GU1, r2 = r % CVT_GU1; const int nb = D_EXPERT / 256, kb = r2 / nb, nbi = r2 % nb;
        const float* W = (half ? p.moe_wu : p.moe_wg) + (size_t)le * D_MODEL * D_EXPERT; bf16_t* Wt = p.Wt_gu + (size_t)le * 2 * D_EXPERT * D_MODEL;
        cvt_block_item(lds, W, D_EXPERT, kb * 64, nbi * 256, [&](int n) { return Wt + (size_t)(32 * (n >> 4) + 16 * half + (n & 15)) * D_MODEL; });
        return; } it -= CVT_GU;
    { const int le = it / CVT_D1, r = it % CVT_D1; cvt_plain(lds, p.moe_wd + (size_t)le * D_EXPERT * D_MODEL, p.Wt_d + (size_t)le * D_MODEL * D_EXPERT, D_EXPERT, D_MODEL, r); }
}
__device__ __forceinline__ void cvt_range(const Params& p, char* lds, int lo, int hi, int bid, int nb) {
    for (int it = lo + bid; it < hi; it += nb) cvt_item(p, lds, it);
}

struct TileGeom { int tid, lane, wid, wr, wc, l15, q, srow, schunk;
    __device__ __forceinline__ int drow(int i) const { return wid * 32 + i * 8 + (lane >> 3); }
    __device__ __forceinline__ int dchunk(int i) const { return (lane & 7) ^ (((lane >> 4) + 4 * i) & 7); } };
__device__ __forceinline__ TileGeom tile_geom() { TileGeom g; g.tid = threadIdx.x; g.lane = g.tid & 63; g.wid = __builtin_amdgcn_readfirstlane(g.tid >> 6); g.wr = g.wid >> 1; g.wc = g.wid & 1; g.l15 = g.lane & 15; g.q = g.lane >> 4; g.srow = g.tid >> 3; g.schunk = g.tid & 7; return g; }

template <class ALoad, class BLoad>
__device__ __forceinline__ void gemm_mainloop(char* lds, const TileGeom& g, int nk, const ALoad& AL, const BLoad& BL, f32x4 (&acc)[4][4]) {
#pragma unroll
    for (int i = 0; i < 4; ++i)
#pragma unroll
        for (int j = 0; j < 4; ++j) acc[i][j] = (f32x4){0.f, 0.f, 0.f, 0.f};
    const int swz = g.l15 >> 1;
    const int aofs = (g.wr * 64 + g.l15) * 128 + ((g.q ^ swz) << 4);
    const int bofs = 32768 + (g.wc * 64 + g.l15) * 128 + ((g.q ^ swz) << 4);
    LAS char* l3 = (LAS char*)lds;
    const int dbase = g.wid * 4096;
#define GEMM_STAGE(kt_, buf_) do { _Pragma("unroll") for (int i_ = 0; i_ < 4; ++i_) { \
        __builtin_amdgcn_global_load_lds((const unsigned*)AL(i_, (kt_)), (LAS unsigned*)(l3 + (buf_) + dbase + i_ * 1024), 16, 0, 0); \
        __builtin_amdgcn_global_load_lds((const unsigned*)BL(i_, (kt_)), (LAS unsigned*)(l3 + 32768 + (buf_) + dbase + i_ * 1024), 16, 0, 0); } } while (0)
#define GEMM_BAR() do { __builtin_amdgcn_s_barrier(); asm volatile("" ::: "memory"); } while (0)
    GEMM_STAGE(0, 0);
    if (nk > 1) GEMM_STAGE(1, 16384);
    asm volatile("s_waitcnt vmcnt(0) lgkmcnt(0)" ::: "memory");
    GEMM_BAR();
    for (int kt = 0; kt < nk; ++kt) {
        const int cur = (kt & 1) * 16384;
        bf16x8 af[2][4], bfr[2][4];
#pragma unroll
        for (int kk = 0; kk < 2; ++kk)
#pragma unroll
            for (int i = 0; i < 4; ++i) { af[kk][i] = *(const bf16x8*)(lds + cur + ((aofs + i * 2048) ^ (kk * 64))); bfr[kk][i] = *(const bf16x8*)(lds + cur + ((bofs + i * 2048) ^ (kk * 64))); }
        asm volatile("s_waitcnt lgkmcnt(0)" ::: "memory");
        GEMM_BAR();
        if (kt + 2 < nk) GEMM_STAGE(kt + 2, cur);
#pragma unroll
        for (int kk = 0; kk < 2; ++kk)
#pragma unroll
            for (int mi = 0; mi < 4; ++mi)
#pragma unroll
                for (int ni = 0; ni < 4; ++ni) acc[mi][ni] = __builtin_amdgcn_mfma_f32_16x16x32_bf16(bfr[kk][ni], af[kk][mi], acc[mi][ni], 0, 0, 0);
        if (kt + 1 < nk) {
            if (kt + 2 < nk) asm volatile("s_waitcnt vmcnt(8)" ::: "memory"); else asm volatile("s_waitcnt vmcnt(0)" ::: "memory");
            GEMM_BAR();
        }
    }
#undef GEMM_STAGE
#undef GEMM_BAR
}

template <class DstF>
__device__ __forceinline__ void store_transposed(char* lds, const TileGeom& g, const f32x4 (&acc)[4][4], const DstF& dst) {
    bf16_t* T = (bf16_t*)lds;
#pragma unroll
    for (int mi = 0; mi < 4; ++mi)
#pragma unroll
        for (int ni = 0; ni < 4; ++ni)
#pragma unroll
            for (int r = 0; r < 4; ++r) T[(g.wc * 64 + ni * 16 + g.q * 4 + r) * 136 + g.wr * 64 + mi * 16 + g.l15] = f2bf(acc[mi][ni][r]);
    __syncthreads();
    { int col = g.tid >> 1, half = g.tid & 1; bf16_t* d = dst(col) + half * 64; const bf16_t* s = T + col * 136 + half * 64;
#pragma unroll
      for (int j = 0; j < 8; ++j) *(u32x4*)(d + j * 8) = *(const u32x4*)(s + j * 8); }
    __syncthreads();
}
__device__ __forceinline__ void store4bf(bf16_t* d, const f32x4& v) { u32x2 w; w.x = pk2bf(v[0], v[1]); w.y = pk2bf(v[2], v[3]); *(u32x2*)d = w; }
__device__ __forceinline__ void rope_head(const Params& p, f32x4 (&a)[4], int s, int q) {
    const int pr = s / GRID_W, pc = s % GRID_W;
    const f32x4 cr = *(const f32x4*)(p.ropet + pr * 32 + q * 4), sr = *(const f32x4*)(p.ropet + pr * 32 + 16 + q * 4);
    const f32x4 cc = *(const f32x4*)(p.ropet + pc * 32 + q * 4), sc = *(const f32x4*)(p.ropet + pc * 32 + 16 + q * 4);
    f32x4 x1 = a[0], x2 = a[1]; a[0] = x1 * cr - x2 * sr; a[1] = x2 * cr + x1 * sr;
    x1 = a[2]; x2 = a[3]; a[2] = x1 * cc - x2 * sc; a[3] = x2 * cc + x1 * sc;
}

template <int LAYER>
__device__ __forceinline__ void inproj_tile(const Params& p, char* lds, int mt, int nt) {
    const TileGeom g = tile_geom();
    const bf16_t* Abase = p.hbuf + (size_t)(mt * 128) * D_MODEL;
    const bf16_t* Bbase = (LAYER == 0 ? p.Wt_in_even : p.Wt_in_odd) + (size_t)(nt * 128) * D_MODEL;
    f32x4 acc[4][4];
    gemm_mainloop(lds, g, D_MODEL / 64, [&](int i, int kt) { return Abase + (size_t)g.drow(i) * D_MODEL + kt * 64 + g.dchunk(i) * 8; }, [&](int i, int kt) { return Bbase + (size_t)g.drow(i) * D_MODEL + kt * 64 + g.dchunk(i) * 8; }, acc);
    const bool lat = mt < MT_LAT; const int row0 = mt * 128;
    const int b = lat ? row0 / SEQ : (row0 - TX) / CTX_LEN, s0 = lat ? row0 % SEQ : (row0 - TX) % CTX_LEN, pos0 = lat ? CTX_LEN + s0 : s0;
    int kind;
    bf16_t* base; int h0 = 0, qcol0 = 0, nh = 2;
    if (LAYER == 0) {
        if (nt < 4) { kind = 0; base = p.QA; qcol0 = nt * 128; }
        else if (nt == 4) { kind = 1; base = p.KA; h0 = 0; nh = 2; }
        else if (nt == 5) { kind = 2; base = p.VAt; h0 = 0; nh = 2; }
        else if (nt < 10) { kind = 0; base = p.QB; qcol0 = (nt - 6) * 128; }
        else if (nt < 14) { kind = 1; base = p.KB; h0 = (nt - 10) * 2; nh = 8; }
        else { kind = 2; base = p.VBt; h0 = (nt - 14) * 2; nh = 8; }
    } else {
        if (nt < 4) { kind = 0; base = p.QC; qcol0 = nt * 128; }
        else if (nt == 4) { kind = 1; base = p.KC; h0 = 0; nh = 2; }
        else if (nt == 5) { kind = 2; base = p.VCt; h0 = 0; nh = 2; }
        else { kind = 3; base = p.UT; }
    }
    if (kind <= 1) {
        const bool rope = lat && (LAYER == 1 || nt <= 4);
#pragma unroll
        for (int mi = 0; mi < 4; ++mi) {
            const int rowl = g.wr * 64 + mi * 16 + g.l15;
            if (LAYER == 1) {
                float ss = 0.f;
#pragma unroll
                for (int ni = 0; ni < 4; ++ni) ss += acc[mi][ni][0] * acc[mi][ni][0] + acc[mi][ni][1] * acc[mi][ni][1] + acc[mi][ni][2] * acc[mi][ni][2] + acc[mi][ni][3] * acc[mi][ni][3];
                ss += __shfl_xor(ss, 16); ss += __shfl_xor(ss, 32);
                const float rstd = 1.0f / sqrtf(ss * (1.0f / 64.0f) + EPS);
                const float* gn = kind == 0 ? p.c_qnorm : p.c_knorm;
#pragma unroll
                for (int ni = 0; ni < 4; ++ni) acc[mi][ni] = acc[mi][ni] * rstd * *(const f32x4*)(gn + ni * 16 + g.q * 4);
            }
            if (rope) rope_head(p, acc[mi], s0 + rowl, g.q);
            bf16_t* d = kind == 0 ? base + (size_t)(row0 + rowl) * 512 + qcol0 + g.wc * 64 + g.q * 4
                                  : base + ((size_t)(b * nh + h0 + g.wc) * LKV + pos0 + rowl) * 64 + g.q * 4;
#pragma unroll
            for (int ni = 0; ni < 4; ++ni) store4bf(d + ni * 16, acc[mi][ni]);
        }
    } else if (kind == 2) {
        store_transposed(lds, g, acc, [&](int col) { return base + ((size_t)(b * nh + h0 + (col >> 6)) * 64 + (col & 63)) * LKV + pos0; });
    } else {
        store_transposed(lds, g, acc, [&](int col) { return base + ((size_t)b * 3 * D_CH + (nt - 6) * 128 + col) * SEQ + s0; });
    }
}
template <int LAYER>
__device__ __forceinline__ void ph_inproj(const Params& p, char* lds, int bid, int nb) {
    constexpr int NT = 18;
    const bool xl = (nb & 7) == 0; const int x = xl ? bid & 7 : 0, step = xl ? nb >> 3 : nb, mstep = xl ? 8 : 1;
    if (LAYER == 0) {
        for (int t = xl ? bid >> 3 : bid; ; t += step) { const int mt = (t / NT) * mstep + x, nt = t % NT; if (mt >= MT_ALL) break; inproj_tile<0>(p, lds, mt, nt); }
    } else {
        const int nlat_t = (MT_LAT / mstep) * NT;
        for (int t = xl ? bid >> 3 : bid; ; t += step) {
            int mt, nt;
            if (t < nlat_t) { mt = (t / NT) * mstep + x; nt = t % NT; }
            else { const int u = t - nlat_t; mt = MT_LAT + (u / 2) * mstep + x; nt = 4 + u % 2; if (mt >= MT_ALL) break; }
            inproj_tile<1>(p, lds, mt, nt);
        }
    }
}

template <int LAYER>
__device__ __forceinline__ void outproj_tile(const Params& p, char* lds, int mt, int nt) {
    const TileGeom g = tile_geom();
    const bf16_t* Abase = p.Y + (size_t)(mt * 128) * 1024;
    const bf16_t* Bbase = (LAYER == 0 ? p.Wt_out_even : p.Wt_out_odd) + (size_t)(nt * 128) * 1024;
    f32x4 acc[4][4];
    gemm_mainloop(lds, g, 16, [&](int i, int kt) { return Abase + (size_t)g.drow(i) * 1024 + kt * 64 + g.dchunk(i) * 8; }, [&](int i, int kt) { return Bbase + (size_t)g.drow(i) * 1024 + kt * 64 + g.dchunk(i) * 8; }, acc);
    const int row0 = mt * 128;
#pragma unroll
    for (int mi = 0; mi < 4; ++mi) {
        const int row = row0 + g.wr * 64 + mi * 16 + g.l15;
        const float* xin = xrow_in(p, LAYER, row); float* xo = xrow_cur(p, row); const float* gate = modp(p, LAYER, row, 2);
#pragma unroll
        for (int ni = 0; ni < 4; ++ni) { const int col = nt * 128 + g.wc * 64 + ni * 16 + g.q * 4;
            *(f32x4*)(xo + col) = *(const f32x4*)(xin + col) + *(const f32x4*)(gate + col) * acc[mi][ni]; }
    }
}

template <int LAYER>
__device__ __forceinline__ void ph_outproj(const Params& p, char* lds, int bid, int nb) {
    const int nmt = LAYER == 0 ? MT_ALL : MT_LAT;
    const bool xl = (nb & 7) == 0; const int x = xl ? bid & 7 : 0, step = xl ? nb >> 3 : nb, mstep = xl ? 8 : 1;
    for (int t = xl ? bid >> 3 : bid; ; t += step) { const int mt = (t / 8) * mstep + x, nt = t % 8; if (mt >= nmt) break; outproj_tile<LAYER>(p, lds, mt, nt); }
}

template <int NTN>
__device__ __forceinline__ bool moe_tile_lookup(const int* cnt, int t, int& pr, int& mt, int& nt, int& n) {
    int acc = 0;
    for (int q = 0; q < NPAIR; ++q) { const int c = __builtin_amdgcn_readfirstlane(cnt[q]); const int tiles = ((c + 127) >> 7) * NTN; if (t < acc + tiles) { pr = q; const int u = t - acc; mt = u / NTN; nt = u % NTN; n = c; return true; } acc += tiles; }
    return false;
}
template <int NTN>
__device__ __forceinline__ bool moe_tile_lookup_xcd(const int* cnt, int xcd, int t, int& pr, int& mt, int& nt, int& n) {
    int acc = 0;
#pragma unroll
    for (int i = 0; i < NPAIR / 8; ++i) { const int q = xcd + 8 * i; const int c = __builtin_amdgcn_readfirstlane(cnt[q]); const int tiles = ((c + 127) >> 7) * NTN;
        if (t < acc + tiles) { pr = q; const int u = t - acc; mt = u / NTN; nt = u % NTN; n = c; return true; } acc += tiles; }
    return false;
}
__device__ __forceinline__ void moe_up_tile(const Params& p, char* lds, int l, int pr, int mt, int nt, int n) {
    const TileGeom g = tile_geom();
    int e1, e2; pair_experts(pr, e1, e2); const int k = nt >> 3, e = k ? e2 : e1;
    const int* lst = p.list + (size_t)pr * TT + mt * 128;
    const int navail = n - mt * 128;
    const bf16_t* arow[4];
#pragma unroll
    for (int i = 0; i < 4; ++i) { int r = g.drow(i); if (r >= navail) r = navail - 1; arow[i] = p.hbuf + (size_t)lst[r] * D_MODEL + g.dchunk(i) * 8; }
    const bf16_t* Bbase = p.Wt_gu + ((size_t)(l * N_EXPERTS + e) * 2 * D_EXPERT + (nt & 7) * 128) * D_MODEL;
    f32x4 acc[4][4];
    gemm_mainloop(lds, g, D_MODEL / 64, [&](int i, int kt) { return arow[i] + kt * 64; }, [&](int i, int kt) { return Bbase + (size_t)g.drow(i) * D_MODEL + kt * 64 + g.dchunk(i) * 8; }, acc);
#pragma unroll
    for (int mi = 0; mi < 4; ++mi) {
        const int rl = g.wr * 64 + mi * 16 + g.l15;
        if (rl < navail) {
            const int row = lst[rl]; const float w = p.tokw[row * 2 + k];
            bf16_t* d = p.HE + (size_t)row * HE_W + k * D_EXPERT + (nt & 7) * 64 + g.wc * 32 + g.q * 4;
#pragma unroll
            for (int h2 = 0; h2 < 2; ++h2) { f32x4 gg = acc[mi][2 * h2], uu = acc[mi][2 * h2 + 1], o;
#pragma unroll
                for (int r = 0; r < 4; ++r) o[r] = w * (gg[r] / (1.0f + __expf(-gg[r]))) * uu[r];
                store4bf(d + h2 * 16, o); }
        }
    }
}
template <bool DUMMY = false>
__device__ __forceinline__ void moe_down_tile(const Params& p, char* lds, int l, int pr, int mt, int nt, int n) {
    const TileGeom g = tile_geom();
    int e1, e2; pair_experts(pr, e1, e2);
    const int* lst = p.list + (size_t)pr * TT + mt * 128;
    const int navail = n - mt * 128;
    const bf16_t* arow[4];
#pragma unroll
    for (int i = 0; i < 4; ++i) { int r = g.drow(i); if (r >= navail) r = navail - 1; arow[i] = p.HE + (size_t)lst[r] * HE_W + g.dchunk(i) * 8; }
    const bf16_t* B1 = p.Wt_d + ((size_t)(l * N_EXPERTS + e1) * D_MODEL + nt * 128) * D_EXPERT;
    const bf16_t* B2 = p.Wt_d + ((size_t)(l * N_EXPERTS + e2) * D_MODEL + nt * 128) * D_EXPERT;
    constexpr int KT1 = D_EXPERT / 64;
    f32x4 acc[4][4];
    gemm_mainloop(lds, g, HE_W / 64, [&](int i, int kt) { return arow[i] + kt * 64; },
                  [&](int i, int kt) { return (kt < KT1 ? B1 + kt * 64 : B2 + (kt - KT1) * 64) + (size_t)g.drow(i) * D_EXPERT + g.dchunk(i) * 8; }, acc);
#pragma unroll
    for (int mi = 0; mi < 4; ++mi) {
        const int rl = g.wr * 64 + mi * 16 + g.l15;
        if (rl < navail) {
            const int row = lst[rl]; float* xo = xrow_cur(p, row); const float* gate = modp(p, l, row, 5);
#pragma unroll
            for (int ni = 0; ni < 4; ++ni) { const int col = nt * 128 + g.wc * 64 + ni * 16 + g.q * 4; float* dst = DUMMY ? (float*)p.QA + (size_t)row * D_MODEL : xo; *(f32x4*)(dst + col) = *(const f32x4*)(xo + col) + *(const f32x4*)(gate + col) * acc[mi][ni]; }
        }
    }
}
__device__ __forceinline__ void ph_moe_up(const Params& p, char* lds, int l, int bid, int nb) {
    int pr, mt, nt, n; const bool xl = (nb & 7) == 0;
    for (int t = xl ? bid >> 3 : bid; xl ? moe_tile_lookup_xcd<16>(p.cnt + l * 32, bid & 7, t, pr, mt, nt, n) : moe_tile_lookup<16>(p.cnt + l * 32, t, pr, mt, nt, n); t += xl ? nb >> 3 : nb) moe_up_tile(p, lds, l, pr, mt, nt, n);
}
template <bool DUMMY = false>
__device__ __forceinline__ void ph_moe_down(const Params& p, char* lds, int l, int bid, int nb) {
    int pr, mt, nt, n; const bool xl = (nb & 7) == 0;
    for (int t = xl ? bid >> 3 : bid; xl ? moe_tile_lookup_xcd<8>(p.cnt + l * 32, bid & 7, t, pr, mt, nt, n) : moe_tile_lookup<8>(p.cnt + l * 32, t, pr, mt, nt, n); t += xl ? nb >> 3 : nb) moe_down_tile<DUMMY>(p, lds, l, pr, mt, nt, n);
}
typedef float f32x2 __attribute__((ext_vector_type(2)));
typedef __bf16 bf16x2_t __attribute__((ext_vector_type(2)));
__device__ __forceinline__ unsigned cvtpk(float lo, float hi) { f32x2 v = {lo, hi}; bf16x2_t b = __builtin_convertvector(v, bf16x2_t); return __builtin_bit_cast(unsigned, b); }
__device__ __forceinline__ int crow(int r, int hi) { return (r & 3) + 8 * (r >> 2) + 4 * hi; }
constexpr float LOG2E = 1.4426950408889634f;
constexpr float QK_C = ATTN_SCALE * LOG2E;
constexpr float NEG_BIG = -1e30f;

__device__ __forceinline__ float max3f(float a, float b, float c) { float r; asm("v_max3_f32 %0, %1, %2, %3" : "=v"(r) : "v"(a), "v"(b), "v"(c)); return r; }
constexpr float ATT_THR = 8.0f;
template <int MODE>
__device__ __forceinline__ void attn_unit(char* lds, const bf16_t* Qp, const bf16_t* Kp, const bf16_t* Vt, bf16_t* Op, int s0, int nctx, int lt0, int nlat, float sink2, bool has_sink, const float* rpb_h) {
    int tid_ = threadIdx.x; asm volatile("" : "+v"(tid_));
    const int tid = tid_, lane = tid & 63, wid = __builtin_amdgcn_readfirstlane(tid >> 6), l31 = lane & 31, hi = lane >> 5;
    float* bias_s = (float*)(lds + 65536);
    if (MODE == 2) { for (int i = tid; i < 15 * 31; i += NTHREADS) bias_s[i] = rpb_h[i] * LOG2E; }
    const int ntiles = nctx + nlat;
    LAS char* l3 = (LAS char*)lds;
    const int drow0 = wid * 16 + (lane >> 3);
    const int dch0 = (lane & 7) ^ (((lane >> 4) + 0) & 7), dch1 = (lane & 7) ^ (((lane >> 4) + 4) & 7);
    const bf16_t* ksrc0 = Kp + (size_t)drow0 * 64 + dch0 * 8; const bf16_t* ksrc1 = Kp + (size_t)(drow0 + 8) * 64 + dch1 * 8;
    const bf16_t* vsrc0 = Vt + (size_t)drow0 * LKV + dch0 * 8; const bf16_t* vsrc1 = Vt + (size_t)(drow0 + 8) * LKV + dch1 * 8;
    const int ddst = wid * 2048;
    auto tile_pos = [&](int j) { return j < nctx ? 64 * j : CTX_LEN + 64 * (lt0 + j - nctx); };
#define ATT_DMA(j_, slot_) do { const int pos_ = tile_pos(j_); \
        __builtin_amdgcn_global_load_lds((const unsigned*)(ksrc0 + (size_t)pos_ * 64), (LAS unsigned*)(l3 + (slot_) * 8192 + ddst), 16, 0, 0); \
        __builtin_amdgcn_global_load_lds((const unsigned*)(ksrc1 + (size_t)pos_ * 64), (LAS unsigned*)(l3 + (slot_) * 8192 + ddst + 1024), 16, 0, 0); \
        __builtin_amdgcn_global_load_lds((const unsigned*)(vsrc0 + pos_), (LAS unsigned*)(l3 + 32768 + (slot_) * 8192 + ddst), 16, 0, 0); \
        __builtin_amdgcn_global_load_lds((const unsigned*)(vsrc1 + pos_), (LAS unsigned*)(l3 + 32768 + (slot_) * 8192 + ddst + 1024), 16, 0, 0); } while (0)
    const int x = (l31 >> 1) & 7;
    const int kofs = l31 * 128 + ((hi ^ x) << 4);
    const int vofs = 32768 + l31 * 128 + (x << 4) + 8 * hi;
    bf16x8 qf[4];
    { const bf16_t* qr = Qp + (size_t)(wid * 32 + l31) * 512 + hi * 8;
#pragma unroll
      for (int s = 0; s < 4; ++s) { const u32x4 raw = *(const u32x4*)(qr + s * 16); u32x4 sc;
#pragma unroll
          for (int e = 0; e < 4; ++e) { const float lo = __builtin_bit_cast(float, raw[e] << 16) * QK_C, hi2 = __builtin_bit_cast(float, raw[e] & 0xffff0000u) * QK_C; sc[e] = cvtpk(lo, hi2); }
          qf[s] = __builtin_bit_cast(bf16x8, sc); } }
#define ATT_WAIT(need_, last_) do { const int lastt_ = (last_) < ntiles - 1 ? (last_) : ntiles - 1; const int ahead_ = lastt_ - (need_); \
        if (ahead_ >= 2) asm volatile("s_waitcnt vmcnt(8) lgkmcnt(0)" ::: "memory"); else if (ahead_ == 1) asm volatile("s_waitcnt vmcnt(4) lgkmcnt(0)" ::: "memory"); \
        else asm volatile("s_waitcnt vmcnt(0) lgkmcnt(0)" ::: "memory"); } while (0)
    ATT_DMA(0, 0);
    if (ntiles > 1) ATT_DMA(1, 1);
    if (ntiles > 2) ATT_DMA(2, 2);
    f32x16 o0 = {}, o1 = {};
    f32x16 negm = {};
    float mref = 0.f, l = 0.f;
    const int sq = s0 + wid * 32 + l31;
    int rq = 0, cq = 0, rsq = 0, csq = 0;
    if (MODE == 2) { rq = sq / GRID_W; cq = sq % GRID_W; rsq = rq - B_WIN_H / 2; rsq = rsq < 0 ? 0 : (rsq > GRID_H - B_WIN_H ? GRID_H - B_WIN_H : rsq); csq = cq - B_WIN_W / 2; csq = csq < 0 ? 0 : (csq > GRID_W - B_WIN_W ? GRID_W - B_WIN_W : csq); }
    ATT_WAIT(0, 2);
    __builtin_amdgcn_s_barrier(); asm volatile("" ::: "memory");
    int slot = 0;
    for (int j = 0; j < ntiles; ++j) {
        const int slot1 = (slot + 1) & 3, slot3 = (slot + 3) & 3;
        if (j + 3 < ntiles) ATT_DMA(j + 3, slot3);
        const char* Kb = lds + slot * 8192; const char* Vb = lds + slot * 8192;
        f32x16 p0, p1;
#pragma unroll
        for (int s = 0; s < 4; ++s) {
            const bf16x8 k0 = *(const bf16x8*)(Kb + (kofs ^ (s << 5))); const bf16x8 k1 = *(const bf16x8*)(Kb + 4096 + (kofs ^ (s << 5)));
            if (s == 0) { p0 = __builtin_amdgcn_mfma_f32_32x32x16_bf16(k0, qf[0], negm, 0, 0, 0); p1 = __builtin_amdgcn_mfma_f32_32x32x16_bf16(k1, qf[0], negm, 0, 0, 0); }
            else { p0 = __builtin_amdgcn_mfma_f32_32x32x16_bf16(k0, qf[s], p0, 0, 0, 0); p1 = __builtin_amdgcn_mfma_f32_32x32x16_bf16(k1, qf[s], p1, 0, 0, 0); }
        }
        asm volatile("s_nop 15\n\ts_nop 7" : "+v"(p0), "+v"(p1));
        if (MODE == 1 && j >= nctx) {
            const int sk0 = 64 * (lt0 + j - nctx);
#pragma unroll
            for (int r = 0; r < 16; ++r) { const int d0 = sk0 + crow(r, hi) - sq, d1 = d0 + 32;
                p0[r] = (d0 >= -A_WINDOW && d0 <= A_WINDOW) ? p0[r] : NEG_BIG; p1[r] = (d1 >= -A_WINDOW && d1 <= A_WINDOW) ? p1[r] : NEG_BIG; }
        } else if (MODE == 2 && j >= nctx) {
            const int kr = lt0 + j - nctx; const bool rowok = kr >= rsq && kr < rsq + B_WIN_H;
            const float* brow = bias_s + (kr - rq + B_WIN_H - 1) * 31 + (B_WIN_W - 1) - cq;
#pragma unroll
            for (int r = 0; r < 16; ++r) { const int kc0 = crow(r, hi), kc1 = kc0 + 32;
                const bool ok0 = rowok && kc0 >= csq && kc0 < csq + B_WIN_W, ok1 = rowok && kc1 >= csq && kc1 < csq + B_WIN_W;
                p0[r] = ok0 ? p0[r] + brow[kc0] : NEG_BIG; p1[r] = ok1 ? p1[r] + brow[kc1] : NEG_BIG; }
        }
        float ta = max3f(p0[0], p0[1], p1[0]), tb = max3f(p0[2], p0[3], p1[1]); ta = max3f(ta, p1[2], p1[3]);
#pragma unroll
        for (int r = 4; r < 16; r += 4) { ta = max3f(ta, p0[r], p0[r + 1]); tb = max3f(tb, p0[r + 2], p0[r + 3]); ta = max3f(ta, p1[r], p1[r + 1]); tb = max3f(tb, p1[r + 2], p1[r + 3]); }
        float tmax = fmaxf(ta, tb); tmax = fmaxf(tmax, __shfl_xor(tmax, 32));
        if (j == 0 || __any(tmax > ATT_THR)) {
            const float dl = j == 0 ? tmax : fmaxf(tmax, 0.f);
            mref += dl;
#pragma unroll
            for (int r = 0; r < 16; ++r) { p0[r] -= dl; p1[r] -= dl; negm[r] = -mref; }
            if (j > 0) { const float f = __builtin_amdgcn_exp2f(-dl); l *= f;
#pragma unroll
                for (int r = 0; r < 16; ++r) { o0[r] *= f; o1[r] *= f; } }
        }
        f32x2 lsum = {0.f, 0.f};
#pragma unroll
        for (int r = 0; r < 16; r += 2) { p0[r] = __builtin_amdgcn_exp2f(p0[r]); p0[r + 1] = __builtin_amdgcn_exp2f(p0[r + 1]); p1[r] = __builtin_amdgcn_exp2f(p1[r]); p1[r + 1] = __builtin_amdgcn_exp2f(p1[r + 1]);
            lsum += (f32x2){p0[r], p0[r + 1]}; lsum += (f32x2){p1[r], p1[r + 1]}; }
        l += lsum.x + lsum.y;
        bf16x8 pf[4];
        { u32x4 w;
          w.x = cvtpk(p0[0], p0[1]); w.y = cvtpk(p0[2], p0[3]); w.z = cvtpk(p0[4], p0[5]); w.w = cvtpk(p0[6], p0[7]); pf[0] = __builtin_bit_cast(bf16x8, w);
          w.x = cvtpk(p0[8], p0[9]); w.y = cvtpk(p0[10], p0[11]); w.z = cvtpk(p0[12], p0[13]); w.w = cvtpk(p0[14], p0[15]); pf[1] = __builtin_bit_cast(bf16x8, w);
          w.x = cvtpk(p1[0], p1[1]); w.y = cvtpk(p1[2], p1[3]); w.z = cvtpk(p1[4], p1[5]); w.w = cvtpk(p1[6], p1[7]); pf[2] = __builtin_bit_cast(bf16x8, w);
          w.x = cvtpk(p1[8], p1[9]); w.y = cvtpk(p1[10], p1[11]); w.z = cvtpk(p1[12], p1[13]); w.w = cvtpk(p1[14], p1[15]); pf[3] = __builtin_bit_cast(bf16x8, w); }
#pragma unroll
        for (int s = 0; s < 4; ++s) {
            const int a0 = vofs ^ (s << 5);
            u32x2 va = *(const u32x2*)(Vb + a0), vb = *(const u32x2*)(Vb + (a0 ^ 16));
            u32x2 vc = *(const u32x2*)(Vb + 4096 + a0), vd = *(const u32x2*)(Vb + 4096 + (a0 ^ 16));
            const bf16x8 f0 = __builtin_bit_cast(bf16x8, (u32x4){va.x, va.y, vb.x, vb.y}), f1 = __builtin_bit_cast(bf16x8, (u32x4){vc.x, vc.y, vd.x, vd.y});
            o0 = __builtin_amdgcn_mfma_f32_32x32x16_bf16(f0, pf[s], o0, 0, 0, 0); o1 = __builtin_amdgcn_mfma_f32_32x32x16_bf16(f1, pf[s], o1, 0, 0, 0);
        }
        ATT_WAIT(j + 1, j + 3);
        __builtin_amdgcn_s_barrier(); asm volatile("" ::: "memory");
        slot = slot1;
    }
#undef ATT_DMA
#undef ATT_WAIT
    l += __shfl_xor(l, 32);
    if (has_sink) l += __builtin_amdgcn_exp2f(sink2 - mref);
    const float inv = 1.0f / l;
    bf16_t* orow = Op + (size_t)(wid * 32 + l31) * 1024;
#pragma unroll
    for (int g4 = 0; g4 < 4; ++g4) {
        u32x2 w; w.x = cvtpk(o0[g4 * 4 + 0] * inv, o0[g4 * 4 + 1] * inv); w.y = cvtpk(o0[g4 * 4 + 2] * inv, o0[g4 * 4 + 3] * inv); *(u32x2*)(orow + 8 * g4 + 4 * hi) = w;
        w.x = cvtpk(o1[g4 * 4 + 0] * inv, o1[g4 * 4 + 1] * inv); w.y = cvtpk(o1[g4 * 4 + 2] * inv, o1[g4 * 4 + 3] * inv); *(u32x2*)(orow + 32 + 8 * g4 + 4 * hi) = w;
    }
    asm volatile("s_waitcnt vmcnt(0)" ::: "memory");
}

constexpr int NU_LAT = BATCH * 8 * (SEQ / 128);
constexpr int NU_CTX = BATCH * 8 * (CTX_LEN / 128);
static_assert(BATCH * 2 == 8, "the XCD-local unit order maps the 8 (batch, kv head) K/V streams onto the 8 XCD groups");
__device__ __forceinline__ void ph_attn0(const Params& p, char* lds, int bid, int nb) {
    const bool xl = (nb & 7) == 0; const int x = bid & 7, lb = bid >> 3, lstep = nb >> 3;
    constexpr int NQB = SEQ / 128;
    for (int v = xl ? lb : bid; v < (xl ? BATCH * NQB : NU_LAT); v += xl ? lstep : nb) {
        int blk, h, b; if (xl) { blk = v % NQB; b = v / NQB; h = x; } else { blk = v % NQB; h = (v / NQB) % 8; b = v / (8 * NQB); }
        const int s0 = blk * 128, r0 = s0 / GRID_W;
        int rs0 = r0 - 4; rs0 = rs0 < 0 ? 0 : (rs0 > GRID_H - 8 ? GRID_H - 8 : rs0); int rs1 = r0 + 1 - 4; rs1 = rs1 < 0 ? 0 : (rs1 > GRID_H - 8 ? GRID_H - 8 : rs1);
        attn_unit<2>(lds, p.QB + (size_t)(b * SEQ + s0) * 512 + h * 64, p.KB + (size_t)(b * 8 + h) * LKV * 64, p.VBt + (size_t)(b * 8 + h) * 64 * LKV,
                     p.Y + (size_t)(b * SEQ + s0) * 1024 + 512 + h * 64, s0, CTX_LEN / 64, rs0, rs1 + 8 - rs0, 0.f, false, p.b_rpb + h * 15 * 31);
    }
    for (int v = xl ? lb : bid; v < (xl ? 4 * NQB : NU_LAT); v += xl ? lstep : nb) {
        int blk, h, b; if (xl) { blk = v % NQB; b = x >> 1; h = (x & 1) * 4 + v / NQB; } else { blk = v % NQB; h = (v / NQB) % 8; b = v / (8 * NQB); }
        const int s0 = blk * 128;
        int t0 = (s0 - 128) / 64; if (t0 < 0) t0 = 0; int t1 = (s0 + 255) / 64; if (t1 > SEQ / 64 - 1) t1 = SEQ / 64 - 1;
        attn_unit<1>(lds, p.QA + (size_t)(b * SEQ + s0) * 512 + h * 64, p.KA + (size_t)(b * 2 + h / 4) * LKV * 64, p.VAt + (size_t)(b * 2 + h / 4) * 64 * LKV,
                     p.Y + (size_t)(b * SEQ + s0) * 1024 + h * 64, s0, CTX_LEN / 64, t0, t1 - t0 + 1, p.a_sink[h] * LOG2E, true, nullptr);
    }
    for (int u = bid; u < 2 * NU_CTX; u += nb) {
        const int ty = u / NU_CTX, w = u % NU_CTX; const int blk = w % (CTX_LEN / 128), h = (w / (CTX_LEN / 128)) % 8, b = w / (8 * (CTX_LEN / 128));
        const int row0 = TX + b * CTX_LEN + blk * 128;
        const bf16_t* Qp = (ty == 0 ? p.QA : p.QB) + (size_t)row0 * 512 + h * 64;
        const bf16_t* Kp = ty == 0 ? p.KA + (size_t)(b * 2 + h / 4) * LKV * 64 : p.KB + (size_t)(b * 8 + h) * LKV * 64;
        const bf16_t* Vp = ty == 0 ? p.VAt + (size_t)(b * 2 + h / 4) * 64 * LKV : p.VBt + (size_t)(b * 8 + h) * 64 * LKV;
        attn_unit<0>(lds, Qp, Kp, Vp, p.Y + (size_t)row0 * 1024 + ty * 512 + h * 64, 0, CTX_LEN / 64, 0, 0, ty == 0 ? p.a_sink[h] * LOG2E : 0.f, ty == 0, nullptr);
    }
}
__device__ __forceinline__ void ph_attnC(const Params& p, char* lds, int bid, int nb) {
    const bool xl = (nb & 7) == 0; const int x = bid & 7, lb = bid >> 3, lstep = nb >> 3;
    constexpr int NQB = SEQ / 128;
    for (int v = xl ? lb : bid; v < (xl ? 4 * NQB : NU_LAT); v += xl ? lstep : nb) {
        int blk, h, b; if (xl) { blk = v % NQB; b = x >> 1; h = (x & 1) * 4 + v / NQB; } else { blk = v % NQB; h = (v / NQB) % 8; b = v / (8 * NQB); }
        const int s0 = blk * 128;
        attn_unit<0>(lds, p.QC + (size_t)(b * SEQ + s0) * 512 + h * 64, p.KC + (size_t)(b * 2 + h / 4) * LKV * 64, p.VCt + (size_t)(b * 2 + h / 4) * 64 * LKV,
                     p.Y + (size_t)(b * SEQ + s0) * 1024 + h * 64, s0, CTX_LEN / 64, 0, SEQ / 64, 0.f, false, nullptr);
    }
}
#ifdef HY_TEST
#define HY_OUT(b, t, v) p.YHT[((size_t)(b) * D_CH + c) * SEQ + (t)] = f2bf(v)
#else
#define HY_OUT(b, t, v) p.YHT[((size_t)(b) * D_CH + c) * SEQ + (t)] = f2bf(v)
#endif
#ifdef CPU_TEST
#define FOR_T for (int tid = 0; tid < 256; ++tid)
#define HSYNC
#define HST(t) st[t]
#define HY_DECL HySt* st = new HySt[256]
#define HY_FREE delete[] st
static inline void sincos_rev(float a, float& c, float& s) { c = cosf(6.283185307179586f * a); s = sinf(6.283185307179586f * a); }
#else
__device__ __forceinline__ int hy_launder(int v) { asm volatile("" : "+v"(v)); return v; }
#define FOR_T if (const int tid = hy_launder((int)threadIdx.x); true)
#define HSYNC __syncthreads()
#define HST(t) st
#define HY_DECL HySt st
#define HY_FREE
__device__ __forceinline__ void sincos_rev(float a, float& c, float& s) { c = __builtin_amdgcn_cosf(a); s = __builtin_amdgcn_sinf(a); }
#endif
constexpr int FN = 2 * SEQ;
constexpr int FPAD = FN + (FN >> 5);
#if !defined(SMALL_CFG)
static_assert(FN == 8192, "pass plan 8,8,8,16 is for N = 8192");
constexpr int R4 = 16;
constexpr int NS4 = 512;
#else
constexpr int R4 = 2;
constexpr int NS4 = 512;
#endif
constexpr int NB8 = FN / 8 / 256;
constexpr int NB4 = FN / R4 / 256;
constexpr int EPT = FN / 256;
struct HySt { float xr[EPT], xi[EPT]; unsigned kp[EPT]; };
HD unsigned hy_pack(float r, float i) { return (unsigned)f2bf(r) | ((unsigned)f2bf(i) << 16); }
HD float hy_lo(unsigned v) { unsigned u = v << 16; float f; __builtin_memcpy(&f, &u, 4); return f; }
HD float hy_hi(unsigned v) { unsigned u = v & 0xffff0000u; float f; __builtin_memcpy(&f, &u, 4); return f; }
HD int pidx(int i) { return i + (i >> 5); }

constexpr float W16C[8] = {1.0f, 0.9238795325112867f, 0.7071067811865476f, 0.3826834323650898f, 0.0f, -0.3826834323650898f, -0.7071067811865476f, -0.9238795325112867f};
constexpr float W16S[8] = {0.0f, -0.3826834323650898f, -0.7071067811865476f, -0.9238795325112867f, -1.0f, -0.9238795325112867f, -0.7071067811865476f, -0.3826834323650898f};
template <int R> HD void fft_reg(float* xr, float* xi) {
    constexpr int LG = R == 16 ? 4 : (R == 8 ? 3 : (R == 4 ? 2 : 1));
#pragma unroll
    for (int sg = 0; sg < LG; ++sg) {
        const int h = (R / 2) >> sg;
#pragma unroll
        for (int pr = 0; pr < R / 2; ++pr) {
            const int blk = (pr / h) * 2 * h, i = pr % h;
            const int a = blk + i, b = blk + i + h;
            const float ar = xr[a], ai = xi[a], br = xr[b], bi = xi[b];
            xr[a] = ar + br; xi[a] = ai + bi;
            const float tr = ar - br, ti = ai - bi;
            const int tw = i * (8 / h);
            if (tw == 0) { xr[b] = tr; xi[b] = ti; }
            else if (tw == 4) { xr[b] = ti; xi[b] = -tr; }
            else { const float c = W16C[tw & 7], s = W16S[tw & 7]; xr[b] = tr * c - ti * s; xi[b] = tr * s + ti * c; }
        }
    }
}
template <int R> HD constexpr int bitrev(int i) { int r = 0; for (int b = 1; b < R; b <<= 1) { r = (r << 1) | (i & 1); i >>= 1; } return r; }

template <int R, int NB, class In> HD void pass_load(int tid, HySt& s, const In& in) {
#pragma unroll
    for (int b = 0; b < NB; ++b)
#pragma unroll
        for (int r = 0; r < R; ++r) in(tid + 256 * b + (FN / R) * r, r, s.xr[b * R + r], s.xi[b * R + r]);
}
template <int R, int NB, class Out> HD void pass_compute(int tid, HySt& s, int Ns, const Out& out) {
#pragma unroll
    for (int b = 0; b < NB; ++b) {
        const int j = tid + 256 * b, k = j & (Ns - 1);
        float* xr = s.xr + b * R; float* xi = s.xi + b * R;
        if (Ns > 1) {
            float wc, ws; sincos_rev(-(float)k / (float)(Ns * R), wc, ws);
            float cr = wc, ci = ws;
#pragma unroll
            for (int r = 1; r < R; ++r) {
                const float vr = xr[r], vi = xi[r]; xr[r] = vr * cr - vi * ci; xi[r] = vr * ci + vi * cr;
                const float nr = cr * wc - ci * ws, ni = cr * ws + ci * wc; cr = nr; ci = ni;
            }
        }
        fft_reg<R>(xr, xi);
        const int j0 = (j - k) * R + k;
#pragma unroll
        for (int i = 0; i < R; ++i) out(j0 + bitrev<R>(i) * Ns, b, bitrev<R>(i), xr[i], xi[i]);
    }
}
struct LdsIn { const float* re; const float* im; HD void operator()(int idx, int, float& r, float& i) const { r = re[pidx(idx)]; i = im[pidx(idx)]; } };
struct LdsOut { float* re; float* im; HD void operator()(int idx, int, int, float r, float i) const { re[pidx(idx)] = r; im[pidx(idx)] = i; } };

HD void hy_pre_load(const Params& p, int c, int b, int tid, float* lds) {
#pragma unroll
    for (int q = 0; q < 3; ++q) {
        const bf16_t* u = p.UT + ((size_t)b * 3 * D_CH + q * D_CH + c) * SEQ; const int t0 = tid * 16;
        const float w0 = p.hy_short_w[0 * 3 * D_CH + q * D_CH + c], w1 = p.hy_short_w[1 * 3 * D_CH + q * D_CH + c], w2 = p.hy_short_w[2 * 3 * D_CH + q * D_CH + c], sb = p.hy_short_b[q * D_CH + c];
        unsigned w[8];
        { const unsigned* u32p = (const unsigned*)(u + t0);
#pragma unroll
          for (int i = 0; i < 8; ++i) w[i] = u32p[i]; }
        float x[18];
        x[0] = t0 > 0 ? bf2f(u[t0 - 1]) : 0.f; x[17] = t0 + 16 < SEQ ? bf2f(u[t0 + 16]) : 0.f;
#pragma unroll
        for (int i = 0; i < 8; ++i) { x[1 + 2 * i] = bf2f((bf16_t)(w[i] & 0xffffu)); x[2 + 2 * i] = bf2f((bf16_t)(w[i] >> 16)); }
#pragma unroll
        for (int i = 0; i < 16; ++i) lds[q * SEQ + t0 + i] = sb + w0 * x[i] + w1 * x[i + 1] + w2 * x[i + 2];
    }
}
HD void hy_pre_store(const Params& p, int c, int b, int tid, const float* lds) {
#pragma unroll
    for (int q = 0; q < 3; ++q) {
        unsigned* u = (unsigned*)(p.UT + ((size_t)b * 3 * D_CH + q * D_CH + c) * SEQ + tid * 16);
#pragma unroll
        for (int i = 0; i < 8; ++i) u[i] = (unsigned)f2bf(lds[q * SEQ + tid + 256 * (2 * i)]) | ((unsigned)f2bf(lds[q * SEQ + tid + 256 * (2 * i + 1)]) << 16);
    }
}
HD void tm_load_bf16(const bf16_t* row, int tid, unsigned (&w)[8]) { const unsigned* q = (const unsigned*)(row + tid * 16);
#pragma unroll
    for (int i = 0; i < 8; ++i) w[i] = q[i]; }
HD float tm_get(const unsigned (&w)[8], int m) { return bf2f((bf16_t)((m & 1) ? (w[m >> 1] >> 16) : (w[m >> 1] & 0xffffu))); }
HD int tm_ofs(int idx) { return (idx & 255) * 16 + (idx >> 8); }

HD void hyena_channel(const Params& p, int c, float* lds) {
    HY_DECL;
    float* re = lds; float* im = lds + FPAD;
    const LdsIn lin{re, im}; const LdsOut lout{re, im};
    for (int b = 0; b < BATCH; ++b) { FOR_T { hy_pre_load(p, c, b, tid, lds); } HSYNC; FOR_T { hy_pre_store(p, c, b, tid, lds); } HSYNC; }
    float nrm[2];
#pragma unroll
    for (int o = 0; o < 2; ++o) {
        const float* hf = p.HFT + (size_t)((0 * 2 + o) * D_CH + c) * SEQ; const float* hb = p.HFT + (size_t)((1 * 2 + o) * D_CH + c) * SEQ;
        FOR_T { float sacc = 0.f; for (int i = 0; i < SEQ / 256; ++i) sacc += fabsf(hf[tid + 256 * i]) + fabsf(hb[tid + 256 * i]); re[tid] = sacc; }
        HSYNC;
        { float tot = 0.f; for (int i = 0; i < 256; ++i) tot += re[i]; nrm[o] = tot + EPS; }
        HSYNC;
    }
    float sw[3][3], sbv[3];
#pragma unroll
    for (int q = 0; q < 3; ++q) { sbv[q] = p.hy_short_b[q * D_CH + c];
#pragma unroll
        for (int kk = 0; kk < 3; ++kk) sw[q][kk] = p.hy_short_w[kk * 3 * D_CH + q * D_CH + c]; }
#pragma unroll 1
    for (int o = 0; o < 2; ++o) {
        const float* hf = p.HFT + (size_t)((0 * 2 + o) * D_CH + c) * SEQ; const float* hb = p.HFT + (size_t)((1 * 2 + o) * D_CH + c) * SEQ;
        const float inv = 1.0f / (o == 0 ? nrm[0] : nrm[1]); const float hbias = p.hy_bias[o * D_CH + c];
        float swg[3]; swg[0] = o == 0 ? sw[1][0] : sw[2][0]; swg[1] = o == 0 ? sw[1][1] : sw[2][1]; swg[2] = o == 0 ? sw[1][2] : sw[2][2]; const float sbg = o == 0 ? sbv[1] : sbv[2];
        FOR_T { pass_load<8, NB8>(tid, HST(tid), [&](int idx, int r8, float& r, float& i) __attribute__((always_inline)) { if (r8 < 4) r = hf[idx] * inv; else { const int q = FN - idx; const float hv = hb[q < SEQ ? q : 0]; r = q < SEQ ? hv * inv : 0.f; } i = 0.f; });
                pass_compute<8, NB8>(tid, HST(tid), 1, lout); }
        HSYNC;
        FOR_T { pass_load<8, NB8>(tid, HST(tid), lin); } HSYNC; FOR_T { pass_compute<8, NB8>(tid, HST(tid), 8, lout); } HSYNC;
        FOR_T { pass_load<8, NB8>(tid, HST(tid), lin); } HSYNC; FOR_T { pass_compute<8, NB8>(tid, HST(tid), 64, lout); } HSYNC;
        FOR_T { pass_load<R4, NB4>(tid, HST(tid), lin);
                HySt& s = HST(tid); pass_compute<R4, NB4>(tid, s, NS4, [&](int, int b, int rr, float r, float i) __attribute__((always_inline)) { s.kp[b + NB4 * rr] = hy_pack(r, i); }); }
        HSYNC;
        for (int bp = 0; bp < BATCH / 2; ++bp) {
            const int b0 = 2 * bp, b1 = 2 * bp + 1;
            const bf16_t* u0 = p.UT + ((size_t)b0 * 3 * D_CH + c) * SEQ; const bf16_t* u1 = p.UT + ((size_t)b1 * 3 * D_CH + c) * SEQ;
            const float* z0 = p.Z1 + ((size_t)b0 * D_CH + c) * SEQ; const float* z1 = p.Z1 + ((size_t)b1 * D_CH + c) * SEQ;
            auto zval = [&](int b, int t) __attribute__((always_inline)) { return o == 0 ? bf2f((b == b0 ? u0 : u1)[tm_ofs(t)]) : (b == b0 ? z0 : z1)[tm_ofs(t)]; };
            FOR_T { HySt& s = HST(tid);
                    if (o == 0) { unsigned w0[8], w1[8]; tm_load_bf16(u0, tid, w0); tm_load_bf16(u1, tid, w1);
#pragma unroll
                        for (int q = 0; q < 32; ++q) { const int b = q >> 3, r = q & 7; if (r < 4) { s.xr[q] = tm_get(w0, b + 4 * r); s.xi[q] = tm_get(w1, b + 4 * r); } else { s.xr[q] = 0.f; s.xi[q] = 0.f; } } }
                    else {
#pragma unroll
                        for (int q = 0; q < 32; ++q) { const int b = q >> 3, r = q & 7; if (r < 4) { s.xr[q] = z0[tid * 16 + b + 4 * r]; s.xi[q] = z1[tid * 16 + b + 4 * r]; } else { s.xr[q] = 0.f; s.xi[q] = 0.f; } } }
                    pass_compute<8, NB8>(tid, s, 1, lout); }
            HSYNC;
            FOR_T { pass_load<8, NB8>(tid, HST(tid), lin); } HSYNC; FOR_T { pass_compute<8, NB8>(tid, HST(tid), 8, lout); } HSYNC;
            FOR_T { pass_load<8, NB8>(tid, HST(tid), lin); } HSYNC; FOR_T { pass_compute<8, NB8>(tid, HST(tid), 64, lout); } HSYNC;
            FOR_T { pass_load<R4, NB4>(tid, HST(tid), lin); } HSYNC;
            FOR_T { HySt& s = HST(tid); pass_compute<R4, NB4>(tid, s, NS4, [&](int idx, int b, int rr, float r, float i) __attribute__((always_inline)) { const float kr = hy_lo(s.kp[b + NB4 * rr]), ki = hy_hi(s.kp[b + NB4 * rr]);
                        re[pidx(idx)] = r * kr - i * ki; im[pidx(idx)] = -(r * ki + i * kr); }); }
            HSYNC;
            FOR_T { pass_load<8, NB8>(tid, HST(tid), lin); } HSYNC; FOR_T { pass_compute<8, NB8>(tid, HST(tid), 1, lout); } HSYNC;
            FOR_T { pass_load<8, NB8>(tid, HST(tid), lin); } HSYNC; FOR_T { pass_compute<8, NB8>(tid, HST(tid), 8, lout); } HSYNC;
            FOR_T { pass_load<8, NB8>(tid, HST(tid), lin); } HSYNC; FOR_T { pass_compute<8, NB8>(tid, HST(tid), 64, lout); } HSYNC;
            FOR_T { pass_load<R4, NB4>(tid, HST(tid), lin); HySt& s = HST(tid); float yr[16], yi[16];
                    pass_compute<R4, NB4>(tid, s, NS4, [&](int, int b, int rr, float r, float i) __attribute__((always_inline)) { if (rr < 8) { yr[b + 2 * rr] = r * (1.0f / FN); yi[b + 2 * rr] = -i * (1.0f / FN); } });
                    const bf16_t* g0 = p.UT + ((size_t)b0 * 3 * D_CH + (o + 1) * D_CH + c) * SEQ; const bf16_t* g1 = p.UT + ((size_t)b1 * 3 * D_CH + (o + 1) * D_CH + c) * SEQ;
                    unsigned gw0[8], gw1[8]; tm_load_bf16(g0, tid, gw0); tm_load_bf16(g1, tid, gw1);
                    if (o == 0) { unsigned w0[8], w1[8]; tm_load_bf16(u0, tid, w0); tm_load_bf16(u1, tid, w1);
                        float* zo0 = p.Z1 + ((size_t)b0 * D_CH + c) * SEQ + tid * 16; float* zo1 = p.Z1 + ((size_t)b1 * D_CH + c) * SEQ + tid * 16;
#pragma unroll
                        for (int m = 0; m < 16; ++m) { zo0[m] = tm_get(gw0, m) * (yr[m] + tm_get(w0, m) * hbias); zo1[m] = tm_get(gw1, m) * (yi[m] + tm_get(w1, m) * hbias); } }
                    else {
#pragma unroll
                        for (int m = 0; m < 16; ++m) { const float zn0 = tm_get(gw0, m) * (yr[m] + z0[tid * 16 + m] * hbias), zn1 = tm_get(gw1, m) * (yi[m] + z1[tid * 16 + m] * hbias);
                            HY_OUT(b0, tid + 256 * m, zn0); HY_OUT(b1, tid + 256 * m, zn1); } } }
            HSYNC;
        }
    }
    HY_FREE;
}
constexpr int MOD_ITEMS = DEPTH * (6 * D_MODEL / 64);
__device__ __forceinline__ void mod_item(const Params& p, char* lds, int item) {
    float* sc = (float*)lds;
    float* red = sc + 5 * D_MODEL;
    const int tid = threadIdx.x, l = item / (6 * D_MODEL / 64), j0 = (item % (6 * D_MODEL / 64)) * 64;
    for (int i = tid; i < 5 * D_MODEL; i += NTHREADS) { const int r = i / D_MODEL, k = i % D_MODEL; const float v = r < BATCH ? p.c[r * D_MODEL + k] : p.c_ctx[k]; sc[i] = silu_f(v); }
    __syncthreads();
    const int col = tid & 63, kp = tid >> 6;
    const float* w = p.w_ada + ((size_t)l * D_MODEL + kp * 256) * 6 * D_MODEL + j0 + col;
    float a0 = 0.f, a1 = 0.f, a2 = 0.f, a3 = 0.f, a4 = 0.f;
#pragma unroll 8
    for (int k = 0; k < 256; ++k) { const float wv = w[(size_t)k * 6 * D_MODEL]; const int kk = kp * 256 + k;
        a0 += sc[kk] * wv; a1 += sc[D_MODEL + kk] * wv; a2 += sc[2 * D_MODEL + kk] * wv; a3 += sc[3 * D_MODEL + kk] * wv; a4 += sc[4 * D_MODEL + kk] * wv; }
    red[(kp * 5 + 0) * 64 + col] = a0; red[(kp * 5 + 1) * 64 + col] = a1; red[(kp * 5 + 2) * 64 + col] = a2; red[(kp * 5 + 3) * 64 + col] = a3; red[(kp * 5 + 4) * 64 + col] = a4;
    __syncthreads();
    for (int i = tid; i < 5 * 64; i += NTHREADS) { const int r = i / 64, cc = i % 64;
        const float v = red[(0 * 5 + r) * 64 + cc] + red[(1 * 5 + r) * 64 + cc] + red[(2 * 5 + r) * 64 + cc] + red[(3 * 5 + r) * 64 + cc];
        p.mod[((size_t)(l * (BATCH + 1) + r)) * 6 * D_MODEL + j0 + cc] = v + p.b_ada[l * 6 * D_MODEL + j0 + cc]; }
    __syncthreads();
}
constexpr int FILT_ITEMS = (SEQ / 256) * (4 * D_CH / 64);
__device__ __forceinline__ void filt_item(const Params& p, char* lds, int item) {
    float* ws = (float*)lds;
    const int tid = threadIdx.x, tb = item % (SEQ / 256), cb = item / (SEQ / 256); const int t = tb * 256 + tid, col0 = cb * 64;
#pragma unroll
    for (int i = 0; i < 16; ++i) { const int k = i * 4 + (tid >> 6), cc = tid & 63; ws[cc * 68 + k] = p.hy_w3[(size_t)k * 4 * D_CH + col0 + cc]; }
    f32x4 h[16];
#pragma unroll
    for (int i = 0; i < 16; ++i) h[i] = *(const f32x4*)(p.h2 + (size_t)t * HY_FFN + i * 4);
    __syncthreads();
    const float tn = (float)t / (float)(SEQ - 1);
    const float mind = logf(1e-2f) / 1.5f, maxd = logf(1e-2f) / 0.3f;
#pragma unroll 2
    for (int cc = 0; cc < 64; ++cc) {
        const int col = col0 + cc; const f32x4* w = (const f32x4*)(ws + cc * 68);
        float acc = p.hy_b3[col];
#pragma unroll
        for (int i = 0; i < 16; ++i) { const f32x4 wv = w[i]; acc += h[i][0] * wv[0] + h[i][1] * wv[1] + h[i][2] * wv[2] + h[i][3] * wv[3]; }
        const float delta = fabsf(mind + (float)(col % D_CH) * (maxd - mind) / (float)(D_CH - 1));
        p.HFT[(size_t)col * SEQ + t] = acc * expf(-tn * delta);
    }
    __syncthreads();
}
__device__ __forceinline__ void ph_norm(const Params& p, int l, int which, int nrows, int bid, int nb) {
    const int lane = threadIdx.x & 63, wid = threadIdx.x >> 6;
    const float* g = p.norm_g + (l * 2 + which) * D_MODEL;
    for (int row = (bid * 4 + wid) * 2; row < nrows; row += nb * 8) {
        const int row1 = row + 1 < nrows ? row + 1 : row;
        const float* xa = which == 0 ? xrow_in(p, l, row) : xrow_cur(p, row); const float* xb = which == 0 ? xrow_in(p, l, row1) : xrow_cur(p, row1);
        f32x4 va[4], vb[4]; float sa = 0.f, sb = 0.f;
#pragma unroll
        for (int j = 0; j < 4; ++j) { va[j] = *(const f32x4*)(xa + j * 256 + lane * 4); vb[j] = *(const f32x4*)(xb + j * 256 + lane * 4); }
#pragma unroll
        for (int j = 0; j < 4; ++j) { sa += va[j][0] * va[j][0] + va[j][1] * va[j][1] + va[j][2] * va[j][2] + va[j][3] * va[j][3]; sb += vb[j][0] * vb[j][0] + vb[j][1] * vb[j][1] + vb[j][2] * vb[j][2] + vb[j][3] * vb[j][3]; }
        const float ra = 1.0f / sqrtf(wave_sum(sa) * (1.0f / D_MODEL) + EPS), rb = 1.0f / sqrtf(wave_sum(sb) * (1.0f / D_MODEL) + EPS);
        const float* sha = modp(p, l, row, which * 3 + 0); const float* sca = modp(p, l, row, which * 3 + 1);
        const float* shb = modp(p, l, row1, which * 3 + 0); const float* scb = modp(p, l, row1, which * 3 + 1);
#pragma unroll
        for (int j = 0; j < 4; ++j) { const int c = j * 256 + lane * 4; const f32x4 gv = *(const f32x4*)(g + c);
            store4bf(p.hbuf + (size_t)row * D_MODEL + c, va[j] * ra * gv * (*(const f32x4*)(sca + c) + 1.0f) + *(const f32x4*)(sha + c));
            if (row1 != row) store4bf(p.hbuf + (size_t)row1 * D_MODEL + c, vb[j] * rb * gv * (*(const f32x4*)(scb + c) + 1.0f) + *(const f32x4*)(shb + c)); }
    }
}
__device__ __forceinline__ void ph_route_a(const Params& p, char* lds, int l, int nrows, int bid, int nb) {
    const int lane = threadIdx.x & 63, wid = threadIdx.x >> 6;
    float* wr_s = (float*)lds; int* hist = (int*)(lds + 65536);
    for (int i = threadIdx.x; i < D_MODEL * 4; i += NTHREADS) { const int k = i >> 2, ch = i & 3, pos = (k & 3) * 256 + (k >> 2); ((f32x4*)wr_s)[pos * 4 + (ch ^ ((pos >> 2) & 3))] = ((const f32x4*)p.w_router)[i]; }
    if (threadIdx.x < 32) hist[threadIdx.x] = 0;
    __syncthreads();
    const int sw = (lane >> 2) & 3;
    const float* g = p.norm_g + (l * 2 + 1) * D_MODEL;
    const int RPB = (nrows + nb - 1) / nb, r0 = bid * RPB;
    f32x4 v[4];
    { const int row = r0 + wid; const float* xr = xrow_cur(p, (wid < RPB && row < nrows) ? row : 0);
#pragma unroll
      for (int j = 0; j < 4; ++j) v[j] = *(const f32x4*)(xr + j * 256 + lane * 4); }
    for (int jr = wid; jr < RPB; jr += 4) {
        const int row = r0 + jr; if (row >= nrows) break;
        const float* sh = modp(p, l, row, 3); const float* sc = modp(p, l, row, 4);
        f32x4 vn[4];
        { const bool more = jr + 4 < RPB && row + 4 < nrows; const float* xn = xrow_cur(p, more ? row + 4 : row);
#pragma unroll
          for (int j = 0; j < 4; ++j) vn[j] = *(const f32x4*)(xn + j * 256 + lane * 4); }
        float ss = 0.f;
#pragma unroll
        for (int j = 0; j < 4; ++j) ss += v[j][0] * v[j][0] + v[j][1] * v[j][1] + v[j][2] * v[j][2] + v[j][3] * v[j][3];
        const float rstd = 1.0f / sqrtf(wave_sum(ss) * (1.0f / D_MODEL) + EPS);
        float lg[16];
#pragma unroll
        for (int e = 0; e < 16; ++e) lg[e] = 0.f;
#pragma unroll
        for (int j = 0; j < 4; ++j) { const int c = j * 256 + lane * 4;
            const f32x4 o = v[j] * rstd * *(const f32x4*)(g + c) * (*(const f32x4*)(sc + c) + 1.0f) + *(const f32x4*)(sh + c);
            store4bf(p.hbuf + (size_t)row * D_MODEL + c, o);
#pragma unroll
            for (int r = 0; r < 4; ++r) { const f32x4* w4 = (const f32x4*)(wr_s + (r * 256 + lane + 64 * j) * 16);
#pragma unroll
                for (int e4 = 0; e4 < 4; ++e4) { const f32x4 wv = w4[e4 ^ sw]; lg[e4 * 4 + 0] += o[r] * wv[0]; lg[e4 * 4 + 1] += o[r] * wv[1]; lg[e4 * 4 + 2] += o[r] * wv[2]; lg[e4 * 4 + 3] += o[r] * wv[3]; }
                if (r & 1) __builtin_amdgcn_sched_barrier(0); } }
        {
#pragma unroll
            for (int i = 0; i < 8; ++i) { const float a = lg[i], b = lg[i + 8]; const bool up = (lane & 32) != 0; const float recv = __shfl_xor(up ? a : b, 32); lg[i] = (up ? b : a) + recv; }
#pragma unroll
            for (int i = 0; i < 4; ++i) { const float a = lg[i], b = lg[i + 4]; const bool up = (lane & 16) != 0; const float recv = __shfl_xor(up ? a : b, 16); lg[i] = (up ? b : a) + recv; }
#pragma unroll
            for (int i = 0; i < 2; ++i) { const float a = lg[i], b = lg[i + 2]; const bool up = (lane & 8) != 0; const float recv = __shfl_xor(up ? a : b, 8); lg[i] = (up ? b : a) + recv; }
            { const float a = lg[0], b = lg[1]; const bool up = (lane & 4) != 0; const float recv = __shfl_xor(up ? a : b, 4); lg[0] = (up ? b : a) + recv; }
            lg[0] += __shfl_xor(lg[0], 2); lg[0] += __shfl_xor(lg[0], 1);
            const float mine = lg[0];
#pragma unroll
            for (int e = 0; e < 16; ++e) lg[e] = __builtin_bit_cast(float, __builtin_amdgcn_readlane(__builtin_bit_cast(int, mine), 4 * e));
        }
        if (lane == 0) {
            int gbest = 0, a = 0, bb = 1; float gbs = -1e30f, wa = 0.f, wb = 0.f;
#pragma unroll
            for (int gI = 0; gI < 4; ++gI) {
                float m1 = -1e30f, m2 = -1e30f, s1 = 0.f, s2 = 0.f; int i1 = 0, i2 = 0;
#pragma unroll
                for (int jj = 0; jj < 4; ++jj) { float sgv = sigmoid_f(lg[gI * 4 + jj]); float vv = sgv + p.b_router[gI * 4 + jj];
                    if (vv > m1) { m2 = m1; i2 = i1; s2 = s1; m1 = vv; i1 = jj; s1 = sgv; } else if (vv > m2) { m2 = vv; i2 = jj; s2 = sgv; } }
                float gs = m1 + m2;
                if (gs > gbs) { gbs = gs; gbest = gI; if (i1 < i2) { a = i1; bb = i2; wa = s1; wb = s2; } else { a = i2; bb = i1; wa = s2; wb = s1; } }
            }
            const float inv = 1.0f / (wa + wb);
            const int pidx = a == 0 ? bb - 1 : (a == 1 ? bb + 1 : 5);
            const int pr = gbest * 6 + pidx;
            p.rpair[row] = pr; p.tokw[row * 2 + 0] = wa * inv; p.tokw[row * 2 + 1] = wb * inv;
            atomicAdd(&hist[pr], 1);
        }
#pragma unroll
        for (int j = 0; j < 4; ++j) v[j] = vn[j];
    }
    __syncthreads();
    if (threadIdx.x < 32) p.bh[bid * 32 + threadIdx.x] = hist[threadIdx.x];
}
__device__ __forceinline__ void ph_route_b(const Params& p, char* lds, int l, int nrows, int bid, int nb) {
    int* sb = (int*)lds;
    const int t = threadIdx.x, pr = t & 31, part = t >> 5;
    { int s_before = 0, s_all = 0; const int b0 = (part * nb) >> 3, b1 = ((part + 1) * nb) >> 3;
      for (int b = b0; b < b1; ++b) { const int c = p.bh[b * 32 + pr]; s_all += c; if (b < bid) s_before += c; }
      sb[part * 32 + pr] = s_before; sb[256 + part * 32 + pr] = s_all; }
    __syncthreads();
    if (t < 32) { int a = 0, c = 0;
#pragma unroll
        for (int q = 0; q < 8; ++q) { a += sb[q * 32 + t]; c += sb[256 + q * 32 + t]; }
        sb[512 + t] = a; sb[544 + t] = c; if (bid == 0) p.cnt[l * 32 + t] = c; }
    const int RPB = (nrows + nb - 1) / nb, row = bid * RPB + t; const bool act = t < RPB && row < nrows;
    int myp = 0; if (act) { myp = p.rpair[row]; sb[576 + t] = myp; }
    __syncthreads();
    if (act) { int rank = 0; for (int j = 0; j < t; ++j) rank += (sb[576 + j] == myp) ? 1 : 0; p.list[(size_t)myp * TT + sb[512 + myp] + rank] = row; }
    __syncthreads();
}
__device__ __forceinline__ void ph_final(const Params& p, int bid, int nb) {
    const int lane = threadIdx.x & 63, wid = threadIdx.x >> 6;
    for (int row = (bid * 4 + wid) * 2; row < TX; row += nb * 8) {
        float* xa = p.out + (size_t)row * D_MODEL; float* xb = xa + D_MODEL;
        f32x4 va[4], vb[4]; float sa = 0.f, sb = 0.f;
#pragma unroll
        for (int j = 0; j < 4; ++j) { va[j] = *(const f32x4*)(xa + j * 256 + lane * 4); vb[j] = *(const f32x4*)(xb + j * 256 + lane * 4); }
#pragma unroll
        for (int j = 0; j < 4; ++j) { sa += va[j][0] * va[j][0] + va[j][1] * va[j][1] + va[j][2] * va[j][2] + va[j][3] * va[j][3]; sb += vb[j][0] * vb[j][0] + vb[j][1] * vb[j][1] + vb[j][2] * vb[j][2] + vb[j][3] * vb[j][3]; }
        const float ra = 1.0f / sqrtf(wave_sum(sa) * (1.0f / D_MODEL) + EPS), rb = 1.0f / sqrtf(wave_sum(sb) * (1.0f / D_MODEL) + EPS);
#pragma unroll
        for (int j = 0; j < 4; ++j) { const int c = j * 256 + lane * 4; const f32x4 gv = *(const f32x4*)(p.final_g + c); *(f32x4*)(xa + c) = va[j] * ra * gv; *(f32x4*)(xb + c) = vb[j] * rb * gv; }
    }
}

#define XB_TMO      128
#define XB_XCNT(j)  (256  + 64 * (j))
#define XB_XSUB(j)  (1280 + 64 * (j))
#define XB_XGEN(j)  (2304 + 64 * (j))
#define XB_TOP      3328
#define XB_TOPGEN   3392
#define XCD_BAR_WORDS 3456
#define XB_SPIN_CAP (1u << 20)
__device__ __forceinline__ unsigned xb_ld(unsigned* p)              { return __hip_atomic_load(p, __ATOMIC_RELAXED, __HIP_MEMORY_SCOPE_AGENT); }
__device__ __forceinline__ unsigned xb_add(unsigned* p, unsigned v) { return __hip_atomic_fetch_add(p, v, __ATOMIC_RELAXED, __HIP_MEMORY_SCOPE_AGENT); }
__device__ __forceinline__ unsigned xb_xcc_id() { return (unsigned)__builtin_amdgcn_s_getreg((3 << 11) | 20) & 0xFu; }
#define XB_SPIN(cond, bar) do { unsigned _sp = 0; while (cond) { __builtin_amdgcn_s_sleep(1); \
    if ((++_sp & 255u) == 0u) { if (xb_ld(&(bar)[XB_TMO])) break; if (_sp > XB_SPIN_CAP) { atomicAdd(&(bar)[XB_TMO], 1u); break; } } } } while (0)
struct XcdBarrier { unsigned* bar; unsigned x; volatile LAS unsigned* st; };
__device__ __forceinline__ XcdBarrier xcd_barrier_post(unsigned* bar, volatile LAS unsigned* st) {
    XcdBarrier b; b.bar = bar; b.x = xb_xcc_id(); b.st = st;
    if (threadIdx.x == 0) (void)xb_add(&bar[XB_XCNT(b.x)], 1u);
    return b;
}
__device__ __forceinline__ void xcd_barrier_complete(unsigned* bar, unsigned x, unsigned& nloc, unsigned& nx) {
    const unsigned G = gridDim.x * gridDim.y * gridDim.z;
    unsigned sum, cnt, mine, sp = 0u;
    for (;;) {
        sum = 0u; cnt = 0u; mine = 0u;
#pragma unroll
        for (unsigned j = 0; j < 16; ++j) { const unsigned c = xb_ld(&bar[XB_XCNT(j)]); sum += c; cnt += (c > 0u) ? 1u : 0u; mine = (j == x) ? c : mine; }
        if (sum == G) break;
        __builtin_amdgcn_s_sleep(1);
        if ((++sp & 255u) == 0u) { if (xb_ld(&bar[XB_TMO])) break; if (sp > XB_SPIN_CAP) { atomicAdd(&bar[XB_TMO], 1u); break; } }
    }
    nloc = mine > 0u ? mine : 1u; nx = cnt > 0u ? cnt : 1u;
}
__device__ __forceinline__ void xcd_barrier(const XcdBarrier& b) {
    asm volatile("s_waitcnt vmcnt(0)" ::: "memory");
    __syncthreads();
    if (threadIdx.x == 0) {
        unsigned* bar = b.bar;
        __builtin_amdgcn_s_waitcnt(0);
        unsigned nloc = b.st[0], nx = b.st[1];
        if (nloc == 0u) { xcd_barrier_complete(bar, b.x, nloc, nx); b.st[0] = nloc; b.st[1] = nx; }
        const unsigned old = xb_add(&bar[XB_XSUB(b.x)], 1u);
        const unsigned gen = old / nloc;
        if (old + 1u == (gen + 1u) * nloc) {
            __builtin_amdgcn_fence(__ATOMIC_RELEASE, "agent");
            asm volatile("s_waitcnt vmcnt(0)" ::: "memory");
            const unsigned og = xb_add(&bar[XB_TOP], 1u);
            const unsigned tg = og / nx;
            if (og + 1u == (tg + 1u) * nx) xb_add(&bar[XB_TOPGEN], 1u);
            else XB_SPIN(xb_ld(&bar[XB_TOPGEN]) == tg, bar);
            __builtin_amdgcn_fence(__ATOMIC_ACQUIRE, "agent");
            xb_add(&bar[XB_XGEN(b.x)], 1u);
            asm volatile("s_waitcnt vmcnt(0)" ::: "memory");
        } else {
            XB_SPIN(xb_ld(&bar[XB_XGEN(b.x)]) == gen, bar);
            __builtin_amdgcn_fence(__ATOMIC_ACQUIRE, "agent");
            asm volatile("s_waitcnt vmcnt(0)" ::: "memory");
        }
    }
    __syncthreads();
}

__device__ __forceinline__ void ph_mix1(const Params& p, char* lds, int bid, int nb, unsigned long long* tsplit = nullptr) {
    const bool hy_first = bid >= (nb >> 1);
    for (int rep = 0; rep < 3; ++rep) {
        if (rep == 1) {
            for (int u = bid; u < NU_LAT; u += nb) { const int blk = u % (SEQ / 128), h = (u / (SEQ / 128)) % 8, b = u / (8 * (SEQ / 128)); const int s0 = blk * 128;
                attn_unit<0>(lds, p.QC + (size_t)(b * SEQ + s0) * 512 + h * 64, p.KC + (size_t)(b * 2 + h / 4) * LKV * 64, p.VCt + (size_t)(b * 2 + h / 4) * 64 * LKV,
                             p.Y + (size_t)(b * SEQ + s0) * 1024 + h * 64, s0, CTX_LEN / 64, 0, SEQ / 64, 0.f, false, nullptr); }
            if (tsplit) *tsplit = __builtin_amdgcn_s_memrealtime();
        } else if ((rep == 0) == hy_first) {
            __syncthreads();
            for (int c = hy_first ? bid - (nb >> 1) : bid + (nb >> 1); c < D_CH; c += nb) hyena_channel(p, c, (float*)lds);
            __syncthreads();
        }
    }
}
constexpr int TR_ITEMS = BATCH * (D_CH / 64) * (SEQ / 64);
__device__ __forceinline__ void tr_item(const Params& p, char* lds, int it) {
    bf16_t* T = (bf16_t*)lds; const int tid = threadIdx.x;
    const int sb = it % (SEQ / 64), cb = (it / (SEQ / 64)) % (D_CH / 64), b = it / ((SEQ / 64) * (D_CH / 64));
    { const int c = tid >> 2, q = tid & 3;
      const u32x4* src = (const u32x4*)(p.YHT + ((size_t)b * D_CH + cb * 64 + c) * SEQ + sb * 64 + q * 16);
      const u32x4 v0 = src[0], v1 = src[1]; unsigned* d = (unsigned*)(T + c * 66 + q * 16);
      d[0] = v0.x; d[1] = v0.y; d[2] = v0.z; d[3] = v0.w; d[4] = v1.x; d[5] = v1.y; d[6] = v1.z; d[7] = v1.w; }
    __syncthreads();
    { const int s = tid >> 2, q = tid & 3;
      unsigned w[8];
#pragma unroll
      for (int i = 0; i < 8; ++i) w[i] = (unsigned)T[(q * 16 + 2 * i) * 66 + s] | ((unsigned)T[(q * 16 + 2 * i + 1) * 66 + s] << 16);
      u32x4* dst = (u32x4*)(p.Y + ((size_t)b * SEQ + sb * 64 + s) * 1024 + 512 + cb * 64 + q * 16);
      dst[0] = (u32x4){w[0], w[1], w[2], w[3]}; dst[1] = (u32x4){w[4], w[5], w[6], w[7]}; }
    __syncthreads();
}
enum { PH_PREP = 0, PH_NORM0, PH_INPROJ0, PH_ATTN0, PH_OUT0, PH_ROUTE0, PH_ROUTEB0, PH_UP0, PH_DOWN0, PH_NORM1, PH_INPROJ1, PH_MIX1, PH_HY1, PH_TR1, PH_OUT1, PH_ROUTE1, PH_ROUTEB1, PH_UP1, PH_DOWN1, PH_FINAL, PH_COUNT };
typedef const __attribute__((address_space(4))) Params* KParams;
__global__ void __launch_bounds__(NTHREADS, 2) mega(Params p_arg, int lo, int hi) {
    extern __shared__ __attribute__((aligned(16))) char lds[];
    const int bid = blockIdx.x, nb = gridDim.x;
    volatile LAS unsigned* st = (volatile LAS unsigned*)(lds + LDS_BYTES - 16);
    if (threadIdx.x < 4) st[threadIdx.x] = 0u;
    __syncthreads();
    KParams kp = (KParams)__builtin_amdgcn_kernarg_segment_ptr();
    XcdBarrier bar; bar.bar = kp->bar; bar.x = 0; bar.st = st;
    if (hi - lo > 1) bar = xcd_barrier_post(kp->bar, st);
#ifdef PROBE_PA
    unsigned long long ts_prev = __builtin_amdgcn_s_memrealtime(), t_a = 0, t_b = 0;
#define STAMP(PH) if (bid == 0 && threadIdx.x == 0) { const unsigned long long now_ = __builtin_amdgcn_s_memrealtime(); if ((PH) == PROBE_PA) t_a = now_ - ts_prev; if ((PH) == PROBE_PB) t_b = now_ - ts_prev; ts_prev = now_; }
#else
#define STAMP(PH)
#endif
#define PHASE(PH, body) if (lo <= (PH) && (PH) < hi) { { KParams kq_ = kp; asm volatile("" : "+s"(kq_)); const Params& p = *(const Params*)kq_; body; } if ((PH) + 1 < hi) xcd_barrier(bar); STAMP(PH) }
    PHASE(PH_PREP, { if (nb > MOD_ITEMS + 64) { if (bid < MOD_ITEMS) mod_item(p, lds, bid); else cvt_range(p, lds, 0, CVT_EARLY, bid - MOD_ITEMS, nb - MOD_ITEMS); }
        else { for (int it = bid; it < MOD_ITEMS; it += nb) mod_item(p, lds, it); cvt_range(p, lds, 0, CVT_EARLY, bid, nb); }
        d_rope(p); d_hy_h1(p); })
    PHASE(PH_NORM0, { ph_norm(p, 0, 0, TT, bid, nb); d_hy_h2(p); })
    PHASE(PH_INPROJ0, ph_inproj<0>(p, lds, bid, nb))
    PHASE(PH_ATTN0, { if (bid >= (nb >> 1)) { cvt_range(p, lds, CVT_EARLY, CVT_TOTAL, bid, nb); __syncthreads(); ph_attn0(p, lds, bid, nb); } else { ph_attn0(p, lds, bid, nb); __syncthreads(); cvt_range(p, lds, CVT_EARLY, CVT_TOTAL, bid, nb); } })
    PHASE(PH_OUT0, { ph_outproj<0>(p, lds, bid, nb);
        __syncthreads(); { const int full_ = (nb & 7) == 0 ? ((MT_ALL / 8) * 8) % (nb >> 3) : 0;
          const int lb_ = bid >> 3; if ((nb & 7) != 0) { for (int it = bid; it < FILT_ITEMS; it += nb) filt_item(p, lds, it); }
          else if (lb_ >= full_) { for (int it = (lb_ - full_) * 8 + (bid & 7); it < FILT_ITEMS; it += nb - full_ * 8) filt_item(p, lds, it); } } })
    PHASE(PH_ROUTE0, ph_route_a(p, lds, 0, TT, bid, nb))
    PHASE(PH_ROUTEB0, ph_route_b(p, lds, 0, TT, bid, nb))
    PHASE(PH_UP0, ph_moe_up(p, lds, 0, bid, nb))
    PHASE(PH_DOWN0, ph_moe_down(p, lds, 0, bid, nb))
    PHASE(PH_NORM1, ph_norm(p, 1, 0, TT, bid, nb))
    PHASE(PH_INPROJ1, ph_inproj<1>(p, lds, bid, nb))
    PHASE(PH_MIX1, ph_attnC(p, lds, bid, nb))
    PHASE(PH_HY1, for (int c = bid; c < D_CH; c += nb) hyena_channel(p, c, (float*)lds))
    PHASE(PH_TR1, for (int it = bid; it < TR_ITEMS; it += nb) tr_item(p, lds, it))
    PHASE(PH_OUT1, ph_outproj<1>(p, lds, bid, nb))
    PHASE(PH_ROUTE1, ph_route_a(p, lds, 1, TX, bid, nb))
    PHASE(PH_ROUTEB1, ph_route_b(p, lds, 1, TX, bid, nb))
    PHASE(PH_UP1, ph_moe_up(p, lds, 1, bid, nb))
    PHASE(PH_DOWN1, ph_moe_down(p, lds, 1, bid, nb))
    PHASE(PH_FINAL, ph_final(p, bid, nb))
#ifdef PROBE_PA
    if (bid == 0 && threadIdx.x == 0) {
        const unsigned long long delay = 2 * t_a + 204800ull * ((t_b + 200) / 400); const unsigned long long t0 = __builtin_amdgcn_s_memrealtime();
        while (__builtin_amdgcn_s_memrealtime() - t0 < delay) __builtin_amdgcn_s_sleep(32);
    }
#endif
}
extern "C" void kernel_launch(void* const* d_in, const int* in_sizes, int n_in, void* d_out, int out_size, void* d_ws, size_t ws_size, hipStream_t stream) {
    static int grid = 0;
    if (grid == 0) {
        int dev = 0, cus = 0;
        if (hipGetDevice(&dev) != hipSuccess || hipDeviceGetAttribute(&cus, hipDeviceAttributeMultiprocessorCount, dev) != hipSuccess) { fprintf(stderr, "kernel_launch: device query failed\n"); grid = -1; return; }
        if (hipFuncSetAttribute((const void*)mega, hipFuncAttributeMaxDynamicSharedMemorySize, LDS_BYTES) != hipSuccess) { fprintf(stderr, "kernel_launch: hipFuncSetAttribute failed\n"); grid = -1; return; }
        grid = 2 * cus;
    }
    if (grid < 0) return;
    Params p{};
    size_t need = setup_ws(p, (char*)d_ws);
    if (n_in != 32 || need > ws_size || out_size != TX * D_MODEL) { fprintf(stderr, "kernel_launch: bad config n_in %d ws %zu need %zu out %d\n", n_in, ws_size, need, out_size); return; }
    fill_inputs(p, d_in, d_out);
    hipMemsetAsync(p.bar, 0, 64 * 1024 + 256, stream);
#ifdef PER_PHASE
    for (int ph = 0; ph < PH_COUNT; ++ph) mega<<<dim3(grid), dim3(NTHREADS), LDS_BYTES, stream>>>(p, ph, ph + 1);
#else
    mega<<<dim3(grid), dim3(NTHREADS), LDS_BYTES, stream>>>(p, 0, PH_COUNT);
#endif
}
```

```cpp
#include <hip/hip_runtime.h>
#include <cstdio>
#include <math.h>
#include <stdint.h>
#include <string.h>

#ifdef CPU_TEST
#define HD
#define GLOBAL
struct U3 { unsigned x, y, z; };
static thread_local U3 threadIdx, blockIdx, blockDim, gridDim;
static inline int atomicAdd(int* p, int v) { return __sync_fetch_and_add(p, v); }
#else
#define HD __device__ __forceinline__
#define GLOBAL __global__ __launch_bounds__(256)
#endif

#if defined(HY_TEST)
constexpr int D_MODEL = 64, BATCH = 2, SEQ = 4096, GRID_W = 64, CTX_LEN = 64, D_CH = 4, D_EXPERT = 64;
#elif defined(SMALL_CFG)
constexpr int D_MODEL = 128, BATCH = 2, SEQ = 512, GRID_W = 32, CTX_LEN = 64, D_CH = 32, D_EXPERT = 64;
#else
constexpr int D_MODEL = 1024, BATCH = 4, SEQ = 4096, GRID_W = 64, CTX_LEN = 256, D_CH = 512, D_EXPERT = 512;
#endif
constexpr int DEPTH = 2, HEAD_DIM = 64;
constexpr int GRID_H = SEQ / GRID_W;
constexpr int A_WINDOW = 128;
constexpr int B_WIN_H = 8, B_WIN_W = 16;
constexpr int HY_BANDS = 16, HY_EMB = 33, HY_FFN = 64;
constexpr int EVEN_IN = 2304, EVEN_OUT = 1024;
constexpr int ODD_IN = 768 + 3 * D_CH, ODD_OUT = 512 + D_CH;
constexpr int N_EXPERTS = 16;
constexpr int TX = BATCH * SEQ, TC = BATCH * CTX_LEN, TT = TX + TC;
constexpr int LKV = CTX_LEN + SEQ;
constexpr int NPAIR = 24;
constexpr int HE_W = 2 * D_EXPERT;
constexpr float EPS = 1e-6f;
constexpr float ATTN_SCALE = 0.125f;

typedef unsigned short bf16_t;
HD bf16_t f2bf(float f) { unsigned u; __builtin_memcpy(&u, &f, 4); u = (u + 0x7fffu + ((u >> 16) & 1u)) >> 16; return (bf16_t)u; }
HD float bf2f(bf16_t h) { unsigned u = ((unsigned)h) << 16; float f; __builtin_memcpy(&f, &u, 4); return f; }
HD float silu_f(float x) { return x / (1.0f + expf(-x)); }
HD float sigmoid_f(float x) { return 1.0f / (1.0f + expf(-x)); }

struct Params {
    const float *x, *c, *ctx, *c_ctx, *w_ada, *b_ada, *norm_g, *final_g, *w_in_even, *w_out_even, *a_sink, *b_rpb;
    const float *w_in_odd, *w_out_odd, *c_qnorm, *c_knorm, *hy_short_w, *hy_short_b, *hy_w1, *hy_b1, *hy_f1, *hy_w2;
    const float *hy_b2, *hy_f2, *hy_w3, *hy_b3, *hy_bias, *w_router, *b_router, *moe_wg, *moe_wu, *moe_wd;
    float* out;
    float* XC;
    float* mod;
    float* ropet;
    float* h1;
    float* h2;
    float* HFT;
    float* hnorm;
    bf16_t* hbuf;
    bf16_t *QA, *KA, *VAt, *QB, *KB, *VBt;
    bf16_t *QC, *KC, *VCt, *UT;
    bf16_t* Y;
    bf16_t* YHT;
    float* Z1;
    bf16_t* HE;
    int* cnt;
    int* list;
    float* tokw;
    bf16_t *Wt_in_even, *Wt_out_even, *Wt_in_odd, *Wt_out_odd, *Wt_gu, *Wt_d;
    unsigned* bar;
    int* rpair;
    int* bh;
    float* rlog;
};

#define GS_LOOP(i, n) for (long i = (long)blockIdx.x * blockDim.x + threadIdx.x; i < (long)(n); i += (long)gridDim.x * blockDim.x)

HD const float* xrow_in(const Params& p, int l, int row) {
    if (l == 0) return row < TX ? p.x + (size_t)row * D_MODEL : p.ctx + (size_t)(row - TX) * D_MODEL;
    return row < TX ? p.out + (size_t)row * D_MODEL : p.XC + (size_t)(row - TX) * D_MODEL;
}
HD float* xrow_cur(const Params& p, int row) { return row < TX ? p.out + (size_t)row * D_MODEL : p.XC + (size_t)(row - TX) * D_MODEL; }
HD int row_mod(int row) { return row < TX ? row / SEQ : BATCH; }
HD const float* modp(const Params& p, int l, int row, int which) { return p.mod + ((size_t)(l * (BATCH + 1) + row_mod(row)) * 6 + which) * D_MODEL; }

GLOBAL void nk_mod(Params p) {
    GS_LOOP(i, DEPTH * (BATCH + 1) * 6 * D_MODEL) {
        int j = i % (6 * D_MODEL); int r = (i / (6 * D_MODEL)) % (BATCH + 1); int l = i / (6 * D_MODEL * (BATCH + 1));
        const float* cv = r < BATCH ? p.c + r * D_MODEL : p.c_ctx;
        const float* w = p.w_ada + (size_t)l * D_MODEL * 6 * D_MODEL;
        float acc = 0.f;
        for (int k = 0; k < D_MODEL; ++k) acc += silu_f(cv[k]) * w[(size_t)k * 6 * D_MODEL + j];
        p.mod[i] = acc + p.b_ada[l * 6 * D_MODEL + j];
    }
}
HD void d_rope(const Params& p) {
    GS_LOOP(i, 64 * 16) {
        int pos = i / 16, k = i % 16;
        float inv = powf(10000.0f, -(float)(2 * k) / 32.0f);
        float a = (float)pos * inv;
        p.ropet[pos * 32 + k] = cosf(a); p.ropet[pos * 32 + 16 + k] = sinf(a);
    }
}
HD void d_hy_h1(const Params& p) {
    GS_LOOP(i, SEQ * HY_FFN) {
        int t = i / HY_FFN, k = i % HY_FFN;
        float tn = (float)t / (float)(SEQ - 1);
        float acc = tn * p.hy_w1[0 * HY_FFN + k];
        for (int b = 0; b < HY_BANDS; ++b) {
            float band = 1e-4f + (float)b * ((float)(HY_BANDS - 1) - 1e-4f) / (float)(HY_BANDS - 1);
            float ang = 2.0f * 3.14159265358979323846f * (float)t * band / (float)SEQ;
            acc += cosf(ang) * p.hy_w1[(1 + b) * HY_FFN + k] + sinf(ang) * p.hy_w1[(1 + HY_BANDS + b) * HY_FFN + k];
        }
        p.h1[i] = sinf(p.hy_f1[k] * (acc + p.hy_b1[k]));
    }
}
HD void d_hy_h2(const Params& p) {
    GS_LOOP(i, SEQ * HY_FFN) {
        int t = i / HY_FFN, j = i % HY_FFN;
        float acc = 0.f;
        for (int k = 0; k < HY_FFN; ++k) acc += p.h1[t * HY_FFN + k] * p.hy_w2[k * HY_FFN + j];
        p.h2[i] = sinf(p.hy_f2[j] * (acc + p.hy_b2[j]));
    }
}
HD float hy_decay(int t, int c) {
    const float mind = logf(1e-2f) / 1.5f, maxd = logf(1e-2f) / 0.3f;
    float delta = fabsf(mind + (float)c * (maxd - mind) / (float)(D_CH - 1));
    float tn = (float)t / (float)(SEQ - 1);
    return expf(-tn * delta);
}
GLOBAL void nk_hy_filt(Params p) {
    GS_LOOP(i, 4 * D_CH * SEQ) {
        int t = i % SEQ, col = i / SEQ, c = col % D_CH;
        float acc = p.hy_b3[col];
        for (int k = 0; k < HY_FFN; ++k) acc += p.h2[t * HY_FFN + k] * p.hy_w3[k * 4 * D_CH + col];
        p.HFT[i] = acc * hy_decay(t, c);
    }
}
GLOBAL void nk_hy_norm(Params p) {
    GS_LOOP(i, 2 * D_CH) {
        int o = i / D_CH, c = i % D_CH;
        float s = 0.f;
        for (int dir = 0; dir < 2; ++dir) { const float* h = p.HFT + (size_t)((dir * 2 + o) * D_CH + c) * SEQ; for (int t = 0; t < SEQ; ++t) s += fabsf(h[t]); }
        p.hnorm[i] = s + EPS;
    }
}
GLOBAL void nk_zero_cnt(Params p) { GS_LOOP(i, 64) p.cnt[i] = 0; }

GLOBAL void nk_norm(Params p, int l, int which, int nrows) {
    GS_LOOP(row, nrows) {
        const float* xr = which == 0 ? xrow_in(p, l, (int)row) : xrow_cur(p, (int)row);
        float ss = 0.f;
        for (int k = 0; k < D_MODEL; ++k) ss += xr[k] * xr[k];
        float rstd = 1.0f / sqrtf(ss / D_MODEL + EPS);
        const float* g = p.norm_g + (l * 2 + which) * D_MODEL;
        const float* sh = modp(p, l, (int)row, which * 3 + 0); const float* sc = modp(p, l, (int)row, which * 3 + 1);
        for (int k = 0; k < D_MODEL; ++k) p.hbuf[row * D_MODEL + k] = f2bf(xr[k] * rstd * g[k] * (1.0f + sc[k]) + sh[k]);
    }
}

HD float dot_row(const bf16_t* a, const float* W, int ldw, int col, int K) {
    float acc = 0.f;
    for (int k = 0; k < K; ++k) acc += bf2f(a[k]) * W[(size_t)k * ldw + col];
    return acc;
}
HD float rope_apply(const Params& p, float v, float partner, int d, int s) {
    int half = d >> 5, dd = d & 31, k = dd & 15;
    int pos = half == 0 ? s / GRID_W : s % GRID_W;
    float c = p.ropet[pos * 32 + k], sn = p.ropet[pos * 32 + 16 + k];
    return dd < 16 ? v * c - partner * sn : v * c + partner * sn;
}

GLOBAL void nk_inproj_even(Params p) {
    GS_LOOP(i, (long)TT * EVEN_IN) {
        int row = i / EVEN_IN, col = i % EVEN_IN;
        const bf16_t* a = p.hbuf + (size_t)row * D_MODEL;
        float v = dot_row(a, p.w_in_even, EVEN_IN, col, D_MODEL);
        bool lat = row < TX; int b = lat ? row / SEQ : (row - TX) / CTX_LEN; int s = lat ? row % SEQ : (row - TX) % CTX_LEN;
        int pos = lat ? CTX_LEN + s : s;
        if (col < 640) {
            int d = col & 63;
            if (lat) { int pc = (d & 31) < 16 ? col + 16 : col - 16; float pv = dot_row(a, p.w_in_even, EVEN_IN, pc, D_MODEL); v = rope_apply(p, v, pv, d, s); }
            if (col < 512) p.QA[(size_t)row * 512 + col] = f2bf(v);
            else { int h = (col - 512) >> 6; p.KA[((size_t)(b * 2 + h) * LKV + pos) * 64 + d] = f2bf(v); }
        } else if (col < 768) { int h = (col - 640) >> 6, d = col & 63; p.VAt[((size_t)(b * 2 + h) * 64 + d) * LKV + pos] = f2bf(v); }
        else if (col < 1280) p.QB[(size_t)row * 512 + (col - 768)] = f2bf(v);
        else if (col < 1792) { int h = (col - 1280) >> 6, d = col & 63; p.KB[((size_t)(b * 8 + h) * LKV + pos) * 64 + d] = f2bf(v); }
        else { int h = (col - 1792) >> 6, d = col & 63; p.VBt[((size_t)(b * 8 + h) * 64 + d) * LKV + pos] = f2bf(v); }
    }
}

struct OSM { float m, l; };
#define ATT_BEGIN() float q[64], acc[64]; for (int d = 0; d < 64; ++d) { q[d] = bf2f(qp[d]) * ATTN_SCALE; acc[d] = 0.f; } float m_ = -1e30f, l_ = 0.f;
#define ATT_KEY(Kp, Vt, key, bias) do { const bf16_t* kk_ = (Kp) + (size_t)(key) * 64; float s_ = (bias); for (int d = 0; d < 64; ++d) s_ += q[d] * bf2f(kk_[d]); \
    float mn_ = fmaxf(m_, s_); float f_ = expf(m_ - mn_), pe_ = expf(s_ - mn_); l_ = l_ * f_ + pe_; \
    for (int d = 0; d < 64; ++d) acc[d] = acc[d] * f_ + pe_ * bf2f((Vt)[(size_t)d * LKV + (key)]); m_ = mn_; } while (0)
#define ATT_SINK(sv) do { float s_ = (sv); float mn_ = fmaxf(m_, s_); float f_ = expf(m_ - mn_); l_ = l_ * f_ + expf(s_ - mn_); for (int d = 0; d < 64; ++d) acc[d] *= f_; m_ = mn_; } while (0)

GLOBAL void nk_attnA(Params p) {
    GS_LOOP(i, (long)TX * 8) {
        int h = i % 8, row = i / 8, b = row / SEQ, s = row % SEQ, kvh = h / 4;
        const bf16_t* qp = p.QA + (size_t)row * 512 + h * 64;
        const bf16_t* Kp = p.KA + (size_t)(b * 2 + kvh) * LKV * 64; const bf16_t* Vt = p.VAt + (size_t)(b * 2 + kvh) * 64 * LKV;
        ATT_BEGIN();
        for (int j = 0; j < CTX_LEN; ++j) ATT_KEY(Kp, Vt, j, 0.f);
        int lo = s - A_WINDOW < 0 ? 0 : s - A_WINDOW, hi = s + A_WINDOW > SEQ - 1 ? SEQ - 1 : s + A_WINDOW;
        for (int j = lo; j <= hi; ++j) ATT_KEY(Kp, Vt, CTX_LEN + j, 0.f);
        ATT_SINK(p.a_sink[h]);
        for (int d = 0; d < 64; ++d) p.Y[(size_t)row * 1024 + h * 64 + d] = f2bf(acc[d] / l_);
    }
}
GLOBAL void nk_attnB(Params p) {
    GS_LOOP(i, (long)TX * 8) {
        int h = i % 8, row = i / 8, b = row / SEQ, s = row % SEQ, r = s / GRID_W, cq = s % GRID_W;
        const bf16_t* qp = p.QB + (size_t)row * 512 + h * 64;
        const bf16_t* Kp = p.KB + (size_t)(b * 8 + h) * LKV * 64; const bf16_t* Vt = p.VBt + (size_t)(b * 8 + h) * 64 * LKV;
        ATT_BEGIN();
        for (int j = 0; j < CTX_LEN; ++j) ATT_KEY(Kp, Vt, j, 0.f);
        int kh = B_WIN_H < GRID_H ? B_WIN_H : GRID_H;
        int rs = r - kh / 2; if (rs < 0) rs = 0; if (rs > GRID_H - kh) rs = GRID_H - kh;
        int cs = cq - B_WIN_W / 2; if (cs < 0) cs = 0; if (cs > GRID_W - B_WIN_W) cs = GRID_W - B_WIN_W;
        for (int kr = rs; kr < rs + kh; ++kr)
            for (int kc = cs; kc < cs + B_WIN_W; ++kc) {
                int dr = kr - r, dc = kc - cq;
                float bias = p.b_rpb[(h * (2 * B_WIN_H - 1) + dr + B_WIN_H - 1) * (2 * B_WIN_W - 1) + dc + B_WIN_W - 1];
                ATT_KEY(Kp, Vt, CTX_LEN + kr * GRID_W + kc, bias);
            }
        for (int d = 0; d < 64; ++d) p.Y[(size_t)row * 1024 + 512 + h * 64 + d] = f2bf(acc[d] / l_);
    }
}
GLOBAL void nk_attn_ctx(Params p) {
    GS_LOOP(i, (long)TC * 16) {
        int hh = i % 16, rc = i / 16, ty = hh / 8, h = hh % 8, b = rc / CTX_LEN; int row = TX + rc;
        const bf16_t* qp = (ty == 0 ? p.QA : p.QB) + (size_t)row * 512 + h * 64;
        const bf16_t* Kp = ty == 0 ? p.KA + (size_t)(b * 2 + h / 4) * LKV * 64 : p.KB + (size_t)(b * 8 + h) * LKV * 64;
        const bf16_t* Vt = ty == 0 ? p.VAt + (size_t)(b * 2 + h / 4) * 64 * LKV : p.VBt + (size_t)(b * 8 + h) * 64 * LKV;
        ATT_BEGIN();
        for (int j = 0; j < CTX_LEN; ++j) ATT_KEY(Kp, Vt, j, 0.f);
        if (ty == 0) ATT_SINK(p.a_sink[h]);
        for (int d = 0; d < 64; ++d) p.Y[(size_t)row * 1024 + ty * 512 + h * 64 + d] = f2bf(acc[d] / l_);
    }
}
GLOBAL void nk_attnC(Params p) {
    GS_LOOP(i, (long)TX * 8) {
        int h = i % 8, row = i / 8, b = row / SEQ, kvh = h / 4;
        const bf16_t* qp = p.QC + (size_t)row * 512 + h * 64;
        const bf16_t* Kp = p.KC + (size_t)(b * 2 + kvh) * LKV * 64; const bf16_t* Vt = p.VCt + (size_t)(b * 2 + kvh) * 64 * LKV;
        ATT_BEGIN();
        for (int j = 0; j < LKV; ++j) ATT_KEY(Kp, Vt, j, 0.f);
        for (int d = 0; d < 64; ++d) p.Y[(size_t)row * 1024 + h * 64 + d] = f2bf(acc[d] / l_);
    }
}

GLOBAL void nk_outproj_even(Params p) {
    GS_LOOP(i, (long)TT * D_MODEL) {
        int row = i / D_MODEL, col = i % D_MODEL;
        float acc = dot_row(p.Y + (size_t)row * 1024, p.w_out_even, D_MODEL, col, EVEN_OUT);
        xrow_cur(p, row)[col] = xrow_in(p, 0, row)[col] + modp(p, 0, row, 2)[col] * acc;
    }
}
GLOBAL void nk_outproj_odd(Params p) {
    GS_LOOP(i, (long)TX * D_MODEL) {
        int row = i / D_MODEL, col = i % D_MODEL, b = row / SEQ, s = row % SEQ;
        float acc = dot_row(p.Y + (size_t)row * 1024, p.w_out_odd, D_MODEL, col, 512);
        for (int c = 0; c < D_CH; ++c) acc += bf2f(p.YHT[((size_t)b * D_CH + c) * SEQ + s]) * p.w_out_odd[(size_t)(512 + c) * D_MODEL + col];
        p.out[i] = p.out[i] + modp(p, 1, row, 2)[col] * acc;
    }
}

GLOBAL void nk_router(Params p, int l, int nrows) {
    GS_LOOP(row, nrows) {
        const float* xr = xrow_cur(p, (int)row);
        float ss = 0.f;
        for (int k = 0; k < D_MODEL; ++k) ss += xr[k] * xr[k];
        float rstd = 1.0f / sqrtf(ss / D_MODEL + EPS);
        const float* g = p.norm_g + (l * 2 + 1) * D_MODEL; const float* sh = modp(p, l, (int)row, 3); const float* sc = modp(p, l, (int)row, 4);
        float lg[16];
#pragma unroll
        for (int e = 0; e < 16; ++e) lg[e] = 0.f;
        for (int k = 0; k < D_MODEL; ++k) { float hv = xr[k] * rstd * g[k] * (1.0f + sc[k]) + sh[k];
#pragma unroll
            for (int e = 0; e < 16; ++e) lg[e] += hv * p.w_router[k * 16 + e]; }
        int gbest = 0, a = 0, bb = 1; float gbs = -1e30f, wa = 0.f, wb = 0.f;
#pragma unroll
        for (int gI = 0; gI < 4; ++gI) {
            float m1 = -1e30f, m2 = -1e30f, s1 = 0.f, s2 = 0.f; int i1 = 0, i2 = 0;
#pragma unroll
            for (int j = 0; j < 4; ++j) { float sgv = sigmoid_f(lg[gI * 4 + j]); float v = sgv + p.b_router[gI * 4 + j];
                if (v > m1) { m2 = m1; i2 = i1; s2 = s1; m1 = v; i1 = j; s1 = sgv; } else if (v > m2) { m2 = v; i2 = j; s2 = sgv; } }
            float gs = m1 + m2;
            if (gs > gbs) { gbs = gs; gbest = gI; if (i1 < i2) { a = i1; bb = i2; wa = s1; wb = s2; } else { a = i2; bb = i1; wa = s2; wb = s1; } }
        }
        float inv = 1.0f / (wa + wb);
        int pidx = a == 0 ? bb - 1 : (a == 1 ? bb + 1 : 5);
        int pr = gbest * 6 + pidx;
        int pos = atomicAdd(p.cnt + l * 32 + pr, 1);
        p.list[(size_t)pr * TT + pos] = (int)row;
        p.tokw[row * 2 + 0] = wa * inv; p.tokw[row * 2 + 1] = wb * inv;
    }
}
HD void pair_experts(int pr, int& e1, int& e2) { int g = pr / 6, q = pr % 6; int a = q < 3 ? 0 : (q < 5 ? 1 : 2); int b = q < 3 ? q + 1 : (q < 5 ? q - 1 : 3); e1 = g * 4 + a; e2 = g * 4 + b; }
HD bool slot_lookup(const Params& p, int l, int slot, int& pr, int& row) { int acc = 0; for (int q = 0; q < NPAIR; ++q) { int c = p.cnt[l * 32 + q]; if (slot < acc + c) { pr = q; row = p.list[(size_t)q * TT + (slot - acc)]; return true; } acc += c; } return false; }
GLOBAL void nk_moe_up(Params p, int l, int nrows) {
    GS_LOOP(i, (long)nrows * HE_W) {
        int slot = i / HE_W, j = i % HE_W, k = j / D_EXPERT, jj = j % D_EXPERT; int pr, row; if (!slot_lookup(p, l, slot, pr, row)) continue;
        int e1, e2; pair_experts(pr, e1, e2); int e = k == 0 ? e1 : e2;
        const bf16_t* a = p.hbuf + (size_t)row * D_MODEL;
        const float* wg = p.moe_wg + (size_t)(l * N_EXPERTS + e) * D_MODEL * D_EXPERT; const float* wu = p.moe_wu + (size_t)(l * N_EXPERTS + e) * D_MODEL * D_EXPERT;
        float g = dot_row(a, wg, D_EXPERT, jj, D_MODEL), u = dot_row(a, wu, D_EXPERT, jj, D_MODEL);
        p.HE[(size_t)row * HE_W + j] = f2bf(p.tokw[row * 2 + k] * silu_f(g) * u);
    }
}
GLOBAL void nk_moe_down(Params p, int l, int nrows) {
    GS_LOOP(i, (long)nrows * D_MODEL) {
        int slot = i / D_MODEL, col = i % D_MODEL; int pr, row; if (!slot_lookup(p, l, slot, pr, row)) continue;
        int e1, e2; pair_experts(pr, e1, e2);
        const bf16_t* a = p.HE + (size_t)row * HE_W;
        float acc = dot_row(a, p.moe_wd + (size_t)(l * N_EXPERTS + e1) * D_EXPERT * D_MODEL, D_MODEL, col, D_EXPERT)
                  + dot_row(a + D_EXPERT, p.moe_wd + (size_t)(l * N_EXPERTS + e2) * D_EXPERT * D_MODEL, D_MODEL, col, D_EXPERT);
        float* xr = xrow_cur(p, row);
        xr[col] = xr[col] + modp(p, l, row, 5)[col] * acc;
    }
}

GLOBAL void nk_inproj_odd_qk(Params p) {
    GS_LOOP(i, (long)TT * 10) {
        int row = i / 10, hu = i % 10; const bf16_t* a = p.hbuf + (size_t)row * D_MODEL;
        bool lat = row < TX; int b = lat ? row / SEQ : (row - TX) / CTX_LEN; int s = lat ? row % SEQ : (row - TX) % CTX_LEN; int pos = lat ? CTX_LEN + s : s;
        int col0 = hu * 64;
        float v[64]; float ss = 0.f;
        for (int d = 0; d < 64; ++d) { v[d] = dot_row(a, p.w_in_odd, ODD_IN, col0 + d, D_MODEL); ss += v[d] * v[d]; }
        float rstd = 1.0f / sqrtf(ss / 64.0f + EPS);
        const float* gn = hu < 8 ? p.c_qnorm : p.c_knorm;
        for (int d = 0; d < 64; ++d) v[d] = v[d] * rstd * gn[d];
        for (int d = 0; d < 64; ++d) {
            float o = v[d];
            if (lat) { int pd = (d & 31) < 16 ? d + 16 : d - 16; o = rope_apply(p, v[d], v[pd], d, s); }
            if (hu < 8) p.QC[(size_t)row * 512 + col0 + d] = f2bf(o);
            else p.KC[((size_t)(b * 2 + (hu - 8)) * LKV + pos) * 64 + d] = f2bf(o);
        }
    }
}
GLOBAL void nk_inproj_odd_vu(Params p) {
    GS_LOOP(i, (long)TT * (ODD_IN - 640)) {
        int row = i / (ODD_IN - 640), col = 640 + i % (ODD_IN - 640); const bf16_t* a = p.hbuf + (size_t)row * D_MODEL;
        bool lat = row < TX; int b = lat ? row / SEQ : (row - TX) / CTX_LEN; int s = lat ? row % SEQ : (row - TX) % CTX_LEN; int pos = lat ? CTX_LEN + s : s;
        if (col >= 768 && !lat) continue;
        float v = dot_row(a, p.w_in_odd, ODD_IN, col, D_MODEL);
        if (col < 768) { int h = (col - 640) >> 6, d = col & 63; p.VCt[((size_t)(b * 2 + h) * 64 + d) * LKV + pos] = f2bf(v); }
        else p.UT[((size_t)b * 3 * D_CH + (col - 768)) * SEQ + s] = f2bf(v);
    }
}

HD float hy_sc(const Params& p, int b, int ch, int t) {
    const bf16_t* u = p.UT + ((size_t)b * 3 * D_CH + ch) * SEQ;
    float acc = p.hy_short_b[ch];
    for (int kk = 0; kk < 3; ++kk) { int tt = t + kk - 1; if (tt >= 0 && tt < SEQ) acc += p.hy_short_w[kk * 3 * D_CH + ch] * bf2f(u[tt]); }
    return acc;
}
GLOBAL void nk_hy_conv(Params p, int o) {
    GS_LOOP(i, (long)BATCH * D_CH * SEQ) {
        int n = i % SEQ, c = (i / SEQ) % D_CH, b = i / ((long)SEQ * D_CH);
        const float* hf = p.HFT + (size_t)((0 * 2 + o) * D_CH + c) * SEQ; const float* hb = p.HFT + (size_t)((1 * 2 + o) * D_CH + c) * SEQ;
        float inv = 1.0f / p.hnorm[o * D_CH + c];
        float acc = 0.f;
        for (int m = 0; m < SEQ; ++m) {
            float z = o == 0 ? hy_sc(p, b, c, m) : p.Z1[((size_t)b * D_CH + c) * SEQ + m];
            int d = n - m; float hv = d >= 0 ? hf[d] : hb[-d];
            acc += hv * z;
        }
        acc *= inv;
        float zn = o == 0 ? hy_sc(p, b, c, n) : p.Z1[((size_t)b * D_CH + c) * SEQ + n];
        float g = hy_sc(p, b, (o + 1) * D_CH + c, n);
        float r = g * (acc + zn * p.hy_bias[o * D_CH + c]);
        if (o == 0) p.Z1[i] = r; else p.YHT[i] = f2bf(r);
    }
}

GLOBAL void nk_final(Params p) {
    GS_LOOP(row, TX) {
        float* xr = p.out + (size_t)row * D_MODEL; float ss = 0.f;
        for (int k = 0; k < D_MODEL; ++k) ss += xr[k] * xr[k];
        float rstd = 1.0f / sqrtf(ss / D_MODEL + EPS);
        for (int k = 0; k < D_MODEL; ++k) xr[k] = xr[k] * rstd * p.final_g[k];
    }
}
GLOBAL void nk_yht_to_y(Params p) {
    GS_LOOP(i, (long)TX * D_CH) { int row = i / D_CH, c = i % D_CH, b = row / SEQ, s = row % SEQ; p.Y[(size_t)row * 1024 + 512 + c] = p.YHT[((size_t)b * D_CH + c) * SEQ + s]; }
}

GLOBAL void nk_rope(Params p) { d_rope(p); }
GLOBAL void nk_hy_h1(Params p) { d_hy_h1(p); }
GLOBAL void nk_hy_h2(Params p) { d_hy_h2(p); }
static inline size_t al256(size_t x) { return (x + 255) & ~(size_t)255; }
static size_t setup_ws(Params& p, char* ws) {
    size_t o = 0;
    auto take = [&](size_t bytes) { char* r = ws + o; o += al256(bytes); return r; };
    p.bar = (unsigned*)take(64 * 1024);
    p.cnt = (int*)take(256);
    p.XC = (float*)take((size_t)TC * D_MODEL * 4);
    p.mod = (float*)take((size_t)DEPTH * (BATCH + 1) * 6 * D_MODEL * 4);
    p.ropet = (float*)take(64 * 32 * 4);
    p.h1 = (float*)take((size_t)SEQ * 64 * 4);
    p.h2 = (float*)take((size_t)SEQ * 64 * 4);
    p.HFT = (float*)take((size_t)4 * D_CH * SEQ * 4);
    p.hnorm = (float*)take(2 * D_CH * 4);
    p.list = (int*)take((size_t)NPAIR * TT * 4);
    p.tokw = (float*)take((size_t)TT * 2 * 4);
    p.rpair = (int*)take((size_t)TT * 4);
    p.bh = (int*)take((size_t)2048 * 32 * 4);
    p.rlog = (float*)take((size_t)TT * 16 * 4);
    size_t hb = (size_t)TT * D_MODEL * 2, z1 = (size_t)BATCH * D_CH * SEQ * 4;
    char* r0 = take(hb > z1 ? hb : z1); p.hbuf = (bf16_t*)r0; p.Z1 = (float*)r0;
    size_t q = al256((size_t)TT * 512 * 2), kva = al256((size_t)BATCH * 2 * LKV * 64 * 2), kvb = al256((size_t)BATCH * 8 * LKV * 64 * 2), ut = al256((size_t)BATCH * 3 * D_CH * SEQ * 2);
    size_t l0 = 2 * q + 2 * kva + 2 * kvb, l1 = q + 2 * kva + ut;
    char* R = take(l0 > l1 ? l0 : l1);
    p.QA = (bf16_t*)R; p.KA = (bf16_t*)(R + q); p.VAt = (bf16_t*)(R + q + kva); p.QB = (bf16_t*)(R + q + 2 * kva); p.KB = (bf16_t*)(R + 2 * q + 2 * kva); p.VBt = (bf16_t*)(R + 2 * q + 2 * kva + kvb);
    p.QC = (bf16_t*)R; p.KC = (bf16_t*)(R + q); p.VCt = (bf16_t*)(R + q + kva); p.UT = (bf16_t*)(R + q + 2 * kva);
    size_t yb = (size_t)TT * 1024 * 2, heb = (size_t)TT * HE_W * 2;
    char* r1 = take(yb > heb ? yb : heb); p.Y = (bf16_t*)r1; p.HE = (bf16_t*)r1;
    p.YHT = (bf16_t*)take((size_t)BATCH * D_CH * SEQ * 2);
    p.Wt_in_even = (bf16_t*)take((size_t)EVEN_IN * D_MODEL * 2);
    p.Wt_out_even = (bf16_t*)take((size_t)D_MODEL * EVEN_OUT * 2);
    p.Wt_in_odd = (bf16_t*)take((size_t)ODD_IN * D_MODEL * 2);
    p.Wt_out_odd = (bf16_t*)take((size_t)D_MODEL * ODD_OUT * 2);
    p.Wt_gu = (bf16_t*)take((size_t)DEPTH * N_EXPERTS * 2 * D_EXPERT * D_MODEL * 2);
    p.Wt_d = (bf16_t*)take((size_t)DEPTH * N_EXPERTS * D_MODEL * D_EXPERT * 2);
    return o;
}
static void fill_inputs(Params& p, void* const* d_in, void* d_out) {
    const float** f = (const float**)&p.x;
    for (int i = 0; i < 32; ++i) f[i] = (const float*)d_in[i];
    p.out = (float*)d_out;
}
#define LAS __attribute__((address_space(3)))
typedef short bf16x8 __attribute__((ext_vector_type(8)));
typedef float f32x4 __attribute__((ext_vector_type(4)));
typedef float f32x16 __attribute__((ext_vector_type(16)));
typedef unsigned u32x4 __attribute__((ext_vector_type(4)));
typedef unsigned u32x2 __attribute__((ext_vector_type(2)));

constexpr int NTHREADS = 256;
constexpr int LDS_BYTES = 69632;
constexpr int MT_ALL = TT / 128, MT_LAT = TX / 128;

__device__ __forceinline__ unsigned pk2bf(float lo, float hi) { return (unsigned)f2bf(lo) | ((unsigned)f2bf(hi) << 16); }
__device__ __forceinline__ float wave_sum(float v) {
#pragma unroll
    for (int o = 1; o < 64; o <<= 1) v += __shfl_xor(v, o);
    return v;
}

template <class DstF>
__device__ __forceinline__ void cvt_block_item(char* lds, const float* W, int N, int k0, int n0, const DstF& dst) {
    float* T = (float*)lds; const int tid = threadIdx.x;
    f32x4 v[16];
#pragma unroll
    for (int i = 0; i < 16; ++i) v[i] = *(const f32x4*)(W + (size_t)(k0 + (tid >> 6) + 4 * i) * N + n0 + 4 * (tid & 63));
#pragma unroll
    for (int i = 0; i < 16; ++i) *(f32x4*)(T + ((tid >> 6) + 4 * i) * 260 + 4 * (tid & 63)) = v[i];
    __syncthreads();
    bf16_t* d = dst(n0 + tid) + k0; const float* s = T + tid;
#pragma unroll
    for (int c = 0; c < 8; ++c) { u32x4 w; w.x = pk2bf(s[(8 * c + 0) * 260], s[(8 * c + 1) * 260]); w.y = pk2bf(s[(8 * c + 2) * 260], s[(8 * c + 3) * 260]);
        w.z = pk2bf(s[(8 * c + 4) * 260], s[(8 * c + 5) * 260]); w.w = pk2bf(s[(8 * c + 6) * 260], s[(8 * c + 7) * 260]); *(u32x4*)(d + 8 * c) = w; }
    __syncthreads();
}
__device__ __forceinline__ void cvt_plain(char* lds, const float* W, bf16_t* Wt, int K, int N, int item) {
    const int nb = N / 256, kb = item / nb, nbi = item % nb;
    cvt_block_item(lds, W, N, kb * 64, nbi * 256, [&](int n) { return Wt + (size_t)n * K; });
}
constexpr int CVT_IN = (D_MODEL / 64) * (EVEN_IN / 256), CVT_OUT = (D_MODEL / 64) * (D_MODEL / 256), CVT_GU1 = (D_MODEL / 64) * (D_EXPERT / 256), CVT_D1 = (D_EXPERT / 64) * (D_MODEL / 256);
constexpr int CVT_GU = DEPTH * N_EXPERTS * 2 * CVT_GU1, CVT_D = DEPTH * N_EXPERTS * CVT_D1;
constexpr int CVT_TOTAL = 2 * CVT_IN + 2 * CVT_OUT + CVT_GU + CVT_D;
constexpr int CVT_EARLY = 2 * CVT_IN + 2 * CVT_OUT;
static_assert(EVEN_IN % 256 == 0 && ODD_IN % 256 == 0 && D_EXPERT % 256 == 0, "conversion tile");
__device__ __forceinline__ void cvt_item(const Params& p, char* lds, int it) {
    if (it < CVT_IN) { cvt_plain(lds, p.w_in_even, p.Wt_in_even, D_MODEL, EVEN_IN, it); return; } it -= CVT_IN;
    if (it < CVT_IN) { cvt_plain(lds, p.w_in_odd, p.Wt_in_odd, D_MODEL, ODD_IN, it); return; } it -= CVT_IN;
    if (it < CVT_OUT) { cvt_plain(lds, p.w_out_even, p.Wt_out_even, EVEN_OUT, D_MODEL, it); return; } it -= CVT_OUT;
    if (it < CVT_OUT) { cvt_plain(lds, p.w_out_odd, p.Wt_out_odd, ODD_OUT, D_MODEL, it); return; } it -= CVT_OUT;
    if (it < CVT_GU) {
        const int le = it / (2 * CVT_GU1), r = it % (2 * CVT_GU1), half = r / CVT_GU1, r2 = r % CVT_GU1; const int nb = D_EXPERT / 256, kb = r2 / nb, nbi = r2 % nb;
        const float* W = (half ? p.moe_wu : p.moe_wg) + (size_t)le * D_MODEL * D_EXPERT; bf16_t* Wt = p.Wt_gu + (size_t)le * 2 * D_EXPERT * D_MODEL;
        cvt_block_item(lds, W, D_EXPERT, kb * 64, nbi * 256, [&](int n) { return Wt + (size_t)(32 * (n >> 4) + 16 * half + (n & 15)) * D_MODEL; });
        return; } it -= CVT_GU;
    { const int le = it / CVT_D1, r = it % CVT_D1; cvt_plain(lds, p.moe_wd + (size_t)le * D_EXPERT * D_MODEL, p.Wt_d + (size_t)le * D_MODEL * D_EXPERT, D_EXPERT, D_MODEL, r); }
}
__device__ __forceinline__ void cvt_range(const Params& p, char* lds, int lo, int hi, int bid, int nb) {
    for (int it = lo + bid; it < hi; it += nb) cvt_item(p, lds, it);
}

struct TileGeom { int tid, lane, wid, wr, wc, l15, q, srow, schunk;
    __device__ __forceinline__ int drow(int i) const { return wid * 32 + i * 8 + (lane >> 3); }
    __device__ __forceinline__ int dchunk(int i) const { return (lane & 7) ^ (((lane >> 4) + 4 * i) & 7); } };
__device__ __forceinline__ TileGeom tile_geom() { TileGeom g; g.tid = threadIdx.x; g.lane = g.tid & 63; g.wid = __builtin_amdgcn_readfirstlane(g.tid >> 6); g.wr = g.wid >> 1; g.wc = g.wid & 1; g.l15 = g.lane & 15; g.q = g.lane >> 4; g.srow = g.tid >> 3; g.schunk = g.tid & 7; return g; }

template <class ALoad, class BLoad>
__device__ __forceinline__ void gemm_mainloop(char* lds, const TileGeom& g, int nk, const ALoad& AL, const BLoad& BL, f32x4 (&acc)[4][4]) {
#pragma unroll
    for (int i = 0; i < 4; ++i)
#pragma unroll
        for (int j = 0; j < 4; ++j) acc[i][j] = (f32x4){0.f, 0.f, 0.f, 0.f};
    const int swz = g.l15 >> 1;
    const int aofs = (g.wr * 64 + g.l15) * 128 + ((g.q ^ swz) << 4);
    const int bofs = 32768 + (g.wc * 64 + g.l15) * 128 + ((g.q ^ swz) << 4);
    LAS char* l3 = (LAS char*)lds;
    const int dbase = g.wid * 4096;
#define GEMM_STAGE(kt_, buf_) do { _Pragma("unroll") for (int i_ = 0; i_ < 4; ++i_) { \
        __builtin_amdgcn_global_load_lds((const unsigned*)AL(i_, (kt_)), (LAS unsigned*)(l3 + (buf_) + dbase + i_ * 1024), 16, 0, 0); \
        __builtin_amdgcn_global_load_lds((const unsigned*)BL(i_, (kt_)), (LAS unsigned*)(l3 + 32768 + (buf_) + dbase + i_ * 1024), 16, 0, 0); } } while (0)
#define GEMM_BAR() do { __builtin_amdgcn_s_barrier(); asm volatile("" ::: "memory"); } while (0)
    GEMM_STAGE(0, 0);
    if (nk > 1) GEMM_STAGE(1, 16384);
    asm volatile("s_waitcnt vmcnt(0) lgkmcnt(0)" ::: "memory");
    GEMM_BAR();
    for (int kt = 0; kt < nk; ++kt) {
        const int cur = (kt & 1) * 16384;
        bf16x8 af[2][4], bfr[2][4];
#pragma unroll
        for (int kk = 0; kk < 2; ++kk)
#pragma unroll
            for (int i = 0; i < 4; ++i) { af[kk][i] = *(const bf16x8*)(lds + cur + ((aofs + i * 2048) ^ (kk * 64))); bfr[kk][i] = *(const bf16x8*)(lds + cur + ((bofs + i * 2048) ^ (kk * 64))); }
        asm volatile("s_waitcnt lgkmcnt(0)" ::: "memory");
        GEMM_BAR();
        if (kt + 2 < nk) GEMM_STAGE(kt + 2, cur);
#pragma unroll
        for (int kk = 0; kk < 2; ++kk)
#pragma unroll
            for (int mi = 0; mi < 4; ++mi)
#pragma unroll
                for (int ni = 0; ni < 4; ++ni) acc[mi][ni] = __builtin_amdgcn_mfma_f32_16x16x32_bf16(bfr[kk][ni], af[kk][mi], acc[mi][ni], 0, 0, 0);
        if (kt + 1 < nk) {
            if (kt + 2 < nk) asm volatile("s_waitcnt vmcnt(8)" ::: "memory"); else asm volatile("s_waitcnt vmcnt(0)" ::: "memory");
            GEMM_BAR();
        }
    }
#undef GEMM_STAGE
#undef GEMM_BAR
}

template <class DstF>
__device__ __forceinline__ void store_transposed(char* lds, const TileGeom& g, const f32x4 (&acc)[4][4], const DstF& dst) {
    bf16_t* T = (bf16_t*)lds;
#pragma unroll
    for (int mi = 0; mi < 4; ++mi)
#pragma unroll
        for (int ni = 0; ni < 4; ++ni)
#pragma unroll
            for (int r = 0; r < 4; ++r) T[(g.wc * 64 + ni * 16 + g.q * 4 + r) * 136 + g.wr * 64 + mi * 16 + g.l15] = f2bf(acc[mi][ni][r]);
    __syncthreads();
    { int col = g.tid >> 1, half = g.tid & 1; bf16_t* d = dst(col) + half * 64; const bf16_t* s = T + col * 136 + half * 64;
#pragma unroll
      for (int j = 0; j < 8; ++j) *(u32x4*)(d + j * 8) = *(const u32x4*)(s + j * 8); }
    __syncthreads();
}
__device__ __forceinline__ void store4bf(bf16_t* d, const f32x4& v) { u32x2 w; w.x = pk2bf(v[0], v[1]); w.y = pk2bf(v[2], v[3]); *(u32x2*)d = w; }
__device__ __forceinline__ void rope_head(const Params& p, f32x4 (&a)[4], int s, int q) {
    const int pr = s / GRID_W, pc = s % GRID_W;
    const f32x4 cr = *(const f32x4*)(p.ropet + pr * 32 + q * 4), sr = *(const f32x4*)(p.ropet + pr * 32 + 16 + q * 4);
    const f32x4 cc = *(const f32x4*)(p.ropet + pc * 32 + q * 4), sc = *(const f32x4*)(p.ropet + pc * 32 + 16 + q * 4);
    f32x4 x1 = a[0], x2 = a[1]; a[0] = x1 * cr - x2 * sr; a[1] = x2 * cr + x1 * sr;
    x1 = a[2]; x2 = a[3]; a[2] = x1 * cc - x2 * sc; a[3] = x2 * cc + x1 * sc;
}

template <int LAYER>
__device__ __forceinline__ void inproj_tile(const Params& p, char* lds, int mt, int nt) {
    const TileGeom g = tile_geom();
    const bf16_t* Abase = p.hbuf + (size_t)(mt * 128) * D_MODEL;
    const bf16_t* Bbase = (LAYER == 0 ? p.Wt_in_even : p.Wt_in_odd) + (size_t)(nt * 128) * D_MODEL;
    f32x4 acc[4][4];
    gemm_mainloop(lds, g, D_MODEL / 64, [&](int i, int kt) { return Abase + (size_t)g.drow(i) * D_MODEL + kt * 64 + g.dchunk(i) * 8; }, [&](int i, int kt) { return Bbase + (size_t)g.drow(i) * D_MODEL + kt * 64 + g.dchunk(i) * 8; }, acc);
    const bool lat = mt < MT_LAT; const int row0 = mt * 128;
    const int b = lat ? row0 / SEQ : (row0 - TX) / CTX_LEN, s0 = lat ? row0 % SEQ : (row0 - TX) % CTX_LEN, pos0 = lat ? CTX_LEN + s0 : s0;
    int kind;
    bf16_t* base; int h0 = 0, qcol0 = 0, nh = 2;
    if (LAYER == 0) {
        if (nt < 4) { kind = 0; base = p.QA; qcol0 = nt * 128; }
        else if (nt == 4) { kind = 1; base = p.KA; h0 = 0; nh = 2; }
        else if (nt == 5) { kind = 2; base = p.VAt; h0 = 0; nh = 2; }
        else if (nt < 10) { kind = 0; base = p.QB; qcol0 = (nt - 6) * 128; }
        else if (nt < 14) { kind = 1; base = p.KB; h0 = (nt - 10) * 2; nh = 8; }
        else { kind = 2; base = p.VBt; h0 = (nt - 14) * 2; nh = 8; }
    } else {
        if (nt < 4) { kind = 0; base = p.QC; qcol0 = nt * 128; }
        else if (nt == 4) { kind = 1; base = p.KC; h0 = 0; nh = 2; }
        else if (nt == 5) { kind = 2; base = p.VCt; h0 = 0; nh = 2; }
        else { kind = 3; base = p.UT; }
    }
    if (kind <= 1) {
        const bool rope = lat && (LAYER == 1 || nt <= 4);
#pragma unroll
        for (int mi = 0; mi < 4; ++mi) {
            const int rowl = g.wr * 64 + mi * 16 + g.l15;
            if (LAYER == 1) {
                float ss = 0.f;
#pragma unroll
                for (int ni = 0; ni < 4; ++ni) ss += acc[mi][ni][0] * acc[mi][ni][0] + acc[mi][ni][1] * acc[mi][ni][1] + acc[mi][ni][2] * acc[mi][ni][2] + acc[mi][ni][3] * acc[mi][ni][3];
                ss += __shfl_xor(ss, 16); ss += __shfl_xor(ss, 32);
                const float rstd = 1.0f / sqrtf(ss * (1.0f / 64.0f) + EPS);
                const float* gn = kind == 0 ? p.c_qnorm : p.c_knorm;
#pragma unroll
                for (int ni = 0; ni < 4; ++ni) acc[mi][ni] = acc[mi][ni] * rstd * *(const f32x4*)(gn + ni * 16 + g.q * 4);
            }
            if (rope) rope_head(p, acc[mi], s0 + rowl, g.q);
            bf16_t* d = kind == 0 ? base + (size_t)(row0 + rowl) * 512 + qcol0 + g.wc * 64 + g.q * 4
                                  : base + ((size_t)(b * nh + h0 + g.wc) * LKV + pos0 + rowl) * 64 + g.q * 4;
#pragma unroll
            for (int ni = 0; ni < 4; ++ni) store4bf(d + ni * 16, acc[mi][ni]);
        }
    } else if (kind == 2) {
        store_transposed(lds, g, acc, [&](int col) { return base + ((size_t)(b * nh + h0 + (col >> 6)) * 64 + (col & 63)) * LKV + pos0; });
    } else {
        store_transposed(lds, g, acc, [&](int col) { return base + ((size_t)b * 3 * D_CH + (nt - 6) * 128 + col) * SEQ + s0; });
    }
}
template <int LAYER>
__device__ __forceinline__ void ph_inproj(const Params& p, char* lds, int bid, int nb) {
    constexpr int NT = 18;
    const bool xl = (nb & 7) == 0; const int x = xl ? bid & 7 : 0, step = xl ? nb >> 3 : nb, mstep = xl ? 8 : 1;
    if (LAYER == 0) {
        for (int t = xl ? bid >> 3 : bid; ; t += step) { const int mt = (t / NT) * mstep + x, nt = t % NT; if (mt >= MT_ALL) break; inproj_tile<0>(p, lds, mt, nt); }
    } else {
        const int nlat_t = (MT_LAT / mstep) * NT;
        for (int t = xl ? bid >> 3 : bid; ; t += step) {
            int mt, nt;
            if (t < nlat_t) { mt = (t / NT) * mstep + x; nt = t % NT; }
            else { const int u = t - nlat_t; mt = MT_LAT + (u / 2) * mstep + x; nt = 4 + u % 2; if (mt >= MT_ALL) break; }
            inproj_tile<1>(p, lds, mt, nt);
        }
    }
}

template <int LAYER>
__device__ __forceinline__ void outproj_tile(const Params& p, char* lds, int mt, int nt) {
    const TileGeom g = tile_geom();
    const bf16_t* Abase = p.Y + (size_t)(mt * 128) * 1024;
    const bf16_t* Bbase = (LAYER == 0 ? p.Wt_out_even : p.Wt_out_odd) + (size_t)(nt * 128) * 1024;
    f32x4 acc[4][4];
    gemm_mainloop(lds, g, 16, [&](int i, int kt) { return Abase + (size_t)g.drow(i) * 1024 + kt * 64 + g.dchunk(i) * 8; }, [&](int i, int kt) { return Bbase + (size_t)g.drow(i) * 1024 + kt * 64 + g.dchunk(i) * 8; }, acc);
    const int row0 = mt * 128;
#pragma unroll
    for (int mi = 0; mi < 4; ++mi) {
        const int row = row0 + g.wr * 64 + mi * 16 + g.l15;
        const float* xin = xrow_in(p, LAYER, row); float* xo = xrow_cur(p, row); const float* gate = modp(p, LAYER, row, 2);
#pragma unroll
        for (int ni = 0; ni < 4; ++ni) { const int col = nt * 128 + g.wc * 64 + ni * 16 + g.q * 4;
            *(f32x4*)(xo + col) = *(const f32x4*)(xin + col) + *(const f32x4*)(gate + col) * acc[mi][ni]; }
    }
}

template <int LAYER>
__device__ __forceinline__ void ph_outproj(const Params& p, char* lds, int bid, int nb) {
    const int nmt = LAYER == 0 ? MT_ALL : MT_LAT;
    const bool xl = (nb & 7) == 0; const int x = xl ? bid & 7 : 0, step = xl ? nb >> 3 : nb, mstep = xl ? 8 : 1;
    for (int t = xl ? bid >> 3 : bid; ; t += step) { const int mt = (t / 8) * mstep + x, nt = t % 8; if (mt >= nmt) break; outproj_tile<LAYER>(p, lds, mt, nt); }
}

template <int NTN>
__device__ __forceinline__ bool moe_tile_lookup(const int* cnt, int t, int& pr, int& mt, int& nt, int& n) {
    int acc = 0;
    for (int q = 0; q < NPAIR; ++q) { const int c = __builtin_amdgcn_readfirstlane(cnt[q]); const int tiles = ((c + 127) >> 7) * NTN; if (t < acc + tiles) { pr = q; const int u = t - acc; mt = u / NTN; nt = u % NTN; n = c; return true; } acc += tiles; }
    return false;
}
template <int NTN>
__device__ __forceinline__ bool moe_tile_lookup_xcd(const int* cnt, int xcd, int t, int& pr, int& mt, int& nt, int& n) {
    int acc = 0;
#pragma unroll
    for (int i = 0; i < NPAIR / 8; ++i) { const int q = xcd + 8 * i; const int c = __builtin_amdgcn_readfirstlane(cnt[q]); const int tiles = ((c + 127) >> 7) * NTN;
        if (t < acc + tiles) { pr = q; const int u = t - acc; mt = u / NTN; nt = u % NTN; n = c; return true; } acc += tiles; }
    return false;
}
__device__ __forceinline__ void moe_up_tile(const Params& p, char* lds, int l, int pr, int mt, int nt, int n) {
    const TileGeom g = tile_geom();
    int e1, e2; pair_experts(pr, e1, e2); const int k = nt >> 3, e = k ? e2 : e1;
    const int* lst = p.list + (size_t)pr * TT + mt * 128;
    const int navail = n - mt * 128;
    const bf16_t* arow[4];
#pragma unroll
    for (int i = 0; i < 4; ++i) { int r = g.drow(i); if (r >= navail) r = navail - 1; arow[i] = p.hbuf + (size_t)lst[r] * D_MODEL + g.dchunk(i) * 8; }
    const bf16_t* Bbase = p.Wt_gu + ((size_t)(l * N_EXPERTS + e) * 2 * D_EXPERT + (nt & 7) * 128) * D_MODEL;
    f32x4 acc[4][4];
    gemm_mainloop(lds, g, D_MODEL / 64, [&](int i, int kt) { return arow[i] + kt * 64; }, [&](int i, int kt) { return Bbase + (size_t)g.drow(i) * D_MODEL + kt * 64 + g.dchunk(i) * 8; }, acc);
#pragma unroll
    for (int mi = 0; mi < 4; ++mi) {
        const int rl = g.wr * 64 + mi * 16 + g.l15;
        if (rl < navail) {
            const int row = lst[rl]; const float w = p.tokw[row * 2 + k];
            bf16_t* d = p.HE + (size_t)row * HE_W + k * D_EXPERT + (nt & 7) * 64 + g.wc * 32 + g.q * 4;
#pragma unroll
            for (int h2 = 0; h2 < 2; ++h2) { f32x4 gg = acc[mi][2 * h2], uu = acc[mi][2 * h2 + 1], o;
#pragma unroll
                for (int r = 0; r < 4; ++r) o[r] = w * (gg[r] / (1.0f + __expf(-gg[r]))) * uu[r];
                store4bf(d + h2 * 16, o); }
        }
    }
}
template <bool DUMMY = false>
__device__ __forceinline__ void moe_down_tile(const Params& p, char* lds, int l, int pr, int mt, int nt, int n) {
    const TileGeom g = tile_geom();
    int e1, e2; pair_experts(pr, e1, e2);
    const int* lst = p.list + (size_t)pr * TT + mt * 128;
    const int navail = n - mt * 128;
    const bf16_t* arow[4];
#pragma unroll
    for (int i = 0; i < 4; ++i) { int r = g.drow(i); if (r >= navail) r = navail - 1; arow[i] = p.HE + (size_t)lst[r] * HE_W + g.dchunk(i) * 8; }
    const bf16_t* B1 = p.Wt_d + ((size_t)(l * N_EXPERTS + e1) * D_MODEL + nt * 128) * D_EXPERT;
    const bf16_t* B2 = p.Wt_d + ((size_t)(l * N_EXPERTS + e2) * D_MODEL + nt * 128) * D_EXPERT;
    constexpr int KT1 = D_EXPERT / 64;
    f32x4 acc[4][4];
    gemm_mainloop(lds, g, HE_W / 64, [&](int i, int kt) { return arow[i] + kt * 64; },
                  [&](int i, int kt) { return (kt < KT1 ? B1 + kt * 64 : B2 + (kt - KT1) * 64) + (size_t)g.drow(i) * D_EXPERT + g.dchunk(i) * 8; }, acc);
#pragma unroll
    for (int mi = 0; mi < 4; ++mi) {
        const int rl = g.wr * 64 + mi * 16 + g.l15;
        if (rl < navail) {
            const int row = lst[rl]; float* xo = xrow_cur(p, row); const float* gate = modp(p, l, row, 5);
#pragma unroll
            for (int ni = 0; ni < 4; ++ni) { const int col = nt * 128 + g.wc * 64 + ni * 16 + g.q * 4; float* dst = DUMMY ? (float*)p.QA + (size_t)row * D_MODEL : xo; *(f32x4*)(dst + col) = *(const f32x4*)(xo + col) + *(const f32x4*)(gate + col) * acc[mi][ni]; }
        }
    }
}
__device__ __forceinline__ void ph_moe_up(const Params& p, char* lds, int l, int bid, int nb) {
    int pr, mt, nt, n; const bool xl = (nb & 7) == 0;
    for (int t = xl ? bid >> 3 : bid; xl ? moe_tile_lookup_xcd<16>(p.cnt + l * 32, bid & 7, t, pr, mt, nt, n) : moe_tile_lookup<16>(p.cnt + l * 32, t, pr, mt, nt, n); t += xl ? nb >> 3 : nb) moe_up_tile(p, lds, l, pr, mt, nt, n);
}
template <bool DUMMY = false>
__device__ __forceinline__ void ph_moe_down(const Params& p, char* lds, int l, int bid, int nb) {
    int pr, mt, nt, n; const bool xl = (nb & 7) == 0;
    for (int t = xl ? bid >> 3 : bid; xl ? moe_tile_lookup_xcd<8>(p.cnt + l * 32, bid & 7, t, pr, mt, nt, n) : moe_tile_lookup<8>(p.cnt + l * 32, t, pr, mt, nt, n); t += xl ? nb >> 3 : nb) moe_down_tile<DUMMY>(p, lds, l, pr, mt, nt, n);
}
typedef float f32x2 __attribute__((ext_vector_type(2)));
typedef __bf16 bf16x2_t __attribute__((ext_vector_type(2)));
__device__ __forceinline__ unsigned cvtpk(float lo, float hi) { f32x2 v = {lo, hi}; bf16x2_t b = __builtin_convertvector(v, bf16x2_t); return __builtin_bit_cast(unsigned, b); }
__device__ __forceinline__ int crow(int r, int hi) { return (r & 3) + 8 * (r >> 2) + 4 * hi; }
constexpr float LOG2E = 1.4426950408889634f;
constexpr float QK_C = ATTN_SCALE * LOG2E;
constexpr float NEG_BIG = -1e30f;

__device__ __forceinline__ float max3f(float a, float b, float c) { float r; asm("v_max3_f32 %0, %1, %2, %3" : "=v"(r) : "v"(a), "v"(b), "v"(c)); return r; }
constexpr float ATT_THR = 8.0f;
template <int MODE>
__device__ __forceinline__ void attn_unit(char* lds, const bf16_t* Qp, const bf16_t* Kp, const bf16_t* Vt, bf16_t* Op, int s0, int nctx, int lt0, int nlat, float sink2, bool has_sink, const float* rpb_h) {
    int tid_ = threadIdx.x; asm volatile("" : "+v"(tid_));
    const int tid = tid_, lane = tid & 63, wid = __builtin_amdgcn_readfirstlane(tid >> 6), l31 = lane & 31, hi = lane >> 5;
    float* bias_s = (float*)(lds + 65536);
    if (MODE == 2 && rpb_h) { for (int i = tid; i < 15 * 31; i += NTHREADS) bias_s[i] = rpb_h[i] * LOG2E; }
    const int ntiles = nctx + nlat;
    LAS char* l3 = (LAS char*)lds;
    const int drow0 = wid * 16 + (lane >> 3);
    const int dch0 = (lane & 7) ^ (((lane >> 4) + 0) & 7), dch1 = (lane & 7) ^ (((lane >> 4) + 4) & 7);
    const bf16_t* ksrc0 = Kp + (size_t)drow0 * 64 + dch0 * 8; const bf16_t* ksrc1 = Kp + (size_t)(drow0 + 8) * 64 + dch1 * 8;
    const bf16_t* vsrc0 = Vt + (size_t)drow0 * LKV + dch0 * 8; const bf16_t* vsrc1 = Vt + (size_t)(drow0 + 8) * LKV + dch1 * 8;
    const int ddst = wid * 2048;
    auto tile_pos = [&](int j) { return j < nctx ? 64 * j : CTX_LEN + 64 * (lt0 + j - nctx); };
#define ATT_DMA(j_, slot_) do { const int pos_ = tile_pos(j_); \
        __builtin_amdgcn_global_load_lds((const unsigned*)(ksrc0 + (size_t)pos_ * 64), (LAS unsigned*)(l3 + (slot_) * 8192 + ddst), 16, 0, 0); \
        __builtin_amdgcn_global_load_lds((const unsigned*)(ksrc1 + (size_t)pos_ * 64), (LAS unsigned*)(l3 + (slot_) * 8192 + ddst + 1024), 16, 0, 0); \
        __builtin_amdgcn_global_load_lds((const unsigned*)(vsrc0 + pos_), (LAS unsigned*)(l3 + 32768 + (slot_) * 8192 + ddst), 16, 0, 0); \
        __builtin_amdgcn_global_load_lds((const unsigned*)(vsrc1 + pos_), (LAS unsigned*)(l3 + 32768 + (slot_) * 8192 + ddst + 1024), 16, 0, 0); } while (0)
    const int x = (l31 >> 1) & 7;
    const int kofs = l31 * 128 + ((hi ^ x) << 4);
    const int vofs = 32768 + l31 * 128 + (x << 4) + 8 * hi;
    bf16x8 qf[4];
    { const bf16_t* qr = Qp + (size_t)(wid * 32 + l31) * 512 + hi * 8;
#pragma unroll
      for (int s = 0; s < 4; ++s) { const u32x4 raw = *(const u32x4*)(qr + s * 16); u32x4 sc;
#pragma unroll
          for (int e = 0; e < 4; ++e) { const float lo = __builtin_bit_cast(float, raw[e] << 16) * QK_C, hi2 = __builtin_bit_cast(float, raw[e] & 0xffff0000u) * QK_C; sc[e] = cvtpk(lo, hi2); }
          qf[s] = __builtin_bit_cast(bf16x8, sc); } }
#define ATT_WAIT(need_, last_) do { const int lastt_ = (last_) < ntiles - 1 ? (last_) : ntiles - 1; const int ahead_ = lastt_ - (need_); \
        if (ahead_ >= 2) asm volatile("s_waitcnt vmcnt(8) lgkmcnt(0)" ::: "memory"); else if (ahead_ == 1) asm volatile("s_waitcnt vmcnt(4) lgkmcnt(0)" ::: "memory"); \
        else asm volatile("s_waitcnt vmcnt(0) lgkmcnt(0)" ::: "memory"); } while (0)
    ATT_DMA(0, 0);
    if (ntiles > 1) ATT_DMA(1, 1);
    if (ntiles > 2) ATT_DMA(2, 2);
    f32x16 o0 = {}, o1 = {};
    f32x16 negm = {};
    float mref = 0.f, l = 0.f;
    const int sq = s0 + wid * 32 + l31;
    int rq = 0, cq = 0, rsq = 0, csq = 0;
    if (MODE == 2) { rq = sq / GRID_W; cq = sq % GRID_W; rsq = rq - B_WIN_H / 2; rsq = rsq < 0 ? 0 : (rsq > GRID_H - B_WIN_H ? GRID_H - B_WIN_H : rsq); csq = cq - B_WIN_W / 2; csq = csq < 0 ? 0 : (csq > GRID_W - B_WIN_W ? GRID_W - B_WIN_W : csq); }
    ATT_WAIT(0, 2);
    __builtin_amdgcn_s_barrier(); asm volatile("" ::: "memory");
    int slot = 0;
    for (int j = 0; j < ntiles; ++j) {
        const int slot1 = (slot + 1) & 3, slot3 = (slot + 3) & 3;
        if (j + 3 < ntiles) ATT_DMA(j + 3, slot3);
        const char* Kb = lds + slot * 8192; const char* Vb = lds + slot * 8192;
        f32x16 p0, p1;
#pragma unroll
        for (int s = 0; s < 4; ++s) {
            const bf16x8 k0 = *(const bf16x8*)(Kb + (kofs ^ (s << 5))); const bf16x8 k1 = *(const bf16x8*)(Kb + 4096 + (kofs ^ (s << 5)));
            if (s == 0) { p0 = __builtin_amdgcn_mfma_f32_32x32x16_bf16(k0, qf[0], negm, 0, 0, 0); p1 = __builtin_amdgcn_mfma_f32_32x32x16_bf16(k1, qf[0], negm, 0, 0, 0); }
            else { p0 = __builtin_amdgcn_mfma_f32_32x32x16_bf16(k0, qf[s], p0, 0, 0, 0); p1 = __builtin_amdgcn_mfma_f32_32x32x16_bf16(k1, qf[s], p1, 0, 0, 0); }
        }
        asm volatile("s_nop 15\n\ts_nop 7" : "+v"(p0), "+v"(p1));
        if (MODE == 1 && j >= nctx) {
            const int sk0 = 64 * (lt0 + j - nctx);
#pragma unroll
            for (int r = 0; r < 16; ++r) { const int d0 = sk0 + crow(r, hi) - sq, d1 = d0 + 32;
                p0[r] = (d0 >= -A_WINDOW && d0 <= A_WINDOW) ? p0[r] : NEG_BIG; p1[r] = (d1 >= -A_WINDOW && d1 <= A_WINDOW) ? p1[r] : NEG_BIG; }
        } else if (MODE == 2 && j >= nctx) {
            const int kr = lt0 + j - nctx; const bool rowok = kr >= rsq && kr < rsq + B_WIN_H;
            const float* brow = bias_s + (kr - rq + B_WIN_H - 1) * 31 + (B_WIN_W - 1) - cq;
#pragma unroll
            for (int r = 0; r < 16; ++r) { const int kc0 = crow(r, hi), kc1 = kc0 + 32;
                const bool ok0 = rowok && kc0 >= csq && kc0 < csq + B_WIN_W, ok1 = rowok && kc1 >= csq && kc1 < csq + B_WIN_W;
                p0[r] = ok0 ? p0[r] + brow[kc0] : NEG_BIG; p1[r] = ok1 ? p1[r] + brow[kc1] : NEG_BIG; }
        }
        float ta = max3f(p0[0], p0[1], p1[0]), tb = max3f(p0[2], p0[3], p1[1]); ta = max3f(ta, p1[2], p1[3]);
#pragma unroll
        for (int r = 4; r < 16; r += 4) { ta = max3f(ta, p0[r], p0[r + 1]); tb = max3f(tb, p0[r + 2], p0[r + 3]); ta = max3f(ta, p1[r], p1[r + 1]); tb = max3f(tb, p1[r + 2], p1[r + 3]); }
        float tmax = fmaxf(ta, tb); tmax = fmaxf(tmax, __shfl_xor(tmax, 32));
        if (j == 0 || __any(tmax > ATT_THR)) {
            const float dl = j == 0 ? tmax : fmaxf(tmax, 0.f);
            mref += dl;
#pragma unroll
            for (int r = 0; r < 16; ++r) { p0[r] -= dl; p1[r] -= dl; negm[r] = -mref; }
            if (j > 0) { const float f = __builtin_amdgcn_exp2f(-dl); l *= f;
#pragma unroll
                for (int r = 0; r < 16; ++r) { o0[r] *= f; o1[r] *= f; } }
        }
        f32x2 lsum = {0.f, 0.f};
#pragma unroll
        for (int r = 0; r < 16; r += 2) { p0[r] = __builtin_amdgcn_exp2f(p0[r]); p0[r + 1] = __builtin_amdgcn_exp2f(p0[r + 1]); p1[r] = __builtin_amdgcn_exp2f(p1[r]); p1[r + 1] = __builtin_amdgcn_exp2f(p1[r + 1]);
            lsum += (f32x2){p0[r], p0[r + 1]}; lsum += (f32x2){p1[r], p1[r + 1]}; }
        l += lsum.x + lsum.y;
        bf16x8 pf[4];
        { u32x4 w;
          w.x = cvtpk(p0[0], p0[1]); w.y = cvtpk(p0[2], p0[3]); w.z = cvtpk(p0[4], p0[5]); w.w = cvtpk(p0[6], p0[7]); pf[0] = __builtin_bit_cast(bf16x8, w);
          w.x = cvtpk(p0[8], p0[9]); w.y = cvtpk(p0[10], p0[11]); w.z = cvtpk(p0[12], p0[13]); w.w = cvtpk(p0[14], p0[15]); pf[1] = __builtin_bit_cast(bf16x8, w);
          w.x = cvtpk(p1[0], p1[1]); w.y = cvtpk(p1[2], p1[3]); w.z = cvtpk(p1[4], p1[5]); w.w = cvtpk(p1[6], p1[7]); pf[2] = __builtin_bit_cast(bf16x8, w);
          w.x = cvtpk(p1[8], p1[9]); w.y = cvtpk(p1[10], p1[11]); w.z = cvtpk(p1[12], p1[13]); w.w = cvtpk(p1[14], p1[15]); pf[3] = __builtin_bit_cast(bf16x8, w); }
#pragma unroll
        for (int s = 0; s < 4; ++s) {
            const int a0 = vofs ^ (s << 5);
            u32x2 va = *(const u32x2*)(Vb + a0), vb = *(const u32x2*)(Vb + (a0 ^ 16));
            u32x2 vc = *(const u32x2*)(Vb + 4096 + a0), vd = *(const u32x2*)(Vb + 4096 + (a0 ^ 16));
            const bf16x8 f0 = __builtin_bit_cast(bf16x8, (u32x4){va.x, va.y, vb.x, vb.y}), f1 = __builtin_bit_cast(bf16x8, (u32x4){vc.x, vc.y, vd.x, vd.y});
            o0 = __builtin_amdgcn_mfma_f32_32x32x16_bf16(f0, pf[s], o0, 0, 0, 0); o1 = __builtin_amdgcn_mfma_f32_32x32x16_bf16(f1, pf[s], o1, 0, 0, 0);
        }
        ATT_WAIT(j + 1, j + 3);
        __builtin_amdgcn_s_barrier(); asm volatile("" ::: "memory");
        slot = slot1;
    }
#undef ATT_DMA
#undef ATT_WAIT
    l += __shfl_xor(l, 32);
    if (has_sink) l += __builtin_amdgcn_exp2f(sink2 - mref);
    const float inv = 1.0f / l;
    bf16_t* orow = Op + (size_t)(wid * 32 + l31) * 1024;
#pragma unroll
    for (int g4 = 0; g4 < 4; ++g4) {
        u32x2 w; w.x = cvtpk(o0[g4 * 4 + 0] * inv, o0[g4 * 4 + 1] * inv); w.y = cvtpk(o0[g4 * 4 + 2] * inv, o0[g4 * 4 + 3] * inv); *(u32x2*)(orow + 8 * g4 + 4 * hi) = w;
        w.x = cvtpk(o1[g4 * 4 + 0] * inv, o1[g4 * 4 + 1] * inv); w.y = cvtpk(o1[g4 * 4 + 2] * inv, o1[g4 * 4 + 3] * inv); *(u32x2*)(orow + 32 + 8 * g4 + 4 * hi) = w;
    }
    asm volatile("s_waitcnt vmcnt(0)" ::: "memory");
}

constexpr int NU_LAT = BATCH * 8 * (SEQ / 128);
constexpr int NU_CTX = BATCH * 8 * (CTX_LEN / 128);
static_assert(BATCH * 2 == 8, "the XCD-local unit order maps the 8 (batch, kv head) K/V streams onto the 8 XCD groups");
__device__ __forceinline__ void ph_attn0(const Params& p, char* lds, bool xl, int x, int lb, int lstep) {
    const int bid = xl ? x + 8 * lb : lb, nb = xl ? 8 * lstep : lstep;
    constexpr int NQB = SEQ / 128;
    for (int v = xl ? lb : bid; v < (xl ? BATCH * NQB : NU_LAT); v += xl ? lstep : nb) {
        int blk, h, b; if (xl) { blk = v % NQB; b = v / NQB; h = x; } else { blk = v % NQB; h = (v / NQB) % 8; b = v / (8 * NQB); }
        const int s0 = blk * 128, r0 = s0 / GRID_W;
        int rs0 = r0 - 4; rs0 = rs0 < 0 ? 0 : (rs0 > GRID_H - 8 ? GRID_H - 8 : rs0); int rs1 = r0 + 1 - 4; rs1 = rs1 < 0 ? 0 : (rs1 > GRID_H - 8 ? GRID_H - 8 : rs1);
        attn_unit<2>(lds, p.QB + (size_t)(b * SEQ + s0) * 512 + h * 64, p.KB + (size_t)(b * 8 + h) * LKV * 64, p.VBt + (size_t)(b * 8 + h) * 64 * LKV,
                     p.Y + (size_t)(b * SEQ + s0) * 1024 + 512 + h * 64, s0, CTX_LEN / 64, rs0, rs1 + 8 - rs0, 0.f, false, (xl && v != lb) ? nullptr : p.b_rpb + h * 15 * 31);
    }
    for (int v = xl ? lb : bid; v < (xl ? 4 * NQB : NU_LAT); v += xl ? lstep : nb) {
        int blk, h, b; if (xl) { blk = v % NQB; b = x >> 1; h = (x & 1) * 4 + v / NQB; } else { blk = v % NQB; h = (v / NQB) % 8; b = v / (8 * NQB); }
        const int s0 = blk * 128;
        int t0 = (s0 - 128) / 64; if (t0 < 0) t0 = 0; int t1 = (s0 + 255) / 64; if (t1 > SEQ / 64 - 1) t1 = SEQ / 64 - 1;
        attn_unit<1>(lds, p.QA + (size_t)(b * SEQ + s0) * 512 + h * 64, p.KA + (size_t)(b * 2 + h / 4) * LKV * 64, p.VAt + (size_t)(b * 2 + h / 4) * 64 * LKV,
                     p.Y + (size_t)(b * SEQ + s0) * 1024 + h * 64, s0, CTX_LEN / 64, t0, t1 - t0 + 1, p.a_sink[h] * LOG2E, true, nullptr);
    }
    for (int u = bid; u < 2 * NU_CTX; u += nb) {
        const int ty = u / NU_CTX, w = u % NU_CTX; const int blk = w % (CTX_LEN / 128), h = (w / (CTX_LEN / 128)) % 8, b = w / (8 * (CTX_LEN / 128));
        const int row0 = TX + b * CTX_LEN + blk * 128;
        const bf16_t* Qp = (ty == 0 ? p.QA : p.QB) + (size_t)row0 * 512 + h * 64;
        const bf16_t* Kp = ty == 0 ? p.KA + (size_t)(b * 2 + h / 4) * LKV * 64 : p.KB + (size_t)(b * 8 + h) * LKV * 64;
        const bf16_t* Vp = ty == 0 ? p.VAt + (size_t)(b * 2 + h / 4) * 64 * LKV : p.VBt + (size_t)(b * 8 + h) * 64 * LKV;
        attn_unit<0>(lds, Qp, Kp, Vp, p.Y + (size_t)row0 * 1024 + ty * 512 + h * 64, 0, CTX_LEN / 64, 0, 0, ty == 0 ? p.a_sink[h] * LOG2E : 0.f, ty == 0, nullptr);
    }
}
__device__ __forceinline__ void ph_attnC(const Params& p, char* lds, int bid, int nb) {
    const bool xl = (nb & 7) == 0; const int x = bid & 7, lb = bid >> 3, lstep = nb >> 3;
    constexpr int NQB = SEQ / 128;
    for (int v = xl ? lb : bid; v < (xl ? 4 * NQB : NU_LAT); v += xl ? lstep : nb) {
        int blk, h, b; if (xl) { blk = v % NQB; b = x >> 1; h = (x & 1) * 4 + v / NQB; } else { blk = v % NQB; h = (v / NQB) % 8; b = v / (8 * NQB); }
        const int s0 = blk * 128;
        attn_unit<0>(lds, p.QC + (size_t)(b * SEQ + s0) * 512 + h * 64, p.KC + (size_t)(b * 2 + h / 4) * LKV * 64, p.VCt + (size_t)(b * 2 + h / 4) * 64 * LKV,
                     p.Y + (size_t)(b * SEQ + s0) * 1024 + h * 64, s0, CTX_LEN / 64, 0, SEQ / 64, 0.f, false, nullptr);
    }
}
#ifdef HY_TEST
#define HY_OUT(b, t, v) p.YHT[((size_t)(b) * D_CH + c) * SEQ + (t)] = f2bf(v)
#else
#define HY_OUT(b, t, v) p.YHT[((size_t)(b) * D_CH + c) * SEQ + (t)] = f2bf(v)
#endif
#ifdef CPU_TEST
#define FOR_T for (int tid = 0; tid < 256; ++tid)
#define HSYNC
#define HY_SB()
#define HST(t) st[t]
#define HY_DECL HySt* st = new HySt[256]
#define HY_FREE delete[] st
static inline void sincos_rev(float a, float& c, float& s) { c = cosf(6.283185307179586f * a); s = sinf(6.283185307179586f * a); }
#else
__device__ __forceinline__ int hy_launder(int v) { asm volatile("" : "+v"(v)); return v; }
#define FOR_T if (const int tid = hy_launder((int)threadIdx.x); true)
#define HSYNC __syncthreads()
#define HY_SB() __builtin_amdgcn_sched_barrier(0)
#define HST(t) st
#define HY_DECL HySt st
#define HY_FREE
__device__ __forceinline__ void sincos_rev(float a, float& c, float& s) { c = __builtin_amdgcn_cosf(a); s = __builtin_amdgcn_sinf(a); }
#endif
constexpr int FN = 2 * SEQ;
constexpr int FPAD = FN + (FN >> 5);
#if !defined(SMALL_CFG)
static_assert(FN == 8192, "pass plan 8,8,8,16 is for N = 8192");
constexpr int R4 = 16;
constexpr int NS4 = 512;
#else
constexpr int R4 = 2;
constexpr int NS4 = 512;
#endif
constexpr int NB8 = FN / 8 / 256;
constexpr int NB4 = FN / R4 / 256;
constexpr int EPT = FN / 256;
struct HySt { float xr[EPT], xi[EPT]; unsigned kp[EPT]; };
HD unsigned hy_pack(float r, float i) { return (unsigned)f2bf(r) | ((unsigned)f2bf(i) << 16); }
HD float hy_lo(unsigned v) { unsigned u = v << 16; float f; __builtin_memcpy(&f, &u, 4); return f; }
HD float hy_hi(unsigned v) { unsigned u = v & 0xffff0000u; float f; __builtin_memcpy(&f, &u, 4); return f; }
HD int pidx(int i) { return i + (i >> 5); }

constexpr float W16C[8] = {1.0f, 0.9238795325112867f, 0.7071067811865476f, 0.3826834323650898f, 0.0f, -0.3826834323650898f, -0.7071067811865476f, -0.9238795325112867f};
constexpr float W16S[8] = {0.0f, -0.3826834323650898f, -0.7071067811865476f, -0.9238795325112867f, -1.0f, -0.9238795325112867f, -0.7071067811865476f, -0.3826834323650898f};
template <int R> HD void fft_reg(float* xr, float* xi) {
    constexpr int LG = R == 16 ? 4 : (R == 8 ? 3 : (R == 4 ? 2 : 1));
#pragma unroll
    for (int sg = 0; sg < LG; ++sg) {
        const int h = (R / 2) >> sg;
#pragma unroll
        for (int pr = 0; pr < R / 2; ++pr) {
            const int blk = (pr / h) * 2 * h, i = pr % h;
            const int a = blk + i, b = blk + i + h;
            const float ar = xr[a], ai = xi[a], br = xr[b], bi = xi[b];
            xr[a] = ar + br; xi[a] = ai + bi;
            const float tr = ar - br, ti = ai - bi;
            const int tw = i * (8 / h);
            if (tw == 0) { xr[b] = tr; xi[b] = ti; }
            else if (tw == 4) { xr[b] = ti; xi[b] = -tr; }
            else { const float c = W16C[tw & 7], s = W16S[tw & 7]; xr[b] = tr * c - ti * s; xi[b] = tr * s + ti * c; }
        }
    }
}
template <int R> HD constexpr int bitrev(int i) { int r = 0; for (int b = 1; b < R; b <<= 1) { r = (r << 1) | (i & 1); i >>= 1; } return r; }

template <int R, int NB, class In> HD void pass_load(int tid, HySt& s, const In& in) {
#pragma unroll
    for (int b = 0; b < NB; ++b)
#pragma unroll
        for (int r = 0; r < R; ++r) in(tid + 256 * b + (FN / R) * r, r, s.xr[b * R + r], s.xi[b * R + r]);
}
template <int R, int NB, class Out> HD void pass_compute(int tid, HySt& s, int Ns, const Out& out) {
#pragma unroll
    for (int b = 0; b < NB; ++b) {
        const int j = tid + 256 * b, k = j & (Ns - 1);
        float* xr = s.xr + b * R; float* xi = s.xi + b * R;
        if (Ns > 1) {
            float wc, ws; sincos_rev(-(float)k / (float)(Ns * R), wc, ws);
            float cr = wc, ci = ws;
#pragma unroll
            for (int r = 1; r < R; ++r) {
                const float vr = xr[r], vi = xi[r]; xr[r] = vr * cr - vi * ci; xi[r] = vr * ci + vi * cr;
                const float nr = cr * wc - ci * ws, ni = cr * ws + ci * wc; cr = nr; ci = ni;
            }
        }
        fft_reg<R>(xr, xi);
        const int j0 = (j - k) * R + k;
#pragma unroll
        for (int i = 0; i < R; ++i) out(j0 + bitrev<R>(i) * Ns, b, bitrev<R>(i), xr[i], xi[i]);
    }
}
template <int R, int NB> HD void pass_load_lds(int tid, HySt& s, const float* re, const float* im) {
    const int base = pidx(tid);
#pragma unroll
    for (int b = 0; b < NB; ++b)
#pragma unroll
        for (int r = 0; r < R; ++r) { const int C = 256 * b + (FN / R) * r; s.xr[b * R + r] = re[base + C + (C >> 5)]; s.xi[b * R + r] = im[base + C + (C >> 5)]; }
}
template <int R, int NB, int NS> HD void pass_compute_lds(int tid, HySt& s, float* re, float* im) {
    static_assert((NS % 32 == 0) || (R == 8 && (NS == 1 || NS == 8)), "no-carry condition of the padded index");
#pragma unroll
    for (int b = 0; b < NB; ++b) {
        const int j = tid + 256 * b, k = j & (NS - 1);
        float* xr = s.xr + b * R; float* xi = s.xi + b * R;
        if (NS > 1) {
            float wc, ws; sincos_rev(-(float)k / (float)(NS * R), wc, ws);
            float cr = wc, ci = ws;
#pragma unroll
            for (int r = 1; r < R; ++r) {
                const float vr = xr[r], vi = xi[r]; xr[r] = vr * cr - vi * ci; xi[r] = vr * ci + vi * cr;
                const float nr = cr * wc - ci * ws, ni = cr * ws + ci * wc; cr = nr; ci = ni;
            }
        }
        fft_reg<R>(xr, xi);
        const int pj0 = pidx((j - k) * R + k);
#pragma unroll
        for (int i = 0; i < R; ++i) { const int C = bitrev<R>(i) * NS; re[pj0 + C + (C >> 5)] = xr[i]; im[pj0 + C + (C >> 5)] = xi[i]; }
        HY_SB();
    }
}
struct LdsIn { const float* re; const float* im; HD void operator()(int idx, int, float& r, float& i) const { r = re[pidx(idx)]; i = im[pidx(idx)]; } };
struct LdsOut { float* re; float* im; HD void operator()(int idx, int, int, float r, float i) const { re[pidx(idx)] = r; im[pidx(idx)] = i; } };

HD void hy_pre_load(const Params& p, int c, int b, int tid, float* lds) {
#pragma unroll
    for (int q = 0; q < 3; ++q) {
        const bf16_t* u = p.UT + ((size_t)b * 3 * D_CH + q * D_CH + c) * SEQ; const int t0 = tid * 16;
        const float w0 = p.hy_short_w[0 * 3 * D_CH + q * D_CH + c], w1 = p.hy_short_w[1 * 3 * D_CH + q * D_CH + c], w2 = p.hy_short_w[2 * 3 * D_CH + q * D_CH + c], sb = p.hy_short_b[q * D_CH + c];
        unsigned w[8];
        { const unsigned* u32p = (const unsigned*)(u + t0);
#pragma unroll
          for (int i = 0; i < 8; ++i) w[i] = u32p[i]; }
        float x[18];
        x[0] = t0 > 0 ? bf2f(u[t0 - 1]) : 0.f; x[17] = t0 + 16 < SEQ ? bf2f(u[t0 + 16]) : 0.f;
#pragma unroll
        for (int i = 0; i < 8; ++i) { x[1 + 2 * i] = bf2f((bf16_t)(w[i] & 0xffffu)); x[2 + 2 * i] = bf2f((bf16_t)(w[i] >> 16)); }
#pragma unroll
        for (int i = 0; i < 16; ++i) lds[q * SEQ + t0 + i] = sb + w0 * x[i] + w1 * x[i + 1] + w2 * x[i + 2];
    }
}
HD void hy_pre_store(const Params& p, int c, int b, int tid, const float* lds) {
#pragma unroll
    for (int q = 0; q < 3; ++q) {
        unsigned* u = (unsigned*)(p.UT + ((size_t)b * 3 * D_CH + q * D_CH + c) * SEQ + tid * 16);
#pragma unroll
        for (int i = 0; i < 8; ++i) u[i] = (unsigned)f2bf(lds[q * SEQ + tid + 256 * (2 * i)]) | ((unsigned)f2bf(lds[q * SEQ + tid + 256 * (2 * i + 1)]) << 16);
    }
}
HD void tm_load_bf16(const bf16_t* row, int tid, unsigned (&w)[8]) { const unsigned* q = (const unsigned*)(row + tid * 16);
#pragma unroll
    for (int i = 0; i < 8; ++i) w[i] = q[i]; }
HD float tm_get(const unsigned (&w)[8], int m) { return bf2f((bf16_t)((m & 1) ? (w[m >> 1] >> 16) : (w[m >> 1] & 0xffffu))); }
HD int tm_ofs(int idx) { return (idx & 255) * 16 + (idx >> 8); }

HD void hyena_channel(const Params& p, int c, float* lds) {
    HY_DECL;
    float* re = lds; float* im = lds + FPAD;
    const LdsIn lin{re, im}; const LdsOut lout{re, im};
    for (int b = 0; b < BATCH; ++b) { FOR_T { hy_pre_load(p, c, b, tid, lds); } HSYNC; FOR_T { hy_pre_store(p, c, b, tid, lds); } HSYNC; }
    float nrm[2];
#pragma unroll
    for (int o = 0; o < 2; ++o) {
        const float* hf = p.HFT + (size_t)((0 * 2 + o) * D_CH + c) * SEQ; const float* hb = p.HFT + (size_t)((1 * 2 + o) * D_CH + c) * SEQ;
        FOR_T { float sacc = 0.f; for (int i = 0; i < SEQ / 256; ++i) sacc += fabsf(hf[tid + 256 * i]) + fabsf(hb[tid + 256 * i]); re[tid] = sacc; }
        HSYNC;
        { float tot = 0.f; for (int i = 0; i < 256; ++i) tot += re[i]; nrm[o] = tot + EPS; }
        HSYNC;
    }
    float sw[3][3], sbv[3];
#pragma unroll
    for (int q = 0; q < 3; ++q) { sbv[q] = p.hy_short_b[q * D_CH + c];
#pragma unroll
        for (int kk = 0; kk < 3; ++kk) sw[q][kk] = p.hy_short_w[kk * 3 * D_CH + q * D_CH + c]; }
#pragma unroll 1
    for (int o = 0; o < 2; ++o) {
        const float* hf = p.HFT + (size_t)((0 * 2 + o) * D_CH + c) * SEQ; const float* hb = p.HFT + (size_t)((1 * 2 + o) * D_CH + c) * SEQ;
        const float inv = 1.0f / (o == 0 ? nrm[0] : nrm[1]); const float hbias = p.hy_bias[o * D_CH + c];
        float swg[3]; swg[0] = o == 0 ? sw[1][0] : sw[2][0]; swg[1] = o == 0 ? sw[1][1] : sw[2][1]; swg[2] = o == 0 ? sw[1][2] : sw[2][2]; const float sbg = o == 0 ? sbv[1] : sbv[2];
        FOR_T { pass_load<8, NB8>(tid, HST(tid), [&](int idx, int r8, float& r, float& i) __attribute__((always_inline)) { if (r8 < 4) r = hf[idx] * inv; else { const int q = FN - idx; const float hv = hb[q < SEQ ? q : 0]; r = q < SEQ ? hv * inv : 0.f; } i = 0.f; });
                pass_compute_lds<8, NB8, 1>(tid, HST(tid), re, im); }
        HSYNC;
        FOR_T { pass_load_lds<8, NB8>(tid, HST(tid), re, im); } HSYNC; FOR_T { pass_compute_lds<8, NB8, 8>(tid, HST(tid), re, im); } HSYNC;
        FOR_T { pass_load_lds<8, NB8>(tid, HST(tid), re, im); } HSYNC; FOR_T { pass_compute_lds<8, NB8, 64>(tid, HST(tid), re, im); } HSYNC;
        FOR_T { pass_load_lds<R4, NB4>(tid, HST(tid), re, im);
                HySt& s = HST(tid); pass_compute<R4, NB4>(tid, s, NS4, [&](int, int b, int rr, float r, float i) __attribute__((always_inline)) { s.kp[b + NB4 * rr] = hy_pack(r, i); }); }
        HSYNC;
        for (int bp = 0; bp < BATCH / 2; ++bp) {
            const int b0 = 2 * bp, b1 = 2 * bp + 1;
            const bf16_t* u0 = p.UT + ((size_t)b0 * 3 * D_CH + c) * SEQ; const bf16_t* u1 = p.UT + ((size_t)b1 * 3 * D_CH + c) * SEQ;
            const float* z0 = p.Z1 + ((size_t)b0 * D_CH + c) * SEQ; const float* z1 = p.Z1 + ((size_t)b1 * D_CH + c) * SEQ;
            auto zval = [&](int b, int t) __attribute__((always_inline)) { return o == 0 ? bf2f((b == b0 ? u0 : u1)[tm_ofs(t)]) : (b == b0 ? z0 : z1)[tm_ofs(t)]; };
            FOR_T { HySt& s = HST(tid);
                    if (o == 0) { unsigned w0[8], w1[8]; tm_load_bf16(u0, tid, w0); tm_load_bf16(u1, tid, w1);
#pragma unroll
                        for (int q = 0; q < 32; ++q) { const int b = q >> 3, r = q & 7; if (r < 4) { s.xr[q] = tm_get(w0, b + 4 * r); s.xi[q] = tm_get(w1, b + 4 * r); } else { s.xr[q] = 0.f; s.xi[q] = 0.f; } } }
                    else {
#pragma unroll
                        for (int q = 0; q < 32; ++q) { const int b = q >> 3, r = q & 7; if (r < 4) { s.xr[q] = z0[tid * 16 + b + 4 * r]; s.xi[q] = z1[tid * 16 + b + 4 * r]; } else { s.xr[q] = 0.f; s.xi[q] = 0.f; } } }
                    pass_compute_lds<8, NB8, 1>(tid, s, re, im); }
            HSYNC;
            FOR_T { pass_load_lds<8, NB8>(tid, HST(tid), re, im); } HSYNC; FOR_T { pass_compute_lds<8, NB8, 8>(tid, HST(tid), re, im); } HSYNC;
            FOR_T { pass_load_lds<8, NB8>(tid, HST(tid), re, im); } HSYNC; FOR_T { pass_compute_lds<8, NB8, 64>(tid, HST(tid), re, im); } HSYNC;
            FOR_T { pass_load_lds<R4, NB4>(tid, HST(tid), re, im); } HSYNC;
            FOR_T { HySt& s = HST(tid); pass_compute<R4, NB4>(tid, s, NS4, [&](int idx, int b, int rr, float r, float i) __attribute__((always_inline)) { const float kr = hy_lo(s.kp[b + NB4 * rr]), ki = hy_hi(s.kp[b + NB4 * rr]);
                        re[pidx(idx)] = r * kr - i * ki; im[pidx(idx)] = -(r * ki + i * kr); }); }
            HSYNC;
            FOR_T { pass_load_lds<8, NB8>(tid, HST(tid), re, im); } HSYNC; FOR_T { pass_compute_lds<8, NB8, 1>(tid, HST(tid), re, im); } HSYNC;
            FOR_T { pass_load_lds<8, NB8>(tid, HST(tid), re, im); } HSYNC; FOR_T { pass_compute_lds<8, NB8, 8>(tid, HST(tid), re, im); } HSYNC;
            FOR_T { pass_load_lds<8, NB8>(tid, HST(tid), re, im); } HSYNC; FOR_T { pass_compute_lds<8, NB8, 64>(tid, HST(tid), re, im); } HSYNC;
            FOR_T { pass_load_lds<R4, NB4>(tid, HST(tid), re, im); HySt& s = HST(tid); float yr[16], yi[16];
                    pass_compute<R4, NB4>(tid, s, NS4, [&](int, int b, int rr, float r, float i) __attribute__((always_inline)) { if (rr < 8) { yr[b + 2 * rr] = r * (1.0f / FN); yi[b + 2 * rr] = -i * (1.0f / FN); } });
                    const bf16_t* g0 = p.UT + ((size_t)b0 * 3 * D_CH + (o + 1) * D_CH + c) * SEQ; const bf16_t* g1 = p.UT + ((size_t)b1 * 3 * D_CH + (o + 1) * D_CH + c) * SEQ;
                    unsigned gw0[8], gw1[8]; tm_load_bf16(g0, tid, gw0); tm_load_bf16(g1, tid, gw1);
                    if (o == 0) { unsigned w0[8], w1[8]; tm_load_bf16(u0, tid, w0); tm_load_bf16(u1, tid, w1);
                        float* zo0 = p.Z1 + ((size_t)b0 * D_CH + c) * SEQ + tid * 16; float* zo1 = p.Z1 + ((size_t)b1 * D_CH + c) * SEQ + tid * 16;
#pragma unroll
                        for (int m = 0; m < 16; ++m) { zo0[m] = tm_get(gw0, m) * (yr[m] + tm_get(w0, m) * hbias); zo1[m] = tm_get(gw1, m) * (yi[m] + tm_get(w1, m) * hbias); } }
                    else {
#pragma unroll
                        for (int m = 0; m < 16; ++m) { const float zn0 = tm_get(gw0, m) * (yr[m] + z0[tid * 16 + m] * hbias), zn1 = tm_get(gw1, m) * (yi[m] + z1[tid * 16 + m] * hbias);
                            HY_OUT(b0, tid + 256 * m, zn0); HY_OUT(b1, tid + 256 * m, zn1); } } }
            HSYNC;
        }
    }
    HY_FREE;
}
constexpr int MOD_ITEMS = DEPTH * (6 * D_MODEL / 64);
__device__ __forceinline__ void mod_item(const Params& p, char* lds, int item) {
    float* sc = (float*)lds;
    float* red = sc + 5 * D_MODEL;
    const int tid = threadIdx.x, l = item / (6 * D_MODEL / 64), j0 = (item % (6 * D_MODEL / 64)) * 64;
    for (int i = tid; i < 5 * D_MODEL; i += NTHREADS) { const int r = i / D_MODEL, k = i % D_MODEL; const float v = r < BATCH ? p.c[r * D_MODEL + k] : p.c_ctx[k]; sc[i] = silu_f(v); }
    __syncthreads();
    const int col = tid & 63, kp = tid >> 6;
    const float* w = p.w_ada + ((size_t)l * D_MODEL + kp * 256) * 6 * D_MODEL + j0 + col;
    float a0 = 0.f, a1 = 0.f, a2 = 0.f, a3 = 0.f, a4 = 0.f;
#pragma unroll 8
    for (int k = 0; k < 256; ++k) { const float wv = w[(size_t)k * 6 * D_MODEL]; const int kk = kp * 256 + k;
        a0 += sc[kk] * wv; a1 += sc[D_MODEL + kk] * wv; a2 += sc[2 * D_MODEL + kk] * wv; a3 += sc[3 * D_MODEL + kk] * wv; a4 += sc[4 * D_MODEL + kk] * wv; }
    red[(kp * 5 + 0) * 64 + col] = a0; red[(kp * 5 + 1) * 64 + col] = a1; red[(kp * 5 + 2) * 64 + col] = a2; red[(kp * 5 + 3) * 64 + col] = a3; red[(kp * 5 + 4) * 64 + col] = a4;
    __syncthreads();
    for (int i = tid; i < 5 * 64; i += NTHREADS) { const int r = i / 64, cc = i % 64;
        const float v = red[(0 * 5 + r) * 64 + cc] + red[(1 * 5 + r) * 64 + cc] + red[(2 * 5 + r) * 64 + cc] + red[(3 * 5 + r) * 64 + cc];
        p.mod[((size_t)(l * (BATCH + 1) + r)) * 6 * D_MODEL + j0 + cc] = v + p.b_ada[l * 6 * D_MODEL + j0 + cc]; }
    __syncthreads();
}
constexpr int FILT_ITEMS = (SEQ / 256) * (4 * D_CH / 64);
__device__ __forceinline__ void filt_item(const Params& p, char* lds, int item) {
    float* ws = (float*)lds;
    const int tid = threadIdx.x, tb = item % (SEQ / 256), cb = item / (SEQ / 256); const int t = tb * 256 + tid, col0 = cb * 64;
#pragma unroll
    for (int i = 0; i < 16; ++i) { const int k = i * 4 + (tid >> 6), cc = tid & 63; ws[cc * 68 + k] = p.hy_w3[(size_t)k * 4 * D_CH + col0 + cc]; }
    f32x4 h[16];
#pragma unroll
    for (int i = 0; i < 16; ++i) h[i] = *(const f32x4*)(p.h2 + (size_t)t * HY_FFN + i * 4);
    __syncthreads();
    const float tn = (float)t / (float)(SEQ - 1);
    const float mind = logf(1e-2f) / 1.5f, maxd = logf(1e-2f) / 0.3f;
#pragma unroll 2
    for (int cc = 0; cc < 64; ++cc) {
        const int col = col0 + cc; const f32x4* w = (const f32x4*)(ws + cc * 68);
        float acc = p.hy_b3[col];
#pragma unroll
        for (int i = 0; i < 16; ++i) { const f32x4 wv = w[i]; acc += h[i][0] * wv[0] + h[i][1] * wv[1] + h[i][2] * wv[2] + h[i][3] * wv[3]; }
        const float delta = fabsf(mind + (float)(col % D_CH) * (maxd - mind) / (float)(D_CH - 1));
        p.HFT[(size_t)col * SEQ + t] = acc * expf(-tn * delta);
    }
    __syncthreads();
}
__device__ __forceinline__ void ph_norm(const Params& p, int l, int which, int nrows, int bid, int nb) {
    const int lane = threadIdx.x & 63, wid = threadIdx.x >> 6;
    const float* g = p.norm_g + (l * 2 + which) * D_MODEL;
    for (int row = (bid * 4 + wid) * 2; row < nrows; row += nb * 8) {
        const int row1 = row + 1 < nrows ? row + 1 : row;
        const float* xa = which == 0 ? xrow_in(p, l, row) : xrow_cur(p, row); const float* xb = which == 0 ? xrow_in(p, l, row1) : xrow_cur(p, row1);
        f32x4 va[4], vb[4]; float sa = 0.f, sb = 0.f;
#pragma unroll
        for (int j = 0; j < 4; ++j) { va[j] = *(const f32x4*)(xa + j * 256 + lane * 4); vb[j] = *(const f32x4*)(xb + j * 256 + lane * 4); }
#pragma unroll
        for (int j = 0; j < 4; ++j) { sa += va[j][0] * va[j][0] + va[j][1] * va[j][1] + va[j][2] * va[j][2] + va[j][3] * va[j][3]; sb += vb[j][0] * vb[j][0] + vb[j][1] * vb[j][1] + vb[j][2] * vb[j][2] + vb[j][3] * vb[j][3]; }
        const float ra = 1.0f / sqrtf(wave_sum(sa) * (1.0f / D_MODEL) + EPS), rb = 1.0f / sqrtf(wave_sum(sb) * (1.0f / D_MODEL) + EPS);
        const float* sha = modp(p, l, row, which * 3 + 0); const float* sca = modp(p, l, row, which * 3 + 1);
        const float* shb = modp(p, l, row1, which * 3 + 0); const float* scb = modp(p, l, row1, which * 3 + 1);
#pragma unroll
        for (int j = 0; j < 4; ++j) { const int c = j * 256 + lane * 4; const f32x4 gv = *(const f32x4*)(g + c);
            store4bf(p.hbuf + (size_t)row * D_MODEL + c, va[j] * ra * gv * (*(const f32x4*)(sca + c) + 1.0f) + *(const f32x4*)(sha + c));
            if (row1 != row) store4bf(p.hbuf + (size_t)row1 * D_MODEL + c, vb[j] * rb * gv * (*(const f32x4*)(scb + c) + 1.0f) + *(const f32x4*)(shb + c)); }
    }
}
__device__ __forceinline__ void ph_route_a(const Params& p, char* lds, int l, int nrows, int bid, int nb) {
    const int lane = threadIdx.x & 63, wid = threadIdx.x >> 6;
    float* wr_s = (float*)lds; int* hist = (int*)(lds + 65536);
    for (int i = threadIdx.x; i < D_MODEL * 4; i += NTHREADS) { const int k = i >> 2, ch = i & 3, pos = (k & 3) * 256 + (k >> 2); ((f32x4*)wr_s)[pos * 4 + (ch ^ ((pos >> 2) & 3))] = ((const f32x4*)p.w_router)[i]; }
    if (threadIdx.x < 32) hist[threadIdx.x] = 0;
    __syncthreads();
    const int sw = (lane >> 2) & 3;
    const float* g = p.norm_g + (l * 2 + 1) * D_MODEL;
    const int RPB = (nrows + nb - 1) / nb, r0 = bid * RPB;
    f32x4 v[4];
    { const int row = r0 + wid; const float* xr = xrow_cur(p, (wid < RPB && row < nrows) ? row : 0);
#pragma unroll
      for (int j = 0; j < 4; ++j) v[j] = *(const f32x4*)(xr + j * 256 + lane * 4); }
    for (int jr = wid; jr < RPB; jr += 4) {
        const int row = r0 + jr; if (row >= nrows) break;
        const float* sh = modp(p, l, row, 3); const float* sc = modp(p, l, row, 4);
        f32x4 vn[4];
        { const bool more = jr + 4 < RPB && row + 4 < nrows; const float* xn = xrow_cur(p, more ? row + 4 : row);
#pragma unroll
          for (int j = 0; j < 4; ++j) vn[j] = *(const f32x4*)(xn + j * 256 + lane * 4); }
        float ss = 0.f;
#pragma unroll
        for (int j = 0; j < 4; ++j) ss += v[j][0] * v[j][0] + v[j][1] * v[j][1] + v[j][2] * v[j][2] + v[j][3] * v[j][3];
        const float rstd = 1.0f / sqrtf(wave_sum(ss) * (1.0f / D_MODEL) + EPS);
        float lg[16];
#pragma unroll
        for (int e = 0; e < 16; ++e) lg[e] = 0.f;
#pragma unroll
        for (int j = 0; j < 4; ++j) { const int c = j * 256 + lane * 4;
            const f32x4 o = v[j] * rstd * *(const f32x4*)(g + c) * (*(const f32x4*)(sc + c) + 1.0f) + *(const f32x4*)(sh + c);
            store4bf(p.hbuf + (size_t)row * D_MODEL + c, o);
#pragma unroll
            for (int r = 0; r < 4; ++r) { const f32x4* w4 = (const f32x4*)(wr_s + (r * 256 + lane + 64 * j) * 16);
#pragma unroll
                for (int e4 = 0; e4 < 4; ++e4) { const f32x4 wv = w4[e4 ^ sw]; lg[e4 * 4 + 0] += o[r] * wv[0]; lg[e4 * 4 + 1] += o[r] * wv[1]; lg[e4 * 4 + 2] += o[r] * wv[2]; lg[e4 * 4 + 3] += o[r] * wv[3]; }
                if (r & 1) __builtin_amdgcn_sched_barrier(0); } }
        {
#pragma unroll
            for (int i = 0; i < 8; ++i) { const float a = lg[i], b = lg[i + 8]; const bool up = (lane & 32) != 0; const float recv = __shfl_xor(up ? a : b, 32); lg[i] = (up ? b : a) + recv; }
#pragma unroll
            for (int i = 0; i < 4; ++i) { const float a = lg[i], b = lg[i + 4]; const bool up = (lane & 16) != 0; const float recv = __shfl_xor(up ? a : b, 16); lg[i] = (up ? b : a) + recv; }
#pragma unroll
            for (int i = 0; i < 2; ++i) { const float a = lg[i], b = lg[i + 2]; const bool up = (lane & 8) != 0; const float recv = __shfl_xor(up ? a : b, 8); lg[i] = (up ? b : a) + recv; }
            { const float a = lg[0], b = lg[1]; const bool up = (lane & 4) != 0; const float recv = __shfl_xor(up ? a : b, 4); lg[0] = (up ? b : a) + recv; }
            lg[0] += __shfl_xor(lg[0], 2); lg[0] += __shfl_xor(lg[0], 1);
            const float mine = lg[0];
#pragma unroll
            for (int e = 0; e < 16; ++e) lg[e] = __builtin_bit_cast(float, __builtin_amdgcn_readlane(__builtin_bit_cast(int, mine), 4 * e));
        }
        if (lane == 0) {
            int gbest = 0, a = 0, bb = 1; float gbs = -1e30f, wa = 0.f, wb = 0.f;
#pragma unroll
            for (int gI = 0; gI < 4; ++gI) {
                float m1 = -1e30f, m2 = -1e30f, s1 = 0.f, s2 = 0.f; int i1 = 0, i2 = 0;
#pragma unroll
                for (int jj = 0; jj < 4; ++jj) { float sgv = sigmoid_f(lg[gI * 4 + jj]); float vv = sgv + p.b_router[gI * 4 + jj];
                    if (vv > m1) { m2 = m1; i2 = i1; s2 = s1; m1 = vv; i1 = jj; s1 = sgv; } else if (vv > m2) { m2 = vv; i2 = jj; s2 = sgv; } }
                float gs = m1 + m2;
                if (gs > gbs) { gbs = gs; gbest = gI; if (i1 < i2) { a = i1; bb = i2; wa = s1; wb = s2; } else { a = i2; bb = i1; wa = s2; wb = s1; } }
            }
            const float inv = 1.0f / (wa + wb);
            const int pidx = a == 0 ? bb - 1 : (a == 1 ? bb + 1 : 5);
            const int pr = gbest * 6 + pidx;
            p.rpair[row] = pr; p.tokw[row * 2 + 0] = wa * inv; p.tokw[row * 2 + 1] = wb * inv;
            atomicAdd(&hist[pr], 1);
        }
#pragma unroll
        for (int j = 0; j < 4; ++j) v[j] = vn[j];
    }
    __syncthreads();
    if (threadIdx.x < 32) p.bh[bid * 32 + threadIdx.x] = hist[threadIdx.x];
}
__device__ __forceinline__ void ph_route_b(const Params& p, char* lds, int l, int nrows, int bid, int nb) {
    int* sb = (int*)lds;
    const int t = threadIdx.x;
    { int cb[32], ca[32];
#pragma unroll
      for (int q = 0; q < 32; ++q) { cb[q] = 0; ca[q] = 0; }
      for (int b = t; b < nb; b += NTHREADS) { const u32x4* src = (const u32x4*)(p.bh + b * 32); const bool before = b < bid;
#pragma unroll
          for (int q4 = 0; q4 < 6; ++q4) { const u32x4 v4 = src[q4];
#pragma unroll
              for (int e = 0; e < 4; ++e) { ca[q4 * 4 + e] += (int)v4[e]; cb[q4 * 4 + e] += before ? (int)v4[e] : 0; } } }
#pragma unroll
      for (int q = 0; q < 24; ++q) { sb[t * 33 + q] = cb[q]; sb[8448 + t * 33 + q] = ca[q]; } }
    __syncthreads();
    if (t < 64) { const int q = t & 31, which = t >> 5; int a = 0; const int* col = sb + which * 8448 + q;
        if (q < 24) { for (int r = 0; r < 256; ++r) a += col[r * 33]; }
        sb[16896 + which * 32 + q] = a; if (which == 1 && bid == 0) p.cnt[l * 32 + q] = a; }
    const int RPB = (nrows + nb - 1) / nb, row = bid * RPB + t; const bool act = t < RPB && row < nrows;
    int myp = 0; if (act) { myp = p.rpair[row]; sb[16896 + 64 + t] = myp; }
    __syncthreads();
    if (act) { int rank = 0; for (int j = 0; j < t; ++j) rank += (sb[16896 + 64 + j] == myp) ? 1 : 0; p.list[(size_t)myp * TT + sb[16896 + myp] + rank] = row; }
    __syncthreads();
}
__device__ __forceinline__ void ph_final(const Params& p, int bid, int nb) {
    const int lane = threadIdx.x & 63, wid = threadIdx.x >> 6;
    for (int row = (bid * 4 + wid) * 2; row < TX; row += nb * 8) {
        float* xa = p.out + (size_t)row * D_MODEL; float* xb = xa + D_MODEL;
        f32x4 va[4], vb[4]; float sa = 0.f, sb = 0.f;
#pragma unroll
        for (int j = 0; j < 4; ++j) { va[j] = *(const f32x4*)(xa + j * 256 + lane * 4); vb[j] = *(const f32x4*)(xb + j * 256 + lane * 4); }
#pragma unroll
        for (int j = 0; j < 4; ++j) { sa += va[j][0] * va[j][0] + va[j][1] * va[j][1] + va[j][2] * va[j][2] + va[j][3] * va[j][3]; sb += vb[j][0] * vb[j][0] + vb[j][1] * vb[j][1] + vb[j][2] * vb[j][2] + vb[j][3] * vb[j][3]; }
        const float ra = 1.0f / sqrtf(wave_sum(sa) * (1.0f / D_MODEL) + EPS), rb = 1.0f / sqrtf(wave_sum(sb) * (1.0f / D_MODEL) + EPS);
#pragma unroll
        for (int j = 0; j < 4; ++j) { const int c = j * 256 + lane * 4; const f32x4 gv = *(const f32x4*)(p.final_g + c); *(f32x4*)(xa + c) = va[j] * ra * gv; *(f32x4*)(xb + c) = vb[j] * rb * gv; }
    }
}

#define XB_TMO      128
#define XB_XCNT(j)  (256  + 64 * (j))
#define XB_XSUB(j)  (1280 + 64 * (j))
#define XB_XGEN(j)  (2304 + 64 * (j))
#define XB_TOP      3328
#define XB_TOPGEN   3392
#define XCD_BAR_WORDS 3456
#define XB_SPIN_CAP (1u << 20)
__device__ __forceinline__ unsigned xb_ld(unsigned* p)              { return __hip_atomic_load(p, __ATOMIC_RELAXED, __HIP_MEMORY_SCOPE_AGENT); }
__device__ __forceinline__ unsigned xb_add(unsigned* p, unsigned v) { return __hip_atomic_fetch_add(p, v, __ATOMIC_RELAXED, __HIP_MEMORY_SCOPE_AGENT); }
__device__ __forceinline__ unsigned xb_xcc_id() { return (unsigned)__builtin_amdgcn_s_getreg((3 << 11) | 20) & 0xFu; }
#define XB_SPIN(cond, bar) do { unsigned _sp = 0; while (cond) { __builtin_amdgcn_s_sleep(1); \
    if ((++_sp & 255u) == 0u) { if (xb_ld(&(bar)[XB_TMO])) break; if (_sp > XB_SPIN_CAP) { atomicAdd(&(bar)[XB_TMO], 1u); break; } } } } while (0)
struct XcdBarrier { unsigned* bar; unsigned x; volatile LAS unsigned* st; };
__device__ __forceinline__ XcdBarrier xcd_barrier_post(unsigned* bar, volatile LAS unsigned* st) {
    XcdBarrier b; b.bar = bar; b.x = xb_xcc_id(); b.st = st;
    if (threadIdx.x == 0) (void)xb_add(&bar[XB_XCNT(b.x)], 1u);
    return b;
}
__device__ __forceinline__ void xcd_barrier_complete(unsigned* bar, unsigned x, unsigned& nloc, unsigned& nx) {
    const unsigned G = gridDim.x * gridDim.y * gridDim.z;
    unsigned sum, cnt, mine, sp = 0u;
    for (;;) {
        sum = 0u; cnt = 0u; mine = 0u;
#pragma unroll
        for (unsigned j = 0; j < 16; ++j) { const unsigned c = xb_ld(&bar[XB_XCNT(j)]); sum += c; cnt += (c > 0u) ? 1u : 0u; mine = (j == x) ? c : mine; }
        if (sum == G) break;
        __builtin_amdgcn_s_sleep(1);
        if ((++sp & 255u) == 0u) { if (xb_ld(&bar[XB_TMO])) break; if (sp > XB_SPIN_CAP) { atomicAdd(&bar[XB_TMO], 1u); break; } }
    }
    nloc = mine > 0u ? mine : 1u; nx = cnt > 0u ? cnt : 1u;
}
__device__ __forceinline__ void xcd_barrier(const XcdBarrier& b) {
    asm volatile("s_waitcnt vmcnt(0)" ::: "memory");
    __syncthreads();
    if (threadIdx.x == 0) {
        unsigned* bar = b.bar;
        __builtin_amdgcn_s_waitcnt(0);
        unsigned nloc = b.st[0], nx = b.st[1];
        if (nloc == 0u) { xcd_barrier_complete(bar, b.x, nloc, nx); b.st[0] = nloc; b.st[1] = nx; }
        const unsigned old = xb_add(&bar[XB_XSUB(b.x)], 1u);
        const unsigned gen = old / nloc;
        if (old + 1u == (gen + 1u) * nloc) {
            __builtin_amdgcn_fence(__ATOMIC_RELEASE, "agent");
            asm volatile("s_waitcnt vmcnt(0)" ::: "memory");
            const unsigned og = xb_add(&bar[XB_TOP], 1u);
            const unsigned tg = og / nx;
            if (og + 1u == (tg + 1u) * nx) xb_add(&bar[XB_TOPGEN], 1u);
            else XB_SPIN(xb_ld(&bar[XB_TOPGEN]) == tg, bar);
            __builtin_amdgcn_fence(__ATOMIC_ACQUIRE, "agent");
            xb_add(&bar[XB_XGEN(b.x)], 1u);
            asm volatile("s_waitcnt vmcnt(0)" ::: "memory");
        } else {
            XB_SPIN(xb_ld(&bar[XB_XGEN(b.x)]) == gen, bar);
            __builtin_amdgcn_fence(__ATOMIC_ACQUIRE, "agent");
            asm volatile("s_waitcnt vmcnt(0)" ::: "memory");
        }
    }
    __syncthreads();
}

__device__ __forceinline__ void ph_mix1(const Params& p, char* lds, int bid, int nb, unsigned long long* tsplit = nullptr) {
    const bool hy_first = bid >= (nb >> 1);
    for (int rep = 0; rep < 3; ++rep) {
        if (rep == 1) {
            for (int u = bid; u < NU_LAT; u += nb) { const int blk = u % (SEQ / 128), h = (u / (SEQ / 128)) % 8, b = u / (8 * (SEQ / 128)); const int s0 = blk * 128;
                attn_unit<0>(lds, p.QC + (size_t)(b * SEQ + s0) * 512 + h * 64, p.KC + (size_t)(b * 2 + h / 4) * LKV * 64, p.VCt + (size_t)(b * 2 + h / 4) * 64 * LKV,
                             p.Y + (size_t)(b * SEQ + s0) * 1024 + h * 64, s0, CTX_LEN / 64, 0, SEQ / 64, 0.f, false, nullptr); }
            if (tsplit) *tsplit = __builtin_amdgcn_s_memrealtime();
        } else if ((rep == 0) == hy_first) {
            __syncthreads();
            for (int c = hy_first ? bid - (nb >> 1) : bid + (nb >> 1); c < D_CH; c += nb) hyena_channel(p, c, (float*)lds);
            __syncthreads();
        }
    }
}
constexpr int TR_ITEMS = BATCH * (D_CH / 64) * (SEQ / 64);
__device__ __forceinline__ void tr_item(const Params& p, char* lds, int it) {
    bf16_t* T = (bf16_t*)lds; const int tid = threadIdx.x;
    const int sb = it % (SEQ / 64), cb = (it / (SEQ / 64)) % (D_CH / 64), b = it / ((SEQ / 64) * (D_CH / 64));
    { const int c = tid >> 2, q = tid & 3;
      const u32x4* src = (const u32x4*)(p.YHT + ((size_t)b * D_CH + cb * 64 + c) * SEQ + sb * 64 + q * 16);
      const u32x4 v0 = src[0], v1 = src[1]; unsigned* d = (unsigned*)(T + c * 66 + q * 16);
      d[0] = v0.x; d[1] = v0.y; d[2] = v0.z; d[3] = v0.w; d[4] = v1.x; d[5] = v1.y; d[6] = v1.z; d[7] = v1.w; }
    __syncthreads();
    { const int s = tid >> 2, q = tid & 3;
      unsigned w[8];
#pragma unroll
      for (int i = 0; i < 8; ++i) w[i] = (unsigned)T[(q * 16 + 2 * i) * 66 + s] | ((unsigned)T[(q * 16 + 2 * i + 1) * 66 + s] << 16);
      u32x4* dst = (u32x4*)(p.Y + ((size_t)b * SEQ + sb * 64 + s) * 1024 + 512 + cb * 64 + q * 16);
      dst[0] = (u32x4){w[0], w[1], w[2], w[3]}; dst[1] = (u32x4){w[4], w[5], w[6], w[7]}; }
    __syncthreads();
}
enum { PH_PREP = 0, PH_NORM0, PH_INPROJ0, PH_ATTN0, PH_OUT0, PH_ROUTE0, PH_ROUTEB0, PH_UP0, PH_DOWN0, PH_NORM1, PH_INPROJ1, PH_MIX1, PH_HY1, PH_TR1, PH_OUT1, PH_ROUTE1, PH_ROUTEB1, PH_UP1, PH_DOWN1, PH_FINAL, PH_COUNT };
typedef const __attribute__((address_space(4))) Params* KParams;
__global__ void __launch_bounds__(NTHREADS, 2) mega(Params p_arg, int lo, int hi) {
    extern __shared__ __attribute__((aligned(16))) char lds[];
    const int bid = blockIdx.x, nb = gridDim.x;
    volatile LAS unsigned* st = (volatile LAS unsigned*)(lds + LDS_BYTES - 16);
    if (threadIdx.x < 4) st[threadIdx.x] = 0u;
    __syncthreads();
    KParams kp = (KParams)__builtin_amdgcn_kernarg_segment_ptr();
    XcdBarrier bar; bar.bar = kp->bar; bar.x = 0; bar.st = st;
    if (hi - lo > 1) bar = xcd_barrier_post(kp->bar, st);
#ifdef PROBE_PA
    unsigned long long ts_prev = __builtin_amdgcn_s_memrealtime(), t_a = 0, t_b = 0;
#define STAMP(PH) if (bid == 0 && threadIdx.x == 0) { const unsigned long long now_ = __builtin_amdgcn_s_memrealtime(); if ((PH) == PROBE_PA) t_a = now_ - ts_prev; if ((PH) == PROBE_PB) t_b = now_ - ts_prev; ts_prev = now_; }
#else
#define STAMP(PH)
#endif
#define PHASE(PH, ...) if (lo <= (PH) && (PH) < hi) { { KParams kq_ = kp; asm volatile("" : "+s"(kq_)); const Params& p = *(const Params*)kq_; __VA_ARGS__; } if ((PH) + 1 < hi) xcd_barrier(bar); STAMP(PH) }
    PHASE(PH_PREP, { if (nb > MOD_ITEMS + 64) { if (bid < MOD_ITEMS) mod_item(p, lds, bid); else cvt_range(p, lds, 0, CVT_EARLY, bid - MOD_ITEMS, nb - MOD_ITEMS); }
        else { for (int it = bid; it < MOD_ITEMS; it += nb) mod_item(p, lds, it); cvt_range(p, lds, 0, CVT_EARLY, bid, nb); }
        d_rope(p); d_hy_h1(p); })
    PHASE(PH_NORM0, { ph_norm(p, 0, 0, TT, bid, nb); d_hy_h2(p); })
    PHASE(PH_INPROJ0, ph_inproj<0>(p, lds, bid, nb))
    PHASE(PH_ATTN0, { const bool xl_ = (nb & 7) == 0;
        if (bid >= (nb >> 1)) { cvt_range(p, lds, CVT_EARLY, CVT_TOTAL, bid, nb); __syncthreads(); ph_attn0(p, lds, xl_, bid & 7, xl_ ? bid >> 3 : bid, xl_ ? nb >> 3 : nb); }
        else { ph_attn0(p, lds, xl_, bid & 7, xl_ ? bid >> 3 : bid, xl_ ? nb >> 3 : nb); __syncthreads(); cvt_range(p, lds, CVT_EARLY, CVT_TOTAL, bid, nb); } })
    PHASE(PH_OUT0, { ph_outproj<0>(p, lds, bid, nb);
        __syncthreads(); { const int full_ = (nb & 7) == 0 ? ((MT_ALL / 8) * 8) % (nb >> 3) : 0;
          const int lb_ = bid >> 3; if ((nb & 7) != 0) { for (int it = bid; it < FILT_ITEMS; it += nb) filt_item(p, lds, it); }
          else if (lb_ >= full_) { for (int it = (lb_ - full_) * 8 + (bid & 7); it < FILT_ITEMS; it += nb - full_ * 8) filt_item(p, lds, it); } } })
    PHASE(PH_ROUTE0, ph_route_a(p, lds, 0, TT, bid, nb))
    PHASE(PH_ROUTEB0, ph_route_b(p, lds, 0, TT, bid, nb))
    PHASE(PH_UP0, ph_moe_up(p, lds, 0, bid, nb))
    PHASE(PH_DOWN0, ph_moe_down(p, lds, 0, bid, nb))
    PHASE(PH_NORM1, ph_norm(p, 1, 0, TT, bid, nb))
    PHASE(PH_INPROJ1, ph_inproj<1>(p, lds, bid, nb))
    PHASE(PH_MIX1, ph_attnC(p, lds, bid, nb))
    PHASE(PH_HY1, for (int c = bid; c < D_CH; c += nb) hyena_channel(p, c, (float*)lds))
    PHASE(PH_TR1, for (int it = bid; it < TR_ITEMS; it += nb) tr_item(p, lds, it))
    PHASE(PH_OUT1, ph_outproj<1>(p, lds, bid, nb))
    PHASE(PH_ROUTE1, ph_route_a(p, lds, 1, TX, bid, nb))
    PHASE(PH_ROUTEB1, ph_route_b(p, lds, 1, TX, bid, nb))
    PHASE(PH_UP1, ph_moe_up(p, lds, 1, bid, nb))
    PHASE(PH_DOWN1, ph_moe_down(p, lds, 1, bid, nb))
    PHASE(PH_FINAL, ph_final(p, bid, nb))
#ifdef PROBE_PA
    if (bid == 0 && threadIdx.x == 0) {
        const unsigned long long delay = 2 * t_a + 204800ull * ((t_b + 200) / 400); const unsigned long long t0 = __builtin_amdgcn_s_memrealtime();
        while (__builtin_amdgcn_s_memrealtime() - t0 < delay) __builtin_amdgcn_s_sleep(32);
    }
#endif
}
extern "C" void kernel_launch(void* const* d_in, const int* in_sizes, int n_in, void* d_out, int out_size, void* d_ws, size_t ws_size, hipStream_t stream) {
    static int grid = 0;
    if (grid == 0) {
        int dev = 0, cus = 0;
        if (hipGetDevice(&dev) != hipSuccess || hipDeviceGetAttribute(&cus, hipDeviceAttributeMultiprocessorCount, dev) != hipSuccess) { fprintf(stderr, "kernel_launch: device query failed\n"); grid = -1; return; }
        if (hipFuncSetAttribute((const void*)mega, hipFuncAttributeMaxDynamicSharedMemorySize, LDS_BYTES) != hipSuccess) { fprintf(stderr, "kernel_launch: hipFuncSetAttribute failed\n"); grid = -1; return; }
        grid = 2 * cus;
    }
    if (grid < 0) return;
    Params p{};
    size_t need = setup_ws(p, (char*)d_ws);
    if (n_in != 32 || need > ws_size || out_size != TX * D_MODEL) { fprintf(stderr, "kernel_launch: bad config n_in %d ws %zu need %zu out %d\n", n_in, ws_size, need, out_size); return; }
    fill_inputs(p, d_in, d_out);
    hipMemsetAsync(p.bar, 0, 64 * 1024 + 256, stream);
#ifdef PER_PHASE
    for (int ph = 0; ph < PH_COUNT; ++ph) mega<<<dim3(grid), dim3(NTHREADS), LDS_BYTES, stream>>>(p, ph, ph + 1);
#else
    mega<<<dim3(grid), dim3(NTHREADS), LDS_BYTES, stream>>>(p, 0, PH_COUNT);
#endif
}
```

```cpp
#include <hip/hip_runtime.h>
#include <cstdio>
#include <math.h>
#include <stdint.h>
#include <string.h>

#ifdef CPU_TEST
#define HD
#define GLOBAL
struct U3 { unsigned x, y, z; };
static thread_local U3 threadIdx, blockIdx, blockDim, gridDim;
static inline int atomicAdd(int* p, int v) { return __sync_fetch_and_add(p, v); }
#else
#define HD __device__ __forceinline__
#define GLOBAL __global__ __launch_bounds__(256)
#endif

#if defined(HY_TEST)
constexpr int D_MODEL = 64, BATCH = 2, SEQ = 4096, GRID_W = 64, CTX_LEN = 64, D_CH = 4, D_EXPERT = 64;
#elif defined(SMALL_CFG)
constexpr int D_MODEL = 128, BATCH = 2, SEQ = 512, GRID_W = 32, CTX_LEN = 64, D_CH = 32, D_EXPERT = 64;
#else
constexpr int D_MODEL = 1024, BATCH = 4, SEQ = 4096, GRID_W = 64, CTX_LEN = 256, D_CH = 512, D_EXPERT = 512;
#endif
constexpr int DEPTH = 2, HEAD_DIM = 64;
constexpr int GRID_H = SEQ / GRID_W;
constexpr int A_WINDOW = 128;
constexpr int B_WIN_H = 8, B_WIN_W = 16;
constexpr int HY_BANDS = 16, HY_EMB = 33, HY_FFN = 64;
constexpr int EVEN_IN = 2304, EVEN_OUT = 1024;
constexpr int ODD_IN = 768 + 3 * D_CH, ODD_OUT = 512 + D_CH;
constexpr int N_EXPERTS = 16;
constexpr int TX = BATCH * SEQ, TC = BATCH * CTX_LEN, TT = TX + TC;
constexpr int LKV = CTX_LEN + SEQ;
constexpr int NPAIR = 24;
constexpr int HE_W = 2 * D_EXPERT;
constexpr float EPS = 1e-6f;
constexpr float ATTN_SCALE = 0.125f;

typedef unsigned short bf16_t;
HD bf16_t f2bf(float f) { unsigned u; __builtin_memcpy(&u, &f, 4); u = (u + 0x7fffu + ((u >> 16) & 1u)) >> 16; return (bf16_t)u; }
HD float bf2f(bf16_t h) { unsigned u = ((unsigned)h) << 16; float f; __builtin_memcpy(&f, &u, 4); return f; }
HD float silu_f(float x) { return x / (1.0f + expf(-x)); }
HD float sigmoid_f(float x) { return 1.0f / (1.0f + expf(-x)); }

struct Params {
    const float *x, *c, *ctx, *c_ctx, *w_ada, *b_ada, *norm_g, *final_g, *w_in_even, *w_out_even, *a_sink, *b_rpb;
    const float *w_in_odd, *w_out_odd, *c_qnorm, *c_knorm, *hy_short_w, *hy_short_b, *hy_w1, *hy_b1, *hy_f1, *hy_w2;
    const float *hy_b2, *hy_f2, *hy_w3, *hy_b3, *hy_bias, *w_router, *b_router, *moe_wg, *moe_wu, *moe_wd;
    float* out;
    float* XC;
    float* mod;
    float* ropet;
    float* h1;
    float* h2;
    float* HFT;
    float* hnorm;
    bf16_t* hbuf;
    bf16_t *QA, *KA, *VAt, *QB, *KB, *VBt;
    bf16_t *QC, *KC, *VCt, *UT;
    bf16_t* Y;
    bf16_t* YHT;
    float* Z1;
    bf16_t* HE;
    int* cnt;
    int* list;
    float* tokw;
    bf16_t *Wt_in_even, *Wt_out_even, *Wt_in_odd, *Wt_out_odd, *Wt_gu, *Wt_d;
    unsigned* bar;
    int* rpair;
    int* bh;
    float* rlog;
};

#define GS_LOOP(i, n) for (long i = (long)blockIdx.x * blockDim.x + threadIdx.x; i < (long)(n); i += (long)gridDim.x * blockDim.x)

HD const float* xrow_in(const Params& p, int l, int row) {
    if (l == 0) return row < TX ? p.x + (size_t)row * D_MODEL : p.ctx + (size_t)(row - TX) * D_MODEL;
    return row < TX ? p.out + (size_t)row * D_MODEL : p.XC + (size_t)(row - TX) * D_MODEL;
}
HD float* xrow_cur(const Params& p, int row) { return row < TX ? p.out + (size_t)row * D_MODEL : p.XC + (size_t)(row - TX) * D_MODEL; }
HD int row_mod(int row) { return row < TX ? row / SEQ : BATCH; }
HD const float* modp(const Params& p, int l, int row, int which) { return p.mod + ((size_t)(l * (BATCH + 1) + row_mod(row)) * 6 + which) * D_MODEL; }

GLOBAL void nk_mod(Params p) {
    GS_LOOP(i, DEPTH * (BATCH + 1) * 6 * D_MODEL) {
        int j = i % (6 * D_MODEL); int r = (i / (6 * D_MODEL)) % (BATCH + 1); int l = i / (6 * D_MODEL * (BATCH + 1));
        const float* cv = r < BATCH ? p.c + r * D_MODEL : p.c_ctx;
        const float* w = p.w_ada + (size_t)l * D_MODEL * 6 * D_MODEL;
        float acc = 0.f;
        for (int k = 0; k < D_MODEL; ++k) acc += silu_f(cv[k]) * w[(size_t)k * 6 * D_MODEL + j];
        p.mod[i] = acc + p.b_ada[l * 6 * D_MODEL + j];
    }
}
HD void d_rope(const Params& p) {
    GS_LOOP(i, 64 * 16) {
        int pos = i / 16, k = i % 16;
        float inv = powf(10000.0f, -(float)(2 * k) / 32.0f);
        float a = (float)pos * inv;
        p.ropet[pos * 32 + k] = cosf(a); p.ropet[pos * 32 + 16 + k] = sinf(a);
    }
}
HD void d_hy_h1(const Params& p) {
    GS_LOOP(i, SEQ * HY_FFN) {
        int t = i / HY_FFN, k = i % HY_FFN;
        float tn = (float)t / (float)(SEQ - 1);
        float acc = tn * p.hy_w1[0 * HY_FFN + k];
        for (int b = 0; b < HY_BANDS; ++b) {
            float band = 1e-4f + (float)b * ((float)(HY_BANDS - 1) - 1e-4f) / (float)(HY_BANDS - 1);
            float ang = 2.0f * 3.14159265358979323846f * (float)t * band / (float)SEQ;
            acc += cosf(ang) * p.hy_w1[(1 + b) * HY_FFN + k] + sinf(ang) * p.hy_w1[(1 + HY_BANDS + b) * HY_FFN + k];
        }
        p.h1[i] = sinf(p.hy_f1[k] * (acc + p.hy_b1[k]));
    }
}
HD void d_hy_h2(const Params& p) {
    GS_LOOP(i, SEQ * HY_FFN) {
        int t = i / HY_FFN, j = i % HY_FFN;
        float acc = 0.f;
        for (int k = 0; k < HY_FFN; ++k) acc += p.h1[t * HY_FFN + k] * p.hy_w2[k * HY_FFN + j];
        p.h2[i] = sinf(p.hy_f2[j] * (acc + p.hy_b2[j]));
    }
}
HD float hy_decay(int t, int c) {
    const float mind = logf(1e-2f) / 1.5f, maxd = logf(1e-2f) / 0.3f;
    float delta = fabsf(mind + (float)c * (maxd - mind) / (float)(D_CH - 1));
    float tn = (float)t / (float)(SEQ - 1);
    return expf(-tn * delta);
}
GLOBAL void nk_hy_filt(Params p) {
    GS_LOOP(i, 4 * D_CH * SEQ) {
        int t = i % SEQ, col = i / SEQ, c = col % D_CH;
        float acc = p.hy_b3[col];
        for (int k = 0; k < HY_FFN; ++k) acc += p.h2[t * HY_FFN + k] * p.hy_w3[k * 4 * D_CH + col];
        p.HFT[i] = acc * hy_decay(t, c);
    }
}
GLOBAL void nk_hy_norm(Params p) {
    GS_LOOP(i, 2 * D_CH) {
        int o = i / D_CH, c = i % D_CH;
        float s = 0.f;
        for (int dir = 0; dir < 2; ++dir) { const float* h = p.HFT + (size_t)((dir * 2 + o) * D_CH + c) * SEQ; for (int t = 0; t < SEQ; ++t) s += fabsf(h[t]); }
        p.hnorm[i] = s + EPS;
    }
}
GLOBAL void nk_zero_cnt(Params p) { GS_LOOP(i, 64) p.cnt[i] = 0; }

GLOBAL void nk_norm(Params p, int l, int which, int nrows) {
    GS_LOOP(row, nrows) {
        const float* xr = which == 0 ? xrow_in(p, l, (int)row) : xrow_cur(p, (int)row);
        float ss = 0.f;
        for (int k = 0; k < D_MODEL; ++k) ss += xr[k] * xr[k];
        float rstd = 1.0f / sqrtf(ss / D_MODEL + EPS);
        const float* g = p.norm_g + (l * 2 + which) * D_MODEL;
        const float* sh = modp(p, l, (int)row, which * 3 + 0); const float* sc = modp(p, l, (int)row, which * 3 + 1);
        for (int k = 0; k < D_MODEL; ++k) p.hbuf[row * D_MODEL + k] = f2bf(xr[k] * rstd * g[k] * (1.0f + sc[k]) + sh[k]);
    }
}

HD float dot_row(const bf16_t* a, const float* W, int ldw, int col, int K) {
    float acc = 0.f;
    for (int k = 0; k < K; ++k) acc += bf2f(a[k]) * W[(size_t)k * ldw + col];
    return acc;
}
HD float rope_apply(const Params& p, float v, float partner, int d, int s) {
    int half = d >> 5, dd = d & 31, k = dd & 15;
    int pos = half == 0 ? s / GRID_W : s % GRID_W;
    float c = p.ropet[pos * 32 + k], sn = p.ropet[pos * 32 + 16 + k];
    return dd < 16 ? v * c - partner * sn : v * c + partner * sn;
}

GLOBAL void nk_inproj_even(Params p) {
    GS_LOOP(i, (long)TT * EVEN_IN) {
        int row = i / EVEN_IN, col = i % EVEN_IN;
        const bf16_t* a = p.hbuf + (size_t)row * D_MODEL;
        float v = dot_row(a, p.w_in_even, EVEN_IN, col, D_MODEL);
        bool lat = row < TX; int b = lat ? row / SEQ : (row - TX) / CTX_LEN; int s = lat ? row % SEQ : (row - TX) % CTX_LEN;
        int pos = lat ? CTX_LEN + s : s;
        if (col < 640) {
            int d = col & 63;
            if (lat) { int pc = (d & 31) < 16 ? col + 16 : col - 16; float pv = dot_row(a, p.w_in_even, EVEN_IN, pc, D_MODEL); v = rope_apply(p, v, pv, d, s); }
            if (col < 512) p.QA[(size_t)row * 512 + col] = f2bf(v);
            else { int h = (col - 512) >> 6; p.KA[((size_t)(b * 2 + h) * LKV + pos) * 64 + d] = f2bf(v); }
        } else if (col < 768) { int h = (col - 640) >> 6, d = col & 63; p.VAt[((size_t)(b * 2 + h) * 64 + d) * LKV + pos] = f2bf(v); }
        else if (col < 1280) p.QB[(size_t)row * 512 + (col - 768)] = f2bf(v);
        else if (col < 1792) { int h = (col - 1280) >> 6, d = col & 63; p.KB[((size_t)(b * 8 + h) * LKV + pos) * 64 + d] = f2bf(v); }
        else { int h = (col - 1792) >> 6, d = col & 63; p.VBt[((size_t)(b * 8 + h) * 64 + d) * LKV + pos] = f2bf(v); }
    }
}

struct OSM { float m, l; };
#define ATT_BEGIN() float q[64], acc[64]; for (int d = 0; d < 64; ++d) { q[d] = bf2f(qp[d]) * ATTN_SCALE; acc[d] = 0.f; } float m_ = -1e30f, l_ = 0.f;
#define ATT_KEY(Kp, Vt, key, bias) do { const bf16_t* kk_ = (Kp) + (size_t)(key) * 64; float s_ = (bias); for (int d = 0; d < 64; ++d) s_ += q[d] * bf2f(kk_[d]); \
    float mn_ = fmaxf(m_, s_); float f_ = expf(m_ - mn_), pe_ = expf(s_ - mn_); l_ = l_ * f_ + pe_; \
    for (int d = 0; d < 64; ++d) acc[d] = acc[d] * f_ + pe_ * bf2f((Vt)[(size_t)d * LKV + (key)]); m_ = mn_; } while (0)
#define ATT_SINK(sv) do { float s_ = (sv); float mn_ = fmaxf(m_, s_); float f_ = expf(m_ - mn_); l_ = l_ * f_ + expf(s_ - mn_); for (int d = 0; d < 64; ++d) acc[d] *= f_; m_ = mn_; } while (0)

GLOBAL void nk_attnA(Params p) {
    GS_LOOP(i, (long)TX * 8) {
        int h = i % 8, row = i / 8, b = row / SEQ, s = row % SEQ, kvh = h / 4;
        const bf16_t* qp = p.QA + (size_t)row * 512 + h * 64;
        const bf16_t* Kp = p.KA + (size_t)(b * 2 + kvh) * LKV * 64; const bf16_t* Vt = p.VAt + (size_t)(b * 2 + kvh) * 64 * LKV;
        ATT_BEGIN();
        for (int j = 0; j < CTX_LEN; ++j) ATT_KEY(Kp, Vt, j, 0.f);
        int lo = s - A_WINDOW < 0 ? 0 : s - A_WINDOW, hi = s + A_WINDOW > SEQ - 1 ? SEQ - 1 : s + A_WINDOW;
        for (int j = lo; j <= hi; ++j) ATT_KEY(Kp, Vt, CTX_LEN + j, 0.f);
        ATT_SINK(p.a_sink[h]);
        for (int d = 0; d < 64; ++d) p.Y[(size_t)row * 1024 + h * 64 + d] = f2bf(acc[d] / l_);
    }
}
GLOBAL void nk_attnB(Params p) {
    GS_LOOP(i, (long)TX * 8) {
        int h = i % 8, row = i / 8, b = row / SEQ, s = row % SEQ, r = s / GRID_W, cq = s % GRID_W;
        const bf16_t* qp = p.QB + (size_t)row * 512 + h * 64;
        const bf16_t* Kp = p.KB + (size_t)(b * 8 + h) * LKV * 64; const bf16_t* Vt = p.VBt + (size_t)(b * 8 + h) * 64 * LKV;
        ATT_BEGIN();
        for (int j = 0; j < CTX_LEN; ++j) ATT_KEY(Kp, Vt, j, 0.f);
        int kh = B_WIN_H < GRID_H ? B_WIN_H : GRID_H;
        int rs = r - kh / 2; if (rs < 0) rs = 0; if (rs > GRID_H - kh) rs = GRID_H - kh;
        int cs = cq - B_WIN_W / 2; if (cs < 0) cs = 0; if (cs > GRID_W - B_WIN_W) cs = GRID_W - B_WIN_W;
        for (int kr = rs; kr < rs + kh; ++kr)
            for (int kc = cs; kc < cs + B_WIN_W; ++kc) {
                int dr = kr - r, dc = kc - cq;
                float bias = p.b_rpb[(h * (2 * B_WIN_H - 1) + dr + B_WIN_H - 1) * (2 * B_WIN_W - 1) + dc + B_WIN_W - 1];
                ATT_KEY(Kp, Vt, CTX_LEN + kr * GRID_W + kc, bias);
            }
        for (int d = 0; d < 64; ++d) p.Y[(size_t)row * 1024 + 512 + h * 64 + d] = f2bf(acc[d] / l_);
    }
}
GLOBAL void nk_attn_ctx(Params p) {
    GS_LOOP(i, (long)TC * 16) {
        int hh = i % 16, rc = i / 16, ty = hh / 8, h = hh % 8, b = rc / CTX_LEN; int row = TX + rc;
        const bf16_t* qp = (ty == 0 ? p.QA : p.QB) + (size_t)row * 512 + h * 64;
        const bf16_t* Kp = ty == 0 ? p.KA + (size_t)(b * 2 + h / 4) * LKV * 64 : p.KB + (size_t)(b * 8 + h) * LKV * 64;
        const bf16_t* Vt = ty == 0 ? p.VAt + (size_t)(b * 2 + h / 4) * 64 * LKV : p.VBt + (size_t)(b * 8 + h) * 64 * LKV;
        ATT_BEGIN();
        for (int j = 0; j < CTX_LEN; ++j) ATT_KEY(Kp, Vt, j, 0.f);
        if (ty == 0) ATT_SINK(p.a_sink[h]);
        for (int d = 0; d < 64; ++d) p.Y[(size_t)row * 1024 + ty * 512 + h * 64 + d] = f2bf(acc[d] / l_);
    }
}
GLOBAL void nk_attnC(Params p) {
    GS_LOOP(i, (long)TX * 8) {
        int h = i % 8, row = i / 8, b = row / SEQ, kvh = h / 4;
        const bf16_t* qp = p.QC + (size_t)row * 512 + h * 64;
        const bf16_t* Kp = p.KC + (size_t)(b * 2 + kvh) * LKV * 64; const bf16_t* Vt = p.VCt + (size_t)(b * 2 + kvh) * 64 * LKV;
        ATT_BEGIN();
        for (int j = 0; j < LKV; ++j) ATT_KEY(Kp, Vt, j, 0.f);
        for (int d = 0; d < 64; ++d) p.Y[(size_t)row * 1024 + h * 64 + d] = f2bf(acc[d] / l_);
    }
}

GLOBAL void nk_outproj_even(Params p) {
    GS_LOOP(i, (long)TT * D_MODEL) {
        int row = i / D_MODEL, col = i % D_MODEL;
        float acc = dot_row(p.Y + (size_t)row * 1024, p.w_out_even, D_MODEL, col, EVEN_OUT);
        xrow_cur(p, row)[col] = xrow_in(p, 0, row)[col] + modp(p, 0, row, 2)[col] * acc;
    }
}
GLOBAL void nk_outproj_odd(Params p) {
    GS_LOOP(i, (long)TX * D_MODEL) {
        int row = i / D_MODEL, col = i % D_MODEL, b = row / SEQ, s = row % SEQ;
        float acc = dot_row(p.Y + (size_t)row * 1024, p.w_out_odd, D_MODEL, col, 512);
        for (int c = 0; c < D_CH; ++c) acc += bf2f(p.YHT[((size_t)b * D_CH + c) * SEQ + s]) * p.w_out_odd[(size_t)(512 + c) * D_MODEL + col];
        p.out[i] = p.out[i] + modp(p, 1, row, 2)[col] * acc;
    }
}

GLOBAL void nk_router(Params p, int l, int nrows) {
    GS_LOOP(row, nrows) {
        const float* xr = xrow_cur(p, (int)row);
        float ss = 0.f;
        for (int k = 0; k < D_MODEL; ++k) ss += xr[k] * xr[k];
        float rstd = 1.0f / sqrtf(ss / D_MODEL + EPS);
        const float* g = p.norm_g + (l * 2 + 1) * D_MODEL; const float* sh = modp(p, l, (int)row, 3); const float* sc = modp(p, l, (int)row, 4);
        float lg[16];
#pragma unroll
        for (int e = 0; e < 16; ++e) lg[e] = 0.f;
        for (int k = 0; k < D_MODEL; ++k) { float hv = xr[k] * rstd * g[k] * (1.0f + sc[k]) + sh[k];
#pragma unroll
            for (int e = 0; e < 16; ++e) lg[e] += hv * p.w_router[k * 16 + e]; }
        int gbest = 0, a = 0, bb = 1; float gbs = -1e30f, wa = 0.f, wb = 0.f;
#pragma unroll
        for (int gI = 0; gI < 4; ++gI) {
            float m1 = -1e30f, m2 = -1e30f, s1 = 0.f, s2 = 0.f; int i1 = 0, i2 = 0;
#pragma unroll
            for (int j = 0; j < 4; ++j) { float sgv = sigmoid_f(lg[gI * 4 + j]); float v = sgv + p.b_router[gI * 4 + j];
                if (v > m1) { m2 = m1; i2 = i1; s2 = s1; m1 = v; i1 = j; s1 = sgv; } else if (v > m2) { m2 = v; i2 = j; s2 = sgv; } }
            float gs = m1 + m2;
            if (gs > gbs) { gbs = gs; gbest = gI; if (i1 < i2) { a = i1; bb = i2; wa = s1; wb = s2; } else { a = i2; bb = i1; wa = s2; wb = s1; } }
        }
        float inv = 1.0f / (wa + wb);
        int pidx = a == 0 ? bb - 1 : (a == 1 ? bb + 1 : 5);
        int pr = gbest * 6 + pidx;
        int pos = atomicAdd(p.cnt + l * 32 + pr, 1);
        p.list[(size_t)pr * TT + pos] = (int)row;
        p.tokw[row * 2 + 0] = wa * inv; p.tokw[row * 2 + 1] = wb * inv;
    }
}
HD void pair_experts(int pr, int& e1, int& e2) { int g = pr / 6, q = pr % 6; int a = q < 3 ? 0 : (q < 5 ? 1 : 2); int b = q < 3 ? q + 1 : (q < 5 ? q - 1 : 3); e1 = g * 4 + a; e2 = g * 4 + b; }
HD bool slot_lookup(const Params& p, int l, int slot, int& pr, int& row) { int acc = 0; for (int q = 0; q < NPAIR; ++q) { int c = p.cnt[l * 32 + q]; if (slot < acc + c) { pr = q; row = p.list[(size_t)q * TT + (slot - acc)]; return true; } acc += c; } return false; }
GLOBAL void nk_moe_up(Params p, int l, int nrows) {
    GS_LOOP(i, (long)nrows * HE_W) {
        int slot = i / HE_W, j = i % HE_W, k = j / D_EXPERT, jj = j % D_EXPERT; int pr, row; if (!slot_lookup(p, l, slot, pr, row)) continue;
        int e1, e2; pair_experts(pr, e1, e2); int e = k == 0 ? e1 : e2;
        const bf16_t* a = p.hbuf + (size_t)row * D_MODEL;
        const float* wg = p.moe_wg + (size_t)(l * N_EXPERTS + e) * D_MODEL * D_EXPERT; const float* wu = p.moe_wu + (size_t)(l * N_EXPERTS + e) * D_MODEL * D_EXPERT;
        float g = dot_row(a, wg, D_EXPERT, jj, D_MODEL), u = dot_row(a, wu, D_EXPERT, jj, D_MODEL);
        p.HE[(size_t)row * HE_W + j] = f2bf(p.tokw[row * 2 + k] * silu_f(g) * u);
    }
}
GLOBAL void nk_moe_down(Params p, int l, int nrows) {
    GS_LOOP(i, (long)nrows * D_MODEL) {
        int slot = i / D_MODEL, col = i % D_MODEL; int pr, row; if (!slot_lookup(p, l, slot, pr, row)) continue;
        int e1, e2; pair_experts(pr, e1, e2);
        const bf16_t* a = p.HE + (size_t)row * HE_W;
        float acc = dot_row(a, p.moe_wd + (size_t)(l * N_EXPERTS + e1) * D_EXPERT * D_MODEL, D_MODEL, col, D_EXPERT)
                  + dot_row(a + D_EXPERT, p.moe_wd + (size_t)(l * N_EXPERTS + e2) * D_EXPERT * D_MODEL, D_MODEL, col, D_EXPERT);
        float* xr = xrow_cur(p, row);
        xr[col] = xr[col] + modp(p, l, row, 5)[col] * acc;
    }
}

GLOBAL void nk_inproj_odd_qk(Params p) {
    GS_LOOP(i, (long)TT * 10) {
        int row = i / 10, hu = i % 10; const bf16_t* a = p.hbuf + (size_t)row * D_MODEL;
        bool lat = row < TX; int b = lat ? row / SEQ : (row - TX) / CTX_LEN; int s = lat ? row % SEQ : (row - TX) % CTX_LEN; int pos = lat ? CTX_LEN + s : s;
        int col0 = hu * 64;
        float v[64]; float ss = 0.f;
        for (int d = 0; d < 64; ++d) { v[d] = dot_row(a, p.w_in_odd, ODD_IN, col0 + d, D_MODEL); ss += v[d] * v[d]; }
        float rstd = 1.0f / sqrtf(ss / 64.0f + EPS);
        const float* gn = hu < 8 ? p.c_qnorm : p.c_knorm;
        for (int d = 0; d < 64; ++d) v[d] = v[d] * rstd * gn[d];
        for (int d = 0; d < 64; ++d) {
            float o = v[d];
            if (lat) { int pd = (d & 31) < 16 ? d + 16 : d - 16; o = rope_apply(p, v[d], v[pd], d, s); }
            if (hu < 8) p.QC[(size_t)row * 512 + col0 + d] = f2bf(o);
            else p.KC[((size_t)(b * 2 + (hu - 8)) * LKV + pos) * 64 + d] = f2bf(o);
        }
    }
}
GLOBAL void nk_inproj_odd_vu(Params p) {
    GS_LOOP(i, (long)TT * (ODD_IN - 640)) {
        int row = i / (ODD_IN - 640), col = 640 + i % (ODD_IN - 640); const bf16_t* a = p.hbuf + (size_t)row * D_MODEL;
        bool lat = row < TX; int b = lat ? row / SEQ : (row - TX) / CTX_LEN; int s = lat ? row % SEQ : (row - TX) % CTX_LEN; int pos = lat ? CTX_LEN + s : s;
        if (col >= 768 && !lat) continue;
        float v = dot_row(a, p.w_in_odd, ODD_IN, col, D_MODEL);
        if (col < 768) { int h = (col - 640) >> 6, d = col & 63; p.VCt[((size_t)(b * 2 + h) * 64 + d) * LKV + pos] = f2bf(v); }
        else p.UT[((size_t)b * 3 * D_CH + (col - 768)) * SEQ + s] = f2bf(v);
    }
}

HD float hy_sc(const Params& p, int b, int ch, int t) {
    const bf16_t* u = p.UT + ((size_t)b * 3 * D_CH + ch) * SEQ;
    float acc = p.hy_short_b[ch];
    for (int kk = 0; kk < 3; ++kk) { int tt = t + kk - 1; if (tt >= 0 && tt < SEQ) acc += p.hy_short_w[kk * 3 * D_CH + ch] * bf2f(u[tt]); }
    return acc;
}
GLOBAL void nk_hy_conv(Params p, int o) {
    GS_LOOP(i, (long)BATCH * D_CH * SEQ) {
        int n = i % SEQ, c = (i / SEQ) % D_CH, b = i / ((long)SEQ * D_CH);
        const float* hf = p.HFT + (size_t)((0 * 2 + o) * D_CH + c) * SEQ; const float* hb = p.HFT + (size_t)((1 * 2 + o) * D_CH + c) * SEQ;
        float inv = 1.0f / p.hnorm[o * D_CH + c];
        float acc = 0.f;
        for (int m = 0; m < SEQ; ++m) {
            float z = o == 0 ? hy_sc(p, b, c, m) : p.Z1[((size_t)b * D_CH + c) * SEQ + m];
            int d = n - m; float hv = d >= 0 ? hf[d] : hb[-d];
            acc += hv * z;
        }
        acc *= inv;
        float zn = o == 0 ? hy_sc(p, b, c, n) : p.Z1[((size_t)b * D_CH + c) * SEQ + n];
        float g = hy_sc(p, b, (o + 1) * D_CH + c, n);
        float r = g * (acc + zn * p.hy_bias[o * D_CH + c]);
        if (o == 0) p.Z1[i] = r; else p.YHT[i] = f2bf(r);
    }
}

GLOBAL void nk_final(Params p) {
    GS_LOOP(row, TX) {
        float* xr = p.out + (size_t)row * D_MODEL; float ss = 0.f;
        for (int k = 0; k < D_MODEL; ++k) ss += xr[k] * xr[k];
        float rstd = 1.0f / sqrtf(ss / D_MODEL + EPS);
        for (int k = 0; k < D_MODEL; ++k) xr[k] = xr[k] * rstd * p.final_g[k];
    }
}
GLOBAL void nk_yht_to_y(Params p) {
    GS_LOOP(i, (long)TX * D_CH) { int row = i / D_CH, c = i % D_CH, b = row / SEQ, s = row % SEQ; p.Y[(size_t)row * 1024 + 512 + c] = p.YHT[((size_t)b * D_CH + c) * SEQ + s]; }
}

GLOBAL void nk_rope(Params p) { d_rope(p); }
GLOBAL void nk_hy_h1(Params p) { d_hy_h1(p); }
GLOBAL void nk_hy_h2(Params p) { d_hy_h2(p); }
static inline size_t al256(size_t x) { return (x + 255) & ~(size_t)255; }
static size_t setup_ws(Params& p, char* ws) {
    size_t o = 0;
    auto take = [&](size_t bytes) { char* r = ws + o; o += al256(bytes); return r; };
    p.bar = (unsigned*)take(64 * 1024);
    p.cnt = (int*)take(256);
    p.XC = (float*)take((size_t)TC * D_MODEL * 4);
    p.mod = (float*)take((size_t)DEPTH * (BATCH + 1) * 6 * D_MODEL * 4);
    p.ropet = (float*)take(64 * 32 * 4);
    p.h1 = (float*)take((size_t)SEQ * 64 * 4);
    p.h2 = (float*)take((size_t)SEQ * 64 * 4);
    p.HFT = (float*)take((size_t)4 * D_CH * SEQ * 4);
    p.hnorm = (float*)take(2 * D_CH * 4);
    p.list = (int*)take((size_t)NPAIR * TT * 4);
    p.tokw = (float*)take((size_t)TT * 2 * 4);
    p.rpair = (int*)take((size_t)TT * 4);
    p.bh = (int*)take((size_t)2048 * 32 * 4);
    p.rlog = (float*)take((size_t)TT * 16 * 4);
    size_t hb = (size_t)TT * D_MODEL * 2, z1 = (size_t)BATCH * D_CH * SEQ * 4;
    char* r0 = take(hb > z1 ? hb : z1); p.hbuf = (bf16_t*)r0; p.Z1 = (float*)r0;
    size_t q = al256((size_t)TT * 512 * 2), kva = al256((size_t)BATCH * 2 * LKV * 64 * 2), kvb = al256((size_t)BATCH * 8 * LKV * 64 * 2), ut = al256((size_t)BATCH * 3 * D_CH * SEQ * 2);
    size_t l0 = 2 * q + 2 * kva + 2 * kvb, l1 = q + 2 * kva + ut;
    char* R = take(l0 > l1 ? l0 : l1);
    p.QA = (bf16_t*)R; p.KA = (bf16_t*)(R + q); p.VAt = (bf16_t*)(R + q + kva); p.QB = (bf16_t*)(R + q + 2 * kva); p.KB = (bf16_t*)(R + 2 * q + 2 * kva); p.VBt = (bf16_t*)(R + 2 * q + 2 * kva + kvb);
    p.QC = (bf16_t*)R; p.KC = (bf16_t*)(R + q); p.VCt = (bf16_t*)(R + q + kva); p.UT = (bf16_t*)(R + q + 2 * kva);
    size_t yb = (size_t)TT * 1024 * 2, heb = (size_t)TT * HE_W * 2;
    char* r1 = take(yb > heb ? yb : heb); p.Y = (bf16_t*)r1; p.HE = (bf16_t*)r1;
    p.YHT = (bf16_t*)take((size_t)BATCH * D_CH * SEQ * 2);
    p.Wt_in_even = (bf16_t*)take((size_t)EVEN_IN * D_MODEL * 2);
    p.Wt_out_even = (bf16_t*)take((size_t)D_MODEL * EVEN_OUT * 2);
    p.Wt_in_odd = (bf16_t*)take((size_t)ODD_IN * D_MODEL * 2);
    p.Wt_out_odd = (bf16_t*)take((size_t)D_MODEL * ODD_OUT * 2);
    p.Wt_gu = (bf16_t*)take((size_t)DEPTH * N_EXPERTS * 2 * D_EXPERT * D_MODEL * 2);
    p.Wt_d = (bf16_t*)take((size_t)DEPTH * N_EXPERTS * D_MODEL * D_EXPERT * 2);
    return o;
}
static void fill_inputs(Params& p, void* const* d_in, void* d_out) {
    const float** f = (const float**)&p.x;
    for (int i = 0; i < 32; ++i) f[i] = (const float*)d_in[i];
    p.out = (float*)d_out;
}
#define LAS __attribute__((address_space(3)))
typedef short bf16x8 __attribute__((ext_vector_type(8)));
typedef float f32x4 __attribute__((ext_vector_type(4)));
typedef float f32x16 __attribute__((ext_vector_type(16)));
typedef unsigned u32x4 __attribute__((ext_vector_type(4)));
typedef unsigned u32x2 __attribute__((ext_vector_type(2)));

constexpr int NTHREADS = 256;
constexpr int LDS_BYTES = 69632;
constexpr int MT_ALL = TT / 128, MT_LAT = TX / 128;

__device__ __forceinline__ unsigned pk2bf(float lo, float hi) { return (unsigned)f2bf(lo) | ((unsigned)f2bf(hi) << 16); }
__device__ __forceinline__ float wave_sum(float v) {
#pragma unroll
    for (int o = 1; o < 64; o <<= 1) v += __shfl_xor(v, o);
    return v;
}

template <class DstF>
__device__ __forceinline__ void cvt_block_item(char* lds, const float* W, int N, int k0, int n0, const DstF& dst) {
    float* T = (float*)lds; const int tid = threadIdx.x;
    f32x4 v[16];
#pragma unroll
    for (int i = 0; i < 16; ++i) v[i] = *(const f32x4*)(W + (size_t)(k0 + (tid >> 6) + 4 * i) * N + n0 + 4 * (tid & 63));
#pragma unroll
    for (int i = 0; i < 16; ++i) *(f32x4*)(T + ((tid >> 6) + 4 * i) * 260 + 4 * (tid & 63)) = v[i];
    __syncthreads();
    bf16_t* d = dst(n0 + tid) + k0; const float* s = T + tid;
#pragma unroll
    for (int c = 0; c < 8; ++c) { u32x4 w; w.x = pk2bf(s[(8 * c + 0) * 260], s[(8 * c + 1) * 260]); w.y = pk2bf(s[(8 * c + 2) * 260], s[(8 * c + 3) * 260]);
        w.z = pk2bf(s[(8 * c + 4) * 260], s[(8 * c + 5) * 260]); w.w = pk2bf(s[(8 * c + 6) * 260], s[(8 * c + 7) * 260]); *(u32x4*)(d + 8 * c) = w; }
    __syncthreads();
}
__device__ __forceinline__ void cvt_plain(char* lds, const float* W, bf16_t* Wt, int K, int N, int item) {
    const int nb = N / 256, kb = item / nb, nbi = item % nb;
    cvt_block_item(lds, W, N, kb * 64, nbi * 256, [&](int n) { return Wt + (size_t)n * K; });
}
constexpr int CVT_IN = (D_MODEL / 64) * (EVEN_IN / 256), CVT_OUT = (D_MODEL / 64) * (D_MODEL / 256), CVT_GU1 = (D_MODEL / 64) * (D_EXPERT / 256), CVT_D1 = (D_EXPERT / 64) * (D_MODEL / 256);
constexpr int CVT_GU = DEPTH * N_EXPERTS * 2 * CVT_GU1, CVT_D = DEPTH * N_EXPERTS * CVT_D1;
constexpr int CVT_TOTAL = 2 * CVT_IN + 2 * CVT_OUT + CVT_GU + CVT_D;
constexpr int CVT_EARLY = 2 * CVT_IN + 2 * CVT_OUT;
static_assert(EVEN_IN % 256 == 0 && ODD_IN % 256 == 0 && D_EXPERT % 256 == 0, "conversion tile");
__device__ __forceinline__ void cvt_item(const Params& p, char* lds, int it) {
    if (it < CVT_IN) { cvt_plain(lds, p.w_in_even, p.Wt_in_even, D_MODEL, EVEN_IN, it); return; } it -= CVT_IN;
    if (it < CVT_IN) { cvt_plain(lds, p.w_in_odd, p.Wt_in_odd, D_MODEL, ODD_IN, it); return; } it -= CVT_IN;
    if (it < CVT_OUT) { cvt_plain(lds, p.w_out_even, p.Wt_out_even, EVEN_OUT, D_MODEL, it); return; } it -= CVT_OUT;
    if (it < CVT_OUT) { cvt_plain(lds, p.w_out_odd, p.Wt_out_odd, ODD_OUT, D_MODEL, it); return; } it -= CVT_OUT;
    if (it < CVT_GU) {
        const int le = it / (2 * CVT_GU1), r = it % (2 * CVT_GU1), half = r / CVT_GU1, r2 = r % CVT_GU1; const int nb = D_EXPERT / 256, kb = r2 / nb, nbi = r2 % nb;
        const float* W = (half ? p.moe_wu : p.moe_wg) + (size_t)le * D_MODEL * D_EXPERT; bf16_t* Wt = p.Wt_gu + (size_t)le * 2 * D_EXPERT * D_MODEL;
        cvt_block_item(lds, W, D_EXPERT, kb * 64, nbi * 256, [&](int n) { return Wt + (size_t)(32 * (n >> 4) + 16 * half + (n & 15)) * D_MODEL; });
        return; } it -= CVT_GU;
    { const int le = it / CVT_D1, r = it % CVT_D1; cvt_plain(lds, p.moe_wd + (size_t)le * D_EXPERT * D_MODEL, p.Wt_d + (size_t)le * D_MODEL * D_EXPERT, D_EXPERT, D_MODEL, r); }
}
__device__ __forceinline__ void cvt_range(const Params& p, char* lds, int lo, int hi, int bid, int nb) {
    for (int it = lo + bid; it < hi; it += nb) cvt_item(p, lds, it);
}

struct TileGeom { int tid, lane, wid, wr, wc, l15, q, srow, schunk;
    __device__ __forceinline__ int drow(int i) const { return wid * 32 + i * 8 + (lane >> 3); }
    __device__ __forceinline__ int dchunk(int i) const { return (lane & 7) ^ (((lane >> 4) + 4 * i) & 7); } };
__device__ __forceinline__ TileGeom tile_geom() { TileGeom g; g.tid = threadIdx.x; g.lane = g.tid & 63; g.wid = __builtin_amdgcn_readfirstlane(g.tid >> 6); g.wr = g.wid >> 1; g.wc = g.wid & 1; g.l15 = g.lane & 15; g.q = g.lane >> 4; g.srow = g.tid >> 3; g.schunk = g.tid & 7; return g; }

template <class ALoad, class BLoad>
__device__ __forceinline__ void gemm_mainloop(char* lds, const TileGeom& g, int nk, const ALoad& AL, const BLoad& BL, f32x4 (&acc)[4][4]) {
#pragma unroll
    for (int i = 0; i < 4; ++i)
#pragma unroll
        for (int j = 0; j < 4; ++j) acc[i][j] = (f32x4){0.f, 0.f, 0.f, 0.f};
    const int swz = g.l15 >> 1;
    const int aofs = (g.wr * 64 + g.l15) * 128 + ((g.q ^ swz) << 4);
    const int bofs = 32768 + (g.wc * 64 + g.l15) * 128 + ((g.q ^ swz) << 4);
    LAS char* l3 = (LAS char*)lds;
    const int dbase = g.wid * 4096;
#define GEMM_STAGE(kt_, buf_) do { _Pragma("unroll") for (int i_ = 0; i_ < 4; ++i_) { \
        __builtin_amdgcn_global_load_lds((const unsigned*)AL(i_, (kt_)), (LAS unsigned*)(l3 + (buf_) + dbase + i_ * 1024), 16, 0, 0); \
        __builtin_amdgcn_global_load_lds((const unsigned*)BL(i_, (kt_)), (LAS unsigned*)(l3 + 32768 + (buf_) + dbase + i_ * 1024), 16, 0, 0); } } while (0)
#define GEMM_BAR() do { __builtin_amdgcn_s_barrier(); asm volatile("" ::: "memory"); } while (0)
    GEMM_STAGE(0, 0);
    if (nk > 1) GEMM_STAGE(1, 16384);
    asm volatile("s_waitcnt vmcnt(0) lgkmcnt(0)" ::: "memory");
    GEMM_BAR();
    for (int kt = 0; kt < nk; ++kt) {
        const int cur = (kt & 1) * 16384;
        bf16x8 af[2][4], bfr[2][4];
#pragma unroll
        for (int kk = 0; kk < 2; ++kk)
#pragma unroll
            for (int i = 0; i < 4; ++i) { af[kk][i] = *(const bf16x8*)(lds + cur + ((aofs + i * 2048) ^ (kk * 64))); bfr[kk][i] = *(const bf16x8*)(lds + cur + ((bofs + i * 2048) ^ (kk * 64))); }
        asm volatile("s_waitcnt lgkmcnt(0)" ::: "memory");
        GEMM_BAR();
        if (kt + 2 < nk) GEMM_STAGE(kt + 2, cur);
#pragma unroll
        for (int kk = 0; kk < 2; ++kk)
#pragma unroll
            for (int mi = 0; mi < 4; ++mi)
#pragma unroll
                for (int ni = 0; ni < 4; ++ni) acc[mi][ni] = __builtin_amdgcn_mfma_f32_16x16x32_bf16(bfr[kk][ni], af[kk][mi], acc[mi][ni], 0, 0, 0);
        if (kt + 1 < nk) {
            if (kt + 2 < nk) asm volatile("s_waitcnt vmcnt(8)" ::: "memory"); else asm volatile("s_waitcnt vmcnt(0)" ::: "memory");
            GEMM_BAR();
        }
    }
#undef GEMM_STAGE
#undef GEMM_BAR
}

template <class DstF>
__device__ __forceinline__ void store_transposed(char* lds, const TileGeom& g, const f32x4 (&acc)[4][4], const DstF& dst) {
    bf16_t* T = (bf16_t*)lds;
#pragma unroll
    for (int mi = 0; mi < 4; ++mi)
#pragma unroll
        for (int ni = 0; ni < 4; ++ni)
#pragma unroll
            for (int r = 0; r < 4; ++r) T[(g.wc * 64 + ni * 16 + g.q * 4 + r) * 136 + g.wr * 64 + mi * 16 + g.l15] = f2bf(acc[mi][ni][r]);
    __syncthreads();
    { int col = g.tid >> 1, half = g.tid & 1; bf16_t* d = dst(col) + half * 64; const bf16_t* s = T + col * 136 + half * 64;
#pragma unroll
      for (int j = 0; j < 8; ++j) *(u32x4*)(d + j * 8) = *(const u32x4*)(s + j * 8); }
    __syncthreads();
}
__device__ __forceinline__ void store4bf(bf16_t* d, const f32x4& v) { u32x2 w; w.x = pk2bf(v[0], v[1]); w.y = pk2bf(v[2], v[3]); *(u32x2*)d = w; }
__device__ __forceinline__ void rope_head(const Params& p, f32x4 (&a)[4], int s, int q) {
    const int pr = s / GRID_W, pc = s % GRID_W;
    const f32x4 cr = *(const f32x4*)(p.ropet + pr * 32 + q * 4), sr = *(const f32x4*)(p.ropet + pr * 32 + 16 + q * 4);
    const f32x4 cc = *(const f32x4*)(p.ropet + pc * 32 + q * 4), sc = *(const f32x4*)(p.ropet + pc * 32 + 16 + q * 4);
    f32x4 x1 = a[0], x2 = a[1]; a[0] = x1 * cr - x2 * sr; a[1] = x2 * cr + x1 * sr;
    x1 = a[2]; x2 = a[3]; a[2] = x1 * cc - x2 * sc; a[3] = x2 * cc + x1 * sc;
}

template <int LAYER>
__device__ __forceinline__ void inproj_tile(const Params& p, char* lds, int mt, int nt) {
    const TileGeom g = tile_geom();
    const bf16_t* Abase = p.hbuf + (size_t)(mt * 128) * D_MODEL;
    const bf16_t* Bbase = (LAYER == 0 ? p.Wt_in_even : p.Wt_in_odd) + (size_t)(nt * 128) * D_MODEL;
    f32x4 acc[4][4];
    gemm_mainloop(lds, g, D_MODEL / 64, [&](int i, int kt) { return Abase + (size_t)g.drow(i) * D_MODEL + kt * 64 + g.dchunk(i) * 8; }, [&](int i, int kt) { return Bbase + (size_t)g.drow(i) * D_MODEL + kt * 64 + g.dchunk(i) * 8; }, acc);
    const bool lat = mt < MT_LAT; const int row0 = mt * 128;
    const int b = lat ? row0 / SEQ : (row0 - TX) / CTX_LEN, s0 = lat ? row0 % SEQ : (row0 - TX) % CTX_LEN, pos0 = lat ? CTX_LEN + s0 : s0;
    int kind;
    bf16_t* base; int h0 = 0, qcol0 = 0, nh = 2;
    if (LAYER == 0) {
        if (nt < 4) { kind = 0; base = p.QA; qcol0 = nt * 128; }
        else if (nt == 4) { kind = 1; base = p.KA; h0 = 0; nh = 2; }
        else if (nt == 5) { kind = 2; base = p.VAt; h0 = 0; nh = 2; }
        else if (nt < 10) { kind = 0; base = p.QB; qcol0 = (nt - 6) * 128; }
        else if (nt < 14) { kind = 1; base = p.KB; h0 = (nt - 10) * 2; nh = 8; }
        else { kind = 2; base = p.VBt; h0 = (nt - 14) * 2; nh = 8; }
    } else {
        if (nt < 4) { kind = 0; base = p.QC; qcol0 = nt * 128; }
        else if (nt == 4) { kind = 1; base = p.KC; h0 = 0; nh = 2; }
        else if (nt == 5) { kind = 2; base = p.VCt; h0 = 0; nh = 2; }
        else { kind = 3; base = p.UT; }
    }
    if (kind <= 1) {
        const bool rope = lat && (LAYER == 1 || nt <= 4);
#pragma unroll
        for (int mi = 0; mi < 4; ++mi) {
            const int rowl = g.wr * 64 + mi * 16 + g.l15;
            if (LAYER == 1) {
                float ss = 0.f;
#pragma unroll
                for (int ni = 0; ni < 4; ++ni) ss += acc[mi][ni][0] * acc[mi][ni][0] + acc[mi][ni][1] * acc[mi][ni][1] + acc[mi][ni][2] * acc[mi][ni][2] + acc[mi][ni][3] * acc[mi][ni][3];
                ss += __shfl_xor(ss, 16); ss += __shfl_xor(ss, 32);
                const float rstd = 1.0f / sqrtf(ss * (1.0f / 64.0f) + EPS);
                const float* gn = kind == 0 ? p.c_qnorm : p.c_knorm;
#pragma unroll
                for (int ni = 0; ni < 4; ++ni) acc[mi][ni] = acc[mi][ni] * rstd * *(const f32x4*)(gn + ni * 16 + g.q * 4);
            }
            if (rope) rope_head(p, acc[mi], s0 + rowl, g.q);
            bf16_t* d = kind == 0 ? base + (size_t)(row0 + rowl) * 512 + qcol0 + g.wc * 64 + g.q * 4
                                  : base + ((size_t)(b * nh + h0 + g.wc) * LKV + pos0 + rowl) * 64 + g.q * 4;
#pragma unroll
            for (int ni = 0; ni < 4; ++ni) store4bf(d + ni * 16, acc[mi][ni]);
        }
    } else if (kind == 2) {
        store_transposed(lds, g, acc, [&](int col) { return base + ((size_t)(b * nh + h0 + (col >> 6)) * 64 + (col & 63)) * LKV + pos0; });
    } else {
        store_transposed(lds, g, acc, [&](int col) { return base + ((size_t)b * 3 * D_CH + (nt - 6) * 128 + col) * SEQ + s0; });
    }
}
template <int LAYER>
__device__ __forceinline__ void ph_inproj(const Params& p, char* lds, int bid, int nb) {
    constexpr int NT = 18;
    const bool xl = (nb & 7) == 0; const int x = xl ? bid & 7 : 0, step = xl ? nb >> 3 : nb, mstep = xl ? 8 : 1;
    if (LAYER == 0) {
        for (int t = xl ? bid >> 3 : bid; ; t += step) { const int mt = (t / NT) * mstep + x, nt = t % NT; if (mt >= MT_ALL) break; inproj_tile<0>(p, lds, mt, nt); }
    } else {
        const int nlat_t = (MT_LAT / mstep) * NT;
        for (int t = xl ? bid >> 3 : bid; ; t += step) {
            int mt, nt;
            if (t < nlat_t) { mt = (t / NT) * mstep + x; nt = t % NT; }
            else { const int u = t - nlat_t; mt = MT_LAT + (u / 2) * mstep + x; nt = 4 + u % 2; if (mt >= MT_ALL) break; }
            inproj_tile<1>(p, lds, mt, nt);
        }
    }
}

template <int LAYER>
__device__ __forceinline__ void outproj_tile(const Params& p, char* lds, int mt, int nt) {
    const TileGeom g = tile_geom();
    const bf16_t* Abase = p.Y + (size_t)(mt * 128) * 1024;
    const bf16_t* Bbase = (LAYER == 0 ? p.Wt_out_even : p.Wt_out_odd) + (size_t)(nt * 128) * 1024;
    f32x4 acc[4][4];
    gemm_mainloop(lds, g, 16, [&](int i, int kt) { return Abase + (size_t)g.drow(i) * 1024 + kt * 64 + g.dchunk(i) * 8; }, [&](int i, int kt) { return Bbase + (size_t)g.drow(i) * 1024 + kt * 64 + g.dchunk(i) * 8; }, acc);
    const int row0 = mt * 128;
#pragma unroll
    for (int mi = 0; mi < 4; ++mi) {
        const int row = row0 + g.wr * 64 + mi * 16 + g.l15;
        const float* xin = xrow_in(p, LAYER, row); float* xo = xrow_cur(p, row); const float* gate = modp(p, LAYER, row, 2);
#pragma unroll
        for (int ni = 0; ni < 4; ++ni) { const int col = nt * 128 + g.wc * 64 + ni * 16 + g.q * 4;
            *(f32x4*)(xo + col) = *(const f32x4*)(xin + col) + *(const f32x4*)(gate + col) * acc[mi][ni]; }
    }
}

template <int LAYER>
__device__ __forceinline__ void ph_outproj(const Params& p, char* lds, int bid, int nb) {
    const int nmt = LAYER == 0 ? MT_ALL : MT_LAT;
    const bool xl = (nb & 7) == 0; const int x = xl ? bid & 7 : 0, step = xl ? nb >> 3 : nb, mstep = xl ? 8 : 1;
    for (int t = xl ? bid >> 3 : bid; ; t += step) { const int mt = (t / 8) * mstep + x, nt = t % 8; if (mt >= nmt) break; outproj_tile<LAYER>(p, lds, mt, nt); }
}

template <int NTN>
__device__ __forceinline__ bool moe_tile_lookup(const int* cnt, int t, int& pr, int& mt, int& nt, int& n) {
    int acc = 0;
    for (int q = 0; q < NPAIR; ++q) { const int c = __builtin_amdgcn_readfirstlane(cnt[q]); const int tiles = ((c + 127) >> 7) * NTN; if (t < acc + tiles) { pr = q; const int u = t - acc; mt = u / NTN; nt = u % NTN; n = c; return true; } acc += tiles; }
    return false;
}
template <int NTN>
__device__ __forceinline__ bool moe_tile_lookup_xcd(const int* cnt, int xcd, int t, int& pr, int& mt, int& nt, int& n) {
    int acc = 0;
#pragma unroll
    for (int i = 0; i < NPAIR / 8; ++i) { const int q = xcd + 8 * i; const int c = __builtin_amdgcn_readfirstlane(cnt[q]); const int tiles = ((c + 127) >> 7) * NTN;
        if (t < acc + tiles) { pr = q; const int u = t - acc; mt = u / NTN; nt = u % NTN; n = c; return true; } acc += tiles; }
    return false;
}
__device__ __forceinline__ void moe_up_tile(const Params& p, char* lds, int l, int pr, int mt, int nt, int n) {
    const TileGeom g = tile_geom();
    int e1, e2; pair_experts(pr, e1, e2); const int k = nt >> 3, e = k ? e2 : e1;
    const int* lst = p.list + (size_t)pr * TT + mt * 128;
    const int navail = n - mt * 128;
    const bf16_t* arow[4];
#pragma unroll
    for (int i = 0; i < 4; ++i) { int r = g.drow(i); if (r >= navail) r = navail - 1; arow[i] = p.hbuf + (size_t)lst[r] * D_MODEL + g.dchunk(i) * 8; }
    const bf16_t* Bbase = p.Wt_gu + ((size_t)(l * N_EXPERTS + e) * 2 * D_EXPERT + (nt & 7) * 128) * D_MODEL;
    f32x4 acc[4][4];
    gemm_mainloop(lds, g, D_MODEL / 64, [&](int i, int kt) { return arow[i] + kt * 64; }, [&](int i, int kt) { return Bbase + (size_t)g.drow(i) * D_MODEL + kt * 64 + g.dchunk(i) * 8; }, acc);
#pragma unroll
    for (int mi = 0; mi < 4; ++mi) {
        const int rl = g.wr * 64 + mi * 16 + g.l15;
        if (rl < navail) {
            const int row = lst[rl]; const float w = p.tokw[row * 2 + k];
            bf16_t* d = p.HE + (size_t)row * HE_W + k * D_EXPERT + (nt & 7) * 64 + g.wc * 32 + g.q * 4;
#pragma unroll
            for (int h2 = 0; h2 < 2; ++h2) { f32x4 gg = acc[mi][2 * h2], uu = acc[mi][2 * h2 + 1], o;
#pragma unroll
                for (int r = 0; r < 4; ++r) o[r] = w * (gg[r] / (1.0f + __expf(-gg[r]))) * uu[r];
                store4bf(d + h2 * 16, o); }
        }
    }
}
template <bool DUMMY = false>
__device__ __forceinline__ void moe_down_tile(const Params& p, char* lds, int l, int pr, int mt, int nt, int n) {
    const TileGeom g = tile_geom();
    int e1, e2; pair_experts(pr, e1, e2);
    const int* lst = p.list + (size_t)pr * TT + mt * 128;
    const int navail = n - mt * 128;
    const bf16_t* arow[4];
#pragma unroll
    for (int i = 0; i < 4; ++i) { int r = g.drow(i); if (r >= navail) r = navail - 1; arow[i] = p.HE + (size_t)lst[r] * HE_W + g.dchunk(i) * 8; }
    const bf16_t* B1 = p.Wt_d + ((size_t)(l * N_EXPERTS + e1) * D_MODEL + nt * 128) * D_EXPERT;
    const bf16_t* B2 = p.Wt_d + ((size_t)(l * N_EXPERTS + e2) * D_MODEL + nt * 128) * D_EXPERT;
    constexpr int KT1 = D_EXPERT / 64;
    f32x4 acc[4][4];
    gemm_mainloop(lds, g, HE_W / 64, [&](int i, int kt) { return arow[i] + kt * 64; },
                  [&](int i, int kt) { return (kt < KT1 ? B1 + kt * 64 : B2 + (kt - KT1) * 64) + (size_t)g.drow(i) * D_EXPERT + g.dchunk(i) * 8; }, acc);
#pragma unroll
    for (int mi = 0; mi < 4; ++mi) {
        const int rl = g.wr * 64 + mi * 16 + g.l15;
        if (rl < navail) {
            const int row = lst[rl]; float* xo = xrow_cur(p, row); const float* gate = modp(p, l, row, 5);
#pragma unroll
            for (int ni = 0; ni < 4; ++ni) { const int col = nt * 128 + g.wc * 64 + ni * 16 + g.q * 4; float* dst = DUMMY ? (float*)p.QA + (size_t)row * D_MODEL : xo; *(f32x4*)(dst + col) = *(const f32x4*)(xo + col) + *(const f32x4*)(gate + col) * acc[mi][ni]; }
        }
    }
}
__device__ __forceinline__ void ph_moe_up(const Params& p, char* lds, int l, int bid, int nb) {
    int pr, mt, nt, n; const bool xl = (nb & 7) == 0;
    for (int t = xl ? bid >> 3 : bid; xl ? moe_tile_lookup_xcd<16>(p.cnt + l * 32, bid & 7, t, pr, mt, nt, n) : moe_tile_lookup<16>(p.cnt + l * 32, t, pr, mt, nt, n); t += xl ? nb >> 3 : nb) moe_up_tile(p, lds, l, pr, mt, nt, n);
}
template <bool DUMMY = false>
__device__ __forceinline__ void ph_moe_down(const Params& p, char* lds, int l, int bid, int nb) {
    int pr, mt, nt, n; const bool xl = (nb & 7) == 0;
    for (int t = xl ? bid >> 3 : bid; xl ? moe_tile_lookup_xcd<8>(p.cnt + l * 32, bid & 7, t, pr, mt, nt, n) : moe_tile_lookup<8>(p.cnt + l * 32, t, pr, mt, nt, n); t += xl ? nb >> 3 : nb) moe_down_tile<DUMMY>(p, lds, l, pr, mt, nt, n);
}
typedef float f32x2 __attribute__((ext_vector_type(2)));
typedef __bf16 bf16x2_t __attribute__((ext_vector_type(2)));
__device__ __forceinline__ unsigned cvtpk(float lo, float hi) { f32x2 v = {lo, hi}; bf16x2_t b = __builtin_convertvector(v, bf16x2_t); return __builtin_bit_cast(unsigned, b); }
__device__ __forceinline__ int crow(int r, int hi) { return (r & 3) + 8 * (r >> 2) + 4 * hi; }
constexpr float LOG2E = 1.4426950408889634f;
constexpr float QK_C = ATTN_SCALE * LOG2E;
constexpr float NEG_BIG = -1e30f;

__device__ __forceinline__ float max3f(float a, float b, float c) { float r; asm("v_max3_f32 %0, %1, %2, %3" : "=v"(r) : "v"(a), "v"(b), "v"(c)); return r; }
constexpr float ATT_THR = 8.0f;
template <int MODE>
__device__ __forceinline__ void attn_unit(char* lds, const bf16_t* Qp, const bf16_t* Kp, const bf16_t* Vt, bf16_t* Op, int s0, int nctx, int lt0, int nlat, float sink2, bool has_sink, const float* rpb_h) {
    int tid_ = threadIdx.x; asm volatile("" : "+v"(tid_));
    const int tid = tid_, lane = tid & 63, wid = __builtin_amdgcn_readfirstlane(tid >> 6), l31 = lane & 31, hi = lane >> 5;
    float* bias_s = (float*)(lds + 65536);
    if (MODE == 2 && rpb_h) { for (int i = tid; i < 15 * 31; i += NTHREADS) bias_s[i] = rpb_h[i] * LOG2E; }
    const int ntiles = nctx + nlat;
    LAS char* l3 = (LAS char*)lds;
    const int drow0 = wid * 16 + (lane >> 3);
    const int dch0 = (lane & 7) ^ (((lane >> 4) + 0) & 7), dch1 = (lane & 7) ^ (((lane >> 4) + 4) & 7);
    const bf16_t* ksrc0 = Kp + (size_t)drow0 * 64 + dch0 * 8; const bf16_t* ksrc1 = Kp + (size_t)(drow0 + 8) * 64 + dch1 * 8;
    const bf16_t* vsrc0 = Vt + (size_t)drow0 * LKV + dch0 * 8; const bf16_t* vsrc1 = Vt + (size_t)(drow0 + 8) * LKV + dch1 * 8;
    const int ddst = wid * 2048;
    auto tile_pos = [&](int j) { return j < nctx ? 64 * j : CTX_LEN + 64 * (lt0 + j - nctx); };
#define ATT_DMA(j_, slot_) do { const int pos_ = tile_pos(j_); \
        __builtin_amdgcn_global_load_lds((const unsigned*)(ksrc0 + (size_t)pos_ * 64), (LAS unsigned*)(l3 + (slot_) * 8192 + ddst), 16, 0, 0); \
        __builtin_amdgcn_global_load_lds((const unsigned*)(ksrc1 + (size_t)pos_ * 64), (LAS unsigned*)(l3 + (slot_) * 8192 + ddst + 1024), 16, 0, 0); \
        __builtin_amdgcn_global_load_lds((const unsigned*)(vsrc0 + pos_), (LAS unsigned*)(l3 + 32768 + (slot_) * 8192 + ddst), 16, 0, 0); \
        __builtin_amdgcn_global_load_lds((const unsigned*)(vsrc1 + pos_), (LAS unsigned*)(l3 + 32768 + (slot_) * 8192 + ddst + 1024), 16, 0, 0); } while (0)
    const int x = (l31 >> 1) & 7;
    const int kofs = l31 * 128 + ((hi ^ x) << 4);
    const int vofs = 32768 + l31 * 128 + (x << 4) + 8 * hi;
    bf16x8 qf[4];
    { const bf16_t* qr = Qp + (size_t)(wid * 32 + l31) * 512 + hi * 8;
#pragma unroll
      for (int s = 0; s < 4; ++s) { const u32x4 raw = *(const u32x4*)(qr + s * 16); u32x4 sc;
#pragma unroll
          for (int e = 0; e < 4; ++e) { const float lo = __builtin_bit_cast(float, raw[e] << 16) * QK_C, hi2 = __builtin_bit_cast(float, raw[e] & 0xffff0000u) * QK_C; sc[e] = cvtpk(lo, hi2); }
          qf[s] = __builtin_bit_cast(bf16x8, sc); } }
#define ATT_WAIT(need_, last_) do { const int lastt_ = (last_) < ntiles - 1 ? (last_) : ntiles - 1; const int ahead_ = lastt_ - (need_); \
        if (ahead_ >= 2) asm volatile("s_waitcnt vmcnt(8) lgkmcnt(0)" ::: "memory"); else if (ahead_ == 1) asm volatile("s_waitcnt vmcnt(4) lgkmcnt(0)" ::: "memory"); \
        else asm volatile("s_waitcnt vmcnt(0) lgkmcnt(0)" ::: "memory"); } while (0)
    ATT_DMA(0, 0);
    if (ntiles > 1) ATT_DMA(1, 1);
    if (ntiles > 2) ATT_DMA(2, 2);
    f32x16 o0 = {}, o1 = {};
    f32x16 negm = {};
    float mref = 0.f, l = 0.f;
    const int sq = s0 + wid * 32 + l31;
    int rq = 0, cq = 0, rsq = 0, csq = 0;
    if (MODE == 2) { rq = sq / GRID_W; cq = sq % GRID_W; rsq = rq - B_WIN_H / 2; rsq = rsq < 0 ? 0 : (rsq > GRID_H - B_WIN_H ? GRID_H - B_WIN_H : rsq); csq = cq - B_WIN_W / 2; csq = csq < 0 ? 0 : (csq > GRID_W - B_WIN_W ? GRID_W - B_WIN_W : csq); }
    ATT_WAIT(0, 2);
    __builtin_amdgcn_s_barrier(); asm volatile("" ::: "memory");
    int slot = 0;
    for (int j = 0; j < ntiles; ++j) {
        const int slot1 = (slot + 1) & 3, slot3 = (slot + 3) & 3;
        if (j + 3 < ntiles) ATT_DMA(j + 3, slot3);
        const char* Kb = lds + slot * 8192; const char* Vb = lds + slot * 8192;
        f32x16 p0, p1;
#pragma unroll
        for (int s = 0; s < 4; ++s) {
            const bf16x8 k0 = *(const bf16x8*)(Kb + (kofs ^ (s << 5))); const bf16x8 k1 = *(const bf16x8*)(Kb + 4096 + (kofs ^ (s << 5)));
            if (s == 0) { p0 = __builtin_amdgcn_mfma_f32_32x32x16_bf16(k0, qf[0], negm, 0, 0, 0); p1 = __builtin_amdgcn_mfma_f32_32x32x16_bf16(k1, qf[0], negm, 0, 0, 0); }
            else { p0 = __builtin_amdgcn_mfma_f32_32x32x16_bf16(k0, qf[s], p0, 0, 0, 0); p1 = __builtin_amdgcn_mfma_f32_32x32x16_bf16(k1, qf[s], p1, 0, 0, 0); }
        }
        asm volatile("s_nop 15\n\ts_nop 7" : "+v"(p0), "+v"(p1));
        if (MODE == 1 && j >= nctx) {
            const int sk0 = 64 * (lt0 + j - nctx);
#pragma unroll
            for (int r = 0; r < 16; ++r) { const int d0 = sk0 + crow(r, hi) - sq, d1 = d0 + 32;
                p0[r] = (d0 >= -A_WINDOW && d0 <= A_WINDOW) ? p0[r] : NEG_BIG; p1[r] = (d1 >= -A_WINDOW && d1 <= A_WINDOW) ? p1[r] : NEG_BIG; }
        } else if (MODE == 2 && j >= nctx) {
            const int kr = lt0 + j - nctx; const bool rowok = kr >= rsq && kr < rsq + B_WIN_H;
            const float* brow = bias_s + (kr - rq + B_WIN_H - 1) * 31 + (B_WIN_W - 1) - cq;
#pragma unroll
            for (int r = 0; r < 16; ++r) { const int kc0 = crow(r, hi), kc1 = kc0 + 32;
                const bool ok0 = rowok && kc0 >= csq && kc0 < csq + B_WIN_W, ok1 = rowok && kc1 >= csq && kc1 < csq + B_WIN_W;
                p0[r] = ok0 ? p0[r] + brow[kc0] : NEG_BIG; p1[r] = ok1 ? p1[r] + brow[kc1] : NEG_BIG; }
        }
        float ta = max3f(p0[0], p0[1], p1[0]), tb = max3f(p0[2], p0[3], p1[1]); ta = max3f(ta, p1[2], p1[3]);
#pragma unroll
        for (int r = 4; r < 16; r += 4) { ta = max3f(ta, p0[r], p0[r + 1]); tb = max3f(tb, p0[r + 2], p0[r + 3]); ta = max3f(ta, p1[r], p1[r + 1]); tb = max3f(tb, p1[r + 2], p1[r + 3]); }
        float tmax = fmaxf(ta, tb); tmax = fmaxf(tmax, __shfl_xor(tmax, 32));
        if (j == 0 || __any(tmax > ATT_THR)) {
            const float dl = j == 0 ? tmax : fmaxf(tmax, 0.f);
            mref += dl;
#pragma unroll
            for (int r = 0; r < 16; ++r) { p0[r] -= dl; p1[r] -= dl; negm[r] = -mref; }
            if (j > 0) { const float f = __builtin_amdgcn_exp2f(-dl); l *= f;
#pragma unroll
                for (int r = 0; r < 16; ++r) { o0[r] *= f; o1[r] *= f; } }
        }
        f32x2 lsum = {0.f, 0.f};
#pragma unroll
        for (int r = 0; r < 16; r += 2) { p0[r] = __builtin_amdgcn_exp2f(p0[r]); p0[r + 1] = __builtin_amdgcn_exp2f(p0[r + 1]); p1[r] = __builtin_amdgcn_exp2f(p1[r]); p1[r + 1] = __builtin_amdgcn_exp2f(p1[r + 1]);
            lsum += (f32x2){p0[r], p0[r + 1]}; lsum += (f32x2){p1[r], p1[r + 1]}; }
        l += lsum.x + lsum.y;
        bf16x8 pf[4];
        { u32x4 w;
          w.x = cvtpk(p0[0], p0[1]); w.y = cvtpk(p0[2], p0[3]); w.z = cvtpk(p0[4], p0[5]); w.w = cvtpk(p0[6], p0[7]); pf[0] = __builtin_bit_cast(bf16x8, w);
          w.x = cvtpk(p0[8], p0[9]); w.y = cvtpk(p0[10], p0[11]); w.z = cvtpk(p0[12], p0[13]); w.w = cvtpk(p0[14], p0[15]); pf[1] = __builtin_bit_cast(bf16x8, w);
          w.x = cvtpk(p1[0], p1[1]); w.y = cvtpk(p1[2], p1[3]); w.z = cvtpk(p1[4], p1[5]); w.w = cvtpk(p1[6], p1[7]); pf[2] = __builtin_bit_cast(bf16x8, w);
          w.x = cvtpk(p1[8], p1[9]); w.y = cvtpk(p1[10], p1[11]); w.z = cvtpk(p1[12], p1[13]); w.w = cvtpk(p1[14], p1[15]); pf[3] = __builtin_bit_cast(bf16x8, w); }
#pragma unroll
        for (int s = 0; s < 4; ++s) {
            const int a0 = vofs ^ (s << 5);
            u32x2 va = *(const u32x2*)(Vb + a0), vb = *(const u32x2*)(Vb + (a0 ^ 16));
            u32x2 vc = *(const u32x2*)(Vb + 4096 + a0), vd = *(const u32x2*)(Vb + 4096 + (a0 ^ 16));
            const bf16x8 f0 = __builtin_bit_cast(bf16x8, (u32x4){va.x, va.y, vb.x, vb.y}), f1 = __builtin_bit_cast(bf16x8, (u32x4){vc.x, vc.y, vd.x, vd.y});
            o0 = __builtin_amdgcn_mfma_f32_32x32x16_bf16(f0, pf[s], o0, 0, 0, 0); o1 = __builtin_amdgcn_mfma_f32_32x32x16_bf16(f1, pf[s], o1, 0, 0, 0);
        }
        ATT_WAIT(j + 1, j + 3);
        __builtin_amdgcn_s_barrier(); asm volatile("" ::: "memory");
        slot = slot1;
    }
#undef ATT_DMA
#undef ATT_WAIT
    l += __shfl_xor(l, 32);
    if (has_sink) l += __builtin_amdgcn_exp2f(sink2 - mref);
    const float inv = 1.0f / l;
    bf16_t* orow = Op + (size_t)(wid * 32 + l31) * 1024;
#pragma unroll
    for (int g4 = 0; g4 < 4; ++g4) {
        u32x2 w; w.x = cvtpk(o0[g4 * 4 + 0] * inv, o0[g4 * 4 + 1] * inv); w.y = cvtpk(o0[g4 * 4 + 2] * inv, o0[g4 * 4 + 3] * inv); *(u32x2*)(orow + 8 * g4 + 4 * hi) = w;
        w.x = cvtpk(o1[g4 * 4 + 0] * inv, o1[g4 * 4 + 1] * inv); w.y = cvtpk(o1[g4 * 4 + 2] * inv, o1[g4 * 4 + 3] * inv); *(u32x2*)(orow + 32 + 8 * g4 + 4 * hi) = w;
    }
    asm volatile("s_waitcnt vmcnt(0)" ::: "memory");
}

constexpr int NU_LAT = BATCH * 8 * (SEQ / 128);
constexpr int NU_CTX = BATCH * 8 * (CTX_LEN / 128);
static_assert(BATCH * 2 == 8, "the XCD-local unit order maps the 8 (batch, kv head) K/V streams onto the 8 XCD groups");
__device__ __forceinline__ void ph_attn0(const Params& p, char* lds, bool xl, int x, int lb, int lstep) {
    const int bid = xl ? x + 8 * lb : lb, nb = xl ? 8 * lstep : lstep;
    constexpr int NQB = SEQ / 128;
    for (int v = xl ? lb : bid; v < (xl ? BATCH * NQB : NU_LAT); v += xl ? lstep : nb) {
        int blk, h, b; if (xl) { blk = v % NQB; b = v / NQB; h = x; } else { blk = v % NQB; h = (v / NQB) % 8; b = v / (8 * NQB); }
        const int s0 = blk * 128, r0 = s0 / GRID_W;
        int rs0 = r0 - 4; rs0 = rs0 < 0 ? 0 : (rs0 > GRID_H - 8 ? GRID_H - 8 : rs0); int rs1 = r0 + 1 - 4; rs1 = rs1 < 0 ? 0 : (rs1 > GRID_H - 8 ? GRID_H - 8 : rs1);
        attn_unit<2>(lds, p.QB + (size_t)(b * SEQ + s0) * 512 + h * 64, p.KB + (size_t)(b * 8 + h) * LKV * 64, p.VBt + (size_t)(b * 8 + h) * 64 * LKV,
                     p.Y + (size_t)(b * SEQ + s0) * 1024 + 512 + h * 64, s0, CTX_LEN / 64, rs0, rs1 + 8 - rs0, 0.f, false, (xl && v != lb) ? nullptr : p.b_rpb + h * 15 * 31);
    }
    for (int v = xl ? lb : bid; v < (xl ? 4 * NQB : NU_LAT); v += xl ? lstep : nb) {
        int blk, h, b; if (xl) { blk = v % NQB; b = x >> 1; h = (x & 1) * 4 + v / NQB; } else { blk = v % NQB; h = (v / NQB) % 8; b = v / (8 * NQB); }
        const int s0 = blk * 128;
        int t0 = (s0 - 128) / 64; if (t0 < 0) t0 = 0; int t1 = (s0 + 255) / 64; if (t1 > SEQ / 64 - 1) t1 = SEQ / 64 - 1;
        attn_unit<1>(lds, p.QA + (size_t)(b * SEQ + s0) * 512 + h * 64, p.KA + (size_t)(b * 2 + h / 4) * LKV * 64, p.VAt + (size_t)(b * 2 + h / 4) * 64 * LKV,
                     p.Y + (size_t)(b * SEQ + s0) * 1024 + h * 64, s0, CTX_LEN / 64, t0, t1 - t0 + 1, p.a_sink[h] * LOG2E, true, nullptr);
    }
    for (int u = bid; u < 2 * NU_CTX; u += nb) {
        const int ty = u / NU_CTX, w = u % NU_CTX; const int blk = w % (CTX_LEN / 128), h = (w / (CTX_LEN / 128)) % 8, b = w / (8 * (CTX_LEN / 128));
        const int row0 = TX + b * CTX_LEN + blk * 128;
        const bf16_t* Qp = (ty == 0 ? p.QA : p.QB) + (size_t)row0 * 512 + h * 64;
        const bf16_t* Kp = ty == 0 ? p.KA + (size_t)(b * 2 + h / 4) * LKV * 64 : p.KB + (size_t)(b * 8 + h) * LKV * 64;
        const bf16_t* Vp = ty == 0 ? p.VAt + (size_t)(b * 2 + h / 4) * 64 * LKV : p.VBt + (size_t)(b * 8 + h) * 64 * LKV;
        attn_unit<0>(lds, Qp, Kp, Vp, p.Y + (size_t)row0 * 1024 + ty * 512 + h * 64, 0, CTX_LEN / 64, 0, 0, ty == 0 ? p.a_sink[h] * LOG2E : 0.f, ty == 0, nullptr);
    }
}
__device__ __forceinline__ void ph_attnC(const Params& p, char* lds, int bid, int nb) {
    const bool xl = (nb & 7) == 0; const int x = bid & 7, lb = bid >> 3, lstep = nb >> 3;
    constexpr int NQB = SEQ / 128;
    for (int v = xl ? lb : bid; v < (xl ? 4 * NQB : NU_LAT); v += xl ? lstep : nb) {
        int blk, h, b; if (xl) { blk = v % NQB; b = x >> 1; h = (x & 1) * 4 + v / NQB; } else { blk = v % NQB; h = (v / NQB) % 8; b = v / (8 * NQB); }
        const int s0 = blk * 128;
        attn_unit<0>(lds, p.QC + (size_t)(b * SEQ + s0) * 512 + h * 64, p.KC + (size_t)(b * 2 + h / 4) * LKV * 64, p.VCt + (size_t)(b * 2 + h / 4) * 64 * LKV,
                     p.Y + (size_t)(b * SEQ + s0) * 1024 + h * 64, s0, CTX_LEN / 64, 0, SEQ / 64, 0.f, false, nullptr);
    }
}
#ifdef HY_TEST
#define HY_OUT(b, t, v) p.YHT[((size_t)(b) * D_CH + c) * SEQ + (t)] = f2bf(v)
#else
#define HY_OUT(b, t, v) p.YHT[((size_t)(b) * D_CH + c) * SEQ + (t)] = f2bf(v)
#endif
#ifdef CPU_TEST
#define FOR_T for (int tid = 0; tid < 256; ++tid)
#define HSYNC
#define HY_SB()
#define HST(t) st[t]
#define HY_DECL HySt* st = new HySt[256]
#define HY_FREE delete[] st
static inline void sincos_rev(float a, float& c, float& s) { c = cosf(6.283185307179586f * a); s = sinf(6.283185307179586f * a); }
#else
__device__ __forceinline__ int hy_launder(int v) { asm volatile("" : "+v"(v)); return v; }
#define FOR_T if (const int tid = hy_launder((int)threadIdx.x); true)
#define HSYNC __syncthreads()
#define HY_SB() __builtin_amdgcn_sched_barrier(0)
#define HST(t) st
#define HY_DECL HySt st
#define HY_FREE
__device__ __forceinline__ void sincos_rev(float a, float& c, float& s) { c = __builtin_amdgcn_cosf(a); s = __builtin_amdgcn_sinf(a); }
#endif
constexpr int FN = 2 * SEQ;
constexpr int FPAD = FN + (FN >> 5);
#if !defined(SMALL_CFG)
static_assert(FN == 8192, "pass plan 8,8,8,16 is for N = 8192");
constexpr int R4 = 32;
constexpr int NS4 = 256;
#else
constexpr int R4 = 2;
constexpr int NS4 = 512;
#endif
constexpr int NB8 = FN / 8 / 256;
constexpr int NB4 = FN / R4 / 256;
constexpr int EPT = FN / 256;
struct HySt { float xr[EPT], xi[EPT]; unsigned kp[EPT]; };
HD unsigned hy_pack(float r, float i) { return (unsigned)f2bf(r) | ((unsigned)f2bf(i) << 16); }
HD float hy_lo(unsigned v) { unsigned u = v << 16; float f; __builtin_memcpy(&f, &u, 4); return f; }
HD float hy_hi(unsigned v) { unsigned u = v & 0xffff0000u; float f; __builtin_memcpy(&f, &u, 4); return f; }
HD int pidx(int i) { return i + (i >> 5); }

constexpr float W32C[16] = {1.0f, 0.9807852804032304f, 0.9238795325112867f, 0.8314696123025452f, 0.7071067811865476f, 0.5555702330196022f, 0.3826834323650898f, 0.19509032201612825f,
                            0.0f, -0.19509032201612825f, -0.3826834323650898f, -0.5555702330196022f, -0.7071067811865476f, -0.8314696123025452f, -0.9238795325112867f, -0.9807852804032304f};
constexpr float W32S[16] = {0.0f, -0.19509032201612825f, -0.3826834323650898f, -0.5555702330196022f, -0.7071067811865476f, -0.8314696123025452f, -0.9238795325112867f, -0.9807852804032304f,
                            -1.0f, -0.9807852804032304f, -0.9238795325112867f, -0.8314696123025452f, -0.7071067811865476f, -0.5555702330196022f, -0.3826834323650898f, -0.19509032201612825f};
constexpr float W16C[8] = {1.0f, 0.9238795325112867f, 0.7071067811865476f, 0.3826834323650898f, 0.0f, -0.3826834323650898f, -0.7071067811865476f, -0.9238795325112867f};
constexpr float W16S[8] = {0.0f, -0.3826834323650898f, -0.7071067811865476f, -0.9238795325112867f, -1.0f, -0.9238795325112867f, -0.7071067811865476f, -0.3826834323650898f};
template <int R> HD void fft_reg(float* xr, float* xi) {
    constexpr int LG = R == 32 ? 5 : (R == 16 ? 4 : (R == 8 ? 3 : (R == 4 ? 2 : 1)));
#pragma unroll
    for (int sg = 0; sg < LG; ++sg) {
        const int h = (R / 2) >> sg;
#pragma unroll
        for (int pr = 0; pr < R / 2; ++pr) {
            const int blk = (pr / h) * 2 * h, i = pr % h;
            const int a = blk + i, b = blk + i + h;
            const float ar = xr[a], ai = xi[a], br = xr[b], bi = xi[b];
            xr[a] = ar + br; xi[a] = ai + bi;
            const float tr = ar - br, ti = ai - bi;
            const int tw = i * (16 / h);
            if (tw == 0) { xr[b] = tr; xi[b] = ti; }
            else if (tw == 8) { xr[b] = ti; xi[b] = -tr; }
            else { const float c = W32C[tw & 15], s = W32S[tw & 15]; xr[b] = tr * c - ti * s; xi[b] = tr * s + ti * c; }
        }
    }
}
template <int R> HD constexpr int bitrev(int i) { int r = 0; for (int b = 1; b < R; b <<= 1) { r = (r << 1) | (i & 1); i >>= 1; } return r; }

template <int R, int NB, class In> HD void pass_load(int tid, HySt& s, const In& in) {
#pragma unroll
    for (int b = 0; b < NB; ++b)
#pragma unroll
        for (int r = 0; r < R; ++r) in(tid + 256 * b + (FN / R) * r, r, s.xr[b * R + r], s.xi[b * R + r]);
}
template <int R, int NB, class Out> HD void pass_compute(int tid, HySt& s, int Ns, const Out& out) {
#pragma unroll
    for (int b = 0; b < NB; ++b) {
        const int j = tid + 256 * b, k = j & (Ns - 1);
        float* xr = s.xr + b * R; float* xi = s.xi + b * R;
        if (Ns > 1) {
            float wc, ws; sincos_rev(-(float)k / (float)(Ns * R), wc, ws);
            float cr = wc, ci = ws;
#pragma unroll
            for (int r = 1; r < R; ++r) {
                const float vr = xr[r], vi = xi[r]; xr[r] = vr * cr - vi * ci; xi[r] = vr * ci + vi * cr;
                const float nr = cr * wc - ci * ws, ni = cr * ws + ci * wc; cr = nr; ci = ni;
            }
        }
        fft_reg<R>(xr, xi);
        const int j0 = (j - k) * R + k;
#pragma unroll
        for (int i = 0; i < R; ++i) out(j0 + bitrev<R>(i) * Ns, b, bitrev<R>(i), xr[i], xi[i]);
    }
}
template <int R, int NB> HD void pass_load_lds(int tid, HySt& s, const float* re, const float* im) {
    const int base = pidx(tid);
#pragma unroll
    for (int b = 0; b < NB; ++b)
#pragma unroll
        for (int r = 0; r < R; ++r) { const int C = 256 * b + (FN / R) * r; s.xr[b * R + r] = re[base + C + (C >> 5)]; s.xi[b * R + r] = im[base + C + (C >> 5)]; }
}
template <int R, int NB, int NS> HD void pass_compute_lds(int tid, HySt& s, float* re, float* im) {
    static_assert((NS % 32 == 0) || (R == 8 && (NS == 1 || NS == 8)) || (R == 16 && (NS == 1 || NS == 16)), "no-carry condition of the padded index");
#pragma unroll
    for (int b = 0; b < NB; ++b) {
        const int j = tid + 256 * b, k = j & (NS - 1);
        float* xr = s.xr + b * R; float* xi = s.xi + b * R;
        if (NS > 1) {
            float wc, ws; sincos_rev(-(float)k / (float)(NS * R), wc, ws);
            float cr = wc, ci = ws;
#pragma unroll
            for (int r = 1; r < R; ++r) {
                const float vr = xr[r], vi = xi[r]; xr[r] = vr * cr - vi * ci; xi[r] = vr * ci + vi * cr;
                const float nr = cr * wc - ci * ws, ni = cr * ws + ci * wc; cr = nr; ci = ni;
            }
        }
        fft_reg<R>(xr, xi);
        const int pj0 = pidx((j - k) * R + k);
#pragma unroll
        for (int i = 0; i < R; ++i) { const int C = bitrev<R>(i) * NS; re[pj0 + C + (C >> 5)] = xr[i]; im[pj0 + C + (C >> 5)] = xi[i]; }
        HY_SB();
    }
}
struct LdsIn { const float* re; const float* im; HD void operator()(int idx, int, float& r, float& i) const { r = re[pidx(idx)]; i = im[pidx(idx)]; } };
struct LdsOut { float* re; float* im; HD void operator()(int idx, int, int, float r, float i) const { re[pidx(idx)] = r; im[pidx(idx)] = i; } };

HD void hy_pre_load(const Params& p, int c, int b, int tid, float* lds) {
#pragma unroll
    for (int q = 0; q < 3; ++q) {
        const bf16_t* u = p.UT + ((size_t)b * 3 * D_CH + q * D_CH + c) * SEQ; const int t0 = tid * 16;
        const float w0 = p.hy_short_w[0 * 3 * D_CH + q * D_CH + c], w1 = p.hy_short_w[1 * 3 * D_CH + q * D_CH + c], w2 = p.hy_short_w[2 * 3 * D_CH + q * D_CH + c], sb = p.hy_short_b[q * D_CH + c];
        unsigned w[8];
        { const unsigned* u32p = (const unsigned*)(u + t0);
#pragma unroll
          for (int i = 0; i < 8; ++i) w[i] = u32p[i]; }
        float x[18];
        x[0] = t0 > 0 ? bf2f(u[t0 - 1]) : 0.f; x[17] = t0 + 16 < SEQ ? bf2f(u[t0 + 16]) : 0.f;
#pragma unroll
        for (int i = 0; i < 8; ++i) { x[1 + 2 * i] = bf2f((bf16_t)(w[i] & 0xffffu)); x[2 + 2 * i] = bf2f((bf16_t)(w[i] >> 16)); }
#pragma unroll
        for (int i = 0; i < 16; ++i) lds[q * SEQ + t0 + i] = sb + w0 * x[i] + w1 * x[i + 1] + w2 * x[i + 2];
    }
}
HD void hy_pre_store(const Params& p, int c, int b, int tid, const float* lds) {
#pragma unroll
    for (int q = 0; q < 3; ++q) {
        unsigned* u = (unsigned*)(p.UT + ((size_t)b * 3 * D_CH + q * D_CH + c) * SEQ + tid * 16);
#pragma unroll
        for (int i = 0; i < 8; ++i) u[i] = (unsigned)f2bf(lds[q * SEQ + tid + 256 * (2 * i)]) | ((unsigned)f2bf(lds[q * SEQ + tid + 256 * (2 * i + 1)]) << 16);
    }
}
HD void tm_load_bf16(const bf16_t* row, int tid, unsigned (&w)[8]) { const unsigned* q = (const unsigned*)(row + tid * 16);
#pragma unroll
    for (int i = 0; i < 8; ++i) w[i] = q[i]; }
HD float tm_get(const unsigned (&w)[8], int m) { return bf2f((bf16_t)((m & 1) ? (w[m >> 1] >> 16) : (w[m >> 1] & 0xffffu))); }
HD int tm_ofs(int idx) { return (idx & 255) * 16 + (idx >> 8); }

HD void hyena_channel(const Params& p, int c, float* lds) {
    HY_DECL;
    float* re = lds; float* im = lds + FPAD;
    const LdsIn lin{re, im}; const LdsOut lout{re, im};
    for (int b = 0; b < BATCH; ++b) { FOR_T { hy_pre_load(p, c, b, tid, lds); } HSYNC; FOR_T { hy_pre_store(p, c, b, tid, lds); } HSYNC; }
    float nrm[2];
#pragma unroll
    for (int o = 0; o < 2; ++o) {
        const float* hf = p.HFT + (size_t)((0 * 2 + o) * D_CH + c) * SEQ; const float* hb = p.HFT + (size_t)((1 * 2 + o) * D_CH + c) * SEQ;
        FOR_T { float sacc = 0.f; for (int i = 0; i < SEQ / 256; ++i) sacc += fabsf(hf[tid + 256 * i]) + fabsf(hb[tid + 256 * i]); re[tid] = sacc; }
        HSYNC;
        { float tot = 0.f; for (int i = 0; i < 256; ++i) tot += re[i]; nrm[o] = tot + EPS; }
        HSYNC;
    }
    float sw[3][3], sbv[3];
#pragma unroll
    for (int q = 0; q < 3; ++q) { sbv[q] = p.hy_short_b[q * D_CH + c];
#pragma unroll
        for (int kk = 0; kk < 3; ++kk) sw[q][kk] = p.hy_short_w[kk * 3 * D_CH + q * D_CH + c]; }
#pragma unroll 1
    for (int o = 0; o < 2; ++o) {
        const float* hf = p.HFT + (size_t)((0 * 2 + o) * D_CH + c) * SEQ; const float* hb = p.HFT + (size_t)((1 * 2 + o) * D_CH + c) * SEQ;
        const float inv = 1.0f / (o == 0 ? nrm[0] : nrm[1]); const float hbias = p.hy_bias[o * D_CH + c];
        float swg[3]; swg[0] = o == 0 ? sw[1][0] : sw[2][0]; swg[1] = o == 0 ? sw[1][1] : sw[2][1]; swg[2] = o == 0 ? sw[1][2] : sw[2][2]; const float sbg = o == 0 ? sbv[1] : sbv[2];
        FOR_T { pass_load<16, 2>(tid, HST(tid), [&](int idx, int r8, float& r, float& i) __attribute__((always_inline)) { if (r8 < 8) r = hf[idx] * inv; else { const int q = FN - idx; const float hv = hb[q < SEQ ? q : 0]; r = q < SEQ ? hv * inv : 0.f; } i = 0.f; });
                pass_compute_lds<16, 2, 1>(tid, HST(tid), re, im); }
        HSYNC;
        FOR_T { pass_load_lds<16, 2>(tid, HST(tid), re, im); } HSYNC; FOR_T { pass_compute_lds<16, 2, 16>(tid, HST(tid), re, im); } HSYNC;
        FOR_T { pass_load_lds<R4, NB4>(tid, HST(tid), re, im);
                HySt& s = HST(tid); pass_compute<R4, NB4>(tid, s, NS4, [&](int, int b, int rr, float r, float i) __attribute__((always_inline)) { s.kp[b + NB4 * rr] = hy_pack(r, i); }); }
        HSYNC;
        for (int bp = 0; bp < BATCH / 2; ++bp) {
            const int b0 = 2 * bp, b1 = 2 * bp + 1;
            const bf16_t* u0 = p.UT + ((size_t)b0 * 3 * D_CH + c) * SEQ; const bf16_t* u1 = p.UT + ((size_t)b1 * 3 * D_CH + c) * SEQ;
            const float* z0 = p.Z1 + ((size_t)b0 * D_CH + c) * SEQ; const float* z1 = p.Z1 + ((size_t)b1 * D_CH + c) * SEQ;
            auto zval = [&](int b, int t) __attribute__((always_inline)) { return o == 0 ? bf2f((b == b0 ? u0 : u1)[tm_ofs(t)]) : (b == b0 ? z0 : z1)[tm_ofs(t)]; };
            FOR_T { HySt& s = HST(tid);
                    if (o == 0) { unsigned w0[8], w1[8]; tm_load_bf16(u0, tid, w0); tm_load_bf16(u1, tid, w1);
#pragma unroll
                        for (int q = 0; q < 32; ++q) { const int b = q >> 4, r = q & 15; if (r < 8) { s.xr[q] = tm_get(w0, b + 2 * r); s.xi[q] = tm_get(w1, b + 2 * r); } else { s.xr[q] = 0.f; s.xi[q] = 0.f; } } }
                    else {
#pragma unroll
                        for (int q = 0; q < 32; ++q) { const int b = q >> 4, r = q & 15; if (r < 8) { s.xr[q] = z0[tid * 16 + b + 2 * r]; s.xi[q] = z1[tid * 16 + b + 2 * r]; } else { s.xr[q] = 0.f; s.xi[q] = 0.f; } } }
                    pass_compute_lds<16, 2, 1>(tid, s, re, im); }
            HSYNC;
            FOR_T { pass_load_lds<16, 2>(tid, HST(tid), re, im); } HSYNC; FOR_T { pass_compute_lds<16, 2, 16>(tid, HST(tid), re, im); } HSYNC;
            FOR_T { pass_load_lds<R4, NB4>(tid, HST(tid), re, im); } HSYNC;
            FOR_T { HySt& s = HST(tid); pass_compute<R4, NB4>(tid, s, NS4, [&](int idx, int b, int rr, float r, float i) __attribute__((always_inline)) { const float kr = hy_lo(s.kp[b + NB4 * rr]), ki = hy_hi(s.kp[b + NB4 * rr]);
                        re[pidx(idx)] = r * kr - i * ki; im[pidx(idx)] = -(r * ki + i * kr); }); }
            HSYNC;
            FOR_T { pass_load_lds<16, 2>(tid, HST(tid), re, im); } HSYNC; FOR_T { pass_compute_lds<16, 2, 1>(tid, HST(tid), re, im); } HSYNC;
            FOR_T { pass_load_lds<16, 2>(tid, HST(tid), re, im); } HSYNC; FOR_T { pass_compute_lds<16, 2, 16>(tid, HST(tid), re, im); } HSYNC;
            FOR_T { pass_load_lds<R4, NB4>(tid, HST(tid), re, im); HySt& s = HST(tid); float yr[16], yi[16];
                    pass_compute<R4, NB4>(tid, s, NS4, [&](int, int b, int rr, float r, float i) __attribute__((always_inline)) { if (rr < 16) { yr[b + NB4 * rr] = r * (1.0f / FN); yi[b + NB4 * rr] = -i * (1.0f / FN); } });
#pragma unroll
                    for (int hb2 = 0; hb2 < 2; ++hb2) {
                        const int bb = hb2 == 0 ? b0 : b1; const float* yy = hb2 == 0 ? yr : yi;
                        const bf16_t* gp = p.UT + ((size_t)bb * 3 * D_CH + (o + 1) * D_CH + c) * SEQ;
                        unsigned gw[8]; tm_load_bf16(gp, tid, gw);
                        if (o == 0) { unsigned w[8]; tm_load_bf16(hb2 == 0 ? u0 : u1, tid, w);
                            float* zo = p.Z1 + ((size_t)bb * D_CH + c) * SEQ + tid * 16;
#pragma unroll
                            for (int m = 0; m < 16; ++m) zo[m] = tm_get(gw, m) * (yy[m] + tm_get(w, m) * hbias); }
                        else { const float* zz = hb2 == 0 ? z0 : z1;
#pragma unroll
                            for (int m = 0; m < 16; ++m) { const float zn = tm_get(gw, m) * (yy[m] + zz[tid * 16 + m] * hbias); HY_OUT(bb, tid + 256 * m, zn); } }
                        HY_SB();
                    } }
            HSYNC;
        }
    }
    HY_FREE;
}
constexpr int MOD_ITEMS = DEPTH * (6 * D_MODEL / 64);
__device__ __forceinline__ void mod_item(const Params& p, char* lds, int item) {
    float* sc = (float*)lds;
    float* red = sc + 5 * D_MODEL;
    const int tid = threadIdx.x, l = item / (6 * D_MODEL / 64), j0 = (item % (6 * D_MODEL / 64)) * 64;
    for (int i = tid; i < 5 * D_MODEL; i += NTHREADS) { const int r = i / D_MODEL, k = i % D_MODEL; const float v = r < BATCH ? p.c[r * D_MODEL + k] : p.c_ctx[k]; sc[i] = silu_f(v); }
    __syncthreads();
    const int col = tid & 63, kp = tid >> 6;
    const float* w = p.w_ada + ((size_t)l * D_MODEL + kp * 256) * 6 * D_MODEL + j0 + col;
    float a0 = 0.f, a1 = 0.f, a2 = 0.f, a3 = 0.f, a4 = 0.f;
#pragma unroll 8
    for (int k = 0; k < 256; ++k) { const float wv = w[(size_t)k * 6 * D_MODEL]; const int kk = kp * 256 + k;
        a0 += sc[kk] * wv; a1 += sc[D_MODEL + kk] * wv; a2 += sc[2 * D_MODEL + kk] * wv; a3 += sc[3 * D_MODEL + kk] * wv; a4 += sc[4 * D_MODEL + kk] * wv; }
    red[(kp * 5 + 0) * 64 + col] = a0; red[(kp * 5 + 1) * 64 + col] = a1; red[(kp * 5 + 2) * 64 + col] = a2; red[(kp * 5 + 3) * 64 + col] = a3; red[(kp * 5 + 4) * 64 + col] = a4;
    __syncthreads();
    for (int i = tid; i < 5 * 64; i += NTHREADS) { const int r = i / 64, cc = i % 64;
        const float v = red[(0 * 5 + r) * 64 + cc] + red[(1 * 5 + r) * 64 + cc] + red[(2 * 5 + r) * 64 + cc] + red[(3 * 5 + r) * 64 + cc];
        p.mod[((size_t)(l * (BATCH + 1) + r)) * 6 * D_MODEL + j0 + cc] = v + p.b_ada[l * 6 * D_MODEL + j0 + cc]; }
    __syncthreads();
}
constexpr int FILT_ITEMS = (SEQ / 256) * (4 * D_CH / 64);
__device__ __forceinline__ void filt_item(const Params& p, char* lds, int item) {
    float* ws = (float*)lds;
    const int tid = threadIdx.x, tb = item % (SEQ / 256), cb = item / (SEQ / 256); const int t = tb * 256 + tid, col0 = cb * 64;
#pragma unroll
    for (int i = 0; i < 16; ++i) { const int k = i * 4 + (tid >> 6), cc = tid & 63; ws[cc * 68 + k] = p.hy_w3[(size_t)k * 4 * D_CH + col0 + cc]; }
    f32x4 h[16];
#pragma unroll
    for (int i = 0; i < 16; ++i) h[i] = *(const f32x4*)(p.h2 + (size_t)t * HY_FFN + i * 4);
    __syncthreads();
    const float tn = (float)t / (float)(SEQ - 1);
    const float mind = logf(1e-2f) / 1.5f, maxd = logf(1e-2f) / 0.3f;
#pragma unroll 2
    for (int cc = 0; cc < 64; ++cc) {
        const int col = col0 + cc; const f32x4* w = (const f32x4*)(ws + cc * 68);
        float acc = p.hy_b3[col];
#pragma unroll
        for (int i = 0; i < 16; ++i) { const f32x4 wv = w[i]; acc += h[i][0] * wv[0] + h[i][1] * wv[1] + h[i][2] * wv[2] + h[i][3] * wv[3]; }
        const float delta = fabsf(mind + (float)(col % D_CH) * (maxd - mind) / (float)(D_CH - 1));
        p.HFT[(size_t)col * SEQ + t] = acc * expf(-tn * delta);
    }
    __syncthreads();
}
__device__ __forceinline__ void ph_norm(const Params& p, int l, int which, int nrows, int bid, int nb) {
    const int lane = threadIdx.x & 63, wid = threadIdx.x >> 6;
    const float* g = p.norm_g + (l * 2 + which) * D_MODEL;
    for (int row = (bid * 4 + wid) * 2; row < nrows; row += nb * 8) {
        const int row1 = row + 1 < nrows ? row + 1 : row;
        const float* xa = which == 0 ? xrow_in(p, l, row) : xrow_cur(p, row); const float* xb = which == 0 ? xrow_in(p, l, row1) : xrow_cur(p, row1);
        f32x4 va[4], vb[4]; float sa = 0.f, sb = 0.f;
#pragma unroll
        for (int j = 0; j < 4; ++j) { va[j] = *(const f32x4*)(xa + j * 256 + lane * 4); vb[j] = *(const f32x4*)(xb + j * 256 + lane * 4); }
#pragma unroll
        for (int j = 0; j < 4; ++j) { sa += va[j][0] * va[j][0] + va[j][1] * va[j][1] + va[j][2] * va[j][2] + va[j][3] * va[j][3]; sb += vb[j][0] * vb[j][0] + vb[j][1] * vb[j][1] + vb[j][2] * vb[j][2] + vb[j][3] * vb[j][3]; }
        const float ra = 1.0f / sqrtf(wave_sum(sa) * (1.0f / D_MODEL) + EPS), rb = 1.0f / sqrtf(wave_sum(sb) * (1.0f / D_MODEL) + EPS);
        const float* sha = modp(p, l, row, which * 3 + 0); const float* sca = modp(p, l, row, which * 3 + 1);
        const float* shb = modp(p, l, row1, which * 3 + 0); const float* scb = modp(p, l, row1, which * 3 + 1);
#pragma unroll
        for (int j = 0; j < 4; ++j) { const int c = j * 256 + lane * 4; const f32x4 gv = *(const f32x4*)(g + c);
            store4bf(p.hbuf + (size_t)row * D_MODEL + c, va[j] * ra * gv * (*(const f32x4*)(sca + c) + 1.0f) + *(const f32x4*)(sha + c));
            if (row1 != row) store4bf(p.hbuf + (size_t)row1 * D_MODEL + c, vb[j] * rb * gv * (*(const f32x4*)(scb + c) + 1.0f) + *(const f32x4*)(shb + c)); }
    }
}
__device__ __forceinline__ void ph_route_a(const Params& p, char* lds, int l, int nrows, int bid, int nb) {
    const int lane = threadIdx.x & 63, wid = threadIdx.x >> 6, l5 = lane & 31, hf = lane >> 5;
    float* wr_s = (float*)lds; int* hist = (int*)(lds + 65536);
    for (int i = threadIdx.x; i < D_MODEL * 4; i += NTHREADS) { const int k = i >> 2, ch = i & 3, pos = (k & 3) * 256 + (k >> 2); ((f32x4*)wr_s)[pos * 4 + (ch ^ ((pos >> 2) & 3))] = ((const f32x4*)p.w_router)[i]; }
    if (threadIdx.x < 32) hist[threadIdx.x] = 0;
    __syncthreads();
    const int sw = (l5 >> 2) & 3;
    const float* g = p.norm_g + (l * 2 + 1) * D_MODEL;
    const int RPB = (nrows + nb - 1) / nb, r0 = bid * RPB;
    for (int jb = wid * 2; jb < RPB; jb += 8) {
        if (r0 + jb >= nrows) break;
        const int jr = jb + hf, row = r0 + jr; const bool act = jr < RPB && row < nrows; const int rowc = act ? row : row - 1;
        const float* sh = modp(p, l, rowc, 3); const float* sc = modp(p, l, rowc, 4);
        f32x4 v[8];
        { const float* xr = xrow_cur(p, rowc);
#pragma unroll
          for (int j = 0; j < 8; ++j) v[j] = *(const f32x4*)(xr + j * 128 + l5 * 4); }
        float ss = 0.f;
#pragma unroll
        for (int j = 0; j < 8; ++j) ss += v[j][0] * v[j][0] + v[j][1] * v[j][1] + v[j][2] * v[j][2] + v[j][3] * v[j][3];
#pragma unroll
        for (int o2 = 1; o2 < 32; o2 <<= 1) ss += __shfl_xor(ss, o2);
        const float rstd = 1.0f / sqrtf(ss * (1.0f / D_MODEL) + EPS);
        float lg[16];
#pragma unroll
        for (int e = 0; e < 16; ++e) lg[e] = 0.f;
        int wofs = 0; asm volatile("" : "+v"(wofs)); const float* wr_i = wr_s + wofs;
#pragma unroll
        for (int j = 0; j < 8; ++j) { const int c = j * 128 + l5 * 4;
            const f32x4 o = v[j] * rstd * *(const f32x4*)(g + c) * (*(const f32x4*)(sc + c) + 1.0f) + *(const f32x4*)(sh + c);
            store4bf(p.hbuf + (size_t)rowc * D_MODEL + c, o);
#pragma unroll
            for (int r = 0; r < 4; ++r) { const f32x4* w4 = (const f32x4*)(wr_i + (r * 256 + l5 + 32 * j) * 16);
#pragma unroll
                for (int e4 = 0; e4 < 4; ++e4) { const f32x4 wv = w4[e4 ^ sw]; lg[e4 * 4 + 0] += o[r] * wv[0]; lg[e4 * 4 + 1] += o[r] * wv[1]; lg[e4 * 4 + 2] += o[r] * wv[2]; lg[e4 * 4 + 3] += o[r] * wv[3]; }
                if (r & 1) __builtin_amdgcn_sched_barrier(0); } }
        {
#pragma unroll
            for (int i = 0; i < 8; ++i) { const float a = lg[i], b = lg[i + 8]; const bool up = (lane & 16) != 0; const float recv = __shfl_xor(up ? a : b, 16); lg[i] = (up ? b : a) + recv; }
#pragma unroll
            for (int i = 0; i < 4; ++i) { const float a = lg[i], b = lg[i + 4]; const bool up = (lane & 8) != 0; const float recv = __shfl_xor(up ? a : b, 8); lg[i] = (up ? b : a) + recv; }
#pragma unroll
            for (int i = 0; i < 2; ++i) { const float a = lg[i], b = lg[i + 2]; const bool up = (lane & 4) != 0; const float recv = __shfl_xor(up ? a : b, 4); lg[i] = (up ? b : a) + recv; }
            { const float a = lg[0], b = lg[1]; const bool up = (lane & 2) != 0; const float recv = __shfl_xor(up ? a : b, 2); lg[0] = (up ? b : a) + recv; }
            lg[0] += __shfl_xor(lg[0], 1);
            const float mine = lg[0];
#pragma unroll
            for (int e = 0; e < 16; ++e) lg[e] = __shfl(mine, (lane & 32) + 2 * e);
        }
        if (l5 == 0 && act) {
            int gbest = 0, a = 0, bb = 1; float gbs = -1e30f, wa = 0.f, wb = 0.f;
#pragma unroll
            for (int gI = 0; gI < 4; ++gI) {
                float m1 = -1e30f, m2 = -1e30f, s1 = 0.f, s2 = 0.f; int i1 = 0, i2 = 0;
#pragma unroll
                for (int jj = 0; jj < 4; ++jj) { float sgv = sigmoid_f(lg[gI * 4 + jj]); float vv = sgv + p.b_router[gI * 4 + jj];
                    if (vv > m1) { m2 = m1; i2 = i1; s2 = s1; m1 = vv; i1 = jj; s1 = sgv; } else if (vv > m2) { m2 = vv; i2 = jj; s2 = sgv; } }
                float gs = m1 + m2;
                if (gs > gbs) { gbs = gs; gbest = gI; if (i1 < i2) { a = i1; bb = i2; wa = s1; wb = s2; } else { a = i2; bb = i1; wa = s2; wb = s1; } }
            }
            const float inv = 1.0f / (wa + wb);
            const int pidx = a == 0 ? bb - 1 : (a == 1 ? bb + 1 : 5);
            const int pr = gbest * 6 + pidx;
            p.rpair[row] = pr; p.tokw[row * 2 + 0] = wa * inv; p.tokw[row * 2 + 1] = wb * inv;
            atomicAdd(&hist[pr], 1);
        }
    }
    __syncthreads();
    if (threadIdx.x < 32) p.bh[bid * 32 + threadIdx.x] = hist[threadIdx.x];
}
__device__ __forceinline__ void ph_route_b(const Params& p, char* lds, int l, int nrows, int bid, int nb) {
    int* sb = (int*)lds;
    const int t = threadIdx.x;
    { int cb[32], ca[32];
#pragma unroll
      for (int q = 0; q < 32; ++q) { cb[q] = 0; ca[q] = 0; }
      for (int b = t; b < nb; b += NTHREADS) { const u32x4* src = (const u32x4*)(p.bh + b * 32); const bool before = b < bid;
#pragma unroll
          for (int q4 = 0; q4 < 6; ++q4) { const u32x4 v4 = src[q4];
#pragma unroll
              for (int e = 0; e < 4; ++e) { ca[q4 * 4 + e] += (int)v4[e]; cb[q4 * 4 + e] += before ? (int)v4[e] : 0; } } }
#pragma unroll
      for (int q = 0; q < 24; ++q) { sb[t * 33 + q] = cb[q]; sb[8448 + t * 33 + q] = ca[q]; } }
    __syncthreads();
    if (t < 64) { const int q = t & 31, which = t >> 5; int a = 0; const int* col = sb + which * 8448 + q;
        if (q < 24) { for (int r = 0; r < 256; ++r) a += col[r * 33]; }
        sb[16896 + which * 32 + q] = a; if (which == 1 && bid == 0) p.cnt[l * 32 + q] = a; }
    const int RPB = (nrows + nb - 1) / nb, row = bid * RPB + t; const bool act = t < RPB && row < nrows;
    int myp = 0; if (act) { myp = p.rpair[row]; sb[16896 + 64 + t] = myp; }
    __syncthreads();
    if (act) { int rank = 0; for (int j = 0; j < t; ++j) rank += (sb[16896 + 64 + j] == myp) ? 1 : 0; p.list[(size_t)myp * TT + sb[16896 + myp] + rank] = row; }
    __syncthreads();
}
__device__ __forceinline__ void ph_final(const Params& p, int bid, int nb) {
    const int lane = threadIdx.x & 63, wid = threadIdx.x >> 6;
    for (int row = (bid * 4 + wid) * 2; row < TX; row += nb * 8) {
        float* xa = p.out + (size_t)row * D_MODEL; float* xb = xa + D_MODEL;
        f32x4 va[4], vb[4]; float sa = 0.f, sb = 0.f;
#pragma unroll
        for (int j = 0; j < 4; ++j) { va[j] = *(const f32x4*)(xa + j * 256 + lane * 4); vb[j] = *(const f32x4*)(xb + j * 256 + lane * 4); }
#pragma unroll
        for (int j = 0; j < 4; ++j) { sa += va[j][0] * va[j][0] + va[j][1] * va[j][1] + va[j][2] * va[j][2] + va[j][3] * va[j][3]; sb += vb[j][0] * vb[j][0] + vb[j][1] * vb[j][1] + vb[j][2] * vb[j][2] + vb[j][3] * vb[j][3]; }
        const float ra = 1.0f / sqrtf(wave_sum(sa) * (1.0f / D_MODEL) + EPS), rb = 1.0f / sqrtf(wave_sum(sb) * (1.0f / D_MODEL) + EPS);
#pragma unroll
        for (int j = 0; j < 4; ++j) { const int c = j * 256 + lane * 4; const f32x4 gv = *(const f32x4*)(p.final_g + c); *(f32x4*)(xa + c) = va[j] * ra * gv; *(f32x4*)(xb + c) = vb[j] * rb * gv; }
    }
}

#define XB_TMO      128
#define XB_XCNT(j)  (256  + 64 * (j))
#define XB_XSUB(j)  (1280 + 64 * (j))
#define XB_XGEN(j)  (2304 + 64 * (j))
#define XB_TOP      3328
#define XB_TOPGEN   3392
#define XCD_BAR_WORDS 3456
#define XB_SPIN_CAP (1u << 20)
__device__ __forceinline__ unsigned xb_ld(unsigned* p)              { return __hip_atomic_load(p, __ATOMIC_RELAXED, __HIP_MEMORY_SCOPE_AGENT); }
__device__ __forceinline__ unsigned xb_add(unsigned* p, unsigned v) { return __hip_atomic_fetch_add(p, v, __ATOMIC_RELAXED, __HIP_MEMORY_SCOPE_AGENT); }
__device__ __forceinline__ unsigned xb_xcc_id() { return (unsigned)__builtin_amdgcn_s_getreg((3 << 11) | 20) & 0xFu; }
#define XB_SPIN(cond, bar) do { unsigned _sp = 0; while (cond) { __builtin_amdgcn_s_sleep(1); \
    if ((++_sp & 255u) == 0u) { if (xb_ld(&(bar)[XB_TMO])) break; if (_sp > XB_SPIN_CAP) { atomicAdd(&(bar)[XB_TMO], 1u); break; } } } } while (0)
struct XcdBarrier { unsigned* bar; unsigned x; volatile LAS unsigned* st; };
__device__ __forceinline__ XcdBarrier xcd_barrier_post(unsigned* bar, volatile LAS unsigned* st) {
    XcdBarrier b; b.bar = bar; b.x = xb_xcc_id(); b.st = st;
    if (threadIdx.x == 0) (void)xb_add(&bar[XB_XCNT(b.x)], 1u);
    return b;
}
__device__ __forceinline__ void xcd_barrier_complete(unsigned* bar, unsigned x, unsigned& nloc, unsigned& nx) {
    const unsigned G = gridDim.x * gridDim.y * gridDim.z;
    unsigned sum, cnt, mine, sp = 0u;
    for (;;) {
        sum = 0u; cnt = 0u; mine = 0u;
#pragma unroll
        for (unsigned j = 0; j < 16; ++j) { const unsigned c = xb_ld(&bar[XB_XCNT(j)]); sum += c; cnt += (c > 0u) ? 1u : 0u; mine = (j == x) ? c : mine; }
        if (sum == G) break;
        __builtin_amdgcn_s_sleep(1);
        if ((++sp & 255u) == 0u) { if (xb_ld(&bar[XB_TMO])) break; if (sp > XB_SPIN_CAP) { atomicAdd(&bar[XB_TMO], 1u); break; } }
    }
    nloc = mine > 0u ? mine : 1u; nx = cnt > 0u ? cnt : 1u;
}
__device__ __forceinline__ void xcd_barrier(const XcdBarrier& b) {
    asm volatile("s_waitcnt vmcnt(0)" ::: "memory");
    __syncthreads();
    if (threadIdx.x == 0) {
        unsigned* bar = b.bar;
        __builtin_amdgcn_s_waitcnt(0);
        unsigned nloc = b.st[0], nx = b.st[1];
        if (nloc == 0u) { xcd_barrier_complete(bar, b.x, nloc, nx); b.st[0] = nloc; b.st[1] = nx; }
        const unsigned old = xb_add(&bar[XB_XSUB(b.x)], 1u);
        const unsigned gen = old / nloc;
        if (old + 1u == (gen + 1u) * nloc) {
            __builtin_amdgcn_fence(__ATOMIC_RELEASE, "agent");
            asm volatile("s_waitcnt vmcnt(0)" ::: "memory");
            const unsigned og = xb_add(&bar[XB_TOP], 1u);
            const unsigned tg = og / nx;
            if (og + 1u == (tg + 1u) * nx) xb_add(&bar[XB_TOPGEN], 1u);
            else XB_SPIN(xb_ld(&bar[XB_TOPGEN]) == tg, bar);
            __builtin_amdgcn_fence(__ATOMIC_ACQUIRE, "agent");
            xb_add(&bar[XB_XGEN(b.x)], 1u);
            asm volatile("s_waitcnt vmcnt(0)" ::: "memory");
        } else {
            XB_SPIN(xb_ld(&bar[XB_XGEN(b.x)]) == gen, bar);
            __builtin_amdgcn_fence(__ATOMIC_ACQUIRE, "agent");
            asm volatile("s_waitcnt vmcnt(0)" ::: "memory");
        }
    }
    __syncthreads();
}

__device__ __forceinline__ void ph_mix1(const Params& p, char* lds, int bid, int nb, unsigned long long* tsplit = nullptr) {
    const bool hy_first = bid >= (nb >> 1);
    for (int rep = 0; rep < 3; ++rep) {
        if (rep == 1) {
            for (int u = bid; u < NU_LAT; u += nb) { const int blk = u % (SEQ / 128), h = (u / (SEQ / 128)) % 8, b = u / (8 * (SEQ / 128)); const int s0 = blk * 128;
                attn_unit<0>(lds, p.QC + (size_t)(b * SEQ + s0) * 512 + h * 64, p.KC + (size_t)(b * 2 + h / 4) * LKV * 64, p.VCt + (size_t)(b * 2 + h / 4) * 64 * LKV,
                             p.Y + (size_t)(b * SEQ + s0) * 1024 + h * 64, s0, CTX_LEN / 64, 0, SEQ / 64, 0.f, false, nullptr); }
            if (tsplit) *tsplit = __builtin_amdgcn_s_memrealtime();
        } else if ((rep == 0) == hy_first) {
            __syncthreads();
            for (int c = hy_first ? bid - (nb >> 1) : bid + (nb >> 1); c < D_CH; c += nb) hyena_channel(p, c, (float*)lds);
            __syncthreads();
        }
    }
}
constexpr int TR_ITEMS = BATCH * (D_CH / 64) * (SEQ / 64);
__device__ __forceinline__ void tr_item(const Params& p, char* lds, int it) {
    bf16_t* T = (bf16_t*)lds; const int tid = threadIdx.x;
    const int sb = it % (SEQ / 64), cb = (it / (SEQ / 64)) % (D_CH / 64), b = it / ((SEQ / 64) * (D_CH / 64));
    { const int c = tid >> 2, q = tid & 3;
      const u32x4* src = (const u32x4*)(p.YHT + ((size_t)b * D_CH + cb * 64 + c) * SEQ + sb * 64 + q * 16);
      const u32x4 v0 = src[0], v1 = src[1]; unsigned* d = (unsigned*)(T + c * 66 + q * 16);
      d[0] = v0.x; d[1] = v0.y; d[2] = v0.z; d[3] = v0.w; d[4] = v1.x; d[5] = v1.y; d[6] = v1.z; d[7] = v1.w; }
    __syncthreads();
    { const int s = tid >> 2, q = tid & 3;
      unsigned w[8];
#pragma unroll
      for (int i = 0; i < 8; ++i) w[i] = (unsigned)T[(q * 16 + 2 * i) * 66 + s] | ((unsigned)T[(q * 16 + 2 * i + 1) * 66 + s] << 16);
      u32x4* dst = (u32x4*)(p.Y + ((size_t)b * SEQ + sb * 64 + s) * 1024 + 512 + cb * 64 + q * 16);
      dst[0] = (u32x4){w[0], w[1], w[2], w[3]}; dst[1] = (u32x4){w[4], w[5], w[6], w[7]}; }
    __syncthreads();
}
enum { PH_PREP = 0, PH_NORM0, PH_INPROJ0, PH_ATTN0, PH_OUT0, PH_ROUTE0, PH_ROUTEB0, PH_UP0, PH_DOWN0, PH_NORM1, PH_INPROJ1, PH_MIX1, PH_HY1, PH_TR1, PH_OUT1, PH_ROUTE1, PH_ROUTEB1, PH_UP1, PH_DOWN1, PH_FINAL, PH_COUNT };
typedef const __attribute__((address_space(4))) Params* KParams;
__global__ void __launch_bounds__(NTHREADS, 2) mega(Params p_arg, int lo, int hi) {
    extern __shared__ __attribute__((aligned(16))) char lds[];
    const int bid = blockIdx.x, nb = gridDim.x;
    volatile LAS unsigned* st = (volatile LAS unsigned*)(lds + LDS_BYTES - 16);
    if (threadIdx.x < 4) st[threadIdx.x] = 0u;
    __syncthreads();
    KParams kp = (KParams)__builtin_amdgcn_kernarg_segment_ptr();
    XcdBarrier bar; bar.bar = kp->bar; bar.x = 0; bar.st = st;
    if (hi - lo > 1) bar = xcd_barrier_post(kp->bar, st);
#ifdef PROBE_PA
    unsigned long long ts_prev = __builtin_amdgcn_s_memrealtime(), t_a = 0, t_b = 0;
#define STAMP(PH) if (bid == 0 && threadIdx.x == 0) { const unsigned long long now_ = __builtin_amdgcn_s_memrealtime(); if ((PH) == PROBE_PA) t_a = now_ - ts_prev; if ((PH) == PROBE_PB) t_b = now_ - ts_prev; ts_prev = now_; }
#else
#define STAMP(PH)
#endif
#define PHASE(PH, ...) if (lo <= (PH) && (PH) < hi) { { KParams kq_ = kp; asm volatile("" : "+s"(kq_)); const Params& p = *(const Params*)kq_; __VA_ARGS__; } if ((PH) + 1 < hi) xcd_barrier(bar); STAMP(PH) }
    PHASE(PH_PREP, { if (nb > MOD_ITEMS + 64) { if (bid < MOD_ITEMS) mod_item(p, lds, bid); else cvt_range(p, lds, 0, CVT_EARLY, bid - MOD_ITEMS, nb - MOD_ITEMS); }
        else { for (int it = bid; it < MOD_ITEMS; it += nb) mod_item(p, lds, it); cvt_range(p, lds, 0, CVT_EARLY, bid, nb); }
        d_rope(p); d_hy_h1(p); })
    PHASE(PH_NORM0, { ph_norm(p, 0, 0, TT, bid, nb); d_hy_h2(p); })
    PHASE(PH_INPROJ0, ph_inproj<0>(p, lds, bid, nb))
    PHASE(PH_ATTN0, { const bool xl_ = (nb & 7) == 0;
        if (bid >= (nb >> 1)) { cvt_range(p, lds, CVT_EARLY, CVT_TOTAL, bid, nb); __syncthreads(); ph_attn0(p, lds, xl_, bid & 7, xl_ ? bid >> 3 : bid, xl_ ? nb >> 3 : nb); }
        else { ph_attn0(p, lds, xl_, bid & 7, xl_ ? bid >> 3 : bid, xl_ ? nb >> 3 : nb); __syncthreads(); cvt_range(p, lds, CVT_EARLY, CVT_TOTAL, bid, nb); } })
    PHASE(PH_OUT0, { ph_outproj<0>(p, lds, bid, nb);
        __syncthreads(); { const int full_ = (nb & 7) == 0 ? ((MT_ALL / 8) * 8) % (nb >> 3) : 0;
          const int lb_ = bid >> 3; if ((nb & 7) != 0) { for (int it = bid; it < FILT_ITEMS; it += nb) filt_item(p, lds, it); }
          else if (lb_ >= full_) { for (int it = (lb_ - full_) * 8 + (bid & 7); it < FILT_ITEMS; it += nb - full_ * 8) filt_item(p, lds, it); } } })
    PHASE(PH_ROUTE0, ph_route_a(p, lds, 0, TT, bid, nb))
    PHASE(PH_ROUTEB0, ph_route_b(p, lds, 0, TT, bid, nb))
    PHASE(PH_UP0, ph_moe_up(p, lds, 0, bid, nb))
    PHASE(PH_DOWN0, ph_moe_down(p, lds, 0, bid, nb))
    PHASE(PH_NORM1, ph_norm(p, 1, 0, TT, bid, nb))
    PHASE(PH_INPROJ1, ph_inproj<1>(p, lds, bid, nb))
    PHASE(PH_MIX1, ph_attnC(p, lds, bid, nb))
    PHASE(PH_HY1, for (int c = bid; c < D_CH; c += nb) hyena_channel(p, c, (float*)lds))
    PHASE(PH_TR1, for (int it = bid; it < TR_ITEMS; it += nb) tr_item(p, lds, it))
    PHASE(PH_OUT1, ph_outproj<1>(p, lds, bid, nb))
    PHASE(PH_ROUTE1, ph_route_a(p, lds, 1, TX, bid, nb))
    PHASE(PH_ROUTEB1, ph_route_b(p, lds, 1, TX, bid, nb))
    PHASE(PH_UP1, ph_moe_up(p, lds, 1, bid, nb))
    PHASE(PH_DOWN1, ph_moe_down(p, lds, 1, bid, nb))
    PHASE(PH_FINAL, ph_final(p, bid, nb))
#ifdef PROBE_PA
    if (bid == 0 && threadIdx.x == 0) {
        const unsigned long long delay = 2 * t_a + 204800ull * ((t_b + 200) / 400); const unsigned long long t0 = __builtin_amdgcn_s_memrealtime();
        while (__builtin_amdgcn_s_memrealtime() - t0 < delay) __builtin_amdgcn_s_sleep(32);
    }
#endif
}
extern "C" void kernel_launch(void* const* d_in, const int* in_sizes, int n_in, void* d_out, int out_size, void* d_ws, size_t ws_size, hipStream_t stream) {
    static int grid = 0;
    if (grid == 0) {
        int dev = 0, cus = 0;
        if (hipGetDevice(&dev) != hipSuccess || hipDeviceGetAttribute(&cus, hipDeviceAttributeMultiprocessorCount, dev) != hipSuccess) { fprintf(stderr, "kernel_launch: device query failed\n"); grid = -1; return; }
        if (hipFuncSetAttribute((const void*)mega, hipFuncAttributeMaxDynamicSharedMemorySize, LDS_BYTES) != hipSuccess) { fprintf(stderr, "kernel_launch: hipFuncSetAttribute failed\n"); grid = -1; return; }
        grid = 2 * cus;
    }
    if (grid < 0) return;
    Params p{};
    size_t need = setup_ws(p, (char*)d_ws);
    if (n_in != 32 || need > ws_size || out_size != TX * D_MODEL) { fprintf(stderr, "kernel_launch: bad config n_in %d ws %zu need %zu out %d\n", n_in, ws_size, need, out_size); return; }
    fill_inputs(p, d_in, d_out);
    hipMemsetAsync(p.bar, 0, 64 * 1024 + 256, stream);
    mega<<<dim3(grid), dim3(NTHREADS), LDS_BYTES, stream>>>(p, 0, PH_COUNT);
}
```

```cpp
#include <hip/hip_runtime.h>
#include <cstdio>
#include <math.h>
#include <stdint.h>
#include <string.h>

#ifdef CPU_TEST
#define HD
#define GLOBAL
struct U3 { unsigned x, y, z; };
static thread_local U3 threadIdx, blockIdx, blockDim, gridDim;
static inline int atomicAdd(int* p, int v) { return __sync_fetch_and_add(p, v); }
#else
#define HD __device__ __forceinline__
#define GLOBAL __global__ __launch_bounds__(256)
#endif

#if defined(HY_TEST)
constexpr int D_MODEL = 64, BATCH = 2, SEQ = 4096, GRID_W = 64, CTX_LEN = 64, D_CH = 4, D_EXPERT = 64;
#elif defined(SMALL_CFG)
constexpr int D_MODEL = 128, BATCH = 2, SEQ = 512, GRID_W = 32, CTX_LEN = 64, D_CH = 32, D_EXPERT = 64;
#else
constexpr int D_MODEL = 1024, BATCH = 4, SEQ = 4096, GRID_W = 64, CTX_LEN = 256, D_CH = 512, D_EXPERT = 512;
#endif
constexpr int DEPTH = 2, HEAD_DIM = 64;
constexpr int GRID_H = SEQ / GRID_W;
constexpr int A_WINDOW = 128;
constexpr int B_WIN_H = 8, B_WIN_W = 16;
constexpr int HY_BANDS = 16, HY_EMB = 33, HY_FFN = 64;
constexpr int EVEN_IN = 2304, EVEN_OUT = 1024;
constexpr int ODD_IN = 768 + 3 * D_CH, ODD_OUT = 512 + D_CH;
constexpr int N_EXPERTS = 16;
constexpr int TX = BATCH * SEQ, TC = BATCH * CTX_LEN, TT = TX + TC;
constexpr int LKV = CTX_LEN + SEQ;
constexpr int NPAIR = 24;
constexpr int HE_W = 2 * D_EXPERT;
constexpr float EPS = 1e-6f;
constexpr float ATTN_SCALE = 0.125f;

typedef unsigned short bf16_t;
HD bf16_t f2bf(float f) { unsigned u; __builtin_memcpy(&u, &f, 4); u = (u + 0x7fffu + ((u >> 16) & 1u)) >> 16; return (bf16_t)u; }
HD float bf2f(bf16_t h) { unsigned u = ((unsigned)h) << 16; float f; __builtin_memcpy(&f, &u, 4); return f; }
HD float silu_f(float x) { return x / (1.0f + expf(-x)); }
HD float sigmoid_f(float x) { return 1.0f / (1.0f + expf(-x)); }

struct Params {
    const float *x, *c, *ctx, *c_ctx, *w_ada, *b_ada, *norm_g, *final_g, *w_in_even, *w_out_even, *a_sink, *b_rpb;
    const float *w_in_odd, *w_out_odd, *c_qnorm, *c_knorm, *hy_short_w, *hy_short_b, *hy_w1, *hy_b1, *hy_f1, *hy_w2;
    const float *hy_b2, *hy_f2, *hy_w3, *hy_b3, *hy_bias, *w_router, *b_router, *moe_wg, *moe_wu, *moe_wd;
    float* out;
    float* XC;
    float* mod;
    float* ropet;
    float* h1;
    float* h2;
    float* HFT;
    float* hnorm;
    bf16_t* hbuf;
    bf16_t *QA, *KA, *VAt, *QB, *KB, *VBt;
    bf16_t *QC, *KC, *VCt, *UT;
    bf16_t* Y;
    bf16_t* YHT;
    float* Z1;
    bf16_t* HE;
    int* cnt;
    int* list;
    float* tokw;
    bf16_t *Wt_in_even, *Wt_out_even, *Wt_in_odd, *Wt_out_odd, *Wt_gu, *Wt_d;
    unsigned* bar;
    int* rpair;
    int* bh;
    float* rlog;
};

#define GS_LOOP(i, n) for (long i = (long)blockIdx.x * blockDim.x + threadIdx.x; i < (long)(n); i += (long)gridDim.x * blockDim.x)

HD const float* xrow_in(const Params& p, int l, int row) {
    if (l == 0) return row < TX ? p.x + (size_t)row * D_MODEL : p.ctx + (size_t)(row - TX) * D_MODEL;
    return row < TX ? p.out + (size_t)row * D_MODEL : p.XC + (size_t)(row - TX) * D_MODEL;
}
HD float* xrow_cur(const Params& p, int row) { return row < TX ? p.out + (size_t)row * D_MODEL : p.XC + (size_t)(row - TX) * D_MODEL; }
HD int row_mod(int row) { return row < TX ? row / SEQ : BATCH; }
HD const float* modp(const Params& p, int l, int row, int which) { return p.mod + ((size_t)(l * (BATCH + 1) + row_mod(row)) * 6 + which) * D_MODEL; }

GLOBAL void nk_mod(Params p) {
    GS_LOOP(i, DEPTH * (BATCH + 1) * 6 * D_MODEL) {
        int j = i % (6 * D_MODEL); int r = (i / (6 * D_MODEL)) % (BATCH + 1); int l = i / (6 * D_MODEL * (BATCH + 1));
        const float* cv = r < BATCH ? p.c + r * D_MODEL : p.c_ctx;
        const float* w = p.w_ada + (size_t)l * D_MODEL * 6 * D_MODEL;
        float acc = 0.f;
        for (int k = 0; k < D_MODEL; ++k) acc += silu_f(cv[k]) * w[(size_t)k * 6 * D_MODEL + j];
        p.mod[i] = acc + p.b_ada[l * 6 * D_MODEL + j];
    }
}
HD void d_rope(const Params& p) {
    GS_LOOP(i, 64 * 16) {
        int pos = i / 16, k = i % 16;
        float inv = powf(10000.0f, -(float)(2 * k) / 32.0f);
        float a = (float)pos * inv;
        p.ropet[pos * 32 + k] = cosf(a); p.ropet[pos * 32 + 16 + k] = sinf(a);
    }
}
HD void d_hy_h1(const Params& p) {
    GS_LOOP(i, SEQ * HY_FFN) {
        int t = i / HY_FFN, k = i % HY_FFN;
        float tn = (float)t / (float)(SEQ - 1);
        float acc = tn * p.hy_w1[0 * HY_FFN + k];
        for (int b = 0; b < HY_BANDS; ++b) {
            float band = 1e-4f + (float)b * ((float)(HY_BANDS - 1) - 1e-4f) / (float)(HY_BANDS - 1);
#if defined(__HIP_DEVICE_COMPILE__)
            const float rev = (float)t * band * (1.0f / (float)SEQ);
            acc += __builtin_amdgcn_cosf(rev) * p.hy_w1[(1 + b) * HY_FFN + k] + __builtin_amdgcn_sinf(rev) * p.hy_w1[(1 + HY_BANDS + b) * HY_FFN + k];
#else
            float ang = 2.0f * 3.14159265358979323846f * (float)t * band / (float)SEQ;
            acc += cosf(ang) * p.hy_w1[(1 + b) * HY_FFN + k] + sinf(ang) * p.hy_w1[(1 + HY_BANDS + b) * HY_FFN + k];
#endif
        }
        p.h1[i] = sinf(p.hy_f1[k] * (acc + p.hy_b1[k]));
    }
}
HD void d_hy_h2(const Params& p) {
    GS_LOOP(i, SEQ * HY_FFN) {
        int t = i / HY_FFN, j = i % HY_FFN;
        float acc = 0.f;
#pragma unroll
        for (int k = 0; k < HY_FFN; ++k) acc += p.h1[t * HY_FFN + k] * p.hy_w2[k * HY_FFN + j];
        p.h2[i] = sinf(p.hy_f2[j] * (acc + p.hy_b2[j]));
    }
}
HD float hy_decay(int t, int c) {
    const float mind = logf(1e-2f) / 1.5f, maxd = logf(1e-2f) / 0.3f;
    float delta = fabsf(mind + (float)c * (maxd - mind) / (float)(D_CH - 1));
    float tn = (float)t / (float)(SEQ - 1);
    return expf(-tn * delta);
}
GLOBAL void nk_hy_filt(Params p) {
    GS_LOOP(i, 4 * D_CH * SEQ) {
        int t = i % SEQ, col = i / SEQ, c = col % D_CH;
        float acc = p.hy_b3[col];
        for (int k = 0; k < HY_FFN; ++k) acc += p.h2[t * HY_FFN + k] * p.hy_w3[k * 4 * D_CH + col];
        p.HFT[i] = acc * hy_decay(t, c);
    }
}
GLOBAL void nk_hy_norm(Params p) {
    GS_LOOP(i, 2 * D_CH) {
        int o = i / D_CH, c = i % D_CH;
        float s = 0.f;
        for (int dir = 0; dir < 2; ++dir) { const float* h = p.HFT + (size_t)((dir * 2 + o) * D_CH + c) * SEQ; for (int t = 0; t < SEQ; ++t) s += fabsf(h[t]); }
        p.hnorm[i] = s + EPS;
    }
}
GLOBAL void nk_zero_cnt(Params p) { GS_LOOP(i, 64) p.cnt[i] = 0; }

GLOBAL void nk_norm(Params p, int l, int which, int nrows) {
    GS_LOOP(row, nrows) {
        const float* xr = which == 0 ? xrow_in(p, l, (int)row) : xrow_cur(p, (int)row);
        float ss = 0.f;
        for (int k = 0; k < D_MODEL; ++k) ss += xr[k] * xr[k];
        float rstd = 1.0f / sqrtf(ss / D_MODEL + EPS);
        const float* g = p.norm_g + (l * 2 + which) * D_MODEL;
        const float* sh = modp(p, l, (int)row, which * 3 + 0); const float* sc = modp(p, l, (int)row, which * 3 + 1);
        for (int k = 0; k < D_MODEL; ++k) p.hbuf[row * D_MODEL + k] = f2bf(xr[k] * rstd * g[k] * (1.0f + sc[k]) + sh[k]);
    }
}

HD float dot_row(const bf16_t* a, const float* W, int ldw, int col, int K) {
    float acc = 0.f;
    for (int k = 0; k < K; ++k) acc += bf2f(a[k]) * W[(size_t)k * ldw + col];
    return acc;
}
HD float rope_apply(const Params& p, float v, float partner, int d, int s) {
    int half = d >> 5, dd = d & 31, k = dd & 15;
    int pos = half == 0 ? s / GRID_W : s % GRID_W;
    float c = p.ropet[pos * 32 + k], sn = p.ropet[pos * 32 + 16 + k];
    return dd < 16 ? v * c - partner * sn : v * c + partner * sn;
}

GLOBAL void nk_inproj_even(Params p) {
    GS_LOOP(i, (long)TT * EVEN_IN) {
        int row = i / EVEN_IN, col = i % EVEN_IN;
        const bf16_t* a = p.hbuf + (size_t)row * D_MODEL;
        float v = dot_row(a, p.w_in_even, EVEN_IN, col, D_MODEL);
        bool lat = row < TX; int b = lat ? row / SEQ : (row - TX) / CTX_LEN; int s = lat ? row % SEQ : (row - TX) % CTX_LEN;
        int pos = lat ? CTX_LEN + s : s;
        if (col < 640) {
            int d = col & 63;
            if (lat) { int pc = (d & 31) < 16 ? col + 16 : col - 16; float pv = dot_row(a, p.w_in_even, EVEN_IN, pc, D_MODEL); v = rope_apply(p, v, pv, d, s); }
            if (col < 512) p.QA[(size_t)row * 512 + col] = f2bf(v);
            else { int h = (col - 512) >> 6; p.KA[((size_t)(b * 2 + h) * LKV + pos) * 64 + d] = f2bf(v); }
        } else if (col < 768) { int h = (col - 640) >> 6, d = col & 63; p.VAt[((size_t)(b * 2 + h) * 64 + d) * LKV + pos] = f2bf(v); }
        else if (col < 1280) p.QB[(size_t)row * 512 + (col - 768)] = f2bf(v);
        else if (col < 1792) { int h = (col - 1280) >> 6, d = col & 63; p.KB[((size_t)(b * 8 + h) * LKV + pos) * 64 + d] = f2bf(v); }
        else { int h = (col - 1792) >> 6, d = col & 63; p.VBt[((size_t)(b * 8 + h) * 64 + d) * LKV + pos] = f2bf(v); }
    }
}

struct OSM { float m, l; };
#define ATT_BEGIN() float q[64], acc[64]; for (int d = 0; d < 64; ++d) { q[d] = bf2f(qp[d]) * ATTN_SCALE; acc[d] = 0.f; } float m_ = -1e30f, l_ = 0.f;
#define ATT_KEY(Kp, Vt, key, bias) do { const bf16_t* kk_ = (Kp) + (size_t)(key) * 64; float s_ = (bias); for (int d = 0; d < 64; ++d) s_ += q[d] * bf2f(kk_[d]); \
    float mn_ = fmaxf(m_, s_); float f_ = expf(m_ - mn_), pe_ = expf(s_ - mn_); l_ = l_ * f_ + pe_; \
    for (int d = 0; d < 64; ++d) acc[d] = acc[d] * f_ + pe_ * bf2f((Vt)[(size_t)d * LKV + (key)]); m_ = mn_; } while (0)
#define ATT_SINK(sv) do { float s_ = (sv); float mn_ = fmaxf(m_, s_); float f_ = expf(m_ - mn_); l_ = l_ * f_ + expf(s_ - mn_); for (int d = 0; d < 64; ++d) acc[d] *= f_; m_ = mn_; } while (0)

GLOBAL void nk_attnA(Params p) {
    GS_LOOP(i, (long)TX * 8) {
        int h = i % 8, row = i / 8, b = row / SEQ, s = row % SEQ, kvh = h / 4;
        const bf16_t* qp = p.QA + (size_t)row * 512 + h * 64;
        const bf16_t* Kp = p.KA + (size_t)(b * 2 + kvh) * LKV * 64; const bf16_t* Vt = p.VAt + (size_t)(b * 2 + kvh) * 64 * LKV;
        ATT_BEGIN();
        for (int j = 0; j < CTX_LEN; ++j) ATT_KEY(Kp, Vt, j, 0.f);
        int lo = s - A_WINDOW < 0 ? 0 : s - A_WINDOW, hi = s + A_WINDOW > SEQ - 1 ? SEQ - 1 : s + A_WINDOW;
        for (int j = lo; j <= hi; ++j) ATT_KEY(Kp, Vt, CTX_LEN + j, 0.f);
        ATT_SINK(p.a_sink[h]);
        for (int d = 0; d < 64; ++d) p.Y[(size_t)row * 1024 + h * 64 + d] = f2bf(acc[d] / l_);
    }
}
GLOBAL void nk_attnB(Params p) {
    GS_LOOP(i, (long)TX * 8) {
        int h = i % 8, row = i / 8, b = row / SEQ, s = row % SEQ, r = s / GRID_W, cq = s % GRID_W;
        const bf16_t* qp = p.QB + (size_t)row * 512 + h * 64;
        const bf16_t* Kp = p.KB + (size_t)(b * 8 + h) * LKV * 64; const bf16_t* Vt = p.VBt + (size_t)(b * 8 + h) * 64 * LKV;
        ATT_BEGIN();
        for (int j = 0; j < CTX_LEN; ++j) ATT_KEY(Kp, Vt, j, 0.f);
        int kh = B_WIN_H < GRID_H ? B_WIN_H : GRID_H;
        int rs = r - kh / 2; if (rs < 0) rs = 0; if (rs > GRID_H - kh) rs = GRID_H - kh;
        int cs = cq - B_WIN_W / 2; if (cs < 0) cs = 0; if (cs > GRID_W - B_WIN_W) cs = GRID_W - B_WIN_W;
        for (int kr = rs; kr < rs + kh; ++kr)
            for (int kc = cs; kc < cs + B_WIN_W; ++kc) {
                int dr = kr - r, dc = kc - cq;
                float bias = p.b_rpb[(h * (2 * B_WIN_H - 1) + dr + B_WIN_H - 1) * (2 * B_WIN_W - 1) + dc + B_WIN_W - 1];
                ATT_KEY(Kp, Vt, CTX_LEN + kr * GRID_W + kc, bias);
            }
        for (int d = 0; d < 64; ++d) p.Y[(size_t)row * 1024 + 512 + h * 64 + d] = f2bf(acc[d] / l_);
    }
}
GLOBAL void nk_attn_ctx(Params p) {
    GS_LOOP(i, (long)TC * 16) {
        int hh = i % 16, rc = i / 16, ty = hh / 8, h = hh % 8, b = rc / CTX_LEN; int row = TX + rc;
        const bf16_t* qp = (ty == 0 ? p.QA : p.QB) + (size_t)row * 512 + h * 64;
        const bf16_t* Kp = ty == 0 ? p.KA + (size_t)(b * 2 + h / 4) * LKV * 64 : p.KB + (size_t)(b * 8 + h) * LKV * 64;
        const bf16_t* Vt = ty == 0 ? p.VAt + (size_t)(b * 2 + h / 4) * 64 * LKV : p.VBt + (size_t)(b * 8 + h) * 64 * LKV;
        ATT_BEGIN();
        for (int j = 0; j < CTX_LEN; ++j) ATT_KEY(Kp, Vt, j, 0.f);
        if (ty == 0) ATT_SINK(p.a_sink[h]);
        for (int d = 0; d < 64; ++d) p.Y[(size_t)row * 1024 + ty * 512 + h * 64 + d] = f2bf(acc[d] / l_);
    }
}
GLOBAL void nk_attnC(Params p) {
    GS_LOOP(i, (long)TX * 8) {
        int h = i % 8, row = i / 8, b = row / SEQ, kvh = h / 4;
        const bf16_t* qp = p.QC + (size_t)row * 512 + h * 64;
        const bf16_t* Kp = p.KC + (size_t)(b * 2 + kvh) * LKV * 64; const bf16_t* Vt = p.VCt + (size_t)(b * 2 + kvh) * 64 * LKV;
        ATT_BEGIN();
        for (int j = 0; j < LKV; ++j) ATT_KEY(Kp, Vt, j, 0.f);
        for (int d = 0; d < 64; ++d) p.Y[(size_t)row * 1024 + h * 64 + d] = f2bf(acc[d] / l_);
    }
}

GLOBAL void nk_outproj_even(Params p) {
    GS_LOOP(i, (long)TT * D_MODEL) {
        int row = i / D_MODEL, col = i % D_MODEL;
        float acc = dot_row(p.Y + (size_t)row * 1024, p.w_out_even, D_MODEL, col, EVEN_OUT);
        xrow_cur(p, row)[col] = xrow_in(p, 0, row)[col] + modp(p, 0, row, 2)[col] * acc;
    }
}
GLOBAL void nk_outproj_odd(Params p) {
    GS_LOOP(i, (long)TX * D_MODEL) {
        int row = i / D_MODEL, col = i % D_MODEL, b = row / SEQ, s = row % SEQ;
        float acc = dot_row(p.Y + (size_t)row * 1024, p.w_out_odd, D_MODEL, col, 512);
        for (int c = 0; c < D_CH; ++c) acc += bf2f(p.YHT[((size_t)b * D_CH + c) * SEQ + s]) * p.w_out_odd[(size_t)(512 + c) * D_MODEL + col];
        p.out[i] = p.out[i] + modp(p, 1, row, 2)[col] * acc;
    }
}

GLOBAL void nk_router(Params p, int l, int nrows) {
    GS_LOOP(row, nrows) {
        const float* xr = xrow_cur(p, (int)row);
        float ss = 0.f;
        for (int k = 0; k < D_MODEL; ++k) ss += xr[k] * xr[k];
        float rstd = 1.0f / sqrtf(ss / D_MODEL + EPS);
        const float* g = p.norm_g + (l * 2 + 1) * D_MODEL; const float* sh = modp(p, l, (int)row, 3); const float* sc = modp(p, l, (int)row, 4);
        float lg[16];
#pragma unroll
        for (int e = 0; e < 16; ++e) lg[e] = 0.f;
        for (int k = 0; k < D_MODEL; ++k) { float hv = xr[k] * rstd * g[k] * (1.0f + sc[k]) + sh[k];
#pragma unroll
            for (int e = 0; e < 16; ++e) lg[e] += hv * p.w_router[k * 16 + e]; }
        int gbest = 0, a = 0, bb = 1; float gbs = -1e30f, wa = 0.f, wb = 0.f;
#pragma unroll
        for (int gI = 0; gI < 4; ++gI) {
            float m1 = -1e30f, m2 = -1e30f, s1 = 0.f, s2 = 0.f; int i1 = 0, i2 = 0;
#pragma unroll
            for (int j = 0; j < 4; ++j) { float sgv = sigmoid_f(lg[gI * 4 + j]); float v = sgv + p.b_router[gI * 4 + j];
                if (v > m1) { m2 = m1; i2 = i1; s2 = s1; m1 = v; i1 = j; s1 = sgv; } else if (v > m2) { m2 = v; i2 = j; s2 = sgv; } }
            float gs = m1 + m2;
            if (gs > gbs) { gbs = gs; gbest = gI; if (i1 < i2) { a = i1; bb = i2; wa = s1; wb = s2; } else { a = i2; bb = i1; wa = s2; wb = s1; } }
        }
        float inv = 1.0f / (wa + wb);
        int pidx = a == 0 ? bb - 1 : (a == 1 ? bb + 1 : 5);
        int pr = gbest * 6 + pidx;
        int pos = atomicAdd(p.cnt + l * 32 + pr, 1);
        p.list[(size_t)pr * TT + pos] = (int)row;
        p.tokw[row * 2 + 0] = wa * inv; p.tokw[row * 2 + 1] = wb * inv;
    }
}
HD void pair_experts(int pr, int& e1, int& e2) { int g = pr / 6, q = pr % 6; int a = q < 3 ? 0 : (q < 5 ? 1 : 2); int b = q < 3 ? q + 1 : (q < 5 ? q - 1 : 3); e1 = g * 4 + a; e2 = g * 4 + b; }
HD bool slot_lookup(const Params& p, int l, int slot, int& pr, int& row) { int acc = 0; for (int q = 0; q < NPAIR; ++q) { int c = p.cnt[l * 32 + q]; if (slot < acc + c) { pr = q; row = p.list[(size_t)q * TT + (slot - acc)]; return true; } acc += c; } return false; }
GLOBAL void nk_moe_up(Params p, int l, int nrows) {
    GS_LOOP(i, (long)nrows * HE_W) {
        int slot = i / HE_W, j = i % HE_W, k = j / D_EXPERT, jj = j % D_EXPERT; int pr, row; if (!slot_lookup(p, l, slot, pr, row)) continue;
        int e1, e2; pair_experts(pr, e1, e2); int e = k == 0 ? e1 : e2;
        const bf16_t* a = p.hbuf + (size_t)row * D_MODEL;
        const float* wg = p.moe_wg + (size_t)(l * N_EXPERTS + e) * D_MODEL * D_EXPERT; const float* wu = p.moe_wu + (size_t)(l * N_EXPERTS + e) * D_MODEL * D_EXPERT;
        float g = dot_row(a, wg, D_EXPERT, jj, D_MODEL), u = dot_row(a, wu, D_EXPERT, jj, D_MODEL);
        p.HE[(size_t)row * HE_W + j] = f2bf(p.tokw[row * 2 + k] * silu_f(g) * u);
    }
}
GLOBAL void nk_moe_down(Params p, int l, int nrows) {
    GS_LOOP(i, (long)nrows * D_MODEL) {
        int slot = i / D_MODEL, col = i % D_MODEL; int pr, row; if (!slot_lookup(p, l, slot, pr, row)) continue;
        int e1, e2; pair_experts(pr, e1, e2);
        const bf16_t* a = p.HE + (size_t)row * HE_W;
        float acc = dot_row(a, p.moe_wd + (size_t)(l * N_EXPERTS + e1) * D_EXPERT * D_MODEL, D_MODEL, col, D_EXPERT)
                  + dot_row(a + D_EXPERT, p.moe_wd + (size_t)(l * N_EXPERTS + e2) * D_EXPERT * D_MODEL, D_MODEL, col, D_EXPERT);
        float* xr = xrow_cur(p, row);
        xr[col] = xr[col] + modp(p, l, row, 5)[col] * acc;
    }
}

GLOBAL void nk_inproj_odd_qk(Params p) {
    GS_LOOP(i, (long)TT * 10) {
        int row = i / 10, hu = i % 10; const bf16_t* a = p.hbuf + (size_t)row * D_MODEL;
        bool lat = row < TX; int b = lat ? row / SEQ : (row - TX) / CTX_LEN; int s = lat ? row % SEQ : (row - TX) % CTX_LEN; int pos = lat ? CTX_LEN + s : s;
        int col0 = hu * 64;
        float v[64]; float ss = 0.f;
        for (int d = 0; d < 64; ++d) { v[d] = dot_row(a, p.w_in_odd, ODD_IN, col0 + d, D_MODEL); ss += v[d] * v[d]; }
        float rstd = 1.0f / sqrtf(ss / 64.0f + EPS);
        const float* gn = hu < 8 ? p.c_qnorm : p.c_knorm;
        for (int d = 0; d < 64; ++d) v[d] = v[d] * rstd * gn[d];
        for (int d = 0; d < 64; ++d) {
            float o = v[d];
            if (lat) { int pd = (d & 31) < 16 ? d + 16 : d - 16; o = rope_apply(p, v[d], v[pd], d, s); }
            if (hu < 8) p.QC[(size_t)row * 512 + col0 + d] = f2bf(o);
            else p.KC[((size_t)(b * 2 + (hu - 8)) * LKV + pos) * 64 + d] = f2bf(o);
        }
    }
}
GLOBAL void nk_inproj_odd_vu(Params p) {
    GS_LOOP(i, (long)TT * (ODD_IN - 640)) {
        int row = i / (ODD_IN - 640), col = 640 + i % (ODD_IN - 640); const bf16_t* a = p.hbuf + (size_t)row * D_MODEL;
        bool lat = row < TX; int b = lat ? row / SEQ : (row - TX) / CTX_LEN; int s = lat ? row % SEQ : (row - TX) % CTX_LEN; int pos = lat ? CTX_LEN + s : s;
        if (col >= 768 && !lat) continue;
        float v = dot_row(a, p.w_in_odd, ODD_IN, col, D_MODEL);
        if (col < 768) { int h = (col - 640) >> 6, d = col & 63; p.VCt[((size_t)(b * 2 + h) * 64 + d) * LKV + pos] = f2bf(v); }
        else p.UT[((size_t)b * 3 * D_CH + (col - 768)) * SEQ + s] = f2bf(v);
    }
}

HD float hy_sc(const Params& p, int b, int ch, int t) {
    const bf16_t* u = p.UT + ((size_t)b * 3 * D_CH + ch) * SEQ;
    float acc = p.hy_short_b[ch];
    for (int kk = 0; kk < 3; ++kk) { int tt = t + kk - 1; if (tt >= 0 && tt < SEQ) acc += p.hy_short_w[kk * 3 * D_CH + ch] * bf2f(u[tt]); }
    return acc;
}
GLOBAL void nk_hy_conv(Params p, int o) {
    GS_LOOP(i, (long)BATCH * D_CH * SEQ) {
        int n = i % SEQ, c = (i / SEQ) % D_CH, b = i / ((long)SEQ * D_CH);
        const float* hf = p.HFT + (size_t)((0 * 2 + o) * D_CH + c) * SEQ; const float* hb = p.HFT + (size_t)((1 * 2 + o) * D_CH + c) * SEQ;
        float inv = 1.0f / p.hnorm[o * D_CH + c];
        float acc = 0.f;
        for (int m = 0; m < SEQ; ++m) {
            float z = o == 0 ? hy_sc(p, b, c, m) : p.Z1[((size_t)b * D_CH + c) * SEQ + m];
            int d = n - m; float hv = d >= 0 ? hf[d] : hb[-d];
            acc += hv * z;
        }
        acc *= inv;
        float zn = o == 0 ? hy_sc(p, b, c, n) : p.Z1[((size_t)b * D_CH + c) * SEQ + n];
        float g = hy_sc(p, b, (o + 1) * D_CH + c, n);
        float r = g * (acc + zn * p.hy_bias[o * D_CH + c]);
        if (o == 0) p.Z1[i] = r; else p.YHT[i] = f2bf(r);
    }
}

GLOBAL void nk_final(Params p) {
    GS_LOOP(row, TX) {
        float* xr = p.out + (size_t)row * D_MODEL; float ss = 0.f;
        for (int k = 0; k < D_MODEL; ++k) ss += xr[k] * xr[k];
        float rstd = 1.0f / sqrtf(ss / D_MODEL + EPS);
        for (int k = 0; k < D_MODEL; ++k) xr[k] = xr[k] * rstd * p.final_g[k];
    }
}
GLOBAL void nk_yht_to_y(Params p) {
    GS_LOOP(i, (long)TX * D_CH) { int row = i / D_CH, c = i % D_CH, b = row / SEQ, s = row % SEQ; p.Y[(size_t)row * 1024 + 512 + c] = p.YHT[((size_t)b * D_CH + c) * SEQ + s]; }
}

GLOBAL void nk_rope(Params p) { d_rope(p); }
GLOBAL void nk_hy_h1(Params p) { d_hy_h1(p); }
GLOBAL void nk_hy_h2(Params p) { d_hy_h2(p); }
static inline size_t al256(size_t x) { return (x + 255) & ~(size_t)255; }
static size_t setup_ws(Params& p, char* ws) {
    size_t o = 0;
    auto take = [&](size_t bytes) { char* r = ws + o; o += al256(bytes); return r; };
    p.bar = (unsigned*)take(64 * 1024);
    p.cnt = (int*)take(256);
    p.XC = (float*)take((size_t)TC * D_MODEL * 4);
    p.mod = (float*)take((size_t)DEPTH * (BATCH + 1) * 6 * D_MODEL * 4);
    p.ropet = (float*)take(64 * 32 * 4);
    p.h1 = (float*)take((size_t)SEQ * 64 * 4);
    p.h2 = (float*)take((size_t)SEQ * 64 * 4);
    p.HFT = (float*)take((size_t)4 * D_CH * SEQ * 4);
    p.hnorm = (float*)take(2 * D_CH * 4);
    p.list = (int*)take((size_t)NPAIR * TT * 4);
    p.tokw = (float*)take((size_t)TT * 2 * 4);
    p.rpair = (int*)take((size_t)TT * 4);
    p.bh = (int*)take((size_t)2048 * 32 * 4);
    p.rlog = (float*)take((size_t)TT * 16 * 4);
    size_t hb = (size_t)TT * D_MODEL * 2, z1 = (size_t)BATCH * D_CH * SEQ * 4;
    char* r0 = take(hb > z1 ? hb : z1); p.hbuf = (bf16_t*)r0; p.Z1 = (float*)r0;
    size_t q = al256((size_t)TT * 512 * 2), kva = al256((size_t)BATCH * 2 * LKV * 64 * 2), kvb = al256((size_t)BATCH * 8 * LKV * 64 * 2), ut = al256((size_t)BATCH * 3 * D_CH * SEQ * 2);
    size_t l0 = 2 * q + 2 * kva + 2 * kvb, l1 = q + 2 * kva + ut;
    char* R = take(l0 > l1 ? l0 : l1);
    p.QA = (bf16_t*)R; p.KA = (bf16_t*)(R + q); p.VAt = (bf16_t*)(R + q + kva); p.QB = (bf16_t*)(R + q + 2 * kva); p.KB = (bf16_t*)(R + 2 * q + 2 * kva); p.VBt = (bf16_t*)(R + 2 * q + 2 * kva + kvb);
    p.QC = (bf16_t*)R; p.KC = (bf16_t*)(R + q); p.VCt = (bf16_t*)(R + q + kva); p.UT = (bf16_t*)(R + q + 2 * kva);
    size_t yb = (size_t)TT * 1024 * 2, heb = (size_t)TT * HE_W * 2;
    char* r1 = take(yb > heb ? yb : heb); p.Y = (bf16_t*)r1; p.HE = (bf16_t*)r1;
    p.YHT = (bf16_t*)take((size_t)BATCH * D_CH * SEQ * 2);
    p.Wt_in_even = (bf16_t*)take((size_t)EVEN_IN * D_MODEL * 2);
    p.Wt_out_even = (bf16_t*)take((size_t)D_MODEL * EVEN_OUT * 2);
    p.Wt_in_odd = (bf16_t*)take((size_t)ODD_IN * D_MODEL * 2);
    p.Wt_out_odd = (bf16_t*)take((size_t)D_MODEL * ODD_OUT * 2);
    p.Wt_gu = (bf16_t*)take((size_t)DEPTH * N_EXPERTS * 2 * D_EXPERT * D_MODEL * 2);
    p.Wt_d = (bf16_t*)take((size_t)DEPTH * N_EXPERTS * D_MODEL * D_EXPERT * 2);
    return o;
}
static void fill_inputs(Params& p, void* const* d_in, void* d_out) {
    const float** f = (const float**)&p.x;
    for (int i = 0; i < 32; ++i) f[i] = (const float*)d_in[i];
    p.out = (float*)d_out;
}
#define LAS __attribute__((address_space(3)))
typedef short bf16x8 __attribute__((ext_vector_type(8)));
typedef float f32x4 __attribute__((ext_vector_type(4)));
typedef float f32x16 __attribute__((ext_vector_type(16)));
typedef unsigned u32x4 __attribute__((ext_vector_type(4)));
typedef unsigned u32x2 __attribute__((ext_vector_type(2)));

constexpr int NTHREADS = 256;
constexpr int LDS_BYTES = 69632;
constexpr int MT_ALL = TT / 128, MT_LAT = TX / 128;

__device__ __forceinline__ unsigned pk2bf(float lo, float hi) { return (unsigned)f2bf(lo) | ((unsigned)f2bf(hi) << 16); }
__device__ __forceinline__ float wave_sum(float v) {
#pragma unroll
    for (int o = 1; o < 64; o <<= 1) v += __shfl_xor(v, o);
    return v;
}

template <class DstF>
__device__ __forceinline__ void cvt_block_item(char* lds, const float* W, int N, int k0, int n0, const DstF& dst) {
    float* T = (float*)lds; const int tid = threadIdx.x;
    f32x4 v[16];
#pragma unroll
    for (int i = 0; i < 16; ++i) v[i] = *(const f32x4*)(W + (size_t)(k0 + (tid >> 6) + 4 * i) * N + n0 + 4 * (tid & 63));
#pragma unroll
    for (int i = 0; i < 16; ++i) *(f32x4*)(T + ((tid >> 6) + 4 * i) * 260 + 4 * (tid & 63)) = v[i];
    __syncthreads();
    bf16_t* d = dst(n0 + tid) + k0; const float* s = T + tid;
#pragma unroll
    for (int c = 0; c < 8; ++c) { u32x4 w; w.x = pk2bf(s[(8 * c + 0) * 260], s[(8 * c + 1) * 260]); w.y = pk2bf(s[(8 * c + 2) * 260], s[(8 * c + 3) * 260]);
        w.z = pk2bf(s[(8 * c + 4) * 260], s[(8 * c + 5) * 260]); w.w = pk2bf(s[(8 * c + 6) * 260], s[(8 * c + 7) * 260]); *(u32x4*)(d + 8 * c) = w; }
    __syncthreads();
}
__device__ __forceinline__ void cvt_plain(char* lds, const float* W, bf16_t* Wt, int K, int N, int item) {
    const int nb = N / 256, kb = item / nb, nbi = item % nb;
    cvt_block_item(lds, W, N, kb * 64, nbi * 256, [&](int n) { return Wt + (size_t)n * K; });
}
constexpr int CVT_IN = (D_MODEL / 64) * (EVEN_IN / 256), CVT_OUT = (D_MODEL / 64) * (D_MODEL / 256), CVT_GU1 = (D_MODEL / 64) * (D_EXPERT / 256), CVT_D1 = (D_EXPERT / 64) * (D_MODEL / 256);
constexpr int CVT_GU = DEPTH * N_EXPERTS * 2 * CVT_GU1, CVT_D = DEPTH * N_EXPERTS * CVT_D1;
constexpr int CVT_TOTAL = 2 * CVT_IN + 2 * CVT_OUT + CVT_GU + CVT_D;
constexpr int CVT_EARLY = 2 * CVT_IN + 2 * CVT_OUT;
static_assert(EVEN_IN % 256 == 0 && ODD_IN % 256 == 0 && D_EXPERT % 256 == 0, "conversion tile");
__device__ __forceinline__ void cvt_item(const Params& p, char* lds, int it) {
    if (it < CVT_IN) { cvt_plain(lds, p.w_in_even, p.Wt_in_even, D_MODEL, EVEN_IN, it); return; } it -= CVT_IN;
    if (it < CVT_IN) { cvt_plain(lds, p.w_in_odd, p.Wt_in_odd, D_MODEL, ODD_IN, it); return; } it -= CVT_IN;
    if (it < CVT_OUT) { cvt_plain(lds, p.w_out_even, p.Wt_out_even, EVEN_OUT, D_MODEL, it); return; } it -= CVT_OUT;
    if (it < CVT_OUT) { cvt_plain(lds, p.w_out_odd, p.Wt_out_odd, ODD_OUT, D_MODEL, it); return; } it -= CVT_OUT;
    if (it < CVT_GU) {
        const int le = it / (2 * CVT_GU1), r = it % (2 * CVT_GU1), half = r / CVT_GU1, r2 = r % CVT_GU1; const int nb = D_EXPERT / 256, kb = r2 / nb, nbi = r2 % nb;
        const float* W = (half ? p.moe_wu : p.moe_wg) + (size_t)le * D_MODEL * D_EXPERT; bf16_t* Wt = p.Wt_gu + (size_t)le * 2 * D_EXPERT * D_MODEL;
        cvt_block_item(lds, W, D_EXPERT, kb * 64, nbi * 256, [&](int n) { return Wt + (size_t)(32 * (n >> 4) + 16 * half + (n & 15)) * D_MODEL; });
        return; } it -= CVT_GU;
    { const int le = it / CVT_D1, r = it % CVT_D1; cvt_plain(lds, p.moe_wd + (size_t)le * D_EXPERT * D_MODEL, p.Wt_d + (size_t)le * D_MODEL * D_EXPERT, D_EXPERT, D_MODEL, r); }
}
constexpr int CVT_MOE_L = (CVT_GU + CVT_D) / DEPTH;
__device__ __forceinline__ int cvt_moe_index(int layer, int j) {
    return j < CVT_GU / DEPTH ? CVT_EARLY + layer * (CVT_GU / DEPTH) + j : CVT_EARLY + CVT_GU + layer * (CVT_D / DEPTH) + (j - CVT_GU / DEPTH);
}
__device__ __forceinline__ void cvt_range(const Params& p, char* lds, int lo, int hi, int bid, int nb) {
    for (int it = lo + bid; it < hi; it += nb) cvt_item(p, lds, it);
}

struct TileGeom { int tid, lane, wid, wr, wc, l15, q, srow, schunk;
    __device__ __forceinline__ int drow(int i) const { return wid * 32 + i * 8 + (lane >> 3); }
    __device__ __forceinline__ int dchunk(int i) const { return (lane & 7) ^ (((lane >> 4) + 4 * i) & 7); } };
__device__ __forceinline__ TileGeom tile_geom() { TileGeom g; g.tid = threadIdx.x; g.lane = g.tid & 63; g.wid = __builtin_amdgcn_readfirstlane(g.tid >> 6); g.wr = g.wid >> 1; g.wc = g.wid & 1; g.l15 = g.lane & 15; g.q = g.lane >> 4; g.srow = g.tid >> 3; g.schunk = g.tid & 7; return g; }

template <class ALoad, class BLoad>
__device__ __forceinline__ void gemm_mainloop(char* lds, const TileGeom& g, int nk, const ALoad& AL, const BLoad& BL, f32x4 (&acc)[4][4]) {
#pragma unroll
    for (int i = 0; i < 4; ++i)
#pragma unroll
        for (int j = 0; j < 4; ++j) acc[i][j] = (f32x4){0.f, 0.f, 0.f, 0.f};
    const int swz = g.l15 >> 1;
    const int aofs = (g.wr * 64 + g.l15) * 128 + ((g.q ^ swz) << 4);
    const int bofs = 32768 + (g.wc * 64 + g.l15) * 128 + ((g.q ^ swz) << 4);
    LAS char* l3 = (LAS char*)lds;
    const int dbase = g.wid * 4096;
#define GEMM_STAGE(kt_, buf_) do { _Pragma("unroll") for (int i_ = 0; i_ < 4; ++i_) { \
        __builtin_amdgcn_global_load_lds((const unsigned*)AL(i_, (kt_)), (LAS unsigned*)(l3 + (buf_) + dbase + i_ * 1024), 16, 0, 0); \
        __builtin_amdgcn_global_load_lds((const unsigned*)BL(i_, (kt_)), (LAS unsigned*)(l3 + 32768 + (buf_) + dbase + i_ * 1024), 16, 0, 0); } } while (0)
#define GEMM_BAR() do { __builtin_amdgcn_s_barrier(); asm volatile("" ::: "memory"); } while (0)
    GEMM_STAGE(0, 0);
    if (nk > 1) GEMM_STAGE(1, 16384);
    asm volatile("s_waitcnt vmcnt(0) lgkmcnt(0)" ::: "memory");
    GEMM_BAR();
    for (int kt = 0; kt < nk; ++kt) {
        const int cur = (kt & 1) * 16384;
        bf16x8 af[2][4], bfr[2][4];
#pragma unroll
        for (int kk = 0; kk < 2; ++kk)
#pragma unroll
            for (int i = 0; i < 4; ++i) { af[kk][i] = *(const bf16x8*)(lds + cur + ((aofs + i * 2048) ^ (kk * 64))); bfr[kk][i] = *(const bf16x8*)(lds + cur + ((bofs + i * 2048) ^ (kk * 64))); }
        asm volatile("s_waitcnt lgkmcnt(0)" ::: "memory");
        GEMM_BAR();
        if (kt + 2 < nk) GEMM_STAGE(kt + 2, cur);
#pragma unroll
        for (int kk = 0; kk < 2; ++kk)
#pragma unroll
            for (int mi = 0; mi < 4; ++mi)
#pragma unroll
                for (int ni = 0; ni < 4; ++ni) acc[mi][ni] = __builtin_amdgcn_mfma_f32_16x16x32_bf16(bfr[kk][ni], af[kk][mi], acc[mi][ni], 0, 0, 0);
        if (kt + 1 < nk) {
            if (kt + 2 < nk) asm volatile("s_waitcnt vmcnt(8)" ::: "memory"); else asm volatile("s_waitcnt vmcnt(0)" ::: "memory");
            GEMM_BAR();
        }
    }
#undef GEMM_STAGE
#undef GEMM_BAR
}

template <class DstF>
__device__ __forceinline__ void store_transposed(char* lds, const TileGeom& g, const f32x4 (&acc)[4][4], const DstF& dst) {
    bf16_t* T = (bf16_t*)lds;
#pragma unroll
    for (int mi = 0; mi < 4; ++mi)
#pragma unroll
        for (int ni = 0; ni < 4; ++ni)
#pragma unroll
            for (int r = 0; r < 4; ++r) T[(g.wc * 64 + ni * 16 + g.q * 4 + r) * 136 + g.wr * 64 + mi * 16 + g.l15] = f2bf(acc[mi][ni][r]);
    __syncthreads();
    { int col = g.tid >> 1, half = g.tid & 1; bf16_t* d = dst(col) + half * 64; const bf16_t* s = T + col * 136 + half * 64;
#pragma unroll
      for (int j = 0; j < 8; ++j) *(u32x4*)(d + j * 8) = *(const u32x4*)(s + j * 8); }
    __syncthreads();
}
__device__ __forceinline__ void store4bf(bf16_t* d, const f32x4& v) { u32x2 w; w.x = pk2bf(v[0], v[1]); w.y = pk2bf(v[2], v[3]); *(u32x2*)d = w; }
__device__ __forceinline__ void rope_head(const Params& p, f32x4 (&a)[4], int s, int q) {
    const int pr = s / GRID_W, pc = s % GRID_W;
    const f32x4 cr = *(const f32x4*)(p.ropet + pr * 32 + q * 4), sr = *(const f32x4*)(p.ropet + pr * 32 + 16 + q * 4);
    const f32x4 cc = *(const f32x4*)(p.ropet + pc * 32 + q * 4), sc = *(const f32x4*)(p.ropet + pc * 32 + 16 + q * 4);
    f32x4 x1 = a[0], x2 = a[1]; a[0] = x1 * cr - x2 * sr; a[1] = x2 * cr + x1 * sr;
    x1 = a[2]; x2 = a[3]; a[2] = x1 * cc - x2 * sc; a[3] = x2 * cc + x1 * sc;
}

template <int LAYER>
__device__ __forceinline__ void inproj_tile(const Params& p, char* lds, int mt, int nt) {
    const TileGeom g = tile_geom();
    const bf16_t* Abase = p.hbuf + (size_t)(mt * 128) * D_MODEL;
    const bf16_t* Bbase = (LAYER == 0 ? p.Wt_in_even : p.Wt_in_odd) + (size_t)(nt * 128) * D_MODEL;
    f32x4 acc[4][4];
    gemm_mainloop(lds, g, D_MODEL / 64, [&](int i, int kt) { return Abase + (size_t)g.drow(i) * D_MODEL + kt * 64 + g.dchunk(i) * 8; }, [&](int i, int kt) { return Bbase + (size_t)g.drow(i) * D_MODEL + kt * 64 + g.dchunk(i) * 8; }, acc);
    const bool lat = mt < MT_LAT; const int row0 = mt * 128;
    const int b = lat ? row0 / SEQ : (row0 - TX) / CTX_LEN, s0 = lat ? row0 % SEQ : (row0 - TX) % CTX_LEN, pos0 = lat ? CTX_LEN + s0 : s0;
    int kind;
    bf16_t* base; int h0 = 0, qcol0 = 0, nh = 2;
    if (LAYER == 0) {
        if (nt < 4) { kind = 0; base = p.QA; qcol0 = nt * 128; }
        else if (nt == 4) { kind = 1; base = p.KA; h0 = 0; nh = 2; }
        else if (nt == 5) { kind = 2; base = p.VAt; h0 = 0; nh = 2; }
        else if (nt < 10) { kind = 0; base = p.QB; qcol0 = (nt - 6) * 128; }
        else if (nt < 14) { kind = 1; base = p.KB; h0 = (nt - 10) * 2; nh = 8; }
        else { kind = 2; base = p.VBt; h0 = (nt - 14) * 2; nh = 8; }
    } else {
        if (nt < 4) { kind = 0; base = p.QC; qcol0 = nt * 128; }
        else if (nt == 4) { kind = 1; base = p.KC; h0 = 0; nh = 2; }
        else if (nt == 5) { kind = 2; base = p.VCt; h0 = 0; nh = 2; }
        else { kind = 3; base = p.UT; }
    }
    if (kind <= 1) {
        const bool rope = lat && (LAYER == 1 || nt <= 4);
#pragma unroll
        for (int mi = 0; mi < 4; ++mi) {
            const int rowl = g.wr * 64 + mi * 16 + g.l15;
            if (LAYER == 1) {
                float ss = 0.f;
#pragma unroll
                for (int ni = 0; ni < 4; ++ni) ss += acc[mi][ni][0] * acc[mi][ni][0] + acc[mi][ni][1] * acc[mi][ni][1] + acc[mi][ni][2] * acc[mi][ni][2] + acc[mi][ni][3] * acc[mi][ni][3];
                ss += __shfl_xor(ss, 16); ss += __shfl_xor(ss, 32);
                const float rstd = 1.0f / sqrtf(ss * (1.0f / 64.0f) + EPS);
                const float* gn = kind == 0 ? p.c_qnorm : p.c_knorm;
#pragma unroll
                for (int ni = 0; ni < 4; ++ni) acc[mi][ni] = acc[mi][ni] * rstd * *(const f32x4*)(gn + ni * 16 + g.q * 4);
            }
            if (rope) rope_head(p, acc[mi], s0 + rowl, g.q);
            bf16_t* d = kind == 0 ? base + (size_t)(row0 + rowl) * 512 + qcol0 + g.wc * 64 + g.q * 4
                                  : base + ((size_t)(b * nh + h0 + g.wc) * LKV + pos0 + rowl) * 64 + g.q * 4;
#pragma unroll
            for (int ni = 0; ni < 4; ++ni) store4bf(d + ni * 16, acc[mi][ni]);
        }
    } else if (kind == 2) {
        store_transposed(lds, g, acc, [&](int col) { return base + ((size_t)(b * nh + h0 + (col >> 6)) * 64 + (col & 63)) * LKV + pos0; });
    } else {
        store_transposed(lds, g, acc, [&](int col) { return base + ((size_t)b * 3 * D_CH + (nt - 6) * 128 + col) * SEQ + s0; });
    }
}
template <int LAYER>
__device__ __forceinline__ void ph_inproj(const Params& p, char* lds, int bid, int nb) {
    constexpr int NT = 18;
    const bool xl = (nb & 7) == 0; const int x = xl ? bid & 7 : 0, step = xl ? nb >> 3 : nb, mstep = xl ? 8 : 1;
    if (LAYER == 0) {
        for (int t = xl ? bid >> 3 : bid; ; t += step) { const int mt = (t / NT) * mstep + x, nt = t % NT; if (mt >= MT_ALL) break; inproj_tile<0>(p, lds, mt, nt); }
    } else {
        const int nlat_t = (MT_LAT / mstep) * NT;
        for (int t = xl ? bid >> 3 : bid; ; t += step) {
            int mt, nt;
            if (t < nlat_t) { mt = (t / NT) * mstep + x; nt = t % NT; }
            else { const int u = t - nlat_t; mt = MT_LAT + (u / 2) * mstep + x; nt = 4 + u % 2; if (mt >= MT_ALL) break; }
            inproj_tile<1>(p, lds, mt, nt);
        }
    }
}

template <int LAYER>
__device__ __forceinline__ void outproj_tile(const Params& p, char* lds, int mt, int nt) {
    const TileGeom g = tile_geom();
    const bf16_t* Abase = p.Y + (size_t)(mt * 128) * 1024;
    const bf16_t* Bbase = (LAYER == 0 ? p.Wt_out_even : p.Wt_out_odd) + (size_t)(nt * 128) * 1024;
    f32x4 acc[4][4];
    gemm_mainloop(lds, g, 16, [&](int i, int kt) { return Abase + (size_t)g.drow(i) * 1024 + kt * 64 + g.dchunk(i) * 8; }, [&](int i, int kt) { return Bbase + (size_t)g.drow(i) * 1024 + kt * 64 + g.dchunk(i) * 8; }, acc);
    const int row0 = mt * 128;
#pragma unroll
    for (int mi = 0; mi < 4; ++mi) {
        const int row = row0 + g.wr * 64 + mi * 16 + g.l15;
        const float* xin = xrow_in(p, LAYER, row); float* xo = xrow_cur(p, row); const float* gate = modp(p, LAYER, row, 2);
#pragma unroll
        for (int ni = 0; ni < 4; ++ni) { const int col = nt * 128 + g.wc * 64 + ni * 16 + g.q * 4;
            *(f32x4*)(xo + col) = *(const f32x4*)(xin + col) + *(const f32x4*)(gate + col) * acc[mi][ni]; }
    }
}

template <int LAYER>
__device__ __forceinline__ void ph_outproj(const Params& p, char* lds, int bid, int nb) {
    const int nmt = LAYER == 0 ? MT_ALL : MT_LAT;
    const bool xl = (nb & 7) == 0; const int x = xl ? bid & 7 : 0, step = xl ? nb >> 3 : nb, mstep = xl ? 8 : 1;
    for (int t = xl ? bid >> 3 : bid; ; t += step) { const int mt = (t / 8) * mstep + x, nt = t % 8; if (mt >= nmt) break; outproj_tile<LAYER>(p, lds, mt, nt); }
}

template <int NTN>
__device__ __forceinline__ bool moe_tile_lookup(const int* cnt, int t, int& pr, int& mt, int& nt, int& n) {
    int acc = 0;
    for (int q = 0; q < NPAIR; ++q) { const int c = __builtin_amdgcn_readfirstlane(cnt[q]); const int tiles = ((c + 127) >> 7) * NTN; if (t < acc + tiles) { pr = q; const int u = t - acc; mt = u / NTN; nt = u % NTN; n = c; return true; } acc += tiles; }
    return false;
}
template <int NTN>
__device__ __forceinline__ bool moe_tile_lookup_xcd(const int* cnt, int xcd, int t, int& pr, int& mt, int& nt, int& n) {
    int acc = 0;
#pragma unroll
    for (int i = 0; i < NPAIR / 8; ++i) { const int q = xcd + 8 * i; const int c = __builtin_amdgcn_readfirstlane(cnt[q]); const int tiles = ((c + 127) >> 7) * NTN;
        if (t < acc + tiles) { pr = q; const int u = t - acc; mt = u / NTN; nt = u % NTN; n = c; return true; } acc += tiles; }
    return false;
}
__device__ __forceinline__ void moe_up_tile(const Params& p, char* lds, int l, int pr, int mt, int nt, int n) {
    const TileGeom g = tile_geom();
    int e1, e2; pair_experts(pr, e1, e2); const int k = nt >> 3, e = k ? e2 : e1;
    const int* lst = p.list + (size_t)pr * TT + mt * 128;
    const int navail = n - mt * 128;
    const bf16_t* arow[4];
#pragma unroll
    for (int i = 0; i < 4; ++i) { int r = g.drow(i); if (r >= navail) r = navail - 1; arow[i] = p.hbuf + (size_t)lst[r] * D_MODEL + g.dchunk(i) * 8; }
    const bf16_t* Bbase = p.Wt_gu + ((size_t)(l * N_EXPERTS + e) * 2 * D_EXPERT + (nt & 7) * 128) * D_MODEL;
    f32x4 acc[4][4];
    gemm_mainloop(lds, g, D_MODEL / 64, [&](int i, int kt) { return arow[i] + kt * 64; }, [&](int i, int kt) { return Bbase + (size_t)g.drow(i) * D_MODEL + kt * 64 + g.dchunk(i) * 8; }, acc);
#pragma unroll
    for (int mi = 0; mi < 4; ++mi) {
        const int rl = g.wr * 64 + mi * 16 + g.l15;
        if (rl < navail) {
            const int row = lst[rl]; const float w = p.tokw[row * 2 + k];
            bf16_t* d = p.HE + (size_t)row * HE_W + k * D_EXPERT + (nt & 7) * 64 + g.wc * 32 + g.q * 4;
#pragma unroll
            for (int h2 = 0; h2 < 2; ++h2) { f32x4 gg = acc[mi][2 * h2], uu = acc[mi][2 * h2 + 1], o;
#pragma unroll
                for (int r = 0; r < 4; ++r) o[r] = w * (gg[r] / (1.0f + __expf(-gg[r]))) * uu[r];
                store4bf(d + h2 * 16, o); }
        }
    }
}
template <bool DUMMY = false>
__device__ __forceinline__ void moe_down_tile(const Params& p, char* lds, int l, int pr, int mt, int nt, int n) {
    const TileGeom g = tile_geom();
    int e1, e2; pair_experts(pr, e1, e2);
    const int* lst = p.list + (size_t)pr * TT + mt * 128;
    const int navail = n - mt * 128;
    const bf16_t* arow[4];
#pragma unroll
    for (int i = 0; i < 4; ++i) { int r = g.drow(i); if (r >= navail) r = navail - 1; arow[i] = p.HE + (size_t)lst[r] * HE_W + g.dchunk(i) * 8; }
    const bf16_t* B1 = p.Wt_d + ((size_t)(l * N_EXPERTS + e1) * D_MODEL + nt * 128) * D_EXPERT;
    const bf16_t* B2 = p.Wt_d + ((size_t)(l * N_EXPERTS + e2) * D_MODEL + nt * 128) * D_EXPERT;
    constexpr int KT1 = D_EXPERT / 64;
    f32x4 acc[4][4];
    gemm_mainloop(lds, g, HE_W / 64, [&](int i, int kt) { return arow[i] + kt * 64; },
                  [&](int i, int kt) { return (kt < KT1 ? B1 + kt * 64 : B2 + (kt - KT1) * 64) + (size_t)g.drow(i) * D_EXPERT + g.dchunk(i) * 8; }, acc);
#pragma unroll
    for (int mi = 0; mi < 4; ++mi) {
        const int rl = g.wr * 64 + mi * 16 + g.l15;
        if (rl < navail) {
            const int row = lst[rl]; float* xo = xrow_cur(p, row); const float* gate = modp(p, l, row, 5);
#pragma unroll
            for (int ni = 0; ni < 4; ++ni) { const int col = nt * 128 + g.wc * 64 + ni * 16 + g.q * 4; float* dst = DUMMY ? (float*)p.QA + (size_t)row * D_MODEL : xo; *(f32x4*)(dst + col) = *(const f32x4*)(xo + col) + *(const f32x4*)(gate + col) * acc[mi][ni]; }
        }
    }
}
__device__ __forceinline__ void ph_moe_up(const Params& p, char* lds, int l, int bid, int nb) {
    int pr, mt, nt, n; const bool xl = (nb & 7) == 0;
    for (int t = xl ? bid >> 3 : bid; xl ? moe_tile_lookup_xcd<16>(p.cnt + l * 32, bid & 7, t, pr, mt, nt, n) : moe_tile_lookup<16>(p.cnt + l * 32, t, pr, mt, nt, n); t += xl ? nb >> 3 : nb) moe_up_tile(p, lds, l, pr, mt, nt, n);
}
template <bool DUMMY = false>
__device__ __forceinline__ void ph_moe_down(const Params& p, char* lds, int l, int bid, int nb) {
    int pr, mt, nt, n; const bool xl = (nb & 7) == 0;
    for (int t = xl ? bid >> 3 : bid; xl ? moe_tile_lookup_xcd<8>(p.cnt + l * 32, bid & 7, t, pr, mt, nt, n) : moe_tile_lookup<8>(p.cnt + l * 32, t, pr, mt, nt, n); t += xl ? nb >> 3 : nb) moe_down_tile<DUMMY>(p, lds, l, pr, mt, nt, n);
}
typedef float f32x2 __attribute__((ext_vector_type(2)));
typedef __bf16 bf16x2_t __attribute__((ext_vector_type(2)));
__device__ __forceinline__ unsigned cvtpk(float lo, float hi) { f32x2 v = {lo, hi}; bf16x2_t b = __builtin_convertvector(v, bf16x2_t); return __builtin_bit_cast(unsigned, b); }
__device__ __forceinline__ int crow(int r, int hi) { return (r & 3) + 8 * (r >> 2) + 4 * hi; }
constexpr float LOG2E = 1.4426950408889634f;
constexpr float QK_C = ATTN_SCALE * LOG2E;
constexpr float NEG_BIG = -1e30f;

__device__ __forceinline__ float max3f(float a, float b, float c) { float r; asm("v_max3_f32 %0, %1, %2, %3" : "=v"(r) : "v"(a), "v"(b), "v"(c)); return r; }
constexpr float ATT_THR = 8.0f;
template <int MODE>
__device__ __forceinline__ void attn_unit(char* lds, const bf16_t* Qp, const bf16_t* Kp, const bf16_t* Vt, bf16_t* Op, int s0, int nctx, int lt0, int nlat, float sink2, bool has_sink, const float* rpb_h) {
    int tid_ = threadIdx.x; asm volatile("" : "+v"(tid_));
    const int tid = tid_, lane = tid & 63, wid = __builtin_amdgcn_readfirstlane(tid >> 6), l31 = lane & 31, hi = lane >> 5;
    float* bias_s = (float*)(lds + 65536);
    if (MODE == 2 && rpb_h) { for (int i = tid; i < 15 * 31; i += NTHREADS) bias_s[i] = rpb_h[i] * LOG2E; }
    const int ntiles = nctx + nlat;
    LAS char* l3 = (LAS char*)lds;
    const int drow0 = wid * 16 + (lane >> 3);
    const int dch0 = (lane & 7) ^ (((lane >> 4) + 0) & 7), dch1 = (lane & 7) ^ (((lane >> 4) + 4) & 7);
    const bf16_t* ksrc0 = Kp + (size_t)drow0 * 64 + dch0 * 8; const bf16_t* ksrc1 = Kp + (size_t)(drow0 + 8) * 64 + dch1 * 8;
    const bf16_t* vsrc0 = Vt + (size_t)drow0 * LKV + dch0 * 8; const bf16_t* vsrc1 = Vt + (size_t)(drow0 + 8) * LKV + dch1 * 8;
    const int ddst = wid * 2048;
    auto tile_pos = [&](int j) { return j < nctx ? 64 * j : CTX_LEN + 64 * (lt0 + j - nctx); };
#define ATT_DMA(j_, slot_) do { const int pos_ = tile_pos(j_); \
        __builtin_amdgcn_global_load_lds((const unsigned*)(ksrc0 + (size_t)pos_ * 64), (LAS unsigned*)(l3 + (slot_) * 8192 + ddst), 16, 0, 0); \
        __builtin_amdgcn_global_load_lds((const unsigned*)(ksrc1 + (size_t)pos_ * 64), (LAS unsigned*)(l3 + (slot_) * 8192 + ddst + 1024), 16, 0, 0); \
        __builtin_amdgcn_global_load_lds((const unsigned*)(vsrc0 + pos_), (LAS unsigned*)(l3 + 32768 + (slot_) * 8192 + ddst), 16, 0, 0); \
        __builtin_amdgcn_global_load_lds((const unsigned*)(vsrc1 + pos_), (LAS unsigned*)(l3 + 32768 + (slot_) * 8192 + ddst + 1024), 16, 0, 0); } while (0)
    const int x = (l31 >> 1) & 7;
    const int kofs = l31 * 128 + ((hi ^ x) << 4);
    const int vofs = 32768 + l31 * 128 + (x << 4) + 8 * hi;
    bf16x8 qf[4];
    { const bf16_t* qr = Qp + (size_t)(wid * 32 + l31) * 512 + hi * 8;
#pragma unroll
      for (int s = 0; s < 4; ++s) { const u32x4 raw = *(const u32x4*)(qr + s * 16); u32x4 sc;
#pragma unroll
          for (int e = 0; e < 4; ++e) { const float lo = __builtin_bit_cast(float, raw[e] << 16) * QK_C, hi2 = __builtin_bit_cast(float, raw[e] & 0xffff0000u) * QK_C; sc[e] = cvtpk(lo, hi2); }
          qf[s] = __builtin_bit_cast(bf16x8, sc); } }
#define ATT_WAIT(need_, last_) do { const int lastt_ = (last_) < ntiles - 1 ? (last_) : ntiles - 1; const int ahead_ = lastt_ - (need_); \
        if (ahead_ >= 2) asm volatile("s_waitcnt vmcnt(8) lgkmcnt(0)" ::: "memory"); else if (ahead_ == 1) asm volatile("s_waitcnt vmcnt(4) lgkmcnt(0)" ::: "memory"); \
        else asm volatile("s_waitcnt vmcnt(0) lgkmcnt(0)" ::: "memory"); } while (0)
    ATT_DMA(0, 0);
    if (ntiles > 1) ATT_DMA(1, 1);
    if (ntiles > 2) ATT_DMA(2, 2);
    f32x16 o0 = {}, o1 = {};
    f32x16 negm = {};
    float mref = 0.f, l = 0.f;
    const int sq = s0 + wid * 32 + l31;
    int rq = 0, cq = 0, rsq = 0, csq = 0;
    if (MODE == 2) { rq = sq / GRID_W; cq = sq % GRID_W; rsq = rq - B_WIN_H / 2; rsq = rsq < 0 ? 0 : (rsq > GRID_H - B_WIN_H ? GRID_H - B_WIN_H : rsq); csq = cq - B_WIN_W / 2; csq = csq < 0 ? 0 : (csq > GRID_W - B_WIN_W ? GRID_W - B_WIN_W : csq); }
    ATT_WAIT(0, 2);
    __builtin_amdgcn_s_barrier(); asm volatile("" ::: "memory");
    int slot = 0;
    for (int j = 0; j < ntiles; ++j) {
        const int slot1 = (slot + 1) & 3, slot3 = (slot + 3) & 3;
        if (j + 3 < ntiles) ATT_DMA(j + 3, slot3);
        const char* Kb = lds + slot * 8192; const char* Vb = lds + slot * 8192;
        f32x16 p0, p1;
#pragma unroll
        for (int s = 0; s < 4; ++s) {
            const bf16x8 k0 = *(const bf16x8*)(Kb + (kofs ^ (s << 5))); const bf16x8 k1 = *(const bf16x8*)(Kb + 4096 + (kofs ^ (s << 5)));
            if (s == 0) { p0 = __builtin_amdgcn_mfma_f32_32x32x16_bf16(k0, qf[0], negm, 0, 0, 0); p1 = __builtin_amdgcn_mfma_f32_32x32x16_bf16(k1, qf[0], negm, 0, 0, 0); }
            else { p0 = __builtin_amdgcn_mfma_f32_32x32x16_bf16(k0, qf[s], p0, 0, 0, 0); p1 = __builtin_amdgcn_mfma_f32_32x32x16_bf16(k1, qf[s], p1, 0, 0, 0); }
        }
        asm volatile("s_nop 15\n\ts_nop 7" : "+v"(p0), "+v"(p1));
        if (MODE == 1 && j >= nctx) {
            const int sk0 = 64 * (lt0 + j - nctx);
#pragma unroll
            for (int r = 0; r < 16; ++r) { const int d0 = sk0 + crow(r, hi) - sq, d1 = d0 + 32;
                p0[r] = (d0 >= -A_WINDOW && d0 <= A_WINDOW) ? p0[r] : NEG_BIG; p1[r] = (d1 >= -A_WINDOW && d1 <= A_WINDOW) ? p1[r] : NEG_BIG; }
        } else if (MODE == 2 && j >= nctx) {
            const int kr = lt0 + j - nctx; const bool rowok = kr >= rsq && kr < rsq + B_WIN_H;
            const float* brow = bias_s + (kr - rq + B_WIN_H - 1) * 31 + (B_WIN_W - 1) - cq;
#pragma unroll
            for (int r = 0; r < 16; ++r) { const int kc0 = crow(r, hi), kc1 = kc0 + 32;
                const bool ok0 = rowok && kc0 >= csq && kc0 < csq + B_WIN_W, ok1 = rowok && kc1 >= csq && kc1 < csq + B_WIN_W;
                p0[r] = ok0 ? p0[r] + brow[kc0] : NEG_BIG; p1[r] = ok1 ? p1[r] + brow[kc1] : NEG_BIG; }
        }
        float ta = max3f(p0[0], p0[1], p1[0]), tb = max3f(p0[2], p0[3], p1[1]); ta = max3f(ta, p1[2], p1[3]);
#pragma unroll
        for (int r = 4; r < 16; r += 4) { ta = max3f(ta, p0[r], p0[r + 1]); tb = max3f(tb, p0[r + 2], p0[r + 3]); ta = max3f(ta, p1[r], p1[r + 1]); tb = max3f(tb, p1[r + 2], p1[r + 3]); }
        float tmax = fmaxf(ta, tb); tmax = fmaxf(tmax, __shfl_xor(tmax, 32));
        if (j == 0 || __any(tmax > ATT_THR)) {
            const float dl = j == 0 ? tmax : fmaxf(tmax, 0.f);
            mref += dl;
#pragma unroll
            for (int r = 0; r < 16; ++r) { p0[r] -= dl; p1[r] -= dl; negm[r] = -mref; }
            if (j > 0) { const float f = __builtin_amdgcn_exp2f(-dl); l *= f;
#pragma unroll
                for (int r = 0; r < 16; ++r) { o0[r] *= f; o1[r] *= f; } }
        }
        f32x2 lsum = {0.f, 0.f};
#pragma unroll
        for (int r = 0; r < 16; r += 2) { p0[r] = __builtin_amdgcn_exp2f(p0[r]); p0[r + 1] = __builtin_amdgcn_exp2f(p0[r + 1]); p1[r] = __builtin_amdgcn_exp2f(p1[r]); p1[r + 1] = __builtin_amdgcn_exp2f(p1[r + 1]);
            lsum += (f32x2){p0[r], p0[r + 1]}; lsum += (f32x2){p1[r], p1[r + 1]}; }
        l += lsum.x + lsum.y;
        bf16x8 pf[4];
        { u32x4 w;
          w.x = cvtpk(p0[0], p0[1]); w.y = cvtpk(p0[2], p0[3]); w.z = cvtpk(p0[4], p0[5]); w.w = cvtpk(p0[6], p0[7]); pf[0] = __builtin_bit_cast(bf16x8, w);
          w.x = cvtpk(p0[8], p0[9]); w.y = cvtpk(p0[10], p0[11]); w.z = cvtpk(p0[12], p0[13]); w.w = cvtpk(p0[14], p0[15]); pf[1] = __builtin_bit_cast(bf16x8, w);
          w.x = cvtpk(p1[0], p1[1]); w.y = cvtpk(p1[2], p1[3]); w.z = cvtpk(p1[4], p1[5]); w.w = cvtpk(p1[6], p1[7]); pf[2] = __builtin_bit_cast(bf16x8, w);
          w.x = cvtpk(p1[8], p1[9]); w.y = cvtpk(p1[10], p1[11]); w.z = cvtpk(p1[12], p1[13]); w.w = cvtpk(p1[14], p1[15]); pf[3] = __builtin_bit_cast(bf16x8, w); }
#pragma unroll
        for (int s = 0; s < 4; ++s) {
            const int a0 = vofs ^ (s << 5);
            u32x2 va = *(const u32x2*)(Vb + a0), vb = *(const u32x2*)(Vb + (a0 ^ 16));
            u32x2 vc = *(const u32x2*)(Vb + 4096 + a0), vd = *(const u32x2*)(Vb + 4096 + (a0 ^ 16));
            const bf16x8 f0 = __builtin_bit_cast(bf16x8, (u32x4){va.x, va.y, vb.x, vb.y}), f1 = __builtin_bit_cast(bf16x8, (u32x4){vc.x, vc.y, vd.x, vd.y});
            o0 = __builtin_amdgcn_mfma_f32_32x32x16_bf16(f0, pf[s], o0, 0, 0, 0); o1 = __builtin_amdgcn_mfma_f32_32x32x16_bf16(f1, pf[s], o1, 0, 0, 0);
        }
        ATT_WAIT(j + 1, j + 3);
        __builtin_amdgcn_s_barrier(); asm volatile("" ::: "memory");
        slot = slot1;
    }
#undef ATT_DMA
#undef ATT_WAIT
    l += __shfl_xor(l, 32);
    if (has_sink) l += __builtin_amdgcn_exp2f(sink2 - mref);
    const float inv = 1.0f / l;
    bf16_t* orow = Op + (size_t)(wid * 32 + l31) * 1024;
#pragma unroll
    for (int g4 = 0; g4 < 4; ++g4) {
        u32x2 w; w.x = cvtpk(o0[g4 * 4 + 0] * inv, o0[g4 * 4 + 1] * inv); w.y = cvtpk(o0[g4 * 4 + 2] * inv, o0[g4 * 4 + 3] * inv); *(u32x2*)(orow + 8 * g4 + 4 * hi) = w;
        w.x = cvtpk(o1[g4 * 4 + 0] * inv, o1[g4 * 4 + 1] * inv); w.y = cvtpk(o1[g4 * 4 + 2] * inv, o1[g4 * 4 + 3] * inv); *(u32x2*)(orow + 32 + 8 * g4 + 4 * hi) = w;
    }
    asm volatile("s_waitcnt vmcnt(0)" ::: "memory");
}

constexpr int NU_LAT = BATCH * 8 * (SEQ / 128);
constexpr int NU_CTX = BATCH * 8 * (CTX_LEN / 128);
static_assert(BATCH * 2 == 8, "the XCD-local unit order maps the 8 (batch, kv head) K/V streams onto the 8 XCD groups");
__device__ __forceinline__ void ph_attn0(const Params& p, char* lds, bool xl, int x, int lb, int lstep) {
    const int bid = xl ? x + 8 * lb : lb, nb = xl ? 8 * lstep : lstep;
    constexpr int NQB = SEQ / 128;
    for (int v = xl ? lb : bid; v < (xl ? BATCH * NQB : NU_LAT); v += xl ? lstep : nb) {
        int blk, h, b; if (xl) { blk = v % NQB; b = v / NQB; h = x; } else { blk = v % NQB; h = (v / NQB) % 8; b = v / (8 * NQB); }
        const int s0 = blk * 128, r0 = s0 / GRID_W;
        int rs0 = r0 - 4; rs0 = rs0 < 0 ? 0 : (rs0 > GRID_H - 8 ? GRID_H - 8 : rs0); int rs1 = r0 + 1 - 4; rs1 = rs1 < 0 ? 0 : (rs1 > GRID_H - 8 ? GRID_H - 8 : rs1);
        attn_unit<2>(lds, p.QB + (size_t)(b * SEQ + s0) * 512 + h * 64, p.KB + (size_t)(b * 8 + h) * LKV * 64, p.VBt + (size_t)(b * 8 + h) * 64 * LKV,
                     p.Y + (size_t)(b * SEQ + s0) * 1024 + 512 + h * 64, s0, CTX_LEN / 64, rs0, rs1 + 8 - rs0, 0.f, false, (xl && v != lb) ? nullptr : p.b_rpb + h * 15 * 31);
    }
    for (int v = xl ? lb : bid; v < (xl ? 4 * NQB : NU_LAT); v += xl ? lstep : nb) {
        int blk, h, b; if (xl) { blk = v % NQB; b = x >> 1; h = (x & 1) * 4 + v / NQB; } else { blk = v % NQB; h = (v / NQB) % 8; b = v / (8 * NQB); }
        const int s0 = blk * 128;
        int t0 = (s0 - 128) / 64; if (t0 < 0) t0 = 0; int t1 = (s0 + 255) / 64; if (t1 > SEQ / 64 - 1) t1 = SEQ / 64 - 1;
        attn_unit<1>(lds, p.QA + (size_t)(b * SEQ + s0) * 512 + h * 64, p.KA + (size_t)(b * 2 + h / 4) * LKV * 64, p.VAt + (size_t)(b * 2 + h / 4) * 64 * LKV,
                     p.Y + (size_t)(b * SEQ + s0) * 1024 + h * 64, s0, CTX_LEN / 64, t0, t1 - t0 + 1, p.a_sink[h] * LOG2E, true, nullptr);
    }
    for (int u = bid; u < 2 * NU_CTX; u += nb) {
        const int ty = u / NU_CTX, w = u % NU_CTX; const int blk = w % (CTX_LEN / 128), h = (w / (CTX_LEN / 128)) % 8, b = w / (8 * (CTX_LEN / 128));
        const int row0 = TX + b * CTX_LEN + blk * 128;
        const bf16_t* Qp = (ty == 0 ? p.QA : p.QB) + (size_t)row0 * 512 + h * 64;
        const bf16_t* Kp = ty == 0 ? p.KA + (size_t)(b * 2 + h / 4) * LKV * 64 : p.KB + (size_t)(b * 8 + h) * LKV * 64;
        const bf16_t* Vp = ty == 0 ? p.VAt + (size_t)(b * 2 + h / 4) * 64 * LKV : p.VBt + (size_t)(b * 8 + h) * 64 * LKV;
        attn_unit<0>(lds, Qp, Kp, Vp, p.Y + (size_t)row0 * 1024 + ty * 512 + h * 64, 0, CTX_LEN / 64, 0, 0, ty == 0 ? p.a_sink[h] * LOG2E : 0.f, ty == 0, nullptr);
    }
}
__device__ __forceinline__ void ph_attnC(const Params& p, char* lds, int bid, int nb) {
    const bool xl = (nb & 7) == 0; const int x = bid & 7, lb = bid >> 3, lstep = nb >> 3;
    constexpr int NQB = SEQ / 128;
    for (int v = xl ? lb : bid; v < (xl ? 4 * NQB : NU_LAT); v += xl ? lstep : nb) {
        int blk, h, b; if (xl) { blk = v % NQB; b = x >> 1; h = (x & 1) * 4 + v / NQB; } else { blk = v % NQB; h = (v / NQB) % 8; b = v / (8 * NQB); }
        const int s0 = blk * 128;
        attn_unit<0>(lds, p.QC + (size_t)(b * SEQ + s0) * 512 + h * 64, p.KC + (size_t)(b * 2 + h / 4) * LKV * 64, p.VCt + (size_t)(b * 2 + h / 4) * 64 * LKV,
                     p.Y + (size_t)(b * SEQ + s0) * 1024 + h * 64, s0, CTX_LEN / 64, 0, SEQ / 64, 0.f, false, nullptr);
    }
}
#ifdef HY_TEST
#define HY_OUT(b, t, v) p.YHT[((size_t)(b) * D_CH + c) * SEQ + (t)] = f2bf(v)
#else
#define HY_OUT(b, t, v) p.YHT[((size_t)(b) * D_CH + c) * SEQ + (t)] = f2bf(v)
#endif
#ifdef CPU_TEST
#define FOR_T for (int tid = 0; tid < 256; ++tid)
#define HSYNC
#define HY_SB()
#define HST(t) st[t]
#define HY_DECL HySt* st = new HySt[256]
#define HY_FREE delete[] st
static inline void sincos_rev(float a, float& c, float& s) { c = cosf(6.283185307179586f * a); s = sinf(6.283185307179586f * a); }
#else
__device__ __forceinline__ int hy_launder(int v) { asm volatile("" : "+v"(v)); return v; }
#define FOR_T if (const int tid = hy_launder((int)threadIdx.x); true)
#define HSYNC __syncthreads()
#define HY_SB() __builtin_amdgcn_sched_barrier(0)
#define HST(t) st
#define HY_DECL HySt st
#define HY_FREE
__device__ __forceinline__ void sincos_rev(float a, float& c, float& s) { c = __builtin_amdgcn_cosf(a); s = __builtin_amdgcn_sinf(a); }
#endif
constexpr int FN = 2 * SEQ;
constexpr int FPAD = FN + (FN >> 5);
#if !defined(SMALL_CFG)
static_assert(FN == 8192, "pass plan 8,8,8,16 is for N = 8192");
constexpr int R4 = 32;
constexpr int NS4 = 256;
#else
constexpr int R4 = 2;
constexpr int NS4 = 512;
#endif
constexpr int NB8 = FN / 8 / 256;
constexpr int NB4 = FN / R4 / 256;
constexpr int EPT = FN / 256;
struct HySt { float xr[EPT], xi[EPT]; unsigned kp[EPT]; };
HD unsigned hy_pack(float r, float i) { return (unsigned)f2bf(r) | ((unsigned)f2bf(i) << 16); }
HD float hy_lo(unsigned v) { unsigned u = v << 16; float f; __builtin_memcpy(&f, &u, 4); return f; }
HD float hy_hi(unsigned v) { unsigned u = v & 0xffff0000u; float f; __builtin_memcpy(&f, &u, 4); return f; }
HD int pidx(int i) { return i + (i >> 5); }

constexpr float W32C[16] = {1.0f, 0.9807852804032304f, 0.9238795325112867f, 0.8314696123025452f, 0.7071067811865476f, 0.5555702330196022f, 0.3826834323650898f, 0.19509032201612825f,
                            0.0f, -0.19509032201612825f, -0.3826834323650898f, -0.5555702330196022f, -0.7071067811865476f, -0.8314696123025452f, -0.9238795325112867f, -0.9807852804032304f};
constexpr float W32S[16] = {0.0f, -0.19509032201612825f, -0.3826834323650898f, -0.5555702330196022f, -0.7071067811865476f, -0.8314696123025452f, -0.9238795325112867f, -0.9807852804032304f,
                            -1.0f, -0.9807852804032304f, -0.9238795325112867f, -0.8314696123025452f, -0.7071067811865476f, -0.5555702330196022f, -0.3826834323650898f, -0.19509032201612825f};
constexpr float W16C[8] = {1.0f, 0.9238795325112867f, 0.7071067811865476f, 0.3826834323650898f, 0.0f, -0.3826834323650898f, -0.7071067811865476f, -0.9238795325112867f};
constexpr float W16S[8] = {0.0f, -0.3826834323650898f, -0.7071067811865476f, -0.9238795325112867f, -1.0f, -0.9238795325112867f, -0.7071067811865476f, -0.3826834323650898f};
template <int R> HD void fft_reg(float* xr, float* xi) {
    constexpr int LG = R == 32 ? 5 : (R == 16 ? 4 : (R == 8 ? 3 : (R == 4 ? 2 : 1)));
#pragma unroll
    for (int sg = 0; sg < LG; ++sg) {
        const int h = (R / 2) >> sg;
#pragma unroll
        for (int pr = 0; pr < R / 2; ++pr) {
            const int blk = (pr / h) * 2 * h, i = pr % h;
            const int a = blk + i, b = blk + i + h;
            const float ar = xr[a], ai = xi[a], br = xr[b], bi = xi[b];
            xr[a] = ar + br; xi[a] = ai + bi;
            const float tr = ar - br, ti = ai - bi;
            const int tw = i * (16 / h);
            if (tw == 0) { xr[b] = tr; xi[b] = ti; }
            else if (tw == 8) { xr[b] = ti; xi[b] = -tr; }
            else { const float c = W32C[tw & 15], s = W32S[tw & 15]; xr[b] = tr * c - ti * s; xi[b] = tr * s + ti * c; }
        }
    }
}
template <int R> HD constexpr int bitrev(int i) { int r = 0; for (int b = 1; b < R; b <<= 1) { r = (r << 1) | (i & 1); i >>= 1; } return r; }

template <int R, int NB, class In> HD void pass_load(int tid, HySt& s, const In& in) {
#pragma unroll
    for (int b = 0; b < NB; ++b)
#pragma unroll
        for (int r = 0; r < R; ++r) in(tid + 256 * b + (FN / R) * r, r, s.xr[b * R + r], s.xi[b * R + r]);
}
template <int R, int NB, class Out> HD void pass_compute(int tid, HySt& s, int Ns, const Out& out) {
#pragma unroll
    for (int b = 0; b < NB; ++b) {
        const int j = tid + 256 * b, k = j & (Ns - 1);
        float* xr = s.xr + b * R; float* xi = s.xi + b * R;
        if (Ns > 1) {
            float wc, ws; sincos_rev(-(float)k / (float)(Ns * R), wc, ws);
            float cr = wc, ci = ws;
#pragma unroll
            for (int r = 1; r < R; ++r) {
                const float vr = xr[r], vi = xi[r]; xr[r] = vr * cr - vi * ci; xi[r] = vr * ci + vi * cr;
                const float nr = cr * wc - ci * ws, ni = cr * ws + ci * wc; cr = nr; ci = ni;
            }
        }
        fft_reg<R>(xr, xi);
        const int j0 = (j - k) * R + k;
#pragma unroll
        for (int i = 0; i < R; ++i) out(j0 + bitrev<R>(i) * Ns, b, bitrev<R>(i), xr[i], xi[i]);
    }
}
template <int R, int NB> HD void pass_load_lds(int tid, HySt& s, const float* re, const float* im) {
    const int base = pidx(tid);
#pragma unroll
    for (int b = 0; b < NB; ++b)
#pragma unroll
        for (int r = 0; r < R; ++r) { const int C = 256 * b + (FN / R) * r; s.xr[b * R + r] = re[base + C + (C >> 5)]; s.xi[b * R + r] = im[base + C + (C >> 5)]; }
}
template <int R, int NB, int NS> HD void pass_compute_lds(int tid, HySt& s, float* re, float* im) {
    static_assert((NS % 32 == 0) || (R == 8 && (NS == 1 || NS == 8)) || (R == 16 && (NS == 1 || NS == 16)), "no-carry condition of the padded index");
#pragma unroll
    for (int b = 0; b < NB; ++b) {
        const int j = tid + 256 * b, k = j & (NS - 1);
        float* xr = s.xr + b * R; float* xi = s.xi + b * R;
        if (NS > 1) {
            float wc, ws; sincos_rev(-(float)k / (float)(NS * R), wc, ws);
            float cr = wc, ci = ws;
#pragma unroll
            for (int r = 1; r < R; ++r) {
                const float vr = xr[r], vi = xi[r]; xr[r] = vr * cr - vi * ci; xi[r] = vr * ci + vi * cr;
                const float nr = cr * wc - ci * ws, ni = cr * ws + ci * wc; cr = nr; ci = ni;
            }
        }
        fft_reg<R>(xr, xi);
        const int pj0 = pidx((j - k) * R + k);
#pragma unroll
        for (int i = 0; i < R; ++i) { const int C = bitrev<R>(i) * NS; re[pj0 + C + (C >> 5)] = xr[i]; im[pj0 + C + (C >> 5)] = xi[i]; }
        HY_SB();
    }
}
struct LdsIn { const float* re; const float* im; HD void operator()(int idx, int, float& r, float& i) const { r = re[pidx(idx)]; i = im[pidx(idx)]; } };
struct LdsOut { float* re; float* im; HD void operator()(int idx, int, int, float r, float i) const { re[pidx(idx)] = r; im[pidx(idx)] = i; } };

HD void hy_pre_load(const Params& p, int c, int b, int tid, float* lds) {
#pragma unroll
    for (int q = 0; q < 3; ++q) {
        const bf16_t* u = p.UT + ((size_t)b * 3 * D_CH + q * D_CH + c) * SEQ; const int t0 = tid * 16;
        const float w0 = p.hy_short_w[0 * 3 * D_CH + q * D_CH + c], w1 = p.hy_short_w[1 * 3 * D_CH + q * D_CH + c], w2 = p.hy_short_w[2 * 3 * D_CH + q * D_CH + c], sb = p.hy_short_b[q * D_CH + c];
        unsigned w[8];
        { const unsigned* u32p = (const unsigned*)(u + t0);
#pragma unroll
          for (int i = 0; i < 8; ++i) w[i] = u32p[i]; }
        float x[18];
        x[0] = t0 > 0 ? bf2f(u[t0 - 1]) : 0.f; x[17] = t0 + 16 < SEQ ? bf2f(u[t0 + 16]) : 0.f;
#pragma unroll
        for (int i = 0; i < 8; ++i) { x[1 + 2 * i] = bf2f((bf16_t)(w[i] & 0xffffu)); x[2 + 2 * i] = bf2f((bf16_t)(w[i] >> 16)); }
#pragma unroll
        for (int i = 0; i < 16; ++i) lds[q * SEQ + t0 + i] = sb + w0 * x[i] + w1 * x[i + 1] + w2 * x[i + 2];
    }
}
HD void hy_pre_store(const Params& p, int c, int b, int tid, const float* lds) {
#pragma unroll
    for (int q = 0; q < 3; ++q) {
        unsigned* u = (unsigned*)(p.UT + ((size_t)b * 3 * D_CH + q * D_CH + c) * SEQ + tid * 16);
#pragma unroll
        for (int i = 0; i < 8; ++i) u[i] = (unsigned)f2bf(lds[q * SEQ + tid + 256 * (2 * i)]) | ((unsigned)f2bf(lds[q * SEQ + tid + 256 * (2 * i + 1)]) << 16);
    }
}
HD void tm_load_bf16(const bf16_t* row, int tid, unsigned (&w)[8]) { const unsigned* q = (const unsigned*)(row + tid * 16);
#pragma unroll
    for (int i = 0; i < 8; ++i) w[i] = q[i]; }
HD float tm_get(const unsigned (&w)[8], int m) { return bf2f((bf16_t)((m & 1) ? (w[m >> 1] >> 16) : (w[m >> 1] & 0xffffu))); }
HD int tm_ofs(int idx) { return (idx & 255) * 16 + (idx >> 8); }

HD void hyena_channel(const Params& p, int c, float* lds) {
    HY_DECL;
    float* re = lds; float* im = lds + FPAD;
    const LdsIn lin{re, im}; const LdsOut lout{re, im};
    for (int b = 0; b < BATCH; ++b) { FOR_T { hy_pre_load(p, c, b, tid, lds); } HSYNC; FOR_T { hy_pre_store(p, c, b, tid, lds); } HSYNC; }
    float nrm[2];
#pragma unroll
    for (int o = 0; o < 2; ++o) {
        const float* hf = p.HFT + (size_t)((0 * 2 + o) * D_CH + c) * SEQ; const float* hb = p.HFT + (size_t)((1 * 2 + o) * D_CH + c) * SEQ;
        FOR_T { float sacc = 0.f; for (int i = 0; i < SEQ / 256; ++i) sacc += fabsf(hf[tid + 256 * i]) + fabsf(hb[tid + 256 * i]); re[tid] = sacc; }
        HSYNC;
        { float tot = 0.f; for (int i = 0; i < 256; ++i) tot += re[i]; nrm[o] = tot + EPS; }
        HSYNC;
    }
    float sw[3][3], sbv[3];
#pragma unroll
    for (int q = 0; q < 3; ++q) { sbv[q] = p.hy_short_b[q * D_CH + c];
#pragma unroll
        for (int kk = 0; kk < 3; ++kk) sw[q][kk] = p.hy_short_w[kk * 3 * D_CH + q * D_CH + c]; }
#pragma unroll 1
    for (int o = 0; o < 2; ++o) {
        const float* hf = p.HFT + (size_t)((0 * 2 + o) * D_CH + c) * SEQ; const float* hb = p.HFT + (size_t)((1 * 2 + o) * D_CH + c) * SEQ;
        const float inv = 1.0f / (o == 0 ? nrm[0] : nrm[1]); const float hbias = p.hy_bias[o * D_CH + c];
        float swg[3]; swg[0] = o == 0 ? sw[1][0] : sw[2][0]; swg[1] = o == 0 ? sw[1][1] : sw[2][1]; swg[2] = o == 0 ? sw[1][2] : sw[2][2]; const float sbg = o == 0 ? sbv[1] : sbv[2];
        FOR_T { pass_load<16, 2>(tid, HST(tid), [&](int idx, int r8, float& r, float& i) __attribute__((always_inline)) { if (r8 < 8) r = hf[idx] * inv; else { const int q = FN - idx; const float hv = hb[q < SEQ ? q : 0]; r = q < SEQ ? hv * inv : 0.f; } i = 0.f; });
                pass_compute_lds<16, 2, 1>(tid, HST(tid), re, im); }
        HSYNC;
        FOR_T { pass_load_lds<16, 2>(tid, HST(tid), re, im); } HSYNC; FOR_T { pass_compute_lds<16, 2, 16>(tid, HST(tid), re, im); } HSYNC;
        FOR_T { pass_load_lds<R4, NB4>(tid, HST(tid), re, im);
                HySt& s = HST(tid); pass_compute<R4, NB4>(tid, s, NS4, [&](int, int b, int rr, float r, float i) __attribute__((always_inline)) { s.kp[b + NB4 * rr] = hy_pack(r, i); }); }
        HSYNC;
        for (int bp = 0; bp < BATCH / 2; ++bp) {
            const int b0 = 2 * bp, b1 = 2 * bp + 1;
            const bf16_t* u0 = p.UT + ((size_t)b0 * 3 * D_CH + c) * SEQ; const bf16_t* u1 = p.UT + ((size_t)b1 * 3 * D_CH + c) * SEQ;
            const float* z0 = p.Z1 + ((size_t)b0 * D_CH + c) * SEQ; const float* z1 = p.Z1 + ((size_t)b1 * D_CH + c) * SEQ;
            auto zval = [&](int b, int t) __attribute__((always_inline)) { return o == 0 ? bf2f((b == b0 ? u0 : u1)[tm_ofs(t)]) : (b == b0 ? z0 : z1)[tm_ofs(t)]; };
            FOR_T { HySt& s = HST(tid);
                    if (o == 0) { unsigned w0[8], w1[8]; tm_load_bf16(u0, tid, w0); tm_load_bf16(u1, tid, w1);
#pragma unroll
                        for (int q = 0; q < 32; ++q) { const int b = q >> 4, r = q & 15; if (r < 8) { s.xr[q] = tm_get(w0, b + 2 * r); s.xi[q] = tm_get(w1, b + 2 * r); } else { s.xr[q] = 0.f; s.xi[q] = 0.f; } } }
                    else {
#pragma unroll
                        for (int q = 0; q < 32; ++q) { const int b = q >> 4, r = q & 15; if (r < 8) { s.xr[q] = z0[tid * 16 + b + 2 * r]; s.xi[q] = z1[tid * 16 + b + 2 * r]; } else { s.xr[q] = 0.f; s.xi[q] = 0.f; } } }
                    pass_compute_lds<16, 2, 1>(tid, s, re, im); }
            HSYNC;
            FOR_T { pass_load_lds<16, 2>(tid, HST(tid), re, im); } HSYNC; FOR_T { pass_compute_lds<16, 2, 16>(tid, HST(tid), re, im); } HSYNC;
            FOR_T { pass_load_lds<R4, NB4>(tid, HST(tid), re, im); } HSYNC;
            FOR_T { HySt& s = HST(tid); pass_compute<R4, NB4>(tid, s, NS4, [&](int idx, int b, int rr, float r, float i) __attribute__((always_inline)) { const float kr = hy_lo(s.kp[b + NB4 * rr]), ki = hy_hi(s.kp[b + NB4 * rr]);
                        re[pidx(idx)] = r * kr - i * ki; im[pidx(idx)] = -(r * ki + i * kr); }); }
            HSYNC;
            FOR_T { pass_load_lds<16, 2>(tid, HST(tid), re, im); } HSYNC; FOR_T { pass_compute_lds<16, 2, 1>(tid, HST(tid), re, im); } HSYNC;
            FOR_T { pass_load_lds<16, 2>(tid, HST(tid), re, im); } HSYNC; FOR_T { pass_compute_lds<16, 2, 16>(tid, HST(tid), re, im); } HSYNC;
            FOR_T { pass_load_lds<R4, NB4>(tid, HST(tid), re, im); HySt& s = HST(tid); float yr[16], yi[16];
                    pass_compute<R4, NB4>(tid, s, NS4, [&](int, int b, int rr, float r, float i) __attribute__((always_inline)) { if (rr < 16) { yr[b + NB4 * rr] = r * (1.0f / FN); yi[b + NB4 * rr] = -i * (1.0f / FN); } });
#pragma unroll
                    for (int hb2 = 0; hb2 < 2; ++hb2) {
                        const int bb = hb2 == 0 ? b0 : b1; const float* yy = hb2 == 0 ? yr : yi;
                        const bf16_t* gp = p.UT + ((size_t)bb * 3 * D_CH + (o + 1) * D_CH + c) * SEQ;
                        unsigned gw[8]; tm_load_bf16(gp, tid, gw);
                        if (o == 0) { unsigned w[8]; tm_load_bf16(hb2 == 0 ? u0 : u1, tid, w);
                            float* zo = p.Z1 + ((size_t)bb * D_CH + c) * SEQ + tid * 16;
#pragma unroll
                            for (int m = 0; m < 16; ++m) zo[m] = tm_get(gw, m) * (yy[m] + tm_get(w, m) * hbias); }
                        else { const float* zz = hb2 == 0 ? z0 : z1;
#pragma unroll
                            for (int m = 0; m < 16; ++m) { const float zn = tm_get(gw, m) * (yy[m] + zz[tid * 16 + m] * hbias); HY_OUT(bb, tid + 256 * m, zn); } }
                        HY_SB();
                    } }
            HSYNC;
        }
    }
    HY_FREE;
}
constexpr int MOD_ITEMS = DEPTH * (6 * D_MODEL / 32);
__device__ __forceinline__ void mod_item(const Params& p, char* lds, int item) {
    float* sc = (float*)lds;
    float* red = sc + 5 * D_MODEL;
    const int tid = threadIdx.x, l = item / (6 * D_MODEL / 32), j0 = (item % (6 * D_MODEL / 32)) * 32;
    const int c4 = tid & 7, rg = tid >> 3;
    const float* w = p.w_ada + ((size_t)l * D_MODEL + rg) * 6 * D_MODEL + j0 + c4 * 4;
    f32x4 v[32];
#pragma unroll
    for (int i = 0; i < 32; ++i) v[i] = *(const f32x4*)(w + (size_t)(32 * i) * 6 * D_MODEL);
    { f32x4 cv[5];
#pragma unroll
      for (int r = 0; r < 5; ++r) cv[r] = *(const f32x4*)((r < BATCH ? p.c + r * D_MODEL : p.c_ctx) + 4 * tid);
#pragma unroll
      for (int r = 0; r < 5; ++r) { f32x4 s; s[0] = silu_f(cv[r][0]); s[1] = silu_f(cv[r][1]); s[2] = silu_f(cv[r][2]); s[3] = silu_f(cv[r][3]); *(f32x4*)(sc + r * D_MODEL + 4 * tid) = s; } }
    __syncthreads();
    f32x4 a0 = {0.f, 0.f, 0.f, 0.f}, a1 = a0, a2 = a0, a3 = a0, a4 = a0;
#pragma unroll
    for (int i = 0; i < 32; ++i) { const int kk = rg + 32 * i;
        a0 += sc[kk] * v[i]; a1 += sc[D_MODEL + kk] * v[i]; a2 += sc[2 * D_MODEL + kk] * v[i]; a3 += sc[3 * D_MODEL + kk] * v[i]; a4 += sc[4 * D_MODEL + kk] * v[i]; }
    *(f32x4*)(red + (rg * 5 + 0) * 32 + c4 * 4) = a0; *(f32x4*)(red + (rg * 5 + 1) * 32 + c4 * 4) = a1; *(f32x4*)(red + (rg * 5 + 2) * 32 + c4 * 4) = a2;
    *(f32x4*)(red + (rg * 5 + 3) * 32 + c4 * 4) = a3; *(f32x4*)(red + (rg * 5 + 4) * 32 + c4 * 4) = a4;
    __syncthreads();
    if (tid < 5 * 32) { const int r = tid / 32, cc = tid % 32; float s = 0.f;
#pragma unroll
        for (int q = 0; q < 32; ++q) s += red[(q * 5 + r) * 32 + cc];
        p.mod[((size_t)(l * (BATCH + 1) + r)) * 6 * D_MODEL + j0 + cc] = s + p.b_ada[l * 6 * D_MODEL + j0 + cc]; }
    __syncthreads();
}
constexpr int FILT_ITEMS = (SEQ / 256) * (4 * D_CH / 64);
__device__ __forceinline__ void filt_item(const Params& p, char* lds, int item) {
    float* ws = (float*)lds;
    const int tid = threadIdx.x, tb = item % (SEQ / 256), cb = item / (SEQ / 256); const int t = tb * 256 + tid, col0 = cb * 64;
#pragma unroll
    for (int i = 0; i < 16; ++i) { const int k = i * 4 + (tid >> 6), cc = tid & 63; ws[cc * 68 + k] = p.hy_w3[(size_t)k * 4 * D_CH + col0 + cc]; }
    f32x4 h[16];
#pragma unroll
    for (int i = 0; i < 16; ++i) h[i] = *(const f32x4*)(p.h2 + (size_t)t * HY_FFN + i * 4);
    __syncthreads();
    const float tn = (float)t / (float)(SEQ - 1);
    const float mind = logf(1e-2f) / 1.5f, maxd = logf(1e-2f) / 0.3f;
#pragma unroll 2
    for (int cc = 0; cc < 64; ++cc) {
        const int col = col0 + cc; const f32x4* w = (const f32x4*)(ws + cc * 68);
        float acc = p.hy_b3[col];
#pragma unroll
        for (int i = 0; i < 16; ++i) { const f32x4 wv = w[i]; acc += h[i][0] * wv[0] + h[i][1] * wv[1] + h[i][2] * wv[2] + h[i][3] * wv[3]; }
        const float delta = fabsf(mind + (float)(col % D_CH) * (maxd - mind) / (float)(D_CH - 1));
        p.HFT[(size_t)col * SEQ + t] = acc * expf(-tn * delta);
    }
    __syncthreads();
}
__device__ __forceinline__ void ph_norm(const Params& p, int l, int which, int nrows, int bid, int nb) {
    const int lane = threadIdx.x & 63, wid = threadIdx.x >> 6;
    const float* g = p.norm_g + (l * 2 + which) * D_MODEL;
    for (int row = (bid * 4 + wid) * 2; row < nrows; row += nb * 8) {
        const int row1 = row + 1 < nrows ? row + 1 : row;
        const float* xa = which == 0 ? xrow_in(p, l, row) : xrow_cur(p, row); const float* xb = which == 0 ? xrow_in(p, l, row1) : xrow_cur(p, row1);
        f32x4 va[4], vb[4]; float sa = 0.f, sb = 0.f;
#pragma unroll
        for (int j = 0; j < 4; ++j) { va[j] = *(const f32x4*)(xa + j * 256 + lane * 4); vb[j] = *(const f32x4*)(xb + j * 256 + lane * 4); }
#pragma unroll
        for (int j = 0; j < 4; ++j) { sa += va[j][0] * va[j][0] + va[j][1] * va[j][1] + va[j][2] * va[j][2] + va[j][3] * va[j][3]; sb += vb[j][0] * vb[j][0] + vb[j][1] * vb[j][1] + vb[j][2] * vb[j][2] + vb[j][3] * vb[j][3]; }
        const float ra = 1.0f / sqrtf(wave_sum(sa) * (1.0f / D_MODEL) + EPS), rb = 1.0f / sqrtf(wave_sum(sb) * (1.0f / D_MODEL) + EPS);
        const float* sha = modp(p, l, row, which * 3 + 0); const float* sca = modp(p, l, row, which * 3 + 1);
        const float* shb = modp(p, l, row1, which * 3 + 0); const float* scb = modp(p, l, row1, which * 3 + 1);
#pragma unroll
        for (int j = 0; j < 4; ++j) { const int c = j * 256 + lane * 4; const f32x4 gv = *(const f32x4*)(g + c);
            store4bf(p.hbuf + (size_t)row * D_MODEL + c, va[j] * ra * gv * (*(const f32x4*)(sca + c) + 1.0f) + *(const f32x4*)(sha + c));
            if (row1 != row) store4bf(p.hbuf + (size_t)row1 * D_MODEL + c, vb[j] * rb * gv * (*(const f32x4*)(scb + c) + 1.0f) + *(const f32x4*)(shb + c)); }
    }
}
__device__ __forceinline__ void ph_route_a(const Params& p, char* lds, int l, int nrows, int bid, int nb) {
    const int lane = threadIdx.x & 63, wid = threadIdx.x >> 6, l5 = lane & 31, hf = lane >> 5;
    float* wr_s = (float*)lds; int* hist = (int*)(lds + 65536);
    { f32x4 wv[16];
#pragma unroll
      for (int q = 0; q < 16; ++q) wv[q] = ((const f32x4*)p.w_router)[threadIdx.x + q * NTHREADS];
#pragma unroll
      for (int q = 0; q < 16; ++q) { const int i = threadIdx.x + q * NTHREADS; const int k = i >> 2, ch = i & 3, pos = (k & 3) * 256 + (k >> 2); ((f32x4*)wr_s)[pos * 4 + (ch ^ ((pos >> 2) & 3))] = wv[q]; } }
    if (threadIdx.x < 32) hist[threadIdx.x] = 0;
    __syncthreads();
    const int sw = (l5 >> 2) & 3;
    const float* g = p.norm_g + (l * 2 + 1) * D_MODEL;
    const int RPB = (nrows + nb - 1) / nb, r0 = bid * RPB;
    for (int jb = wid * 2; jb < RPB; jb += 8) {
        if (r0 + jb >= nrows) break;
        const int jr = jb + hf, row = r0 + jr; const bool act = jr < RPB && row < nrows; const int rowc = act ? row : row - 1;
        const float* sh = modp(p, l, rowc, 3); const float* sc = modp(p, l, rowc, 4);
        f32x4 v[8];
        { const float* xr = xrow_cur(p, rowc);
#pragma unroll
          for (int j = 0; j < 8; ++j) v[j] = *(const f32x4*)(xr + j * 128 + l5 * 4); }
        float ss = 0.f;
#pragma unroll
        for (int j = 0; j < 8; ++j) ss += v[j][0] * v[j][0] + v[j][1] * v[j][1] + v[j][2] * v[j][2] + v[j][3] * v[j][3];
#pragma unroll
        for (int o2 = 1; o2 < 32; o2 <<= 1) ss += __shfl_xor(ss, o2);
        const float rstd = 1.0f / sqrtf(ss * (1.0f / D_MODEL) + EPS);
        float lg[16];
#pragma unroll
        for (int e = 0; e < 16; ++e) lg[e] = 0.f;
        int wofs = 0; asm volatile("" : "+v"(wofs)); const float* wr_i = wr_s + wofs;
#pragma unroll
        for (int j = 0; j < 8; ++j) { const int c = j * 128 + l5 * 4;
            const f32x4 o = v[j] * rstd * *(const f32x4*)(g + c) * (*(const f32x4*)(sc + c) + 1.0f) + *(const f32x4*)(sh + c);
            store4bf(p.hbuf + (size_t)rowc * D_MODEL + c, o);
#pragma unroll
            for (int r = 0; r < 4; ++r) { const f32x4* w4 = (const f32x4*)(wr_i + (r * 256 + l5 + 32 * j) * 16);
#pragma unroll
                for (int e4 = 0; e4 < 4; ++e4) { const f32x4 wv = w4[e4 ^ sw]; lg[e4 * 4 + 0] += o[r] * wv[0]; lg[e4 * 4 + 1] += o[r] * wv[1]; lg[e4 * 4 + 2] += o[r] * wv[2]; lg[e4 * 4 + 3] += o[r] * wv[3]; }
                if (r & 1) __builtin_amdgcn_sched_barrier(0); } }
        {
#pragma unroll
            for (int i = 0; i < 8; ++i) { const float a = lg[i], b = lg[i + 8]; const bool up = (lane & 16) != 0; const float recv = __shfl_xor(up ? a : b, 16); lg[i] = (up ? b : a) + recv; }
#pragma unroll
            for (int i = 0; i < 4; ++i) { const float a = lg[i], b = lg[i + 4]; const bool up = (lane & 8) != 0; const float recv = __shfl_xor(up ? a : b, 8); lg[i] = (up ? b : a) + recv; }
#pragma unroll
            for (int i = 0; i < 2; ++i) { const float a = lg[i], b = lg[i + 2]; const bool up = (lane & 4) != 0; const float recv = __shfl_xor(up ? a : b, 4); lg[i] = (up ? b : a) + recv; }
            { const float a = lg[0], b = lg[1]; const bool up = (lane & 2) != 0; const float recv = __shfl_xor(up ? a : b, 2); lg[0] = (up ? b : a) + recv; }
            lg[0] += __shfl_xor(lg[0], 1);
            const float mine = lg[0];
#pragma unroll
            for (int e = 0; e < 16; ++e) lg[e] = __shfl(mine, (lane & 32) + 2 * e);
        }
        if (l5 == 0 && act) {
            int gbest = 0, a = 0, bb = 1; float gbs = -1e30f, wa = 0.f, wb = 0.f;
#pragma unroll
            for (int gI = 0; gI < 4; ++gI) {
                float m1 = -1e30f, m2 = -1e30f, s1 = 0.f, s2 = 0.f; int i1 = 0, i2 = 0;
#pragma unroll
                for (int jj = 0; jj < 4; ++jj) { float sgv = sigmoid_f(lg[gI * 4 + jj]); float vv = sgv + p.b_router[gI * 4 + jj];
                    if (vv > m1) { m2 = m1; i2 = i1; s2 = s1; m1 = vv; i1 = jj; s1 = sgv; } else if (vv > m2) { m2 = vv; i2 = jj; s2 = sgv; } }
                float gs = m1 + m2;
                if (gs > gbs) { gbs = gs; gbest = gI; if (i1 < i2) { a = i1; bb = i2; wa = s1; wb = s2; } else { a = i2; bb = i1; wa = s2; wb = s1; } }
            }
            const float inv = 1.0f / (wa + wb);
            const int pidx = a == 0 ? bb - 1 : (a == 1 ? bb + 1 : 5);
            const int pr = gbest * 6 + pidx;
            p.rpair[row] = pr; p.tokw[row * 2 + 0] = wa * inv; p.tokw[row * 2 + 1] = wb * inv;
            atomicAdd(&hist[pr], 1);
        }
    }
    __syncthreads();
    if (threadIdx.x < 32) p.bh[bid * 32 + threadIdx.x] = hist[threadIdx.x];
}
__device__ __forceinline__ void ph_route_b(const Params& p, char* lds, int l, int nrows, int bid, int nb) {
    int* sb = (int*)lds;
    const int t = threadIdx.x;
    { int cb[32], ca[32];
#pragma unroll
      for (int q = 0; q < 32; ++q) { cb[q] = 0; ca[q] = 0; }
      for (int b = t; b < nb; b += NTHREADS) { const u32x4* src = (const u32x4*)(p.bh + b * 32); const bool before = b < bid;
#pragma unroll
          for (int q4 = 0; q4 < 6; ++q4) { const u32x4 v4 = src[q4];
#pragma unroll
              for (int e = 0; e < 4; ++e) { ca[q4 * 4 + e] += (int)v4[e]; cb[q4 * 4 + e] += before ? (int)v4[e] : 0; } } }
#pragma unroll
      for (int q = 0; q < 24; ++q) { sb[t * 33 + q] = cb[q]; sb[8448 + t * 33 + q] = ca[q]; } }
    __syncthreads();
    if (t < 64) { const int q = t & 31, which = t >> 5; int a = 0; const int* col = sb + which * 8448 + q;
        if (q < 24) { for (int r = 0; r < 256; ++r) a += col[r * 33]; }
        sb[16896 + which * 32 + q] = a; if (which == 1 && bid == 0) p.cnt[l * 32 + q] = a; }
    const int RPB = (nrows + nb - 1) / nb, row = bid * RPB + t; const bool act = t < RPB && row < nrows;
    int myp = 0; if (act) { myp = p.rpair[row]; sb[16896 + 64 + t] = myp; }
    __syncthreads();
    if (act) { int rank = 0; for (int j = 0; j < t; ++j) rank += (sb[16896 + 64 + j] == myp) ? 1 : 0; p.list[(size_t)myp * TT + sb[16896 + myp] + rank] = row; }
    __syncthreads();
}
__device__ __forceinline__ void ph_final(const Params& p, int bid, int nb) {
    const int lane = threadIdx.x & 63, wid = threadIdx.x >> 6;
    for (int row = (bid * 4 + wid) * 2; row < TX; row += nb * 8) {
        float* xa = p.out + (size_t)row * D_MODEL; float* xb = xa + D_MODEL;
        f32x4 va[4], vb[4]; float sa = 0.f, sb = 0.f;
#pragma unroll
        for (int j = 0; j < 4; ++j) { va[j] = *(const f32x4*)(xa + j * 256 + lane * 4); vb[j] = *(const f32x4*)(xb + j * 256 + lane * 4); }
#pragma unroll
        for (int j = 0; j < 4; ++j) { sa += va[j][0] * va[j][0] + va[j][1] * va[j][1] + va[j][2] * va[j][2] + va[j][3] * va[j][3]; sb += vb[j][0] * vb[j][0] + vb[j][1] * vb[j][1] + vb[j][2] * vb[j][2] + vb[j][3] * vb[j][3]; }
        const float ra = 1.0f / sqrtf(wave_sum(sa) * (1.0f / D_MODEL) + EPS), rb = 1.0f / sqrtf(wave_sum(sb) * (1.0f / D_MODEL) + EPS);
#pragma unroll
        for (int j = 0; j < 4; ++j) { const int c = j * 256 + lane * 4; const f32x4 gv = *(const f32x4*)(p.final_g + c); *(f32x4*)(xa + c) = va[j] * ra * gv; *(f32x4*)(xb + c) = vb[j] * rb * gv; }
    }
}

#define XB_TMO      128
#define XB_XCNT(j)  (256  + 64 * (j))
#define XB_XSUB(j)  (1280 + 64 * (j))
#define XB_XGEN(j)  (2304 + 64 * (j))
#define XB_TOP      3328
#define XB_TOPGEN   3392
#define XCD_BAR_WORDS 3456
#define XB_SPIN_CAP (1u << 20)
__device__ __forceinline__ unsigned xb_ld(unsigned* p)              { return __hip_atomic_load(p, __ATOMIC_RELAXED, __HIP_MEMORY_SCOPE_AGENT); }
__device__ __forceinline__ unsigned xb_add(unsigned* p, unsigned v) { return __hip_atomic_fetch_add(p, v, __ATOMIC_RELAXED, __HIP_MEMORY_SCOPE_AGENT); }
__device__ __forceinline__ unsigned xb_xcc_id() { return (unsigned)__builtin_amdgcn_s_getreg((3 << 11) | 20) & 0xFu; }
#define XB_SPIN(cond, bar) do { unsigned _sp = 0; while (cond) { __builtin_amdgcn_s_sleep(1); \
    if ((++_sp & 255u) == 0u) { if (xb_ld(&(bar)[XB_TMO])) break; if (_sp > XB_SPIN_CAP) { atomicAdd(&(bar)[XB_TMO], 1u); break; } } } } while (0)
struct XcdBarrier { unsigned* bar; unsigned x; volatile LAS unsigned* st; };
__device__ __forceinline__ XcdBarrier xcd_barrier_post(unsigned* bar, volatile LAS unsigned* st) {
    XcdBarrier b; b.bar = bar; b.x = xb_xcc_id(); b.st = st;
    if (threadIdx.x == 0) (void)xb_add(&bar[XB_XCNT(b.x)], 1u);
    return b;
}
__device__ __forceinline__ void xcd_barrier_complete(unsigned* bar, unsigned x, unsigned& nloc, unsigned& nx) {
    const unsigned G = gridDim.x * gridDim.y * gridDim.z;
    unsigned sum, cnt, mine, sp = 0u;
    for (;;) {
        sum = 0u; cnt = 0u; mine = 0u;
#pragma unroll
        for (unsigned j = 0; j < 16; ++j) { const unsigned c = xb_ld(&bar[XB_XCNT(j)]); sum += c; cnt += (c > 0u) ? 1u : 0u; mine = (j == x) ? c : mine; }
        if (sum == G) break;
        __builtin_amdgcn_s_sleep(1);
        if ((++sp & 255u) == 0u) { if (xb_ld(&bar[XB_TMO])) break; if (sp > XB_SPIN_CAP) { atomicAdd(&bar[XB_TMO], 1u); break; } }
    }
    nloc = mine > 0u ? mine : 1u; nx = cnt > 0u ? cnt : 1u;
}
__device__ __forceinline__ void xcd_barrier(const XcdBarrier& b) {
    asm volatile("s_waitcnt vmcnt(0)" ::: "memory");
    __syncthreads();
    if (threadIdx.x == 0) {
        unsigned* bar = b.bar;
        __builtin_amdgcn_s_waitcnt(0);
        unsigned nloc = b.st[0], nx = b.st[1];
        if (nloc == 0u) { xcd_barrier_complete(bar, b.x, nloc, nx); b.st[0] = nloc; b.st[1] = nx; }
        const unsigned old = xb_add(&bar[XB_XSUB(b.x)], 1u);
        const unsigned gen = old / nloc;
        if (old + 1u == (gen + 1u) * nloc) {
            __builtin_amdgcn_fence(__ATOMIC_RELEASE, "agent");
            asm volatile("s_waitcnt vmcnt(0)" ::: "memory");
            const unsigned og = xb_add(&bar[XB_TOP], 1u);
            const unsigned tg = og / nx;
            if (og + 1u == (tg + 1u) * nx) xb_add(&bar[XB_TOPGEN], 1u);
            else XB_SPIN(xb_ld(&bar[XB_TOPGEN]) == tg, bar);
            __builtin_amdgcn_fence(__ATOMIC_ACQUIRE, "agent");
            xb_add(&bar[XB_XGEN(b.x)], 1u);
            asm volatile("s_waitcnt vmcnt(0)" ::: "memory");
        } else {
            XB_SPIN(xb_ld(&bar[XB_XGEN(b.x)]) == gen, bar);
            __builtin_amdgcn_fence(__ATOMIC_ACQUIRE, "agent");
            asm volatile("s_waitcnt vmcnt(0)" ::: "memory");
        }
    }
    __syncthreads();
}

__device__ __forceinline__ void ph_mix1(const Params& p, char* lds, int bid, int nb, unsigned long long* tsplit = nullptr) {
    const bool hy_first = bid >= (nb >> 1);
    for (int rep = 0; rep < 3; ++rep) {
        if (rep == 1) {
            for (int u = bid; u < NU_LAT; u += nb) { const int blk = u % (SEQ / 128), h = (u / (SEQ / 128)) % 8, b = u / (8 * (SEQ / 128)); const int s0 = blk * 128;
                attn_unit<0>(lds, p.QC + (size_t)(b * SEQ + s0) * 512 + h * 64, p.KC + (size_t)(b * 2 + h / 4) * LKV * 64, p.VCt + (size_t)(b * 2 + h / 4) * 64 * LKV,
                             p.Y + (size_t)(b * SEQ + s0) * 1024 + h * 64, s0, CTX_LEN / 64, 0, SEQ / 64, 0.f, false, nullptr); }
            if (tsplit) *tsplit = __builtin_amdgcn_s_memrealtime();
        } else if ((rep == 0) == hy_first) {
            __syncthreads();
            for (int c = hy_first ? bid - (nb >> 1) : bid + (nb >> 1); c < D_CH; c += nb) hyena_channel(p, c, (float*)lds);
            __syncthreads();
        }
    }
}
constexpr int TR_ITEMS = BATCH * (D_CH / 64) * (SEQ / 64);
__device__ __forceinline__ void tr_item(const Params& p, char* lds, int it) {
    bf16_t* T = (bf16_t*)lds; const int tid = threadIdx.x;
    const int sb = it % (SEQ / 64), cb = (it / (SEQ / 64)) % (D_CH / 64), b = it / ((SEQ / 64) * (D_CH / 64));
    { const int c = tid >> 2, q = tid & 3;
      const u32x4* src = (const u32x4*)(p.YHT + ((size_t)b * D_CH + cb * 64 + c) * SEQ + sb * 64 + q * 16);
      const u32x4 v0 = src[0], v1 = src[1]; unsigned* d = (unsigned*)(T + c * 66 + q * 16);
      d[0] = v0.x; d[1] = v0.y; d[2] = v0.z; d[3] = v0.w; d[4] = v1.x; d[5] = v1.y; d[6] = v1.z; d[7] = v1.w; }
    __syncthreads();
    { const int s = tid >> 2, q = tid & 3;
      unsigned w[8];
#pragma unroll
      for (int i = 0; i < 8; ++i) w[i] = (unsigned)T[(q * 16 + 2 * i) * 66 + s] | ((unsigned)T[(q * 16 + 2 * i + 1) * 66 + s] << 16);
      u32x4* dst = (u32x4*)(p.Y + ((size_t)b * SEQ + sb * 64 + s) * 1024 + 512 + cb * 64 + q * 16);
      dst[0] = (u32x4){w[0], w[1], w[2], w[3]}; dst[1] = (u32x4){w[4], w[5], w[6], w[7]}; }
    __syncthreads();
}
enum { PH_PREP = 0, PH_NORM0, PH_INPROJ0, PH_ATTN0, PH_OUT0, PH_ROUTE0, PH_ROUTEB0, PH_UP0, PH_DOWN0, PH_NORM1, PH_INPROJ1, PH_MIX1, PH_HY1, PH_TR1, PH_OUT1, PH_ROUTE1, PH_ROUTEB1, PH_UP1, PH_DOWN1, PH_FINAL, PH_COUNT };
typedef const __attribute__((address_space(4))) Params* KParams;
__global__ void __launch_bounds__(NTHREADS, 2) mega(Params p_arg, int lo, int hi) {
    extern __shared__ __attribute__((aligned(16))) char lds[];
    const int bid = blockIdx.x, nb = gridDim.x;
    volatile LAS unsigned* st = (volatile LAS unsigned*)(lds + LDS_BYTES - 16);
    if (threadIdx.x < 4) st[threadIdx.x] = 0u;
    __syncthreads();
    KParams kp = (KParams)__builtin_amdgcn_kernarg_segment_ptr();
    XcdBarrier bar; bar.bar = kp->bar; bar.x = 0; bar.st = st;
    if (hi - lo > 1) bar = xcd_barrier_post(kp->bar, st);
#ifdef PROBE_PA
    volatile LAS unsigned long long* pst = (volatile LAS unsigned long long*)(lds + LDS_BYTES - 64);
    if (bid == 0 && threadIdx.x == 0) { pst[0] = __builtin_amdgcn_s_memrealtime(); pst[1] = 0; pst[2] = 0; }
#define STAMP(PH) if (bid == 0 && threadIdx.x == 0) { const unsigned long long now_ = __builtin_amdgcn_s_memrealtime(); if ((PH) == PROBE_PA) pst[1] = now_ - pst[0]; if ((PH) == PROBE_PB) pst[2] = now_ - pst[0]; pst[0] = now_; }
#define SUBSTAMP(ID) if ((PROBE_PA == (ID) || PROBE_PB == (ID)) && bid == 0 && threadIdx.x == 0) { const unsigned long long d_ = __builtin_amdgcn_s_memrealtime() - pst[0]; if (PROBE_PA == (ID)) pst[1] = d_; else pst[2] = d_; }
#define STAMP2(PH) SUBSTAMP(100 + (PH))
#else
#define STAMP(PH)
#define STAMP2(PH)
#define SUBSTAMP(ID)
#endif
#define PHASE(PH, ...) if (lo <= (PH) && (PH) < hi) { { KParams kq_ = kp; asm volatile("" : "+s"(kq_)); const Params& p = *(const Params*)kq_; __VA_ARGS__; } STAMP2(PH) if ((PH) + 1 < hi) xcd_barrier(bar); STAMP(PH) }
    PHASE(PH_PREP, { for (int it = bid; it < MOD_ITEMS + CVT_EARLY; it += nb) { if (it < MOD_ITEMS) mod_item(p, lds, it); else cvt_item(p, lds, it - MOD_ITEMS); if (it == bid) { SUBSTAMP(200) } }
        SUBSTAMP(201) d_rope(p); SUBSTAMP(202) d_hy_h1(p); })
    PHASE(PH_NORM0, { ph_norm(p, 0, 0, TT, bid, nb); SUBSTAMP(210) d_hy_h2(p); })
    PHASE(PH_INPROJ0, ph_inproj<0>(p, lds, bid, nb))
    PHASE(PH_ATTN0, { const bool xl_ = (nb & 7) == 0;
        if (bid >= (nb >> 1)) { for (int j = bid; j < CVT_MOE_L; j += nb) cvt_item(p, lds, cvt_moe_index(0, j)); __syncthreads(); ph_attn0(p, lds, xl_, bid & 7, xl_ ? bid >> 3 : bid, xl_ ? nb >> 3 : nb); }
        else { ph_attn0(p, lds, xl_, bid & 7, xl_ ? bid >> 3 : bid, xl_ ? nb >> 3 : nb); __syncthreads(); for (int j = bid; j < CVT_MOE_L; j += nb) cvt_item(p, lds, cvt_moe_index(0, j)); } })
    PHASE(PH_OUT0, { ph_outproj<0>(p, lds, bid, nb);
        __syncthreads(); { const int full_ = (nb & 7) == 0 ? ((MT_ALL / 8) * 8) % (nb >> 3) : 0;
          const int lb_ = bid >> 3; if ((nb & 7) != 0) { for (int it = bid; it < FILT_ITEMS + CVT_MOE_L; it += nb) { if (it < FILT_ITEMS) filt_item(p, lds, it); else cvt_item(p, lds, cvt_moe_index(1, it - FILT_ITEMS)); } }
          else if (lb_ >= full_) { for (int it = (lb_ - full_) * 8 + (bid & 7); it < FILT_ITEMS + CVT_MOE_L; it += nb - full_ * 8) { if (it < FILT_ITEMS) filt_item(p, lds, it); else cvt_item(p, lds, cvt_moe_index(1, it - FILT_ITEMS)); } } } })
    PHASE(PH_ROUTE0, ph_route_a(p, lds, 0, TT, bid, nb))
    PHASE(PH_ROUTEB0, ph_route_b(p, lds, 0, TT, bid, nb))
    PHASE(PH_UP0, ph_moe_up(p, lds, 0, bid, nb))
    PHASE(PH_DOWN0, ph_moe_down(p, lds, 0, bid, nb))
    PHASE(PH_NORM1, ph_norm(p, 1, 0, TT, bid, nb))
    PHASE(PH_INPROJ1, ph_inproj<1>(p, lds, bid, nb))
    PHASE(PH_MIX1, ph_attnC(p, lds, bid, nb))
    PHASE(PH_HY1, for (int c = bid; c < D_CH; c += nb) hyena_channel(p, c, (float*)lds))
    PHASE(PH_TR1, for (int it = bid; it < TR_ITEMS; it += nb) tr_item(p, lds, it))
    PHASE(PH_OUT1, ph_outproj<1>(p, lds, bid, nb))
    PHASE(PH_ROUTE1, ph_route_a(p, lds, 1, TX, bid, nb))
    PHASE(PH_ROUTEB1, ph_route_b(p, lds, 1, TX, bid, nb))
    PHASE(PH_UP1, ph_moe_up(p, lds, 1, bid, nb))
    PHASE(PH_DOWN1, ph_moe_down(p, lds, 1, bid, nb))
    PHASE(PH_FINAL, ph_final(p, bid, nb))
#ifdef PROBE_PA
    if (bid == 0 && threadIdx.x == 0) {
        const unsigned long long t_a = pst[1], t_b = pst[2]; const unsigned long long delay = 2 * t_a + 204800ull * ((t_b + 200) / 400); const unsigned long long t0 = __builtin_amdgcn_s_memrealtime();
        while (__builtin_amdgcn_s_memrealtime() - t0 < delay) __builtin_amdgcn_s_sleep(32);
    }
#endif
}
extern "C" void kernel_launch(void* const* d_in, const int* in_sizes, int n_in, void* d_out, int out_size, void* d_ws, size_t ws_size, hipStream_t stream) {
    static int grid = 0;
    if (grid == 0) {
        int dev = 0, cus = 0;
        if (hipGetDevice(&dev) != hipSuccess || hipDeviceGetAttribute(&cus, hipDeviceAttributeMultiprocessorCount, dev) != hipSuccess) { fprintf(stderr, "kernel_launch: device query failed\n"); grid = -1; return; }
        if (hipFuncSetAttribute((const void*)mega, hipFuncAttributeMaxDynamicSharedMemorySize, LDS_BYTES) != hipSuccess) { fprintf(stderr, "kernel_launch: hipFuncSetAttribute failed\n"); grid = -1; return; }
        grid = 2 * cus;
    }
    if (grid < 0) return;
    Params p{};
    size_t need = setup_ws(p, (char*)d_ws);
    if (n_in != 32 || need > ws_size || out_size != TX * D_MODEL) { fprintf(stderr, "kernel_launch: bad config n_in %d ws %zu need %zu out %d\n", n_in, ws_size, need, out_size); return; }
    fill_inputs(p, d_in, d_out);
    hipMemsetAsync(p.bar, 0, 64 * 1024 + 256, stream);
    mega<<<dim3(grid), dim3(NTHREADS), LDS_BYTES, stream>>>(p, 0, PH_COUNT);
}
```
